# Optimizing an MI355X kernel written in HIP

```python
import math
import jax, jax.numpy as jnp
from jax import lax
import numpy as np

D_MODEL = 1024
BATCH = 1
SEQ = 16384
DEPTH = 2

GRID_W = 64
CTX_LEN = 256
RMS_EPS = 1e-6
N_MOD = 6

SCONV_W = 3
CONV_CH = D_MODEL // 2
SSM_CH = D_MODEL // 2
SSM_H = 16
SSM_G = SSM_CH // SSM_H
SSM_P = 64
EVEN_IN = 3 * CONV_CH + SSM_CH
EVEN_MIX = CONV_CH + SSM_CH

DN_HEADS = 8
DN_DK = 128
DN_DV = 128
DN_QK = DN_HEADS * DN_DK
DN_V = DN_HEADS * DN_DV
DN_CONV_CH = 2 * DN_QK + DN_V
ODD_IN = 2 * DN_QK + 2 * DN_V + 4 * DN_HEADS
DN_CHUNK = 64

PEER_HEADS = 8
PEER_KEYS = 128
PEER_EXPERTS = PEER_KEYS * PEER_KEYS
PEER_TOPK = 16
PEER_DKEY = 256
PEER_BLOCK = 128

N_EVEN = (DEPTH + 1) // 2
N_ODD = DEPTH // 2

kernel_name = 'hybrid_conv_s5_gdn_peer_dit'


def rmsnorm(x, g):
    xf = x.astype(jnp.float32)
    y = xf * lax.rsqrt(jnp.mean(xf * xf, axis=-1, keepdims=True) + RMS_EPS)
    return (y * g.astype(jnp.float32)).astype(x.dtype)


def modulate(h, shift, scale):
    return h * (1 + scale) + shift


def l2norm(x):
    return x * lax.rsqrt(jnp.sum(x * x, axis=-1, keepdims=True) + 1e-6)


def dwconv3(x, w):
    L = x.shape[-2]
    pad = [(0, 0)] * (x.ndim - 2) + [(1, 1), (0, 0)]
    xp = jnp.pad(x, pad)
    return xp[..., 0:L, :] * w[0] + xp[..., 1:L + 1, :] * w[1] + xp[..., 2:L + 2, :] * w[2]


def grid_conv(x, w):
    B, L, C = x.shape
    rows = L // GRID_W
    return dwconv3(x.reshape(B, rows, GRID_W, C), w).reshape(B, L, C)


def s5_discretize(lam_re, lam_im, log_dt, b_re, b_im):
    lam_re = jnp.minimum(lam_re.astype(jnp.float32), -1e-4)
    lam_im = lam_im.astype(jnp.float32)
    dt = jnp.exp(log_dt.astype(jnp.float32))[:, None]
    mag = jnp.exp(lam_re * dt)
    ab_re = mag * jnp.cos(lam_im * dt)
    ab_im = mag * jnp.sin(lam_im * dt)
    den = lam_re * lam_re + lam_im * lam_im
    f_re = ((ab_re - 1) * lam_re + ab_im * lam_im) / den
    f_im = (ab_im * lam_re - (ab_re - 1) * lam_im) / den
    b_re = b_re.astype(jnp.float32)
    b_im = b_im.astype(jnp.float32)
    bb_re = f_re[..., None] * b_re - f_im[..., None] * b_im
    bb_im = f_re[..., None] * b_im + f_im[..., None] * b_re
    return ab_re, ab_im, bb_re, bb_im


def complex_affine_combine(e1, e2):
    a1r, a1i, b1r, b1i = e1
    a2r, a2i, b2r, b2i = e2
    ar = a1r * a2r - a1i * a2i
    ai = a1r * a2i + a1i * a2r
    br = a2r * b1r - a2i * b1i + b2r
    bi = a2r * b1i + a2i * b1r + b2i
    return ar, ai, br, bi


def s5_scan(ab_re, ab_im, bu_re, bu_im, reverse, s0=None):
    a_re = jnp.broadcast_to(ab_re, bu_re.shape)
    a_im = jnp.broadcast_to(ab_im, bu_im.shape)
    A_re, A_im, s_re, s_im = lax.associative_scan(
        complex_affine_combine, (a_re, a_im, bu_re, bu_im), reverse=reverse, axis=1)
    if s0 is not None:
        r0 = s0[0][:, None]
        i0 = s0[1][:, None]
        s_re, s_im = s_re + A_re * r0 - A_im * i0, s_im + A_re * i0 + A_im * r0
    return s_re, s_im


def s5_bidir(u_ctx, u_lat, lam_re, lam_im, log_dt, b_re, b_im, c_re, c_im, d_skip, need_ctx_out):
    B, Lc, _ = u_ctx.shape
    L = u_lat.shape[1]
    uc = u_ctx.astype(jnp.float32).reshape(B, Lc, SSM_G, SSM_H)
    ul = u_lat.astype(jnp.float32).reshape(B, L, SSM_G, SSM_H)
    dsk = d_skip.astype(jnp.float32).reshape(SSM_G, SSM_H)
    y_lat = ul * dsk
    y_ctx = uc * dsk
    for di in range(2):
        rev = di == 1
        ab_re, ab_im, bb_re, bb_im = s5_discretize(lam_re[di], lam_im[di], log_dt[di], b_re[di], b_im[di])
        cr = c_re[di].astype(jnp.float32)
        ci = c_im[di].astype(jnp.float32)
        bu_c = (jnp.einsum('blgh,gph->blgp', uc, bb_re), jnp.einsum('blgh,gph->blgp', uc, bb_im))
        bu_l = (jnp.einsum('blgh,gph->blgp', ul, bb_re), jnp.einsum('blgh,gph->blgp', ul, bb_im))
        sc_re, sc_im = s5_scan(ab_re, ab_im, bu_c[0], bu_c[1], rev)
        end = 0 if rev else -1
        sl_re, sl_im = s5_scan(ab_re, ab_im, bu_l[0], bu_l[1], rev, (sc_re[:, end], sc_im[:, end]))
        y_lat = y_lat + jnp.einsum('blgp,ghp->blgh', sl_re, cr) - jnp.einsum('blgp,ghp->blgh', sl_im, ci)
        if need_ctx_out:
            y_ctx = y_ctx + jnp.einsum('blgp,ghp->blgh', sc_re, cr) - jnp.einsum('blgp,ghp->blgh', sc_im, ci)
    y_lat = y_lat.reshape(B, L, SSM_CH).astype(u_lat.dtype)
    y_ctx = y_ctx.reshape(B, Lc, SSM_CH).astype(u_ctx.dtype) if need_ctx_out else None
    return y_ctx, y_lat


def even_mixer(a_ctx, a_lat, w_in, conv_w, lam_re, lam_im, log_dt, b_re, b_im, c_re, c_im,
               d_skip, glu_w, glu_b, w_out, need_ctx_out):
    p_ctx = a_ctx @ w_in
    p_lat = a_lat @ w_in

    def conv_branch(p, conv_fn):
        u = p[..., :CONV_CH]
        g_in = p[..., CONV_CH:2 * CONV_CH]
        g_out = p[..., 2 * CONV_CH:3 * CONV_CH]
        return g_out * conv_fn(g_in * u, conv_w)

    def half_glu(y):
        y = jax.nn.gelu(y)
        return y * jax.nn.sigmoid(y @ glu_w + glu_b)

    s_ctx, s_lat = s5_bidir(p_ctx[..., 3 * CONV_CH:], p_lat[..., 3 * CONV_CH:], lam_re, lam_im, log_dt,
                            b_re, b_im, c_re, c_im, d_skip, need_ctx_out)
    y_lat = jnp.concatenate([conv_branch(p_lat, grid_conv), half_glu(s_lat)], axis=-1) @ w_out
    y_ctx = None
    if need_ctx_out:
        y_ctx = jnp.concatenate([conv_branch(p_ctx, dwconv3), half_glu(s_ctx)], axis=-1) @ w_out
    return y_ctx, y_lat


def gdn_chunk(q, k, v, g, beta, s0):
    B, H, L, dk = q.shape
    dv = v.shape[-1]
    C = DN_CHUNK
    N = L // C
    q = q.reshape(B, H, N, C, dk)
    k = k.reshape(B, H, N, C, dk)
    v = v.reshape(B, H, N, C, dv)
    g = jnp.cumsum(g.reshape(B, H, N, C), axis=-1)
    beta = beta.reshape(B, H, N, C)
    kb = k * beta[..., None]
    vb = v * beta[..., None]
    incl = jnp.tril(jnp.ones((C, C), dtype=bool))
    strict = jnp.tril(jnp.ones((C, C), dtype=bool), -1)
    diff = g[..., :, None] - g[..., None, :]
    decay = jnp.where(incl, jnp.exp(jnp.where(incl, diff, 0.0)), 0.0)
    a = jnp.where(strict, jnp.einsum('bhnik,bhnjk->bhnij', kb, k) * decay, 0.0)
    eye = jnp.eye(C, dtype=q.dtype)
    tinv = lax.linalg.triangular_solve(eye + a, jnp.broadcast_to(eye, a.shape), left_side=True,
                                       lower=True, unit_diagonal=True)
    u = jnp.einsum('bhnij,bhnjv->bhniv', tinv, vb)
    w = jnp.einsum('bhnij,bhnjk->bhnik', tinv, kb * jnp.exp(g)[..., None])
    attn = jnp.einsum('bhnik,bhnjk->bhnij', q, k) * decay
    g_last = g[..., -1]
    q_dec = q * jnp.exp(g)[..., None]
    k_dec = k * jnp.exp(g_last[..., None] - g)[..., None]

    def step(S, inp):
        qd, kd, ui, wi, ai, gl = inp
        v_new = ui - jnp.einsum('bhck,bhkv->bhcv', wi, S)
        o = jnp.einsum('bhck,bhkv->bhcv', qd, S) + jnp.einsum('bhij,bhjv->bhiv', ai, v_new)
        S = S * jnp.exp(gl)[..., None, None] + jnp.einsum('bhck,bhcv->bhkv', kd, v_new)
        return S, o

    xs = tuple(jnp.moveaxis(t_, 2, 0) for t_ in (q_dec, k_dec, u, w, attn, g_last))
    s_final, o = lax.scan(step, s0, xs)
    return jnp.moveaxis(o, 0, 2).reshape(B, H, L, dv), s_final


def gdn_prep(p, conv_fn, conv_w, a_log, dt_bias):
    B, L, _ = p.shape
    qkv = jax.nn.silu(conv_fn(p[..., :DN_CONV_CH], conv_w)).astype(jnp.float32)
    z = p[..., DN_CONV_CH:DN_CONV_CH + DN_V]
    o0 = DN_CONV_CH + DN_V
    a = p[..., o0:o0 + 2 * DN_HEADS].astype(jnp.float32).reshape(B, L, 2, DN_HEADS)
    b = p[..., o0 + 2 * DN_HEADS:].astype(jnp.float32).reshape(B, L, 2, DN_HEADS)
    heads = lambda t, dh: t.reshape(B, L, DN_HEADS, dh).transpose(0, 2, 1, 3)
    q = l2norm(heads(qkv[..., :DN_QK], DN_DK)) * (DN_DK ** -0.5)
    k = l2norm(heads(qkv[..., DN_QK:2 * DN_QK], DN_DK))
    v = heads(qkv[..., 2 * DN_QK:], DN_DV)
    g = -jnp.exp(a_log.astype(jnp.float32)) * jax.nn.softplus(a + dt_bias.astype(jnp.float32))
    beta = jax.nn.sigmoid(b)
    return q, k, v, g.transpose(2, 0, 3, 1), beta.transpose(2, 0, 3, 1), z


def gdn_mixer(a_ctx, a_lat, w_in, conv_w, a_log, dt_bias, norm_g, w_out, need_ctx_out):
    qc, kc, vc, gc, bc, zc = gdn_prep(a_ctx @ w_in, dwconv3, conv_w, a_log, dt_bias)
    ql, kl, vl, gl, bl, zl = gdn_prep(a_lat @ w_in, grid_conv, conv_w, a_log, dt_bias)
    B = a_lat.shape[0]
    zero = jnp.zeros((B, DN_HEADS, DN_DK, DN_DV), jnp.float32)
    flip = lambda t: jnp.flip(t, axis=2)
    oc_f, sc_f = gdn_chunk(qc, kc, vc, gc[0], bc[0], zero)
    oc_b, sc_b = gdn_chunk(flip(qc), flip(kc), flip(vc), flip(gc[1]), flip(bc[1]), zero)
    ol_f, _ = gdn_chunk(ql, kl, vl, gl[0], bl[0], sc_f)
    ol_b, _ = gdn_chunk(flip(ql), flip(kl), flip(vl), flip(gl[1]), flip(bl[1]), sc_b)

    def readout(o, z):
        Bz, L, _ = z.shape
        o = o.transpose(0, 2, 1, 3)
        y = rmsnorm(o, norm_g) * jax.nn.silu(z.astype(jnp.float32)).reshape(Bz, L, DN_HEADS, DN_DV)
        return y.reshape(Bz, L, DN_V).astype(z.dtype) @ w_out

    y_lat = readout(ol_f + flip(ol_b), zl)
    y_ctx = readout(oc_f + flip(oc_b), zc) if need_ctx_out else None
    return y_ctx, y_lat


def peer(h, wq, subkeys, u_tab, v_tab):
    B, L, D = h.shape
    T = B * L
    hf = h.reshape(T, D)
    q = (hf @ wq).astype(jnp.float32).reshape(T, PEER_HEADS, 2, PEER_DKEY // 2)
    s = jnp.einsum('thsk,snk->thsn', q, subkeys.astype(jnp.float32))
    s_top, i_top = lax.top_k(s, PEER_TOPK)
    kk = PEER_TOPK * PEER_TOPK
    cand = (s_top[:, :, 0, :, None] + s_top[:, :, 1, None, :]).reshape(T, PEER_HEADS, kk)
    cand_idx = (i_top[:, :, 0, :, None] * PEER_KEYS + i_top[:, :, 1, None, :]).reshape(T, PEER_HEADS, kk)
    best, pos = lax.top_k(cand, PEER_TOPK)
    idx = jnp.take_along_axis(cand_idx, pos, axis=-1)
    gate = jax.nn.softmax(best, axis=-1).astype(h.dtype)
    nb = T // PEER_BLOCK

    def block(args):
        xb, ib, gb = args
        act = jax.nn.gelu(jnp.einsum('td,thkd->thk', xb, u_tab[ib]))
        return jnp.einsum('thk,thkd->td', act * gb, v_tab[ib])

    y = lax.map(block, (hf.reshape(nb, PEER_BLOCK, D),
                        idx.reshape(nb, PEER_BLOCK, PEER_HEADS, PEER_TOPK),
                        gate.reshape(nb, PEER_BLOCK, PEER_HEADS, PEER_TOPK)))
    return y.reshape(B, L, D)


def setup_inputs(seed: int = 0) -> dict:
    key = jax.random.key(seed)
    ks = iter(jax.random.split(key, 48))
    f32 = jnp.float32
    nrm = lambda shape, s: jax.random.normal(next(ks), shape, f32) * s
    D = D_MODEL
    x = nrm((BATCH, SEQ, D), 1.0)
    c = nrm((BATCH, D), 1.0)
    ctx = nrm((BATCH, CTX_LEN, D), 1.0)
    c_ctx = nrm((D,), 1.0)
    ada_w = nrm((DEPTH, D, N_MOD * D), 0.5 * D ** -0.5)
    ada_b = nrm((DEPTH, N_MOD * D), 0.01)
    norm1_g = 1.0 + nrm((DEPTH, D), 0.05)
    norm2_g = 1.0 + nrm((DEPTH, D), 0.05)
    e_w_in = nrm((N_EVEN, D, EVEN_IN), D ** -0.5)
    e_conv_w = nrm((N_EVEN, SCONV_W, CONV_CH), 0.5)
    n_idx = jnp.arange(SSM_P, dtype=f32)
    s5_lam_re = -0.5 + nrm((N_EVEN, 2, SSM_G, SSM_P), 0.01)
    s5_lam_im = math.pi * n_idx + nrm((N_EVEN, 2, SSM_G, SSM_P), 0.01)
    s5_log_dt = jax.random.uniform(next(ks), (N_EVEN, 2, SSM_G), f32, math.log(1e-3), math.log(1e-1))
    s5_b_re = nrm((N_EVEN, 2, SSM_G, SSM_P, SSM_H), (2 * SSM_H) ** -0.5)
    s5_b_im = nrm((N_EVEN, 2, SSM_G, SSM_P, SSM_H), (2 * SSM_H) ** -0.5)
    s5_c_re = nrm((N_EVEN, 2, SSM_G, SSM_H, SSM_P), (2 * SSM_P) ** -0.5)
    s5_c_im = nrm((N_EVEN, 2, SSM_G, SSM_H, SSM_P), (2 * SSM_P) ** -0.5)
    s5_d = nrm((N_EVEN, SSM_CH), 1.0)
    s5_glu_w = nrm((N_EVEN, SSM_CH, SSM_CH), SSM_CH ** -0.5)
    s5_glu_b = nrm((N_EVEN, SSM_CH), 0.01)
    e_w_out = nrm((N_EVEN, EVEN_MIX, D), EVEN_MIX ** -0.5)
    o_w_in = nrm((N_ODD, D, ODD_IN), D ** -0.5)
    dn_conv_w = nrm((N_ODD, SCONV_W, DN_CONV_CH), 0.5)
    dn_a_log = jnp.log(jax.random.uniform(next(ks), (N_ODD, 2, DN_HEADS), f32, 1.0, 16.0))
    dt0 = jnp.exp(jax.random.uniform(next(ks), (N_ODD, 2, DN_HEADS), f32, math.log(1e-3), math.log(1e-1)))
    dn_dt_bias = dt0 + jnp.log(-jnp.expm1(-dt0))
    dn_norm_g = 1.0 + nrm((N_ODD, DN_DV), 0.05)
    o_w_out = nrm((N_ODD, DN_V, D), DN_V ** -0.5)
    peer_wq = nrm((DEPTH, D, PEER_HEADS * PEER_DKEY), D ** -0.5)
    peer_subkeys = nrm((DEPTH, 2, PEER_KEYS, PEER_DKEY // 2), (PEER_DKEY // 2) ** -0.5)
    peer_u = nrm((DEPTH, PEER_EXPERTS, D), D ** -0.5)
    peer_v = nrm((DEPTH, PEER_EXPERTS, D), 0.5)
    final_g = 1.0 + nrm((D,), 0.05)
    return {'x': x, 'c': c, 'ctx': ctx, 'c_ctx': c_ctx, 'ada_w': ada_w, 'ada_b': ada_b,
            'norm1_g': norm1_g, 'norm2_g': norm2_g, 'e_w_in': e_w_in, 'e_conv_w': e_conv_w,
            's5_lam_re': s5_lam_re, 's5_lam_im': s5_lam_im, 's5_log_dt': s5_log_dt,
            's5_b_re': s5_b_re, 's5_b_im': s5_b_im, 's5_c_re': s5_c_re, 's5_c_im': s5_c_im,
            's5_d': s5_d, 's5_glu_w': s5_glu_w, 's5_glu_b': s5_glu_b, 'e_w_out': e_w_out,
            'o_w_in': o_w_in, 'dn_conv_w': dn_conv_w, 'dn_a_log': dn_a_log, 'dn_dt_bias': dn_dt_bias,
            'dn_norm_g': dn_norm_g, 'o_w_out': o_w_out, 'peer_wq': peer_wq, 'peer_subkeys': peer_subkeys,
            'peer_u': peer_u, 'peer_v': peer_v, 'final_g': final_g}


def reference(x, c, ctx, c_ctx, ada_w, ada_b, norm1_g, norm2_g, e_w_in, e_conv_w,
              s5_lam_re, s5_lam_im, s5_log_dt, s5_b_re, s5_b_im, s5_c_re, s5_c_im,
              s5_d, s5_glu_w, s5_glu_b, e_w_out, o_w_in, dn_conv_w, dn_a_log, dn_dt_bias,
              dn_norm_g, o_w_out, peer_wq, peer_subkeys, peer_u, peer_v, final_g):
    h_lat = x
    h_ctx = ctx
    sc_lat = jax.nn.silu(c)
    sc_ctx = jax.nn.silu(c_ctx)
    for l in range(DEPTH):
        last = l == DEPTH - 1
        i = l // 2
        m_lat = jnp.split((sc_lat @ ada_w[l] + ada_b[l])[:, None, :], N_MOD, axis=-1)
        m_ctx = jnp.split(sc_ctx @ ada_w[l] + ada_b[l], N_MOD, axis=-1)
        a_lat = modulate(rmsnorm(h_lat, norm1_g[l]), m_lat[0], m_lat[1])
        a_ctx = modulate(rmsnorm(h_ctx, norm1_g[l]), m_ctx[0], m_ctx[1])
        if l % 2 == 0:
            y_ctx, y_lat = even_mixer(a_ctx, a_lat, e_w_in[i], e_conv_w[i], s5_lam_re[i], s5_lam_im[i],
                                      s5_log_dt[i], s5_b_re[i], s5_b_im[i], s5_c_re[i], s5_c_im[i],
                                      s5_d[i], s5_glu_w[i], s5_glu_b[i], e_w_out[i], not last)
        else:
            y_ctx, y_lat = gdn_mixer(a_ctx, a_lat, o_w_in[i], dn_conv_w[i], dn_a_log[i], dn_dt_bias[i],
                                     dn_norm_g[i], o_w_out[i], not last)
        h_lat = h_lat + m_lat[2] * y_lat
        h_lat = h_lat + m_lat[5] * peer(modulate(rmsnorm(h_lat, norm2_g[l]), m_lat[3], m_lat[4]),
                                        peer_wq[l], peer_subkeys[l], peer_u[l], peer_v[l])
        if not last:
            h_ctx = h_ctx + m_ctx[2] * y_ctx
            h_ctx = h_ctx + m_ctx[5] * peer(modulate(rmsnorm(h_ctx, norm2_g[l]), m_ctx[3], m_ctx[4]),
                                            peer_wq[l], peer_subkeys[l], peer_u[l], peer_v[l])
    return rmsnorm(h_lat, final_g)
```

```cpp
#include <hip/hip_runtime.h>
#include <hip/hip_cooperative_groups.h>
#include <cstdio>
#include <cstdint>
namespace cg = cooperative_groups;

typedef unsigned short bf16_t;
typedef short bf16x8 __attribute__((ext_vector_type(8)));
typedef float f32x4 __attribute__((ext_vector_type(4)));
typedef float f32x16 __attribute__((ext_vector_type(16)));
typedef unsigned u32x4 __attribute__((ext_vector_type(4)));

constexpr int D = 1024, SEQ = 16384, CTX = 256, R = SEQ + CTX;
constexpr int NCH = R / 64;
constexpr int NCH_LAT = SEQ / 64;
constexpr int NTHREADS = 512;
constexpr int ODD_IN = 4128;
constexpr int NUNITS = 16 * NCH;

constexpr size_t al256(size_t x) { return (x + 255) & ~(size_t)255; }
constexpr size_t WS_MOD   = 0;
constexpr size_t WS_A64   = WS_MOD + al256(2 * 2 * 6 * 1024 * 4);
constexpr size_t WS_SK    = WS_A64 + al256(2 * 32 * 64 * 8);
constexpr size_t WS_WEIN  = WS_SK + al256(2 * 2 * 128 * 128 * 2);
constexpr size_t WS_WGLU  = WS_WEIN + (size_t)2048 * 1024 * 2;
constexpr size_t WS_WEOUT = WS_WGLU + (size_t)512 * 512 * 2;
constexpr size_t WS_WQ0   = WS_WEOUT + (size_t)1024 * 1024 * 2;
constexpr size_t WS_WQ1   = WS_WQ0 + (size_t)2048 * 1024 * 2;
constexpr size_t WS_WOIN  = WS_WQ1 + (size_t)2048 * 1024 * 2;
constexpr size_t WS_WOOUT = WS_WOIN + al256((size_t)ODD_IN * 1024 * 2);
constexpr size_t WS_H     = WS_WOOUT + (size_t)1024 * 1024 * 2;
constexpr size_t WS_PUV   = WS_H + (size_t)R * 1024 * 4;
constexpr size_t WS_ACT   = WS_PUV + (size_t)2 * 16384 * 1024 * 2;
constexpr size_t WS_ARENA = WS_ACT + (size_t)R * 1024 * 2;
constexpr size_t WS_GG    = WS_WEIN;
constexpr size_t WS_BETA  = WS_GG + (size_t)16 * R * 4;
constexpr size_t WS_GC    = WS_BETA + (size_t)16 * R * 4;
constexpr size_t WS_AB    = WS_GC + (size_t)NUNITS * 64 * 4;
static_assert(WS_AB + (size_t)R * 32 * 4 <= WS_WQ1, "layer-1 small buffers overflow the dead layer-0 weights");
constexpr size_t WS_PA    = WS_ARENA;
constexpr size_t WS_UG    = WS_PA + (size_t)R * 1536 * 2;
constexpr size_t WS_MS5   = WS_UG + (size_t)32 * NCH * 1024 * 2;
constexpr size_t WS_O5    = WS_MS5 + (size_t)32 * 1280 * 1024 * 2;
constexpr size_t WS_KTAB  = WS_O5 + (size_t)32 * 1024 * 256 * 2;
constexpr size_t WS_YL    = WS_KTAB + (size_t)2 * 32 * 64 * 256 * 4;
constexpr size_t WS_LST   = WS_YL + (size_t)R * 512 * 4;
constexpr size_t WS_A5    = WS_LST + (size_t)32 * NCH * 256 * 4;
constexpr size_t WS_GS    = WS_A5 + (size_t)32 * NCH * 256 * 2;
constexpr size_t WS_CB    = WS_GS + (size_t)R * 512 * 2;
constexpr size_t WS_END_L0 = WS_CB + (size_t)R * 1024 * 2;
constexpr size_t WS_Q     = WS_ARENA;
constexpr size_t WS_SC    = WS_Q + (size_t)R * 2048 * 2;
constexpr size_t WS_IDX   = WS_SC + (size_t)R * 2048 * 2;
constexpr size_t WS_GATE  = WS_IDX + (size_t)R * 128 * 4;
constexpr size_t WS_END_PEER = WS_GATE + (size_t)R * 128 * 4;
constexpr size_t WS_QKVR  = WS_ARENA;
constexpr size_t WS_W     = WS_QKVR;
constexpr size_t WS_ATT   = WS_W + (size_t)NUNITS * 64 * 128 * 2;
static_assert(WS_ATT + (size_t)NUNITS * 64 * 64 * 2 <= WS_QKVR + (size_t)R * 3072 * 2, "W+ATT must fit in QKVR");
constexpr size_t WS_Z     = WS_QKVR + (size_t)R * 3072 * 2;
constexpr size_t WS_QN    = WS_Z + (size_t)R * 1024 * 2;
constexpr size_t WS_KN    = WS_QN + (size_t)R * 1024 * 2;
constexpr size_t WS_VN    = WS_KN + (size_t)R * 1024 * 2;
constexpr size_t WS_UT    = WS_VN + (size_t)R * 1024 * 2;
constexpr size_t WS_END_L1 = WS_UT + (size_t)NUNITS * 128 * 64 * 2;
constexpr size_t WS_OF    = WS_PUV;
constexpr size_t cmax(size_t a, size_t b) { return a > b ? a : b; }
constexpr size_t WS_NEED  = cmax(cmax(WS_END_L0, WS_END_PEER), WS_END_L1);
static_assert(WS_NEED <= (size_t)512 * 1024 * 1024, "workspace plan exceeds 512 MiB");

constexpr int LDS_BYTES = 140 * 1024;

struct Params {
    const float* in[32];
    float* out;
    unsigned char* ws;
};

__device__ __forceinline__ int tid_() { int t = threadIdx.x; asm volatile("" : "+v"(t)); return t; }
__device__ __forceinline__ float bf2f(bf16_t b) { return __uint_as_float((unsigned)b << 16); }
__device__ __forceinline__ bf16_t f2bf(float f) { const __bf16 b = (__bf16)f; return __builtin_bit_cast(bf16_t, b); }
typedef float f32x2_t __attribute__((ext_vector_type(2)));
typedef __bf16 bf16x2_t __attribute__((ext_vector_type(2)));
__device__ __forceinline__ unsigned pack2(float lo, float hi) { const f32x2_t v = {lo, hi}; const bf16x2_t b = __builtin_convertvector(v, bf16x2_t); return __builtin_bit_cast(unsigned, b); }
__device__ __forceinline__ float lo2f(unsigned p) { return __uint_as_float(p << 16); }
__device__ __forceinline__ float hi2f(unsigned p) { return __uint_as_float(p & 0xFFFF0000u); }
__device__ __forceinline__ float sigmoidf_(float x) { return 1.f / (1.f + __expf(-x)); }
__device__ __forceinline__ float siluf_(float x) { return x * sigmoidf_(x); }
__device__ __forceinline__ float gelu_tanh(float x) {
    const float u = 0.7978845608028654f * (x + 0.044715f * x * x * x);
    const float t = 1.f - 2.f / (1.f + __expf(2.f * u));
    return 0.5f * x * (1.f + t);
}
__device__ __forceinline__ float wave_sum(float v) {
#pragma unroll
    for (int o = 32; o > 0; o >>= 1) v += __shfl_xor(v, o, 64);
    return v;
}
__device__ __forceinline__ void unpack8(const uint4& p, float* f) {
    f[0] = lo2f(p.x); f[1] = hi2f(p.x); f[2] = lo2f(p.y); f[3] = hi2f(p.y);
    f[4] = lo2f(p.z); f[5] = hi2f(p.z); f[6] = lo2f(p.w); f[7] = hi2f(p.w);
}
__device__ __forceinline__ uint4 pack8(const float* f) {
    uint4 p; p.x = pack2(f[0], f[1]); p.y = pack2(f[2], f[3]); p.z = pack2(f[4], f[5]); p.w = pack2(f[6], f[7]); return p;
}
__device__ __forceinline__ const float* modp(const Params& p, int l, int row, int j) {
    const float* m = (const float*)(p.ws + WS_MOD);
    return m + ((l * 2 + (row >= SEQ ? 1 : 0)) * 6 + j) * 1024;
}

constexpr int GT_LD = 72;
constexpr int GT_OPB = 128 * GT_LD * 2;
template <class Epi>
__device__ __forceinline__ void gemm_tile(const bf16_t* __restrict__ A, int lda, int M, const bf16_t* __restrict__ Bt, int ldb, int N, int K,
                                          int row0, int col0, Epi epi, unsigned char* lds) {
    const int tid = tid_(), lane = tid & 63, wave = tid >> 6;
    const int wm = wave >> 2, wn = wave & 3, r = lane & 31, h = lane >> 5;
    const int lr = tid >> 3, lc = (tid & 7) * 8;
    int ar0 = row0 + lr, ar1 = row0 + lr + 64, br0 = col0 + lr, br1 = col0 + lr + 64;
    ar0 = ar0 < M ? ar0 : M - 1; ar1 = ar1 < M ? ar1 : M - 1; br0 = br0 < N ? br0 : N - 1; br1 = br1 < N ? br1 : N - 1;
    const bf16_t* pa0 = A + (size_t)ar0 * lda + lc; const bf16_t* pa1 = A + (size_t)ar1 * lda + lc;
    const bf16_t* pb0 = Bt + (size_t)br0 * ldb + lc; const bf16_t* pb1 = Bt + (size_t)br1 * ldb + lc;
    f32x16 acc0, acc1;
#pragma unroll
    for (int i = 0; i < 16; ++i) { acc0[i] = 0.f; acc1[i] = 0.f; }
    const int nk = K >> 6;
    uint4 ra0 = *(const uint4*)pa0, ra1 = *(const uint4*)pa1, rb0 = *(const uint4*)pb0, rb1 = *(const uint4*)pb1;
    __syncthreads();
    {
        unsigned char* sa = lds; unsigned char* sb = lds + GT_OPB;
        *(uint4*)(sa + (lr * GT_LD + lc) * 2) = ra0; *(uint4*)(sa + ((lr + 64) * GT_LD + lc) * 2) = ra1;
        *(uint4*)(sb + (lr * GT_LD + lc) * 2) = rb0; *(uint4*)(sb + ((lr + 64) * GT_LD + lc) * 2) = rb1;
    }
    __syncthreads();
    for (int kt = 0; kt < nk; ++kt) {
        const int cur = kt & 1;
        if (kt + 1 < nk) {
            const int ko = (kt + 1) * 64;
            ra0 = *(const uint4*)(pa0 + ko); ra1 = *(const uint4*)(pa1 + ko); rb0 = *(const uint4*)(pb0 + ko); rb1 = *(const uint4*)(pb1 + ko);
        }
        const unsigned char* sa = lds + cur * 2 * GT_OPB; const unsigned char* sb = sa + GT_OPB;
#pragma unroll
        for (int s = 0; s < 4; ++s) {
            const bf16x8 a0 = *(const bf16x8*)(sa + ((wm * 64 + r) * GT_LD + s * 16 + 8 * h) * 2);
            const bf16x8 a1 = *(const bf16x8*)(sa + ((wm * 64 + 32 + r) * GT_LD + s * 16 + 8 * h) * 2);
            const bf16x8 b  = *(const bf16x8*)(sb + ((wn * 32 + r) * GT_LD + s * 16 + 8 * h) * 2);
            acc0 = __builtin_amdgcn_mfma_f32_32x32x16_bf16(a0, b, acc0, 0, 0, 0);
            acc1 = __builtin_amdgcn_mfma_f32_32x32x16_bf16(a1, b, acc1, 0, 0, 0);
        }
        if (kt + 1 < nk) {
            unsigned char* na = lds + (cur ^ 1) * 2 * GT_OPB; unsigned char* nb = na + GT_OPB;
            *(uint4*)(na + (lr * GT_LD + lc) * 2) = ra0; *(uint4*)(na + ((lr + 64) * GT_LD + lc) * 2) = ra1;
            *(uint4*)(nb + (lr * GT_LD + lc) * 2) = rb0; *(uint4*)(nb + ((lr + 64) * GT_LD + lc) * 2) = rb1;
        }
        __syncthreads();
    }
    const int col = col0 + wn * 32 + r;
    if (col < N) {
#pragma unroll
        for (int i = 0; i < 16; ++i) {
            const int rr = (i & 3) + 8 * (i >> 2) + 4 * h;
            const int row_a = row0 + wm * 64 + rr, row_b = row_a + 32;
            if (row_a < M) epi(row_a, col, acc0[i]);
            if (row_b < M) epi(row_b, col, acc1[i]);
        }
    }
}

__device__ __forceinline__ void p0_adaln(const Params& p, int item, unsigned char* lds) {
    const int l = item / 96, cb = item % 96, tid = tid_();
    const int kq = tid >> 4, c4 = tid & 15;
    const float* W = p.in[4] + (size_t)l * 1024 * 6144 + cb * 64 + c4 * 4;
    const float* c = p.in[1]; const float* cc = p.in[3];
    float al[4] = {0, 0, 0, 0}, ac[4] = {0, 0, 0, 0};
    for (int k = kq; k < 1024; k += 32) {
        const float4 w = *(const float4*)(W + (size_t)k * 6144);
        const float sl = siluf_(c[k]), sc = siluf_(cc[k]);
        al[0] += sl * w.x; al[1] += sl * w.y; al[2] += sl * w.z; al[3] += sl * w.w;
        ac[0] += sc * w.x; ac[1] += sc * w.y; ac[2] += sc * w.z; ac[3] += sc * w.w;
    }
    float* red = (float*)lds;
    __syncthreads();
#pragma unroll
    for (int e = 0; e < 4; ++e) { red[(kq * 2 + 0) * 64 + c4 * 4 + e] = al[e]; red[(kq * 2 + 1) * 64 + c4 * 4 + e] = ac[e]; }
    __syncthreads();
    if (tid < 128) {
        const int s = tid >> 6, cidx = tid & 63;
        float sum = 0.f;
        for (int q = 0; q < 32; ++q) sum += red[(q * 2 + s) * 64 + cidx];
        const int col = cb * 64 + cidx;
        sum += p.in[5][l * 6144 + col];
        ((float*)(p.ws + WS_MOD))[(l * 2 + s) * 6144 + col] = sum;
    }
}
__device__ __forceinline__ void p0_transpose(const float* __restrict__ src, int K, int N, bf16_t* __restrict__ dst, int tile, unsigned char* lds) {
    const int ntn = (N + 63) / 64, tk = tile / ntn, tn = tile % ntn, tid = tid_();
    float* s = (float*)lds;
    __syncthreads();
    for (int e = tid; e < 64 * 64; e += NTHREADS) {
        const int kk = e >> 6, nn = e & 63; const int n = tn * 64 + nn;
        s[kk * 65 + nn] = n < N ? src[(size_t)(tk * 64 + kk) * N + n] : 0.f;
    }
    __syncthreads();
    {
        const int nn = tid >> 3, kg = (tid & 7) * 8; const int n = tn * 64 + nn;
        if (n < N) {
            float f[8];
#pragma unroll
            for (int e = 0; e < 8; ++e) f[e] = s[(kg + e) * 65 + nn];
            *(uint4*)(dst + (size_t)n * K + tk * 64 + kg) = pack8(f);
        }
    }
}
__device__ __forceinline__ void cvt_chunk(const float* __restrict__ src, bf16_t* __restrict__ dst, size_t item) {
    const size_t o = item * 4096 + (size_t)tid_() * 8;
    const float4 a = *(const float4*)(src + o), b = *(const float4*)(src + o + 4);
    uint4 q; q.x = pack2(a.x, a.y); q.y = pack2(a.z, a.w); q.z = pack2(b.x, b.y); q.w = pack2(b.z, b.w);
    *(uint4*)(dst + o) = q;
}
__device__ __forceinline__ void sincos_d(double x, double& s, double& c) {
    const double TWO_OVER_PI = 0.63661977236758134308, PIO2_HI = 1.57079632679489655800e+00, PIO2_LO = 6.12323399573676603587e-17;
    const double kf = rint(x * TWO_OVER_PI);
    const double y = (x - kf * PIO2_HI) - kf * PIO2_LO;
    const double y2 = y * y;
    double sp = -1.0 / 1307674368000.0;
    sp = sp * y2 + 1.0 / 6227020800.0; sp = sp * y2 - 1.0 / 39916800.0; sp = sp * y2 + 1.0 / 362880.0; sp = sp * y2 - 1.0 / 5040.0;
    sp = sp * y2 + 1.0 / 120.0; sp = sp * y2 - 1.0 / 6.0; sp = sp * y2 + 1.0; sp *= y;
    double cp = 1.0 / 20922789888000.0;
    cp = cp * y2 - 1.0 / 87178291200.0; cp = cp * y2 + 1.0 / 479001600.0; cp = cp * y2 - 1.0 / 3628800.0; cp = cp * y2 + 1.0 / 40320.0;
    cp = cp * y2 - 1.0 / 720.0; cp = cp * y2 + 1.0 / 24.0; cp = cp * y2 - 0.5; cp = cp * y2 + 1.0;
    const int q = ((int)kf) & 3;
    s = (q == 0) ? sp : (q == 1) ? cp : (q == 2) ? -sp : -cp;
    c = (q == 0) ? cp : (q == 1) ? -sp : (q == 2) ? -cp : sp;
}
__device__ __forceinline__ void p0_s5_tables(const Params& p, int item, unsigned char* lds) {
    const int di = item >> 5, g = item & 31, tid = tid_();
    float2* apw = (float2*)lds;
    float2* Bb = apw + 64 * 65;
    float2* Cc = Bb + 64 * 16;
    __syncthreads();
    if (tid < 64) {
        const int pidx = (di * 32 + g) * 64 + tid;
        float lr = p.in[10][pidx]; lr = lr < -1e-4f ? lr : -1e-4f;
        const float li = p.in[11][pidx];
        const float dt = expf(p.in[12][di * 32 + g]);
        const double mag = (double)expf(lr * dt);
        double sn, cs; sincos_d((double)li * (double)dt, sn, cs);
        const double are = mag * cs, aim = mag * sn;
        double pr = 1.0, pi_ = 0.0;
        for (int t = 0; t <= 64; ++t) {
            apw[tid * 65 + t] = make_float2((float)pr, (float)pi_);
            const double nr = pr * are - pi_ * aim, ni = pr * aim + pi_ * are; pr = nr; pi_ = ni;
        }
        ((float2*)(p.ws + WS_A64))[(di * 32 + g) * 64 + tid] = apw[tid * 65 + 64];
        const double den = (double)lr * lr + (double)li * li;
        const double fre = ((are - 1.0) * lr + aim * li) / den, fim = (aim * lr - (are - 1.0) * li) / den;
        for (int hh = 0; hh < 16; ++hh) {
            const double br = p.in[13][(size_t)pidx * 16 + hh], bi = p.in[14][(size_t)pidx * 16 + hh];
            Bb[tid * 16 + hh] = make_float2((float)(fre * br - fim * bi), (float)(fre * bi + fim * br));
        }
    }
    for (int e = tid; e < 1024; e += NTHREADS) {
        const size_t gi = ((size_t)(di * 32 + g) * 16) * 64 + e;
        Cc[e] = make_float2(p.in[15][gi], p.in[16][gi]);
    }
    __syncthreads();
    float* ktab = (float*)(p.ws + WS_KTAB) + (size_t)(di * 32 + g) * 64 * 256;
    for (int o = tid; o < 64 * 256; o += NTHREADS) {
        const int tau = o >> 8, hh = (o >> 4) & 15, h2 = o & 15;
        float acc = 0.f;
        for (int pp = 0; pp < 64; ++pp) {
            const float2 a = apw[pp * 65 + tau], c = Cc[hh * 64 + pp], b = Bb[pp * 16 + h2];
            const float cr = c.x * a.x - c.y * a.y, ci = c.x * a.y + c.y * a.x;
            acc += cr * b.x - ci * b.y;
        }
        ktab[o] = acc;
    }
    bf16_t* ms5 = (bf16_t*)(p.ws + WS_MS5) + (size_t)g * 1280 * 1024;
    for (int t = tid; t < 128 * 128; t += NTHREADS) {
        const int row = t >> 7, k8 = t & 127; const int ri = row >> 6, pp = row & 63, j = k8 >> 1, h0 = (k8 & 1) * 8;
        const float2 a = apw[pp * 65 + (di == 0 ? 63 - j : j)];
        float f[8];
#pragma unroll
        for (int e = 0; e < 8; ++e) { const float2 b = Bb[pp * 16 + h0 + e]; f[e] = ri == 0 ? (a.x * b.x - a.y * b.y) : (a.x * b.y + a.y * b.x); }
        *(uint4*)(ms5 + (size_t)(1024 + di * 128 + row) * 1024 + k8 * 8) = pack8(f);
    }
    bf16_t* o5 = (bf16_t*)(p.ws + WS_O5) + (size_t)g * 1024 * 256;
    for (int t = tid; t < 1024 * 16; t += NTHREADS) {
        const int n = t >> 4, q = t & 15; const int ri = q >> 3, p0 = (q & 7) * 8, i = n >> 4, hh = n & 15;
        float f[8];
#pragma unroll
        for (int e = 0; e < 8; ++e) {
            const float2 a = apw[(p0 + e) * 65 + (di == 0 ? i + 1 : 64 - i)], c = Cc[hh * 64 + p0 + e];
            f[e] = ri == 0 ? (c.x * a.x - c.y * a.y) : -(c.x * a.y + c.y * a.x);
        }
        *(uint4*)(o5 + (size_t)n * 256 + di * 128 + ri * 64 + p0) = pack8(f);
    }
}

__device__ __forceinline__ void norm_mod_row(const float* __restrict__ src, const float* __restrict__ g, const float* __restrict__ shift,
                                             const float* __restrict__ scale, bf16_t* __restrict__ dst, int lane) {
    float4 v[4]; float ss = 0.f;
#pragma unroll
    for (int k = 0; k < 4; ++k) { v[k] = *(const float4*)(src + k * 256 + lane * 4); ss += v[k].x * v[k].x + v[k].y * v[k].y + v[k].z * v[k].z + v[k].w * v[k].w; }
    ss = wave_sum(ss);
    const float rs = rsqrtf(ss * (1.f / 1024.f) + 1e-6f);
#pragma unroll
    for (int k = 0; k < 4; ++k) {
        const int c = k * 256 + lane * 4;
        const float4 gg = *(const float4*)(g + c), sh = *(const float4*)(shift + c), sc = *(const float4*)(scale + c);
        uint2 o;
        o.x = pack2(v[k].x * rs * gg.x * (1.f + sc.x) + sh.x, v[k].y * rs * gg.y * (1.f + sc.y) + sh.y);
        o.y = pack2(v[k].z * rs * gg.z * (1.f + sc.z) + sh.z, v[k].w * rs * gg.w * (1.f + sc.w) + sh.w);
        *(uint2*)(dst + c) = o;
    }
}
__device__ __forceinline__ void norm_rows_item(const Params& p, int item, int l, const float* g, int js, bool from_inputs) {
    const int row = item * 8 + (tid_() >> 6), lane = tid_() & 63;
    const float* src = from_inputs ? (row < SEQ ? p.in[0] + (size_t)row * 1024 : p.in[2] + (size_t)(row - SEQ) * 1024)
                                   : (const float*)(p.ws + WS_H) + (size_t)row * 1024;
    norm_mod_row(src, g, modp(p, l, row, js), modp(p, l, row, js + 1), (bf16_t*)(p.ws + WS_ACT) + (size_t)row * 1024, lane);
}
__device__ __forceinline__ void s5_mintra_item(const Params& p, int item) {
    const int g = item >> 6, i = item & 63;
    const float* kt0 = (const float*)(p.ws + WS_KTAB) + (size_t)(0 * 32 + g) * 64 * 256;
    const float* kt1 = (const float*)(p.ws + WS_KTAB) + (size_t)(1 * 32 + g) * 64 * 256;
    const float* dsk = p.in[17] + g * 16;
    bf16_t* ms5 = (bf16_t*)(p.ws + WS_MS5) + (size_t)g * 1280 * 1024;
    for (int t = tid_(); t < 16 * 128; t += NTHREADS) {
        const int hh = t >> 7, k8 = t & 127, j = k8 >> 1, h0 = (k8 & 1) * 8;
        float f[8];
        if (j < i) { const float* s = kt0 + ((i - j) * 16 + hh) * 16 + h0;
#pragma unroll
            for (int e = 0; e < 8; ++e) f[e] = s[e]; }
        else if (j > i) { const float* s = kt1 + ((j - i) * 16 + hh) * 16 + h0;
#pragma unroll
            for (int e = 0; e < 8; ++e) f[e] = s[e]; }
        else { const float* s0 = kt0 + hh * 16 + h0; const float* s1 = kt1 + hh * 16 + h0;
#pragma unroll
            for (int e = 0; e < 8; ++e) f[e] = s0[e] + s1[e] + ((h0 + e) == hh ? dsk[hh] : 0.f); }
        *(uint4*)(ms5 + (size_t)(i * 16 + hh) * 1024 + k8 * 8) = pack8(f);
    }
}

struct EpiEvenIn {
    bf16_t* pa; bf16_t* ug;
    __device__ __forceinline__ void operator()(int row, int col, float v) const {
        if (col < 1536) pa[(size_t)row * 1536 + col] = f2bf(v);
        else { const int c2 = col - 1536; ug[((size_t)(c2 >> 4) * NCH + (row >> 6)) * 1024 + (row & 63) * 16 + (c2 & 15)] = f2bf(v); }
    }
};
struct EpiS5Local {
    float* yl; float* lst; int g;
    __device__ __forceinline__ void operator()(int row, int col, float v) const {
        if (col < 1024) yl[(size_t)(row * 64 + (col >> 4)) * 512 + g * 16 + (col & 15)] = v;
        else lst[((size_t)g * NCH + row) * 256 + (col - 1024)] = v;
    }
};
struct EpiS5Out {
    const float* yl; bf16_t* gs; int g;
    __device__ __forceinline__ void operator()(int row, int col, float v) const {
        const size_t o = (size_t)(row * 64 + (col >> 4)) * 512 + g * 16 + (col & 15);
        gs[o] = f2bf(gelu_tanh(v + yl[o]));
    }
};
struct EpiGlu {
    const bf16_t* gs; const float* b; bf16_t* cb;
    __device__ __forceinline__ void operator()(int row, int col, float v) const {
        cb[(size_t)row * 1024 + 512 + col] = f2bf(bf2f(gs[(size_t)row * 512 + col]) * sigmoidf_(v + b[col]));
    }
};
struct EpiResid {
    const float* x; const float* ctx; float* hbuf; const float* mod; int l; bool from_inputs;
    __device__ __forceinline__ void operator()(int row, int col, float v) const {
        float* h = hbuf + (size_t)row * 1024 + col;
        const float base = from_inputs ? (row < SEQ ? x[(size_t)row * 1024 + col] : ctx[(size_t)(row - SEQ) * 1024 + col]) : *h;
        *h = base + mod[((l * 2 + (row >= SEQ ? 1 : 0)) * 6 + 2) * 1024 + col] * v;
    }
};
struct EpiBf16 {
    bf16_t* dst; int ld;
    __device__ __forceinline__ void operator()(int row, int col, float v) const { dst[(size_t)row * ld + col] = f2bf(v); }
};
struct EpiScore {
    unsigned short* dst; int coff;
    __device__ __forceinline__ void operator()(int row, int col, float v) const {
        const _Float16 hv = (_Float16)v; dst[(size_t)row * 2048 + coff + col] = __builtin_bit_cast(unsigned short, hv);
    }
};
struct EpiOddIn {
    bf16_t* qkvr; bf16_t* z; float* ab;
    __device__ __forceinline__ void operator()(int row, int col, float v) const {
        if (col < 3072) qkvr[(size_t)row * 3072 + col] = f2bf(v);
        else if (col < 4096) z[(size_t)row * 1024 + (col - 3072)] = f2bf(v);
        else ab[(size_t)row * 32 + (col - 4096)] = v;
    }
};

__device__ __forceinline__ void s5_scan(const Params& p) {
    const int gt = blockIdx.x * NTHREADS + tid_();
    if (gt >= 4096) return;
    const int di = gt >> 11, g = (gt >> 6) & 31, pp = gt & 63;
    const float2 a = ((const float2*)(p.ws + WS_A64))[(di * 32 + g) * 64 + pp];
    const float* lst = (const float*)(p.ws + WS_LST) + (size_t)g * NCH * 256 + di * 128 + pp;
    bf16_t* a5 = (bf16_t*)(p.ws + WS_A5) + (size_t)g * NCH * 256 + di * 128 + pp;
    float sr = 0.f, si = 0.f;
    for (int s0 = 0; s0 < NCH; s0 += 4) {
        int c[4]; float lr[4], li[4];
#pragma unroll
        for (int u = 0; u < 4; ++u) {
            const int s = s0 + u;
            c[u] = di == 0 ? (s < 4 ? NCH_LAT + s : s - 4) : (s < 4 ? NCH - 1 - s : NCH - 1 - s);
            lr[u] = lst[(size_t)c[u] * 256]; li[u] = lst[(size_t)c[u] * 256 + 64];
        }
#pragma unroll
        for (int u = 0; u < 4; ++u) {
            a5[(size_t)c[u] * 256] = f2bf(sr); a5[(size_t)c[u] * 256 + 64] = f2bf(si);
            const float nr = a.x * sr - a.y * si + lr[u], ni = a.x * si + a.y * sr + li[u]; sr = nr; si = ni;
        }
    }
}

__device__ __forceinline__ void even_conv_item(const Params& p, int item) {
    const bf16_t* pa = (const bf16_t*)(p.ws + WS_PA); bf16_t* cb = (bf16_t*)(p.ws + WS_CB);
    const float* cw = p.in[9];
    for (int t = tid_(); t < 64 * 64; t += NTHREADS) {
        const int row = item * 64 + (t >> 6), c0 = (t & 63) * 8;
        bool hasp, hasn;
        if (row < SEQ) { hasp = (row & 63) != 0; hasn = (row & 63) != 63; } else { hasp = row != SEQ; hasn = row != R - 1; }
        float m[3][8];
#pragma unroll
        for (int d = 0; d < 3; ++d) {
            const bool ok = d == 1 || (d == 0 ? hasp : hasn);
            if (ok) {
                const bf16_t* rp = pa + (size_t)(row + d - 1) * 1536 + c0;
                float u[8], gi[8]; unpack8(*(const uint4*)rp, u); unpack8(*(const uint4*)(rp + 512), gi);
#pragma unroll
                for (int e = 0; e < 8; ++e) m[d][e] = u[e] * gi[e];
            } else {
#pragma unroll
                for (int e = 0; e < 8; ++e) m[d][e] = 0.f;
            }
        }
        float go[8], f[8]; unpack8(*(const uint4*)(pa + (size_t)row * 1536 + 1024 + c0), go);
#pragma unroll
        for (int e = 0; e < 8; ++e) f[e] = go[e] * (m[0][e] * cw[c0 + e] + m[1][e] * cw[512 + c0 + e] + m[2][e] * cw[1024 + c0 + e]);
        *(uint4*)(cb + (size_t)row * 1024 + c0) = pack8(f);
    }
}

__device__ __forceinline__ unsigned ord_enc(float v) { const unsigned u = __float_as_uint(v); return (u & 0x80000000u) ? ~u : (u | 0x80000000u); }
__device__ __forceinline__ float ord_dec(unsigned e) { const unsigned u = (e & 0x80000000u) ? (e & 0x7FFFFFFFu) : ~e; return __uint_as_float(u); }
#define TOP_INSERT(key) { unsigned x_ = (key); _Pragma("unroll") for (int k_ = 0; k_ < 16; ++k_) { const unsigned hi_ = top[k_] > x_ ? top[k_] : x_; x_ = top[k_] > x_ ? x_ : top[k_]; top[k_] = hi_; } }
__device__ __forceinline__ void peer_route_item(const Params& p, int item, int nrows, unsigned char* lds) {
    const int tid = tid_();
    const int row = item * 64 + (tid >> 3), head = tid & 7;
    unsigned* sIdx = (unsigned*)lds;
    __syncthreads();
    if (row < nrows) {
        const unsigned short* sc = (const unsigned short*)(p.ws + WS_SC) + (size_t)row * 2048 + head * 256;
        float fa[16], fb[16];
#pragma unroll
        for (int side = 0; side < 2; ++side) {
            unsigned top[16];
#pragma unroll
            for (int k = 0; k < 16; ++k) top[k] = 0u;
            for (int c = 0; c < 16; ++c) {
                const uint4 q = *(const uint4*)(sc + side * 128 + c * 8);
                const unsigned w[4] = {q.x, q.y, q.z, q.w};
#pragma unroll
                for (int e = 0; e < 8; ++e) {
                    const unsigned short hb = (unsigned short)((e & 1) ? (w[e >> 1] >> 16) : (w[e >> 1] & 0xFFFFu));
                    const float v = (float)__builtin_bit_cast(_Float16, hb);
                    TOP_INSERT((ord_enc(v) & ~0x7Fu) | (unsigned)(c * 8 + e));
                }
            }
#pragma unroll
            for (int k = 0; k < 16; ++k) {
                sIdx[(side * 16 + k) * NTHREADS + tid] = top[k] & 0x7Fu;
                const float v = ord_dec(top[k] & ~0x7Fu);
                if (side == 0) fa[k] = v; else fb[k] = v;
            }
        }
        unsigned top[16];
#pragma unroll
        for (int k = 0; k < 16; ++k) top[k] = 0u;
#pragma unroll
        for (int i = 0; i < 16; ++i) {
#pragma unroll
            for (int j = 0; j < 16; ++j) {
                if ((i + 1) * (j + 1) <= 16) { TOP_INSERT((ord_enc(fa[i] + fb[j]) & ~0xFFu) | (unsigned)(i * 16 + j)); }
            }
        }
        float ev[16]; float m = ord_dec(top[0] & ~0xFFu), sum = 0.f;
        int* idxo = (int*)(p.ws + WS_IDX) + (size_t)row * 128 + head * 16;
        float* go = (float*)(p.ws + WS_GATE) + (size_t)row * 128 + head * 16;
#pragma unroll
        for (int k = 0; k < 16; ++k) { ev[k] = __expf(ord_dec(top[k] & ~0xFFu) - m); sum += ev[k]; }
        const float inv = 1.f / sum;
#pragma unroll
        for (int k = 0; k < 16; ++k) {
            const unsigned pos = top[k] & 0xFFu;
            const unsigned ia = sIdx[(pos >> 4) * NTHREADS + tid], ib = sIdx[(16 + (pos & 15)) * NTHREADS + tid];
            idxo[k] = (int)(ia * 128u + ib); go[k] = ev[k] * inv;
        }
    }
}

__device__ __forceinline__ void peer_gather_row(const Params& p, int row, int l, bool last) {
    const int lane = tid_() & 63;
    const bf16_t* xr = (const bf16_t*)(p.ws + WS_ACT) + (size_t)row * 1024;
    const bf16_t* PU = (const bf16_t*)(p.ws + WS_PUV); const bf16_t* PV = PU + (size_t)16384 * 1024;
    float x[16], y[16];
    unpack8(*(const uint4*)(xr + lane * 8), x); unpack8(*(const uint4*)(xr + 512 + lane * 8), x + 8);
#pragma unroll
    for (int e = 0; e < 16; ++e) y[e] = 0.f;
    const int* idxp = (const int*)(p.ws + WS_IDX) + (size_t)row * 128; const float* gp = (const float*)(p.ws + WS_GATE) + (size_t)row * 128;
#pragma unroll 1
    for (int half = 0; half < 2; ++half) {
        const int myidx = idxp[half * 64 + lane]; const float mygate = gp[half * 64 + lane];
#pragma unroll 1
        for (int e0 = 0; e0 < 64; e0 += 4) {
            uint4 ur[4][2], vr[4][2]; int gt[4];
#pragma unroll
            for (int u = 0; u < 4; ++u) {
                const int id = __builtin_amdgcn_readlane(myidx, e0 + u);
                gt[u] = __builtin_amdgcn_readlane(__float_as_int(mygate), e0 + u);
                const bf16_t* up = PU + (size_t)id * 1024 + lane * 8; const bf16_t* vp = PV + (size_t)id * 1024 + lane * 8;
                ur[u][0] = *(const uint4*)up; ur[u][1] = *(const uint4*)(up + 512);
                vr[u][0] = *(const uint4*)vp; vr[u][1] = *(const uint4*)(vp + 512);
            }
#pragma unroll
            for (int u = 0; u < 4; ++u) {
                float f[16]; unpack8(ur[u][0], f); unpack8(ur[u][1], f + 8);
                float d = 0.f;
#pragma unroll
                for (int e = 0; e < 16; ++e) d += f[e] * x[e];
                d = wave_sum(d);
                const float coef = gelu_tanh(d) * __int_as_float(gt[u]);
                unpack8(vr[u][0], f); unpack8(vr[u][1], f + 8);
#pragma unroll
                for (int e = 0; e < 16; ++e) y[e] += coef * f[e];
            }
        }
    }
    float* h = (float*)(p.ws + WS_H) + (size_t)row * 1024;
    const float* m5 = modp(p, l, row, 5);
    float hv[16];
#pragma unroll
    for (int q = 0; q < 2; ++q) {
        const int c = q * 512 + lane * 8;
        const float4 h0 = *(const float4*)(h + c), h1 = *(const float4*)(h + c + 4);
        const float4 g0 = *(const float4*)(m5 + c), g1 = *(const float4*)(m5 + c + 4);
        hv[q * 8 + 0] = h0.x + g0.x * y[q * 8 + 0]; hv[q * 8 + 1] = h0.y + g0.y * y[q * 8 + 1];
        hv[q * 8 + 2] = h0.z + g0.z * y[q * 8 + 2]; hv[q * 8 + 3] = h0.w + g0.w * y[q * 8 + 3];
        hv[q * 8 + 4] = h1.x + g1.x * y[q * 8 + 4]; hv[q * 8 + 5] = h1.y + g1.y * y[q * 8 + 5];
        hv[q * 8 + 6] = h1.z + g1.z * y[q * 8 + 6]; hv[q * 8 + 7] = h1.w + g1.w * y[q * 8 + 7];
    }
    if (!last) {
#pragma unroll
        for (int q = 0; q < 2; ++q) {
            const int c = q * 512 + lane * 8;
            *(float4*)(h + c) = make_float4(hv[q * 8 + 0], hv[q * 8 + 1], hv[q * 8 + 2], hv[q * 8 + 3]);
            *(float4*)(h + c + 4) = make_float4(hv[q * 8 + 4], hv[q * 8 + 5], hv[q * 8 + 6], hv[q * 8 + 7]);
        }
    } else {
        float ss = 0.f;
#pragma unroll
        for (int e = 0; e < 16; ++e) ss += hv[e] * hv[e];
        ss = wave_sum(ss);
        const float rs = rsqrtf(ss * (1.f / 1024.f) + 1e-6f);
        const float* fg = p.in[31]; float* o = p.out + (size_t)row * 1024;
#pragma unroll
        for (int q = 0; q < 2; ++q) {
            const int c = q * 512 + lane * 8;
            const float4 g0 = *(const float4*)(fg + c), g1 = *(const float4*)(fg + c + 4);
            *(float4*)(o + c) = make_float4(hv[q * 8 + 0] * rs * g0.x, hv[q * 8 + 1] * rs * g0.y, hv[q * 8 + 2] * rs * g0.z, hv[q * 8 + 3] * rs * g0.w);
            *(float4*)(o + c + 4) = make_float4(hv[q * 8 + 4] * rs * g1.x, hv[q * 8 + 5] * rs * g1.y, hv[q * 8 + 6] * rs * g1.z, hv[q * 8 + 7] * rs * g1.w);
        }
    }
}

__device__ __forceinline__ void gdn_prep_item(const Params& p, int item) {
    const int lane = tid_() & 63, wave = tid_() >> 6;
    const bf16_t* qkvr = (const bf16_t*)(p.ws + WS_QKVR);
    const float* cw = p.in[22];
    for (int it = 0; it < 8; ++it) {
        const int row = item * 64 + it * 8 + wave;
        bool hasp, hasn;
        if (row < SEQ) { hasp = (row & 63) != 0; hasn = (row & 63) != 63; } else { hasp = row != SEQ; hasn = row != R - 1; }
#pragma unroll 1
        for (int ph = 0; ph < 6; ++ph) {
            const int part = ph >> 1, head = (ph & 1) * 4 + (lane >> 4), d0 = (lane & 15) * 8;
            const int ch = part * 1024 + head * 128 + d0;
            float xm[8], x0[8], xp[8], f[8];
            unpack8(*(const uint4*)(qkvr + (size_t)row * 3072 + ch), x0);
            if (hasp) unpack8(*(const uint4*)(qkvr + (size_t)(row - 1) * 3072 + ch), xm);
            if (hasn) unpack8(*(const uint4*)(qkvr + (size_t)(row + 1) * 3072 + ch), xp);
            float ss = 0.f;
#pragma unroll
            for (int e = 0; e < 8; ++e) {
                float a = x0[e] * cw[3072 + ch + e];
                if (hasp) a += xm[e] * cw[ch + e];
                if (hasn) a += xp[e] * cw[6144 + ch + e];
                a = siluf_(a); f[e] = a; ss += a * a;
            }
            if (part < 2) {
                ss += __shfl_xor(ss, 1, 64); ss += __shfl_xor(ss, 2, 64); ss += __shfl_xor(ss, 4, 64); ss += __shfl_xor(ss, 8, 64);
                const float sc = rsqrtf(ss + 1e-6f) * (part == 0 ? 0.08838834764831845f : 1.f);
#pragma unroll
                for (int e = 0; e < 8; ++e) f[e] *= sc;
            }
            bf16_t* dst = (bf16_t*)(p.ws + (part == 0 ? WS_QN : part == 1 ? WS_KN : WS_VN)) + (size_t)row * 1024 + head * 128 + d0;
            *(uint4*)dst = pack8(f);
        }
        if (lane < 16) {
            const float* ab = (const float*)(p.ws + WS_AB) + (size_t)row * 32;
            const float a = ab[lane] + p.in[24][lane], b = ab[16 + lane];
            const float sp = a > 20.f ? a : log1pf(__expf(a));
            ((float*)(p.ws + WS_GG))[(size_t)lane * R + row] = -__expf(p.in[23][lane]) * sp;
            ((float*)(p.ws + WS_BETA))[(size_t)lane * R + row] = sigmoidf_(b);
        }
    }
}

constexpr int GU_LDQ = 136, GU_LDT = 72, GU_LDA = 68;
constexpr int GU_SQ = 0, GU_SK = 17408, GU_SKB = 34816, GU_SVBT = 52224, GU_SKGT = 70656, GU_SA = 89088, GU_SAT = 106496, GU_ST = 123904, GU_SG = 133120;
__device__ __forceinline__ int perm_slot64(int pos) { return 32 * (pos >> 5) + 8 * ((pos >> 2) & 3) + 4 * ((pos >> 4) & 1) + (pos & 3); }
__device__ __forceinline__ void gdn_unit(const Params& p, int u, unsigned char* lds) {
    const int tid = tid_(), lane = tid & 63, wave = tid >> 6;
    const int dh = u / NCH, c = u % NCH, dir = dh >> 3, head = dh & 7;
    bf16_t* sQ = (bf16_t*)(lds + GU_SQ); bf16_t* sK = (bf16_t*)(lds + GU_SK); bf16_t* sKB = (bf16_t*)(lds + GU_SKB);
    bf16_t* sVBT = (bf16_t*)(lds + GU_SVBT); bf16_t* sKGT = (bf16_t*)(lds + GU_SKGT);
    float* sA = (float*)(lds + GU_SA); float* sAT = (float*)(lds + GU_SAT); bf16_t* sT = (bf16_t*)(lds + GU_ST);
    float* sG = (float*)(lds + GU_SG); float* sBeta = sG + 64;
    __syncthreads();
    if (wave == 0) {
        const int row = c * 64 + (dir ? 63 - lane : lane);
        float g = ((const float*)(p.ws + WS_GG))[(size_t)dh * R + row];
#pragma unroll
        for (int o = 1; o < 64; o <<= 1) { const float t = __shfl_up(g, o, 64); if (lane >= o) g += t; }
        sG[lane] = g; sBeta[lane] = ((const float*)(p.ws + WS_BETA))[(size_t)dh * R + row];
        ((float*)(p.ws + WS_GC))[(size_t)u * 64 + lane] = g;
    }
    __syncthreads();
    for (int t = tid; t < 1024; t += NTHREADS) {
        const int i = t >> 4, d8 = (t & 15) * 8;
        const size_t ro = (size_t)(c * 64 + (dir ? 63 - i : i)) * 1024 + head * 128 + d8;
        const uint4 q = *(const uint4*)((const bf16_t*)(p.ws + WS_QN) + ro);
        const uint4 k = *(const uint4*)((const bf16_t*)(p.ws + WS_KN) + ro);
        const uint4 v = *(const uint4*)((const bf16_t*)(p.ws + WS_VN) + ro);
        const float beta = sBeta[i], eg = __expf(sG[i]);
        float kf[8], vf[8], kb[8];
        unpack8(k, kf); unpack8(v, vf);
#pragma unroll
        for (int e = 0; e < 8; ++e) kb[e] = kf[e] * beta;
        *(uint4*)(sQ + i * GU_LDQ + d8) = q; *(uint4*)(sK + i * GU_LDQ + d8) = k; *(uint4*)(sKB + i * GU_LDQ + d8) = pack8(kb);
#pragma unroll
        for (int e = 0; e < 8; ++e) { sVBT[(d8 + e) * GU_LDT + i] = f2bf(vf[e] * beta); sKGT[(d8 + e) * GU_LDT + i] = f2bf(kb[e] * eg); }
    }
    __syncthreads();
    {
        const int mat = wave >> 2, mt = wave & 3, rr = lane & 15, q4 = lane >> 4;
        const bf16_t* sX = mat ? sQ : sKB;
        f32x4 acc[4];
#pragma unroll
        for (int nt = 0; nt < 4; ++nt) acc[nt] = (f32x4){0.f, 0.f, 0.f, 0.f};
#pragma unroll
        for (int kk = 0; kk < 4; ++kk) {
            const bf16x8 a = *(const bf16x8*)(sX + (16 * mt + rr) * GU_LDQ + kk * 32 + 8 * q4);
#pragma unroll
            for (int nt = 0; nt < 4; ++nt) {
                const bf16x8 b = *(const bf16x8*)(sK + (16 * nt + rr) * GU_LDQ + kk * 32 + 8 * q4);
                acc[nt] = __builtin_amdgcn_mfma_f32_16x16x32_bf16(a, b, acc[nt], 0, 0, 0);
            }
        }
        float* dstm = mat ? sAT : sA;
#pragma unroll
        for (int nt = 0; nt < 4; ++nt) {
            const int j = 16 * nt + rr; const float gj = sG[j];
#pragma unroll
            for (int jj = 0; jj < 4; ++jj) {
                const int i = 16 * mt + 4 * q4 + jj;
                const bool keep = mat ? (j <= i) : (j < i);
                dstm[i * GU_LDA + j] = keep ? acc[nt][jj] * __expf(sG[i] - gj) : 0.f;
            }
        }
    }
    __syncthreads();
    if (wave == 0) {
        float* Tf = (float*)(lds + GU_SQ);
#pragma unroll 1
        for (int i = 0; i < 64; ++i) {
            float a0 = (i == lane) ? 1.f : 0.f, a1 = 0.f, a2 = 0.f, a3 = 0.f;
            const float* Ai = sA + i * GU_LDA;
            int j = 0;
#pragma unroll 1
            for (; j + 4 <= i; j += 4) {
                const float4 av = *(const float4*)(Ai + j);
                a0 -= av.x * Tf[(j + 0) * 64 + lane]; a1 -= av.y * Tf[(j + 1) * 64 + lane];
                a2 -= av.z * Tf[(j + 2) * 64 + lane]; a3 -= av.w * Tf[(j + 3) * 64 + lane];
            }
#pragma unroll 1
            for (; j < i; ++j) a0 -= Ai[j] * Tf[j * 64 + lane];
            const float a = (a0 + a1) + (a2 + a3);
            Tf[i * 64 + lane] = a;
            sT[i * GU_LDT + lane] = f2bf(a);
        }
    } else {
        bf16_t* att = (bf16_t*)(p.ws + WS_ATT) + (size_t)u * 64 * 64;
        for (int t = tid - 64; t < 512; t += NTHREADS - 64) {
            const int i = t >> 3, kk2 = (t >> 2) & 1, qq = t & 3;
            const float4 lo = *(const float4*)(sAT + i * GU_LDA + 32 * kk2 + 4 * qq), hi = *(const float4*)(sAT + i * GU_LDA + 32 * kk2 + 16 + 4 * qq);
            uint4 o; o.x = pack2(lo.x, lo.y); o.y = pack2(lo.z, lo.w); o.z = pack2(hi.x, hi.y); o.w = pack2(hi.z, hi.w);
            *(uint4*)(att + i * 64 + 32 * kk2 + 8 * qq) = o;
        }
    }
    __syncthreads();
    {
        const int rr = lane & 15, q4 = lane >> 4;
        bf16_t* ut = (bf16_t*)(p.ws + WS_UT) + (size_t)u * 128 * 64;
        bf16_t* wg = (bf16_t*)(p.ws + WS_W) + (size_t)u * 64 * 128;
        f32x4 au[4], aw[4];
#pragma unroll
        for (int m = 0; m < 4; ++m) { au[m] = (f32x4){0.f, 0.f, 0.f, 0.f}; aw[m] = (f32x4){0.f, 0.f, 0.f, 0.f}; }
#pragma unroll
        for (int kk2 = 0; kk2 < 2; ++kk2) {
            const bf16x8 bv = *(const bf16x8*)(sVBT + (16 * wave + rr) * GU_LDT + kk2 * 32 + 8 * q4);
            const bf16x8 ak = *(const bf16x8*)(sKGT + (16 * wave + rr) * GU_LDT + kk2 * 32 + 8 * q4);
#pragma unroll
            for (int m = 0; m < 4; ++m) {
                const bf16x8 tf = *(const bf16x8*)(sT + (16 * m + rr) * GU_LDT + kk2 * 32 + 8 * q4);
                au[m] = __builtin_amdgcn_mfma_f32_16x16x32_bf16(tf, bv, au[m], 0, 0, 0);
                aw[m] = __builtin_amdgcn_mfma_f32_16x16x32_bf16(ak, tf, aw[m], 0, 0, 0);
            }
        }
#pragma unroll
        for (int m = 0; m < 4; ++m) {
            uint2 o; o.x = pack2(au[m][0], au[m][1]); o.y = pack2(au[m][2], au[m][3]);
            *(uint2*)(ut + (size_t)(16 * wave + rr) * 64 + 16 * m + 4 * q4) = o;
            uint2 w2; w2.x = pack2(aw[m][0], aw[m][1]); w2.y = pack2(aw[m][2], aw[m][3]);
            *(uint2*)(wg + (size_t)(16 * m + rr) * 128 + 32 * (wave >> 1) + 8 * q4 + 4 * (wave & 1)) = w2;
        }
    }
}

constexpr int GS_SW = 0, GS_SQD = 17408, GS_SKDT = 34816, GS_SATT = 53248, GS_BUF = 62464;
typedef unsigned u32x2 __attribute__((ext_vector_type(2)));
__device__ __forceinline__ int gdn_chain_chunk(int dir, int s) { return dir == 0 ? (s < 4 ? NCH_LAT + s : s - 4) : NCH - 1 - s; }
struct GsG1 { u32x4 w[2]; u32x4 att; };
struct GsG2 { u32x2 qlo[2], qhi[2]; float gq[2]; };
struct GsG3 { u32x4 kd[2]; float gk[2]; float gl; u32x2 ut[4]; };
__device__ __forceinline__ void gs_load1(const Params& p, int dh, int c, GsG1& st) {
    const int tid = tid_(); const size_t u = (size_t)dh * NCH + c;
    const bf16_t* wg = (const bf16_t*)(p.ws + WS_W) + u * 64 * 128; const bf16_t* att = (const bf16_t*)(p.ws + WS_ATT) + u * 64 * 64;
#pragma unroll
    for (int q = 0; q < 2; ++q) { const int t = tid + q * NTHREADS; st.w[q] = *(const u32x4*)(wg + (size_t)(t >> 4) * 128 + (t & 15) * 8); }
    st.att = *(const u32x4*)(att + (size_t)(tid >> 3) * 64 + (tid & 7) * 8);
}
__device__ __forceinline__ void gs_store1(const GsG1& st, unsigned char* buf) {
    const int tid = tid_(); bf16_t* sW = (bf16_t*)(buf + GS_SW); bf16_t* sATT = (bf16_t*)(buf + GS_SATT);
#pragma unroll
    for (int q = 0; q < 2; ++q) { const int t = tid + q * NTHREADS; *(u32x4*)(sW + (t >> 4) * GU_LDQ + (t & 15) * 8) = st.w[q]; }
    *(u32x4*)(sATT + (tid >> 3) * GU_LDT + (tid & 7) * 8) = st.att;
}
__device__ __forceinline__ void gs_load2(const Params& p, int dh, int c, GsG2& st) {
    const int tid = tid_(), dir = dh >> 3, head = dh & 7; const size_t u = (size_t)dh * NCH + c;
    const float* gc = (const float*)(p.ws + WS_GC) + u * 64; const bf16_t* qn = (const bf16_t*)(p.ws + WS_QN);
#pragma unroll
    for (int q = 0; q < 2; ++q) {
        const int t = tid + q * NTHREADS, i = t >> 4, kk = (t >> 2) & 3, qq = t & 3;
        const bf16_t* src = qn + (size_t)(c * 64 + (dir ? 63 - i : i)) * 1024 + head * 128 + 32 * kk + 4 * qq;
        st.qlo[q] = *(const u32x2*)src; st.qhi[q] = *(const u32x2*)(src + 16); st.gq[q] = gc[i];
    }
}
__device__ __forceinline__ void gs_store2(const GsG2& st, unsigned char* buf) {
    const int tid = tid_(); bf16_t* sQD = (bf16_t*)(buf + GS_SQD);
#pragma unroll
    for (int q = 0; q < 2; ++q) {
        const int t = tid + q * NTHREADS, i = t >> 4, kk = (t >> 2) & 3, qq = t & 3; const float e = __expf(st.gq[q]);
        u32x4 o; o.x = pack2(lo2f(st.qlo[q].x) * e, hi2f(st.qlo[q].x) * e); o.y = pack2(lo2f(st.qlo[q].y) * e, hi2f(st.qlo[q].y) * e);
        o.z = pack2(lo2f(st.qhi[q].x) * e, hi2f(st.qhi[q].x) * e); o.w = pack2(lo2f(st.qhi[q].y) * e, hi2f(st.qhi[q].y) * e);
        *(u32x4*)(sQD + i * GU_LDQ + 32 * kk + 8 * qq) = o;
    }
}
__device__ __forceinline__ void gs_load3(const Params& p, int dh, int c, GsG3& st) {
    const int tid = tid_(), lane = tid & 63, wave = tid >> 6, dir = dh >> 3, head = dh & 7; const size_t u = (size_t)dh * NCH + c;
    const float* gc = (const float*)(p.ws + WS_GC) + u * 64; const bf16_t* kn = (const bf16_t*)(p.ws + WS_KN);
    st.gl = gc[63];
#pragma unroll
    for (int q = 0; q < 2; ++q) {
        const int t = tid + q * NTHREADS, pos = t >> 4, d8 = (t & 15) * 8;
        st.kd[q] = *(const u32x4*)(kn + (size_t)(c * 64 + (dir ? 63 - pos : pos)) * 1024 + head * 128 + d8); st.gk[q] = gc[pos];
    }
    const bf16_t* ut = (const bf16_t*)(p.ws + WS_UT) + u * 128 * 64 + (size_t)(16 * wave + (lane & 15)) * 64 + 4 * (lane >> 4);
#pragma unroll
    for (int m = 0; m < 4; ++m) st.ut[m] = *(const u32x2*)(ut + 16 * m);
}
__device__ __forceinline__ void gs_store3(const GsG3& st, unsigned char* buf) {
    const int tid = tid_(); bf16_t* sKDT = (bf16_t*)(buf + GS_SKDT);
#pragma unroll
    for (int q = 0; q < 2; ++q) {
        const int t = tid + q * NTHREADS, pos = t >> 4, d8 = (t & 15) * 8; const float e = __expf(st.gl - st.gk[q]);
        const u32x4 kq = st.kd[q]; const int sl = perm_slot64(pos);
        sKDT[(d8 + 0) * GU_LDT + sl] = f2bf(lo2f(kq.x) * e); sKDT[(d8 + 1) * GU_LDT + sl] = f2bf(hi2f(kq.x) * e);
        sKDT[(d8 + 2) * GU_LDT + sl] = f2bf(lo2f(kq.y) * e); sKDT[(d8 + 3) * GU_LDT + sl] = f2bf(hi2f(kq.y) * e);
        sKDT[(d8 + 4) * GU_LDT + sl] = f2bf(lo2f(kq.z) * e); sKDT[(d8 + 5) * GU_LDT + sl] = f2bf(hi2f(kq.z) * e);
        sKDT[(d8 + 6) * GU_LDT + sl] = f2bf(lo2f(kq.w) * e); sKDT[(d8 + 7) * GU_LDT + sl] = f2bf(hi2f(kq.w) * e);
    }
}
__device__ __forceinline__ void gdn_seq(const Params& p, int dh, unsigned char* lds) {
    const int tid = tid_(), lane = tid & 63, wave = tid >> 6, rr = lane & 15, q4 = lane >> 4, dir = dh >> 3, head = dh & 7;
    f32x4 Sc[8]; bf16x8 Sb[4];
#pragma unroll
    for (int m = 0; m < 8; ++m) Sc[m] = (f32x4){0.f, 0.f, 0.f, 0.f};
#pragma unroll
    for (int k = 0; k < 4; ++k) Sb[k] = (bf16x8){0, 0, 0, 0, 0, 0, 0, 0};
    u32x2 ucur[4]; float glcur;
    __syncthreads();
    {
        const int c0 = gdn_chain_chunk(dir, 0);
        GsG1 g1; gs_load1(p, dh, c0, g1); gs_store1(g1, lds);
        GsG2 g2; gs_load2(p, dh, c0, g2); gs_store2(g2, lds);
        GsG3 g3; gs_load3(p, dh, c0, g3); gs_store3(g3, lds);
#pragma unroll
        for (int m = 0; m < 4; ++m) ucur[m] = g3.ut[m];
        glcur = g3.gl;
    }
    __syncthreads();
    bf16_t* of = (bf16_t*)(p.ws + WS_OF) + (size_t)dir * SEQ * 1024;
#pragma unroll 1
    for (int s = 0; s < NCH; ++s) {
        const int c = gdn_chain_chunk(dir, s);
        const bool more = s + 1 < NCH;
        const int cn = gdn_chain_chunk(dir, more ? s + 1 : s);
        const unsigned char* buf = lds + (s & 1) * GS_BUF; unsigned char* nbuf = lds + ((s + 1) & 1) * GS_BUF;
        const bf16_t* sW = (const bf16_t*)(buf + GS_SW); const bf16_t* sQD = (const bf16_t*)(buf + GS_SQD);
        const bf16_t* sKDT = (const bf16_t*)(buf + GS_SKDT); const bf16_t* sATT = (const bf16_t*)(buf + GS_SATT);
        GsG1 g1; gs_load1(p, dh, cn, g1);
        f32x4 vn[4];
#pragma unroll
        for (int m = 0; m < 4; ++m) {
            f32x4 acc = (f32x4){0.f, 0.f, 0.f, 0.f};
#pragma unroll
            for (int kk = 0; kk < 4; ++kk)
                acc = __builtin_amdgcn_mfma_f32_16x16x32_bf16(*(const bf16x8*)(sW + (16 * m + rr) * GU_LDQ + kk * 32 + 8 * q4), Sb[kk], acc, 0, 0, 0);
            vn[m][0] = lo2f(ucur[m].x) - acc[0]; vn[m][1] = hi2f(ucur[m].x) - acc[1]; vn[m][2] = lo2f(ucur[m].y) - acc[2]; vn[m][3] = hi2f(ucur[m].y) - acc[3];
        }
        bf16x8 VB[2];
#pragma unroll
        for (int k2 = 0; k2 < 2; ++k2) {
            const unsigned a0 = pack2(vn[2 * k2][0], vn[2 * k2][1]), a1 = pack2(vn[2 * k2][2], vn[2 * k2][3]);
            const unsigned a2 = pack2(vn[2 * k2 + 1][0], vn[2 * k2 + 1][1]), a3 = pack2(vn[2 * k2 + 1][2], vn[2 * k2 + 1][3]);
            const u32x4 pk = {a0, a1, a2, a3}; VB[k2] = __builtin_bit_cast(bf16x8, pk);
        }
        gs_store1(g1, nbuf);
        GsG2 g2; gs_load2(p, dh, cn, g2);
        if (c < NCH_LAT) {
#pragma unroll
            for (int m = 0; m < 4; ++m) {
                f32x4 acc = (f32x4){0.f, 0.f, 0.f, 0.f};
#pragma unroll
                for (int kk = 0; kk < 4; ++kk)
                    acc = __builtin_amdgcn_mfma_f32_16x16x32_bf16(*(const bf16x8*)(sQD + (16 * m + rr) * GU_LDQ + kk * 32 + 8 * q4), Sb[kk], acc, 0, 0, 0);
#pragma unroll
                for (int k2 = 0; k2 < 2; ++k2)
                    acc = __builtin_amdgcn_mfma_f32_16x16x32_bf16(*(const bf16x8*)(sATT + (16 * m + rr) * GU_LDT + k2 * 32 + 8 * q4), VB[k2], acc, 0, 0, 0);
#pragma unroll
                for (int jj = 0; jj < 4; ++jj) {
                    const int pos = 16 * m + 4 * q4 + jj;
                    of[(size_t)(c * 64 + (dir ? 63 - pos : pos)) * 1024 + head * 128 + 16 * wave + rr] = f2bf(acc[jj]);
                }
            }
        }
        gs_store2(g2, nbuf);
        GsG3 g3; gs_load3(p, dh, cn, g3);
        const float egl = __expf(glcur);
#pragma unroll
        for (int m = 0; m < 8; ++m) {
            f32x4 acc = Sc[m] * egl;
#pragma unroll
            for (int k2 = 0; k2 < 2; ++k2)
                acc = __builtin_amdgcn_mfma_f32_16x16x32_bf16(*(const bf16x8*)(sKDT + (16 * m + rr) * GU_LDT + k2 * 32 + 8 * q4), VB[k2], acc, 0, 0, 0);
            Sc[m] = acc;
        }
#pragma unroll
        for (int kk = 0; kk < 4; ++kk) {
            const u32x4 pk = {pack2(Sc[2 * kk][0], Sc[2 * kk][1]), pack2(Sc[2 * kk][2], Sc[2 * kk][3]),
                              pack2(Sc[2 * kk + 1][0], Sc[2 * kk + 1][1]), pack2(Sc[2 * kk + 1][2], Sc[2 * kk + 1][3])};
            Sb[kk] = __builtin_bit_cast(bf16x8, pk);
        }
        gs_store3(g3, nbuf);
#pragma unroll
        for (int m = 0; m < 4; ++m) ucur[m] = g3.ut[m];
        glcur = g3.gl;
        __syncthreads();
    }
}

__device__ __forceinline__ void gdn_readout_row(const Params& p, int row) {
    const int lane = tid_() & 63, head = lane >> 3, d0 = (lane & 7) * 16;
    const bf16_t* of0 = (const bf16_t*)(p.ws + WS_OF) + (size_t)row * 1024 + head * 128 + d0;
    const bf16_t* of1 = of0 + (size_t)SEQ * 1024;
    const bf16_t* zp = (const bf16_t*)(p.ws + WS_Z) + (size_t)row * 1024 + head * 128 + d0;
    float a[16], b[16], z[16];
    unpack8(*(const uint4*)of0, a); unpack8(*(const uint4*)(of0 + 8), a + 8);
    unpack8(*(const uint4*)of1, b); unpack8(*(const uint4*)(of1 + 8), b + 8);
    unpack8(*(const uint4*)zp, z); unpack8(*(const uint4*)(zp + 8), z + 8);
    float ss = 0.f;
#pragma unroll
    for (int e = 0; e < 16; ++e) { a[e] += b[e]; ss += a[e] * a[e]; }
    ss += __shfl_xor(ss, 1, 64); ss += __shfl_xor(ss, 2, 64); ss += __shfl_xor(ss, 4, 64);
    const float rs = rsqrtf(ss * (1.f / 128.f) + 1e-6f);
    const float* ng = p.in[25] + d0;
    float f[16];
#pragma unroll
    for (int e = 0; e < 16; ++e) f[e] = a[e] * rs * ng[e] * siluf_(z[e]);
    bf16_t* dst = (bf16_t*)(p.ws + WS_VN) + (size_t)row * 1024 + head * 128 + d0;
    *(uint4*)dst = pack8(f); *(uint4*)(dst + 8) = pack8(f + 8);
}

#ifndef PHMASK
#define PHMASK 0xFFFFFFFFull
#endif
#define PH(n) (((PHMASK) >> (n)) & 1ull)
#define FOR_ITEMS(n) for (int item = blockIdx.x; item < (n); item += gridDim.x)
__global__ void __launch_bounds__(NTHREADS) fwd_megakernel(Params p) {
    extern __shared__ __attribute__((aligned(16))) unsigned char lds[];
    cg::grid_group grid = cg::this_grid();
    unsigned char* ws = p.ws;

    if (PH(0)) {
        constexpr int N_S5 = 64, N_ADA = 192, N_T0 = 512, N_T1 = 64, N_T2 = 256, N_T3 = 16 * 65, N_T4 = 256, N_T5 = 512, N_T6 = 512, N_SK = 16, N_PT = 8192;
        constexpr int O1 = N_S5, O2 = O1 + N_ADA, O3 = O2 + N_T0, O4 = O3 + N_T1, O5 = O4 + N_T2, O6 = O5 + N_T3, O7 = O6 + N_T4, O8 = O7 + N_T5, O9 = O8 + N_T6, O10 = O9 + N_SK, O11 = O10 + N_PT;
        FOR_ITEMS(O11) {
            if (item < O1) p0_s5_tables(p, item, lds);
            else if (item < O2) p0_adaln(p, item - O1, lds);
            else if (item < O3) p0_transpose(p.in[8], 1024, 2048, (bf16_t*)(ws + WS_WEIN), item - O2, lds);
            else if (item < O4) p0_transpose(p.in[18], 512, 512, (bf16_t*)(ws + WS_WGLU), item - O3, lds);
            else if (item < O5) p0_transpose(p.in[20], 1024, 1024, (bf16_t*)(ws + WS_WEOUT), item - O4, lds);
            else if (item < O6) p0_transpose(p.in[21], 1024, ODD_IN, (bf16_t*)(ws + WS_WOIN), item - O5, lds);
            else if (item < O7) p0_transpose(p.in[26], 1024, 1024, (bf16_t*)(ws + WS_WOOUT), item - O6, lds);
            else if (item < O8) p0_transpose(p.in[27], 1024, 2048, (bf16_t*)(ws + WS_WQ0), item - O7, lds);
            else if (item < O9) p0_transpose(p.in[27] + (size_t)1024 * 2048, 1024, 2048, (bf16_t*)(ws + WS_WQ1), item - O8, lds);
            else if (item < O10) cvt_chunk(p.in[28], (bf16_t*)(ws + WS_SK), item - O9);
            else { const int q = item - O10; cvt_chunk(q < 4096 ? p.in[29] : p.in[30], (bf16_t*)(ws + WS_PUV) + (q < 4096 ? 0 : (size_t)16384 * 1024), q & 4095); }
        }
    }
    grid.sync();
    if (PH(1)) FOR_ITEMS(2080 + 2048) {
        if (item < 2080) norm_rows_item(p, item, 0, p.in[6], 0, true);
        else s5_mintra_item(p, item - 2080);
    }
    grid.sync();
    if (PH(2)) FOR_ITEMS(130 * 16) {
        EpiEvenIn e{(bf16_t*)(ws + WS_PA), (bf16_t*)(ws + WS_UG)};
        gemm_tile((const bf16_t*)(ws + WS_ACT), 1024, R, (const bf16_t*)(ws + WS_WEIN), 1024, 2048, 1024, (item >> 4) * 128, (item & 15) * 128, e, lds);
    }
    grid.sync();
    if (PH(3)) FOR_ITEMS(32 * 30) {
        const int g = item / 30, r = item % 30, tm = r / 10, tn = r % 10;
        EpiS5Local e{(float*)(ws + WS_YL), (float*)(ws + WS_LST), g};
        gemm_tile((const bf16_t*)(ws + WS_UG) + (size_t)g * NCH * 1024, 1024, NCH, (const bf16_t*)(ws + WS_MS5) + (size_t)g * 1280 * 1024, 1024, 1280, 1024, tm * 128, tn * 128, e, lds);
    }
    grid.sync();
    if (PH(4)) s5_scan(p);
    grid.sync();
    if (PH(5)) FOR_ITEMS(32 * 24) {
        const int g = item / 24, r = item % 24, tm = r / 8, tn = r % 8;
        EpiS5Out e{(const float*)(ws + WS_YL), (bf16_t*)(ws + WS_GS), g};
        gemm_tile((const bf16_t*)(ws + WS_A5) + (size_t)g * NCH * 256, 256, NCH, (const bf16_t*)(ws + WS_O5) + (size_t)g * 1024 * 256, 256, 1024, 256, tm * 128, tn * 128, e, lds);
    }
    grid.sync();
    if (PH(6)) FOR_ITEMS(130 * 4 + NCH) {
        if (item < 520) {
            EpiGlu e{(const bf16_t*)(ws + WS_GS), p.in[19], (bf16_t*)(ws + WS_CB)};
            gemm_tile((const bf16_t*)(ws + WS_GS), 512, R, (const bf16_t*)(ws + WS_WGLU), 512, 512, 512, (item >> 2) * 128, (item & 3) * 128, e, lds);
        } else even_conv_item(p, item - 520);
    }
    grid.sync();
    if (PH(7)) FOR_ITEMS(130 * 8) {
        EpiResid e{p.in[0], p.in[2], (float*)(ws + WS_H), (const float*)(ws + WS_MOD), 0, true};
        gemm_tile((const bf16_t*)(ws + WS_CB), 1024, R, (const bf16_t*)(ws + WS_WEOUT), 1024, 1024, 1024, (item >> 3) * 128, (item & 7) * 128, e, lds);
    }
    grid.sync();
#pragma unroll 1
    for (int l = 0; l < 2; ++l) {
        const int nrows = l == 0 ? R : SEQ, ntm = nrows / 128;
        if (l == 1) {
            if (PH(13)) FOR_ITEMS(2080) norm_rows_item(p, item, 1, p.in[6] + 1024, 0, false);
            grid.sync();
            if (PH(14)) FOR_ITEMS(130 * 33) {
                EpiOddIn e{(bf16_t*)(ws + WS_QKVR), (bf16_t*)(ws + WS_Z), (float*)(ws + WS_AB)};
                gemm_tile((const bf16_t*)(ws + WS_ACT), 1024, R, (const bf16_t*)(ws + WS_WOIN), 1024, ODD_IN, 1024, (item / 33) * 128, (item % 33) * 128, e, lds);
            }
            grid.sync();
            if (PH(15)) FOR_ITEMS(NCH) gdn_prep_item(p, item);
            grid.sync();
            if (PH(16)) FOR_ITEMS(NUNITS) gdn_unit(p, item, lds);
            grid.sync();
            if (PH(17)) if (blockIdx.x < 16) gdn_seq(p, blockIdx.x, lds);
            grid.sync();
            if (PH(18)) FOR_ITEMS(SEQ / 8) gdn_readout_row(p, item * 8 + (tid_() >> 6));
            grid.sync();
            if (PH(19)) FOR_ITEMS(128 * 8 + 8192) {
                if (item < 1024) {
                    EpiResid e{p.in[0], p.in[2], (float*)(ws + WS_H), (const float*)(ws + WS_MOD), 1, false};
                    gemm_tile((const bf16_t*)(ws + WS_VN), 1024, SEQ, (const bf16_t*)(ws + WS_WOOUT), 1024, 1024, 1024, (item >> 3) * 128, (item & 7) * 128, e, lds);
                } else {
                    const int q = item - 1024;
                    cvt_chunk((q < 4096 ? p.in[29] : p.in[30]) + (size_t)16384 * 1024, (bf16_t*)(ws + WS_PUV) + (q < 4096 ? 0 : (size_t)16384 * 1024), q & 4095);
                }
            }
            grid.sync();
        }
        if (PH(8)) FOR_ITEMS(nrows / 8) norm_rows_item(p, item, l, p.in[7] + l * 1024, 3, false);
        grid.sync();
        if (PH(9)) FOR_ITEMS(ntm * 16) {
            EpiBf16 e{(bf16_t*)(ws + WS_Q), 2048};
            gemm_tile((const bf16_t*)(ws + WS_ACT), 1024, nrows, (const bf16_t*)(ws + (l == 0 ? WS_WQ0 : WS_WQ1)), 1024, 2048, 1024, (item >> 4) * 128, (item & 15) * 128, e, lds);
        }
        grid.sync();
        if (PH(10)) FOR_ITEMS(ntm * 16) {
            const int b = item & 15;
            EpiScore e{(unsigned short*)(ws + WS_SC), b * 128};
            gemm_tile((const bf16_t*)(ws + WS_Q) + b * 128, 2048, nrows, (const bf16_t*)(ws + WS_SK) + (size_t)(l * 2 + (b & 1)) * 128 * 128, 128, 128, 128, (item >> 4) * 128, 0, e, lds);
        }
        grid.sync();
        if (PH(11)) FOR_ITEMS(nrows / 64) peer_route_item(p, item, nrows, lds);
        grid.sync();
        if (PH(12)) FOR_ITEMS(nrows / 8) peer_gather_row(p, item * 8 + (tid_() >> 6), l, l == 1);
        if (l == 0) grid.sync();
    }
}

extern "C" void kernel_launch(void* const* d_in, const int* in_sizes, int n_in, void* d_out, int out_size, void* d_ws, size_t ws_size, hipStream_t stream) {
    static int grid_blocks = 0;
    if (grid_blocks == 0) {
        if (n_in != 32 || out_size != SEQ * D || ws_size < WS_NEED) {
            fprintf(stderr, "kernel_launch: unexpected problem (n_in %d, out %d, ws %zu, need %zu); nothing launched\n", n_in, out_size, ws_size, (size_t)WS_NEED);
            grid_blocks = -1; return;
        }
        int dev = 0, cus = 0, per_cu = 0;
        hipGetDevice(&dev);
        hipDeviceGetAttribute(&cus, hipDeviceAttributeMultiprocessorCount, dev);
        hipFuncSetAttribute((const void*)fwd_megakernel, hipFuncAttributeMaxDynamicSharedMemorySize, LDS_BYTES);
        hipOccupancyMaxActiveBlocksPerMultiprocessor(&per_cu, (const void*)fwd_megakernel, NTHREADS, LDS_BYTES);
        if (per_cu < 1) { fprintf(stderr, "kernel_launch: occupancy query says %d blocks per CU; nothing launched\n", per_cu); grid_blocks = -1; return; }
        grid_blocks = cus;
    }
    if (grid_blocks < 0) return;
    Params prm{};
    for (int i = 0; i < 32; ++i) prm.in[i] = (const float*)d_in[i];
    prm.out = (float*)d_out; prm.ws = (unsigned char*)d_ws;
    void* args[] = {&prm};
    hipError_t e = hipLaunchCooperativeKernel((const void*)fwd_megakernel, dim3(grid_blocks), dim3(NTHREADS), args, LDS_BYTES, stream);
    if (e != hipSuccess) fprintf(stderr, "cooperative launch failed: %s (grid %d)\n", hipGetErrorString(e), grid_blocks);
}
```

```cpp
#include <hip/hip_runtime.h>
#include <hip/hip_cooperative_groups.h>
#include <cstdio>
#include <cstdint>
namespace cg = cooperative_groups;

typedef unsigned short bf16_t;
typedef short bf16x8 __attribute__((ext_vector_type(8)));
typedef float f32x4 __attribute__((ext_vector_type(4)));
typedef float f32x16 __attribute__((ext_vector_type(16)));
typedef unsigned u32x4 __attribute__((ext_vector_type(4)));

constexpr int D = 1024, SEQ = 16384, CTX = 256, R = SEQ + CTX;
constexpr int NCH = R / 64;
constexpr int NCH_LAT = SEQ / 64;
constexpr int NTHREADS = 512;
constexpr int ODD_IN = 4128;
constexpr int NUNITS = 16 * NCH;

constexpr size_t al256(size_t x) { return (x + 255) & ~(size_t)255; }
constexpr size_t WS_BAR   = 0;
constexpr size_t WS_MOD   = 16384;
constexpr size_t WS_A64   = WS_MOD + al256(2 * 2 * 6 * 1024 * 4);
constexpr size_t WS_SK    = WS_A64 + al256(2 * 32 * 64 * 8);
constexpr size_t WS_WEIN  = WS_SK + al256(2 * 2 * 128 * 128 * 2);
constexpr size_t WS_WGLU  = WS_WEIN + (size_t)2048 * 1024 * 2;
constexpr size_t WS_WEOUT = WS_WGLU + (size_t)512 * 512 * 2;
constexpr size_t WS_WQ0   = WS_WEOUT + (size_t)1024 * 1024 * 2;
constexpr size_t WS_WQ1   = WS_WQ0 + (size_t)2048 * 1024 * 2;
constexpr size_t WS_WOIN  = WS_WQ1 + (size_t)2048 * 1024 * 2;
constexpr size_t WS_WOOUT = WS_WOIN + al256((size_t)ODD_IN * 1024 * 2);
constexpr size_t WS_H     = WS_WOOUT + (size_t)1024 * 1024 * 2;
constexpr size_t WS_PUV   = WS_H + (size_t)R * 1024 * 4;
constexpr size_t WS_ACT   = WS_PUV + (size_t)2 * 16384 * 1024 * 2;
constexpr size_t WS_ARENA = WS_ACT + (size_t)R * 1024 * 2;
constexpr size_t WS_GG    = WS_WEIN;
constexpr size_t WS_BETA  = WS_GG + (size_t)16 * R * 4;
constexpr size_t WS_GC    = WS_BETA + (size_t)16 * R * 4;
constexpr size_t WS_AB    = WS_GC + (size_t)NUNITS * 64 * 4;
static_assert(WS_AB + (size_t)R * 32 * 4 <= WS_WQ1, "layer-1 small buffers overflow the dead layer-0 weights");
constexpr size_t WS_PA    = WS_ARENA;
constexpr size_t WS_UG    = WS_PA + (size_t)R * 1536 * 2;
constexpr size_t WS_MS5   = WS_UG + (size_t)32 * NCH * 1024 * 2;
constexpr size_t WS_O5    = WS_MS5 + (size_t)32 * 1280 * 1024 * 2;
constexpr size_t WS_KTAB  = WS_O5 + (size_t)32 * 1024 * 256 * 2;
constexpr size_t WS_YL    = WS_KTAB + (size_t)2 * 32 * 64 * 256 * 4;
constexpr size_t WS_LST   = WS_YL + (size_t)R * 512 * 4;
constexpr size_t WS_A5    = WS_LST + (size_t)32 * NCH * 256 * 4;
constexpr size_t WS_GS    = WS_A5 + (size_t)32 * NCH * 256 * 2;
constexpr size_t WS_CB    = WS_GS + (size_t)R * 512 * 2;
constexpr size_t WS_END_L0 = WS_CB + (size_t)R * 1024 * 2;
constexpr size_t WS_Q     = WS_ARENA;
constexpr size_t WS_SC    = WS_Q + (size_t)R * 2048 * 2;
constexpr size_t WS_IDX   = WS_SC + (size_t)R * 2048 * 2;
constexpr size_t WS_GATE  = WS_IDX + (size_t)R * 128 * 4;
constexpr size_t WS_END_PEER = WS_GATE + (size_t)R * 128 * 4;
constexpr size_t WS_QKVR  = WS_ARENA;
constexpr size_t WS_W     = WS_QKVR;
constexpr size_t WS_ATT   = WS_W + (size_t)NUNITS * 64 * 128 * 2;
static_assert(WS_ATT + (size_t)NUNITS * 64 * 64 * 2 <= WS_QKVR + (size_t)R * 3072 * 2, "W+ATT must fit in QKVR");
constexpr size_t WS_Z     = WS_QKVR + (size_t)R * 3072 * 2;
constexpr size_t WS_QN    = WS_Z + (size_t)R * 1024 * 2;
constexpr size_t WS_KN    = WS_QN + (size_t)R * 1024 * 2;
constexpr size_t WS_VN    = WS_KN + (size_t)R * 1024 * 2;
constexpr size_t WS_UT    = WS_VN + (size_t)R * 1024 * 2;
constexpr size_t WS_END_L1 = WS_UT + (size_t)NUNITS * 128 * 64 * 2;
constexpr size_t WS_OF    = WS_PUV;
constexpr size_t cmax(size_t a, size_t b) { return a > b ? a : b; }
constexpr size_t WS_NEED  = cmax(cmax(WS_END_L0, WS_END_PEER), WS_END_L1);
static_assert(WS_NEED <= (size_t)512 * 1024 * 1024, "workspace plan exceeds 512 MiB");

constexpr int LDS_BYTES = 140 * 1024;

struct Params {
    const float* in[32];
    float* out;
    unsigned char* ws;
};

__device__ __forceinline__ int tid_() { int t = threadIdx.x; asm volatile("" : "+v"(t)); return t; }
__device__ __forceinline__ float bf2f(bf16_t b) { return __uint_as_float((unsigned)b << 16); }
__device__ __forceinline__ bf16_t f2bf(float f) { const __bf16 b = (__bf16)f; return __builtin_bit_cast(bf16_t, b); }
typedef float f32x2_t __attribute__((ext_vector_type(2)));
typedef __bf16 bf16x2_t __attribute__((ext_vector_type(2)));
__device__ __forceinline__ unsigned pack2(float lo, float hi) { const f32x2_t v = {lo, hi}; const bf16x2_t b = __builtin_convertvector(v, bf16x2_t); return __builtin_bit_cast(unsigned, b); }
__device__ __forceinline__ float lo2f(unsigned p) { return __uint_as_float(p << 16); }
__device__ __forceinline__ float hi2f(unsigned p) { return __uint_as_float(p & 0xFFFF0000u); }
__device__ __forceinline__ float sigmoidf_(float x) { return 1.f / (1.f + __expf(-x)); }
__device__ __forceinline__ float siluf_(float x) { return x * sigmoidf_(x); }
__device__ __forceinline__ float gelu_tanh(float x) {
    const float u = 0.7978845608028654f * (x + 0.044715f * x * x * x);
    const float t = 1.f - 2.f / (1.f + __expf(2.f * u));
    return 0.5f * x * (1.f + t);
}
__device__ __forceinline__ float wave_sum(float v) {
#pragma unroll
    for (int o = 32; o > 0; o >>= 1) v += __shfl_xor(v, o, 64);
    return v;
}
__device__ __forceinline__ void unpack8(const uint4& p, float* f) {
    f[0] = lo2f(p.x); f[1] = hi2f(p.x); f[2] = lo2f(p.y); f[3] = hi2f(p.y);
    f[4] = lo2f(p.z); f[5] = hi2f(p.z); f[6] = lo2f(p.w); f[7] = hi2f(p.w);
}
__device__ __forceinline__ uint4 pack8(const float* f) {
    uint4 p; p.x = pack2(f[0], f[1]); p.y = pack2(f[2], f[3]); p.z = pack2(f[4], f[5]); p.w = pack2(f[6], f[7]); return p;
}
__device__ __forceinline__ const float* modp(const Params& p, int l, int row, int j) {
    const float* m = (const float*)(p.ws + WS_MOD);
    return m + ((l * 2 + (row >= SEQ ? 1 : 0)) * 6 + j) * 1024;
}

constexpr int GT_LD = 72;
constexpr int GT_OPB = 128 * GT_LD * 2;
template <class Epi>
__device__ __forceinline__ void gemm_tile(const bf16_t* __restrict__ A, int lda, int M, const bf16_t* __restrict__ Bt, int ldb, int N, int K,
                                          int row0, int col0, Epi epi, unsigned char* lds) {
    const int tid = tid_(), lane = tid & 63, wave = tid >> 6;
    const int wm = wave >> 2, wn = wave & 3, r = lane & 31, h = lane >> 5;
    const int lr = tid >> 3, lc = (tid & 7) * 8;
    int ar0 = row0 + lr, ar1 = row0 + lr + 64, br0 = col0 + lr, br1 = col0 + lr + 64;
    ar0 = ar0 < M ? ar0 : M - 1; ar1 = ar1 < M ? ar1 : M - 1; br0 = br0 < N ? br0 : N - 1; br1 = br1 < N ? br1 : N - 1;
    const bf16_t* pa0 = A + (size_t)ar0 * lda + lc; const bf16_t* pa1 = A + (size_t)ar1 * lda + lc;
    const bf16_t* pb0 = Bt + (size_t)br0 * ldb + lc; const bf16_t* pb1 = Bt + (size_t)br1 * ldb + lc;
    f32x16 acc0, acc1;
#pragma unroll
    for (int i = 0; i < 16; ++i) { acc0[i] = 0.f; acc1[i] = 0.f; }
    const int nk = K >> 6;
    uint4 ra0 = *(const uint4*)pa0, ra1 = *(const uint4*)pa1, rb0 = *(const uint4*)pb0, rb1 = *(const uint4*)pb1;
    __syncthreads();
    {
        unsigned char* sa = lds; unsigned char* sb = lds + GT_OPB;
        *(uint4*)(sa + (lr * GT_LD + lc) * 2) = ra0; *(uint4*)(sa + ((lr + 64) * GT_LD + lc) * 2) = ra1;
        *(uint4*)(sb + (lr * GT_LD + lc) * 2) = rb0; *(uint4*)(sb + ((lr + 64) * GT_LD + lc) * 2) = rb1;
    }
    __syncthreads();
    for (int kt = 0; kt < nk; ++kt) {
        const int cur = kt & 1;
        if (kt + 1 < nk) {
            const int ko = (kt + 1) * 64;
            ra0 = *(const uint4*)(pa0 + ko); ra1 = *(const uint4*)(pa1 + ko); rb0 = *(const uint4*)(pb0 + ko); rb1 = *(const uint4*)(pb1 + ko);
        }
        const unsigned char* sa = lds + cur * 2 * GT_OPB; const unsigned char* sb = sa + GT_OPB;
#pragma unroll
        for (int s = 0; s < 4; ++s) {
            const bf16x8 a0 = *(const bf16x8*)(sa + ((wm * 64 + r) * GT_LD + s * 16 + 8 * h) * 2);
            const bf16x8 a1 = *(const bf16x8*)(sa + ((wm * 64 + 32 + r) * GT_LD + s * 16 + 8 * h) * 2);
            const bf16x8 b  = *(const bf16x8*)(sb + ((wn * 32 + r) * GT_LD + s * 16 + 8 * h) * 2);
            acc0 = __builtin_amdgcn_mfma_f32_32x32x16_bf16(a0, b, acc0, 0, 0, 0);
            acc1 = __builtin_amdgcn_mfma_f32_32x32x16_bf16(a1, b, acc1, 0, 0, 0);
        }
        if (kt + 1 < nk) {
            unsigned char* na = lds + (cur ^ 1) * 2 * GT_OPB; unsigned char* nb = na + GT_OPB;
            *(uint4*)(na + (lr * GT_LD + lc) * 2) = ra0; *(uint4*)(na + ((lr + 64) * GT_LD + lc) * 2) = ra1;
            *(uint4*)(nb + (lr * GT_LD + lc) * 2) = rb0; *(uint4*)(nb + ((lr + 64) * GT_LD + lc) * 2) = rb1;
        }
        __syncthreads();
    }
    const int col = col0 + wn * 32 + r;
    if (col < N) {
#pragma unroll
        for (int i = 0; i < 16; ++i) {
            const int rr = (i & 3) + 8 * (i >> 2) + 4 * h;
            const int row_a = row0 + wm * 64 + rr, row_b = row_a + 32;
            if (row_a < M) epi(row_a, col, acc0[i]);
            if (row_b < M) epi(row_b, col, acc1[i]);
        }
    }
}

__device__ __forceinline__ void p0_adaln(const Params& p, int item, unsigned char* lds) {
    const int l = item / 96, cb = item % 96, tid = tid_();
    const int kq = tid >> 4, c4 = tid & 15;
    const float* W = p.in[4] + (size_t)l * 1024 * 6144 + cb * 64 + c4 * 4;
    const float* c = p.in[1]; const float* cc = p.in[3];
    float al[4] = {0, 0, 0, 0}, ac[4] = {0, 0, 0, 0};
    for (int k = kq; k < 1024; k += 32) {
        const float4 w = *(const float4*)(W + (size_t)k * 6144);
        const float sl = siluf_(c[k]), sc = siluf_(cc[k]);
        al[0] += sl * w.x; al[1] += sl * w.y; al[2] += sl * w.z; al[3] += sl * w.w;
        ac[0] += sc * w.x; ac[1] += sc * w.y; ac[2] += sc * w.z; ac[3] += sc * w.w;
    }
    float* red = (float*)lds;
    __syncthreads();
#pragma unroll
    for (int e = 0; e < 4; ++e) { red[(kq * 2 + 0) * 64 + c4 * 4 + e] = al[e]; red[(kq * 2 + 1) * 64 + c4 * 4 + e] = ac[e]; }
    __syncthreads();
    if (tid < 128) {
        const int s = tid >> 6, cidx = tid & 63;
        float sum = 0.f;
        for (int q = 0; q < 32; ++q) sum += red[(q * 2 + s) * 64 + cidx];
        const int col = cb * 64 + cidx;
        sum += p.in[5][l * 6144 + col];
        ((float*)(p.ws + WS_MOD))[(l * 2 + s) * 6144 + col] = sum;
    }
}
__device__ __forceinline__ void p0_transpose(const float* __restrict__ src, int K, int N, bf16_t* __restrict__ dst, int tile, unsigned char* lds) {
    const int ntn = (N + 63) / 64, tk = tile / ntn, tn = tile % ntn, tid = tid_();
    float* s = (float*)lds;
    __syncthreads();
    for (int e = tid; e < 64 * 64; e += NTHREADS) {
        const int kk = e >> 6, nn = e & 63; const int n = tn * 64 + nn;
        s[kk * 65 + nn] = n < N ? src[(size_t)(tk * 64 + kk) * N + n] : 0.f;
    }
    __syncthreads();
    {
        const int nn = tid >> 3, kg = (tid & 7) * 8; const int n = tn * 64 + nn;
        if (n < N) {
            float f[8];
#pragma unroll
            for (int e = 0; e < 8; ++e) f[e] = s[(kg + e) * 65 + nn];
            *(uint4*)(dst + (size_t)n * K + tk * 64 + kg) = pack8(f);
        }
    }
}
__device__ __forceinline__ void cvt_chunk(const float* __restrict__ src, bf16_t* __restrict__ dst, size_t item) {
    const size_t o = item * 4096 + (size_t)tid_() * 8;
    const float4 a = *(const float4*)(src + o), b = *(const float4*)(src + o + 4);
    uint4 q; q.x = pack2(a.x, a.y); q.y = pack2(a.z, a.w); q.z = pack2(b.x, b.y); q.w = pack2(b.z, b.w);
    *(uint4*)(dst + o) = q;
}
__device__ __forceinline__ void sincos_d(double x, double& s, double& c) {
    const double TWO_OVER_PI = 0.63661977236758134308, PIO2_HI = 1.57079632679489655800e+00, PIO2_LO = 6.12323399573676603587e-17;
    const double kf = rint(x * TWO_OVER_PI);
    const double y = (x - kf * PIO2_HI) - kf * PIO2_LO;
    const double y2 = y * y;
    double sp = -1.0 / 1307674368000.0;
    sp = sp * y2 + 1.0 / 6227020800.0; sp = sp * y2 - 1.0 / 39916800.0; sp = sp * y2 + 1.0 / 362880.0; sp = sp * y2 - 1.0 / 5040.0;
    sp = sp * y2 + 1.0 / 120.0; sp = sp * y2 - 1.0 / 6.0; sp = sp * y2 + 1.0; sp *= y;
    double cp = 1.0 / 20922789888000.0;
    cp = cp * y2 - 1.0 / 87178291200.0; cp = cp * y2 + 1.0 / 479001600.0; cp = cp * y2 - 1.0 / 3628800.0; cp = cp * y2 + 1.0 / 40320.0;
    cp = cp * y2 - 1.0 / 720.0; cp = cp * y2 + 1.0 / 24.0; cp = cp * y2 - 0.5; cp = cp * y2 + 1.0;
    const int q = ((int)kf) & 3;
    s = (q == 0) ? sp : (q == 1) ? cp : (q == 2) ? -sp : -cp;
    c = (q == 0) ? cp : (q == 1) ? -sp : (q == 2) ? -cp : sp;
}
__device__ __forceinline__ void p0_s5_tables(const Params& p, int item, unsigned char* lds) {
    const int di = item >> 5, g = item & 31, tid = tid_();
    float2* apw = (float2*)lds;
    float2* Bb = apw + 64 * 65;
    float2* Cc = Bb + 64 * 16;
    __syncthreads();
    if (tid < 64) {
        const int pidx = (di * 32 + g) * 64 + tid;
        float lr = p.in[10][pidx]; lr = lr < -1e-4f ? lr : -1e-4f;
        const float li = p.in[11][pidx];
        const float dt = expf(p.in[12][di * 32 + g]);
        const double mag = (double)expf(lr * dt);
        double sn, cs; sincos_d((double)li * (double)dt, sn, cs);
        const double are = mag * cs, aim = mag * sn;
        double pr = 1.0, pi_ = 0.0;
        for (int t = 0; t <= 64; ++t) {
            apw[tid * 65 + t] = make_float2((float)pr, (float)pi_);
            const double nr = pr * are - pi_ * aim, ni = pr * aim + pi_ * are; pr = nr; pi_ = ni;
        }
        ((float2*)(p.ws + WS_A64))[(di * 32 + g) * 64 + tid] = apw[tid * 65 + 64];
        const double den = (double)lr * lr + (double)li * li;
        const double fre = ((are - 1.0) * lr + aim * li) / den, fim = (aim * lr - (are - 1.0) * li) / den;
        for (int hh = 0; hh < 16; ++hh) {
            const double br = p.in[13][(size_t)pidx * 16 + hh], bi = p.in[14][(size_t)pidx * 16 + hh];
            Bb[tid * 16 + hh] = make_float2((float)(fre * br - fim * bi), (float)(fre * bi + fim * br));
        }
    }
    for (int e = tid; e < 1024; e += NTHREADS) {
        const size_t gi = ((size_t)(di * 32 + g) * 16) * 64 + e;
        Cc[e] = make_float2(p.in[15][gi], p.in[16][gi]);
    }
    __syncthreads();
    float* ktab = (float*)(p.ws + WS_KTAB) + (size_t)(di * 32 + g) * 64 * 256;
    for (int o = tid; o < 64 * 256; o += NTHREADS) {
        const int tau = o >> 8, hh = (o >> 4) & 15, h2 = o & 15;
        float acc = 0.f;
        for (int pp = 0; pp < 64; ++pp) {
            const float2 a = apw[pp * 65 + tau], c = Cc[hh * 64 + pp], b = Bb[pp * 16 + h2];
            const float cr = c.x * a.x - c.y * a.y, ci = c.x * a.y + c.y * a.x;
            acc += cr * b.x - ci * b.y;
        }
        ktab[o] = acc;
    }
    bf16_t* ms5 = (bf16_t*)(p.ws + WS_MS5) + (size_t)g * 1280 * 1024;
    for (int t = tid; t < 128 * 128; t += NTHREADS) {
        const int row = t >> 7, k8 = t & 127; const int ri = row >> 6, pp = row & 63, j = k8 >> 1, h0 = (k8 & 1) * 8;
        const float2 a = apw[pp * 65 + (di == 0 ? 63 - j : j)];
        float f[8];
#pragma unroll
        for (int e = 0; e < 8; ++e) { const float2 b = Bb[pp * 16 + h0 + e]; f[e] = ri == 0 ? (a.x * b.x - a.y * b.y) : (a.x * b.y + a.y * b.x); }
        *(uint4*)(ms5 + (size_t)(1024 + di * 128 + row) * 1024 + k8 * 8) = pack8(f);
    }
    bf16_t* o5 = (bf16_t*)(p.ws + WS_O5) + (size_t)g * 1024 * 256;
    for (int t = tid; t < 1024 * 16; t += NTHREADS) {
        const int n = t >> 4, q = t & 15; const int ri = q >> 3, p0 = (q & 7) * 8, i = n >> 4, hh = n & 15;
        float f[8];
#pragma unroll
        for (int e = 0; e < 8; ++e) {
            const float2 a = apw[(p0 + e) * 65 + (di == 0 ? i + 1 : 64 - i)], c = Cc[hh * 64 + p0 + e];
            f[e] = ri == 0 ? (c.x * a.x - c.y * a.y) : -(c.x * a.y + c.y * a.x);
        }
        *(uint4*)(o5 + (size_t)n * 256 + di * 128 + ri * 64 + p0) = pack8(f);
    }
}

__device__ __forceinline__ void norm_mod_row(const float* __restrict__ src, const float* __restrict__ g, const float* __restrict__ shift,
                                             const float* __restrict__ scale, bf16_t* __restrict__ dst, int lane) {
    float4 v[4]; float ss = 0.f;
#pragma unroll
    for (int k = 0; k < 4; ++k) { v[k] = *(const float4*)(src + k * 256 + lane * 4); ss += v[k].x * v[k].x + v[k].y * v[k].y + v[k].z * v[k].z + v[k].w * v[k].w; }
    ss = wave_sum(ss);
    const float rs = rsqrtf(ss * (1.f / 1024.f) + 1e-6f);
#pragma unroll
    for (int k = 0; k < 4; ++k) {
        const int c = k * 256 + lane * 4;
        const float4 gg = *(const float4*)(g + c), sh = *(const float4*)(shift + c), sc = *(const float4*)(scale + c);
        uint2 o;
        o.x = pack2(v[k].x * rs * gg.x * (1.f + sc.x) + sh.x, v[k].y * rs * gg.y * (1.f + sc.y) + sh.y);
        o.y = pack2(v[k].z * rs * gg.z * (1.f + sc.z) + sh.z, v[k].w * rs * gg.w * (1.f + sc.w) + sh.w);
        *(uint2*)(dst + c) = o;
    }
}
__device__ __forceinline__ void norm_rows_item(const Params& p, int item, int l, const float* g, int js, bool from_inputs) {
    const int row = item * 8 + (tid_() >> 6), lane = tid_() & 63;
    const float* src = from_inputs ? (row < SEQ ? p.in[0] + (size_t)row * 1024 : p.in[2] + (size_t)(row - SEQ) * 1024)
                                   : (const float*)(p.ws + WS_H) + (size_t)row * 1024;
    norm_mod_row(src, g, modp(p, l, row, js), modp(p, l, row, js + 1), (bf16_t*)(p.ws + WS_ACT) + (size_t)row * 1024, lane);
}
__device__ __forceinline__ void s5_mintra_item(const Params& p, int item) {
    const int g = item >> 6, i = item & 63;
    const float* kt0 = (const float*)(p.ws + WS_KTAB) + (size_t)(0 * 32 + g) * 64 * 256;
    const float* kt1 = (const float*)(p.ws + WS_KTAB) + (size_t)(1 * 32 + g) * 64 * 256;
    const float* dsk = p.in[17] + g * 16;
    bf16_t* ms5 = (bf16_t*)(p.ws + WS_MS5) + (size_t)g * 1280 * 1024;
    for (int t = tid_(); t < 16 * 128; t += NTHREADS) {
        const int hh = t >> 7, k8 = t & 127, j = k8 >> 1, h0 = (k8 & 1) * 8;
        float f[8];
        if (j < i) { const float* s = kt0 + ((i - j) * 16 + hh) * 16 + h0;
#pragma unroll
            for (int e = 0; e < 8; ++e) f[e] = s[e]; }
        else if (j > i) { const float* s = kt1 + ((j - i) * 16 + hh) * 16 + h0;
#pragma unroll
            for (int e = 0; e < 8; ++e) f[e] = s[e]; }
        else { const float* s0 = kt0 + hh * 16 + h0; const float* s1 = kt1 + hh * 16 + h0;
#pragma unroll
            for (int e = 0; e < 8; ++e) f[e] = s0[e] + s1[e] + ((h0 + e) == hh ? dsk[hh] : 0.f); }
        *(uint4*)(ms5 + (size_t)(i * 16 + hh) * 1024 + k8 * 8) = pack8(f);
    }
}

struct EpiEvenIn {
    bf16_t* pa; bf16_t* ug;
    __device__ __forceinline__ void operator()(int row, int col, float v) const {
        if (col < 1536) pa[(size_t)row * 1536 + col] = f2bf(v);
        else { const int c2 = col - 1536; ug[((size_t)(c2 >> 4) * NCH + (row >> 6)) * 1024 + (row & 63) * 16 + (c2 & 15)] = f2bf(v); }
    }
};
struct EpiS5Local {
    float* yl; float* lst; int g;
    __device__ __forceinline__ void operator()(int row, int col, float v) const {
        if (col < 1024) yl[(size_t)(row * 64 + (col >> 4)) * 512 + g * 16 + (col & 15)] = v;
        else lst[((size_t)g * NCH + row) * 256 + (col - 1024)] = v;
    }
};
struct EpiS5Out {
    const float* yl; bf16_t* gs; int g;
    __device__ __forceinline__ void operator()(int row, int col, float v) const {
        const size_t o = (size_t)(row * 64 + (col >> 4)) * 512 + g * 16 + (col & 15);
        gs[o] = f2bf(gelu_tanh(v + yl[o]));
    }
};
struct EpiGlu {
    const bf16_t* gs; const float* b; bf16_t* cb;
    __device__ __forceinline__ void operator()(int row, int col, float v) const {
        cb[(size_t)row * 1024 + 512 + col] = f2bf(bf2f(gs[(size_t)row * 512 + col]) * sigmoidf_(v + b[col]));
    }
};
struct EpiResid {
    const float* x; const float* ctx; float* hbuf; const float* mod; int l; bool from_inputs;
    __device__ __forceinline__ void operator()(int row, int col, float v) const {
        float* h = hbuf + (size_t)row * 1024 + col;
        const float base = from_inputs ? (row < SEQ ? x[(size_t)row * 1024 + col] : ctx[(size_t)(row - SEQ) * 1024 + col]) : *h;
        *h = base + mod[((l * 2 + (row >= SEQ ? 1 : 0)) * 6 + 2) * 1024 + col] * v;
    }
};
struct EpiBf16 {
    bf16_t* dst; int ld;
    __device__ __forceinline__ void operator()(int row, int col, float v) const { dst[(size_t)row * ld + col] = f2bf(v); }
};
struct EpiScore {
    unsigned short* dst; int coff;
    __device__ __forceinline__ void operator()(int row, int col, float v) const {
        const _Float16 hv = (_Float16)v; dst[(size_t)row * 2048 + coff + col] = __builtin_bit_cast(unsigned short, hv);
    }
};
struct EpiOddIn {
    bf16_t* qkvr; bf16_t* z; float* ab;
    __device__ __forceinline__ void operator()(int row, int col, float v) const {
        if (col < 3072) qkvr[(size_t)row * 3072 + col] = f2bf(v);
        else if (col < 4096) z[(size_t)row * 1024 + (col - 3072)] = f2bf(v);
        else ab[(size_t)row * 32 + (col - 4096)] = v;
    }
};

__device__ __forceinline__ void s5_scan(const Params& p) {
    const int gt = blockIdx.x * NTHREADS + tid_();
    if (gt >= 4096) return;
    const int di = gt >> 11, g = (gt >> 6) & 31, pp = gt & 63;
    const float2 a = ((const float2*)(p.ws + WS_A64))[(di * 32 + g) * 64 + pp];
    const float* lst = (const float*)(p.ws + WS_LST) + (size_t)g * NCH * 256 + di * 128 + pp;
    bf16_t* a5 = (bf16_t*)(p.ws + WS_A5) + (size_t)g * NCH * 256 + di * 128 + pp;
    float sr = 0.f, si = 0.f;
    for (int s0 = 0; s0 < NCH; s0 += 4) {
        int c[4]; float lr[4], li[4];
#pragma unroll
        for (int u = 0; u < 4; ++u) {
            const int s = s0 + u;
            c[u] = di == 0 ? (s < 4 ? NCH_LAT + s : s - 4) : (s < 4 ? NCH - 1 - s : NCH - 1 - s);
            lr[u] = lst[(size_t)c[u] * 256]; li[u] = lst[(size_t)c[u] * 256 + 64];
        }
#pragma unroll
        for (int u = 0; u < 4; ++u) {
            a5[(size_t)c[u] * 256] = f2bf(sr); a5[(size_t)c[u] * 256 + 64] = f2bf(si);
            const float nr = a.x * sr - a.y * si + lr[u], ni = a.x * si + a.y * sr + li[u]; sr = nr; si = ni;
        }
    }
}

__device__ __forceinline__ void even_conv_item(const Params& p, int item) {
    const bf16_t* pa = (const bf16_t*)(p.ws + WS_PA); bf16_t* cb = (bf16_t*)(p.ws + WS_CB);
    const float* cw = p.in[9];
    for (int t = tid_(); t < 64 * 64; t += NTHREADS) {
        const int row = item * 64 + (t >> 6), c0 = (t & 63) * 8;
        bool hasp, hasn;
        if (row < SEQ) { hasp = (row & 63) != 0; hasn = (row & 63) != 63; } else { hasp = row != SEQ; hasn = row != R - 1; }
        float m[3][8];
#pragma unroll
        for (int d = 0; d < 3; ++d) {
            const bool ok = d == 1 || (d == 0 ? hasp : hasn);
            if (ok) {
                const bf16_t* rp = pa + (size_t)(row + d - 1) * 1536 + c0;
                float u[8], gi[8]; unpack8(*(const uint4*)rp, u); unpack8(*(const uint4*)(rp + 512), gi);
#pragma unroll
                for (int e = 0; e < 8; ++e) m[d][e] = u[e] * gi[e];
            } else {
#pragma unroll
                for (int e = 0; e < 8; ++e) m[d][e] = 0.f;
            }
        }
        float go[8], f[8]; unpack8(*(const uint4*)(pa + (size_t)row * 1536 + 1024 + c0), go);
#pragma unroll
        for (int e = 0; e < 8; ++e) f[e] = go[e] * (m[0][e] * cw[c0 + e] + m[1][e] * cw[512 + c0 + e] + m[2][e] * cw[1024 + c0 + e]);
        *(uint4*)(cb + (size_t)row * 1024 + c0) = pack8(f);
    }
}

__device__ __forceinline__ unsigned ord_enc(float v) { const unsigned u = __float_as_uint(v); return (u & 0x80000000u) ? ~u : (u | 0x80000000u); }
__device__ __forceinline__ float ord_dec(unsigned e) { const unsigned u = (e & 0x80000000u) ? (e & 0x7FFFFFFFu) : ~e; return __uint_as_float(u); }
#define TOP_INSERT(key) { unsigned x_ = (key); _Pragma("unroll") for (int k_ = 0; k_ < 16; ++k_) { const unsigned hi_ = top[k_] > x_ ? top[k_] : x_; x_ = top[k_] > x_ ? x_ : top[k_]; top[k_] = hi_; } }
__device__ __forceinline__ void peer_route_item(const Params& p, int item, int nrows, unsigned char* lds) {
    const int tid = tid_();
    const int row = item * 64 + (tid >> 3), head = tid & 7;
    unsigned* sIdx = (unsigned*)lds;
    __syncthreads();
    if (row < nrows) {
        const unsigned short* sc = (const unsigned short*)(p.ws + WS_SC) + (size_t)row * 2048 + head * 256;
        float fa[16], fb[16];
#pragma unroll
        for (int side = 0; side < 2; ++side) {
            unsigned top[16];
#pragma unroll
            for (int k = 0; k < 16; ++k) top[k] = 0u;
            for (int c = 0; c < 16; ++c) {
                const uint4 q = *(const uint4*)(sc + side * 128 + c * 8);
                const unsigned w[4] = {q.x, q.y, q.z, q.w};
#pragma unroll
                for (int e = 0; e < 8; ++e) {
                    const unsigned short hb = (unsigned short)((e & 1) ? (w[e >> 1] >> 16) : (w[e >> 1] & 0xFFFFu));
                    const float v = (float)__builtin_bit_cast(_Float16, hb);
                    TOP_INSERT((ord_enc(v) & ~0x7Fu) | (unsigned)(c * 8 + e));
                }
            }
#pragma unroll
            for (int k = 0; k < 16; ++k) {
                sIdx[(side * 16 + k) * NTHREADS + tid] = top[k] & 0x7Fu;
                const float v = ord_dec(top[k] & ~0x7Fu);
                if (side == 0) fa[k] = v; else fb[k] = v;
            }
        }
        unsigned top[16];
#pragma unroll
        for (int k = 0; k < 16; ++k) top[k] = 0u;
#pragma unroll
        for (int i = 0; i < 16; ++i) {
#pragma unroll
            for (int j = 0; j < 16; ++j) {
                if ((i + 1) * (j + 1) <= 16) { TOP_INSERT((ord_enc(fa[i] + fb[j]) & ~0xFFu) | (unsigned)(i * 16 + j)); }
            }
        }
        float ev[16]; float m = ord_dec(top[0] & ~0xFFu), sum = 0.f;
        int* idxo = (int*)(p.ws + WS_IDX) + (size_t)row * 128 + head * 16;
        float* go = (float*)(p.ws + WS_GATE) + (size_t)row * 128 + head * 16;
#pragma unroll
        for (int k = 0; k < 16; ++k) { ev[k] = __expf(ord_dec(top[k] & ~0xFFu) - m); sum += ev[k]; }
        const float inv = 1.f / sum;
#pragma unroll
        for (int k = 0; k < 16; ++k) {
            const unsigned pos = top[k] & 0xFFu;
            const unsigned ia = sIdx[(pos >> 4) * NTHREADS + tid], ib = sIdx[(16 + (pos & 15)) * NTHREADS + tid];
            idxo[k] = (int)(ia * 128u + ib); go[k] = ev[k] * inv;
        }
    }
}

__device__ __forceinline__ void peer_gather_row(const Params& p, int row, int l, bool last) {
    const int lane = tid_() & 63;
    const bf16_t* xr = (const bf16_t*)(p.ws + WS_ACT) + (size_t)row * 1024;
    const bf16_t* PU = (const bf16_t*)(p.ws + WS_PUV); const bf16_t* PV = PU + (size_t)16384 * 1024;
    float x[16], y[16];
    unpack8(*(const uint4*)(xr + lane * 8), x); unpack8(*(const uint4*)(xr + 512 + lane * 8), x + 8);
#pragma unroll
    for (int e = 0; e < 16; ++e) y[e] = 0.f;
    const int* idxp = (const int*)(p.ws + WS_IDX) + (size_t)row * 128; const float* gp = (const float*)(p.ws + WS_GATE) + (size_t)row * 128;
#pragma unroll 1
    for (int half = 0; half < 2; ++half) {
        const int myidx = idxp[half * 64 + lane]; const float mygate = gp[half * 64 + lane];
#pragma unroll 1
        for (int e0 = 0; e0 < 64; e0 += 4) {
            uint4 ur[4][2], vr[4][2]; int gt[4];
#pragma unroll
            for (int u = 0; u < 4; ++u) {
                const int id = __builtin_amdgcn_readlane(myidx, e0 + u);
                gt[u] = __builtin_amdgcn_readlane(__float_as_int(mygate), e0 + u);
                const bf16_t* up = PU + (size_t)id * 1024 + lane * 8; const bf16_t* vp = PV + (size_t)id * 1024 + lane * 8;
                ur[u][0] = *(const uint4*)up; ur[u][1] = *(const uint4*)(up + 512);
                vr[u][0] = *(const uint4*)vp; vr[u][1] = *(const uint4*)(vp + 512);
            }
#pragma unroll
            for (int u = 0; u < 4; ++u) {
                float f[16]; unpack8(ur[u][0], f); unpack8(ur[u][1], f + 8);
                float d = 0.f;
#pragma unroll
                for (int e = 0; e < 16; ++e) d += f[e] * x[e];
                d = wave_sum(d);
                const float coef = gelu_tanh(d) * __int_as_float(gt[u]);
                unpack8(vr[u][0], f); unpack8(vr[u][1], f + 8);
#pragma unroll
                for (int e = 0; e < 16; ++e) y[e] += coef * f[e];
            }
        }
    }
    float* h = (float*)(p.ws + WS_H) + (size_t)row * 1024;
    const float* m5 = modp(p, l, row, 5);
    float hv[16];
#pragma unroll
    for (int q = 0; q < 2; ++q) {
        const int c = q * 512 + lane * 8;
        const float4 h0 = *(const float4*)(h + c), h1 = *(const float4*)(h + c + 4);
        const float4 g0 = *(const float4*)(m5 + c), g1 = *(const float4*)(m5 + c + 4);
        hv[q * 8 + 0] = h0.x + g0.x * y[q * 8 + 0]; hv[q * 8 + 1] = h0.y + g0.y * y[q * 8 + 1];
        hv[q * 8 + 2] = h0.z + g0.z * y[q * 8 + 2]; hv[q * 8 + 3] = h0.w + g0.w * y[q * 8 + 3];
        hv[q * 8 + 4] = h1.x + g1.x * y[q * 8 + 4]; hv[q * 8 + 5] = h1.y + g1.y * y[q * 8 + 5];
        hv[q * 8 + 6] = h1.z + g1.z * y[q * 8 + 6]; hv[q * 8 + 7] = h1.w + g1.w * y[q * 8 + 7];
    }
    if (!last) {
#pragma unroll
        for (int q = 0; q < 2; ++q) {
            const int c = q * 512 + lane * 8;
            *(float4*)(h + c) = make_float4(hv[q * 8 + 0], hv[q * 8 + 1], hv[q * 8 + 2], hv[q * 8 + 3]);
            *(float4*)(h + c + 4) = make_float4(hv[q * 8 + 4], hv[q * 8 + 5], hv[q * 8 + 6], hv[q * 8 + 7]);
        }
    } else {
        float ss = 0.f;
#pragma unroll
        for (int e = 0; e < 16; ++e) ss += hv[e] * hv[e];
        ss = wave_sum(ss);
        const float rs = rsqrtf(ss * (1.f / 1024.f) + 1e-6f);
        const float* fg = p.in[31]; float* o = p.out + (size_t)row * 1024;
#pragma unroll
        for (int q = 0; q < 2; ++q) {
            const int c = q * 512 + lane * 8;
            const float4 g0 = *(const float4*)(fg + c), g1 = *(const float4*)(fg + c + 4);
            *(float4*)(o + c) = make_float4(hv[q * 8 + 0] * rs * g0.x, hv[q * 8 + 1] * rs * g0.y, hv[q * 8 + 2] * rs * g0.z, hv[q * 8 + 3] * rs * g0.w);
            *(float4*)(o + c + 4) = make_float4(hv[q * 8 + 4] * rs * g1.x, hv[q * 8 + 5] * rs * g1.y, hv[q * 8 + 6] * rs * g1.z, hv[q * 8 + 7] * rs * g1.w);
        }
    }
}

__device__ __forceinline__ void gdn_prep_item(const Params& p, int item) {
    const int lane = tid_() & 63, wave = tid_() >> 6;
    const bf16_t* qkvr = (const bf16_t*)(p.ws + WS_QKVR);
    const float* cw = p.in[22];
    for (int it = 0; it < 8; ++it) {
        const int row = item * 64 + it * 8 + wave;
        bool hasp, hasn;
        if (row < SEQ) { hasp = (row & 63) != 0; hasn = (row & 63) != 63; } else { hasp = row != SEQ; hasn = row != R - 1; }
#pragma unroll 1
        for (int ph = 0; ph < 6; ++ph) {
            const int part = ph >> 1, head = (ph & 1) * 4 + (lane >> 4), d0 = (lane & 15) * 8;
            const int ch = part * 1024 + head * 128 + d0;
            float xm[8], x0[8], xp[8], f[8];
            unpack8(*(const uint4*)(qkvr + (size_t)row * 3072 + ch), x0);
            if (hasp) unpack8(*(const uint4*)(qkvr + (size_t)(row - 1) * 3072 + ch), xm);
            if (hasn) unpack8(*(const uint4*)(qkvr + (size_t)(row + 1) * 3072 + ch), xp);
            float ss = 0.f;
#pragma unroll
            for (int e = 0; e < 8; ++e) {
                float a = x0[e] * cw[3072 + ch + e];
                if (hasp) a += xm[e] * cw[ch + e];
                if (hasn) a += xp[e] * cw[6144 + ch + e];
                a = siluf_(a); f[e] = a; ss += a * a;
            }
            if (part < 2) {
                ss += __shfl_xor(ss, 1, 64); ss += __shfl_xor(ss, 2, 64); ss += __shfl_xor(ss, 4, 64); ss += __shfl_xor(ss, 8, 64);
                const float sc = rsqrtf(ss + 1e-6f) * (part == 0 ? 0.08838834764831845f : 1.f);
#pragma unroll
                for (int e = 0; e < 8; ++e) f[e] *= sc;
            }
            bf16_t* dst = (bf16_t*)(p.ws + (part == 0 ? WS_QN : part == 1 ? WS_KN : WS_VN)) + (size_t)row * 1024 + head * 128 + d0;
            *(uint4*)dst = pack8(f);
        }
        if (lane < 16) {
            const float* ab = (const float*)(p.ws + WS_AB) + (size_t)row * 32;
            const float a = ab[lane] + p.in[24][lane], b = ab[16 + lane];
            const float sp = a > 20.f ? a : log1pf(__expf(a));
            ((float*)(p.ws + WS_GG))[(size_t)lane * R + row] = -__expf(p.in[23][lane]) * sp;
            ((float*)(p.ws + WS_BETA))[(size_t)lane * R + row] = sigmoidf_(b);
        }
    }
}

constexpr int GU_LDQ = 136, GU_LDT = 72, GU_LDA = 68;
constexpr int GU_SQ = 0, GU_SK = 17408, GU_SKB = 34816, GU_SVBT = 52224, GU_SKGT = 70656, GU_SA = 89088, GU_SAT = 106496, GU_ST = 123904, GU_SG = 133120;
__device__ __forceinline__ int perm_slot64(int pos) { return 32 * (pos >> 5) + 8 * ((pos >> 2) & 3) + 4 * ((pos >> 4) & 1) + (pos & 3); }
__device__ __forceinline__ void gdn_unit(const Params& p, int u, unsigned char* lds) {
    const int tid = tid_(), lane = tid & 63, wave = tid >> 6;
    const int dh = u / NCH, c = u % NCH, dir = dh >> 3, head = dh & 7;
    bf16_t* sQ = (bf16_t*)(lds + GU_SQ); bf16_t* sK = (bf16_t*)(lds + GU_SK); bf16_t* sKB = (bf16_t*)(lds + GU_SKB);
    bf16_t* sVBT = (bf16_t*)(lds + GU_SVBT); bf16_t* sKGT = (bf16_t*)(lds + GU_SKGT);
    float* sA = (float*)(lds + GU_SA); float* sAT = (float*)(lds + GU_SAT); bf16_t* sT = (bf16_t*)(lds + GU_ST);
    float* sG = (float*)(lds + GU_SG); float* sBeta = sG + 64;
    __syncthreads();
    if (wave == 0) {
        const int row = c * 64 + (dir ? 63 - lane : lane);
        float g = ((const float*)(p.ws + WS_GG))[(size_t)dh * R + row];
#pragma unroll
        for (int o = 1; o < 64; o <<= 1) { const float t = __shfl_up(g, o, 64); if (lane >= o) g += t; }
        sG[lane] = g; sBeta[lane] = ((const float*)(p.ws + WS_BETA))[(size_t)dh * R + row];
        ((float*)(p.ws + WS_GC))[(size_t)u * 64 + lane] = g;
    }
    __syncthreads();
    for (int t = tid; t < 1024; t += NTHREADS) {
        const int i = t >> 4, d8 = (t & 15) * 8;
        const size_t ro = (size_t)(c * 64 + (dir ? 63 - i : i)) * 1024 + head * 128 + d8;
        const uint4 q = *(const uint4*)((const bf16_t*)(p.ws + WS_QN) + ro);
        const uint4 k = *(const uint4*)((const bf16_t*)(p.ws + WS_KN) + ro);
        const uint4 v = *(const uint4*)((const bf16_t*)(p.ws + WS_VN) + ro);
        const float beta = sBeta[i], eg = __expf(sG[i]);
        float kf[8], vf[8], kb[8];
        unpack8(k, kf); unpack8(v, vf);
#pragma unroll
        for (int e = 0; e < 8; ++e) kb[e] = kf[e] * beta;
        *(uint4*)(sQ + i * GU_LDQ + d8) = q; *(uint4*)(sK + i * GU_LDQ + d8) = k; *(uint4*)(sKB + i * GU_LDQ + d8) = pack8(kb);
#pragma unroll
        for (int e = 0; e < 8; ++e) { sVBT[(d8 + e) * GU_LDT + i] = f2bf(vf[e] * beta); sKGT[(d8 + e) * GU_LDT + i] = f2bf(kb[e] * eg); }
    }
    __syncthreads();
    {
        const int mat = wave >> 2, mt = wave & 3, rr = lane & 15, q4 = lane >> 4;
        const bf16_t* sX = mat ? sQ : sKB;
        f32x4 acc[4];
#pragma unroll
        for (int nt = 0; nt < 4; ++nt) acc[nt] = (f32x4){0.f, 0.f, 0.f, 0.f};
#pragma unroll
        for (int kk = 0; kk < 4; ++kk) {
            const bf16x8 a = *(const bf16x8*)(sX + (16 * mt + rr) * GU_LDQ + kk * 32 + 8 * q4);
#pragma unroll
            for (int nt = 0; nt < 4; ++nt) {
                const bf16x8 b = *(const bf16x8*)(sK + (16 * nt + rr) * GU_LDQ + kk * 32 + 8 * q4);
                acc[nt] = __builtin_amdgcn_mfma_f32_16x16x32_bf16(a, b, acc[nt], 0, 0, 0);
            }
        }
        float* dstm = mat ? sAT : sA;
#pragma unroll
        for (int nt = 0; nt < 4; ++nt) {
            const int j = 16 * nt + rr; const float gj = sG[j];
#pragma unroll
            for (int jj = 0; jj < 4; ++jj) {
                const int i = 16 * mt + 4 * q4 + jj;
                const bool keep = mat ? (j <= i) : (j < i);
                dstm[i * GU_LDA + j] = keep ? acc[nt][jj] * __expf(sG[i] - gj) : 0.f;
            }
        }
    }
    __syncthreads();
    if (wave == 0) {
        float* Tf = (float*)(lds + GU_SQ);
#pragma unroll 1
        for (int i = 0; i < 64; ++i) {
            float a0 = (i == lane) ? 1.f : 0.f, a1 = 0.f, a2 = 0.f, a3 = 0.f;
            const float* Ai = sA + i * GU_LDA;
            int j = 0;
#pragma unroll 1
            for (; j + 4 <= i; j += 4) {
                const float4 av = *(const float4*)(Ai + j);
                a0 -= av.x * Tf[(j + 0) * 64 + lane]; a1 -= av.y * Tf[(j + 1) * 64 + lane];
                a2 -= av.z * Tf[(j + 2) * 64 + lane]; a3 -= av.w * Tf[(j + 3) * 64 + lane];
            }
#pragma unroll 1
            for (; j < i; ++j) a0 -= Ai[j] * Tf[j * 64 + lane];
            const float a = (a0 + a1) + (a2 + a3);
            Tf[i * 64 + lane] = a;
            sT[i * GU_LDT + lane] = f2bf(a);
        }
    } else {
        bf16_t* att = (bf16_t*)(p.ws + WS_ATT) + (size_t)u * 64 * 64;
        for (int t = tid - 64; t < 512; t += NTHREADS - 64) {
            const int i = t >> 3, kk2 = (t >> 2) & 1, qq = t & 3;
            const float4 lo = *(const float4*)(sAT + i * GU_LDA + 32 * kk2 + 4 * qq), hi = *(const float4*)(sAT + i * GU_LDA + 32 * kk2 + 16 + 4 * qq);
            uint4 o; o.x = pack2(lo.x, lo.y); o.y = pack2(lo.z, lo.w); o.z = pack2(hi.x, hi.y); o.w = pack2(hi.z, hi.w);
            *(uint4*)(att + i * 64 + 32 * kk2 + 8 * qq) = o;
        }
    }
    __syncthreads();
    {
        const int rr = lane & 15, q4 = lane >> 4;
        bf16_t* ut = (bf16_t*)(p.ws + WS_UT) + (size_t)u * 128 * 64;
        bf16_t* wg = (bf16_t*)(p.ws + WS_W) + (size_t)u * 64 * 128;
        f32x4 au[4], aw[4];
#pragma unroll
        for (int m = 0; m < 4; ++m) { au[m] = (f32x4){0.f, 0.f, 0.f, 0.f}; aw[m] = (f32x4){0.f, 0.f, 0.f, 0.f}; }
#pragma unroll
        for (int kk2 = 0; kk2 < 2; ++kk2) {
            const bf16x8 bv = *(const bf16x8*)(sVBT + (16 * wave + rr) * GU_LDT + kk2 * 32 + 8 * q4);
            const bf16x8 ak = *(const bf16x8*)(sKGT + (16 * wave + rr) * GU_LDT + kk2 * 32 + 8 * q4);
#pragma unroll
            for (int m = 0; m < 4; ++m) {
                const bf16x8 tf = *(const bf16x8*)(sT + (16 * m + rr) * GU_LDT + kk2 * 32 + 8 * q4);
                au[m] = __builtin_amdgcn_mfma_f32_16x16x32_bf16(tf, bv, au[m], 0, 0, 0);
                aw[m] = __builtin_amdgcn_mfma_f32_16x16x32_bf16(ak, tf, aw[m], 0, 0, 0);
            }
        }
#pragma unroll
        for (int m = 0; m < 4; ++m) {
            uint2 o; o.x = pack2(au[m][0], au[m][1]); o.y = pack2(au[m][2], au[m][3]);
            *(uint2*)(ut + (size_t)(16 * wave + rr) * 64 + 16 * m + 4 * q4) = o;
            uint2 w2; w2.x = pack2(aw[m][0], aw[m][1]); w2.y = pack2(aw[m][2], aw[m][3]);
            *(uint2*)(wg + (size_t)(16 * m + rr) * 128 + 32 * (wave >> 1) + 8 * q4 + 4 * (wave & 1)) = w2;
        }
    }
}

constexpr int GS_SW = 0, GS_SQD = 17408, GS_SKDT = 34816, GS_SATT = 53248, GS_BUF = 62464;
typedef unsigned u32x2 __attribute__((ext_vector_type(2)));
__device__ __forceinline__ int gdn_chain_chunk(int dir, int s) { return dir == 0 ? (s < 4 ? NCH_LAT + s : s - 4) : NCH - 1 - s; }
struct GsG1 { u32x4 w[2]; u32x4 att; };
struct GsG2 { u32x2 qlo[2], qhi[2]; float gq[2]; };
struct GsG3 { u32x4 kd[2]; float gk[2]; float gl; u32x2 ut[4]; };
__device__ __forceinline__ void gs_load1(const Params& p, int dh, int c, GsG1& st) {
    const int tid = tid_(); const size_t u = (size_t)dh * NCH + c;
    const bf16_t* wg = (const bf16_t*)(p.ws + WS_W) + u * 64 * 128; const bf16_t* att = (const bf16_t*)(p.ws + WS_ATT) + u * 64 * 64;
#pragma unroll
    for (int q = 0; q < 2; ++q) { const int t = tid + q * NTHREADS; st.w[q] = *(const u32x4*)(wg + (size_t)(t >> 4) * 128 + (t & 15) * 8); }
    st.att = *(const u32x4*)(att + (size_t)(tid >> 3) * 64 + (tid & 7) * 8);
}
__device__ __forceinline__ void gs_store1(const GsG1& st, unsigned char* buf) {
    const int tid = tid_(); bf16_t* sW = (bf16_t*)(buf + GS_SW); bf16_t* sATT = (bf16_t*)(buf + GS_SATT);
#pragma unroll
    for (int q = 0; q < 2; ++q) { const int t = tid + q * NTHREADS; *(u32x4*)(sW + (t >> 4) * GU_LDQ + (t & 15) * 8) = st.w[q]; }
    *(u32x4*)(sATT + (tid >> 3) * GU_LDT + (tid & 7) * 8) = st.att;
}
__device__ __forceinline__ void gs_load2(const Params& p, int dh, int c, GsG2& st) {
    const int tid = tid_(), dir = dh >> 3, head = dh & 7; const size_t u = (size_t)dh * NCH + c;
    const float* gc = (const float*)(p.ws + WS_GC) + u * 64; const bf16_t* qn = (const bf16_t*)(p.ws + WS_QN);
#pragma unroll
    for (int q = 0; q < 2; ++q) {
        const int t = tid + q * NTHREADS, i = t >> 4, kk = (t >> 2) & 3, qq = t & 3;
        const bf16_t* src = qn + (size_t)(c * 64 + (dir ? 63 - i : i)) * 1024 + head * 128 + 32 * kk + 4 * qq;
        st.qlo[q] = *(const u32x2*)src; st.qhi[q] = *(const u32x2*)(src + 16); st.gq[q] = gc[i];
    }
}
__device__ __forceinline__ void gs_store2(const GsG2& st, unsigned char* buf) {
    const int tid = tid_(); bf16_t* sQD = (bf16_t*)(buf + GS_SQD);
#pragma unroll
    for (int q = 0; q < 2; ++q) {
        const int t = tid + q * NTHREADS, i = t >> 4, kk = (t >> 2) & 3, qq = t & 3; const float e = __expf(st.gq[q]);
        u32x4 o; o.x = pack2(lo2f(st.qlo[q].x) * e, hi2f(st.qlo[q].x) * e); o.y = pack2(lo2f(st.qlo[q].y) * e, hi2f(st.qlo[q].y) * e);
        o.z = pack2(lo2f(st.qhi[q].x) * e, hi2f(st.qhi[q].x) * e); o.w = pack2(lo2f(st.qhi[q].y) * e, hi2f(st.qhi[q].y) * e);
        *(u32x4*)(sQD + i * GU_LDQ + 32 * kk + 8 * qq) = o;
    }
}
__device__ __forceinline__ void gs_load3(const Params& p, int dh, int c, GsG3& st) {
    const int tid = tid_(), lane = tid & 63, wave = tid >> 6, dir = dh >> 3, head = dh & 7; const size_t u = (size_t)dh * NCH + c;
    const float* gc = (const float*)(p.ws + WS_GC) + u * 64; const bf16_t* kn = (const bf16_t*)(p.ws + WS_KN);
    st.gl = gc[63];
#pragma unroll
    for (int q = 0; q < 2; ++q) {
        const int t = tid + q * NTHREADS, pos = t >> 4, d8 = (t & 15) * 8;
        st.kd[q] = *(const u32x4*)(kn + (size_t)(c * 64 + (dir ? 63 - pos : pos)) * 1024 + head * 128 + d8); st.gk[q] = gc[pos];
    }
    const bf16_t* ut = (const bf16_t*)(p.ws + WS_UT) + u * 128 * 64 + (size_t)(16 * wave + (lane & 15)) * 64 + 4 * (lane >> 4);
#pragma unroll
    for (int m = 0; m < 4; ++m) st.ut[m] = *(const u32x2*)(ut + 16 * m);
}
__device__ __forceinline__ void gs_store3(const GsG3& st, unsigned char* buf) {
    const int tid = tid_(); bf16_t* sKDT = (bf16_t*)(buf + GS_SKDT);
#pragma unroll
    for (int q = 0; q < 2; ++q) {
        const int t = tid + q * NTHREADS, pos = t >> 4, d8 = (t & 15) * 8; const float e = __expf(st.gl - st.gk[q]);
        const u32x4 kq = st.kd[q]; const int sl = perm_slot64(pos);
        sKDT[(d8 + 0) * GU_LDT + sl] = f2bf(lo2f(kq.x) * e); sKDT[(d8 + 1) * GU_LDT + sl] = f2bf(hi2f(kq.x) * e);
        sKDT[(d8 + 2) * GU_LDT + sl] = f2bf(lo2f(kq.y) * e); sKDT[(d8 + 3) * GU_LDT + sl] = f2bf(hi2f(kq.y) * e);
        sKDT[(d8 + 4) * GU_LDT + sl] = f2bf(lo2f(kq.z) * e); sKDT[(d8 + 5) * GU_LDT + sl] = f2bf(hi2f(kq.z) * e);
        sKDT[(d8 + 6) * GU_LDT + sl] = f2bf(lo2f(kq.w) * e); sKDT[(d8 + 7) * GU_LDT + sl] = f2bf(hi2f(kq.w) * e);
    }
}
__device__ __forceinline__ void gdn_seq(const Params& p, int dh, unsigned char* lds) {
    const int tid = tid_(), lane = tid & 63, wave = tid >> 6, rr = lane & 15, q4 = lane >> 4, dir = dh >> 3, head = dh & 7;
    f32x4 Sc[8]; bf16x8 Sb[4];
#pragma unroll
    for (int m = 0; m < 8; ++m) Sc[m] = (f32x4){0.f, 0.f, 0.f, 0.f};
#pragma unroll
    for (int k = 0; k < 4; ++k) Sb[k] = (bf16x8){0, 0, 0, 0, 0, 0, 0, 0};
    u32x2 ucur[4]; float glcur;
    __syncthreads();
    {
        const int c0 = gdn_chain_chunk(dir, 0);
        GsG1 g1; gs_load1(p, dh, c0, g1); gs_store1(g1, lds);
        GsG2 g2; gs_load2(p, dh, c0, g2); gs_store2(g2, lds);
        GsG3 g3; gs_load3(p, dh, c0, g3); gs_store3(g3, lds);
#pragma unroll
        for (int m = 0; m < 4; ++m) ucur[m] = g3.ut[m];
        glcur = g3.gl;
    }
    __syncthreads();
    bf16_t* of = (bf16_t*)(p.ws + WS_OF) + (size_t)dir * SEQ * 1024;
#pragma unroll 1
    for (int s = 0; s < NCH; ++s) {
        const int c = gdn_chain_chunk(dir, s);
        const bool more = s + 1 < NCH;
        const int cn = gdn_chain_chunk(dir, more ? s + 1 : s);
        const unsigned char* buf = lds + (s & 1) * GS_BUF; unsigned char* nbuf = lds + ((s + 1) & 1) * GS_BUF;
        const bf16_t* sW = (const bf16_t*)(buf + GS_SW); const bf16_t* sQD = (const bf16_t*)(buf + GS_SQD);
        const bf16_t* sKDT = (const bf16_t*)(buf + GS_SKDT); const bf16_t* sATT = (const bf16_t*)(buf + GS_SATT);
        GsG1 g1; gs_load1(p, dh, cn, g1);
        f32x4 vn[4];
#pragma unroll
        for (int m = 0; m < 4; ++m) {
            f32x4 acc = (f32x4){0.f, 0.f, 0.f, 0.f};
#pragma unroll
            for (int kk = 0; kk < 4; ++kk)
                acc = __builtin_amdgcn_mfma_f32_16x16x32_bf16(*(const bf16x8*)(sW + (16 * m + rr) * GU_LDQ + kk * 32 + 8 * q4), Sb[kk], acc, 0, 0, 0);
            vn[m][0] = lo2f(ucur[m].x) - acc[0]; vn[m][1] = hi2f(ucur[m].x) - acc[1]; vn[m][2] = lo2f(ucur[m].y) - acc[2]; vn[m][3] = hi2f(ucur[m].y) - acc[3];
        }
        bf16x8 VB[2];
#pragma unroll
        for (int k2 = 0; k2 < 2; ++k2) {
            const unsigned a0 = pack2(vn[2 * k2][0], vn[2 * k2][1]), a1 = pack2(vn[2 * k2][2], vn[2 * k2][3]);
            const unsigned a2 = pack2(vn[2 * k2 + 1][0], vn[2 * k2 + 1][1]), a3 = pack2(vn[2 * k2 + 1][2], vn[2 * k2 + 1][3]);
            const u32x4 pk = {a0, a1, a2, a3}; VB[k2] = __builtin_bit_cast(bf16x8, pk);
        }
        gs_store1(g1, nbuf);
        GsG2 g2; gs_load2(p, dh, cn, g2);
        if (c < NCH_LAT) {
#pragma unroll
            for (int m = 0; m < 4; ++m) {
                f32x4 acc = (f32x4){0.f, 0.f, 0.f, 0.f};
#pragma unroll
                for (int kk = 0; kk < 4; ++kk)
                    acc = __builtin_amdgcn_mfma_f32_16x16x32_bf16(*(const bf16x8*)(sQD + (16 * m + rr) * GU_LDQ + kk * 32 + 8 * q4), Sb[kk], acc, 0, 0, 0);
#pragma unroll
                for (int k2 = 0; k2 < 2; ++k2)
                    acc = __builtin_amdgcn_mfma_f32_16x16x32_bf16(*(const bf16x8*)(sATT + (16 * m + rr) * GU_LDT + k2 * 32 + 8 * q4), VB[k2], acc, 0, 0, 0);
#pragma unroll
                for (int jj = 0; jj < 4; ++jj) {
                    const int pos = 16 * m + 4 * q4 + jj;
                    of[(size_t)(c * 64 + (dir ? 63 - pos : pos)) * 1024 + head * 128 + 16 * wave + rr] = f2bf(acc[jj]);
                }
            }
        }
        gs_store2(g2, nbuf);
        GsG3 g3; gs_load3(p, dh, cn, g3);
        const float egl = __expf(glcur);
#pragma unroll
        for (int m = 0; m < 8; ++m) {
            f32x4 acc = Sc[m] * egl;
#pragma unroll
            for (int k2 = 0; k2 < 2; ++k2)
                acc = __builtin_amdgcn_mfma_f32_16x16x32_bf16(*(const bf16x8*)(sKDT + (16 * m + rr) * GU_LDT + k2 * 32 + 8 * q4), VB[k2], acc, 0, 0, 0);
            Sc[m] = acc;
        }
#pragma unroll
        for (int kk = 0; kk < 4; ++kk) {
            const u32x4 pk = {pack2(Sc[2 * kk][0], Sc[2 * kk][1]), pack2(Sc[2 * kk][2], Sc[2 * kk][3]),
                              pack2(Sc[2 * kk + 1][0], Sc[2 * kk + 1][1]), pack2(Sc[2 * kk + 1][2], Sc[2 * kk + 1][3])};
            Sb[kk] = __builtin_bit_cast(bf16x8, pk);
        }
        gs_store3(g3, nbuf);
#pragma unroll
        for (int m = 0; m < 4; ++m) ucur[m] = g3.ut[m];
        glcur = g3.gl;
        __syncthreads();
    }
}

__device__ __forceinline__ void gdn_readout_row(const Params& p, int row) {
    const int lane = tid_() & 63, head = lane >> 3, d0 = (lane & 7) * 16;
    const bf16_t* of0 = (const bf16_t*)(p.ws + WS_OF) + (size_t)row * 1024 + head * 128 + d0;
    const bf16_t* of1 = of0 + (size_t)SEQ * 1024;
    const bf16_t* zp = (const bf16_t*)(p.ws + WS_Z) + (size_t)row * 1024 + head * 128 + d0;
    float a[16], b[16], z[16];
    unpack8(*(const uint4*)of0, a); unpack8(*(const uint4*)(of0 + 8), a + 8);
    unpack8(*(const uint4*)of1, b); unpack8(*(const uint4*)(of1 + 8), b + 8);
    unpack8(*(const uint4*)zp, z); unpack8(*(const uint4*)(zp + 8), z + 8);
    float ss = 0.f;
#pragma unroll
    for (int e = 0; e < 16; ++e) { a[e] += b[e]; ss += a[e] * a[e]; }
    ss += __shfl_xor(ss, 1, 64); ss += __shfl_xor(ss, 2, 64); ss += __shfl_xor(ss, 4, 64);
    const float rs = rsqrtf(ss * (1.f / 128.f) + 1e-6f);
    const float* ng = p.in[25] + d0;
    float f[16];
#pragma unroll
    for (int e = 0; e < 16; ++e) f[e] = a[e] * rs * ng[e] * siluf_(z[e]);
    bf16_t* dst = (bf16_t*)(p.ws + WS_VN) + (size_t)row * 1024 + head * 128 + d0;
    *(uint4*)dst = pack8(f); *(uint4*)(dst + 8) = pack8(f + 8);
}

#define XB_TMO      128
#define XB_XCNT(j)  (256  + 64 * (j))
#define XB_XSUB(j)  (1280 + 64 * (j))
#define XB_XGEN(j)  (2304 + 64 * (j))
#define XB_TOP      3328
#define XB_TOPGEN   3392
#define XCD_BAR_WORDS 3456
#define XB_SPIN_CAP (1u << 22)
#define LAS __attribute__((address_space(3)))
__device__ __forceinline__ unsigned xb_ld(unsigned* p)              { return __hip_atomic_load(p, __ATOMIC_RELAXED, __HIP_MEMORY_SCOPE_AGENT); }
__device__ __forceinline__ unsigned xb_add(unsigned* p, unsigned v) { return __hip_atomic_fetch_add(p, v, __ATOMIC_RELAXED, __HIP_MEMORY_SCOPE_AGENT); }
__device__ __forceinline__ unsigned xb_xcc_id() { return (unsigned)__builtin_amdgcn_s_getreg((3 << 11) | 20) & 0xFu; }
#define XB_SPIN(cond, bar) do { unsigned _sp = 0; while (cond) { __builtin_amdgcn_s_sleep(1); \
    if ((++_sp & 255u) == 0u) { if (xb_ld(&(bar)[XB_TMO])) break; if (_sp > XB_SPIN_CAP) { atomicAdd(&(bar)[XB_TMO], 1u); break; } } } } while (0)
struct XcdBarrier { unsigned* bar; unsigned x; volatile LAS unsigned* st; };
__device__ __forceinline__ XcdBarrier xcd_barrier_post(unsigned* bar, volatile LAS unsigned* st) {
    XcdBarrier b; b.bar = bar; b.x = xb_xcc_id(); b.st = st;
    if (threadIdx.x == 0) (void)xb_add(&bar[XB_XCNT(b.x)], 1u);
    return b;
}
__device__ __forceinline__ void xcd_barrier_complete(unsigned* bar, unsigned x, unsigned& nloc, unsigned& nx) {
    const unsigned G = gridDim.x * gridDim.y * gridDim.z;
    unsigned sum, cnt, mine, sp = 0u;
    for (;;) {
        sum = 0u; cnt = 0u; mine = 0u;
#pragma unroll
        for (unsigned j = 0; j < 16; ++j) { const unsigned c = xb_ld(&bar[XB_XCNT(j)]); sum += c; cnt += (c > 0u) ? 1u : 0u; mine = (j == x) ? c : mine; }
        if (sum == G) break;
        __builtin_amdgcn_s_sleep(1);
        if ((++sp & 255u) == 0u) { if (xb_ld(&bar[XB_TMO])) break; if (sp > XB_SPIN_CAP) { atomicAdd(&bar[XB_TMO], 1u); break; } }
    }
    nloc = mine > 0u ? mine : 1u; nx = cnt > 0u ? cnt : 1u;
}
__device__ __forceinline__ void xcd_barrier(const XcdBarrier& b) {
    asm volatile("s_waitcnt vmcnt(0)" ::: "memory");
    __syncthreads();
    if (threadIdx.x == 0) {
        unsigned* bar = b.bar;
        __builtin_amdgcn_s_waitcnt(0);
        unsigned nloc = b.st[0], nx = b.st[1];
        if (nloc == 0u) { xcd_barrier_complete(bar, b.x, nloc, nx); b.st[0] = nloc; b.st[1] = nx; }
        const unsigned old = xb_add(&bar[XB_XSUB(b.x)], 1u);
        const unsigned gen = old / nloc;
        if (old + 1u == (gen + 1u) * nloc) {
            __builtin_amdgcn_fence(__ATOMIC_RELEASE, "agent");
            asm volatile("s_waitcnt vmcnt(0)" ::: "memory");
            const unsigned og = xb_add(&bar[XB_TOP], 1u);
            const unsigned tg = og / nx;
            if (og + 1u == (tg + 1u) * nx) xb_add(&bar[XB_TOPGEN], 1u);
            else XB_SPIN(xb_ld(&bar[XB_TOPGEN]) == tg, bar);
            __builtin_amdgcn_fence(__ATOMIC_ACQUIRE, "agent");
            xb_add(&bar[XB_XGEN(b.x)], 1u);
            asm volatile("s_waitcnt vmcnt(0)" ::: "memory");
        } else {
            XB_SPIN(xb_ld(&bar[XB_XGEN(b.x)]) == gen, bar);
            __builtin_amdgcn_fence(__ATOMIC_ACQUIRE, "agent");
            asm volatile("s_waitcnt vmcnt(0)" ::: "memory");
        }
    }
    __syncthreads();
}

#ifndef PHMASK
#define PHMASK 0xFFFFFFFFull
#endif
#define PH(n) (((PHMASK) >> (n)) & 1ull)
#define FOR_ITEMS(n) for (int item = blockIdx.x; item < (n); item += gridDim.x)
__global__ void __launch_bounds__(NTHREADS) fwd_megakernel(Params p) {
    extern __shared__ __attribute__((aligned(16))) unsigned char lds[];
    cg::grid_group grid = cg::this_grid();
    unsigned char* ws = p.ws;
    volatile LAS unsigned* xbst = (volatile LAS unsigned*)(LAS unsigned char*)(lds + LDS_BYTES - 16);
    if (threadIdx.x == 0) { xbst[0] = 0u; xbst[1] = 0u; }
    __syncthreads();
    const XcdBarrier xbar = xcd_barrier_post((unsigned*)(ws + WS_BAR), xbst);

    if (PH(0)) {
        constexpr int N_S5 = 64, N_ADA = 192, N_T0 = 512, N_T1 = 64, N_T2 = 256, N_T3 = 16 * 65, N_T4 = 256, N_T5 = 512, N_T6 = 512, N_SK = 16, N_PT = 8192;
        constexpr int O1 = N_S5, O2 = O1 + N_ADA, O3 = O2 + N_T0, O4 = O3 + N_T1, O5 = O4 + N_T2, O6 = O5 + N_T3, O7 = O6 + N_T4, O8 = O7 + N_T5, O9 = O8 + N_T6, O10 = O9 + N_SK, O11 = O10 + N_PT;
        FOR_ITEMS(O11) {
            if (item < O1) p0_s5_tables(p, item, lds);
            else if (item < O2) p0_adaln(p, item - O1, lds);
            else if (item < O3) p0_transpose(p.in[8], 1024, 2048, (bf16_t*)(ws + WS_WEIN), item - O2, lds);
            else if (item < O4) p0_transpose(p.in[18], 512, 512, (bf16_t*)(ws + WS_WGLU), item - O3, lds);
            else if (item < O5) p0_transpose(p.in[20], 1024, 1024, (bf16_t*)(ws + WS_WEOUT), item - O4, lds);
            else if (item < O6) p0_transpose(p.in[21], 1024, ODD_IN, (bf16_t*)(ws + WS_WOIN), item - O5, lds);
            else if (item < O7) p0_transpose(p.in[26], 1024, 1024, (bf16_t*)(ws + WS_WOOUT), item - O6, lds);
            else if (item < O8) p0_transpose(p.in[27], 1024, 2048, (bf16_t*)(ws + WS_WQ0), item - O7, lds);
            else if (item < O9) p0_transpose(p.in[27] + (size_t)1024 * 2048, 1024, 2048, (bf16_t*)(ws + WS_WQ1), item - O8, lds);
            else if (item < O10) cvt_chunk(p.in[28], (bf16_t*)(ws + WS_SK), item - O9);
            else { const int q = item - O10; cvt_chunk(q < 4096 ? p.in[29] : p.in[30], (bf16_t*)(ws + WS_PUV) + (q < 4096 ? 0 : (size_t)16384 * 1024), q & 4095); }
        }
    }
    grid.sync();
    if (PH(1)) FOR_ITEMS(2080 + 2048) {
        if (item < 2080) norm_rows_item(p, item, 0, p.in[6], 0, true);
        else s5_mintra_item(p, item - 2080);
    }
    xcd_barrier(xbar);
    if (PH(2)) FOR_ITEMS(130 * 16) {
        EpiEvenIn e{(bf16_t*)(ws + WS_PA), (bf16_t*)(ws + WS_UG)};
        gemm_tile((const bf16_t*)(ws + WS_ACT), 1024, R, (const bf16_t*)(ws + WS_WEIN), 1024, 2048, 1024, (item >> 4) * 128, (item & 15) * 128, e, lds);
    }
    xcd_barrier(xbar);
    if (PH(3)) FOR_ITEMS(32 * 30) {
        const int g = item / 30, r = item % 30, tm = r / 10, tn = r % 10;
        EpiS5Local e{(float*)(ws + WS_YL), (float*)(ws + WS_LST), g};
        gemm_tile((const bf16_t*)(ws + WS_UG) + (size_t)g * NCH * 1024, 1024, NCH, (const bf16_t*)(ws + WS_MS5) + (size_t)g * 1280 * 1024, 1024, 1280, 1024, tm * 128, tn * 128, e, lds);
    }
    xcd_barrier(xbar);
    if (PH(4)) s5_scan(p);
    xcd_barrier(xbar);
    if (PH(5)) FOR_ITEMS(32 * 24) {
        const int g = item / 24, r = item % 24, tm = r / 8, tn = r % 8;
        EpiS5Out e{(const float*)(ws + WS_YL), (bf16_t*)(ws + WS_GS), g};
        gemm_tile((const bf16_t*)(ws + WS_A5) + (size_t)g * NCH * 256, 256, NCH, (const bf16_t*)(ws + WS_O5) + (size_t)g * 1024 * 256, 256, 1024, 256, tm * 128, tn * 128, e, lds);
    }
    xcd_barrier(xbar);
    if (PH(6)) FOR_ITEMS(130 * 4 + NCH) {
        if (item < 520) {
            EpiGlu e{(const bf16_t*)(ws + WS_GS), p.in[19], (bf16_t*)(ws + WS_CB)};
            gemm_tile((const bf16_t*)(ws + WS_GS), 512, R, (const bf16_t*)(ws + WS_WGLU), 512, 512, 512, (item >> 2) * 128, (item & 3) * 128, e, lds);
        } else even_conv_item(p, item - 520);
    }
    xcd_barrier(xbar);
    if (PH(7)) FOR_ITEMS(130 * 8) {
        EpiResid e{p.in[0], p.in[2], (float*)(ws + WS_H), (const float*)(ws + WS_MOD), 0, true};
        gemm_tile((const bf16_t*)(ws + WS_CB), 1024, R, (const bf16_t*)(ws + WS_WEOUT), 1024, 1024, 1024, (item >> 3) * 128, (item & 7) * 128, e, lds);
    }
    xcd_barrier(xbar);
#pragma unroll 1
    for (int l = 0; l < 2; ++l) {
        const int nrows = l == 0 ? R : SEQ, ntm = nrows / 128;
        if (l == 1) {
            if (PH(13)) FOR_ITEMS(2080) norm_rows_item(p, item, 1, p.in[6] + 1024, 0, false);
            xcd_barrier(xbar);
            if (PH(14)) FOR_ITEMS(130 * 33) {
                EpiOddIn e{(bf16_t*)(ws + WS_QKVR), (bf16_t*)(ws + WS_Z), (float*)(ws + WS_AB)};
                gemm_tile((const bf16_t*)(ws + WS_ACT), 1024, R, (const bf16_t*)(ws + WS_WOIN), 1024, ODD_IN, 1024, (item / 33) * 128, (item % 33) * 128, e, lds);
            }
            xcd_barrier(xbar);
            if (PH(15)) FOR_ITEMS(NCH) gdn_prep_item(p, item);
            xcd_barrier(xbar);
            if (PH(16)) FOR_ITEMS(NUNITS) gdn_unit(p, item, lds);
            xcd_barrier(xbar);
            if (PH(17)) if (blockIdx.x < 16) gdn_seq(p, blockIdx.x, lds);
            xcd_barrier(xbar);
            if (PH(18)) FOR_ITEMS(SEQ / 8) gdn_readout_row(p, item * 8 + (tid_() >> 6));
            xcd_barrier(xbar);
            if (PH(19)) FOR_ITEMS(128 * 8 + 8192) {
                if (item < 1024) {
                    EpiResid e{p.in[0], p.in[2], (float*)(ws + WS_H), (const float*)(ws + WS_MOD), 1, false};
                    gemm_tile((const bf16_t*)(ws + WS_VN), 1024, SEQ, (const bf16_t*)(ws + WS_WOOUT), 1024, 1024, 1024, (item >> 3) * 128, (item & 7) * 128, e, lds);
                } else {
                    const int q = item - 1024;
                    cvt_chunk((q < 4096 ? p.in[29] : p.in[30]) + (size_t)16384 * 1024, (bf16_t*)(ws + WS_PUV) + (q < 4096 ? 0 : (size_t)16384 * 1024), q & 4095);
                }
            }
            xcd_barrier(xbar);
        }
        if (PH(8)) FOR_ITEMS(nrows / 8) norm_rows_item(p, item, l, p.in[7] + l * 1024, 3, false);
        xcd_barrier(xbar);
        if (PH(9)) FOR_ITEMS(ntm * 16) {
            EpiBf16 e{(bf16_t*)(ws + WS_Q), 2048};
            gemm_tile((const bf16_t*)(ws + WS_ACT), 1024, nrows, (const bf16_t*)(ws + (l == 0 ? WS_WQ0 : WS_WQ1)), 1024, 2048, 1024, (item >> 4) * 128, (item & 15) * 128, e, lds);
        }
        xcd_barrier(xbar);
        if (PH(10)) FOR_ITEMS(ntm * 16) {
            const int b = item & 15;
            EpiScore e{(unsigned short*)(ws + WS_SC), b * 128};
            gemm_tile((const bf16_t*)(ws + WS_Q) + b * 128, 2048, nrows, (const bf16_t*)(ws + WS_SK) + (size_t)(l * 2 + (b & 1)) * 128 * 128, 128, 128, 128, (item >> 4) * 128, 0, e, lds);
        }
        xcd_barrier(xbar);
        if (PH(11)) FOR_ITEMS(nrows / 64) peer_route_item(p, item, nrows, lds);
        xcd_barrier(xbar);
        if (PH(12)) FOR_ITEMS(nrows / 8) peer_gather_row(p, item * 8 + (tid_() >> 6), l, l == 1);
        if (l == 0) xcd_barrier(xbar);
    }
}

extern "C" void kernel_launch(void* const* d_in, const int* in_sizes, int n_in, void* d_out, int out_size, void* d_ws, size_t ws_size, hipStream_t stream) {
    static int grid_blocks = 0;
    if (grid_blocks == 0) {
        if (n_in != 32 || out_size != SEQ * D || ws_size < WS_NEED) {
            fprintf(stderr, "kernel_launch: unexpected problem (n_in %d, out %d, ws %zu, need %zu); nothing launched\n", n_in, out_size, ws_size, (size_t)WS_NEED);
            grid_blocks = -1; return;
        }
        int dev = 0, cus = 0, per_cu = 0;
        hipGetDevice(&dev);
        hipDeviceGetAttribute(&cus, hipDeviceAttributeMultiprocessorCount, dev);
        hipFuncSetAttribute((const void*)fwd_megakernel, hipFuncAttributeMaxDynamicSharedMemorySize, LDS_BYTES);
        hipOccupancyMaxActiveBlocksPerMultiprocessor(&per_cu, (const void*)fwd_megakernel, NTHREADS, LDS_BYTES);
        if (per_cu < 1) { fprintf(stderr, "kernel_launch: occupancy query says %d blocks per CU; nothing launched\n", per_cu); grid_blocks = -1; return; }
        grid_blocks = cus;
    }
    if (grid_blocks < 0) return;
    (void)hipMemsetAsync((unsigned char*)d_ws + WS_BAR, 0, XCD_BAR_WORDS * 4, stream);
    Params prm{};
    for (int i = 0; i < 32; ++i) prm.in[i] = (const float*)d_in[i];
    prm.out = (float*)d_out; prm.ws = (unsigned char*)d_ws;
    void* args[] = {&prm};
    hipError_t e = hipLaunchCooperativeKernel((const void*)fwd_megakernel, dim3(grid_blocks), dim3(NTHREADS), args, LDS_BYTES, stream);
    if (e != hipSuccess) fprintf(stderr, "cooperative launch failed: %s (grid %d)\n", hipGetErrorString(e), grid_blocks);
}
```

```cpp
#include <hip/hip_runtime.h>
#include <hip/hip_cooperative_groups.h>
#include <cstdio>
#include <cstdint>
namespace cg = cooperative_groups;

typedef unsigned short bf16_t;
typedef short bf16x8 __attribute__((ext_vector_type(8)));
typedef float f32x4 __attribute__((ext_vector_type(4)));
typedef float f32x16 __attribute__((ext_vector_type(16)));
typedef unsigned u32x4 __attribute__((ext_vector_type(4)));

constexpr int D = 1024, SEQ = 16384, CTX = 256, R = SEQ + CTX;
constexpr int NCH = R / 64;
constexpr int NCH_LAT = SEQ / 64;
constexpr int NTHREADS = 512;
constexpr int ODD_IN = 4128;
constexpr int NUNITS = 16 * NCH;

constexpr size_t al256(size_t x) { return (x + 255) & ~(size_t)255; }
constexpr size_t WS_BAR   = 0;
constexpr size_t WS_MOD   = 16384;
constexpr size_t WS_A64   = WS_MOD + al256(2 * 2 * 6 * 1024 * 4);
constexpr size_t WS_SK    = WS_A64 + al256(2 * 32 * 64 * 8);
constexpr size_t WS_WEIN  = WS_SK + al256(2 * 2 * 128 * 128 * 2);
constexpr size_t WS_WGLU  = WS_WEIN + (size_t)2048 * 1024 * 2;
constexpr size_t WS_WEOUT = WS_WGLU + (size_t)512 * 512 * 2;
constexpr size_t WS_WQ0   = WS_WEOUT + (size_t)1024 * 1024 * 2;
constexpr size_t WS_WQ1   = WS_WQ0 + (size_t)2048 * 1024 * 2;
constexpr size_t WS_WOIN  = WS_WQ1 + (size_t)2048 * 1024 * 2;
constexpr size_t WS_WOOUT = WS_WOIN + al256((size_t)ODD_IN * 1024 * 2);
constexpr size_t WS_H     = WS_WOOUT + (size_t)1024 * 1024 * 2;
constexpr size_t WS_PUV   = WS_H + (size_t)R * 1024 * 4;
constexpr size_t WS_ACT   = WS_PUV + (size_t)2 * 16384 * 1024 * 2;
constexpr size_t WS_ARENA = WS_ACT + (size_t)R * 1024 * 2;
constexpr size_t WS_GG    = WS_WEIN;
constexpr size_t WS_BETA  = WS_GG + (size_t)16 * R * 4;
constexpr size_t WS_GC    = WS_BETA + (size_t)16 * R * 4;
constexpr size_t WS_AB    = WS_GC + (size_t)NUNITS * 64 * 4;
static_assert(WS_AB + (size_t)R * 32 * 4 <= WS_WQ1, "layer-1 small buffers overflow the dead layer-0 weights");
constexpr size_t WS_PA    = WS_ARENA;
constexpr size_t WS_UG    = WS_PA + (size_t)R * 1536 * 2;
constexpr size_t WS_MS5   = WS_UG + (size_t)32 * NCH * 1024 * 2;
constexpr size_t WS_O5    = WS_MS5 + (size_t)32 * 1280 * 1024 * 2;
constexpr size_t WS_KTAB  = WS_O5 + (size_t)32 * 1024 * 256 * 2;
constexpr size_t WS_YL    = WS_KTAB + (size_t)2 * 32 * 64 * 256 * 4;
constexpr size_t WS_LST   = WS_YL + (size_t)R * 512 * 4;
constexpr size_t WS_A5    = WS_LST + (size_t)32 * NCH * 256 * 4;
constexpr size_t WS_GS    = WS_A5 + (size_t)32 * NCH * 256 * 2;
constexpr size_t WS_CB    = WS_GS + (size_t)R * 512 * 2;
constexpr size_t WS_END_L0 = WS_CB + (size_t)R * 1024 * 2;
constexpr size_t WS_Q     = WS_ARENA;
constexpr size_t WS_SC    = WS_Q + (size_t)R * 2048 * 2;
constexpr size_t WS_IDX   = WS_SC + (size_t)R * 2048 * 2;
constexpr size_t WS_GATE  = WS_IDX + (size_t)R * 128 * 4;
constexpr size_t WS_END_PEER = WS_GATE + (size_t)R * 128 * 4;
constexpr size_t WS_QKVR  = WS_ARENA;
constexpr size_t WS_W     = WS_QKVR;
constexpr size_t WS_ATT   = WS_W + (size_t)NUNITS * 64 * 128 * 2;
static_assert(WS_ATT + (size_t)NUNITS * 64 * 64 * 2 <= WS_QKVR + (size_t)R * 3072 * 2, "W+ATT must fit in QKVR");
constexpr size_t WS_Z     = WS_QKVR + (size_t)R * 3072 * 2;
constexpr size_t WS_QN    = WS_Z + (size_t)R * 1024 * 2;
constexpr size_t WS_KN    = WS_QN + (size_t)R * 1024 * 2;
constexpr size_t WS_VN    = WS_KN + (size_t)R * 1024 * 2;
constexpr size_t WS_UT    = WS_VN + (size_t)R * 1024 * 2;
constexpr size_t WS_END_L1 = WS_UT + (size_t)NUNITS * 128 * 64 * 2;
constexpr size_t WS_OF    = WS_PUV;
constexpr size_t WS_SIN   = WS_ACT;
constexpr size_t WS_BSEG  = WS_SIN + (size_t)256 * 65536;
constexpr size_t WS_ASEG  = WS_VN;
static_assert(WS_BSEG + (size_t)256 * 65536 <= WS_ARENA, "SIN+BSEG must fit in ACT");
constexpr size_t cmax(size_t a, size_t b) { return a > b ? a : b; }
constexpr size_t WS_NEED  = cmax(cmax(WS_END_L0, WS_END_PEER), WS_END_L1);
static_assert(WS_NEED <= (size_t)512 * 1024 * 1024, "workspace plan exceeds 512 MiB");

constexpr int LDS_BYTES = 140 * 1024;

struct Params {
    const float* in[32];
    float* out;
    unsigned char* ws;
};

__device__ __forceinline__ int tid_() { int t = threadIdx.x; asm volatile("" : "+v"(t)); return t; }
__device__ __forceinline__ float bf2f(bf16_t b) { return __uint_as_float((unsigned)b << 16); }
__device__ __forceinline__ bf16_t f2bf(float f) { const __bf16 b = (__bf16)f; return __builtin_bit_cast(bf16_t, b); }
typedef float f32x2_t __attribute__((ext_vector_type(2)));
typedef __bf16 bf16x2_t __attribute__((ext_vector_type(2)));
__device__ __forceinline__ unsigned pack2(float lo, float hi) { const f32x2_t v = {lo, hi}; const bf16x2_t b = __builtin_convertvector(v, bf16x2_t); return __builtin_bit_cast(unsigned, b); }
__device__ __forceinline__ float lo2f(unsigned p) { return __uint_as_float(p << 16); }
__device__ __forceinline__ float hi2f(unsigned p) { return __uint_as_float(p & 0xFFFF0000u); }
__device__ __forceinline__ float sigmoidf_(float x) { return 1.f / (1.f + __expf(-x)); }
__device__ __forceinline__ float siluf_(float x) { return x * sigmoidf_(x); }
__device__ __forceinline__ float gelu_tanh(float x) {
    const float u = 0.7978845608028654f * (x + 0.044715f * x * x * x);
    const float t = 1.f - 2.f / (1.f + __expf(2.f * u));
    return 0.5f * x * (1.f + t);
}
__device__ __forceinline__ float wave_sum(float v) {
#pragma unroll
    for (int o = 32; o > 0; o >>= 1) v += __shfl_xor(v, o, 64);
    return v;
}
__device__ __forceinline__ void unpack8(const uint4& p, float* f) {
    f[0] = lo2f(p.x); f[1] = hi2f(p.x); f[2] = lo2f(p.y); f[3] = hi2f(p.y);
    f[4] = lo2f(p.z); f[5] = hi2f(p.z); f[6] = lo2f(p.w); f[7] = hi2f(p.w);
}
__device__ __forceinline__ uint4 pack8(const float* f) {
    uint4 p; p.x = pack2(f[0], f[1]); p.y = pack2(f[2], f[3]); p.z = pack2(f[4], f[5]); p.w = pack2(f[6], f[7]); return p;
}
__device__ __forceinline__ const float* modp(const Params& p, int l, int row, int j) {
    const float* m = (const float*)(p.ws + WS_MOD);
    return m + ((l * 2 + (row >= SEQ ? 1 : 0)) * 6 + j) * 1024;
}

constexpr int GT_LD = 72;
constexpr int GT_OPB = 128 * GT_LD * 2;
template <class Epi>
__device__ __forceinline__ void gemm_tile(const bf16_t* __restrict__ A, int lda, int M, const bf16_t* __restrict__ Bt, int ldb, int N, int K,
                                          int row0, int col0, Epi epi, unsigned char* lds) {
    const int tid = tid_(), lane = tid & 63, wave = tid >> 6;
    const int wm = wave >> 2, wn = wave & 3, r = lane & 31, h = lane >> 5;
    const int lr = tid >> 3, lc = (tid & 7) * 8;
    int ar0 = row0 + lr, ar1 = row0 + lr + 64, br0 = col0 + lr, br1 = col0 + lr + 64;
    ar0 = ar0 < M ? ar0 : M - 1; ar1 = ar1 < M ? ar1 : M - 1; br0 = br0 < N ? br0 : N - 1; br1 = br1 < N ? br1 : N - 1;
    const bf16_t* pa0 = A + (size_t)ar0 * lda + lc; const bf16_t* pa1 = A + (size_t)ar1 * lda + lc;
    const bf16_t* pb0 = Bt + (size_t)br0 * ldb + lc; const bf16_t* pb1 = Bt + (size_t)br1 * ldb + lc;
    f32x16 acc0, acc1;
#pragma unroll
    for (int i = 0; i < 16; ++i) { acc0[i] = 0.f; acc1[i] = 0.f; }
    const int nk = K >> 6;
    uint4 ra0 = *(const uint4*)pa0, ra1 = *(const uint4*)pa1, rb0 = *(const uint4*)pb0, rb1 = *(const uint4*)pb1;
    __syncthreads();
    {
        unsigned char* sa = lds; unsigned char* sb = lds + GT_OPB;
        *(uint4*)(sa + (lr * GT_LD + lc) * 2) = ra0; *(uint4*)(sa + ((lr + 64) * GT_LD + lc) * 2) = ra1;
        *(uint4*)(sb + (lr * GT_LD + lc) * 2) = rb0; *(uint4*)(sb + ((lr + 64) * GT_LD + lc) * 2) = rb1;
    }
    __syncthreads();
    for (int kt = 0; kt < nk; ++kt) {
        const int cur = kt & 1;
        if (kt + 1 < nk) {
            const int ko = (kt + 1) * 64;
            ra0 = *(const uint4*)(pa0 + ko); ra1 = *(const uint4*)(pa1 + ko); rb0 = *(const uint4*)(pb0 + ko); rb1 = *(const uint4*)(pb1 + ko);
        }
        const unsigned char* sa = lds + cur * 2 * GT_OPB; const unsigned char* sb = sa + GT_OPB;
#pragma unroll
        for (int s = 0; s < 4; ++s) {
            const bf16x8 a0 = *(const bf16x8*)(sa + ((wm * 64 + r) * GT_LD + s * 16 + 8 * h) * 2);
            const bf16x8 a1 = *(const bf16x8*)(sa + ((wm * 64 + 32 + r) * GT_LD + s * 16 + 8 * h) * 2);
            const bf16x8 b  = *(const bf16x8*)(sb + ((wn * 32 + r) * GT_LD + s * 16 + 8 * h) * 2);
            acc0 = __builtin_amdgcn_mfma_f32_32x32x16_bf16(a0, b, acc0, 0, 0, 0);
            acc1 = __builtin_amdgcn_mfma_f32_32x32x16_bf16(a1, b, acc1, 0, 0, 0);
        }
        if (kt + 1 < nk) {
            unsigned char* na = lds + (cur ^ 1) * 2 * GT_OPB; unsigned char* nb = na + GT_OPB;
            *(uint4*)(na + (lr * GT_LD + lc) * 2) = ra0; *(uint4*)(na + ((lr + 64) * GT_LD + lc) * 2) = ra1;
            *(uint4*)(nb + (lr * GT_LD + lc) * 2) = rb0; *(uint4*)(nb + ((lr + 64) * GT_LD + lc) * 2) = rb1;
        }
        __syncthreads();
    }
    const int col = col0 + wn * 32 + r;
    if (col < N) {
#pragma unroll
        for (int i = 0; i < 16; ++i) {
            const int rr = (i & 3) + 8 * (i >> 2) + 4 * h;
            const int row_a = row0 + wm * 64 + rr, row_b = row_a + 32;
            if (row_a < M) epi(row_a, col, acc0[i]);
            if (row_b < M) epi(row_b, col, acc1[i]);
        }
    }
}

__device__ __forceinline__ void p0_adaln(const Params& p, int item, unsigned char* lds) {
    const int l = item / 96, cb = item % 96, tid = tid_();
    const int kq = tid >> 4, c4 = tid & 15;
    const float* W = p.in[4] + (size_t)l * 1024 * 6144 + cb * 64 + c4 * 4;
    const float* c = p.in[1]; const float* cc = p.in[3];
    float al[4] = {0, 0, 0, 0}, ac[4] = {0, 0, 0, 0};
    for (int k = kq; k < 1024; k += 32) {
        const float4 w = *(const float4*)(W + (size_t)k * 6144);
        const float sl = siluf_(c[k]), sc = siluf_(cc[k]);
        al[0] += sl * w.x; al[1] += sl * w.y; al[2] += sl * w.z; al[3] += sl * w.w;
        ac[0] += sc * w.x; ac[1] += sc * w.y; ac[2] += sc * w.z; ac[3] += sc * w.w;
    }
    float* red = (float*)lds;
    __syncthreads();
#pragma unroll
    for (int e = 0; e < 4; ++e) { red[(kq * 2 + 0) * 64 + c4 * 4 + e] = al[e]; red[(kq * 2 + 1) * 64 + c4 * 4 + e] = ac[e]; }
    __syncthreads();
    if (tid < 128) {
        const int s = tid >> 6, cidx = tid & 63;
        float sum = 0.f;
        for (int q = 0; q < 32; ++q) sum += red[(q * 2 + s) * 64 + cidx];
        const int col = cb * 64 + cidx;
        sum += p.in[5][l * 6144 + col];
        ((float*)(p.ws + WS_MOD))[(l * 2 + s) * 6144 + col] = sum;
    }
}
__device__ __forceinline__ void p0_transpose(const float* __restrict__ src, int K, int N, bf16_t* __restrict__ dst, int tile, unsigned char* lds) {
    const int ntn = (N + 63) / 64, tk = tile / ntn, tn = tile % ntn, tid = tid_();
    float* s = (float*)lds;
    __syncthreads();
    for (int e = tid; e < 64 * 64; e += NTHREADS) {
        const int kk = e >> 6, nn = e & 63; const int n = tn * 64 + nn;
        s[kk * 65 + nn] = n < N ? src[(size_t)(tk * 64 + kk) * N + n] : 0.f;
    }
    __syncthreads();
    {
        const int nn = tid >> 3, kg = (tid & 7) * 8; const int n = tn * 64 + nn;
        if (n < N) {
            float f[8];
#pragma unroll
            for (int e = 0; e < 8; ++e) f[e] = s[(kg + e) * 65 + nn];
            *(uint4*)(dst + (size_t)n * K + tk * 64 + kg) = pack8(f);
        }
    }
}
__device__ __forceinline__ void cvt_chunk(const float* __restrict__ src, bf16_t* __restrict__ dst, size_t item) {
    const size_t o = item * 4096 + (size_t)tid_() * 8;
    const float4 a = *(const float4*)(src + o), b = *(const float4*)(src + o + 4);
    uint4 q; q.x = pack2(a.x, a.y); q.y = pack2(a.z, a.w); q.z = pack2(b.x, b.y); q.w = pack2(b.z, b.w);
    *(uint4*)(dst + o) = q;
}
__device__ __forceinline__ void sincos_d(double x, double& s, double& c) {
    const double TWO_OVER_PI = 0.63661977236758134308, PIO2_HI = 1.57079632679489655800e+00, PIO2_LO = 6.12323399573676603587e-17;
    const double kf = rint(x * TWO_OVER_PI);
    const double y = (x - kf * PIO2_HI) - kf * PIO2_LO;
    const double y2 = y * y;
    double sp = -1.0 / 1307674368000.0;
    sp = sp * y2 + 1.0 / 6227020800.0; sp = sp * y2 - 1.0 / 39916800.0; sp = sp * y2 + 1.0 / 362880.0; sp = sp * y2 - 1.0 / 5040.0;
    sp = sp * y2 + 1.0 / 120.0; sp = sp * y2 - 1.0 / 6.0; sp = sp * y2 + 1.0; sp *= y;
    double cp = 1.0 / 20922789888000.0;
    cp = cp * y2 - 1.0 / 87178291200.0; cp = cp * y2 + 1.0 / 479001600.0; cp = cp * y2 - 1.0 / 3628800.0; cp = cp * y2 + 1.0 / 40320.0;
    cp = cp * y2 - 1.0 / 720.0; cp = cp * y2 + 1.0 / 24.0; cp = cp * y2 - 0.5; cp = cp * y2 + 1.0;
    const int q = ((int)kf) & 3;
    s = (q == 0) ? sp : (q == 1) ? cp : (q == 2) ? -sp : -cp;
    c = (q == 0) ? cp : (q == 1) ? -sp : (q == 2) ? -cp : sp;
}
__device__ __forceinline__ void p0_s5_tables(const Params& p, int item, unsigned char* lds) {
    const int di = item >> 5, g = item & 31, tid = tid_();
    float2* apw = (float2*)lds;
    float2* Bb = apw + 64 * 65;
    float2* Cc = Bb + 64 * 16;
    __syncthreads();
    if (tid < 64) {
        const int pidx = (di * 32 + g) * 64 + tid;
        float lr = p.in[10][pidx]; lr = lr < -1e-4f ? lr : -1e-4f;
        const float li = p.in[11][pidx];
        const float dt = expf(p.in[12][di * 32 + g]);
        const double mag = (double)expf(lr * dt);
        double sn, cs; sincos_d((double)li * (double)dt, sn, cs);
        const double are = mag * cs, aim = mag * sn;
        double pr = 1.0, pi_ = 0.0;
        for (int t = 0; t <= 64; ++t) {
            apw[tid * 65 + t] = make_float2((float)pr, (float)pi_);
            const double nr = pr * are - pi_ * aim, ni = pr * aim + pi_ * are; pr = nr; pi_ = ni;
        }
        ((float2*)(p.ws + WS_A64))[(di * 32 + g) * 64 + tid] = apw[tid * 65 + 64];
        const double den = (double)lr * lr + (double)li * li;
        const double fre = ((are - 1.0) * lr + aim * li) / den, fim = (aim * lr - (are - 1.0) * li) / den;
        for (int hh = 0; hh < 16; ++hh) {
            const double br = p.in[13][(size_t)pidx * 16 + hh], bi = p.in[14][(size_t)pidx * 16 + hh];
            Bb[tid * 16 + hh] = make_float2((float)(fre * br - fim * bi), (float)(fre * bi + fim * br));
        }
    }
    for (int e = tid; e < 1024; e += NTHREADS) {
        const size_t gi = ((size_t)(di * 32 + g) * 16) * 64 + e;
        Cc[e] = make_float2(p.in[15][gi], p.in[16][gi]);
    }
    __syncthreads();
    float* ktab = (float*)(p.ws + WS_KTAB) + (size_t)(di * 32 + g) * 64 * 256;
    for (int o = tid; o < 64 * 256; o += NTHREADS) {
        const int tau = o >> 8, hh = (o >> 4) & 15, h2 = o & 15;
        float acc = 0.f;
        for (int pp = 0; pp < 64; ++pp) {
            const float2 a = apw[pp * 65 + tau], c = Cc[hh * 64 + pp], b = Bb[pp * 16 + h2];
            const float cr = c.x * a.x - c.y * a.y, ci = c.x * a.y + c.y * a.x;
            acc += cr * b.x - ci * b.y;
        }
        ktab[o] = acc;
    }
    bf16_t* ms5 = (bf16_t*)(p.ws + WS_MS5) + (size_t)g * 1280 * 1024;
    for (int t = tid; t < 128 * 128; t += NTHREADS) {
        const int row = t >> 7, k8 = t & 127; const int ri = row >> 6, pp = row & 63, j = k8 >> 1, h0 = (k8 & 1) * 8;
        const float2 a = apw[pp * 65 + (di == 0 ? 63 - j : j)];
        float f[8];
#pragma unroll
        for (int e = 0; e < 8; ++e) { const float2 b = Bb[pp * 16 + h0 + e]; f[e] = ri == 0 ? (a.x * b.x - a.y * b.y) : (a.x * b.y + a.y * b.x); }
        *(uint4*)(ms5 + (size_t)(1024 + di * 128 + row) * 1024 + k8 * 8) = pack8(f);
    }
    bf16_t* o5 = (bf16_t*)(p.ws + WS_O5) + (size_t)g * 1024 * 256;
    for (int t = tid; t < 1024 * 16; t += NTHREADS) {
        const int n = t >> 4, q = t & 15; const int ri = q >> 3, p0 = (q & 7) * 8, i = n >> 4, hh = n & 15;
        float f[8];
#pragma unroll
        for (int e = 0; e < 8; ++e) {
            const float2 a = apw[(p0 + e) * 65 + (di == 0 ? i + 1 : 64 - i)], c = Cc[hh * 64 + p0 + e];
            f[e] = ri == 0 ? (c.x * a.x - c.y * a.y) : -(c.x * a.y + c.y * a.x);
        }
        *(uint4*)(o5 + (size_t)n * 256 + di * 128 + ri * 64 + p0) = pack8(f);
    }
}

__device__ __forceinline__ void norm_mod_row(const float* __restrict__ src, const float* __restrict__ g, const float* __restrict__ shift,
                                             const float* __restrict__ scale, bf16_t* __restrict__ dst, int lane) {
    float4 v[4]; float ss = 0.f;
#pragma unroll
    for (int k = 0; k < 4; ++k) { v[k] = *(const float4*)(src + k * 256 + lane * 4); ss += v[k].x * v[k].x + v[k].y * v[k].y + v[k].z * v[k].z + v[k].w * v[k].w; }
    ss = wave_sum(ss);
    const float rs = rsqrtf(ss * (1.f / 1024.f) + 1e-6f);
#pragma unroll
    for (int k = 0; k < 4; ++k) {
        const int c = k * 256 + lane * 4;
        const float4 gg = *(const float4*)(g + c), sh = *(const float4*)(shift + c), sc = *(const float4*)(scale + c);
        uint2 o;
        o.x = pack2(v[k].x * rs * gg.x * (1.f + sc.x) + sh.x, v[k].y * rs * gg.y * (1.f + sc.y) + sh.y);
        o.y = pack2(v[k].z * rs * gg.z * (1.f + sc.z) + sh.z, v[k].w * rs * gg.w * (1.f + sc.w) + sh.w);
        *(uint2*)(dst + c) = o;
    }
}
__device__ __forceinline__ void norm_rows_item(const Params& p, int item, int l, const float* g, int js, bool from_inputs) {
    const int row = item * 8 + (tid_() >> 6), lane = tid_() & 63;
    const float* src = from_inputs ? (row < SEQ ? p.in[0] + (size_t)row * 1024 : p.in[2] + (size_t)(row - SEQ) * 1024)
                                   : (const float*)(p.ws + WS_H) + (size_t)row * 1024;
    norm_mod_row(src, g, modp(p, l, row, js), modp(p, l, row, js + 1), (bf16_t*)(p.ws + WS_ACT) + (size_t)row * 1024, lane);
}
__device__ __forceinline__ void s5_mintra_item(const Params& p, int item) {
    const int g = item >> 6, i = item & 63;
    const float* kt0 = (const float*)(p.ws + WS_KTAB) + (size_t)(0 * 32 + g) * 64 * 256;
    const float* kt1 = (const float*)(p.ws + WS_KTAB) + (size_t)(1 * 32 + g) * 64 * 256;
    const float* dsk = p.in[17] + g * 16;
    bf16_t* ms5 = (bf16_t*)(p.ws + WS_MS5) + (size_t)g * 1280 * 1024;
    for (int t = tid_(); t < 16 * 128; t += NTHREADS) {
        const int hh = t >> 7, k8 = t & 127, j = k8 >> 1, h0 = (k8 & 1) * 8;
        float f[8];
        if (j < i) { const float* s = kt0 + ((i - j) * 16 + hh) * 16 + h0;
#pragma unroll
            for (int e = 0; e < 8; ++e) f[e] = s[e]; }
        else if (j > i) { const float* s = kt1 + ((j - i) * 16 + hh) * 16 + h0;
#pragma unroll
            for (int e = 0; e < 8; ++e) f[e] = s[e]; }
        else { const float* s0 = kt0 + hh * 16 + h0; const float* s1 = kt1 + hh * 16 + h0;
#pragma unroll
            for (int e = 0; e < 8; ++e) f[e] = s0[e] + s1[e] + ((h0 + e) == hh ? dsk[hh] : 0.f); }
        *(uint4*)(ms5 + (size_t)(i * 16 + hh) * 1024 + k8 * 8) = pack8(f);
    }
}

struct EpiEvenIn {
    bf16_t* pa; bf16_t* ug;
    __device__ __forceinline__ void operator()(int row, int col, float v) const {
        if (col < 1536) pa[(size_t)row * 1536 + col] = f2bf(v);
        else { const int c2 = col - 1536; ug[((size_t)(c2 >> 4) * NCH + (row >> 6)) * 1024 + (row & 63) * 16 + (c2 & 15)] = f2bf(v); }
    }
};
struct EpiS5Local {
    float* yl; float* lst; int g;
    __device__ __forceinline__ void operator()(int row, int col, float v) const {
        if (col < 1024) yl[(size_t)(row * 64 + (col >> 4)) * 512 + g * 16 + (col & 15)] = v;
        else lst[((size_t)g * NCH + row) * 256 + (col - 1024)] = v;
    }
};
struct EpiS5Out {
    const float* yl; bf16_t* gs; int g;
    __device__ __forceinline__ void operator()(int row, int col, float v) const {
        const size_t o = (size_t)(row * 64 + (col >> 4)) * 512 + g * 16 + (col & 15);
        gs[o] = f2bf(gelu_tanh(v + yl[o]));
    }
};
struct EpiGlu {
    const bf16_t* gs; const float* b; bf16_t* cb;
    __device__ __forceinline__ void operator()(int row, int col, float v) const {
        cb[(size_t)row * 1024 + 512 + col] = f2bf(bf2f(gs[(size_t)row * 512 + col]) * sigmoidf_(v + b[col]));
    }
};
struct EpiResid {
    const float* x; const float* ctx; float* hbuf; const float* mod; int l; bool from_inputs;
    __device__ __forceinline__ void operator()(int row, int col, float v) const {
        float* h = hbuf + (size_t)row * 1024 + col;
        const float base = from_inputs ? (row < SEQ ? x[(size_t)row * 1024 + col] : ctx[(size_t)(row - SEQ) * 1024 + col]) : *h;
        *h = base + mod[((l * 2 + (row >= SEQ ? 1 : 0)) * 6 + 2) * 1024 + col] * v;
    }
};
struct EpiBf16 {
    bf16_t* dst; int ld;
    __device__ __forceinline__ void operator()(int row, int col, float v) const { dst[(size_t)row * ld + col] = f2bf(v); }
};
struct EpiScore {
    unsigned short* dst; int coff;
    __device__ __forceinline__ void operator()(int row, int col, float v) const {
        const _Float16 hv = (_Float16)v; dst[(size_t)row * 2048 + coff + col] = __builtin_bit_cast(unsigned short, hv);
    }
};
struct EpiOddIn {
    bf16_t* qkvr; bf16_t* z; float* ab;
    __device__ __forceinline__ void operator()(int row, int col, float v) const {
        if (col < 3072) qkvr[(size_t)row * 3072 + col] = f2bf(v);
        else if (col < 4096) z[(size_t)row * 1024 + (col - 3072)] = f2bf(v);
        else ab[(size_t)row * 32 + (col - 4096)] = v;
    }
};

__device__ __forceinline__ void s5_scan(const Params& p) {
    const int gt = blockIdx.x * NTHREADS + tid_();
    if (gt >= 4096) return;
    const int di = gt >> 11, g = (gt >> 6) & 31, pp = gt & 63;
    const float2 a = ((const float2*)(p.ws + WS_A64))[(di * 32 + g) * 64 + pp];
    const float* lst = (const float*)(p.ws + WS_LST) + (size_t)g * NCH * 256 + di * 128 + pp;
    bf16_t* a5 = (bf16_t*)(p.ws + WS_A5) + (size_t)g * NCH * 256 + di * 128 + pp;
    float sr = 0.f, si = 0.f;
    for (int s0 = 0; s0 < NCH; s0 += 4) {
        int c[4]; float lr[4], li[4];
#pragma unroll
        for (int u = 0; u < 4; ++u) {
            const int s = s0 + u;
            c[u] = di == 0 ? (s < 4 ? NCH_LAT + s : s - 4) : (s < 4 ? NCH - 1 - s : NCH - 1 - s);
            lr[u] = lst[(size_t)c[u] * 256]; li[u] = lst[(size_t)c[u] * 256 + 64];
        }
#pragma unroll
        for (int u = 0; u < 4; ++u) {
            a5[(size_t)c[u] * 256] = f2bf(sr); a5[(size_t)c[u] * 256 + 64] = f2bf(si);
            const float nr = a.x * sr - a.y * si + lr[u], ni = a.x * si + a.y * sr + li[u]; sr = nr; si = ni;
        }
    }
}

__device__ __forceinline__ void even_conv_item(const Params& p, int item) {
    const bf16_t* pa = (const bf16_t*)(p.ws + WS_PA); bf16_t* cb = (bf16_t*)(p.ws + WS_CB);
    const float* cw = p.in[9];
    for (int t = tid_(); t < 64 * 64; t += NTHREADS) {
        const int row = item * 64 + (t >> 6), c0 = (t & 63) * 8;
        bool hasp, hasn;
        if (row < SEQ) { hasp = (row & 63) != 0; hasn = (row & 63) != 63; } else { hasp = row != SEQ; hasn = row != R - 1; }
        float m[3][8];
#pragma unroll
        for (int d = 0; d < 3; ++d) {
            const bool ok = d == 1 || (d == 0 ? hasp : hasn);
            if (ok) {
                const bf16_t* rp = pa + (size_t)(row + d - 1) * 1536 + c0;
                float u[8], gi[8]; unpack8(*(const uint4*)rp, u); unpack8(*(const uint4*)(rp + 512), gi);
#pragma unroll
                for (int e = 0; e < 8; ++e) m[d][e] = u[e] * gi[e];
            } else {
#pragma unroll
                for (int e = 0; e < 8; ++e) m[d][e] = 0.f;
            }
        }
        float go[8], f[8]; unpack8(*(const uint4*)(pa + (size_t)row * 1536 + 1024 + c0), go);
#pragma unroll
        for (int e = 0; e < 8; ++e) f[e] = go[e] * (m[0][e] * cw[c0 + e] + m[1][e] * cw[512 + c0 + e] + m[2][e] * cw[1024 + c0 + e]);
        *(uint4*)(cb + (size_t)row * 1024 + c0) = pack8(f);
    }
}

__device__ __forceinline__ unsigned ord_enc(float v) { const unsigned u = __float_as_uint(v); return (u & 0x80000000u) ? ~u : (u | 0x80000000u); }
__device__ __forceinline__ float ord_dec(unsigned e) { const unsigned u = (e & 0x80000000u) ? (e & 0x7FFFFFFFu) : ~e; return __uint_as_float(u); }
#define TOP_INSERT(key) { unsigned x_ = (key); _Pragma("unroll") for (int k_ = 0; k_ < 16; ++k_) { const unsigned hi_ = top[k_] > x_ ? top[k_] : x_; x_ = top[k_] > x_ ? x_ : top[k_]; top[k_] = hi_; } }
__device__ __forceinline__ void peer_route_item(const Params& p, int item, int nrows, unsigned char* lds) {
    const int tid = tid_();
    const int row = item * 64 + (tid >> 3), head = tid & 7;
    unsigned* sIdx = (unsigned*)lds;
    __syncthreads();
    if (row < nrows) {
        const unsigned short* sc = (const unsigned short*)(p.ws + WS_SC) + (size_t)row * 2048 + head * 256;
        float fa[16], fb[16];
#pragma unroll
        for (int side = 0; side < 2; ++side) {
            unsigned top[16];
#pragma unroll
            for (int k = 0; k < 16; ++k) top[k] = 0u;
            for (int c = 0; c < 16; ++c) {
                const uint4 q = *(const uint4*)(sc + side * 128 + c * 8);
                const unsigned w[4] = {q.x, q.y, q.z, q.w};
#pragma unroll
                for (int e = 0; e < 8; ++e) {
                    const unsigned short hb = (unsigned short)((e & 1) ? (w[e >> 1] >> 16) : (w[e >> 1] & 0xFFFFu));
                    const float v = (float)__builtin_bit_cast(_Float16, hb);
                    TOP_INSERT((ord_enc(v) & ~0x7Fu) | (unsigned)(c * 8 + e));
                }
            }
#pragma unroll
            for (int k = 0; k < 16; ++k) {
                sIdx[(side * 16 + k) * NTHREADS + tid] = top[k] & 0x7Fu;
                const float v = ord_dec(top[k] & ~0x7Fu);
                if (side == 0) fa[k] = v; else fb[k] = v;
            }
        }
        unsigned top[16];
#pragma unroll
        for (int k = 0; k < 16; ++k) top[k] = 0u;
#pragma unroll
        for (int i = 0; i < 16; ++i) {
#pragma unroll
            for (int j = 0; j < 16; ++j) {
                if ((i + 1) * (j + 1) <= 16) { TOP_INSERT((ord_enc(fa[i] + fb[j]) & ~0xFFu) | (unsigned)(i * 16 + j)); }
            }
        }
        float ev[16]; float m = ord_dec(top[0] & ~0xFFu), sum = 0.f;
        int* idxo = (int*)(p.ws + WS_IDX) + (size_t)row * 128 + head * 16;
        float* go = (float*)(p.ws + WS_GATE) + (size_t)row * 128 + head * 16;
#pragma unroll
        for (int k = 0; k < 16; ++k) { ev[k] = __expf(ord_dec(top[k] & ~0xFFu) - m); sum += ev[k]; }
        const float inv = 1.f / sum;
#pragma unroll
        for (int k = 0; k < 16; ++k) {
            const unsigned pos = top[k] & 0xFFu;
            const unsigned ia = sIdx[(pos >> 4) * NTHREADS + tid], ib = sIdx[(16 + (pos & 15)) * NTHREADS + tid];
            idxo[k] = (int)(ia * 128u + ib); go[k] = ev[k] * inv;
        }
    }
}

__device__ __forceinline__ void peer_gather_row(const Params& p, int row, int l, bool last) {
    const int lane = tid_() & 63;
    const bf16_t* xr = (const bf16_t*)(p.ws + WS_ACT) + (size_t)row * 1024;
    const bf16_t* PU = (const bf16_t*)(p.ws + WS_PUV); const bf16_t* PV = PU + (size_t)16384 * 1024;
    float x[16], y[16];
    unpack8(*(const uint4*)(xr + lane * 8), x); unpack8(*(const uint4*)(xr + 512 + lane * 8), x + 8);
#pragma unroll
    for (int e = 0; e < 16; ++e) y[e] = 0.f;
    const int* idxp = (const int*)(p.ws + WS_IDX) + (size_t)row * 128; const float* gp = (const float*)(p.ws + WS_GATE) + (size_t)row * 128;
#pragma unroll 1
    for (int half = 0; half < 2; ++half) {
        const int myidx = idxp[half * 64 + lane]; const float mygate = gp[half * 64 + lane];
#pragma unroll 1
        for (int e0 = 0; e0 < 64; e0 += 4) {
            uint4 ur[4][2], vr[4][2]; int gt[4];
#pragma unroll
            for (int u = 0; u < 4; ++u) {
                const int id = __builtin_amdgcn_readlane(myidx, e0 + u);
                gt[u] = __builtin_amdgcn_readlane(__float_as_int(mygate), e0 + u);
                const bf16_t* up = PU + (size_t)id * 1024 + lane * 8; const bf16_t* vp = PV + (size_t)id * 1024 + lane * 8;
                ur[u][0] = *(const uint4*)up; ur[u][1] = *(const uint4*)(up + 512);
                vr[u][0] = *(const uint4*)vp; vr[u][1] = *(const uint4*)(vp + 512);
            }
#pragma unroll
            for (int u = 0; u < 4; ++u) {
                float f[16]; unpack8(ur[u][0], f); unpack8(ur[u][1], f + 8);
                float d = 0.f;
#pragma unroll
                for (int e = 0; e < 16; ++e) d += f[e] * x[e];
                d = wave_sum(d);
                const float coef = gelu_tanh(d) * __int_as_float(gt[u]);
                unpack8(vr[u][0], f); unpack8(vr[u][1], f + 8);
#pragma unroll
                for (int e = 0; e < 16; ++e) y[e] += coef * f[e];
            }
        }
    }
    float* h = (float*)(p.ws + WS_H) + (size_t)row * 1024;
    const float* m5 = modp(p, l, row, 5);
    float hv[16];
#pragma unroll
    for (int q = 0; q < 2; ++q) {
        const int c = q * 512 + lane * 8;
        const float4 h0 = *(const float4*)(h + c), h1 = *(const float4*)(h + c + 4);
        const float4 g0 = *(const float4*)(m5 + c), g1 = *(const float4*)(m5 + c + 4);
        hv[q * 8 + 0] = h0.x + g0.x * y[q * 8 + 0]; hv[q * 8 + 1] = h0.y + g0.y * y[q * 8 + 1];
        hv[q * 8 + 2] = h0.z + g0.z * y[q * 8 + 2]; hv[q * 8 + 3] = h0.w + g0.w * y[q * 8 + 3];
        hv[q * 8 + 4] = h1.x + g1.x * y[q * 8 + 4]; hv[q * 8 + 5] = h1.y + g1.y * y[q * 8 + 5];
        hv[q * 8 + 6] = h1.z + g1.z * y[q * 8 + 6]; hv[q * 8 + 7] = h1.w + g1.w * y[q * 8 + 7];
    }
    if (!last) {
#pragma unroll
        for (int q = 0; q < 2; ++q) {
            const int c = q * 512 + lane * 8;
            *(float4*)(h + c) = make_float4(hv[q * 8 + 0], hv[q * 8 + 1], hv[q * 8 + 2], hv[q * 8 + 3]);
            *(float4*)(h + c + 4) = make_float4(hv[q * 8 + 4], hv[q * 8 + 5], hv[q * 8 + 6], hv[q * 8 + 7]);
        }
    } else {
        float ss = 0.f;
#pragma unroll
        for (int e = 0; e < 16; ++e) ss += hv[e] * hv[e];
        ss = wave_sum(ss);
        const float rs = rsqrtf(ss * (1.f / 1024.f) + 1e-6f);
        const float* fg = p.in[31]; float* o = p.out + (size_t)row * 1024;
#pragma unroll
        for (int q = 0; q < 2; ++q) {
            const int c = q * 512 + lane * 8;
            const float4 g0 = *(const float4*)(fg + c), g1 = *(const float4*)(fg + c + 4);
            *(float4*)(o + c) = make_float4(hv[q * 8 + 0] * rs * g0.x, hv[q * 8 + 1] * rs * g0.y, hv[q * 8 + 2] * rs * g0.z, hv[q * 8 + 3] * rs * g0.w);
            *(float4*)(o + c + 4) = make_float4(hv[q * 8 + 4] * rs * g1.x, hv[q * 8 + 5] * rs * g1.y, hv[q * 8 + 6] * rs * g1.z, hv[q * 8 + 7] * rs * g1.w);
        }
    }
}

__device__ __forceinline__ void gdn_prep_item(const Params& p, int item) {
    const int lane = tid_() & 63, wave = tid_() >> 6;
    const bf16_t* qkvr = (const bf16_t*)(p.ws + WS_QKVR);
    const float* cw = p.in[22];
    for (int it = 0; it < 8; ++it) {
        const int row = item * 64 + it * 8 + wave;
        bool hasp, hasn;
        if (row < SEQ) { hasp = (row & 63) != 0; hasn = (row & 63) != 63; } else { hasp = row != SEQ; hasn = row != R - 1; }
#pragma unroll 1
        for (int ph = 0; ph < 6; ++ph) {
            const int part = ph >> 1, head = (ph & 1) * 4 + (lane >> 4), d0 = (lane & 15) * 8;
            const int ch = part * 1024 + head * 128 + d0;
            float xm[8], x0[8], xp[8], f[8];
            unpack8(*(const uint4*)(qkvr + (size_t)row * 3072 + ch), x0);
            if (hasp) unpack8(*(const uint4*)(qkvr + (size_t)(row - 1) * 3072 + ch), xm);
            if (hasn) unpack8(*(const uint4*)(qkvr + (size_t)(row + 1) * 3072 + ch), xp);
            float ss = 0.f;
#pragma unroll
            for (int e = 0; e < 8; ++e) {
                float a = x0[e] * cw[3072 + ch + e];
                if (hasp) a += xm[e] * cw[ch + e];
                if (hasn) a += xp[e] * cw[6144 + ch + e];
                a = siluf_(a); f[e] = a; ss += a * a;
            }
            if (part < 2) {
                ss += __shfl_xor(ss, 1, 64); ss += __shfl_xor(ss, 2, 64); ss += __shfl_xor(ss, 4, 64); ss += __shfl_xor(ss, 8, 64);
                const float sc = rsqrtf(ss + 1e-6f) * (part == 0 ? 0.08838834764831845f : 1.f);
#pragma unroll
                for (int e = 0; e < 8; ++e) f[e] *= sc;
            }
            bf16_t* dst = (bf16_t*)(p.ws + (part == 0 ? WS_QN : part == 1 ? WS_KN : WS_VN)) + (size_t)row * 1024 + head * 128 + d0;
            *(uint4*)dst = pack8(f);
        }
        if (lane < 16) {
            const float* ab = (const float*)(p.ws + WS_AB) + (size_t)row * 32;
            const float a = ab[lane] + p.in[24][lane], b = ab[16 + lane];
            const float sp = a > 20.f ? a : log1pf(__expf(a));
            ((float*)(p.ws + WS_GG))[(size_t)lane * R + row] = -__expf(p.in[23][lane]) * sp;
            ((float*)(p.ws + WS_BETA))[(size_t)lane * R + row] = sigmoidf_(b);
        }
    }
}

constexpr int GU_LDQ = 136, GU_LDT = 72, GU_LDA = 68;
constexpr int GU_SQ = 0, GU_SK = 17408, GU_SKB = 34816, GU_SVBT = 52224, GU_SKGT = 70656, GU_SA = 89088, GU_SAT = 106496, GU_ST = 123904, GU_SG = 133120;
__device__ __forceinline__ int perm_slot64(int pos) { return 32 * (pos >> 5) + 8 * ((pos >> 2) & 3) + 4 * ((pos >> 4) & 1) + (pos & 3); }
__device__ __forceinline__ void gdn_unit(const Params& p, int u, unsigned char* lds) {
    const int tid = tid_(), lane = tid & 63, wave = tid >> 6;
    const int dh = u / NCH, c = u % NCH, dir = dh >> 3, head = dh & 7;
    bf16_t* sQ = (bf16_t*)(lds + GU_SQ); bf16_t* sK = (bf16_t*)(lds + GU_SK); bf16_t* sKB = (bf16_t*)(lds + GU_SKB);
    bf16_t* sVBT = (bf16_t*)(lds + GU_SVBT); bf16_t* sKGT = (bf16_t*)(lds + GU_SKGT);
    float* sA = (float*)(lds + GU_SA); float* sAT = (float*)(lds + GU_SAT); bf16_t* sT = (bf16_t*)(lds + GU_ST);
    float* sG = (float*)(lds + GU_SG); float* sBeta = sG + 64;
    __syncthreads();
    if (wave == 0) {
        const int row = c * 64 + (dir ? 63 - lane : lane);
        float g = ((const float*)(p.ws + WS_GG))[(size_t)dh * R + row];
#pragma unroll
        for (int o = 1; o < 64; o <<= 1) { const float t = __shfl_up(g, o, 64); if (lane >= o) g += t; }
        sG[lane] = g; sBeta[lane] = ((const float*)(p.ws + WS_BETA))[(size_t)dh * R + row];
        ((float*)(p.ws + WS_GC))[(size_t)u * 64 + lane] = g;
    }
    __syncthreads();
    for (int t = tid; t < 1024; t += NTHREADS) {
        const int i = t >> 4, d8 = (t & 15) * 8;
        const size_t ro = (size_t)(c * 64 + (dir ? 63 - i : i)) * 1024 + head * 128 + d8;
        const uint4 q = *(const uint4*)((const bf16_t*)(p.ws + WS_QN) + ro);
        const uint4 k = *(const uint4*)((const bf16_t*)(p.ws + WS_KN) + ro);
        const uint4 v = *(const uint4*)((const bf16_t*)(p.ws + WS_VN) + ro);
        const float beta = sBeta[i], eg = __expf(sG[i]);
        float kf[8], vf[8], kb[8];
        unpack8(k, kf); unpack8(v, vf);
#pragma unroll
        for (int e = 0; e < 8; ++e) kb[e] = kf[e] * beta;
        *(uint4*)(sQ + i * GU_LDQ + d8) = q; *(uint4*)(sK + i * GU_LDQ + d8) = k; *(uint4*)(sKB + i * GU_LDQ + d8) = pack8(kb);
#pragma unroll
        for (int e = 0; e < 8; ++e) { sVBT[(d8 + e) * GU_LDT + i] = f2bf(vf[e] * beta); sKGT[(d8 + e) * GU_LDT + i] = f2bf(kb[e] * eg); }
    }
    __syncthreads();
    {
        const int mat = wave >> 2, mt = wave & 3, rr = lane & 15, q4 = lane >> 4;
        const bf16_t* sX = mat ? sQ : sKB;
        f32x4 acc[4];
#pragma unroll
        for (int nt = 0; nt < 4; ++nt) acc[nt] = (f32x4){0.f, 0.f, 0.f, 0.f};
#pragma unroll
        for (int kk = 0; kk < 4; ++kk) {
            const bf16x8 a = *(const bf16x8*)(sX + (16 * mt + rr) * GU_LDQ + kk * 32 + 8 * q4);
#pragma unroll
            for (int nt = 0; nt < 4; ++nt) {
                const bf16x8 b = *(const bf16x8*)(sK + (16 * nt + rr) * GU_LDQ + kk * 32 + 8 * q4);
                acc[nt] = __builtin_amdgcn_mfma_f32_16x16x32_bf16(a, b, acc[nt], 0, 0, 0);
            }
        }
        float* dstm = mat ? sAT : sA;
#pragma unroll
        for (int nt = 0; nt < 4; ++nt) {
            const int j = 16 * nt + rr; const float gj = sG[j];
#pragma unroll
            for (int jj = 0; jj < 4; ++jj) {
                const int i = 16 * mt + 4 * q4 + jj;
                const bool keep = mat ? (j <= i) : (j < i);
                dstm[i * GU_LDA + j] = keep ? acc[nt][jj] * __expf(sG[i] - gj) : 0.f;
            }
        }
    }
    __syncthreads();
    float* sD = (float*)(lds + GU_SQ);
    if (wave < 4) {
        if (lane < 16) {
            float d[16];
#pragma unroll
            for (int i = 0; i < 16; ++i) {
                float a = (i == lane) ? 1.f : 0.f;
                const float* Ai = sA + (16 * wave + i) * GU_LDA + 16 * wave;
#pragma unroll
                for (int j = 0; j < i; ++j) a -= Ai[j] * d[j];
                d[i] = a;
                sD[(wave * 16 + i) * 16 + lane] = a;
            }
        }
    } else {
        bf16_t* att = (bf16_t*)(p.ws + WS_ATT) + (size_t)u * 64 * 64;
        for (int t = tid - 256; t < 512; t += 256) {
            const int i = t >> 3, kk2 = (t >> 2) & 1, qq = t & 3;
            const float4 lo = *(const float4*)(sAT + i * GU_LDA + 32 * kk2 + 4 * qq), hi = *(const float4*)(sAT + i * GU_LDA + 32 * kk2 + 16 + 4 * qq);
            uint4 o; o.x = pack2(lo.x, lo.y); o.y = pack2(lo.z, lo.w); o.z = pack2(hi.x, hi.y); o.w = pack2(hi.z, hi.w);
            *(uint4*)(att + i * 64 + 32 * kk2 + 8 * qq) = o;
        }
    }
    __syncthreads();
    if (wave < 4) {
        const int rr = lane & 15, q4 = lane >> 4;
        f32x4 Tt[4];
#pragma unroll
        for (int m = 0; m < 4; ++m) Tt[m] = (f32x4){0.f, 0.f, 0.f, 0.f};
#pragma unroll
        for (int b = 0; b < 4; ++b) {
            if (b >= wave) {
                f32x4 X = (f32x4){0.f, 0.f, 0.f, 0.f};
#pragma unroll
                for (int kk = 0; kk < 2; ++kk) {
                    if (2 * kk < b) {
                        const float* Ar = sA + (16 * b + rr) * GU_LDA + 32 * kk + 4 * q4;
                        const float4 lo = *(const float4*)Ar;
                        float4 hi = make_float4(0.f, 0.f, 0.f, 0.f);
                        if (2 * kk + 1 < b) hi = *(const float4*)(Ar + 16);
                        const u32x4 ap = {pack2(lo.x, lo.y), pack2(lo.z, lo.w), pack2(hi.x, hi.y), pack2(hi.z, hi.w)};
                        const u32x4 bp = {pack2(Tt[2 * kk][0], Tt[2 * kk][1]), pack2(Tt[2 * kk][2], Tt[2 * kk][3]),
                                          pack2(Tt[2 * kk + 1][0], Tt[2 * kk + 1][1]), pack2(Tt[2 * kk + 1][2], Tt[2 * kk + 1][3])};
                        X = __builtin_amdgcn_mfma_f32_16x16x32_bf16(__builtin_bit_cast(bf16x8, ap), __builtin_bit_cast(bf16x8, bp), X, 0, 0, 0);
                    }
                }
                float y[4];
#pragma unroll
                for (int jj = 0; jj < 4; ++jj) y[jj] = ((b == wave && 4 * q4 + jj == rr) ? 1.f : 0.f) - X[jj];
                const float4 dv4 = *(const float4*)(sD + (b * 16 + rr) * 16 + 4 * q4);
                const u32x4 ap = {pack2(dv4.x, dv4.y), pack2(dv4.z, dv4.w), 0u, 0u};
                const u32x4 bp = {pack2(y[0], y[1]), pack2(y[2], y[3]), 0u, 0u};
                const f32x4 z4 = (f32x4){0.f, 0.f, 0.f, 0.f};
                Tt[b] = __builtin_amdgcn_mfma_f32_16x16x32_bf16(__builtin_bit_cast(bf16x8, ap), __builtin_bit_cast(bf16x8, bp), z4, 0, 0, 0);
            }
#pragma unroll
            for (int jj = 0; jj < 4; ++jj) sT[(16 * b + 4 * q4 + jj) * GU_LDT + 16 * wave + rr] = f2bf(Tt[b][jj]);
        }
    }
    __syncthreads();
    {
        const int rr = lane & 15, q4 = lane >> 4;
        bf16_t* ut = (bf16_t*)(p.ws + WS_UT) + (size_t)u * 128 * 64;
        bf16_t* wg = (bf16_t*)(p.ws + WS_W) + (size_t)u * 64 * 128;
        f32x4 au[4], aw[4];
#pragma unroll
        for (int m = 0; m < 4; ++m) { au[m] = (f32x4){0.f, 0.f, 0.f, 0.f}; aw[m] = (f32x4){0.f, 0.f, 0.f, 0.f}; }
#pragma unroll
        for (int kk2 = 0; kk2 < 2; ++kk2) {
            const bf16x8 bv = *(const bf16x8*)(sVBT + (16 * wave + rr) * GU_LDT + kk2 * 32 + 8 * q4);
            const bf16x8 ak = *(const bf16x8*)(sKGT + (16 * wave + rr) * GU_LDT + kk2 * 32 + 8 * q4);
#pragma unroll
            for (int m = 0; m < 4; ++m) {
                const bf16x8 tf = *(const bf16x8*)(sT + (16 * m + rr) * GU_LDT + kk2 * 32 + 8 * q4);
                au[m] = __builtin_amdgcn_mfma_f32_16x16x32_bf16(tf, bv, au[m], 0, 0, 0);
                aw[m] = __builtin_amdgcn_mfma_f32_16x16x32_bf16(ak, tf, aw[m], 0, 0, 0);
            }
        }
#pragma unroll
        for (int m = 0; m < 4; ++m) {
            uint2 o; o.x = pack2(au[m][0], au[m][1]); o.y = pack2(au[m][2], au[m][3]);
            *(uint2*)(ut + (size_t)(16 * wave + rr) * 64 + 16 * m + 4 * q4) = o;
            uint2 w2; w2.x = pack2(aw[m][0], aw[m][1]); w2.y = pack2(aw[m][2], aw[m][3]);
            *(uint2*)(wg + (size_t)(16 * m + rr) * 128 + 32 * (wave >> 1) + 8 * q4 + 4 * (wave & 1)) = w2;
        }
    }
}

constexpr int GS_SW = 0, GS_SQD = 17408, GS_SKDT = 34816, GS_SATT = 53248, GS_BUF = 62464;
typedef unsigned u32x2 __attribute__((ext_vector_type(2)));
__device__ __forceinline__ int gdn_chain_chunk(int dir, int s) { return dir == 0 ? (s < 4 ? NCH_LAT + s : s - 4) : NCH - 1 - s; }
struct GsG1 { u32x4 w[2]; u32x4 att; };
struct GsG2 { u32x2 qlo[2], qhi[2]; float gq[2]; };
struct GsG3 { u32x4 kd[2]; float gk[2]; float gl; u32x2 ut[4]; };
__device__ __forceinline__ void gs_load1(const Params& p, int dh, int c, GsG1& st) {
    const int tid = tid_(); const size_t u = (size_t)dh * NCH + c;
    const bf16_t* wg = (const bf16_t*)(p.ws + WS_W) + u * 64 * 128; const bf16_t* att = (const bf16_t*)(p.ws + WS_ATT) + u * 64 * 64;
#pragma unroll
    for (int q = 0; q < 2; ++q) { const int t = tid + q * NTHREADS; st.w[q] = *(const u32x4*)(wg + (size_t)(t >> 4) * 128 + (t & 15) * 8); }
    st.att = *(const u32x4*)(att + (size_t)(tid >> 3) * 64 + (tid & 7) * 8);
}
__device__ __forceinline__ void gs_store1(const GsG1& st, unsigned char* buf) {
    const int tid = tid_(); bf16_t* sW = (bf16_t*)(buf + GS_SW); bf16_t* sATT = (bf16_t*)(buf + GS_SATT);
#pragma unroll
    for (int q = 0; q < 2; ++q) { const int t = tid + q * NTHREADS; *(u32x4*)(sW + (t >> 4) * GU_LDQ + (t & 15) * 8) = st.w[q]; }
    *(u32x4*)(sATT + (tid >> 3) * GU_LDT + (tid & 7) * 8) = st.att;
}
__device__ __forceinline__ void gs_load2(const Params& p, int dh, int c, GsG2& st) {
    const int tid = tid_(), dir = dh >> 3, head = dh & 7; const size_t u = (size_t)dh * NCH + c;
    const float* gc = (const float*)(p.ws + WS_GC) + u * 64; const bf16_t* qn = (const bf16_t*)(p.ws + WS_QN);
#pragma unroll
    for (int q = 0; q < 2; ++q) {
        const int t = tid + q * NTHREADS, i = t >> 4, kk = (t >> 2) & 3, qq = t & 3;
        const bf16_t* src = qn + (size_t)(c * 64 + (dir ? 63 - i : i)) * 1024 + head * 128 + 32 * kk + 4 * qq;
        st.qlo[q] = *(const u32x2*)src; st.qhi[q] = *(const u32x2*)(src + 16); st.gq[q] = gc[i];
    }
}
__device__ __forceinline__ void gs_store2(const GsG2& st, unsigned char* buf) {
    const int tid = tid_(); bf16_t* sQD = (bf16_t*)(buf + GS_SQD);
#pragma unroll
    for (int q = 0; q < 2; ++q) {
        const int t = tid + q * NTHREADS, i = t >> 4, kk = (t >> 2) & 3, qq = t & 3; const float e = __expf(st.gq[q]);
        u32x4 o; o.x = pack2(lo2f(st.qlo[q].x) * e, hi2f(st.qlo[q].x) * e); o.y = pack2(lo2f(st.qlo[q].y) * e, hi2f(st.qlo[q].y) * e);
        o.z = pack2(lo2f(st.qhi[q].x) * e, hi2f(st.qhi[q].x) * e); o.w = pack2(lo2f(st.qhi[q].y) * e, hi2f(st.qhi[q].y) * e);
        *(u32x4*)(sQD + i * GU_LDQ + 32 * kk + 8 * qq) = o;
    }
}
__device__ __forceinline__ void gs_load3(const Params& p, int dh, int c, GsG3& st) {
    const int tid = tid_(), lane = tid & 63, wave = tid >> 6, dir = dh >> 3, head = dh & 7; const size_t u = (size_t)dh * NCH + c;
    const float* gc = (const float*)(p.ws + WS_GC) + u * 64; const bf16_t* kn = (const bf16_t*)(p.ws + WS_KN);
    st.gl = gc[63];
#pragma unroll
    for (int q = 0; q < 2; ++q) {
        const int t = tid + q * NTHREADS, pos = t >> 4, d8 = (t & 15) * 8;
        st.kd[q] = *(const u32x4*)(kn + (size_t)(c * 64 + (dir ? 63 - pos : pos)) * 1024 + head * 128 + d8); st.gk[q] = gc[pos];
    }
    const bf16_t* ut = (const bf16_t*)(p.ws + WS_UT) + u * 128 * 64 + (size_t)(16 * wave + (lane & 15)) * 64 + 4 * (lane >> 4);
#pragma unroll
    for (int m = 0; m < 4; ++m) st.ut[m] = *(const u32x2*)(ut + 16 * m);
}
__device__ __forceinline__ void gs_store3(const GsG3& st, unsigned char* buf) {
    const int tid = tid_(); bf16_t* sKDT = (bf16_t*)(buf + GS_SKDT);
#pragma unroll
    for (int q = 0; q < 2; ++q) {
        const int t = tid + q * NTHREADS, pos = t >> 4, d8 = (t & 15) * 8; const float e = __expf(st.gl - st.gk[q]);
        const u32x4 kq = st.kd[q]; const int sl = perm_slot64(pos);
        sKDT[(d8 + 0) * GU_LDT + sl] = f2bf(lo2f(kq.x) * e); sKDT[(d8 + 1) * GU_LDT + sl] = f2bf(hi2f(kq.x) * e);
        sKDT[(d8 + 2) * GU_LDT + sl] = f2bf(lo2f(kq.y) * e); sKDT[(d8 + 3) * GU_LDT + sl] = f2bf(hi2f(kq.y) * e);
        sKDT[(d8 + 4) * GU_LDT + sl] = f2bf(lo2f(kq.z) * e); sKDT[(d8 + 5) * GU_LDT + sl] = f2bf(hi2f(kq.z) * e);
        sKDT[(d8 + 6) * GU_LDT + sl] = f2bf(lo2f(kq.w) * e); sKDT[(d8 + 7) * GU_LDT + sl] = f2bf(hi2f(kq.w) * e);
    }
}
__device__ __forceinline__ void gdn_seg_ab(const Params& p, int dh, int k, unsigned char* lds) {
    const int tid = tid_(), lane = tid & 63, wave = tid >> 6, rr = lane & 15, q4 = lane >> 4, dir = dh >> 3;
    const bool first = (k == 0);
    const int s_begin = first ? 0 : 4 + 16 * k, nsteps = first ? 20 : 16;
    f32x4 ScB[8], ScA[8]; bf16x8 SbB[4], SbA[4];
#pragma unroll
    for (int m = 0; m < 8; ++m) {
        ScB[m] = (f32x4){0.f, 0.f, 0.f, 0.f};
#pragma unroll
        for (int jj = 0; jj < 4; ++jj) ScA[m][jj] = (16 * m + 4 * q4 + jj == 16 * wave + rr) ? 1.f : 0.f;
    }
#pragma unroll
    for (int kk = 0; kk < 4; ++kk) {
        SbB[kk] = (bf16x8){0, 0, 0, 0, 0, 0, 0, 0};
        const u32x4 pk = {pack2(ScA[2 * kk][0], ScA[2 * kk][1]), pack2(ScA[2 * kk][2], ScA[2 * kk][3]),
                          pack2(ScA[2 * kk + 1][0], ScA[2 * kk + 1][1]), pack2(ScA[2 * kk + 1][2], ScA[2 * kk + 1][3])};
        SbA[kk] = __builtin_bit_cast(bf16x8, pk);
    }
    u32x2 ucur[4]; float glcur;
    float4* sin_img = (float4*)(p.ws + WS_SIN) + (size_t)(dh * 16) * 4096;
    __syncthreads();
    {
        const int c0 = gdn_chain_chunk(dir, s_begin);
        GsG1 g1; gs_load1(p, dh, c0, g1); gs_store1(g1, lds);
        GsG3 g3; gs_load3(p, dh, c0, g3); gs_store3(g3, lds);
#pragma unroll
        for (int m = 0; m < 4; ++m) ucur[m] = g3.ut[m];
        glcur = g3.gl;
    }
    __syncthreads();
#pragma unroll 1
    for (int t = 0; t < nsteps; ++t) {
        const int s = s_begin + t;
        const int cn = gdn_chain_chunk(dir, t + 1 < nsteps ? s + 1 : s);
        const unsigned char* buf = lds + (t & 1) * GS_BUF; unsigned char* nbuf = lds + ((t + 1) & 1) * GS_BUF;
        const bf16_t* sW = (const bf16_t*)(buf + GS_SW); const bf16_t* sKDT = (const bf16_t*)(buf + GS_SKDT);
        GsG1 g1; gs_load1(p, dh, cn, g1);
        f32x4 vb_[4], va_[4];
#pragma unroll
        for (int m = 0; m < 4; ++m) {
            f32x4 accb = (f32x4){0.f, 0.f, 0.f, 0.f}, acca = (f32x4){0.f, 0.f, 0.f, 0.f};
#pragma unroll
            for (int kk = 0; kk < 4; ++kk) {
                const bf16x8 a = *(const bf16x8*)(sW + (16 * m + rr) * GU_LDQ + kk * 32 + 8 * q4);
                accb = __builtin_amdgcn_mfma_f32_16x16x32_bf16(a, SbB[kk], accb, 0, 0, 0);
                if (!first) acca = __builtin_amdgcn_mfma_f32_16x16x32_bf16(a, SbA[kk], acca, 0, 0, 0);
            }
            vb_[m][0] = lo2f(ucur[m].x) - accb[0]; vb_[m][1] = hi2f(ucur[m].x) - accb[1]; vb_[m][2] = lo2f(ucur[m].y) - accb[2]; vb_[m][3] = hi2f(ucur[m].y) - accb[3];
            va_[m] = -acca;
        }
        bf16x8 VBb[2], VBa[2];
#pragma unroll
        for (int k2 = 0; k2 < 2; ++k2) {
            const u32x4 pb = {pack2(vb_[2 * k2][0], vb_[2 * k2][1]), pack2(vb_[2 * k2][2], vb_[2 * k2][3]), pack2(vb_[2 * k2 + 1][0], vb_[2 * k2 + 1][1]), pack2(vb_[2 * k2 + 1][2], vb_[2 * k2 + 1][3])};
            const u32x4 pa = {pack2(va_[2 * k2][0], va_[2 * k2][1]), pack2(va_[2 * k2][2], va_[2 * k2][3]), pack2(va_[2 * k2 + 1][0], va_[2 * k2 + 1][1]), pack2(va_[2 * k2 + 1][2], va_[2 * k2 + 1][3])};
            VBb[k2] = __builtin_bit_cast(bf16x8, pb); VBa[k2] = __builtin_bit_cast(bf16x8, pa);
        }
        gs_store1(g1, nbuf);
        GsG3 g3; gs_load3(p, dh, cn, g3);
        const float egl = __expf(glcur);
#pragma unroll
        for (int m = 0; m < 8; ++m) {
            f32x4 accb = ScB[m] * egl, acca = ScA[m] * egl;
#pragma unroll
            for (int k2 = 0; k2 < 2; ++k2) {
                const bf16x8 a = *(const bf16x8*)(sKDT + (16 * m + rr) * GU_LDT + k2 * 32 + 8 * q4);
                accb = __builtin_amdgcn_mfma_f32_16x16x32_bf16(a, VBb[k2], accb, 0, 0, 0);
                if (!first) acca = __builtin_amdgcn_mfma_f32_16x16x32_bf16(a, VBa[k2], acca, 0, 0, 0);
            }
            ScB[m] = accb; ScA[m] = acca;
        }
#pragma unroll
        for (int kk = 0; kk < 4; ++kk) {
            const u32x4 pb = {pack2(ScB[2 * kk][0], ScB[2 * kk][1]), pack2(ScB[2 * kk][2], ScB[2 * kk][3]), pack2(ScB[2 * kk + 1][0], ScB[2 * kk + 1][1]), pack2(ScB[2 * kk + 1][2], ScB[2 * kk + 1][3])};
            const u32x4 pa = {pack2(ScA[2 * kk][0], ScA[2 * kk][1]), pack2(ScA[2 * kk][2], ScA[2 * kk][3]), pack2(ScA[2 * kk + 1][0], ScA[2 * kk + 1][1]), pack2(ScA[2 * kk + 1][2], ScA[2 * kk + 1][3])};
            SbB[kk] = __builtin_bit_cast(bf16x8, pb); SbA[kk] = __builtin_bit_cast(bf16x8, pa);
        }
        gs_store3(g3, nbuf);
#pragma unroll
        for (int m = 0; m < 4; ++m) ucur[m] = g3.ut[m];
        glcur = g3.gl;
        if (first && t == 3) {
#pragma unroll
            for (int m = 0; m < 8; ++m) sin_img[(wave * 8 + m) * 64 + lane] = make_float4(ScB[m][0], ScB[m][1], ScB[m][2], ScB[m][3]);
        }
        __syncthreads();
    }
    if (first) {
#pragma unroll
        for (int m = 0; m < 8; ++m) sin_img[4096 + (wave * 8 + m) * 64 + lane] = make_float4(ScB[m][0], ScB[m][1], ScB[m][2], ScB[m][3]);
    } else {
        float4* bimg = (float4*)(p.ws + WS_BSEG) + (size_t)(dh * 16 + k) * 4096;
        bf16_t* aseg = (bf16_t*)(p.ws + WS_ASEG) + (size_t)(dh * 16 + k) * 128 * 128;
        const int pc = perm_slot64(16 * wave + rr);
#pragma unroll
        for (int m = 0; m < 8; ++m) {
            bimg[(wave * 8 + m) * 64 + lane] = make_float4(ScB[m][0], ScB[m][1], ScB[m][2], ScB[m][3]);
#pragma unroll
            for (int jj = 0; jj < 4; ++jj) aseg[(size_t)(16 * m + 4 * q4 + jj) * 128 + pc] = f2bf(ScA[m][jj]);
        }
    }
}
__device__ __forceinline__ void gdn_seg_chain(const Params& p, int dh, unsigned char* lds) {
    const int tid = tid_(), lane = tid & 63, wave = tid >> 6, rr = lane & 15, q4 = lane >> 4;
    float4* sin_img = (float4*)(p.ws + WS_SIN) + (size_t)(dh * 16) * 4096;
    const float4* bimg = (const float4*)(p.ws + WS_BSEG) + (size_t)(dh * 16) * 4096;
    const bf16_t* aseg = (const bf16_t*)(p.ws + WS_ASEG) + (size_t)(dh * 16) * 128 * 128;
    f32x4 Sc[8]; bf16x8 Sb[4];
#pragma unroll
    for (int m = 0; m < 8; ++m) { const float4 v = sin_img[4096 + (wave * 8 + m) * 64 + lane]; Sc[m] = (f32x4){v.x, v.y, v.z, v.w}; }
    u32x4 ar[4];
    __syncthreads();
#pragma unroll
    for (int q = 0; q < 4; ++q) { const int t = tid + q * NTHREADS; ar[q] = *(const u32x4*)(aseg + (size_t)1 * 16384 + (size_t)(t >> 4) * 128 + (t & 15) * 8); }
#pragma unroll
    for (int q = 0; q < 4; ++q) { const int t = tid + q * NTHREADS; *(u32x4*)((bf16_t*)lds + (t >> 4) * GU_LDQ + (t & 15) * 8) = ar[q]; }
    __syncthreads();
#pragma unroll 1
    for (int k = 1; k <= 14; ++k) {
        const bf16_t* sA = (const bf16_t*)(lds + ((k - 1) & 1) * 34816);
        if (k < 14) {
#pragma unroll
            for (int q = 0; q < 4; ++q) { const int t = tid + q * NTHREADS; ar[q] = *(const u32x4*)(aseg + (size_t)(k + 1) * 16384 + (size_t)(t >> 4) * 128 + (t & 15) * 8); }
        }
#pragma unroll
        for (int kk = 0; kk < 4; ++kk) {
            const u32x4 pk = {pack2(Sc[2 * kk][0], Sc[2 * kk][1]), pack2(Sc[2 * kk][2], Sc[2 * kk][3]), pack2(Sc[2 * kk + 1][0], Sc[2 * kk + 1][1]), pack2(Sc[2 * kk + 1][2], Sc[2 * kk + 1][3])};
            Sb[kk] = __builtin_bit_cast(bf16x8, pk);
        }
#pragma unroll
        for (int m = 0; m < 8; ++m) {
            const float4 bv = bimg[(size_t)k * 4096 + (wave * 8 + m) * 64 + lane];
            f32x4 acc = (f32x4){bv.x, bv.y, bv.z, bv.w};
#pragma unroll
            for (int kk = 0; kk < 4; ++kk)
                acc = __builtin_amdgcn_mfma_f32_16x16x32_bf16(*(const bf16x8*)(sA + (16 * m + rr) * GU_LDQ + kk * 32 + 8 * q4), Sb[kk], acc, 0, 0, 0);
            Sc[m] = acc;
            sin_img[(size_t)(k + 1) * 4096 + (wave * 8 + m) * 64 + lane] = make_float4(acc[0], acc[1], acc[2], acc[3]);
        }
        if (k < 14) {
#pragma unroll
            for (int q = 0; q < 4; ++q) { const int t = tid + q * NTHREADS; *(u32x4*)((bf16_t*)(lds + (k & 1) * 34816) + (t >> 4) * GU_LDQ + (t & 15) * 8) = ar[q]; }
        }
        __syncthreads();
    }
}
__device__ __forceinline__ void gdn_seq(const Params& p, int dh, int k, unsigned char* lds) {
    const int tid = tid_(), lane = tid & 63, wave = tid >> 6, rr = lane & 15, q4 = lane >> 4, dir = dh >> 3, head = dh & 7;
    const int s_begin = 4 + 16 * k;
    f32x4 Sc[8]; bf16x8 Sb[4];
    {
        const float4* sin_img = (const float4*)(p.ws + WS_SIN) + (size_t)(dh * 16 + k) * 4096;
#pragma unroll
        for (int m = 0; m < 8; ++m) { const float4 v = sin_img[(wave * 8 + m) * 64 + lane]; Sc[m] = (f32x4){v.x, v.y, v.z, v.w}; }
#pragma unroll
        for (int kk = 0; kk < 4; ++kk) {
            const u32x4 pk = {pack2(Sc[2 * kk][0], Sc[2 * kk][1]), pack2(Sc[2 * kk][2], Sc[2 * kk][3]), pack2(Sc[2 * kk + 1][0], Sc[2 * kk + 1][1]), pack2(Sc[2 * kk + 1][2], Sc[2 * kk + 1][3])};
            Sb[kk] = __builtin_bit_cast(bf16x8, pk);
        }
    }
    u32x2 ucur[4]; float glcur;
    __syncthreads();
    {
        const int c0 = gdn_chain_chunk(dir, s_begin);
        GsG1 g1; gs_load1(p, dh, c0, g1); gs_store1(g1, lds);
        GsG2 g2; gs_load2(p, dh, c0, g2); gs_store2(g2, lds);
        GsG3 g3; gs_load3(p, dh, c0, g3); gs_store3(g3, lds);
#pragma unroll
        for (int m = 0; m < 4; ++m) ucur[m] = g3.ut[m];
        glcur = g3.gl;
    }
    __syncthreads();
    bf16_t* of = (bf16_t*)(p.ws + WS_OF) + (size_t)dir * SEQ * 1024;
#pragma unroll 1
    for (int t = 0; t < 16; ++t) {
        const int s = s_begin + t;
        const int c = gdn_chain_chunk(dir, s);
        const int cn = gdn_chain_chunk(dir, t + 1 < 16 ? s + 1 : s);
        const unsigned char* buf = lds + (t & 1) * GS_BUF; unsigned char* nbuf = lds + ((t + 1) & 1) * GS_BUF;
        const bf16_t* sW = (const bf16_t*)(buf + GS_SW); const bf16_t* sQD = (const bf16_t*)(buf + GS_SQD);
        const bf16_t* sKDT = (const bf16_t*)(buf + GS_SKDT); const bf16_t* sATT = (const bf16_t*)(buf + GS_SATT);
        GsG1 g1; gs_load1(p, dh, cn, g1);
        f32x4 vn[4];
#pragma unroll
        for (int m = 0; m < 4; ++m) {
            f32x4 acc = (f32x4){0.f, 0.f, 0.f, 0.f};
#pragma unroll
            for (int kk = 0; kk < 4; ++kk)
                acc = __builtin_amdgcn_mfma_f32_16x16x32_bf16(*(const bf16x8*)(sW + (16 * m + rr) * GU_LDQ + kk * 32 + 8 * q4), Sb[kk], acc, 0, 0, 0);
            vn[m][0] = lo2f(ucur[m].x) - acc[0]; vn[m][1] = hi2f(ucur[m].x) - acc[1]; vn[m][2] = lo2f(ucur[m].y) - acc[2]; vn[m][3] = hi2f(ucur[m].y) - acc[3];
        }
        bf16x8 VB[2];
#pragma unroll
        for (int k2 = 0; k2 < 2; ++k2) {
            const unsigned a0 = pack2(vn[2 * k2][0], vn[2 * k2][1]), a1 = pack2(vn[2 * k2][2], vn[2 * k2][3]);
            const unsigned a2 = pack2(vn[2 * k2 + 1][0], vn[2 * k2 + 1][1]), a3 = pack2(vn[2 * k2 + 1][2], vn[2 * k2 + 1][3]);
            const u32x4 pk = {a0, a1, a2, a3}; VB[k2] = __builtin_bit_cast(bf16x8, pk);
        }
        gs_store1(g1, nbuf);
        GsG2 g2; gs_load2(p, dh, cn, g2);
#pragma unroll
        for (int m = 0; m < 4; ++m) {
            f32x4 acc = (f32x4){0.f, 0.f, 0.f, 0.f};
#pragma unroll
            for (int kk = 0; kk < 4; ++kk)
                acc = __builtin_amdgcn_mfma_f32_16x16x32_bf16(*(const bf16x8*)(sQD + (16 * m + rr) * GU_LDQ + kk * 32 + 8 * q4), Sb[kk], acc, 0, 0, 0);
#pragma unroll
            for (int k2 = 0; k2 < 2; ++k2)
                acc = __builtin_amdgcn_mfma_f32_16x16x32_bf16(*(const bf16x8*)(sATT + (16 * m + rr) * GU_LDT + k2 * 32 + 8 * q4), VB[k2], acc, 0, 0, 0);
#pragma unroll
            for (int jj = 0; jj < 4; ++jj) {
                const int pos = 16 * m + 4 * q4 + jj;
                of[(size_t)(c * 64 + (dir ? 63 - pos : pos)) * 1024 + head * 128 + 16 * wave + rr] = f2bf(acc[jj]);
            }
        }
        gs_store2(g2, nbuf);
        GsG3 g3; gs_load3(p, dh, cn, g3);
        const float egl = __expf(glcur);
#pragma unroll
        for (int m = 0; m < 8; ++m) {
            f32x4 acc = Sc[m] * egl;
#pragma unroll
            for (int k2 = 0; k2 < 2; ++k2)
                acc = __builtin_amdgcn_mfma_f32_16x16x32_bf16(*(const bf16x8*)(sKDT + (16 * m + rr) * GU_LDT + k2 * 32 + 8 * q4), VB[k2], acc, 0, 0, 0);
            Sc[m] = acc;
        }
#pragma unroll
        for (int kk = 0; kk < 4; ++kk) {
            const u32x4 pk = {pack2(Sc[2 * kk][0], Sc[2 * kk][1]), pack2(Sc[2 * kk][2], Sc[2 * kk][3]),
                              pack2(Sc[2 * kk + 1][0], Sc[2 * kk + 1][1]), pack2(Sc[2 * kk + 1][2], Sc[2 * kk + 1][3])};
            Sb[kk] = __builtin_bit_cast(bf16x8, pk);
        }
        gs_store3(g3, nbuf);
#pragma unroll
        for (int m = 0; m < 4; ++m) ucur[m] = g3.ut[m];
        glcur = g3.gl;
        __syncthreads();
    }
}

__device__ __forceinline__ void gdn_readout_row(const Params& p, int row) {
    const int lane = tid_() & 63, head = lane >> 3, d0 = (lane & 7) * 16;
    const bf16_t* of0 = (const bf16_t*)(p.ws + WS_OF) + (size_t)row * 1024 + head * 128 + d0;
    const bf16_t* of1 = of0 + (size_t)SEQ * 1024;
    const bf16_t* zp = (const bf16_t*)(p.ws + WS_Z) + (size_t)row * 1024 + head * 128 + d0;
    float a[16], b[16], z[16];
    unpack8(*(const uint4*)of0, a); unpack8(*(const uint4*)(of0 + 8), a + 8);
    unpack8(*(const uint4*)of1, b); unpack8(*(const uint4*)(of1 + 8), b + 8);
    unpack8(*(const uint4*)zp, z); unpack8(*(const uint4*)(zp + 8), z + 8);
    float ss = 0.f;
#pragma unroll
    for (int e = 0; e < 16; ++e) { a[e] += b[e]; ss += a[e] * a[e]; }
    ss += __shfl_xor(ss, 1, 64); ss += __shfl_xor(ss, 2, 64); ss += __shfl_xor(ss, 4, 64);
    const float rs = rsqrtf(ss * (1.f / 128.f) + 1e-6f);
    const float* ng = p.in[25] + d0;
    float f[16];
#pragma unroll
    for (int e = 0; e < 16; ++e) f[e] = a[e] * rs * ng[e] * siluf_(z[e]);
    bf16_t* dst = (bf16_t*)(p.ws + WS_VN) + (size_t)row * 1024 + head * 128 + d0;
    *(uint4*)dst = pack8(f); *(uint4*)(dst + 8) = pack8(f + 8);
}

#define XB_TMO      128
#define XB_XCNT(j)  (256  + 64 * (j))
#define XB_XSUB(j)  (1280 + 64 * (j))
#define XB_XGEN(j)  (2304 + 64 * (j))
#define XB_TOP      3328
#define XB_TOPGEN   3392
#define XCD_BAR_WORDS 3456
#define XB_SPIN_CAP (1u << 22)
#define LAS __attribute__((address_space(3)))
__device__ __forceinline__ unsigned xb_ld(unsigned* p)              { return __hip_atomic_load(p, __ATOMIC_RELAXED, __HIP_MEMORY_SCOPE_AGENT); }
__device__ __forceinline__ unsigned xb_add(unsigned* p, unsigned v) { return __hip_atomic_fetch_add(p, v, __ATOMIC_RELAXED, __HIP_MEMORY_SCOPE_AGENT); }
__device__ __forceinline__ unsigned xb_xcc_id() { return (unsigned)__builtin_amdgcn_s_getreg((3 << 11) | 20) & 0xFu; }
#define XB_SPIN(cond, bar) do { unsigned _sp = 0; while (cond) { __builtin_amdgcn_s_sleep(1); \
    if ((++_sp & 255u) == 0u) { if (xb_ld(&(bar)[XB_TMO])) break; if (_sp > XB_SPIN_CAP) { atomicAdd(&(bar)[XB_TMO], 1u); break; } } } } while (0)
struct XcdBarrier { unsigned* bar; unsigned x; volatile LAS unsigned* st; };
__device__ __forceinline__ XcdBarrier xcd_barrier_post(unsigned* bar, volatile LAS unsigned* st) {
    XcdBarrier b; b.bar = bar; b.x = xb_xcc_id(); b.st = st;
    if (threadIdx.x == 0) (void)xb_add(&bar[XB_XCNT(b.x)], 1u);
    return b;
}
__device__ __forceinline__ void xcd_barrier_complete(unsigned* bar, unsigned x, unsigned& nloc, unsigned& nx) {
    const unsigned G = gridDim.x * gridDim.y * gridDim.z;
    unsigned sum, cnt, mine, sp = 0u;
    for (;;) {
        sum = 0u; cnt = 0u; mine = 0u;
#pragma unroll
        for (unsigned j = 0; j < 16; ++j) { const unsigned c = xb_ld(&bar[XB_XCNT(j)]); sum += c; cnt += (c > 0u) ? 1u : 0u; mine = (j == x) ? c : mine; }
        if (sum == G) break;
        __builtin_amdgcn_s_sleep(1);
        if ((++sp & 255u) == 0u) { if (xb_ld(&bar[XB_TMO])) break; if (sp > XB_SPIN_CAP) { atomicAdd(&bar[XB_TMO], 1u); break; } }
    }
    nloc = mine > 0u ? mine : 1u; nx = cnt > 0u ? cnt : 1u;
}
__device__ __forceinline__ void xcd_barrier(const XcdBarrier& b) {
    asm volatile("s_waitcnt vmcnt(0)" ::: "memory");
    __syncthreads();
    if (threadIdx.x == 0) {
        unsigned* bar = b.bar;
        __builtin_amdgcn_s_waitcnt(0);
        unsigned nloc = b.st[0], nx = b.st[1];
        if (nloc == 0u) { xcd_barrier_complete(bar, b.x, nloc, nx); b.st[0] = nloc; b.st[1] = nx; }
        const unsigned old = xb_add(&bar[XB_XSUB(b.x)], 1u);
        const unsigned gen = old / nloc;
        if (old + 1u == (gen + 1u) * nloc) {
            __builtin_amdgcn_fence(__ATOMIC_RELEASE, "agent");
            asm volatile("s_waitcnt vmcnt(0)" ::: "memory");
            const unsigned og = xb_add(&bar[XB_TOP], 1u);
            const unsigned tg = og / nx;
            if (og + 1u == (tg + 1u) * nx) xb_add(&bar[XB_TOPGEN], 1u);
            else XB_SPIN(xb_ld(&bar[XB_TOPGEN]) == tg, bar);
            __builtin_amdgcn_fence(__ATOMIC_ACQUIRE, "agent");
            xb_add(&bar[XB_XGEN(b.x)], 1u);
            asm volatile("s_waitcnt vmcnt(0)" ::: "memory");
        } else {
            XB_SPIN(xb_ld(&bar[XB_XGEN(b.x)]) == gen, bar);
            __builtin_amdgcn_fence(__ATOMIC_ACQUIRE, "agent");
            asm volatile("s_waitcnt vmcnt(0)" ::: "memory");
        }
    }
    __syncthreads();
}

#ifndef PHMASK
#define PHMASK 0xFFFFFFFFull
#endif
#define PH(n) (((PHMASK) >> (n)) & 1ull)
#define FOR_ITEMS(n) for (int item = blockIdx.x; item < (n); item += gridDim.x)
__global__ void __launch_bounds__(NTHREADS) fwd_megakernel(Params p) {
    extern __shared__ __attribute__((aligned(16))) unsigned char lds[];
    cg::grid_group grid = cg::this_grid();
    unsigned char* ws = p.ws;
    volatile LAS unsigned* xbst = (volatile LAS unsigned*)(LAS unsigned char*)(lds + LDS_BYTES - 16);
    if (threadIdx.x == 0) { xbst[0] = 0u; xbst[1] = 0u; }
    __syncthreads();
    const XcdBarrier xbar = xcd_barrier_post((unsigned*)(ws + WS_BAR), xbst);

    if (PH(0)) {
        constexpr int N_S5 = 64, N_ADA = 192, N_T0 = 512, N_T1 = 64, N_T2 = 256, N_T3 = 16 * 65, N_T4 = 256, N_T5 = 512, N_T6 = 512, N_SK = 16, N_PT = 8192;
        constexpr int O1 = N_S5, O2 = O1 + N_ADA, O3 = O2 + N_T0, O4 = O3 + N_T1, O5 = O4 + N_T2, O6 = O5 + N_T3, O7 = O6 + N_T4, O8 = O7 + N_T5, O9 = O8 + N_T6, O10 = O9 + N_SK, O11 = O10 + N_PT;
        FOR_ITEMS(O11) {
            if (item < O1) p0_s5_tables(p, item, lds);
            else if (item < O2) p0_adaln(p, item - O1, lds);
            else if (item < O3) p0_transpose(p.in[8], 1024, 2048, (bf16_t*)(ws + WS_WEIN), item - O2, lds);
            else if (item < O4) p0_transpose(p.in[18], 512, 512, (bf16_t*)(ws + WS_WGLU), item - O3, lds);
            else if (item < O5) p0_transpose(p.in[20], 1024, 1024, (bf16_t*)(ws + WS_WEOUT), item - O4, lds);
            else if (item < O6) p0_transpose(p.in[21], 1024, ODD_IN, (bf16_t*)(ws + WS_WOIN), item - O5, lds);
            else if (item < O7) p0_transpose(p.in[26], 1024, 1024, (bf16_t*)(ws + WS_WOOUT), item - O6, lds);
            else if (item < O8) p0_transpose(p.in[27], 1024, 2048, (bf16_t*)(ws + WS_WQ0), item - O7, lds);
            else if (item < O9) p0_transpose(p.in[27] + (size_t)1024 * 2048, 1024, 2048, (bf16_t*)(ws + WS_WQ1), item - O8, lds);
            else if (item < O10) cvt_chunk(p.in[28], (bf16_t*)(ws + WS_SK), item - O9);
            else { const int q = item - O10; cvt_chunk(q < 4096 ? p.in[29] : p.in[30], (bf16_t*)(ws + WS_PUV) + (q < 4096 ? 0 : (size_t)16384 * 1024), q & 4095); }
        }
    }
    grid.sync();
    if (PH(1)) FOR_ITEMS(2080 + 2048) {
        if (item < 2080) norm_rows_item(p, item, 0, p.in[6], 0, true);
        else s5_mintra_item(p, item - 2080);
    }
    xcd_barrier(xbar);
    if (PH(2)) FOR_ITEMS(130 * 16) {
        EpiEvenIn e{(bf16_t*)(ws + WS_PA), (bf16_t*)(ws + WS_UG)};
        gemm_tile((const bf16_t*)(ws + WS_ACT), 1024, R, (const bf16_t*)(ws + WS_WEIN), 1024, 2048, 1024, (item >> 4) * 128, (item & 15) * 128, e, lds);
    }
    xcd_barrier(xbar);
    if (PH(3)) FOR_ITEMS(32 * 30) {
        const int g = item / 30, r = item % 30, tm = r / 10, tn = r % 10;
        EpiS5Local e{(float*)(ws + WS_YL), (float*)(ws + WS_LST), g};
        gemm_tile((const bf16_t*)(ws + WS_UG) + (size_t)g * NCH * 1024, 1024, NCH, (const bf16_t*)(ws + WS_MS5) + (size_t)g * 1280 * 1024, 1024, 1280, 1024, tm * 128, tn * 128, e, lds);
    }
    xcd_barrier(xbar);
    if (PH(4)) s5_scan(p);
    xcd_barrier(xbar);
    if (PH(5)) FOR_ITEMS(32 * 24) {
        const int g = item / 24, r = item % 24, tm = r / 8, tn = r % 8;
        EpiS5Out e{(const float*)(ws + WS_YL), (bf16_t*)(ws + WS_GS), g};
        gemm_tile((const bf16_t*)(ws + WS_A5) + (size_t)g * NCH * 256, 256, NCH, (const bf16_t*)(ws + WS_O5) + (size_t)g * 1024 * 256, 256, 1024, 256, tm * 128, tn * 128, e, lds);
    }
    xcd_barrier(xbar);
    if (PH(6)) FOR_ITEMS(130 * 4 + NCH) {
        if (item < 520) {
            EpiGlu e{(const bf16_t*)(ws + WS_GS), p.in[19], (bf16_t*)(ws + WS_CB)};
            gemm_tile((const bf16_t*)(ws + WS_GS), 512, R, (const bf16_t*)(ws + WS_WGLU), 512, 512, 512, (item >> 2) * 128, (item & 3) * 128, e, lds);
        } else even_conv_item(p, item - 520);
    }
    xcd_barrier(xbar);
    if (PH(7)) FOR_ITEMS(130 * 8) {
        EpiResid e{p.in[0], p.in[2], (float*)(ws + WS_H), (const float*)(ws + WS_MOD), 0, true};
        gemm_tile((const bf16_t*)(ws + WS_CB), 1024, R, (const bf16_t*)(ws + WS_WEOUT), 1024, 1024, 1024, (item >> 3) * 128, (item & 7) * 128, e, lds);
    }
    xcd_barrier(xbar);
#pragma unroll 1
    for (int l = 0; l < 2; ++l) {
        const int nrows = l == 0 ? R : SEQ, ntm = nrows / 128;
        if (l == 1) {
            if (PH(13)) FOR_ITEMS(2080) norm_rows_item(p, item, 1, p.in[6] + 1024, 0, false);
            xcd_barrier(xbar);
            if (PH(14)) FOR_ITEMS(130 * 33) {
                EpiOddIn e{(bf16_t*)(ws + WS_QKVR), (bf16_t*)(ws + WS_Z), (float*)(ws + WS_AB)};
                gemm_tile((const bf16_t*)(ws + WS_ACT), 1024, R, (const bf16_t*)(ws + WS_WOIN), 1024, ODD_IN, 1024, (item / 33) * 128, (item % 33) * 128, e, lds);
            }
            xcd_barrier(xbar);
            if (PH(15)) FOR_ITEMS(NCH) gdn_prep_item(p, item);
            xcd_barrier(xbar);
            if (PH(16)) FOR_ITEMS(NUNITS) gdn_unit(p, item, lds);
            xcd_barrier(xbar);
            if (PH(17)) {
                FOR_ITEMS(256) { if ((item & 15) != 15) gdn_seg_ab(p, item >> 4, item & 15, lds); }
                xcd_barrier(xbar);
                if (blockIdx.x < 16) gdn_seg_chain(p, blockIdx.x, lds);
                xcd_barrier(xbar);
                FOR_ITEMS(256) gdn_seq(p, item >> 4, item & 15, lds);
            }
            xcd_barrier(xbar);
            if (PH(18)) FOR_ITEMS(SEQ / 8) gdn_readout_row(p, item * 8 + (tid_() >> 6));
            xcd_barrier(xbar);
            if (PH(19)) FOR_ITEMS(128 * 8 + 8192) {
                if (item < 1024) {
                    EpiResid e{p.in[0], p.in[2], (float*)(ws + WS_H), (const float*)(ws + WS_MOD), 1, false};
                    gemm_tile((const bf16_t*)(ws + WS_VN), 1024, SEQ, (const bf16_t*)(ws + WS_WOOUT), 1024, 1024, 1024, (item >> 3) * 128, (item & 7) * 128, e, lds);
                } else {
                    const int q = item - 1024;
                    cvt_chunk((q < 4096 ? p.in[29] : p.in[30]) + (size_t)16384 * 1024, (bf16_t*)(ws + WS_PUV) + (q < 4096 ? 0 : (size_t)16384 * 1024), q & 4095);
                }
            }
            xcd_barrier(xbar);
        }
        if (PH(8)) FOR_ITEMS(nrows / 8) norm_rows_item(p, item, l, p.in[7] + l * 1024, 3, false);
        xcd_barrier(xbar);
        if (PH(9)) FOR_ITEMS(ntm * 16) {
            EpiBf16 e{(bf16_t*)(ws + WS_Q), 2048};
            gemm_tile((const bf16_t*)(ws + WS_ACT), 1024, nrows, (const bf16_t*)(ws + (l == 0 ? WS_WQ0 : WS_WQ1)), 1024, 2048, 1024, (item >> 4) * 128, (item & 15) * 128, e, lds);
        }
        xcd_barrier(xbar);
        if (PH(10)) FOR_ITEMS(ntm * 16) {
            const int b = item & 15;
            EpiScore e{(unsigned short*)(ws + WS_SC), b * 128};
            gemm_tile((const bf16_t*)(ws + WS_Q) + b * 128, 2048, nrows, (const bf16_t*)(ws + WS_SK) + (size_t)(l * 2 + (b & 1)) * 128 * 128, 128, 128, 128, (item >> 4) * 128, 0, e, lds);
        }
        xcd_barrier(xbar);
        if (PH(11)) FOR_ITEMS(nrows / 64) peer_route_item(p, item, nrows, lds);
        xcd_barrier(xbar);
        if (PH(12)) FOR_ITEMS(nrows / 8) peer_gather_row(p, item * 8 + (tid_() >> 6), l, l == 1);
        if (l == 0) xcd_barrier(xbar);
    }
}

extern "C" void kernel_launch(void* const* d_in, const int* in_sizes, int n_in, void* d_out, int out_size, void* d_ws, size_t ws_size, hipStream_t stream) {
    static int grid_blocks = 0;
    if (grid_blocks == 0) {
        if (n_in != 32 || out_size != SEQ * D || ws_size < WS_NEED) {
            fprintf(stderr, "kernel_launch: unexpected problem (n_in %d, out %d, ws %zu, need %zu); nothing launched\n", n_in, out_size, ws_size, (size_t)WS_NEED);
            grid_blocks = -1; return;
        }
        int dev = 0, cus = 0, per_cu = 0;
        hipGetDevice(&dev);
        hipDeviceGetAttribute(&cus, hipDeviceAttributeMultiprocessorCount, dev);
        hipFuncSetAttribute((const void*)fwd_megakernel, hipFuncAttributeMaxDynamicSharedMemorySize, LDS_BYTES);
        hipOccupancyMaxActiveBlocksPerMultiprocessor(&per_cu, (const void*)fwd_megakernel, NTHREADS, LDS_BYTES);
        if (per_cu < 1) { fprintf(stderr, "kernel_launch: occupancy query says %d blocks per CU; nothing launched\n", per_cu); grid_blocks = -1; return; }
        grid_blocks = cus;
    }
    if (grid_blocks < 0) return;
    (void)hipMemsetAsync((unsigned char*)d_ws + WS_BAR, 0, XCD_BAR_WORDS * 4, stream);
    Params prm{};
    for (int i = 0; i < 32; ++i) prm.in[i] = (const float*)d_in[i];
    prm.out = (float*)d_out; prm.ws = (unsigned char*)d_ws;
    void* args[] = {&prm};
    hipError_t e = hipLaunchCooperativeKernel((const void*)fwd_megakernel, dim3(grid_blocks), dim3(NTHREADS), args, LDS_BYTES, stream);
    if (e != hipSuccess) fprintf(stderr, "cooperative launch failed: %s (grid %d)\n", hipGetErrorString(e), grid_blocks);
}
```

```cpp
#include <hip/hip_runtime.h>
#include <hip/hip_cooperative_groups.h>
#include <cstdio>
#include <cstdint>
namespace cg = cooperative_groups;

typedef unsigned short bf16_t;
typedef short bf16x8 __attribute__((ext_vector_type(8)));
typedef float f32x4 __attribute__((ext_vector_type(4)));
typedef float f32x16 __attribute__((ext_vector_type(16)));
typedef unsigned u32x4 __attribute__((ext_vector_type(4)));

constexpr int D = 1024, SEQ = 16384, CTX = 256, R = SEQ + CTX;
constexpr int NCH = R / 64;
constexpr int NCH_LAT = SEQ / 64;
constexpr int NTHREADS = 512;
constexpr int ODD_IN = 4128;
constexpr int NUNITS = 16 * NCH;

constexpr size_t al256(size_t x) { return (x + 255) & ~(size_t)255; }
constexpr size_t WS_BAR   = 0;
constexpr size_t WS_MOD   = 16384;
constexpr size_t WS_A64   = WS_MOD + al256(2 * 2 * 6 * 1024 * 4);
constexpr size_t WS_SK    = WS_A64 + al256(2 * 32 * 64 * 8);
constexpr size_t WS_PSC   = WS_SK + al256(2 * 2 * 128 * 128 * 2);
constexpr size_t WS_WEIN  = WS_PSC + al256(2 * 16384 * 4);
constexpr size_t WS_WGLU  = WS_WEIN + (size_t)2048 * 1024 * 2;
constexpr size_t WS_WEOUT = WS_WGLU + (size_t)512 * 512 * 2;
constexpr size_t WS_WQ0   = WS_WEOUT + (size_t)1024 * 1024 * 2;
constexpr size_t WS_WQ1   = WS_WQ0 + (size_t)2048 * 1024 * 2;
constexpr size_t WS_WOIN  = WS_WQ1 + (size_t)2048 * 1024 * 2;
constexpr size_t WS_WOOUT = WS_WOIN + al256((size_t)ODD_IN * 1024 * 2);
constexpr size_t WS_H     = WS_WOOUT + (size_t)1024 * 1024 * 2;
constexpr size_t WS_PUV   = WS_H + (size_t)R * 1024 * 4;
constexpr size_t WS_ACT   = WS_PUV + (size_t)2 * 16384 * 1024 * 2;
constexpr size_t WS_ARENA = WS_ACT + (size_t)R * 1024 * 2;
constexpr size_t WS_GG    = WS_WEIN;
constexpr size_t WS_BETA  = WS_GG + (size_t)16 * R * 4;
constexpr size_t WS_GC    = WS_BETA + (size_t)16 * R * 4;
constexpr size_t WS_AB    = WS_GC + (size_t)NUNITS * 64 * 4;
static_assert(WS_AB + (size_t)R * 32 * 4 <= WS_WQ1, "layer-1 small buffers overflow the dead layer-0 weights");
constexpr size_t WS_PA    = WS_ARENA;
constexpr size_t WS_UG    = WS_PA + (size_t)R * 1536 * 2;
constexpr size_t WS_MS5   = WS_UG + (size_t)32 * NCH * 1024 * 2;
constexpr size_t WS_O5    = WS_MS5 + (size_t)32 * 1280 * 1024 * 2;
constexpr size_t WS_KTAB  = WS_O5 + (size_t)32 * 1024 * 256 * 2;
constexpr size_t WS_YL    = WS_KTAB + (size_t)2 * 32 * 64 * 256 * 4;
constexpr size_t WS_LST   = WS_YL + (size_t)R * 512 * 4;
constexpr size_t WS_A5    = WS_LST + (size_t)32 * NCH * 256 * 4;
constexpr size_t WS_GS    = WS_A5 + (size_t)32 * NCH * 256 * 2;
constexpr size_t WS_CB    = WS_GS + (size_t)R * 512 * 2;
constexpr size_t WS_END_L0 = WS_CB + (size_t)R * 1024 * 2;
constexpr size_t WS_Q     = WS_ARENA;
constexpr size_t WS_SC    = WS_Q + (size_t)R * 2048 * 2;
constexpr size_t WS_IDX   = WS_SC + (size_t)R * 2048 * 2;
constexpr size_t WS_GATE  = WS_IDX + (size_t)R * 128 * 4;
constexpr size_t WS_END_PEER = WS_GATE + (size_t)R * 128 * 4;
constexpr size_t WS_QKVR  = WS_ARENA;
constexpr size_t WS_W     = WS_QKVR;
constexpr size_t WS_ATT   = WS_W + (size_t)NUNITS * 64 * 128 * 2;
static_assert(WS_ATT + (size_t)NUNITS * 64 * 64 * 2 <= WS_QKVR + (size_t)R * 3072 * 2, "W+ATT must fit in QKVR");
constexpr size_t WS_Z     = WS_QKVR + (size_t)R * 3072 * 2;
constexpr size_t WS_QN    = WS_Z + (size_t)R * 1024 * 2;
constexpr size_t WS_KN    = WS_QN + (size_t)R * 1024 * 2;
constexpr size_t WS_VN    = WS_KN + (size_t)R * 1024 * 2;
constexpr size_t WS_UT    = WS_VN + (size_t)R * 1024 * 2;
constexpr size_t WS_END_L1 = WS_UT + (size_t)NUNITS * 128 * 64 * 2;
constexpr size_t WS_OF    = WS_PUV;
constexpr size_t WS_SIN   = WS_ACT;
constexpr size_t WS_BSEG  = WS_SIN + (size_t)256 * 65536;
constexpr size_t WS_ASEG  = WS_VN;
static_assert(WS_BSEG + (size_t)256 * 65536 <= WS_ARENA, "SIN+BSEG must fit in ACT");
constexpr size_t cmax(size_t a, size_t b) { return a > b ? a : b; }
constexpr size_t WS_NEED  = cmax(cmax(WS_END_L0, WS_END_PEER), WS_END_L1);
static_assert(WS_NEED <= (size_t)512 * 1024 * 1024, "workspace plan exceeds 512 MiB");

constexpr int LDS_BYTES = 140 * 1024;

struct Params {
    const float* in[32];
    float* out;
    unsigned char* ws;
};

__device__ __forceinline__ int tid_() { int t = threadIdx.x; asm volatile("" : "+v"(t)); return t; }
__device__ __forceinline__ float bf2f(bf16_t b) { return __uint_as_float((unsigned)b << 16); }
__device__ __forceinline__ bf16_t f2bf(float f) { const __bf16 b = (__bf16)f; return __builtin_bit_cast(bf16_t, b); }
typedef float f32x2_t __attribute__((ext_vector_type(2)));
typedef __bf16 bf16x2_t __attribute__((ext_vector_type(2)));
__device__ __forceinline__ unsigned pack2(float lo, float hi) { const f32x2_t v = {lo, hi}; const bf16x2_t b = __builtin_convertvector(v, bf16x2_t); return __builtin_bit_cast(unsigned, b); }
__device__ __forceinline__ float lo2f(unsigned p) { return __uint_as_float(p << 16); }
__device__ __forceinline__ float hi2f(unsigned p) { return __uint_as_float(p & 0xFFFF0000u); }
__device__ __forceinline__ float sigmoidf_(float x) { return 1.f / (1.f + __expf(-x)); }
__device__ __forceinline__ float siluf_(float x) { return x * sigmoidf_(x); }
__device__ __forceinline__ float gelu_tanh(float x) {
    const float u = 0.7978845608028654f * (x + 0.044715f * x * x * x);
    const float t = 1.f - 2.f / (1.f + __expf(2.f * u));
    return 0.5f * x * (1.f + t);
}
__device__ __forceinline__ float wave_sum(float v) {
#pragma unroll
    for (int o = 32; o > 0; o >>= 1) v += __shfl_xor(v, o, 64);
    return v;
}
__device__ __forceinline__ void unpack8(const uint4& p, float* f) {
    f[0] = lo2f(p.x); f[1] = hi2f(p.x); f[2] = lo2f(p.y); f[3] = hi2f(p.y);
    f[4] = lo2f(p.z); f[5] = hi2f(p.z); f[6] = lo2f(p.w); f[7] = hi2f(p.w);
}
__device__ __forceinline__ uint4 pack8(const float* f) {
    uint4 p; p.x = pack2(f[0], f[1]); p.y = pack2(f[2], f[3]); p.z = pack2(f[4], f[5]); p.w = pack2(f[6], f[7]); return p;
}
__device__ __forceinline__ const float* modp(const Params& p, int l, int row, int j) {
    const float* m = (const float*)(p.ws + WS_MOD);
    return m + ((l * 2 + (row >= SEQ ? 1 : 0)) * 6 + j) * 1024;
}

constexpr int GT_LD = 72;
constexpr int GT_OPB = 128 * GT_LD * 2;
template <class Epi>
__device__ __forceinline__ void gemm_tile(const bf16_t* __restrict__ A, int lda, int M, const bf16_t* __restrict__ Bt, int ldb, int N, int K,
                                          int row0, int col0, Epi epi, unsigned char* lds) {
    const int tid = tid_(), lane = tid & 63, wave = tid >> 6;
    const int wm = wave >> 2, wn = wave & 3, r = lane & 31, h = lane >> 5;
    const int lr = tid >> 3, lc = (tid & 7) * 8;
    int ar0 = row0 + lr, ar1 = row0 + lr + 64, br0 = col0 + lr, br1 = col0 + lr + 64;
    ar0 = ar0 < M ? ar0 : M - 1; ar1 = ar1 < M ? ar1 : M - 1; br0 = br0 < N ? br0 : N - 1; br1 = br1 < N ? br1 : N - 1;
    const bf16_t* pa0 = A + (size_t)ar0 * lda + lc; const bf16_t* pa1 = A + (size_t)ar1 * lda + lc;
    const bf16_t* pb0 = Bt + (size_t)br0 * ldb + lc; const bf16_t* pb1 = Bt + (size_t)br1 * ldb + lc;
    f32x16 acc0, acc1;
#pragma unroll
    for (int i = 0; i < 16; ++i) { acc0[i] = 0.f; acc1[i] = 0.f; }
    const int nk = K >> 6;
    uint4 ra0 = *(const uint4*)pa0, ra1 = *(const uint4*)pa1, rb0 = *(const uint4*)pb0, rb1 = *(const uint4*)pb1;
    __syncthreads();
    {
        unsigned char* sa = lds; unsigned char* sb = lds + GT_OPB;
        *(uint4*)(sa + (lr * GT_LD + lc) * 2) = ra0; *(uint4*)(sa + ((lr + 64) * GT_LD + lc) * 2) = ra1;
        *(uint4*)(sb + (lr * GT_LD + lc) * 2) = rb0; *(uint4*)(sb + ((lr + 64) * GT_LD + lc) * 2) = rb1;
    }
    __syncthreads();
    for (int kt = 0; kt < nk; ++kt) {
        const int cur = kt & 1;
        if (kt + 1 < nk) {
            const int ko = (kt + 1) * 64;
            ra0 = *(const uint4*)(pa0 + ko); ra1 = *(const uint4*)(pa1 + ko); rb0 = *(const uint4*)(pb0 + ko); rb1 = *(const uint4*)(pb1 + ko);
        }
        const unsigned char* sa = lds + cur * 2 * GT_OPB; const unsigned char* sb = sa + GT_OPB;
#pragma unroll
        for (int s = 0; s < 4; ++s) {
            const bf16x8 a0 = *(const bf16x8*)(sa + ((wm * 64 + r) * GT_LD + s * 16 + 8 * h) * 2);
            const bf16x8 a1 = *(const bf16x8*)(sa + ((wm * 64 + 32 + r) * GT_LD + s * 16 + 8 * h) * 2);
            const bf16x8 b  = *(const bf16x8*)(sb + ((wn * 32 + r) * GT_LD + s * 16 + 8 * h) * 2);
            acc0 = __builtin_amdgcn_mfma_f32_32x32x16_bf16(a0, b, acc0, 0, 0, 0);
            acc1 = __builtin_amdgcn_mfma_f32_32x32x16_bf16(a1, b, acc1, 0, 0, 0);
        }
        if (kt + 1 < nk) {
            unsigned char* na = lds + (cur ^ 1) * 2 * GT_OPB; unsigned char* nb = na + GT_OPB;
            *(uint4*)(na + (lr * GT_LD + lc) * 2) = ra0; *(uint4*)(na + ((lr + 64) * GT_LD + lc) * 2) = ra1;
            *(uint4*)(nb + (lr * GT_LD + lc) * 2) = rb0; *(uint4*)(nb + ((lr + 64) * GT_LD + lc) * 2) = rb1;
        }
        __syncthreads();
    }
    const int col = col0 + wn * 32 + r;
    if (col < N) {
#pragma unroll
        for (int i = 0; i < 16; ++i) {
            const int rr = (i & 3) + 8 * (i >> 2) + 4 * h;
            const int row_a = row0 + wm * 64 + rr, row_b = row_a + 32;
            if (row_a < M) epi(row_a, col, acc0[i]);
            if (row_b < M) epi(row_b, col, acc1[i]);
        }
    }
}

__device__ __forceinline__ void p0_adaln(const Params& p, int item, unsigned char* lds) {
    const int l = item / 96, cb = item % 96, tid = tid_();
    const int kq = tid >> 4, c4 = tid & 15;
    const float* W = p.in[4] + (size_t)l * 1024 * 6144 + cb * 64 + c4 * 4;
    const float* c = p.in[1]; const float* cc = p.in[3];
    float al[4] = {0, 0, 0, 0}, ac[4] = {0, 0, 0, 0};
    for (int k = kq; k < 1024; k += 32) {
        const float4 w = *(const float4*)(W + (size_t)k * 6144);
        const float sl = siluf_(c[k]), sc = siluf_(cc[k]);
        al[0] += sl * w.x; al[1] += sl * w.y; al[2] += sl * w.z; al[3] += sl * w.w;
        ac[0] += sc * w.x; ac[1] += sc * w.y; ac[2] += sc * w.z; ac[3] += sc * w.w;
    }
    float* red = (float*)lds;
    __syncthreads();
#pragma unroll
    for (int e = 0; e < 4; ++e) { red[(kq * 2 + 0) * 64 + c4 * 4 + e] = al[e]; red[(kq * 2 + 1) * 64 + c4 * 4 + e] = ac[e]; }
    __syncthreads();
    if (tid < 128) {
        const int s = tid >> 6, cidx = tid & 63;
        float sum = 0.f;
        for (int q = 0; q < 32; ++q) sum += red[(q * 2 + s) * 64 + cidx];
        const int col = cb * 64 + cidx;
        sum += p.in[5][l * 6144 + col];
        ((float*)(p.ws + WS_MOD))[(l * 2 + s) * 6144 + col] = sum;
    }
}
__device__ __forceinline__ void p0_transpose(const float* __restrict__ src, int K, int N, bf16_t* __restrict__ dst, int tile, unsigned char* lds) {
    const int ntn = (N + 63) / 64, tk = tile / ntn, tn = tile % ntn, tid = tid_();
    float* s = (float*)lds;
    __syncthreads();
    for (int e = tid; e < 64 * 64; e += NTHREADS) {
        const int kk = e >> 6, nn = e & 63; const int n = tn * 64 + nn;
        s[kk * 65 + nn] = n < N ? src[(size_t)(tk * 64 + kk) * N + n] : 0.f;
    }
    __syncthreads();
    {
        const int nn = tid >> 3, kg = (tid & 7) * 8; const int n = tn * 64 + nn;
        if (n < N) {
            float f[8];
#pragma unroll
            for (int e = 0; e < 8; ++e) f[e] = s[(kg + e) * 65 + nn];
            *(uint4*)(dst + (size_t)n * K + tk * 64 + kg) = pack8(f);
        }
    }
}
__device__ __forceinline__ void cvt_chunk(const float* __restrict__ src, bf16_t* __restrict__ dst, size_t item) {
    const size_t o = item * 4096 + (size_t)tid_() * 8;
    const float4 a = *(const float4*)(src + o), b = *(const float4*)(src + o + 4);
    uint4 q; q.x = pack2(a.x, a.y); q.y = pack2(a.z, a.w); q.z = pack2(b.x, b.y); q.w = pack2(b.z, b.w);
    *(uint4*)(dst + o) = q;
}
__device__ __forceinline__ void cvt_row_fp8(const float* __restrict__ src, unsigned char* __restrict__ dst, float* __restrict__ inv_scale) {
    const int lane = tid_() & 63;
    float4 v[4]; float am = 0.f;
#pragma unroll
    for (int q = 0; q < 4; ++q) { v[q] = *(const float4*)(src + lane * 16 + q * 4); am = fmaxf(am, fmaxf(fmaxf(fabsf(v[q].x), fabsf(v[q].y)), fmaxf(fabsf(v[q].z), fabsf(v[q].w)))); }
#pragma unroll
    for (int o = 32; o > 0; o >>= 1) am = fmaxf(am, __shfl_xor(am, o, 64));
    const float sc = am > 0.f ? 224.f / am : 1.f;
    u32x4 o;
#pragma unroll
    for (int q = 0; q < 4; ++q) {
        int w = 0;
        w = __builtin_amdgcn_cvt_pk_fp8_f32(v[q].x * sc, v[q].y * sc, w, false);
        w = __builtin_amdgcn_cvt_pk_fp8_f32(v[q].z * sc, v[q].w * sc, w, true);
        o[q] = (unsigned)w;
    }
    *(u32x4*)(dst + lane * 16) = o;
    if (lane == 0) *inv_scale = am > 0.f ? am / 224.f : 1.f;
}
__device__ __forceinline__ void peer_tables_item(const Params& p, int item, int l) {
    const int tab = item >> 11, row = (item & 2047) * 8 + (tid_() >> 6);
    const float* src = (tab ? p.in[30] : p.in[29]) + ((size_t)l * 16384 + row) * 1024;
    cvt_row_fp8(src, p.ws + WS_PUV + ((size_t)tab * 16384 + row) * 1024, (float*)(p.ws + WS_PSC) + tab * 16384 + row);
}

__device__ __forceinline__ void sincos_d(double x, double& s, double& c) {
    const double TWO_OVER_PI = 0.63661977236758134308, PIO2_HI = 1.57079632679489655800e+00, PIO2_LO = 6.12323399573676603587e-17;
    const double kf = rint(x * TWO_OVER_PI);
    const double y = (x - kf * PIO2_HI) - kf * PIO2_LO;
    const double y2 = y * y;
    double sp = -1.0 / 1307674368000.0;
    sp = sp * y2 + 1.0 / 6227020800.0; sp = sp * y2 - 1.0 / 39916800.0; sp = sp * y2 + 1.0 / 362880.0; sp = sp * y2 - 1.0 / 5040.0;
    sp = sp * y2 + 1.0 / 120.0; sp = sp * y2 - 1.0 / 6.0; sp = sp * y2 + 1.0; sp *= y;
    double cp = 1.0 / 20922789888000.0;
    cp = cp * y2 - 1.0 / 87178291200.0; cp = cp * y2 + 1.0 / 479001600.0; cp = cp * y2 - 1.0 / 3628800.0; cp = cp * y2 + 1.0 / 40320.0;
    cp = cp * y2 - 1.0 / 720.0; cp = cp * y2 + 1.0 / 24.0; cp = cp * y2 - 0.5; cp = cp * y2 + 1.0;
    const int q = ((int)kf) & 3;
    s = (q == 0) ? sp : (q == 1) ? cp : (q == 2) ? -sp : -cp;
    c = (q == 0) ? cp : (q == 1) ? -sp : (q == 2) ? -cp : sp;
}
__device__ __forceinline__ void p0_s5_tables(const Params& p, int item, unsigned char* lds) {
    const int di = item >> 5, g = item & 31, tid = tid_();
    float2* apw = (float2*)lds;
    float2* Bb = apw + 64 * 65;
    float2* Cc = Bb + 64 * 16;
    __syncthreads();
    if (tid < 64) {
        const int pidx = (di * 32 + g) * 64 + tid;
        float lr = p.in[10][pidx]; lr = lr < -1e-4f ? lr : -1e-4f;
        const float li = p.in[11][pidx];
        const float dt = expf(p.in[12][di * 32 + g]);
        const double mag = (double)expf(lr * dt);
        double sn, cs; sincos_d((double)li * (double)dt, sn, cs);
        const double are = mag * cs, aim = mag * sn;
        double pr = 1.0, pi_ = 0.0;
        for (int t = 0; t <= 64; ++t) {
            apw[tid * 65 + t] = make_float2((float)pr, (float)pi_);
            const double nr = pr * are - pi_ * aim, ni = pr * aim + pi_ * are; pr = nr; pi_ = ni;
        }
        ((float2*)(p.ws + WS_A64))[(di * 32 + g) * 64 + tid] = apw[tid * 65 + 64];
        const double den = (double)lr * lr + (double)li * li;
        const double fre = ((are - 1.0) * lr + aim * li) / den, fim = (aim * lr - (are - 1.0) * li) / den;
        for (int hh = 0; hh < 16; ++hh) {
            const double br = p.in[13][(size_t)pidx * 16 + hh], bi = p.in[14][(size_t)pidx * 16 + hh];
            Bb[tid * 16 + hh] = make_float2((float)(fre * br - fim * bi), (float)(fre * bi + fim * br));
        }
    }
    for (int e = tid; e < 1024; e += NTHREADS) {
        const size_t gi = ((size_t)(di * 32 + g) * 16) * 64 + e;
        Cc[e] = make_float2(p.in[15][gi], p.in[16][gi]);
    }
    __syncthreads();
    float* ktab = (float*)(p.ws + WS_KTAB) + (size_t)(di * 32 + g) * 64 * 256;
    for (int o = tid; o < 64 * 256; o += NTHREADS) {
        const int tau = o >> 8, hh = (o >> 4) & 15, h2 = o & 15;
        float acc = 0.f;
        for (int pp = 0; pp < 64; ++pp) {
            const float2 a = apw[pp * 65 + tau], c = Cc[hh * 64 + pp], b = Bb[pp * 16 + h2];
            const float cr = c.x * a.x - c.y * a.y, ci = c.x * a.y + c.y * a.x;
            acc += cr * b.x - ci * b.y;
        }
        ktab[o] = acc;
    }
    bf16_t* ms5 = (bf16_t*)(p.ws + WS_MS5) + (size_t)g * 1280 * 1024;
    for (int t = tid; t < 128 * 128; t += NTHREADS) {
        const int row = t >> 7, k8 = t & 127; const int ri = row >> 6, pp = row & 63, j = k8 >> 1, h0 = (k8 & 1) * 8;
        const float2 a = apw[pp * 65 + (di == 0 ? 63 - j : j)];
        float f[8];
#pragma unroll
        for (int e = 0; e < 8; ++e) { const float2 b = Bb[pp * 16 + h0 + e]; f[e] = ri == 0 ? (a.x * b.x - a.y * b.y) : (a.x * b.y + a.y * b.x); }
        *(uint4*)(ms5 + (size_t)(1024 + di * 128 + row) * 1024 + k8 * 8) = pack8(f);
    }
    bf16_t* o5 = (bf16_t*)(p.ws + WS_O5) + (size_t)g * 1024 * 256;
    for (int t = tid; t < 1024 * 16; t += NTHREADS) {
        const int n = t >> 4, q = t & 15; const int ri = q >> 3, p0 = (q & 7) * 8, i = n >> 4, hh = n & 15;
        float f[8];
#pragma unroll
        for (int e = 0; e < 8; ++e) {
            const float2 a = apw[(p0 + e) * 65 + (di == 0 ? i + 1 : 64 - i)], c = Cc[hh * 64 + p0 + e];
            f[e] = ri == 0 ? (c.x * a.x - c.y * a.y) : -(c.x * a.y + c.y * a.x);
        }
        *(uint4*)(o5 + (size_t)n * 256 + di * 128 + ri * 64 + p0) = pack8(f);
    }
}

__device__ __forceinline__ void norm_mod_row(const float* __restrict__ src, const float* __restrict__ g, const float* __restrict__ shift,
                                             const float* __restrict__ scale, bf16_t* __restrict__ dst, int lane) {
    float4 v[4]; float ss = 0.f;
#pragma unroll
    for (int k = 0; k < 4; ++k) { v[k] = *(const float4*)(src + k * 256 + lane * 4); ss += v[k].x * v[k].x + v[k].y * v[k].y + v[k].z * v[k].z + v[k].w * v[k].w; }
    ss = wave_sum(ss);
    const float rs = rsqrtf(ss * (1.f / 1024.f) + 1e-6f);
#pragma unroll
    for (int k = 0; k < 4; ++k) {
        const int c = k * 256 + lane * 4;
        const float4 gg = *(const float4*)(g + c), sh = *(const float4*)(shift + c), sc = *(const float4*)(scale + c);
        uint2 o;
        o.x = pack2(v[k].x * rs * gg.x * (1.f + sc.x) + sh.x, v[k].y * rs * gg.y * (1.f + sc.y) + sh.y);
        o.y = pack2(v[k].z * rs * gg.z * (1.f + sc.z) + sh.z, v[k].w * rs * gg.w * (1.f + sc.w) + sh.w);
        *(uint2*)(dst + c) = o;
    }
}
__device__ __forceinline__ void norm_rows_item(const Params& p, int item, int l, const float* g, int js, bool from_inputs) {
    const int row = item * 8 + (tid_() >> 6), lane = tid_() & 63;
    const float* src = from_inputs ? (row < SEQ ? p.in[0] + (size_t)row * 1024 : p.in[2] + (size_t)(row - SEQ) * 1024)
                                   : (const float*)(p.ws + WS_H) + (size_t)row * 1024;
    norm_mod_row(src, g, modp(p, l, row, js), modp(p, l, row, js + 1), (bf16_t*)(p.ws + WS_ACT) + (size_t)row * 1024, lane);
}
__device__ __forceinline__ void s5_mintra_item(const Params& p, int item) {
    const int g = item >> 6, i = item & 63;
    const float* kt0 = (const float*)(p.ws + WS_KTAB) + (size_t)(0 * 32 + g) * 64 * 256;
    const float* kt1 = (const float*)(p.ws + WS_KTAB) + (size_t)(1 * 32 + g) * 64 * 256;
    const float* dsk = p.in[17] + g * 16;
    bf16_t* ms5 = (bf16_t*)(p.ws + WS_MS5) + (size_t)g * 1280 * 1024;
    for (int t = tid_(); t < 16 * 128; t += NTHREADS) {
        const int hh = t >> 7, k8 = t & 127, j = k8 >> 1, h0 = (k8 & 1) * 8;
        float f[8];
        if (j < i) { const float* s = kt0 + ((i - j) * 16 + hh) * 16 + h0;
#pragma unroll
            for (int e = 0; e < 8; ++e) f[e] = s[e]; }
        else if (j > i) { const float* s = kt1 + ((j - i) * 16 + hh) * 16 + h0;
#pragma unroll
            for (int e = 0; e < 8; ++e) f[e] = s[e]; }
        else { const float* s0 = kt0 + hh * 16 + h0; const float* s1 = kt1 + hh * 16 + h0;
#pragma unroll
            for (int e = 0; e < 8; ++e) f[e] = s0[e] + s1[e] + ((h0 + e) == hh ? dsk[hh] : 0.f); }
        *(uint4*)(ms5 + (size_t)(i * 16 + hh) * 1024 + k8 * 8) = pack8(f);
    }
}

struct EpiEvenIn {
    bf16_t* pa; bf16_t* ug;
    __device__ __forceinline__ void operator()(int row, int col, float v) const {
        if (col < 1536) pa[(size_t)row * 1536 + col] = f2bf(v);
        else { const int c2 = col - 1536; ug[((size_t)(c2 >> 4) * NCH + (row >> 6)) * 1024 + (row & 63) * 16 + (c2 & 15)] = f2bf(v); }
    }
};
struct EpiS5Local {
    float* yl; float* lst; int g;
    __device__ __forceinline__ void operator()(int row, int col, float v) const {
        if (col < 1024) yl[(size_t)(row * 64 + (col >> 4)) * 512 + g * 16 + (col & 15)] = v;
        else lst[((size_t)g * NCH + row) * 256 + (col - 1024)] = v;
    }
};
struct EpiS5Out {
    const float* yl; bf16_t* gs; int g;
    __device__ __forceinline__ void operator()(int row, int col, float v) const {
        const size_t o = (size_t)(row * 64 + (col >> 4)) * 512 + g * 16 + (col & 15);
        gs[o] = f2bf(gelu_tanh(v + yl[o]));
    }
};
struct EpiGlu {
    const bf16_t* gs; const float* b; bf16_t* cb;
    __device__ __forceinline__ void operator()(int row, int col, float v) const {
        cb[(size_t)row * 1024 + 512 + col] = f2bf(bf2f(gs[(size_t)row * 512 + col]) * sigmoidf_(v + b[col]));
    }
};
struct EpiResid {
    const float* x; const float* ctx; float* hbuf; const float* mod; int l; bool from_inputs;
    __device__ __forceinline__ void operator()(int row, int col, float v) const {
        float* h = hbuf + (size_t)row * 1024 + col;
        const float base = from_inputs ? (row < SEQ ? x[(size_t)row * 1024 + col] : ctx[(size_t)(row - SEQ) * 1024 + col]) : *h;
        *h = base + mod[((l * 2 + (row >= SEQ ? 1 : 0)) * 6 + 2) * 1024 + col] * v;
    }
};
struct EpiBf16 {
    bf16_t* dst; int ld;
    __device__ __forceinline__ void operator()(int row, int col, float v) const { dst[(size_t)row * ld + col] = f2bf(v); }
};
struct EpiScore {
    unsigned short* dst; int coff;
    __device__ __forceinline__ void operator()(int row, int col, float v) const {
        const _Float16 hv = (_Float16)v; dst[(size_t)row * 2048 + coff + col] = __builtin_bit_cast(unsigned short, hv);
    }
};
struct EpiOddIn {
    bf16_t* qkvr; bf16_t* z; float* ab;
    __device__ __forceinline__ void operator()(int row, int col, float v) const {
        if (col < 3072) qkvr[(size_t)row * 3072 + col] = f2bf(v);
        else if (col < 4096) z[(size_t)row * 1024 + (col - 3072)] = f2bf(v);
        else ab[(size_t)row * 32 + (col - 4096)] = v;
    }
};

__device__ __forceinline__ void s5_scan(const Params& p) {
    const int gt = blockIdx.x * NTHREADS + tid_();
    if (gt >= 4096) return;
    const int di = gt >> 11, g = (gt >> 6) & 31, pp = gt & 63;
    const float2 a = ((const float2*)(p.ws + WS_A64))[(di * 32 + g) * 64 + pp];
    const float* lst = (const float*)(p.ws + WS_LST) + (size_t)g * NCH * 256 + di * 128 + pp;
    bf16_t* a5 = (bf16_t*)(p.ws + WS_A5) + (size_t)g * NCH * 256 + di * 128 + pp;
    float sr = 0.f, si = 0.f;
    for (int s0 = 0; s0 < NCH; s0 += 4) {
        int c[4]; float lr[4], li[4];
#pragma unroll
        for (int u = 0; u < 4; ++u) {
            const int s = s0 + u;
            c[u] = di == 0 ? (s < 4 ? NCH_LAT + s : s - 4) : (s < 4 ? NCH - 1 - s : NCH - 1 - s);
            lr[u] = lst[(size_t)c[u] * 256]; li[u] = lst[(size_t)c[u] * 256 + 64];
        }
#pragma unroll
        for (int u = 0; u < 4; ++u) {
            a5[(size_t)c[u] * 256] = f2bf(sr); a5[(size_t)c[u] * 256 + 64] = f2bf(si);
            const float nr = a.x * sr - a.y * si + lr[u], ni = a.x * si + a.y * sr + li[u]; sr = nr; si = ni;
        }
    }
}

__device__ __forceinline__ void even_conv_item(const Params& p, int item) {
    const bf16_t* pa = (const bf16_t*)(p.ws + WS_PA); bf16_t* cb = (bf16_t*)(p.ws + WS_CB);
    const float* cw = p.in[9];
    for (int t = tid_(); t < 64 * 64; t += NTHREADS) {
        const int row = item * 64 + (t >> 6), c0 = (t & 63) * 8;
        bool hasp, hasn;
        if (row < SEQ) { hasp = (row & 63) != 0; hasn = (row & 63) != 63; } else { hasp = row != SEQ; hasn = row != R - 1; }
        float m[3][8];
#pragma unroll
        for (int d = 0; d < 3; ++d) {
            const bool ok = d == 1 || (d == 0 ? hasp : hasn);
            if (ok) {
                const bf16_t* rp = pa + (size_t)(row + d - 1) * 1536 + c0;
                float u[8], gi[8]; unpack8(*(const uint4*)rp, u); unpack8(*(const uint4*)(rp + 512), gi);
#pragma unroll
                for (int e = 0; e < 8; ++e) m[d][e] = u[e] * gi[e];
            } else {
#pragma unroll
                for (int e = 0; e < 8; ++e) m[d][e] = 0.f;
            }
        }
        float go[8], f[8]; unpack8(*(const uint4*)(pa + (size_t)row * 1536 + 1024 + c0), go);
#pragma unroll
        for (int e = 0; e < 8; ++e) f[e] = go[e] * (m[0][e] * cw[c0 + e] + m[1][e] * cw[512 + c0 + e] + m[2][e] * cw[1024 + c0 + e]);
        *(uint4*)(cb + (size_t)row * 1024 + c0) = pack8(f);
    }
}

__device__ __forceinline__ unsigned ord_enc(float v) { const unsigned u = __float_as_uint(v); return (u & 0x80000000u) ? ~u : (u | 0x80000000u); }
__device__ __forceinline__ float ord_dec(unsigned e) { const unsigned u = (e & 0x80000000u) ? (e & 0x7FFFFFFFu) : ~e; return __uint_as_float(u); }
#define TOP_INSERT(key) { unsigned x_ = (key); _Pragma("unroll") for (int k_ = 0; k_ < 16; ++k_) { const unsigned hi_ = top[k_] > x_ ? top[k_] : x_; x_ = top[k_] > x_ ? x_ : top[k_]; top[k_] = hi_; } }
__device__ __forceinline__ void peer_route_item(const Params& p, int item, int nrows, unsigned char* lds) {
    const int tid = tid_();
    const int row = item * 64 + (tid >> 3), head = tid & 7;
    unsigned* sIdx = (unsigned*)lds;
    __syncthreads();
    if (row < nrows) {
        const unsigned short* sc = (const unsigned short*)(p.ws + WS_SC) + (size_t)row * 2048 + head * 256;
        float fa[16], fb[16];
#pragma unroll
        for (int side = 0; side < 2; ++side) {
            unsigned top[16];
#pragma unroll
            for (int k = 0; k < 16; ++k) top[k] = 0u;
            for (int c = 0; c < 16; ++c) {
                const uint4 q = *(const uint4*)(sc + side * 128 + c * 8);
                const unsigned w[4] = {q.x, q.y, q.z, q.w};
#pragma unroll
                for (int e = 0; e < 8; ++e) {
                    const unsigned short hb = (unsigned short)((e & 1) ? (w[e >> 1] >> 16) : (w[e >> 1] & 0xFFFFu));
                    const float v = (float)__builtin_bit_cast(_Float16, hb);
                    TOP_INSERT((ord_enc(v) & ~0x7Fu) | (unsigned)(c * 8 + e));
                }
            }
#pragma unroll
            for (int k = 0; k < 16; ++k) {
                sIdx[(side * 16 + k) * NTHREADS + tid] = top[k] & 0x7Fu;
                const float v = ord_dec(top[k] & ~0x7Fu);
                if (side == 0) fa[k] = v; else fb[k] = v;
            }
        }
        unsigned top[16];
#pragma unroll
        for (int k = 0; k < 16; ++k) top[k] = 0u;
#pragma unroll
        for (int i = 0; i < 16; ++i) {
#pragma unroll
            for (int j = 0; j < 16; ++j) {
                if ((i + 1) * (j + 1) <= 16) { TOP_INSERT((ord_enc(fa[i] + fb[j]) & ~0xFFu) | (unsigned)(i * 16 + j)); }
            }
        }
        float ev[16]; float m = ord_dec(top[0] & ~0xFFu), sum = 0.f;
        int* idxo = (int*)(p.ws + WS_IDX) + (size_t)row * 128 + head * 16;
        float* go = (float*)(p.ws + WS_GATE) + (size_t)row * 128 + head * 16;
#pragma unroll
        for (int k = 0; k < 16; ++k) { ev[k] = __expf(ord_dec(top[k] & ~0xFFu) - m); sum += ev[k]; }
        const float inv = 1.f / sum;
#pragma unroll
        for (int k = 0; k < 16; ++k) {
            const unsigned pos = top[k] & 0xFFu;
            const unsigned ia = sIdx[(pos >> 4) * NTHREADS + tid], ib = sIdx[(16 + (pos & 15)) * NTHREADS + tid];
            idxo[k] = (int)(ia * 128u + ib); go[k] = ev[k] * inv;
        }
    }
}

__device__ __forceinline__ void fp8x16_to_f32(const u32x4& q, float* f) {
#pragma unroll
    for (int d = 0; d < 4; ++d) {
        const f32x2_t lo = __builtin_amdgcn_cvt_pk_f32_fp8((int)q[d], false), hi = __builtin_amdgcn_cvt_pk_f32_fp8((int)q[d], true);
        f[4 * d + 0] = lo.x; f[4 * d + 1] = lo.y; f[4 * d + 2] = hi.x; f[4 * d + 3] = hi.y;
    }
}
__device__ __forceinline__ void peer_gather_row(const Params& p, int row, int l, bool last) {
    const int lane = tid_() & 63;
    const bf16_t* xr = (const bf16_t*)(p.ws + WS_ACT) + (size_t)row * 1024 + lane * 16;
    const unsigned char* PU = p.ws + WS_PUV; const unsigned char* PV = PU + (size_t)16384 * 1024;
    const float* psc = (const float*)(p.ws + WS_PSC);
    float x[16], y[16];
    unpack8(*(const uint4*)xr, x); unpack8(*(const uint4*)(xr + 8), x + 8);
#pragma unroll
    for (int e = 0; e < 16; ++e) y[e] = 0.f;
    const int* idxp = (const int*)(p.ws + WS_IDX) + (size_t)row * 128; const float* gp = (const float*)(p.ws + WS_GATE) + (size_t)row * 128;
#pragma unroll 1
    for (int half = 0; half < 2; ++half) {
        const int myidx = idxp[half * 64 + lane];
        const float myus = psc[myidx], mygv = gp[half * 64 + lane] * psc[16384 + myidx];
#pragma unroll 1
        for (int e0 = 0; e0 < 64; e0 += 8) {
            u32x4 ur[8], vr[8];
#pragma unroll
            for (int u = 0; u < 8; ++u) {
                const int id = __builtin_amdgcn_readlane(myidx, e0 + u);
                ur[u] = *(const u32x4*)(PU + (size_t)id * 1024 + lane * 16);
                vr[u] = *(const u32x4*)(PV + (size_t)id * 1024 + lane * 16);
            }
            float d[8];
#pragma unroll
            for (int u = 0; u < 8; ++u) {
                float f[16]; fp8x16_to_f32(ur[u], f);
                float a = 0.f;
#pragma unroll
                for (int e = 0; e < 16; ++e) a += f[e] * x[e];
                d[u] = a;
            }
#pragma unroll
            for (int o = 32; o > 0; o >>= 1) {
#pragma unroll
                for (int u = 0; u < 8; ++u) d[u] += __shfl_xor(d[u], o, 64);
            }
#pragma unroll
            for (int u = 0; u < 8; ++u) {
                const float us = __int_as_float(__builtin_amdgcn_readlane(__float_as_int(myus), e0 + u));
                const float gv = __int_as_float(__builtin_amdgcn_readlane(__float_as_int(mygv), e0 + u));
                const float coef = gelu_tanh(d[u] * us) * gv;
                float f[16]; fp8x16_to_f32(vr[u], f);
#pragma unroll
                for (int e = 0; e < 16; ++e) y[e] += coef * f[e];
            }
        }
    }
    float* h = (float*)(p.ws + WS_H) + (size_t)row * 1024 + lane * 16;
    const float* m5 = modp(p, l, row, 5) + lane * 16;
    float hv[16];
#pragma unroll
    for (int q = 0; q < 4; ++q) {
        const float4 h0 = *(const float4*)(h + q * 4), g0 = *(const float4*)(m5 + q * 4);
        hv[q * 4 + 0] = h0.x + g0.x * y[q * 4 + 0]; hv[q * 4 + 1] = h0.y + g0.y * y[q * 4 + 1];
        hv[q * 4 + 2] = h0.z + g0.z * y[q * 4 + 2]; hv[q * 4 + 3] = h0.w + g0.w * y[q * 4 + 3];
    }
    if (!last) {
#pragma unroll
        for (int q = 0; q < 4; ++q) *(float4*)(h + q * 4) = make_float4(hv[q * 4 + 0], hv[q * 4 + 1], hv[q * 4 + 2], hv[q * 4 + 3]);
    } else {
        float ss = 0.f;
#pragma unroll
        for (int e = 0; e < 16; ++e) ss += hv[e] * hv[e];
        ss = wave_sum(ss);
        const float rs = rsqrtf(ss * (1.f / 1024.f) + 1e-6f);
        const float* fg = p.in[31] + lane * 16; float* o = p.out + (size_t)row * 1024 + lane * 16;
#pragma unroll
        for (int q = 0; q < 4; ++q) {
            const float4 g0 = *(const float4*)(fg + q * 4);
            *(float4*)(o + q * 4) = make_float4(hv[q * 4 + 0] * rs * g0.x, hv[q * 4 + 1] * rs * g0.y, hv[q * 4 + 2] * rs * g0.z, hv[q * 4 + 3] * rs * g0.w);
        }
    }
}

__device__ __forceinline__ void gdn_prep_item(const Params& p, int item) {
    const int lane = tid_() & 63, wave = tid_() >> 6;
    const bf16_t* qkvr = (const bf16_t*)(p.ws + WS_QKVR);
    const float* cw = p.in[22];
    for (int it = 0; it < 8; ++it) {
        const int row = item * 64 + it * 8 + wave;
        bool hasp, hasn;
        if (row < SEQ) { hasp = (row & 63) != 0; hasn = (row & 63) != 63; } else { hasp = row != SEQ; hasn = row != R - 1; }
#pragma unroll 1
        for (int ph = 0; ph < 6; ++ph) {
            const int part = ph >> 1, head = (ph & 1) * 4 + (lane >> 4), d0 = (lane & 15) * 8;
            const int ch = part * 1024 + head * 128 + d0;
            float xm[8], x0[8], xp[8], f[8];
            unpack8(*(const uint4*)(qkvr + (size_t)row * 3072 + ch), x0);
            if (hasp) unpack8(*(const uint4*)(qkvr + (size_t)(row - 1) * 3072 + ch), xm);
            if (hasn) unpack8(*(const uint4*)(qkvr + (size_t)(row + 1) * 3072 + ch), xp);
            float ss = 0.f;
#pragma unroll
            for (int e = 0; e < 8; ++e) {
                float a = x0[e] * cw[3072 + ch + e];
                if (hasp) a += xm[e] * cw[ch + e];
                if (hasn) a += xp[e] * cw[6144 + ch + e];
                a = siluf_(a); f[e] = a; ss += a * a;
            }
            if (part < 2) {
                ss += __shfl_xor(ss, 1, 64); ss += __shfl_xor(ss, 2, 64); ss += __shfl_xor(ss, 4, 64); ss += __shfl_xor(ss, 8, 64);
                const float sc = rsqrtf(ss + 1e-6f) * (part == 0 ? 0.08838834764831845f : 1.f);
#pragma unroll
                for (int e = 0; e < 8; ++e) f[e] *= sc;
            }
            bf16_t* dst = (bf16_t*)(p.ws + (part == 0 ? WS_QN : part == 1 ? WS_KN : WS_VN)) + (size_t)row * 1024 + head * 128 + d0;
            *(uint4*)dst = pack8(f);
        }
        if (lane < 16) {
            const float* ab = (const float*)(p.ws + WS_AB) + (size_t)row * 32;
            const float a = ab[lane] + p.in[24][lane], b = ab[16 + lane];
            const float sp = a > 20.f ? a : log1pf(__expf(a));
            ((float*)(p.ws + WS_GG))[(size_t)lane * R + row] = -__expf(p.in[23][lane]) * sp;
            ((float*)(p.ws + WS_BETA))[(size_t)lane * R + row] = sigmoidf_(b);
        }
    }
}

constexpr int GU_LDQ = 136, GU_LDT = 72, GU_LDA = 68;
constexpr int GU_SQ = 0, GU_SK = 17408, GU_SKB = 34816, GU_SVBT = 52224, GU_SKGT = 70656, GU_SA = 89088, GU_SAT = 106496, GU_ST = 123904, GU_SG = 133120;
__device__ __forceinline__ int perm_slot64(int pos) { return 32 * (pos >> 5) + 8 * ((pos >> 2) & 3) + 4 * ((pos >> 4) & 1) + (pos & 3); }
__device__ __forceinline__ void gdn_unit(const Params& p, int u, unsigned char* lds) {
    const int tid = tid_(), lane = tid & 63, wave = tid >> 6;
    const int dh = u / NCH, c = u % NCH, dir = dh >> 3, head = dh & 7;
    bf16_t* sQ = (bf16_t*)(lds + GU_SQ); bf16_t* sK = (bf16_t*)(lds + GU_SK); bf16_t* sKB = (bf16_t*)(lds + GU_SKB);
    bf16_t* sVBT = (bf16_t*)(lds + GU_SVBT); bf16_t* sKGT = (bf16_t*)(lds + GU_SKGT);
    float* sA = (float*)(lds + GU_SA); float* sAT = (float*)(lds + GU_SAT); bf16_t* sT = (bf16_t*)(lds + GU_ST);
    float* sG = (float*)(lds + GU_SG); float* sBeta = sG + 64;
    __syncthreads();
    if (wave == 0) {
        const int row = c * 64 + (dir ? 63 - lane : lane);
        float g = ((const float*)(p.ws + WS_GG))[(size_t)dh * R + row];
#pragma unroll
        for (int o = 1; o < 64; o <<= 1) { const float t = __shfl_up(g, o, 64); if (lane >= o) g += t; }
        sG[lane] = g; sBeta[lane] = ((const float*)(p.ws + WS_BETA))[(size_t)dh * R + row];
        ((float*)(p.ws + WS_GC))[(size_t)u * 64 + lane] = g;
    }
    __syncthreads();
    for (int t = tid; t < 1024; t += NTHREADS) {
        const int i = t >> 4, d8 = (t & 15) * 8;
        const size_t ro = (size_t)(c * 64 + (dir ? 63 - i : i)) * 1024 + head * 128 + d8;
        const uint4 q = *(const uint4*)((const bf16_t*)(p.ws + WS_QN) + ro);
        const uint4 k = *(const uint4*)((const bf16_t*)(p.ws + WS_KN) + ro);
        const uint4 v = *(const uint4*)((const bf16_t*)(p.ws + WS_VN) + ro);
        const float beta = sBeta[i], eg = __expf(sG[i]);
        float kf[8], vf[8], kb[8];
        unpack8(k, kf); unpack8(v, vf);
#pragma unroll
        for (int e = 0; e < 8; ++e) kb[e] = kf[e] * beta;
        *(uint4*)(sQ + i * GU_LDQ + d8) = q; *(uint4*)(sK + i * GU_LDQ + d8) = k; *(uint4*)(sKB + i * GU_LDQ + d8) = pack8(kb);
#pragma unroll
        for (int e = 0; e < 8; ++e) { sVBT[(d8 + e) * GU_LDT + i] = f2bf(vf[e] * beta); sKGT[(d8 + e) * GU_LDT + i] = f2bf(kb[e] * eg); }
    }
    __syncthreads();
    {
        const int mat = wave >> 2, mt = wave & 3, rr = lane & 15, q4 = lane >> 4;
        const bf16_t* sX = mat ? sQ : sKB;
        f32x4 acc[4];
#pragma unroll
        for (int nt = 0; nt < 4; ++nt) acc[nt] = (f32x4){0.f, 0.f, 0.f, 0.f};
#pragma unroll
        for (int kk = 0; kk < 4; ++kk) {
            const bf16x8 a = *(const bf16x8*)(sX + (16 * mt + rr) * GU_LDQ + kk * 32 + 8 * q4);
#pragma unroll
            for (int nt = 0; nt < 4; ++nt) {
                const bf16x8 b = *(const bf16x8*)(sK + (16 * nt + rr) * GU_LDQ + kk * 32 + 8 * q4);
                acc[nt] = __builtin_amdgcn_mfma_f32_16x16x32_bf16(a, b, acc[nt], 0, 0, 0);
            }
        }
        float* dstm = mat ? sAT : sA;
#pragma unroll
        for (int nt = 0; nt < 4; ++nt) {
            const int j = 16 * nt + rr; const float gj = sG[j];
#pragma unroll
            for (int jj = 0; jj < 4; ++jj) {
                const int i = 16 * mt + 4 * q4 + jj;
                const bool keep = mat ? (j <= i) : (j < i);
                dstm[i * GU_LDA + j] = keep ? acc[nt][jj] * __expf(sG[i] - gj) : 0.f;
            }
        }
    }
    __syncthreads();
    float* sD = (float*)(lds + GU_SQ);
    if (wave < 4) {
        if (lane < 16) {
            float d[16];
#pragma unroll
            for (int i = 0; i < 16; ++i) {
                float a = (i == lane) ? 1.f : 0.f;
                const float* Ai = sA + (16 * wave + i) * GU_LDA + 16 * wave;
#pragma unroll
                for (int j = 0; j < i; ++j) a -= Ai[j] * d[j];
                d[i] = a;
                sD[(wave * 16 + i) * 16 + lane] = a;
            }
        }
    } else {
        bf16_t* att = (bf16_t*)(p.ws + WS_ATT) + (size_t)u * 64 * 64;
        for (int t = tid - 256; t < 512; t += 256) {
            const int i = t >> 3, kk2 = (t >> 2) & 1, qq = t & 3;
            const float4 lo = *(const float4*)(sAT + i * GU_LDA + 32 * kk2 + 4 * qq), hi = *(const float4*)(sAT + i * GU_LDA + 32 * kk2 + 16 + 4 * qq);
            uint4 o; o.x = pack2(lo.x, lo.y); o.y = pack2(lo.z, lo.w); o.z = pack2(hi.x, hi.y); o.w = pack2(hi.z, hi.w);
            *(uint4*)(att + i * 64 + 32 * kk2 + 8 * qq) = o;
        }
    }
    __syncthreads();
    if (wave < 4) {
        const int rr = lane & 15, q4 = lane >> 4;
        f32x4 Tt[4];
#pragma unroll
        for (int m = 0; m < 4; ++m) Tt[m] = (f32x4){0.f, 0.f, 0.f, 0.f};
#pragma unroll
        for (int b = 0; b < 4; ++b) {
            if (b >= wave) {
                f32x4 X = (f32x4){0.f, 0.f, 0.f, 0.f};
#pragma unroll
                for (int kk = 0; kk < 2; ++kk) {
                    if (2 * kk < b) {
                        const float* Ar = sA + (16 * b + rr) * GU_LDA + 32 * kk + 4 * q4;
                        const float4 lo = *(const float4*)Ar;
                        float4 hi = make_float4(0.f, 0.f, 0.f, 0.f);
                        if (2 * kk + 1 < b) hi = *(const float4*)(Ar + 16);
                        const u32x4 ap = {pack2(lo.x, lo.y), pack2(lo.z, lo.w), pack2(hi.x, hi.y), pack2(hi.z, hi.w)};
                        const u32x4 bp = {pack2(Tt[2 * kk][0], Tt[2 * kk][1]), pack2(Tt[2 * kk][2], Tt[2 * kk][3]),
                                          pack2(Tt[2 * kk + 1][0], Tt[2 * kk + 1][1]), pack2(Tt[2 * kk + 1][2], Tt[2 * kk + 1][3])};
                        X = __builtin_amdgcn_mfma_f32_16x16x32_bf16(__builtin_bit_cast(bf16x8, ap), __builtin_bit_cast(bf16x8, bp), X, 0, 0, 0);
                    }
                }
                float y[4];
#pragma unroll
                for (int jj = 0; jj < 4; ++jj) y[jj] = ((b == wave && 4 * q4 + jj == rr) ? 1.f : 0.f) - X[jj];
                const float4 dv4 = *(const float4*)(sD + (b * 16 + rr) * 16 + 4 * q4);
                const u32x4 ap = {pack2(dv4.x, dv4.y), pack2(dv4.z, dv4.w), 0u, 0u};
                const u32x4 bp = {pack2(y[0], y[1]), pack2(y[2], y[3]), 0u, 0u};
                const f32x4 z4 = (f32x4){0.f, 0.f, 0.f, 0.f};
                Tt[b] = __builtin_amdgcn_mfma_f32_16x16x32_bf16(__builtin_bit_cast(bf16x8, ap), __builtin_bit_cast(bf16x8, bp), z4, 0, 0, 0);
            }
#pragma unroll
            for (int jj = 0; jj < 4; ++jj) sT[(16 * b + 4 * q4 + jj) * GU_LDT + 16 * wave + rr] = f2bf(Tt[b][jj]);
        }
    }
    __syncthreads();
    {
        const int rr = lane & 15, q4 = lane >> 4;
        bf16_t* ut = (bf16_t*)(p.ws + WS_UT) + (size_t)u * 128 * 64;
        bf16_t* wg = (bf16_t*)(p.ws + WS_W) + (size_t)u * 64 * 128;
        f32x4 au[4], aw[4];
#pragma unroll
        for (int m = 0; m < 4; ++m) { au[m] = (f32x4){0.f, 0.f, 0.f, 0.f}; aw[m] = (f32x4){0.f, 0.f, 0.f, 0.f}; }
#pragma unroll
        for (int kk2 = 0; kk2 < 2; ++kk2) {
            const bf16x8 bv = *(const bf16x8*)(sVBT + (16 * wave + rr) * GU_LDT + kk2 * 32 + 8 * q4);
            const bf16x8 ak = *(const bf16x8*)(sKGT + (16 * wave + rr) * GU_LDT + kk2 * 32 + 8 * q4);
#pragma unroll
            for (int m = 0; m < 4; ++m) {
                const bf16x8 tf = *(const bf16x8*)(sT + (16 * m + rr) * GU_LDT + kk2 * 32 + 8 * q4);
                au[m] = __builtin_amdgcn_mfma_f32_16x16x32_bf16(tf, bv, au[m], 0, 0, 0);
                aw[m] = __builtin_amdgcn_mfma_f32_16x16x32_bf16(ak, tf, aw[m], 0, 0, 0);
            }
        }
#pragma unroll
        for (int m = 0; m < 4; ++m) {
            uint2 o; o.x = pack2(au[m][0], au[m][1]); o.y = pack2(au[m][2], au[m][3]);
            *(uint2*)(ut + (size_t)(16 * wave + rr) * 64 + 16 * m + 4 * q4) = o;
            uint2 w2; w2.x = pack2(aw[m][0], aw[m][1]); w2.y = pack2(aw[m][2], aw[m][3]);
            *(uint2*)(wg + (size_t)(16 * m + rr) * 128 + 32 * (wave >> 1) + 8 * q4 + 4 * (wave & 1)) = w2;
        }
    }
}

constexpr int GS_SW = 0, GS_SQD = 17408, GS_SKDT = 34816, GS_SATT = 53248, GS_BUF = 62464;
typedef unsigned u32x2 __attribute__((ext_vector_type(2)));
__device__ __forceinline__ int gdn_chain_chunk(int dir, int s) { return dir == 0 ? (s < 4 ? NCH_LAT + s : s - 4) : NCH - 1 - s; }
struct GsG1 { u32x4 w[2]; u32x4 att; };
struct GsG2 { u32x2 qlo[2], qhi[2]; float gq[2]; };
struct GsG3 { u32x4 kd[2]; float gk[2]; float gl; u32x2 ut[4]; };
__device__ __forceinline__ void gs_load1(const Params& p, int dh, int c, GsG1& st) {
    const int tid = tid_(); const size_t u = (size_t)dh * NCH + c;
    const bf16_t* wg = (const bf16_t*)(p.ws + WS_W) + u * 64 * 128; const bf16_t* att = (const bf16_t*)(p.ws + WS_ATT) + u * 64 * 64;
#pragma unroll
    for (int q = 0; q < 2; ++q) { const int t = tid + q * NTHREADS; st.w[q] = *(const u32x4*)(wg + (size_t)(t >> 4) * 128 + (t & 15) * 8); }
    st.att = *(const u32x4*)(att + (size_t)(tid >> 3) * 64 + (tid & 7) * 8);
}
__device__ __forceinline__ void gs_store1(const GsG1& st, unsigned char* buf) {
    const int tid = tid_(); bf16_t* sW = (bf16_t*)(buf + GS_SW); bf16_t* sATT = (bf16_t*)(buf + GS_SATT);
#pragma unroll
    for (int q = 0; q < 2; ++q) { const int t = tid + q * NTHREADS; *(u32x4*)(sW + (t >> 4) * GU_LDQ + (t & 15) * 8) = st.w[q]; }
    *(u32x4*)(sATT + (tid >> 3) * GU_LDT + (tid & 7) * 8) = st.att;
}
__device__ __forceinline__ void gs_load2(const Params& p, int dh, int c, GsG2& st) {
    const int tid = tid_(), dir = dh >> 3, head = dh & 7; const size_t u = (size_t)dh * NCH + c;
    const float* gc = (const float*)(p.ws + WS_GC) + u * 64; const bf16_t* qn = (const bf16_t*)(p.ws + WS_QN);
#pragma unroll
    for (int q = 0; q < 2; ++q) {
        const int t = tid + q * NTHREADS, i = t >> 4, kk = (t >> 2) & 3, qq = t & 3;
        const bf16_t* src = qn + (size_t)(c * 64 + (dir ? 63 - i : i)) * 1024 + head * 128 + 32 * kk + 4 * qq;
        st.qlo[q] = *(const u32x2*)src; st.qhi[q] = *(const u32x2*)(src + 16); st.gq[q] = gc[i];
    }
}
__device__ __forceinline__ void gs_store2(const GsG2& st, unsigned char* buf) {
    const int tid = tid_(); bf16_t* sQD = (bf16_t*)(buf + GS_SQD);
#pragma unroll
    for (int q = 0; q < 2; ++q) {
        const int t = tid + q * NTHREADS, i = t >> 4, kk = (t >> 2) & 3, qq = t & 3; const float e = __expf(st.gq[q]);
        u32x4 o; o.x = pack2(lo2f(st.qlo[q].x) * e, hi2f(st.qlo[q].x) * e); o.y = pack2(lo2f(st.qlo[q].y) * e, hi2f(st.qlo[q].y) * e);
        o.z = pack2(lo2f(st.qhi[q].x) * e, hi2f(st.qhi[q].x) * e); o.w = pack2(lo2f(st.qhi[q].y) * e, hi2f(st.qhi[q].y) * e);
        *(u32x4*)(sQD + i * GU_LDQ + 32 * kk + 8 * qq) = o;
    }
}
__device__ __forceinline__ void gs_load3(const Params& p, int dh, int c, GsG3& st) {
    const int tid = tid_(), lane = tid & 63, wave = tid >> 6, dir = dh >> 3, head = dh & 7; const size_t u = (size_t)dh * NCH + c;
    const float* gc = (const float*)(p.ws + WS_GC) + u * 64; const bf16_t* kn = (const bf16_t*)(p.ws + WS_KN);
    st.gl = gc[63];
#pragma unroll
    for (int q = 0; q < 2; ++q) {
        const int t = tid + q * NTHREADS, pos = t >> 4, d8 = (t & 15) * 8;
        st.kd[q] = *(const u32x4*)(kn + (size_t)(c * 64 + (dir ? 63 - pos : pos)) * 1024 + head * 128 + d8); st.gk[q] = gc[pos];
    }
    const bf16_t* ut = (const bf16_t*)(p.ws + WS_UT) + u * 128 * 64 + (size_t)(16 * wave + (lane & 15)) * 64 + 4 * (lane >> 4);
#pragma unroll
    for (int m = 0; m < 4; ++m) st.ut[m] = *(const u32x2*)(ut + 16 * m);
}
__device__ __forceinline__ void gs_store3(const GsG3& st, unsigned char* buf) {
    const int tid = tid_(); bf16_t* sKDT = (bf16_t*)(buf + GS_SKDT);
#pragma unroll
    for (int q = 0; q < 2; ++q) {
        const int t = tid + q * NTHREADS, pos = t >> 4, d8 = (t & 15) * 8; const float e = __expf(st.gl - st.gk[q]);
        const u32x4 kq = st.kd[q]; const int sl = perm_slot64(pos);
        sKDT[(d8 + 0) * GU_LDT + sl] = f2bf(lo2f(kq.x) * e); sKDT[(d8 + 1) * GU_LDT + sl] = f2bf(hi2f(kq.x) * e);
        sKDT[(d8 + 2) * GU_LDT + sl] = f2bf(lo2f(kq.y) * e); sKDT[(d8 + 3) * GU_LDT + sl] = f2bf(hi2f(kq.y) * e);
        sKDT[(d8 + 4) * GU_LDT + sl] = f2bf(lo2f(kq.z) * e); sKDT[(d8 + 5) * GU_LDT + sl] = f2bf(hi2f(kq.z) * e);
        sKDT[(d8 + 6) * GU_LDT + sl] = f2bf(lo2f(kq.w) * e); sKDT[(d8 + 7) * GU_LDT + sl] = f2bf(hi2f(kq.w) * e);
    }
}
__device__ __forceinline__ void gdn_seg_ab(const Params& p, int dh, int k, unsigned char* lds) {
    const int tid = tid_(), lane = tid & 63, wave = tid >> 6, rr = lane & 15, q4 = lane >> 4, dir = dh >> 3;
    const bool first = (k == 0);
    const int s_begin = first ? 0 : 4 + 16 * k, nsteps = first ? 20 : 16;
    f32x4 ScB[8], ScA[8]; bf16x8 SbB[4], SbA[4];
#pragma unroll
    for (int m = 0; m < 8; ++m) {
        ScB[m] = (f32x4){0.f, 0.f, 0.f, 0.f};
#pragma unroll
        for (int jj = 0; jj < 4; ++jj) ScA[m][jj] = (16 * m + 4 * q4 + jj == 16 * wave + rr) ? 1.f : 0.f;
    }
#pragma unroll
    for (int kk = 0; kk < 4; ++kk) {
        SbB[kk] = (bf16x8){0, 0, 0, 0, 0, 0, 0, 0};
        const u32x4 pk = {pack2(ScA[2 * kk][0], ScA[2 * kk][1]), pack2(ScA[2 * kk][2], ScA[2 * kk][3]),
                          pack2(ScA[2 * kk + 1][0], ScA[2 * kk + 1][1]), pack2(ScA[2 * kk + 1][2], ScA[2 * kk + 1][3])};
        SbA[kk] = __builtin_bit_cast(bf16x8, pk);
    }
    u32x2 ucur[4]; float glcur;
    float4* sin_img = (float4*)(p.ws + WS_SIN) + (size_t)(dh * 16) * 4096;
    __syncthreads();
    {
        const int c0 = gdn_chain_chunk(dir, s_begin);
        GsG1 g1; gs_load1(p, dh, c0, g1); gs_store1(g1, lds);
        GsG3 g3; gs_load3(p, dh, c0, g3); gs_store3(g3, lds);
#pragma unroll
        for (int m = 0; m < 4; ++m) ucur[m] = g3.ut[m];
        glcur = g3.gl;
    }
    __syncthreads();
#pragma unroll 1
    for (int t = 0; t < nsteps; ++t) {
        const int s = s_begin + t;
        const int cn = gdn_chain_chunk(dir, t + 1 < nsteps ? s + 1 : s);
        const unsigned char* buf = lds + (t & 1) * GS_BUF; unsigned char* nbuf = lds + ((t + 1) & 1) * GS_BUF;
        const bf16_t* sW = (const bf16_t*)(buf + GS_SW); const bf16_t* sKDT = (const bf16_t*)(buf + GS_SKDT);
        GsG1 g1; gs_load1(p, dh, cn, g1);
        f32x4 vb_[4], va_[4];
#pragma unroll
        for (int m = 0; m < 4; ++m) {
            f32x4 accb = (f32x4){0.f, 0.f, 0.f, 0.f}, acca = (f32x4){0.f, 0.f, 0.f, 0.f};
#pragma unroll
            for (int kk = 0; kk < 4; ++kk) {
                const bf16x8 a = *(const bf16x8*)(sW + (16 * m + rr) * GU_LDQ + kk * 32 + 8 * q4);
                accb = __builtin_amdgcn_mfma_f32_16x16x32_bf16(a, SbB[kk], accb, 0, 0, 0);
                if (!first) acca = __builtin_amdgcn_mfma_f32_16x16x32_bf16(a, SbA[kk], acca, 0, 0, 0);
            }
            vb_[m][0] = lo2f(ucur[m].x) - accb[0]; vb_[m][1] = hi2f(ucur[m].x) - accb[1]; vb_[m][2] = lo2f(ucur[m].y) - accb[2]; vb_[m][3] = hi2f(ucur[m].y) - accb[3];
            va_[m] = -acca;
        }
        bf16x8 VBb[2], VBa[2];
#pragma unroll
        for (int k2 = 0; k2 < 2; ++k2) {
            const u32x4 pb = {pack2(vb_[2 * k2][0], vb_[2 * k2][1]), pack2(vb_[2 * k2][2], vb_[2 * k2][3]), pack2(vb_[2 * k2 + 1][0], vb_[2 * k2 + 1][1]), pack2(vb_[2 * k2 + 1][2], vb_[2 * k2 + 1][3])};
            const u32x4 pa = {pack2(va_[2 * k2][0], va_[2 * k2][1]), pack2(va_[2 * k2][2], va_[2 * k2][3]), pack2(va_[2 * k2 + 1][0], va_[2 * k2 + 1][1]), pack2(va_[2 * k2 + 1][2], va_[2 * k2 + 1][3])};
            VBb[k2] = __builtin_bit_cast(bf16x8, pb); VBa[k2] = __builtin_bit_cast(bf16x8, pa);
        }
        gs_store1(g1, nbuf);
        GsG3 g3; gs_load3(p, dh, cn, g3);
        const float egl = __expf(glcur);
#pragma unroll
        for (int m = 0; m < 8; ++m) {
            f32x4 accb = ScB[m] * egl, acca = ScA[m] * egl;
#pragma unroll
            for (int k2 = 0; k2 < 2; ++k2) {
                const bf16x8 a = *(const bf16x8*)(sKDT + (16 * m + rr) * GU_LDT + k2 * 32 + 8 * q4);
                accb = __builtin_amdgcn_mfma_f32_16x16x32_bf16(a, VBb[k2], accb, 0, 0, 0);
                if (!first) acca = __builtin_amdgcn_mfma_f32_16x16x32_bf16(a, VBa[k2], acca, 0, 0, 0);
            }
            ScB[m] = accb; ScA[m] = acca;
        }
#pragma unroll
        for (int kk = 0; kk < 4; ++kk) {
            const u32x4 pb = {pack2(ScB[2 * kk][0], ScB[2 * kk][1]), pack2(ScB[2 * kk][2], ScB[2 * kk][3]), pack2(ScB[2 * kk + 1][0], ScB[2 * kk + 1][1]), pack2(ScB[2 * kk + 1][2], ScB[2 * kk + 1][3])};
            const u32x4 pa = {pack2(ScA[2 * kk][0], ScA[2 * kk][1]), pack2(ScA[2 * kk][2], ScA[2 * kk][3]), pack2(ScA[2 * kk + 1][0], ScA[2 * kk + 1][1]), pack2(ScA[2 * kk + 1][2], ScA[2 * kk + 1][3])};
            SbB[kk] = __builtin_bit_cast(bf16x8, pb); SbA[kk] = __builtin_bit_cast(bf16x8, pa);
        }
        gs_store3(g3, nbuf);
#pragma unroll
        for (int m = 0; m < 4; ++m) ucur[m] = g3.ut[m];
        glcur = g3.gl;
        if (first && t == 3) {
#pragma unroll
            for (int m = 0; m < 8; ++m) sin_img[(wave * 8 + m) * 64 + lane] = make_float4(ScB[m][0], ScB[m][1], ScB[m][2], ScB[m][3]);
        }
        __syncthreads();
    }
    if (first) {
#pragma unroll
        for (int m = 0; m < 8; ++m) sin_img[4096 + (wave * 8 + m) * 64 + lane] = make_float4(ScB[m][0], ScB[m][1], ScB[m][2], ScB[m][3]);
    } else {
        float4* bimg = (float4*)(p.ws + WS_BSEG) + (size_t)(dh * 16 + k) * 4096;
        bf16_t* aseg = (bf16_t*)(p.ws + WS_ASEG) + (size_t)(dh * 16 + k) * 128 * 128;
        const int pc = perm_slot64(16 * wave + rr);
#pragma unroll
        for (int m = 0; m < 8; ++m) {
            bimg[(wave * 8 + m) * 64 + lane] = make_float4(ScB[m][0], ScB[m][1], ScB[m][2], ScB[m][3]);
#pragma unroll
            for (int jj = 0; jj < 4; ++jj) aseg[(size_t)(16 * m + 4 * q4 + jj) * 128 + pc] = f2bf(ScA[m][jj]);
        }
    }
}
__device__ __forceinline__ void gdn_seg_chain(const Params& p, int dh, unsigned char* lds) {
    const int tid = tid_(), lane = tid & 63, wave = tid >> 6, rr = lane & 15, q4 = lane >> 4;
    float4* sin_img = (float4*)(p.ws + WS_SIN) + (size_t)(dh * 16) * 4096;
    const float4* bimg = (const float4*)(p.ws + WS_BSEG) + (size_t)(dh * 16) * 4096;
    const bf16_t* aseg = (const bf16_t*)(p.ws + WS_ASEG) + (size_t)(dh * 16) * 128 * 128;
    f32x4 Sc[8]; bf16x8 Sb[4];
#pragma unroll
    for (int m = 0; m < 8; ++m) { const float4 v = sin_img[4096 + (wave * 8 + m) * 64 + lane]; Sc[m] = (f32x4){v.x, v.y, v.z, v.w}; }
    u32x4 ar[4];
    __syncthreads();
#pragma unroll
    for (int q = 0; q < 4; ++q) { const int t = tid + q * NTHREADS; ar[q] = *(const u32x4*)(aseg + (size_t)1 * 16384 + (size_t)(t >> 4) * 128 + (t & 15) * 8); }
#pragma unroll
    for (int q = 0; q < 4; ++q) { const int t = tid + q * NTHREADS; *(u32x4*)((bf16_t*)lds + (t >> 4) * GU_LDQ + (t & 15) * 8) = ar[q]; }
    __syncthreads();
#pragma unroll 1
    for (int k = 1; k <= 14; ++k) {
        const bf16_t* sA = (const bf16_t*)(lds + ((k - 1) & 1) * 34816);
        if (k < 14) {
#pragma unroll
            for (int q = 0; q < 4; ++q) { const int t = tid + q * NTHREADS; ar[q] = *(const u32x4*)(aseg + (size_t)(k + 1) * 16384 + (size_t)(t >> 4) * 128 + (t & 15) * 8); }
        }
#pragma unroll
        for (int kk = 0; kk < 4; ++kk) {
            const u32x4 pk = {pack2(Sc[2 * kk][0], Sc[2 * kk][1]), pack2(Sc[2 * kk][2], Sc[2 * kk][3]), pack2(Sc[2 * kk + 1][0], Sc[2 * kk + 1][1]), pack2(Sc[2 * kk + 1][2], Sc[2 * kk + 1][3])};
            Sb[kk] = __builtin_bit_cast(bf16x8, pk);
        }
#pragma unroll
        for (int m = 0; m < 8; ++m) {
            const float4 bv = bimg[(size_t)k * 4096 + (wave * 8 + m) * 64 + lane];
            f32x4 acc = (f32x4){bv.x, bv.y, bv.z, bv.w};
#pragma unroll
            for (int kk = 0; kk < 4; ++kk)
                acc = __builtin_amdgcn_mfma_f32_16x16x32_bf16(*(const bf16x8*)(sA + (16 * m + rr) * GU_LDQ + kk * 32 + 8 * q4), Sb[kk], acc, 0, 0, 0);
            Sc[m] = acc;
            sin_img[(size_t)(k + 1) * 4096 + (wave * 8 + m) * 64 + lane] = make_float4(acc[0], acc[1], acc[2], acc[3]);
        }
        if (k < 14) {
#pragma unroll
            for (int q = 0; q < 4; ++q) { const int t = tid + q * NTHREADS; *(u32x4*)((bf16_t*)(lds + (k & 1) * 34816) + (t >> 4) * GU_LDQ + (t & 15) * 8) = ar[q]; }
        }
        __syncthreads();
    }
}
__device__ __forceinline__ void gdn_seq(const Params& p, int dh, int k, unsigned char* lds) {
    const int tid = tid_(), lane = tid & 63, wave = tid >> 6, rr = lane & 15, q4 = lane >> 4, dir = dh >> 3, head = dh & 7;
    const int s_begin = 4 + 16 * k;
    f32x4 Sc[8]; bf16x8 Sb[4];
    {
        const float4* sin_img = (const float4*)(p.ws + WS_SIN) + (size_t)(dh * 16 + k) * 4096;
#pragma unroll
        for (int m = 0; m < 8; ++m) { const float4 v = sin_img[(wave * 8 + m) * 64 + lane]; Sc[m] = (f32x4){v.x, v.y, v.z, v.w}; }
#pragma unroll
        for (int kk = 0; kk < 4; ++kk) {
            const u32x4 pk = {pack2(Sc[2 * kk][0], Sc[2 * kk][1]), pack2(Sc[2 * kk][2], Sc[2 * kk][3]), pack2(Sc[2 * kk + 1][0], Sc[2 * kk + 1][1]), pack2(Sc[2 * kk + 1][2], Sc[2 * kk + 1][3])};
            Sb[kk] = __builtin_bit_cast(bf16x8, pk);
        }
    }
    u32x2 ucur[4]; float glcur;
    __syncthreads();
    {
        const int c0 = gdn_chain_chunk(dir, s_begin);
        GsG1 g1; gs_load1(p, dh, c0, g1); gs_store1(g1, lds);
        GsG2 g2; gs_load2(p, dh, c0, g2); gs_store2(g2, lds);
        GsG3 g3; gs_load3(p, dh, c0, g3); gs_store3(g3, lds);
#pragma unroll
        for (int m = 0; m < 4; ++m) ucur[m] = g3.ut[m];
        glcur = g3.gl;
    }
    __syncthreads();
    bf16_t* of = (bf16_t*)(p.ws + WS_OF) + (size_t)dir * SEQ * 1024;
#pragma unroll 1
    for (int t = 0; t < 16; ++t) {
        const int s = s_begin + t;
        const int c = gdn_chain_chunk(dir, s);
        const int cn = gdn_chain_chunk(dir, t + 1 < 16 ? s + 1 : s);
        const unsigned char* buf = lds + (t & 1) * GS_BUF; unsigned char* nbuf = lds + ((t + 1) & 1) * GS_BUF;
        const bf16_t* sW = (const bf16_t*)(buf + GS_SW); const bf16_t* sQD = (const bf16_t*)(buf + GS_SQD);
        const bf16_t* sKDT = (const bf16_t*)(buf + GS_SKDT); const bf16_t* sATT = (const bf16_t*)(buf + GS_SATT);
        GsG1 g1; gs_load1(p, dh, cn, g1);
        f32x4 vn[4];
#pragma unroll
        for (int m = 0; m < 4; ++m) {
            f32x4 acc = (f32x4){0.f, 0.f, 0.f, 0.f};
#pragma unroll
            for (int kk = 0; kk < 4; ++kk)
                acc = __builtin_amdgcn_mfma_f32_16x16x32_bf16(*(const bf16x8*)(sW + (16 * m + rr) * GU_LDQ + kk * 32 + 8 * q4), Sb[kk], acc, 0, 0, 0);
            vn[m][0] = lo2f(ucur[m].x) - acc[0]; vn[m][1] = hi2f(ucur[m].x) - acc[1]; vn[m][2] = lo2f(ucur[m].y) - acc[2]; vn[m][3] = hi2f(ucur[m].y) - acc[3];
        }
        bf16x8 VB[2];
#pragma unroll
        for (int k2 = 0; k2 < 2; ++k2) {
            const unsigned a0 = pack2(vn[2 * k2][0], vn[2 * k2][1]), a1 = pack2(vn[2 * k2][2], vn[2 * k2][3]);
            const unsigned a2 = pack2(vn[2 * k2 + 1][0], vn[2 * k2 + 1][1]), a3 = pack2(vn[2 * k2 + 1][2], vn[2 * k2 + 1][3]);
            const u32x4 pk = {a0, a1, a2, a3}; VB[k2] = __builtin_bit_cast(bf16x8, pk);
        }
        gs_store1(g1, nbuf);
        GsG2 g2; gs_load2(p, dh, cn, g2);
#pragma unroll
        for (int m = 0; m < 4; ++m) {
            f32x4 acc = (f32x4){0.f, 0.f, 0.f, 0.f};
#pragma unroll
            for (int kk = 0; kk < 4; ++kk)
                acc = __builtin_amdgcn_mfma_f32_16x16x32_bf16(*(const bf16x8*)(sQD + (16 * m + rr) * GU_LDQ + kk * 32 + 8 * q4), Sb[kk], acc, 0, 0, 0);
#pragma unroll
            for (int k2 = 0; k2 < 2; ++k2)
                acc = __builtin_amdgcn_mfma_f32_16x16x32_bf16(*(const bf16x8*)(sATT + (16 * m + rr) * GU_LDT + k2 * 32 + 8 * q4), VB[k2], acc, 0, 0, 0);
#pragma unroll
            for (int jj = 0; jj < 4; ++jj) {
                const int pos = 16 * m + 4 * q4 + jj;
                of[(size_t)(c * 64 + (dir ? 63 - pos : pos)) * 1024 + head * 128 + 16 * wave + rr] = f2bf(acc[jj]);
            }
        }
        gs_store2(g2, nbuf);
        GsG3 g3; gs_load3(p, dh, cn, g3);
        const float egl = __expf(glcur);
#pragma unroll
        for (int m = 0; m < 8; ++m) {
            f32x4 acc = Sc[m] * egl;
#pragma unroll
            for (int k2 = 0; k2 < 2; ++k2)
                acc = __builtin_amdgcn_mfma_f32_16x16x32_bf16(*(const bf16x8*)(sKDT + (16 * m + rr) * GU_LDT + k2 * 32 + 8 * q4), VB[k2], acc, 0, 0, 0);
            Sc[m] = acc;
        }
#pragma unroll
        for (int kk = 0; kk < 4; ++kk) {
            const u32x4 pk = {pack2(Sc[2 * kk][0], Sc[2 * kk][1]), pack2(Sc[2 * kk][2], Sc[2 * kk][3]),
                              pack2(Sc[2 * kk + 1][0], Sc[2 * kk + 1][1]), pack2(Sc[2 * kk + 1][2], Sc[2 * kk + 1][3])};
            Sb[kk] = __builtin_bit_cast(bf16x8, pk);
        }
        gs_store3(g3, nbuf);
#pragma unroll
        for (int m = 0; m < 4; ++m) ucur[m] = g3.ut[m];
        glcur = g3.gl;
        __syncthreads();
    }
}

__device__ __forceinline__ void gdn_readout_row(const Params& p, int row) {
    const int lane = tid_() & 63, head = lane >> 3, d0 = (lane & 7) * 16;
    const bf16_t* of0 = (const bf16_t*)(p.ws + WS_OF) + (size_t)row * 1024 + head * 128 + d0;
    const bf16_t* of1 = of0 + (size_t)SEQ * 1024;
    const bf16_t* zp = (const bf16_t*)(p.ws + WS_Z) + (size_t)row * 1024 + head * 128 + d0;
    float a[16], b[16], z[16];
    unpack8(*(const uint4*)of0, a); unpack8(*(const uint4*)(of0 + 8), a + 8);
    unpack8(*(const uint4*)of1, b); unpack8(*(const uint4*)(of1 + 8), b + 8);
    unpack8(*(const uint4*)zp, z); unpack8(*(const uint4*)(zp + 8), z + 8);
    float ss = 0.f;
#pragma unroll
    for (int e = 0; e < 16; ++e) { a[e] += b[e]; ss += a[e] * a[e]; }
    ss += __shfl_xor(ss, 1, 64); ss += __shfl_xor(ss, 2, 64); ss += __shfl_xor(ss, 4, 64);
    const float rs = rsqrtf(ss * (1.f / 128.f) + 1e-6f);
    const float* ng = p.in[25] + d0;
    float f[16];
#pragma unroll
    for (int e = 0; e < 16; ++e) f[e] = a[e] * rs * ng[e] * siluf_(z[e]);
    bf16_t* dst = (bf16_t*)(p.ws + WS_VN) + (size_t)row * 1024 + head * 128 + d0;
    *(uint4*)dst = pack8(f); *(uint4*)(dst + 8) = pack8(f + 8);
}

#define XB_TMO      128
#define XB_XCNT(j)  (256  + 64 * (j))
#define XB_XSUB(j)  (1280 + 64 * (j))
#define XB_XGEN(j)  (2304 + 64 * (j))
#define XB_TOP      3328
#define XB_TOPGEN   3392
#define XCD_BAR_WORDS 3456
#define XB_SPIN_CAP (1u << 22)
#define LAS __attribute__((address_space(3)))
__device__ __forceinline__ unsigned xb_ld(unsigned* p)              { return __hip_atomic_load(p, __ATOMIC_RELAXED, __HIP_MEMORY_SCOPE_AGENT); }
__device__ __forceinline__ unsigned xb_add(unsigned* p, unsigned v) { return __hip_atomic_fetch_add(p, v, __ATOMIC_RELAXED, __HIP_MEMORY_SCOPE_AGENT); }
__device__ __forceinline__ unsigned xb_xcc_id() { return (unsigned)__builtin_amdgcn_s_getreg((3 << 11) | 20) & 0xFu; }
#define XB_SPIN(cond, bar) do { unsigned _sp = 0; while (cond) { __builtin_amdgcn_s_sleep(1); \
    if ((++_sp & 255u) == 0u) { if (xb_ld(&(bar)[XB_TMO])) break; if (_sp > XB_SPIN_CAP) { atomicAdd(&(bar)[XB_TMO], 1u); break; } } } } while (0)
struct XcdBarrier { unsigned* bar; unsigned x; volatile LAS unsigned* st; };
__device__ __forceinline__ XcdBarrier xcd_barrier_post(unsigned* bar, volatile LAS unsigned* st) {
    XcdBarrier b; b.bar = bar; b.x = xb_xcc_id(); b.st = st;
    if (threadIdx.x == 0) (void)xb_add(&bar[XB_XCNT(b.x)], 1u);
    return b;
}
__device__ __forceinline__ void xcd_barrier_complete(unsigned* bar, unsigned x, unsigned& nloc, unsigned& nx) {
    const unsigned G = gridDim.x * gridDim.y * gridDim.z;
    unsigned sum, cnt, mine, sp = 0u;
    for (;;) {
        sum = 0u; cnt = 0u; mine = 0u;
#pragma unroll
        for (unsigned j = 0; j < 16; ++j) { const unsigned c = xb_ld(&bar[XB_XCNT(j)]); sum += c; cnt += (c > 0u) ? 1u : 0u; mine = (j == x) ? c : mine; }
        if (sum == G) break;
        __builtin_amdgcn_s_sleep(1);
        if ((++sp & 255u) == 0u) { if (xb_ld(&bar[XB_TMO])) break; if (sp > XB_SPIN_CAP) { atomicAdd(&bar[XB_TMO], 1u); break; } }
    }
    nloc = mine > 0u ? mine : 1u; nx = cnt > 0u ? cnt : 1u;
}
__device__ __forceinline__ void xcd_barrier(const XcdBarrier& b) {
    asm volatile("s_waitcnt vmcnt(0)" ::: "memory");
    __syncthreads();
    if (threadIdx.x == 0) {
        unsigned* bar = b.bar;
        __builtin_amdgcn_s_waitcnt(0);
        unsigned nloc = b.st[0], nx = b.st[1];
        if (nloc == 0u) { xcd_barrier_complete(bar, b.x, nloc, nx); b.st[0] = nloc; b.st[1] = nx; }
        const unsigned old = xb_add(&bar[XB_XSUB(b.x)], 1u);
        const unsigned gen = old / nloc;
        if (old + 1u == (gen + 1u) * nloc) {
            __builtin_amdgcn_fence(__ATOMIC_RELEASE, "agent");
            asm volatile("s_waitcnt vmcnt(0)" ::: "memory");
            const unsigned og = xb_add(&bar[XB_TOP], 1u);
            const unsigned tg = og / nx;
            if (og + 1u == (tg + 1u) * nx) xb_add(&bar[XB_TOPGEN], 1u);
            else XB_SPIN(xb_ld(&bar[XB_TOPGEN]) == tg, bar);
            __builtin_amdgcn_fence(__ATOMIC_ACQUIRE, "agent");
            xb_add(&bar[XB_XGEN(b.x)], 1u);
            asm volatile("s_waitcnt vmcnt(0)" ::: "memory");
        } else {
            XB_SPIN(xb_ld(&bar[XB_XGEN(b.x)]) == gen, bar);
            __builtin_amdgcn_fence(__ATOMIC_ACQUIRE, "agent");
            asm volatile("s_waitcnt vmcnt(0)" ::: "memory");
        }
    }
    __syncthreads();
}

#ifndef PHMASK
#define PHMASK 0xFFFFFFFFull
#endif
#define PH(n) (((PHMASK) >> (n)) & 1ull)
#define FOR_ITEMS(n) for (int item = blockIdx.x; item < (n); item += gridDim.x)
__global__ void __launch_bounds__(NTHREADS) fwd_megakernel(Params p) {
    extern __shared__ __attribute__((aligned(16))) unsigned char lds[];
    cg::grid_group grid = cg::this_grid();
    unsigned char* ws = p.ws;
    volatile LAS unsigned* xbst = (volatile LAS unsigned*)(LAS unsigned char*)(lds + LDS_BYTES - 16);
    if (threadIdx.x == 0) { xbst[0] = 0u; xbst[1] = 0u; }
    __syncthreads();
    const XcdBarrier xbar = xcd_barrier_post((unsigned*)(ws + WS_BAR), xbst);

    if (PH(0)) {
        constexpr int N_S5 = 64, N_ADA = 192, N_T0 = 512, N_T1 = 64, N_T2 = 256, N_T3 = 16 * 65, N_T4 = 256, N_T5 = 512, N_T6 = 512, N_SK = 16, N_PT = 4096;
        constexpr int O1 = N_S5, O2 = O1 + N_ADA, O3 = O2 + N_T0, O4 = O3 + N_T1, O5 = O4 + N_T2, O6 = O5 + N_T3, O7 = O6 + N_T4, O8 = O7 + N_T5, O9 = O8 + N_T6, O10 = O9 + N_SK, O11 = O10 + N_PT;
        FOR_ITEMS(O11) {
            if (item < O1) p0_s5_tables(p, item, lds);
            else if (item < O2) p0_adaln(p, item - O1, lds);
            else if (item < O3) p0_transpose(p.in[8], 1024, 2048, (bf16_t*)(ws + WS_WEIN), item - O2, lds);
            else if (item < O4) p0_transpose(p.in[18], 512, 512, (bf16_t*)(ws + WS_WGLU), item - O3, lds);
            else if (item < O5) p0_transpose(p.in[20], 1024, 1024, (bf16_t*)(ws + WS_WEOUT), item - O4, lds);
            else if (item < O6) p0_transpose(p.in[21], 1024, ODD_IN, (bf16_t*)(ws + WS_WOIN), item - O5, lds);
            else if (item < O7) p0_transpose(p.in[26], 1024, 1024, (bf16_t*)(ws + WS_WOOUT), item - O6, lds);
            else if (item < O8) p0_transpose(p.in[27], 1024, 2048, (bf16_t*)(ws + WS_WQ0), item - O7, lds);
            else if (item < O9) p0_transpose(p.in[27] + (size_t)1024 * 2048, 1024, 2048, (bf16_t*)(ws + WS_WQ1), item - O8, lds);
            else if (item < O10) cvt_chunk(p.in[28], (bf16_t*)(ws + WS_SK), item - O9);
            else peer_tables_item(p, item - O10, 0);
        }
    }
    grid.sync();
    if (PH(1)) FOR_ITEMS(2080 + 2048) {
        if (item < 2080) norm_rows_item(p, item, 0, p.in[6], 0, true);
        else s5_mintra_item(p, item - 2080);
    }
    xcd_barrier(xbar);
    if (PH(2)) FOR_ITEMS(130 * 16) {
        EpiEvenIn e{(bf16_t*)(ws + WS_PA), (bf16_t*)(ws + WS_UG)};
        gemm_tile((const bf16_t*)(ws + WS_ACT), 1024, R, (const bf16_t*)(ws + WS_WEIN), 1024, 2048, 1024, (item >> 4) * 128, (item & 15) * 128, e, lds);
    }
    xcd_barrier(xbar);
    if (PH(3)) FOR_ITEMS(32 * 30) {
        const int g = item / 30, r = item % 30, tm = r / 10, tn = r % 10;
        EpiS5Local e{(float*)(ws + WS_YL), (float*)(ws + WS_LST), g};
        gemm_tile((const bf16_t*)(ws + WS_UG) + (size_t)g * NCH * 1024, 1024, NCH, (const bf16_t*)(ws + WS_MS5) + (size_t)g * 1280 * 1024, 1024, 1280, 1024, tm * 128, tn * 128, e, lds);
    }
    xcd_barrier(xbar);
    if (PH(4)) s5_scan(p);
    xcd_barrier(xbar);
    if (PH(5)) FOR_ITEMS(32 * 24) {
        const int g = item / 24, r = item % 24, tm = r / 8, tn = r % 8;
        EpiS5Out e{(const float*)(ws + WS_YL), (bf16_t*)(ws + WS_GS), g};
        gemm_tile((const bf16_t*)(ws + WS_A5) + (size_t)g * NCH * 256, 256, NCH, (const bf16_t*)(ws + WS_O5) + (size_t)g * 1024 * 256, 256, 1024, 256, tm * 128, tn * 128, e, lds);
    }
    xcd_barrier(xbar);
    if (PH(6)) FOR_ITEMS(130 * 4 + NCH) {
        if (item < 520) {
            EpiGlu e{(const bf16_t*)(ws + WS_GS), p.in[19], (bf16_t*)(ws + WS_CB)};
            gemm_tile((const bf16_t*)(ws + WS_GS), 512, R, (const bf16_t*)(ws + WS_WGLU), 512, 512, 512, (item >> 2) * 128, (item & 3) * 128, e, lds);
        } else even_conv_item(p, item - 520);
    }
    xcd_barrier(xbar);
    if (PH(7)) FOR_ITEMS(130 * 8) {
        EpiResid e{p.in[0], p.in[2], (float*)(ws + WS_H), (const float*)(ws + WS_MOD), 0, true};
        gemm_tile((const bf16_t*)(ws + WS_CB), 1024, R, (const bf16_t*)(ws + WS_WEOUT), 1024, 1024, 1024, (item >> 3) * 128, (item & 7) * 128, e, lds);
    }
    xcd_barrier(xbar);
#pragma unroll 1
    for (int l = 0; l < 2; ++l) {
        const int nrows = l == 0 ? R : SEQ, ntm = nrows / 128;
        if (l == 1) {
            if (PH(13)) FOR_ITEMS(2080) norm_rows_item(p, item, 1, p.in[6] + 1024, 0, false);
            xcd_barrier(xbar);
            if (PH(14)) FOR_ITEMS(130 * 33) {
                EpiOddIn e{(bf16_t*)(ws + WS_QKVR), (bf16_t*)(ws + WS_Z), (float*)(ws + WS_AB)};
                gemm_tile((const bf16_t*)(ws + WS_ACT), 1024, R, (const bf16_t*)(ws + WS_WOIN), 1024, ODD_IN, 1024, (item / 33) * 128, (item % 33) * 128, e, lds);
            }
            xcd_barrier(xbar);
            if (PH(15)) FOR_ITEMS(NCH) gdn_prep_item(p, item);
            xcd_barrier(xbar);
            if (PH(16)) FOR_ITEMS(NUNITS) gdn_unit(p, item, lds);
            xcd_barrier(xbar);
            if (PH(17)) {
                FOR_ITEMS(256) { if ((item & 15) != 15) gdn_seg_ab(p, item >> 4, item & 15, lds); }
                xcd_barrier(xbar);
                if (blockIdx.x < 16) gdn_seg_chain(p, blockIdx.x, lds);
                xcd_barrier(xbar);
                FOR_ITEMS(256) gdn_seq(p, item >> 4, item & 15, lds);
            }
            xcd_barrier(xbar);
            if (PH(18)) FOR_ITEMS(SEQ / 8) gdn_readout_row(p, item * 8 + (tid_() >> 6));
            xcd_barrier(xbar);
            if (PH(19)) FOR_ITEMS(128 * 8 + 4096) {
                if (item < 1024) {
                    EpiResid e{p.in[0], p.in[2], (float*)(ws + WS_H), (const float*)(ws + WS_MOD), 1, false};
                    gemm_tile((const bf16_t*)(ws + WS_VN), 1024, SEQ, (const bf16_t*)(ws + WS_WOOUT), 1024, 1024, 1024, (item >> 3) * 128, (item & 7) * 128, e, lds);
                } else peer_tables_item(p, item - 1024, 1);
            }
            xcd_barrier(xbar);
        }
        if (PH(8)) FOR_ITEMS(nrows / 8) norm_rows_item(p, item, l, p.in[7] + l * 1024, 3, false);
        xcd_barrier(xbar);
        if (PH(9)) FOR_ITEMS(ntm * 16) {
            EpiBf16 e{(bf16_t*)(ws + WS_Q), 2048};
            gemm_tile((const bf16_t*)(ws + WS_ACT), 1024, nrows, (const bf16_t*)(ws + (l == 0 ? WS_WQ0 : WS_WQ1)), 1024, 2048, 1024, (item >> 4) * 128, (item & 15) * 128, e, lds);
        }
        xcd_barrier(xbar);
        if (PH(10)) FOR_ITEMS(ntm * 16) {
            const int b = item & 15;
            EpiScore e{(unsigned short*)(ws + WS_SC), b * 128};
            gemm_tile((const bf16_t*)(ws + WS_Q) + b * 128, 2048, nrows, (const bf16_t*)(ws + WS_SK) + (size_t)(l * 2 + (b & 1)) * 128 * 128, 128, 128, 128, (item >> 4) * 128, 0, e, lds);
        }
        xcd_barrier(xbar);
        if (PH(11)) FOR_ITEMS(nrows / 64) peer_route_item(p, item, nrows, lds);
        xcd_barrier(xbar);
        if (PH(12)) FOR_ITEMS(nrows / 8) peer_gather_row(p, item * 8 + (tid_() >> 6), l, l == 1);
        if (l == 0) xcd_barrier(xbar);
    }
}

extern "C" void kernel_launch(void* const* d_in, const int* in_sizes, int n_in, void* d_out, int out_size, void* d_ws, size_t ws_size, hipStream_t stream) {
    static int grid_blocks = 0;
    if (grid_blocks == 0) {
        if (n_in != 32 || out_size != SEQ * D || ws_size < WS_NEED) {
            fprintf(stderr, "kernel_launch: unexpected problem (n_in %d, out %d, ws %zu, need %zu); nothing launched\n", n_in, out_size, ws_size, (size_t)WS_NEED);
            grid_blocks = -1; return;
        }
        int dev = 0, cus = 0, per_cu = 0;
        hipGetDevice(&dev);
        hipDeviceGetAttribute(&cus, hipDeviceAttributeMultiprocessorCount, dev);
        hipFuncSetAttribute((const void*)fwd_megakernel, hipFuncAttributeMaxDynamicSharedMemorySize, LDS_BYTES);
        hipOccupancyMaxActiveBlocksPerMultiprocessor(&per_cu, (const void*)fwd_megakernel, NTHREADS, LDS_BYTES);
        if (per_cu < 1) { fprintf(stderr, "kernel_launch: occupancy query says %d blocks per CU; nothing launched\n", per_cu); grid_blocks = -1; return; }
        grid_blocks = cus;
    }
    if (grid_blocks < 0) return;
    (void)hipMemsetAsync((unsigned char*)d_ws + WS_BAR, 0, XCD_BAR_WORDS * 4, stream);
    Params prm{};
    for (int i = 0; i < 32; ++i) prm.in[i] = (const float*)d_in[i];
    prm.out = (float*)d_out; prm.ws = (unsigned char*)d_ws;
    void* args[] = {&prm};
    hipError_t e = hipLaunchCooperativeKernel((const void*)fwd_megakernel, dim3(grid_blocks), dim3(NTHREADS), args, LDS_BYTES, stream);
    if (e != hipSuccess) fprintf(stderr, "cooperative launch failed: %s (grid %d)\n", hipGetErrorString(e), grid_blocks);
}
```

```cpp
#include <hip/hip_runtime.h>
#include <hip/hip_cooperative_groups.h>
#include <cstdio>
#include <cstdint>
namespace cg = cooperative_groups;

typedef unsigned short bf16_t;
typedef short bf16x8 __attribute__((ext_vector_type(8)));
typedef float f32x4 __attribute__((ext_vector_type(4)));
typedef float f32x16 __attribute__((ext_vector_type(16)));
typedef unsigned u32x4 __attribute__((ext_vector_type(4)));

constexpr int D = 1024, SEQ = 16384, CTX = 256, R = SEQ + CTX;
constexpr int NCH = R / 64;
constexpr int NCH_LAT = SEQ / 64;
constexpr int NTHREADS = 512;
constexpr int ODD_IN = 4128;
constexpr int NUNITS = 16 * NCH;

constexpr size_t al256(size_t x) { return (x + 255) & ~(size_t)255; }
constexpr size_t WS_BAR   = 0;
constexpr size_t WS_MOD   = 16384;
constexpr size_t WS_A64   = WS_MOD + al256(2 * 2 * 6 * 1024 * 4);
constexpr size_t WS_SK    = WS_A64 + al256(2 * 32 * 64 * 8);
constexpr size_t WS_PSC   = WS_SK + al256(2 * 2 * 128 * 128 * 2);
constexpr size_t WS_WEIN  = WS_PSC + al256(2 * 16384 * 4);
constexpr size_t WS_WGLU  = WS_WEIN + (size_t)2048 * 1024 * 2;
constexpr size_t WS_WEOUT = WS_WGLU + (size_t)512 * 512 * 2;
constexpr size_t WS_WQ0   = WS_WEOUT + (size_t)1024 * 1024 * 2;
constexpr size_t WS_WQ1   = WS_WQ0 + (size_t)2048 * 1024 * 2;
constexpr size_t WS_WOIN  = WS_WQ1 + (size_t)2048 * 1024 * 2;
constexpr size_t WS_WOOUT = WS_WOIN + al256((size_t)ODD_IN * 1024 * 2);
constexpr size_t WS_H     = WS_WOOUT + (size_t)1024 * 1024 * 2;
constexpr size_t WS_PUV   = WS_H + (size_t)R * 1024 * 4;
constexpr size_t WS_ACT   = WS_PUV + (size_t)2 * 16384 * 1024 * 2;
constexpr size_t WS_ARENA = WS_ACT + (size_t)R * 1024 * 2;
constexpr size_t WS_GG    = WS_WEIN;
constexpr size_t WS_BETA  = WS_GG + (size_t)16 * R * 4;
constexpr size_t WS_GC    = WS_BETA + (size_t)16 * R * 4;
constexpr size_t WS_AB    = WS_GC + (size_t)NUNITS * 64 * 4;
static_assert(WS_AB + (size_t)R * 32 * 4 <= WS_WQ1, "layer-1 small buffers overflow the dead layer-0 weights");
constexpr size_t WS_PA    = WS_ARENA;
constexpr size_t WS_UG    = WS_PA + (size_t)R * 1536 * 2;
constexpr size_t WS_MS5   = WS_UG + (size_t)32 * NCH * 1024 * 2;
constexpr size_t WS_O5    = WS_MS5 + (size_t)32 * 1280 * 1024 * 2;
constexpr size_t WS_KTAB  = WS_O5 + (size_t)32 * 1024 * 256 * 2;
constexpr size_t WS_YL    = WS_KTAB + (size_t)2 * 32 * 64 * 256 * 4;
constexpr size_t WS_LST   = WS_YL + (size_t)R * 512 * 4;
constexpr size_t WS_A5    = WS_LST + (size_t)32 * NCH * 256 * 4;
constexpr size_t WS_GS    = WS_A5 + (size_t)32 * NCH * 256 * 2;
constexpr size_t WS_CB    = WS_GS + (size_t)R * 512 * 2;
constexpr size_t WS_END_L0 = WS_CB + (size_t)R * 1024 * 2;
constexpr size_t WS_Q     = WS_ARENA;
constexpr size_t WS_SC    = WS_Q + (size_t)R * 2048 * 2;
constexpr size_t WS_IDX   = WS_SC + (size_t)R * 2048 * 2;
constexpr size_t WS_GATE  = WS_IDX + (size_t)R * 128 * 4;
constexpr size_t WS_END_PEER = WS_GATE + (size_t)R * 128 * 4;
constexpr size_t WS_QKVR  = WS_ARENA;
constexpr size_t WS_W     = WS_QKVR;
constexpr size_t WS_ATT   = WS_W + (size_t)NUNITS * 64 * 128 * 2;
static_assert(WS_ATT + (size_t)NUNITS * 64 * 64 * 2 <= WS_QKVR + (size_t)R * 3072 * 2, "W+ATT must fit in QKVR");
constexpr size_t WS_Z     = WS_QKVR + (size_t)R * 3072 * 2;
constexpr size_t WS_QN    = WS_Z + (size_t)R * 1024 * 2;
constexpr size_t WS_KN    = WS_QN + (size_t)R * 1024 * 2;
constexpr size_t WS_VN    = WS_KN + (size_t)R * 1024 * 2;
constexpr size_t WS_UT    = WS_VN + (size_t)R * 1024 * 2;
constexpr size_t WS_END_L1 = WS_UT + (size_t)NUNITS * 128 * 64 * 2;
constexpr size_t WS_OF    = WS_PUV;
constexpr size_t WS_SIN   = WS_ACT;
constexpr size_t WS_BSEG  = WS_SIN + (size_t)256 * 65536;
constexpr size_t WS_ASEG  = WS_VN;
static_assert(WS_BSEG + (size_t)256 * 65536 <= WS_ARENA, "SIN+BSEG must fit in ACT");
constexpr size_t cmax(size_t a, size_t b) { return a > b ? a : b; }
constexpr size_t WS_NEED  = cmax(cmax(WS_END_L0, WS_END_PEER), WS_END_L1);
static_assert(WS_NEED <= (size_t)512 * 1024 * 1024, "workspace plan exceeds 512 MiB");

constexpr int LDS_BYTES = 140 * 1024;

struct Params {
    const float* in[32];
    float* out;
    unsigned char* ws;
};

__device__ __forceinline__ int tid_() { int t = threadIdx.x; asm volatile("" : "+v"(t)); return t; }
__device__ __forceinline__ float bf2f(bf16_t b) { return __uint_as_float((unsigned)b << 16); }
__device__ __forceinline__ bf16_t f2bf(float f) { const __bf16 b = (__bf16)f; return __builtin_bit_cast(bf16_t, b); }
typedef float f32x2_t __attribute__((ext_vector_type(2)));
typedef __bf16 bf16x2_t __attribute__((ext_vector_type(2)));
__device__ __forceinline__ unsigned pack2(float lo, float hi) { const f32x2_t v = {lo, hi}; const bf16x2_t b = __builtin_convertvector(v, bf16x2_t); return __builtin_bit_cast(unsigned, b); }
__device__ __forceinline__ float lo2f(unsigned p) { return __uint_as_float(p << 16); }
__device__ __forceinline__ float hi2f(unsigned p) { return __uint_as_float(p & 0xFFFF0000u); }
__device__ __forceinline__ float sigmoidf_(float x) { return 1.f / (1.f + __expf(-x)); }
__device__ __forceinline__ float siluf_(float x) { return x * sigmoidf_(x); }
__device__ __forceinline__ float gelu_tanh(float x) {
    const float u = 0.7978845608028654f * (x + 0.044715f * x * x * x);
    const float t = 1.f - 2.f / (1.f + __expf(2.f * u));
    return 0.5f * x * (1.f + t);
}
__device__ __forceinline__ float wave_sum(float v) {
#pragma unroll
    for (int o = 32; o > 0; o >>= 1) v += __shfl_xor(v, o, 64);
    return v;
}
__device__ __forceinline__ void unpack8(const uint4& p, float* f) {
    f[0] = lo2f(p.x); f[1] = hi2f(p.x); f[2] = lo2f(p.y); f[3] = hi2f(p.y);
    f[4] = lo2f(p.z); f[5] = hi2f(p.z); f[6] = lo2f(p.w); f[7] = hi2f(p.w);
}
__device__ __forceinline__ uint4 pack8(const float* f) {
    uint4 p; p.x = pack2(f[0], f[1]); p.y = pack2(f[2], f[3]); p.z = pack2(f[4], f[5]); p.w = pack2(f[6], f[7]); return p;
}
__device__ __forceinline__ const float* modp(const Params& p, int l, int row, int j) {
    const float* m = (const float*)(p.ws + WS_MOD);
    return m + ((l * 2 + (row >= SEQ ? 1 : 0)) * 6 + j) * 1024;
}

#define LAS __attribute__((address_space(3)))
constexpr int GT_STAGE = 32768;
template <class Epi>
__device__ __forceinline__ void gemm_tile(const bf16_t* __restrict__ A, int lda, int M, const bf16_t* __restrict__ Bt, int ldb, int N, int K,
                                          int row0, int col0, Epi epi, unsigned char* lds_generic) {
    LAS unsigned char* lds = (LAS unsigned char*)lds_generic;
    const int tid = tid_(), lane = tid & 63, wave = __builtin_amdgcn_readfirstlane(tid >> 6);
    const int wm = wave >> 2, wn = wave & 3, r = lane & 31, h = lane >> 5;
    const bf16_t* ga[2]; const bf16_t* gb[2];
#pragma unroll
    for (int i = 0; i < 2; ++i) {
        const int trow = 8 * (wave + 8 * i) + (lane >> 3), kp = (lane & 7) ^ ((trow >> 1) & 7);
        int ra = row0 + trow, rb = col0 + trow; ra = ra < M ? ra : M - 1; rb = rb < N ? rb : N - 1;
        ga[i] = A + (size_t)ra * lda + kp * 8; gb[i] = Bt + (size_t)rb * ldb + kp * 8;
    }
    f32x16 acc0, acc1;
#pragma unroll
    for (int i = 0; i < 16; ++i) { acc0[i] = 0.f; acc1[i] = 0.f; }
    const int nk = K >> 6;
#define GT_ISSUE(kt_) do { const int st_ = ((kt_) & 3) * GT_STAGE; _Pragma("unroll") for (int i_ = 0; i_ < 2; ++i_) { \
        __builtin_amdgcn_global_load_lds((const unsigned*)(ga[i_] + (kt_) * 64), (LAS unsigned*)(lds + st_ + (wave + 8 * i_) * 1024), 16, 0, 0); \
        __builtin_amdgcn_global_load_lds((const unsigned*)(gb[i_] + (kt_) * 64), (LAS unsigned*)(lds + st_ + 16384 + (wave + 8 * i_) * 1024), 16, 0, 0); } } while (0)
    __syncthreads();
    GT_ISSUE(0);
    if (nk > 1) GT_ISSUE(1);
    if (nk > 2) GT_ISSUE(2);
    const int xs = (r >> 1) & 7;
    const int aoff = (wm * 64 + r) * 128, boff = 16384 + (wn * 32 + r) * 128;
#pragma unroll 1
    for (int kt = 0; kt < nk; ++kt) {
        const int ahead = nk - 1 - kt;
        if (ahead >= 2) asm volatile("s_waitcnt vmcnt(8)" ::: "memory");
        else if (ahead == 1) asm volatile("s_waitcnt vmcnt(4)" ::: "memory");
        else asm volatile("s_waitcnt vmcnt(0)" ::: "memory");
        __builtin_amdgcn_s_barrier();
        asm volatile("" ::: "memory");
        if (kt + 3 < nk) GT_ISSUE(kt + 3);
        const LAS unsigned char* sb = lds + (kt & 3) * GT_STAGE;
#pragma unroll
        for (int s = 0; s < 4; ++s) {
            const int ko = ((2 * s + h) ^ xs) * 16;
            const bf16x8 a0 = *(const LAS bf16x8*)(sb + aoff + ko);
            const bf16x8 a1 = *(const LAS bf16x8*)(sb + aoff + 32 * 128 + ko);
            const bf16x8 b  = *(const LAS bf16x8*)(sb + boff + ko);
            acc0 = __builtin_amdgcn_mfma_f32_32x32x16_bf16(a0, b, acc0, 0, 0, 0);
            acc1 = __builtin_amdgcn_mfma_f32_32x32x16_bf16(a1, b, acc1, 0, 0, 0);
        }
    }
#undef GT_ISSUE
    __builtin_amdgcn_s_barrier();
    asm volatile("" ::: "memory");
    {
        LAS float* sc = (LAS float*)lds;
#pragma unroll
        for (int i = 0; i < 16; ++i) {
            const int rr = wm * 64 + (i & 3) + 8 * (i >> 2) + 4 * h;
            sc[rr * 132 + wn * 32 + r] = acc0[i];
            sc[(rr + 32) * 132 + wn * 32 + r] = acc1[i];
        }
    }
    __syncthreads();
    {
        const LAS float* sc = (const LAS float*)lds;
        const int c8 = (tid & 15) * 8, col = col0 + c8;
#pragma unroll
        for (int ps = 0; ps < 4; ++ps) {
            const int rl = (tid >> 4) + 32 * ps, row = row0 + rl;
            const f32x4 v0 = *(const LAS f32x4*)(sc + rl * 132 + c8), v1 = *(const LAS f32x4*)(sc + rl * 132 + c8 + 4);
            if (row < M && col < N) { const float v[8] = {v0[0], v0[1], v0[2], v0[3], v1[0], v1[1], v1[2], v1[3]}; epi(row, col, v); }
        }
    }
}

__device__ __forceinline__ void p0_adaln(const Params& p, int item, unsigned char* lds) {
    const int l = item / 96, cb = item % 96, tid = tid_();
    const int kq = tid >> 4, c4 = tid & 15;
    const float* W = p.in[4] + (size_t)l * 1024 * 6144 + cb * 64 + c4 * 4;
    const float* c = p.in[1]; const float* cc = p.in[3];
    float al[4] = {0, 0, 0, 0}, ac[4] = {0, 0, 0, 0};
    for (int k = kq; k < 1024; k += 32) {
        const float4 w = *(const float4*)(W + (size_t)k * 6144);
        const float sl = siluf_(c[k]), sc = siluf_(cc[k]);
        al[0] += sl * w.x; al[1] += sl * w.y; al[2] += sl * w.z; al[3] += sl * w.w;
        ac[0] += sc * w.x; ac[1] += sc * w.y; ac[2] += sc * w.z; ac[3] += sc * w.w;
    }
    float* red = (float*)lds;
    __syncthreads();
#pragma unroll
    for (int e = 0; e < 4; ++e) { red[(kq * 2 + 0) * 64 + c4 * 4 + e] = al[e]; red[(kq * 2 + 1) * 64 + c4 * 4 + e] = ac[e]; }
    __syncthreads();
    if (tid < 128) {
        const int s = tid >> 6, cidx = tid & 63;
        float sum = 0.f;
        for (int q = 0; q < 32; ++q) sum += red[(q * 2 + s) * 64 + cidx];
        const int col = cb * 64 + cidx;
        sum += p.in[5][l * 6144 + col];
        ((float*)(p.ws + WS_MOD))[(l * 2 + s) * 6144 + col] = sum;
    }
}
__device__ __forceinline__ void p0_transpose(const float* __restrict__ src, int K, int N, bf16_t* __restrict__ dst, int tile, unsigned char* lds) {
    const int ntn = (N + 63) / 64, tk = tile / ntn, tn = tile % ntn, tid = tid_();
    float* s = (float*)lds;
    __syncthreads();
    for (int e = tid; e < 64 * 64; e += NTHREADS) {
        const int kk = e >> 6, nn = e & 63; const int n = tn * 64 + nn;
        s[kk * 65 + nn] = n < N ? src[(size_t)(tk * 64 + kk) * N + n] : 0.f;
    }
    __syncthreads();
    {
        const int nn = tid >> 3, kg = (tid & 7) * 8; const int n = tn * 64 + nn;
        if (n < N) {
            float f[8];
#pragma unroll
            for (int e = 0; e < 8; ++e) f[e] = s[(kg + e) * 65 + nn];
            *(uint4*)(dst + (size_t)n * K + tk * 64 + kg) = pack8(f);
        }
    }
}
__device__ __forceinline__ void cvt_chunk(const float* __restrict__ src, bf16_t* __restrict__ dst, size_t item) {
    const size_t o = item * 4096 + (size_t)tid_() * 8;
    const float4 a = *(const float4*)(src + o), b = *(const float4*)(src + o + 4);
    uint4 q; q.x = pack2(a.x, a.y); q.y = pack2(a.z, a.w); q.z = pack2(b.x, b.y); q.w = pack2(b.z, b.w);
    *(uint4*)(dst + o) = q;
}
__device__ __forceinline__ void cvt_row_fp8(const float* __restrict__ src, unsigned char* __restrict__ dst, float* __restrict__ inv_scale) {
    const int lane = tid_() & 63;
    float4 v[4]; float am = 0.f;
#pragma unroll
    for (int q = 0; q < 4; ++q) { v[q] = *(const float4*)(src + lane * 16 + q * 4); am = fmaxf(am, fmaxf(fmaxf(fabsf(v[q].x), fabsf(v[q].y)), fmaxf(fabsf(v[q].z), fabsf(v[q].w)))); }
#pragma unroll
    for (int o = 32; o > 0; o >>= 1) am = fmaxf(am, __shfl_xor(am, o, 64));
    const float sc = am > 0.f ? 224.f / am : 1.f;
    u32x4 o;
#pragma unroll
    for (int q = 0; q < 4; ++q) {
        int w = 0;
        w = __builtin_amdgcn_cvt_pk_fp8_f32(v[q].x * sc, v[q].y * sc, w, false);
        w = __builtin_amdgcn_cvt_pk_fp8_f32(v[q].z * sc, v[q].w * sc, w, true);
        o[q] = (unsigned)w;
    }
    *(u32x4*)(dst + lane * 16) = o;
    if (lane == 0) *inv_scale = am > 0.f ? am / 224.f : 1.f;
}
__device__ __forceinline__ void peer_tables_item(const Params& p, int item, int l) {
    const int tab = item >> 11, row = (item & 2047) * 8 + (tid_() >> 6);
    const float* src = (tab ? p.in[30] : p.in[29]) + ((size_t)l * 16384 + row) * 1024;
    cvt_row_fp8(src, p.ws + WS_PUV + ((size_t)tab * 16384 + row) * 1024, (float*)(p.ws + WS_PSC) + tab * 16384 + row);
}

__device__ __forceinline__ void sincos_d(double x, double& s, double& c) {
    const double TWO_OVER_PI = 0.63661977236758134308, PIO2_HI = 1.57079632679489655800e+00, PIO2_LO = 6.12323399573676603587e-17;
    const double kf = rint(x * TWO_OVER_PI);
    const double y = (x - kf * PIO2_HI) - kf * PIO2_LO;
    const double y2 = y * y;
    double sp = -1.0 / 1307674368000.0;
    sp = sp * y2 + 1.0 / 6227020800.0; sp = sp * y2 - 1.0 / 39916800.0; sp = sp * y2 + 1.0 / 362880.0; sp = sp * y2 - 1.0 / 5040.0;
    sp = sp * y2 + 1.0 / 120.0; sp = sp * y2 - 1.0 / 6.0; sp = sp * y2 + 1.0; sp *= y;
    double cp = 1.0 / 20922789888000.0;
    cp = cp * y2 - 1.0 / 87178291200.0; cp = cp * y2 + 1.0 / 479001600.0; cp = cp * y2 - 1.0 / 3628800.0; cp = cp * y2 + 1.0 / 40320.0;
    cp = cp * y2 - 1.0 / 720.0; cp = cp * y2 + 1.0 / 24.0; cp = cp * y2 - 0.5; cp = cp * y2 + 1.0;
    const int q = ((int)kf) & 3;
    s = (q == 0) ? sp : (q == 1) ? cp : (q == 2) ? -sp : -cp;
    c = (q == 0) ? cp : (q == 1) ? -sp : (q == 2) ? -cp : sp;
}
__device__ __forceinline__ void p0_s5_tables(const Params& p, int item, unsigned char* lds) {
    const int di = item >> 5, g = item & 31, tid = tid_();
    float2* apw = (float2*)lds;
    float2* Bb = apw + 64 * 65;
    float2* Cc = Bb + 64 * 16;
    __syncthreads();
    if (tid < 64) {
        const int pidx = (di * 32 + g) * 64 + tid;
        float lr = p.in[10][pidx]; lr = lr < -1e-4f ? lr : -1e-4f;
        const float li = p.in[11][pidx];
        const float dt = expf(p.in[12][di * 32 + g]);
        const double mag = (double)expf(lr * dt);
        double sn, cs; sincos_d((double)li * (double)dt, sn, cs);
        const double are = mag * cs, aim = mag * sn;
        double pr = 1.0, pi_ = 0.0;
        for (int t = 0; t <= 64; ++t) {
            apw[tid * 65 + t] = make_float2((float)pr, (float)pi_);
            const double nr = pr * are - pi_ * aim, ni = pr * aim + pi_ * are; pr = nr; pi_ = ni;
        }
        ((float2*)(p.ws + WS_A64))[(di * 32 + g) * 64 + tid] = apw[tid * 65 + 64];
        const double den = (double)lr * lr + (double)li * li;
        const double fre = ((are - 1.0) * lr + aim * li) / den, fim = (aim * lr - (are - 1.0) * li) / den;
        for (int hh = 0; hh < 16; ++hh) {
            const double br = p.in[13][(size_t)pidx * 16 + hh], bi = p.in[14][(size_t)pidx * 16 + hh];
            Bb[tid * 16 + hh] = make_float2((float)(fre * br - fim * bi), (float)(fre * bi + fim * br));
        }
    }
    for (int e = tid; e < 1024; e += NTHREADS) {
        const size_t gi = ((size_t)(di * 32 + g) * 16) * 64 + e;
        Cc[e] = make_float2(p.in[15][gi], p.in[16][gi]);
    }
    __syncthreads();
    float* ktab = (float*)(p.ws + WS_KTAB) + (size_t)(di * 32 + g) * 64 * 256;
    for (int o = tid; o < 64 * 256; o += NTHREADS) {
        const int tau = o >> 8, hh = (o >> 4) & 15, h2 = o & 15;
        float acc = 0.f;
        for (int pp = 0; pp < 64; ++pp) {
            const float2 a = apw[pp * 65 + tau], c = Cc[hh * 64 + pp], b = Bb[pp * 16 + h2];
            const float cr = c.x * a.x - c.y * a.y, ci = c.x * a.y + c.y * a.x;
            acc += cr * b.x - ci * b.y;
        }
        ktab[o] = acc;
    }
    bf16_t* ms5 = (bf16_t*)(p.ws + WS_MS5) + (size_t)g * 1280 * 1024;
    for (int t = tid; t < 128 * 128; t += NTHREADS) {
        const int row = t >> 7, k8 = t & 127; const int ri = row >> 6, pp = row & 63, j = k8 >> 1, h0 = (k8 & 1) * 8;
        const float2 a = apw[pp * 65 + (di == 0 ? 63 - j : j)];
        float f[8];
#pragma unroll
        for (int e = 0; e < 8; ++e) { const float2 b = Bb[pp * 16 + h0 + e]; f[e] = ri == 0 ? (a.x * b.x - a.y * b.y) : (a.x * b.y + a.y * b.x); }
        *(uint4*)(ms5 + (size_t)(1024 + di * 128 + row) * 1024 + k8 * 8) = pack8(f);
    }
    bf16_t* o5 = (bf16_t*)(p.ws + WS_O5) + (size_t)g * 1024 * 256;
    for (int t = tid; t < 1024 * 16; t += NTHREADS) {
        const int n = t >> 4, q = t & 15; const int ri = q >> 3, p0 = (q & 7) * 8, i = n >> 4, hh = n & 15;
        float f[8];
#pragma unroll
        for (int e = 0; e < 8; ++e) {
            const float2 a = apw[(p0 + e) * 65 + (di == 0 ? i + 1 : 64 - i)], c = Cc[hh * 64 + p0 + e];
            f[e] = ri == 0 ? (c.x * a.x - c.y * a.y) : -(c.x * a.y + c.y * a.x);
        }
        *(uint4*)(o5 + (size_t)n * 256 + di * 128 + ri * 64 + p0) = pack8(f);
    }
}

__device__ __forceinline__ void norm_mod_row(const float* __restrict__ src, const float* __restrict__ g, const float* __restrict__ shift,
                                             const float* __restrict__ scale, bf16_t* __restrict__ dst, int lane) {
    float4 v[4]; float ss = 0.f;
#pragma unroll
    for (int k = 0; k < 4; ++k) { v[k] = *(const float4*)(src + k * 256 + lane * 4); ss += v[k].x * v[k].x + v[k].y * v[k].y + v[k].z * v[k].z + v[k].w * v[k].w; }
    ss = wave_sum(ss);
    const float rs = rsqrtf(ss * (1.f / 1024.f) + 1e-6f);
#pragma unroll
    for (int k = 0; k < 4; ++k) {
        const int c = k * 256 + lane * 4;
        const float4 gg = *(const float4*)(g + c), sh = *(const float4*)(shift + c), sc = *(const float4*)(scale + c);
        uint2 o;
        o.x = pack2(v[k].x * rs * gg.x * (1.f + sc.x) + sh.x, v[k].y * rs * gg.y * (1.f + sc.y) + sh.y);
        o.y = pack2(v[k].z * rs * gg.z * (1.f + sc.z) + sh.z, v[k].w * rs * gg.w * (1.f + sc.w) + sh.w);
        *(uint2*)(dst + c) = o;
    }
}
__device__ __forceinline__ void norm_rows_item(const Params& p, int item, int l, const float* g, int js, bool from_inputs) {
    const int row = item * 8 + (tid_() >> 6), lane = tid_() & 63;
    const float* src = from_inputs ? (row < SEQ ? p.in[0] + (size_t)row * 1024 : p.in[2] + (size_t)(row - SEQ) * 1024)
                                   : (const float*)(p.ws + WS_H) + (size_t)row * 1024;
    norm_mod_row(src, g, modp(p, l, row, js), modp(p, l, row, js + 1), (bf16_t*)(p.ws + WS_ACT) + (size_t)row * 1024, lane);
}
__device__ __forceinline__ void s5_mintra_item(const Params& p, int item) {
    const int g = item >> 6, i = item & 63;
    const float* kt0 = (const float*)(p.ws + WS_KTAB) + (size_t)(0 * 32 + g) * 64 * 256;
    const float* kt1 = (const float*)(p.ws + WS_KTAB) + (size_t)(1 * 32 + g) * 64 * 256;
    const float* dsk = p.in[17] + g * 16;
    bf16_t* ms5 = (bf16_t*)(p.ws + WS_MS5) + (size_t)g * 1280 * 1024;
    for (int t = tid_(); t < 16 * 128; t += NTHREADS) {
        const int hh = t >> 7, k8 = t & 127, j = k8 >> 1, h0 = (k8 & 1) * 8;
        float f[8];
        if (j < i) { const float* s = kt0 + ((i - j) * 16 + hh) * 16 + h0;
#pragma unroll
            for (int e = 0; e < 8; ++e) f[e] = s[e]; }
        else if (j > i) { const float* s = kt1 + ((j - i) * 16 + hh) * 16 + h0;
#pragma unroll
            for (int e = 0; e < 8; ++e) f[e] = s[e]; }
        else { const float* s0 = kt0 + hh * 16 + h0; const float* s1 = kt1 + hh * 16 + h0;
#pragma unroll
            for (int e = 0; e < 8; ++e) f[e] = s0[e] + s1[e] + ((h0 + e) == hh ? dsk[hh] : 0.f); }
        *(uint4*)(ms5 + (size_t)(i * 16 + hh) * 1024 + k8 * 8) = pack8(f);
    }
}

struct EpiEvenIn {
    bf16_t* pa; bf16_t* ug;
    __device__ __forceinline__ void operator()(int row, int col, const float* v) const {
        if (col < 1536) *(uint4*)(pa + (size_t)row * 1536 + col) = pack8(v);
        else { const int c2 = col - 1536; *(uint4*)(ug + ((size_t)(c2 >> 4) * NCH + (row >> 6)) * 1024 + (row & 63) * 16 + (c2 & 15)) = pack8(v); }
    }
};
struct EpiS5Local {
    float* yl; float* lst; int g;
    __device__ __forceinline__ void operator()(int row, int col, const float* v) const {
        float* d = col < 1024 ? yl + (size_t)(row * 64 + (col >> 4)) * 512 + g * 16 + (col & 15) : lst + ((size_t)g * NCH + row) * 256 + (col - 1024);
        *(float4*)d = make_float4(v[0], v[1], v[2], v[3]); *(float4*)(d + 4) = make_float4(v[4], v[5], v[6], v[7]);
    }
};
struct EpiS5Out {
    const float* yl; bf16_t* gs; int g;
    __device__ __forceinline__ void operator()(int row, int col, const float* v) const {
        const size_t o = (size_t)(row * 64 + (col >> 4)) * 512 + g * 16 + (col & 15);
        const float4 y0 = *(const float4*)(yl + o), y1 = *(const float4*)(yl + o + 4);
        const float f[8] = {gelu_tanh(v[0] + y0.x), gelu_tanh(v[1] + y0.y), gelu_tanh(v[2] + y0.z), gelu_tanh(v[3] + y0.w),
                            gelu_tanh(v[4] + y1.x), gelu_tanh(v[5] + y1.y), gelu_tanh(v[6] + y1.z), gelu_tanh(v[7] + y1.w)};
        *(uint4*)(gs + o) = pack8(f);
    }
};
struct EpiGlu {
    const bf16_t* gs; const float* b; bf16_t* cb;
    __device__ __forceinline__ void operator()(int row, int col, const float* v) const {
        float g[8], f[8]; unpack8(*(const uint4*)(gs + (size_t)row * 512 + col), g);
#pragma unroll
        for (int e = 0; e < 8; ++e) f[e] = g[e] * sigmoidf_(v[e] + b[col + e]);
        *(uint4*)(cb + (size_t)row * 1024 + 512 + col) = pack8(f);
    }
};
struct EpiResid {
    const float* x; const float* ctx; float* hbuf; const float* mod; int l; bool from_inputs;
    __device__ __forceinline__ void operator()(int row, int col, const float* v) const {
        float* h = hbuf + (size_t)row * 1024 + col;
        const float* bp = from_inputs ? (row < SEQ ? x + (size_t)row * 1024 + col : ctx + (size_t)(row - SEQ) * 1024 + col) : h;
        const float* mp = mod + ((l * 2 + (row >= SEQ ? 1 : 0)) * 6 + 2) * 1024 + col;
        const float4 b0 = *(const float4*)bp, b1 = *(const float4*)(bp + 4), m0 = *(const float4*)mp, m1 = *(const float4*)(mp + 4);
        *(float4*)h = make_float4(b0.x + m0.x * v[0], b0.y + m0.y * v[1], b0.z + m0.z * v[2], b0.w + m0.w * v[3]);
        *(float4*)(h + 4) = make_float4(b1.x + m1.x * v[4], b1.y + m1.y * v[5], b1.z + m1.z * v[6], b1.w + m1.w * v[7]);
    }
};
struct EpiBf16 {
    bf16_t* dst; int ld;
    __device__ __forceinline__ void operator()(int row, int col, const float* v) const { *(uint4*)(dst + (size_t)row * ld + col) = pack8(v); }
};
struct EpiScore {
    unsigned short* dst; int coff;
    __device__ __forceinline__ void operator()(int row, int col, const float* v) const {
        typedef _Float16 h2 __attribute__((ext_vector_type(2)));
        u32x4 o;
#pragma unroll
        for (int e = 0; e < 4; ++e) { const h2 hv = {(_Float16)v[2 * e], (_Float16)v[2 * e + 1]}; o[e] = __builtin_bit_cast(unsigned, hv); }
        *(u32x4*)(dst + (size_t)row * 2048 + coff + col) = o;
    }
};
struct EpiOddIn {
    bf16_t* qkvr; bf16_t* z; float* ab;
    __device__ __forceinline__ void operator()(int row, int col, const float* v) const {
        if (col < 3072) *(uint4*)(qkvr + (size_t)row * 3072 + col) = pack8(v);
        else if (col < 4096) *(uint4*)(z + (size_t)row * 1024 + (col - 3072)) = pack8(v);
        else { float* d = ab + (size_t)row * 32 + (col - 4096); *(float4*)d = make_float4(v[0], v[1], v[2], v[3]); *(float4*)(d + 4) = make_float4(v[4], v[5], v[6], v[7]); }
    }
};

__device__ __forceinline__ void s5_scan(const Params& p) {
    const int gt = blockIdx.x * NTHREADS + tid_();
    if (gt >= 4096) return;
    const int di = gt >> 11, g = (gt >> 6) & 31, pp = gt & 63;
    const float2 a = ((const float2*)(p.ws + WS_A64))[(di * 32 + g) * 64 + pp];
    const float* lst = (const float*)(p.ws + WS_LST) + (size_t)g * NCH * 256 + di * 128 + pp;
    bf16_t* a5 = (bf16_t*)(p.ws + WS_A5) + (size_t)g * NCH * 256 + di * 128 + pp;
    float sr = 0.f, si = 0.f;
    for (int s0 = 0; s0 < NCH; s0 += 4) {
        int c[4]; float lr[4], li[4];
#pragma unroll
        for (int u = 0; u < 4; ++u) {
            const int s = s0 + u;
            c[u] = di == 0 ? (s < 4 ? NCH_LAT + s : s - 4) : (s < 4 ? NCH - 1 - s : NCH - 1 - s);
            lr[u] = lst[(size_t)c[u] * 256]; li[u] = lst[(size_t)c[u] * 256 + 64];
        }
#pragma unroll
        for (int u = 0; u < 4; ++u) {
            a5[(size_t)c[u] * 256] = f2bf(sr); a5[(size_t)c[u] * 256 + 64] = f2bf(si);
            const float nr = a.x * sr - a.y * si + lr[u], ni = a.x * si + a.y * sr + li[u]; sr = nr; si = ni;
        }
    }
}

__device__ __forceinline__ void even_conv_item(const Params& p, int item) {
    const bf16_t* pa = (const bf16_t*)(p.ws + WS_PA); bf16_t* cb = (bf16_t*)(p.ws + WS_CB);
    const float* cw = p.in[9];
    for (int t = tid_(); t < 64 * 64; t += NTHREADS) {
        const int row = item * 64 + (t >> 6), c0 = (t & 63) * 8;
        bool hasp, hasn;
        if (row < SEQ) { hasp = (row & 63) != 0; hasn = (row & 63) != 63; } else { hasp = row != SEQ; hasn = row != R - 1; }
        float m[3][8];
#pragma unroll
        for (int d = 0; d < 3; ++d) {
            const bool ok = d == 1 || (d == 0 ? hasp : hasn);
            if (ok) {
                const bf16_t* rp = pa + (size_t)(row + d - 1) * 1536 + c0;
                float u[8], gi[8]; unpack8(*(const uint4*)rp, u); unpack8(*(const uint4*)(rp + 512), gi);
#pragma unroll
                for (int e = 0; e < 8; ++e) m[d][e] = u[e] * gi[e];
            } else {
#pragma unroll
                for (int e = 0; e < 8; ++e) m[d][e] = 0.f;
            }
        }
        float go[8], f[8]; unpack8(*(const uint4*)(pa + (size_t)row * 1536 + 1024 + c0), go);
#pragma unroll
        for (int e = 0; e < 8; ++e) f[e] = go[e] * (m[0][e] * cw[c0 + e] + m[1][e] * cw[512 + c0 + e] + m[2][e] * cw[1024 + c0 + e]);
        *(uint4*)(cb + (size_t)row * 1024 + c0) = pack8(f);
    }
}

__device__ __forceinline__ unsigned ord_enc(float v) { const unsigned u = __float_as_uint(v); return (u & 0x80000000u) ? ~u : (u | 0x80000000u); }
__device__ __forceinline__ float ord_dec(unsigned e) { const unsigned u = (e & 0x80000000u) ? (e & 0x7FFFFFFFu) : ~e; return __uint_as_float(u); }
#define TOP_INSERT(key) { unsigned x_ = (key); _Pragma("unroll") for (int k_ = 0; k_ < 16; ++k_) { const unsigned hi_ = top[k_] > x_ ? top[k_] : x_; x_ = top[k_] > x_ ? x_ : top[k_]; top[k_] = hi_; } }
__device__ __forceinline__ void peer_route_item(const Params& p, int item, int nrows, unsigned char* lds) {
    const int tid = tid_();
    const int row = item * 64 + (tid >> 3), head = tid & 7;
    unsigned* sIdx = (unsigned*)lds;
    __syncthreads();
    if (row < nrows) {
        const unsigned short* sc = (const unsigned short*)(p.ws + WS_SC) + (size_t)row * 2048 + head * 256;
        float fa[16], fb[16];
#pragma unroll
        for (int side = 0; side < 2; ++side) {
            unsigned top[16];
#pragma unroll
            for (int k = 0; k < 16; ++k) top[k] = 0u;
            for (int c = 0; c < 16; ++c) {
                const uint4 q = *(const uint4*)(sc + side * 128 + c * 8);
                const unsigned w[4] = {q.x, q.y, q.z, q.w};
#pragma unroll
                for (int e = 0; e < 8; ++e) {
                    const unsigned short hb = (unsigned short)((e & 1) ? (w[e >> 1] >> 16) : (w[e >> 1] & 0xFFFFu));
                    const float v = (float)__builtin_bit_cast(_Float16, hb);
                    TOP_INSERT((ord_enc(v) & ~0x7Fu) | (unsigned)(c * 8 + e));
                }
            }
#pragma unroll
            for (int k = 0; k < 16; ++k) {
                sIdx[(side * 16 + k) * NTHREADS + tid] = top[k] & 0x7Fu;
                const float v = ord_dec(top[k] & ~0x7Fu);
                if (side == 0) fa[k] = v; else fb[k] = v;
            }
        }
        unsigned top[16];
#pragma unroll
        for (int k = 0; k < 16; ++k) top[k] = 0u;
#pragma unroll
        for (int i = 0; i < 16; ++i) {
#pragma unroll
            for (int j = 0; j < 16; ++j) {
                if ((i + 1) * (j + 1) <= 16) { TOP_INSERT((ord_enc(fa[i] + fb[j]) & ~0xFFu) | (unsigned)(i * 16 + j)); }
            }
        }
        float ev[16]; float m = ord_dec(top[0] & ~0xFFu), sum = 0.f;
        int* idxo = (int*)(p.ws + WS_IDX) + (size_t)row * 128 + head * 16;
        float* go = (float*)(p.ws + WS_GATE) + (size_t)row * 128 + head * 16;
#pragma unroll
        for (int k = 0; k < 16; ++k) { ev[k] = __expf(ord_dec(top[k] & ~0xFFu) - m); sum += ev[k]; }
        const float inv = 1.f / sum;
#pragma unroll
        for (int k = 0; k < 16; ++k) {
            const unsigned pos = top[k] & 0xFFu;
            const unsigned ia = sIdx[(pos >> 4) * NTHREADS + tid], ib = sIdx[(16 + (pos & 15)) * NTHREADS + tid];
            idxo[k] = (int)(ia * 128u + ib); go[k] = ev[k] * inv;
        }
    }
}

__device__ __forceinline__ void fp8x16_to_f32(const u32x4& q, float* f) {
#pragma unroll
    for (int d = 0; d < 4; ++d) {
        const f32x2_t lo = __builtin_amdgcn_cvt_pk_f32_fp8((int)q[d], false), hi = __builtin_amdgcn_cvt_pk_f32_fp8((int)q[d], true);
        f[4 * d + 0] = lo.x; f[4 * d + 1] = lo.y; f[4 * d + 2] = hi.x; f[4 * d + 3] = hi.y;
    }
}
__device__ __forceinline__ void peer_gather_row(const Params& p, int row, int l, bool last) {
    const int lane = tid_() & 63;
    const bf16_t* xr = (const bf16_t*)(p.ws + WS_ACT) + (size_t)row * 1024 + lane * 16;
    const unsigned char* PU = p.ws + WS_PUV; const unsigned char* PV = PU + (size_t)16384 * 1024;
    const float* psc = (const float*)(p.ws + WS_PSC);
    float x[16], y[16];
    unpack8(*(const uint4*)xr, x); unpack8(*(const uint4*)(xr + 8), x + 8);
#pragma unroll
    for (int e = 0; e < 16; ++e) y[e] = 0.f;
    const int* idxp = (const int*)(p.ws + WS_IDX) + (size_t)row * 128; const float* gp = (const float*)(p.ws + WS_GATE) + (size_t)row * 128;
#pragma unroll 1
    for (int half = 0; half < 2; ++half) {
        const int myidx = idxp[half * 64 + lane];
        const float myus = psc[myidx], mygv = gp[half * 64 + lane] * psc[16384 + myidx];
#pragma unroll 1
        for (int e0 = 0; e0 < 64; e0 += 8) {
            u32x4 ur[8], vr[8];
#pragma unroll
            for (int u = 0; u < 8; ++u) {
                const int id = __builtin_amdgcn_readlane(myidx, e0 + u);
                ur[u] = *(const u32x4*)(PU + (size_t)id * 1024 + lane * 16);
                vr[u] = *(const u32x4*)(PV + (size_t)id * 1024 + lane * 16);
            }
            float d[8];
#pragma unroll
            for (int u = 0; u < 8; ++u) {
                float f[16]; fp8x16_to_f32(ur[u], f);
                float a = 0.f;
#pragma unroll
                for (int e = 0; e < 16; ++e) a += f[e] * x[e];
                d[u] = a;
            }
#pragma unroll
            for (int o = 32; o > 0; o >>= 1) {
#pragma unroll
                for (int u = 0; u < 8; ++u) d[u] += __shfl_xor(d[u], o, 64);
            }
#pragma unroll
            for (int u = 0; u < 8; ++u) {
                const float us = __int_as_float(__builtin_amdgcn_readlane(__float_as_int(myus), e0 + u));
                const float gv = __int_as_float(__builtin_amdgcn_readlane(__float_as_int(mygv), e0 + u));
                const float coef = gelu_tanh(d[u] * us) * gv;
                float f[16]; fp8x16_to_f32(vr[u], f);
#pragma unroll
                for (int e = 0; e < 16; ++e) y[e] += coef * f[e];
            }
        }
    }
    float* h = (float*)(p.ws + WS_H) + (size_t)row * 1024 + lane * 16;
    const float* m5 = modp(p, l, row, 5) + lane * 16;
    float hv[16];
#pragma unroll
    for (int q = 0; q < 4; ++q) {
        const float4 h0 = *(const float4*)(h + q * 4), g0 = *(const float4*)(m5 + q * 4);
        hv[q * 4 + 0] = h0.x + g0.x * y[q * 4 + 0]; hv[q * 4 + 1] = h0.y + g0.y * y[q * 4 + 1];
        hv[q * 4 + 2] = h0.z + g0.z * y[q * 4 + 2]; hv[q * 4 + 3] = h0.w + g0.w * y[q * 4 + 3];
    }
    if (!last) {
#pragma unroll
        for (int q = 0; q < 4; ++q) *(float4*)(h + q * 4) = make_float4(hv[q * 4 + 0], hv[q * 4 + 1], hv[q * 4 + 2], hv[q * 4 + 3]);
    } else {
        float ss = 0.f;
#pragma unroll
        for (int e = 0; e < 16; ++e) ss += hv[e] * hv[e];
        ss = wave_sum(ss);
        const float rs = rsqrtf(ss * (1.f / 1024.f) + 1e-6f);
        const float* fg = p.in[31] + lane * 16; float* o = p.out + (size_t)row * 1024 + lane * 16;
#pragma unroll
        for (int q = 0; q < 4; ++q) {
            const float4 g0 = *(const float4*)(fg + q * 4);
            *(float4*)(o + q * 4) = make_float4(hv[q * 4 + 0] * rs * g0.x, hv[q * 4 + 1] * rs * g0.y, hv[q * 4 + 2] * rs * g0.z, hv[q * 4 + 3] * rs * g0.w);
        }
    }
}

__device__ __forceinline__ void gdn_prep_item(const Params& p, int item) {
    const int tid = tid_();
    const int r0 = item * 16;
    if (tid < 384) {
        const int part = tid >> 7, ch = tid * 8;
        const bf16_t* src = (const bf16_t*)(p.ws + WS_QKVR) + ch;
        bf16_t* dst = (bf16_t*)(p.ws + (part == 0 ? WS_QN : part == 1 ? WS_KN : WS_VN)) + (ch & 1023);
        const float* cw = p.in[22] + ch;
        float w0[8], w1[8], w2[8];
#pragma unroll
        for (int e = 0; e < 8; ++e) { w0[e] = cw[e]; w1[e] = cw[3072 + e]; w2[e] = cw[6144 + e]; }
        bool hasp0, hasn15;
        if (r0 < SEQ) { hasp0 = (r0 & 63) != 0; hasn15 = ((r0 + 15) & 63) != 63; } else { hasp0 = r0 != SEQ; hasn15 = (r0 + 15) != R - 1; }
        float xm[8], x0[8], xp[8];
#pragma unroll
        for (int e = 0; e < 8; ++e) xm[e] = 0.f;
        if (hasp0) unpack8(*(const uint4*)(src + (size_t)(r0 - 1) * 3072), xm);
        unpack8(*(const uint4*)(src + (size_t)r0 * 3072), x0);
        uint4 nx[4];
#pragma unroll 1
        for (int i0 = 0; i0 < 16; i0 += 4) {
#pragma unroll
            for (int u = 0; u < 4; ++u) {
                const int i = i0 + u;
                const bool ok = i < 15 || hasn15;
                nx[u] = ok ? *(const uint4*)(src + (size_t)(r0 + i + 1) * 3072) : make_uint4(0u, 0u, 0u, 0u);
            }
#pragma unroll
            for (int u = 0; u < 4; ++u) {
                const int i = i0 + u;
                unpack8(nx[u], xp);
                float f[8], ss = 0.f;
#pragma unroll
                for (int e = 0; e < 8; ++e) { const float a = siluf_(xm[e] * w0[e] + x0[e] * w1[e] + xp[e] * w2[e]); f[e] = a; ss += a * a; }
                if (part < 2) {
                    ss += __shfl_xor(ss, 1, 64); ss += __shfl_xor(ss, 2, 64); ss += __shfl_xor(ss, 4, 64); ss += __shfl_xor(ss, 8, 64);
                    const float sc = rsqrtf(ss + 1e-6f) * (part == 0 ? 0.08838834764831845f : 1.f);
#pragma unroll
                    for (int e = 0; e < 8; ++e) f[e] *= sc;
                }
                *(uint4*)(dst + (size_t)(r0 + i) * 1024) = pack8(f);
#pragma unroll
                for (int e = 0; e < 8; ++e) { xm[e] = x0[e]; x0[e] = xp[e]; }
            }
        }
    } else if (tid < 384 + 64) {
        const int l = tid - 384;
#pragma unroll
        for (int q = 0; q < 4; ++q) {
            const int v = l * 4 + q, i = v >> 4, dh = v & 15, row = r0 + i;
            const float* ab = (const float*)(p.ws + WS_AB) + (size_t)row * 32;
            const float a = ab[dh] + p.in[24][dh], b = ab[16 + dh];
            const float sp = a > 20.f ? a : log1pf(__expf(a));
            ((float*)(p.ws + WS_GG))[(size_t)dh * R + row] = -__expf(p.in[23][dh]) * sp;
            ((float*)(p.ws + WS_BETA))[(size_t)dh * R + row] = sigmoidf_(b);
        }
    }
}

constexpr int GU_LDQ = 136, GU_LDT = 72, GU_LDA = 68;
constexpr int GU_SQ = 0, GU_SK = 17408, GU_SKB = 34816, GU_SVBT = 52224, GU_SKGT = 70656, GU_SA = 89088, GU_SAT = 106496, GU_ST = 123904, GU_SG = 133120;
__device__ __forceinline__ int perm_slot64(int pos) { return 32 * (pos >> 5) + 8 * ((pos >> 2) & 3) + 4 * ((pos >> 4) & 1) + (pos & 3); }
__device__ __forceinline__ void gdn_unit(const Params& p, int u, unsigned char* lds) {
    const int tid = tid_(), lane = tid & 63, wave = tid >> 6;
    const int dh = u / NCH, c = u % NCH, dir = dh >> 3, head = dh & 7;
    bf16_t* sQ = (bf16_t*)(lds + GU_SQ); bf16_t* sK = (bf16_t*)(lds + GU_SK); bf16_t* sKB = (bf16_t*)(lds + GU_SKB);
    bf16_t* sVBT = (bf16_t*)(lds + GU_SVBT); bf16_t* sKGT = (bf16_t*)(lds + GU_SKGT);
    float* sA = (float*)(lds + GU_SA); float* sAT = (float*)(lds + GU_SAT); bf16_t* sT = (bf16_t*)(lds + GU_ST);
    float* sG = (float*)(lds + GU_SG); float* sBeta = sG + 64;
    __syncthreads();
    if (wave == 0) {
        const int row = c * 64 + (dir ? 63 - lane : lane);
        float g = ((const float*)(p.ws + WS_GG))[(size_t)dh * R + row];
#pragma unroll
        for (int o = 1; o < 64; o <<= 1) { const float t = __shfl_up(g, o, 64); if (lane >= o) g += t; }
        sG[lane] = g; sBeta[lane] = ((const float*)(p.ws + WS_BETA))[(size_t)dh * R + row];
        ((float*)(p.ws + WS_GC))[(size_t)u * 64 + lane] = g;
    }
    __syncthreads();
    for (int t = tid; t < 1024; t += NTHREADS) {
        const int i = t >> 4, d8 = (t & 15) * 8;
        const size_t ro = (size_t)(c * 64 + (dir ? 63 - i : i)) * 1024 + head * 128 + d8;
        const uint4 q = *(const uint4*)((const bf16_t*)(p.ws + WS_QN) + ro);
        const uint4 k = *(const uint4*)((const bf16_t*)(p.ws + WS_KN) + ro);
        const uint4 v = *(const uint4*)((const bf16_t*)(p.ws + WS_VN) + ro);
        const float beta = sBeta[i], eg = __expf(sG[i]);
        float kf[8], vf[8], kb[8];
        unpack8(k, kf); unpack8(v, vf);
#pragma unroll
        for (int e = 0; e < 8; ++e) kb[e] = kf[e] * beta;
        *(uint4*)(sQ + i * GU_LDQ + d8) = q; *(uint4*)(sK + i * GU_LDQ + d8) = k; *(uint4*)(sKB + i * GU_LDQ + d8) = pack8(kb);
#pragma unroll
        for (int e = 0; e < 8; ++e) { sVBT[(d8 + e) * GU_LDT + i] = f2bf(vf[e] * beta); sKGT[(d8 + e) * GU_LDT + i] = f2bf(kb[e] * eg); }
    }
    __syncthreads();
    {
        const int mat = wave >> 2, mt = wave & 3, rr = lane & 15, q4 = lane >> 4;
        const bf16_t* sX = mat ? sQ : sKB;
        f32x4 acc[4];
#pragma unroll
        for (int nt = 0; nt < 4; ++nt) acc[nt] = (f32x4){0.f, 0.f, 0.f, 0.f};
#pragma unroll
        for (int kk = 0; kk < 4; ++kk) {
            const bf16x8 a = *(const bf16x8*)(sX + (16 * mt + rr) * GU_LDQ + kk * 32 + 8 * q4);
#pragma unroll
            for (int nt = 0; nt < 4; ++nt) {
                const bf16x8 b = *(const bf16x8*)(sK + (16 * nt + rr) * GU_LDQ + kk * 32 + 8 * q4);
                acc[nt] = __builtin_amdgcn_mfma_f32_16x16x32_bf16(a, b, acc[nt], 0, 0, 0);
            }
        }
        float* dstm = mat ? sAT : sA;
#pragma unroll
        for (int nt = 0; nt < 4; ++nt) {
            const int j = 16 * nt + rr; const float gj = sG[j];
#pragma unroll
            for (int jj = 0; jj < 4; ++jj) {
                const int i = 16 * mt + 4 * q4 + jj;
                const bool keep = mat ? (j <= i) : (j < i);
                dstm[i * GU_LDA + j] = keep ? acc[nt][jj] * __expf(sG[i] - gj) : 0.f;
            }
        }
    }
    __syncthreads();
    float* sD = (float*)(lds + GU_SQ);
    if (wave < 4) {
        if (lane < 16) {
            float d[16];
#pragma unroll
            for (int i = 0; i < 16; ++i) {
                float a = (i == lane) ? 1.f : 0.f;
                const float* Ai = sA + (16 * wave + i) * GU_LDA + 16 * wave;
#pragma unroll
                for (int j = 0; j < i; ++j) a -= Ai[j] * d[j];
                d[i] = a;
                sD[(wave * 16 + i) * 16 + lane] = a;
            }
        }
    } else {
        bf16_t* att = (bf16_t*)(p.ws + WS_ATT) + (size_t)u * 64 * 64;
        for (int t = tid - 256; t < 512; t += 256) {
            const int i = t >> 3, kk2 = (t >> 2) & 1, qq = t & 3;
            const float4 lo = *(const float4*)(sAT + i * GU_LDA + 32 * kk2 + 4 * qq), hi = *(const float4*)(sAT + i * GU_LDA + 32 * kk2 + 16 + 4 * qq);
            uint4 o; o.x = pack2(lo.x, lo.y); o.y = pack2(lo.z, lo.w); o.z = pack2(hi.x, hi.y); o.w = pack2(hi.z, hi.w);
            *(uint4*)(att + i * 64 + 32 * kk2 + 8 * qq) = o;
        }
    }
    __syncthreads();
    if (wave < 4) {
        const int rr = lane & 15, q4 = lane >> 4;
        f32x4 Tt[4];
#pragma unroll
        for (int m = 0; m < 4; ++m) Tt[m] = (f32x4){0.f, 0.f, 0.f, 0.f};
#pragma unroll
        for (int b = 0; b < 4; ++b) {
            if (b >= wave) {
                f32x4 X = (f32x4){0.f, 0.f, 0.f, 0.f};
#pragma unroll
                for (int kk = 0; kk < 2; ++kk) {
                    if (2 * kk < b) {
                        const float* Ar = sA + (16 * b + rr) * GU_LDA + 32 * kk + 4 * q4;
                        const float4 lo = *(const float4*)Ar;
                        float4 hi = make_float4(0.f, 0.f, 0.f, 0.f);
                        if (2 * kk + 1 < b) hi = *(const float4*)(Ar + 16);
                        const u32x4 ap = {pack2(lo.x, lo.y), pack2(lo.z, lo.w), pack2(hi.x, hi.y), pack2(hi.z, hi.w)};
                        const u32x4 bp = {pack2(Tt[2 * kk][0], Tt[2 * kk][1]), pack2(Tt[2 * kk][2], Tt[2 * kk][3]),
                                          pack2(Tt[2 * kk + 1][0], Tt[2 * kk + 1][1]), pack2(Tt[2 * kk + 1][2], Tt[2 * kk + 1][3])};
                        X = __builtin_amdgcn_mfma_f32_16x16x32_bf16(__builtin_bit_cast(bf16x8, ap), __builtin_bit_cast(bf16x8, bp), X, 0, 0, 0);
                    }
                }
                float y[4];
#pragma unroll
                for (int jj = 0; jj < 4; ++jj) y[jj] = ((b == wave && 4 * q4 + jj == rr) ? 1.f : 0.f) - X[jj];
                const float4 dv4 = *(const float4*)(sD + (b * 16 + rr) * 16 + 4 * q4);
                const u32x4 ap = {pack2(dv4.x, dv4.y), pack2(dv4.z, dv4.w), 0u, 0u};
                const u32x4 bp = {pack2(y[0], y[1]), pack2(y[2], y[3]), 0u, 0u};
                const f32x4 z4 = (f32x4){0.f, 0.f, 0.f, 0.f};
                Tt[b] = __builtin_amdgcn_mfma_f32_16x16x32_bf16(__builtin_bit_cast(bf16x8, ap), __builtin_bit_cast(bf16x8, bp), z4, 0, 0, 0);
            }
#pragma unroll
            for (int jj = 0; jj < 4; ++jj) sT[(16 * b + 4 * q4 + jj) * GU_LDT + 16 * wave + rr] = f2bf(Tt[b][jj]);
        }
    }
    __syncthreads();
    {
        const int rr = lane & 15, q4 = lane >> 4;
        bf16_t* ut = (bf16_t*)(p.ws + WS_UT) + (size_t)u * 128 * 64;
        bf16_t* wg = (bf16_t*)(p.ws + WS_W) + (size_t)u * 64 * 128;
        f32x4 au[4], aw[4];
#pragma unroll
        for (int m = 0; m < 4; ++m) { au[m] = (f32x4){0.f, 0.f, 0.f, 0.f}; aw[m] = (f32x4){0.f, 0.f, 0.f, 0.f}; }
#pragma unroll
        for (int kk2 = 0; kk2 < 2; ++kk2) {
            const bf16x8 bv = *(const bf16x8*)(sVBT + (16 * wave + rr) * GU_LDT + kk2 * 32 + 8 * q4);
            const bf16x8 ak = *(const bf16x8*)(sKGT + (16 * wave + rr) * GU_LDT + kk2 * 32 + 8 * q4);
#pragma unroll
            for (int m = 0; m < 4; ++m) {
                const bf16x8 tf = *(const bf16x8*)(sT + (16 * m + rr) * GU_LDT + kk2 * 32 + 8 * q4);
                au[m] = __builtin_amdgcn_mfma_f32_16x16x32_bf16(tf, bv, au[m], 0, 0, 0);
                aw[m] = __builtin_amdgcn_mfma_f32_16x16x32_bf16(ak, tf, aw[m], 0, 0, 0);
            }
        }
#pragma unroll
        for (int m = 0; m < 4; ++m) {
            uint2 o; o.x = pack2(au[m][0], au[m][1]); o.y = pack2(au[m][2], au[m][3]);
            *(uint2*)(ut + (size_t)(16 * wave + rr) * 64 + 16 * m + 4 * q4) = o;
            uint2 w2; w2.x = pack2(aw[m][0], aw[m][1]); w2.y = pack2(aw[m][2], aw[m][3]);
            *(uint2*)(wg + (size_t)(16 * m + rr) * 128 + 32 * (wave >> 1) + 8 * q4 + 4 * (wave & 1)) = w2;
        }
    }
}

constexpr int GS_SW = 0, GS_SQD = 17408, GS_SKDT = 34816, GS_SATT = 53248, GS_BUF = 62464;
typedef unsigned u32x2 __attribute__((ext_vector_type(2)));
__device__ __forceinline__ int gdn_chain_chunk(int dir, int s) { return dir == 0 ? (s < 4 ? NCH_LAT + s : s - 4) : NCH - 1 - s; }
struct GsG1 { u32x4 w[2]; u32x4 att; };
struct GsG2 { u32x2 qlo[2], qhi[2]; float gq[2]; };
struct GsG3 { u32x4 kd[2]; float gk[2]; float gl; u32x2 ut[4]; };
__device__ __forceinline__ void gs_load1(const Params& p, int dh, int c, GsG1& st) {
    const int tid = tid_(); const size_t u = (size_t)dh * NCH + c;
    const bf16_t* wg = (const bf16_t*)(p.ws + WS_W) + u * 64 * 128; const bf16_t* att = (const bf16_t*)(p.ws + WS_ATT) + u * 64 * 64;
#pragma unroll
    for (int q = 0; q < 2; ++q) { const int t = tid + q * NTHREADS; st.w[q] = *(const u32x4*)(wg + (size_t)(t >> 4) * 128 + (t & 15) * 8); }
    st.att = *(const u32x4*)(att + (size_t)(tid >> 3) * 64 + (tid & 7) * 8);
}
__device__ __forceinline__ void gs_store1(const GsG1& st, unsigned char* buf) {
    const int tid = tid_(); bf16_t* sW = (bf16_t*)(buf + GS_SW); bf16_t* sATT = (bf16_t*)(buf + GS_SATT);
#pragma unroll
    for (int q = 0; q < 2; ++q) { const int t = tid + q * NTHREADS; *(u32x4*)(sW + (t >> 4) * GU_LDQ + (t & 15) * 8) = st.w[q]; }
    *(u32x4*)(sATT + (tid >> 3) * GU_LDT + (tid & 7) * 8) = st.att;
}
__device__ __forceinline__ void gs_load2(const Params& p, int dh, int c, GsG2& st) {
    const int tid = tid_(), dir = dh >> 3, head = dh & 7; const size_t u = (size_t)dh * NCH + c;
    const float* gc = (const float*)(p.ws + WS_GC) + u * 64; const bf16_t* qn = (const bf16_t*)(p.ws + WS_QN);
#pragma unroll
    for (int q = 0; q < 2; ++q) {
        const int t = tid + q * NTHREADS, i = t >> 4, kk = (t >> 2) & 3, qq = t & 3;
        const bf16_t* src = qn + (size_t)(c * 64 + (dir ? 63 - i : i)) * 1024 + head * 128 + 32 * kk + 4 * qq;
        st.qlo[q] = *(const u32x2*)src; st.qhi[q] = *(const u32x2*)(src + 16); st.gq[q] = gc[i];
    }
}
__device__ __forceinline__ void gs_store2(const GsG2& st, unsigned char* buf) {
    const int tid = tid_(); bf16_t* sQD = (bf16_t*)(buf + GS_SQD);
#pragma unroll
    for (int q = 0; q < 2; ++q) {
        const int t = tid + q * NTHREADS, i = t >> 4, kk = (t >> 2) & 3, qq = t & 3; const float e = __expf(st.gq[q]);
        u32x4 o; o.x = pack2(lo2f(st.qlo[q].x) * e, hi2f(st.qlo[q].x) * e); o.y = pack2(lo2f(st.qlo[q].y) * e, hi2f(st.qlo[q].y) * e);
        o.z = pack2(lo2f(st.qhi[q].x) * e, hi2f(st.qhi[q].x) * e); o.w = pack2(lo2f(st.qhi[q].y) * e, hi2f(st.qhi[q].y) * e);
        *(u32x4*)(sQD + i * GU_LDQ + 32 * kk + 8 * qq) = o;
    }
}
__device__ __forceinline__ void gs_load3(const Params& p, int dh, int c, GsG3& st) {
    const int tid = tid_(), lane = tid & 63, wave = tid >> 6, dir = dh >> 3, head = dh & 7; const size_t u = (size_t)dh * NCH + c;
    const float* gc = (const float*)(p.ws + WS_GC) + u * 64; const bf16_t* kn = (const bf16_t*)(p.ws + WS_KN);
    st.gl = gc[63];
#pragma unroll
    for (int q = 0; q < 2; ++q) {
        const int t = tid + q * NTHREADS, pos = t >> 4, d8 = (t & 15) * 8;
        st.kd[q] = *(const u32x4*)(kn + (size_t)(c * 64 + (dir ? 63 - pos : pos)) * 1024 + head * 128 + d8); st.gk[q] = gc[pos];
    }
    const bf16_t* ut = (const bf16_t*)(p.ws + WS_UT) + u * 128 * 64 + (size_t)(16 * wave + (lane & 15)) * 64 + 4 * (lane >> 4);
#pragma unroll
    for (int m = 0; m < 4; ++m) st.ut[m] = *(const u32x2*)(ut + 16 * m);
}
__device__ __forceinline__ void gs_store3(const GsG3& st, unsigned char* buf) {
    const int tid = tid_(); bf16_t* sKDT = (bf16_t*)(buf + GS_SKDT);
#pragma unroll
    for (int q = 0; q < 2; ++q) {
        const int t = tid + q * NTHREADS, pos = t >> 4, d8 = (t & 15) * 8; const float e = __expf(st.gl - st.gk[q]);
        const u32x4 kq = st.kd[q]; const int sl = perm_slot64(pos);
        sKDT[(d8 + 0) * GU_LDT + sl] = f2bf(lo2f(kq.x) * e); sKDT[(d8 + 1) * GU_LDT + sl] = f2bf(hi2f(kq.x) * e);
        sKDT[(d8 + 2) * GU_LDT + sl] = f2bf(lo2f(kq.y) * e); sKDT[(d8 + 3) * GU_LDT + sl] = f2bf(hi2f(kq.y) * e);
        sKDT[(d8 + 4) * GU_LDT + sl] = f2bf(lo2f(kq.z) * e); sKDT[(d8 + 5) * GU_LDT + sl] = f2bf(hi2f(kq.z) * e);
        sKDT[(d8 + 6) * GU_LDT + sl] = f2bf(lo2f(kq.w) * e); sKDT[(d8 + 7) * GU_LDT + sl] = f2bf(hi2f(kq.w) * e);
    }
}
__device__ __forceinline__ void gdn_seg_ab(const Params& p, int dh, int k, unsigned char* lds) {
    const int tid = tid_(), lane = tid & 63, wave = tid >> 6, rr = lane & 15, q4 = lane >> 4, dir = dh >> 3;
    const bool first = (k == 0);
    const int s_begin = first ? 0 : 4 + 16 * k, nsteps = first ? 20 : 16;
    f32x4 ScB[8], ScA[8]; bf16x8 SbB[4], SbA[4];
#pragma unroll
    for (int m = 0; m < 8; ++m) {
        ScB[m] = (f32x4){0.f, 0.f, 0.f, 0.f};
#pragma unroll
        for (int jj = 0; jj < 4; ++jj) ScA[m][jj] = (16 * m + 4 * q4 + jj == 16 * wave + rr) ? 1.f : 0.f;
    }
#pragma unroll
    for (int kk = 0; kk < 4; ++kk) {
        SbB[kk] = (bf16x8){0, 0, 0, 0, 0, 0, 0, 0};
        const u32x4 pk = {pack2(ScA[2 * kk][0], ScA[2 * kk][1]), pack2(ScA[2 * kk][2], ScA[2 * kk][3]),
                          pack2(ScA[2 * kk + 1][0], ScA[2 * kk + 1][1]), pack2(ScA[2 * kk + 1][2], ScA[2 * kk + 1][3])};
        SbA[kk] = __builtin_bit_cast(bf16x8, pk);
    }
    u32x2 ucur[4]; float glcur;
    float4* sin_img = (float4*)(p.ws + WS_SIN) + (size_t)(dh * 16) * 4096;
    __syncthreads();
    {
        const int c0 = gdn_chain_chunk(dir, s_begin);
        GsG1 g1; gs_load1(p, dh, c0, g1); gs_store1(g1, lds);
        GsG3 g3; gs_load3(p, dh, c0, g3); gs_store3(g3, lds);
#pragma unroll
        for (int m = 0; m < 4; ++m) ucur[m] = g3.ut[m];
        glcur = g3.gl;
    }
    __syncthreads();
#pragma unroll 1
    for (int t = 0; t < nsteps; ++t) {
        const int s = s_begin + t;
        const int cn = gdn_chain_chunk(dir, t + 1 < nsteps ? s + 1 : s);
        const unsigned char* buf = lds + (t & 1) * GS_BUF; unsigned char* nbuf = lds + ((t + 1) & 1) * GS_BUF;
        const bf16_t* sW = (const bf16_t*)(buf + GS_SW); const bf16_t* sKDT = (const bf16_t*)(buf + GS_SKDT);
        GsG1 g1; gs_load1(p, dh, cn, g1);
        f32x4 vb_[4], va_[4];
#pragma unroll
        for (int m = 0; m < 4; ++m) {
            f32x4 accb = (f32x4){0.f, 0.f, 0.f, 0.f}, acca = (f32x4){0.f, 0.f, 0.f, 0.f};
#pragma unroll
            for (int kk = 0; kk < 4; ++kk) {
                const bf16x8 a = *(const bf16x8*)(sW + (16 * m + rr) * GU_LDQ + kk * 32 + 8 * q4);
                accb = __builtin_amdgcn_mfma_f32_16x16x32_bf16(a, SbB[kk], accb, 0, 0, 0);
                if (!first) acca = __builtin_amdgcn_mfma_f32_16x16x32_bf16(a, SbA[kk], acca, 0, 0, 0);
            }
            vb_[m][0] = lo2f(ucur[m].x) - accb[0]; vb_[m][1] = hi2f(ucur[m].x) - accb[1]; vb_[m][2] = lo2f(ucur[m].y) - accb[2]; vb_[m][3] = hi2f(ucur[m].y) - accb[3];
            va_[m] = -acca;
        }
        bf16x8 VBb[2], VBa[2];
#pragma unroll
        for (int k2 = 0; k2 < 2; ++k2) {
            const u32x4 pb = {pack2(vb_[2 * k2][0], vb_[2 * k2][1]), pack2(vb_[2 * k2][2], vb_[2 * k2][3]), pack2(vb_[2 * k2 + 1][0], vb_[2 * k2 + 1][1]), pack2(vb_[2 * k2 + 1][2], vb_[2 * k2 + 1][3])};
            const u32x4 pa = {pack2(va_[2 * k2][0], va_[2 * k2][1]), pack2(va_[2 * k2][2], va_[2 * k2][3]), pack2(va_[2 * k2 + 1][0], va_[2 * k2 + 1][1]), pack2(va_[2 * k2 + 1][2], va_[2 * k2 + 1][3])};
            VBb[k2] = __builtin_bit_cast(bf16x8, pb); VBa[k2] = __builtin_bit_cast(bf16x8, pa);
        }
        gs_store1(g1, nbuf);
        GsG3 g3; gs_load3(p, dh, cn, g3);
        const float egl = __expf(glcur);
#pragma unroll
        for (int m = 0; m < 8; ++m) {
            f32x4 accb = ScB[m] * egl, acca = ScA[m] * egl;
#pragma unroll
            for (int k2 = 0; k2 < 2; ++k2) {
                const bf16x8 a = *(const bf16x8*)(sKDT + (16 * m + rr) * GU_LDT + k2 * 32 + 8 * q4);
                accb = __builtin_amdgcn_mfma_f32_16x16x32_bf16(a, VBb[k2], accb, 0, 0, 0);
                if (!first) acca = __builtin_amdgcn_mfma_f32_16x16x32_bf16(a, VBa[k2], acca, 0, 0, 0);
            }
            ScB[m] = accb; ScA[m] = acca;
        }
#pragma unroll
        for (int kk = 0; kk < 4; ++kk) {
            const u32x4 pb = {pack2(ScB[2 * kk][0], ScB[2 * kk][1]), pack2(ScB[2 * kk][2], ScB[2 * kk][3]), pack2(ScB[2 * kk + 1][0], ScB[2 * kk + 1][1]), pack2(ScB[2 * kk + 1][2], ScB[2 * kk + 1][3])};
            const u32x4 pa = {pack2(ScA[2 * kk][0], ScA[2 * kk][1]), pack2(ScA[2 * kk][2], ScA[2 * kk][3]), pack2(ScA[2 * kk + 1][0], ScA[2 * kk + 1][1]), pack2(ScA[2 * kk + 1][2], ScA[2 * kk + 1][3])};
            SbB[kk] = __builtin_bit_cast(bf16x8, pb); SbA[kk] = __builtin_bit_cast(bf16x8, pa);
        }
        gs_store3(g3, nbuf);
#pragma unroll
        for (int m = 0; m < 4; ++m) ucur[m] = g3.ut[m];
        glcur = g3.gl;
        if (first && t == 3) {
#pragma unroll
            for (int m = 0; m < 8; ++m) sin_img[(wave * 8 + m) * 64 + lane] = make_float4(ScB[m][0], ScB[m][1], ScB[m][2], ScB[m][3]);
        }
        __syncthreads();
    }
    if (first) {
#pragma unroll
        for (int m = 0; m < 8; ++m) sin_img[4096 + (wave * 8 + m) * 64 + lane] = make_float4(ScB[m][0], ScB[m][1], ScB[m][2], ScB[m][3]);
    } else {
        float4* bimg = (float4*)(p.ws + WS_BSEG) + (size_t)(dh * 16 + k) * 4096;
        bf16_t* aseg = (bf16_t*)(p.ws + WS_ASEG) + (size_t)(dh * 16 + k) * 128 * 128;
        const int pc = perm_slot64(16 * wave + rr);
#pragma unroll
        for (int m = 0; m < 8; ++m) {
            bimg[(wave * 8 + m) * 64 + lane] = make_float4(ScB[m][0], ScB[m][1], ScB[m][2], ScB[m][3]);
#pragma unroll
            for (int jj = 0; jj < 4; ++jj) aseg[(size_t)(16 * m + 4 * q4 + jj) * 128 + pc] = f2bf(ScA[m][jj]);
        }
    }
}
__device__ __forceinline__ void gdn_seg_chain(const Params& p, int dh, unsigned char* lds) {
    const int tid = tid_(), lane = tid & 63, wave = tid >> 6, rr = lane & 15, q4 = lane >> 4;
    float4* sin_img = (float4*)(p.ws + WS_SIN) + (size_t)(dh * 16) * 4096;
    const float4* bimg = (const float4*)(p.ws + WS_BSEG) + (size_t)(dh * 16) * 4096;
    const bf16_t* aseg = (const bf16_t*)(p.ws + WS_ASEG) + (size_t)(dh * 16) * 128 * 128;
    f32x4 Sc[8]; bf16x8 Sb[4];
#pragma unroll
    for (int m = 0; m < 8; ++m) { const float4 v = sin_img[4096 + (wave * 8 + m) * 64 + lane]; Sc[m] = (f32x4){v.x, v.y, v.z, v.w}; }
    u32x4 ar[4];
    __syncthreads();
#pragma unroll
    for (int q = 0; q < 4; ++q) { const int t = tid + q * NTHREADS; ar[q] = *(const u32x4*)(aseg + (size_t)1 * 16384 + (size_t)(t >> 4) * 128 + (t & 15) * 8); }
#pragma unroll
    for (int q = 0; q < 4; ++q) { const int t = tid + q * NTHREADS; *(u32x4*)((bf16_t*)lds + (t >> 4) * GU_LDQ + (t & 15) * 8) = ar[q]; }
    __syncthreads();
#pragma unroll 1
    for (int k = 1; k <= 14; ++k) {
        const bf16_t* sA = (const bf16_t*)(lds + ((k - 1) & 1) * 34816);
        if (k < 14) {
#pragma unroll
            for (int q = 0; q < 4; ++q) { const int t = tid + q * NTHREADS; ar[q] = *(const u32x4*)(aseg + (size_t)(k + 1) * 16384 + (size_t)(t >> 4) * 128 + (t & 15) * 8); }
        }
#pragma unroll
        for (int kk = 0; kk < 4; ++kk) {
            const u32x4 pk = {pack2(Sc[2 * kk][0], Sc[2 * kk][1]), pack2(Sc[2 * kk][2], Sc[2 * kk][3]), pack2(Sc[2 * kk + 1][0], Sc[2 * kk + 1][1]), pack2(Sc[2 * kk + 1][2], Sc[2 * kk + 1][3])};
            Sb[kk] = __builtin_bit_cast(bf16x8, pk);
        }
#pragma unroll
        for (int m = 0; m < 8; ++m) {
            const float4 bv = bimg[(size_t)k * 4096 + (wave * 8 + m) * 64 + lane];
            f32x4 acc = (f32x4){bv.x, bv.y, bv.z, bv.w};
#pragma unroll
            for (int kk = 0; kk < 4; ++kk)
                acc = __builtin_amdgcn_mfma_f32_16x16x32_bf16(*(const bf16x8*)(sA + (16 * m + rr) * GU_LDQ + kk * 32 + 8 * q4), Sb[kk], acc, 0, 0, 0);
            Sc[m] = acc;
            sin_img[(size_t)(k + 1) * 4096 + (wave * 8 + m) * 64 + lane] = make_float4(acc[0], acc[1], acc[2], acc[3]);
        }
        if (k < 14) {
#pragma unroll
            for (int q = 0; q < 4; ++q) { const int t = tid + q * NTHREADS; *(u32x4*)((bf16_t*)(lds + (k & 1) * 34816) + (t >> 4) * GU_LDQ + (t & 15) * 8) = ar[q]; }
        }
        __syncthreads();
    }
}
__device__ __forceinline__ void gdn_seq(const Params& p, int dh, int k, unsigned char* lds) {
    const int tid = tid_(), lane = tid & 63, wave = tid >> 6, rr = lane & 15, q4 = lane >> 4, dir = dh >> 3, head = dh & 7;
    const int s_begin = 4 + 16 * k;
    f32x4 Sc[8]; bf16x8 Sb[4];
    {
        const float4* sin_img = (const float4*)(p.ws + WS_SIN) + (size_t)(dh * 16 + k) * 4096;
#pragma unroll
        for (int m = 0; m < 8; ++m) { const float4 v = sin_img[(wave * 8 + m) * 64 + lane]; Sc[m] = (f32x4){v.x, v.y, v.z, v.w}; }
#pragma unroll
        for (int kk = 0; kk < 4; ++kk) {
            const u32x4 pk = {pack2(Sc[2 * kk][0], Sc[2 * kk][1]), pack2(Sc[2 * kk][2], Sc[2 * kk][3]), pack2(Sc[2 * kk + 1][0], Sc[2 * kk + 1][1]), pack2(Sc[2 * kk + 1][2], Sc[2 * kk + 1][3])};
            Sb[kk] = __builtin_bit_cast(bf16x8, pk);
        }
    }
    u32x2 ucur[4]; float glcur;
    __syncthreads();
    {
        const int c0 = gdn_chain_chunk(dir, s_begin);
        GsG1 g1; gs_load1(p, dh, c0, g1); gs_store1(g1, lds);
        GsG2 g2; gs_load2(p, dh, c0, g2); gs_store2(g2, lds);
        GsG3 g3; gs_load3(p, dh, c0, g3); gs_store3(g3, lds);
#pragma unroll
        for (int m = 0; m < 4; ++m) ucur[m] = g3.ut[m];
        glcur = g3.gl;
    }
    __syncthreads();
    bf16_t* of = (bf16_t*)(p.ws + WS_OF) + (size_t)dir * SEQ * 1024;
#pragma unroll 1
    for (int t = 0; t < 16; ++t) {
        const int s = s_begin + t;
        const int c = gdn_chain_chunk(dir, s);
        const int cn = gdn_chain_chunk(dir, t + 1 < 16 ? s + 1 : s);
        const unsigned char* buf = lds + (t & 1) * GS_BUF; unsigned char* nbuf = lds + ((t + 1) & 1) * GS_BUF;
        const bf16_t* sW = (const bf16_t*)(buf + GS_SW); const bf16_t* sQD = (const bf16_t*)(buf + GS_SQD);
        const bf16_t* sKDT = (const bf16_t*)(buf + GS_SKDT); const bf16_t* sATT = (const bf16_t*)(buf + GS_SATT);
        GsG1 g1; gs_load1(p, dh, cn, g1);
        f32x4 vn[4];
#pragma unroll
        for (int m = 0; m < 4; ++m) {
            f32x4 acc = (f32x4){0.f, 0.f, 0.f, 0.f};
#pragma unroll
            for (int kk = 0; kk < 4; ++kk)
                acc = __builtin_amdgcn_mfma_f32_16x16x32_bf16(*(const bf16x8*)(sW + (16 * m + rr) * GU_LDQ + kk * 32 + 8 * q4), Sb[kk], acc, 0, 0, 0);
            vn[m][0] = lo2f(ucur[m].x) - acc[0]; vn[m][1] = hi2f(ucur[m].x) - acc[1]; vn[m][2] = lo2f(ucur[m].y) - acc[2]; vn[m][3] = hi2f(ucur[m].y) - acc[3];
        }
        bf16x8 VB[2];
#pragma unroll
        for (int k2 = 0; k2 < 2; ++k2) {
            const unsigned a0 = pack2(vn[2 * k2][0], vn[2 * k2][1]), a1 = pack2(vn[2 * k2][2], vn[2 * k2][3]);
            const unsigned a2 = pack2(vn[2 * k2 + 1][0], vn[2 * k2 + 1][1]), a3 = pack2(vn[2 * k2 + 1][2], vn[2 * k2 + 1][3]);
            const u32x4 pk = {a0, a1, a2, a3}; VB[k2] = __builtin_bit_cast(bf16x8, pk);
        }
        gs_store1(g1, nbuf);
        GsG2 g2; gs_load2(p, dh, cn, g2);
#pragma unroll
        for (int m = 0; m < 4; ++m) {
            f32x4 acc = (f32x4){0.f, 0.f, 0.f, 0.f};
#pragma unroll
            for (int kk = 0; kk < 4; ++kk)
                acc = __builtin_amdgcn_mfma_f32_16x16x32_bf16(*(const bf16x8*)(sQD + (16 * m + rr) * GU_LDQ + kk * 32 + 8 * q4), Sb[kk], acc, 0, 0, 0);
#pragma unroll
            for (int k2 = 0; k2 < 2; ++k2)
                acc = __builtin_amdgcn_mfma_f32_16x16x32_bf16(*(const bf16x8*)(sATT + (16 * m + rr) * GU_LDT + k2 * 32 + 8 * q4), VB[k2], acc, 0, 0, 0);
#pragma unroll
            for (int jj = 0; jj < 4; ++jj) {
                const int pos = 16 * m + 4 * q4 + jj;
                of[(size_t)(c * 64 + (dir ? 63 - pos : pos)) * 1024 + head * 128 + 16 * wave + rr] = f2bf(acc[jj]);
            }
        }
        gs_store2(g2, nbuf);
        GsG3 g3; gs_load3(p, dh, cn, g3);
        const float egl = __expf(glcur);
#pragma unroll
        for (int m = 0; m < 8; ++m) {
            f32x4 acc = Sc[m] * egl;
#pragma unroll
            for (int k2 = 0; k2 < 2; ++k2)
                acc = __builtin_amdgcn_mfma_f32_16x16x32_bf16(*(const bf16x8*)(sKDT + (16 * m + rr) * GU_LDT + k2 * 32 + 8 * q4), VB[k2], acc, 0, 0, 0);
            Sc[m] = acc;
        }
#pragma unroll
        for (int kk = 0; kk < 4; ++kk) {
            const u32x4 pk = {pack2(Sc[2 * kk][0], Sc[2 * kk][1]), pack2(Sc[2 * kk][2], Sc[2 * kk][3]),
                              pack2(Sc[2 * kk + 1][0], Sc[2 * kk + 1][1]), pack2(Sc[2 * kk + 1][2], Sc[2 * kk + 1][3])};
            Sb[kk] = __builtin_bit_cast(bf16x8, pk);
        }
        gs_store3(g3, nbuf);
#pragma unroll
        for (int m = 0; m < 4; ++m) ucur[m] = g3.ut[m];
        glcur = g3.gl;
        __syncthreads();
    }
}

__device__ __forceinline__ void gdn_readout_row(const Params& p, int row) {
    const int lane = tid_() & 63, head = lane >> 3, d0 = (lane & 7) * 16;
    const bf16_t* of0 = (const bf16_t*)(p.ws + WS_OF) + (size_t)row * 1024 + head * 128 + d0;
    const bf16_t* of1 = of0 + (size_t)SEQ * 1024;
    const bf16_t* zp = (const bf16_t*)(p.ws + WS_Z) + (size_t)row * 1024 + head * 128 + d0;
    float a[16], b[16], z[16];
    unpack8(*(const uint4*)of0, a); unpack8(*(const uint4*)(of0 + 8), a + 8);
    unpack8(*(const uint4*)of1, b); unpack8(*(const uint4*)(of1 + 8), b + 8);
    unpack8(*(const uint4*)zp, z); unpack8(*(const uint4*)(zp + 8), z + 8);
    float ss = 0.f;
#pragma unroll
    for (int e = 0; e < 16; ++e) { a[e] += b[e]; ss += a[e] * a[e]; }
    ss += __shfl_xor(ss, 1, 64); ss += __shfl_xor(ss, 2, 64); ss += __shfl_xor(ss, 4, 64);
    const float rs = rsqrtf(ss * (1.f / 128.f) + 1e-6f);
    const float* ng = p.in[25] + d0;
    float f[16];
#pragma unroll
    for (int e = 0; e < 16; ++e) f[e] = a[e] * rs * ng[e] * siluf_(z[e]);
    bf16_t* dst = (bf16_t*)(p.ws + WS_VN) + (size_t)row * 1024 + head * 128 + d0;
    *(uint4*)dst = pack8(f); *(uint4*)(dst + 8) = pack8(f + 8);
}

#define XB_TMO      128
#define XB_XCNT(j)  (256  + 64 * (j))
#define XB_XSUB(j)  (1280 + 64 * (j))
#define XB_XGEN(j)  (2304 + 64 * (j))
#define XB_TOP      3328
#define XB_TOPGEN   3392
#define XCD_BAR_WORDS 3456
#define XB_SPIN_CAP (1u << 22)
__device__ __forceinline__ unsigned xb_ld(unsigned* p)              { return __hip_atomic_load(p, __ATOMIC_RELAXED, __HIP_MEMORY_SCOPE_AGENT); }
__device__ __forceinline__ unsigned xb_add(unsigned* p, unsigned v) { return __hip_atomic_fetch_add(p, v, __ATOMIC_RELAXED, __HIP_MEMORY_SCOPE_AGENT); }
__device__ __forceinline__ unsigned xb_xcc_id() { return (unsigned)__builtin_amdgcn_s_getreg((3 << 11) | 20) & 0xFu; }
#define XB_SPIN(cond, bar) do { unsigned _sp = 0; while (cond) { __builtin_amdgcn_s_sleep(1); \
    if ((++_sp & 255u) == 0u) { if (xb_ld(&(bar)[XB_TMO])) break; if (_sp > XB_SPIN_CAP) { atomicAdd(&(bar)[XB_TMO], 1u); break; } } } } while (0)
struct XcdBarrier { unsigned* bar; unsigned x; volatile LAS unsigned* st; };
__device__ __forceinline__ XcdBarrier xcd_barrier_post(unsigned* bar, volatile LAS unsigned* st) {
    XcdBarrier b; b.bar = bar; b.x = xb_xcc_id(); b.st = st;
    if (threadIdx.x == 0) (void)xb_add(&bar[XB_XCNT(b.x)], 1u);
    return b;
}
__device__ __forceinline__ void xcd_barrier_complete(unsigned* bar, unsigned x, unsigned& nloc, unsigned& nx) {
    const unsigned G = gridDim.x * gridDim.y * gridDim.z;
    unsigned sum, cnt, mine, sp = 0u;
    for (;;) {
        sum = 0u; cnt = 0u; mine = 0u;
#pragma unroll
        for (unsigned j = 0; j < 16; ++j) { const unsigned c = xb_ld(&bar[XB_XCNT(j)]); sum += c; cnt += (c > 0u) ? 1u : 0u; mine = (j == x) ? c : mine; }
        if (sum == G) break;
        __builtin_amdgcn_s_sleep(1);
        if ((++sp & 255u) == 0u) { if (xb_ld(&bar[XB_TMO])) break; if (sp > XB_SPIN_CAP) { atomicAdd(&bar[XB_TMO], 1u); break; } }
    }
    nloc = mine > 0u ? mine : 1u; nx = cnt > 0u ? cnt : 1u;
}
__device__ __forceinline__ void xcd_barrier(const XcdBarrier& b) {
    asm volatile("s_waitcnt vmcnt(0)" ::: "memory");
    __syncthreads();
    if (threadIdx.x == 0) {
        unsigned* bar = b.bar;
        __builtin_amdgcn_s_waitcnt(0);
        unsigned nloc = b.st[0], nx = b.st[1];
        if (nloc == 0u) { xcd_barrier_complete(bar, b.x, nloc, nx); b.st[0] = nloc; b.st[1] = nx; }
        const unsigned old = xb_add(&bar[XB_XSUB(b.x)], 1u);
        const unsigned gen = old / nloc;
        if (old + 1u == (gen + 1u) * nloc) {
            __builtin_amdgcn_fence(__ATOMIC_RELEASE, "agent");
            asm volatile("s_waitcnt vmcnt(0)" ::: "memory");
            const unsigned og = xb_add(&bar[XB_TOP], 1u);
            const unsigned tg = og / nx;
            if (og + 1u == (tg + 1u) * nx) xb_add(&bar[XB_TOPGEN], 1u);
            else XB_SPIN(xb_ld(&bar[XB_TOPGEN]) == tg, bar);
            __builtin_amdgcn_fence(__ATOMIC_ACQUIRE, "agent");
            xb_add(&bar[XB_XGEN(b.x)], 1u);
            asm volatile("s_waitcnt vmcnt(0)" ::: "memory");
        } else {
            XB_SPIN(xb_ld(&bar[XB_XGEN(b.x)]) == gen, bar);
            __builtin_amdgcn_fence(__ATOMIC_ACQUIRE, "agent");
            asm volatile("s_waitcnt vmcnt(0)" ::: "memory");
        }
    }
    __syncthreads();
}

#ifndef PHMASK
#define PHMASK 0xFFFFFFFFull
#endif
#define PH(n) (((PHMASK) >> (n)) & 1ull)
#define FOR_ITEMS(n) for (int item = blockIdx.x; item < (n); item += gridDim.x)
__global__ void __launch_bounds__(NTHREADS) fwd_megakernel(Params p) {
    extern __shared__ __attribute__((aligned(16))) unsigned char lds[];
    cg::grid_group grid = cg::this_grid();
    unsigned char* ws = p.ws;
    volatile LAS unsigned* xbst = (volatile LAS unsigned*)(LAS unsigned char*)(lds + LDS_BYTES - 16);
    if (threadIdx.x == 0) { xbst[0] = 0u; xbst[1] = 0u; }
    __syncthreads();
    const XcdBarrier xbar = xcd_barrier_post((unsigned*)(ws + WS_BAR), xbst);

    if (PH(0)) {
        constexpr int N_S5 = 64, N_ADA = 192, N_T0 = 512, N_T1 = 64, N_T2 = 256, N_T3 = 16 * 65, N_T4 = 256, N_T5 = 512, N_T6 = 512, N_SK = 16, N_PT = 4096;
        constexpr int O1 = N_S5, O2 = O1 + N_ADA, O3 = O2 + N_T0, O4 = O3 + N_T1, O5 = O4 + N_T2, O6 = O5 + N_T3, O7 = O6 + N_T4, O8 = O7 + N_T5, O9 = O8 + N_T6, O10 = O9 + N_SK, O11 = O10 + N_PT;
        FOR_ITEMS(O11) {
            if (item < O1) p0_s5_tables(p, item, lds);
            else if (item < O2) p0_adaln(p, item - O1, lds);
            else if (item < O3) p0_transpose(p.in[8], 1024, 2048, (bf16_t*)(ws + WS_WEIN), item - O2, lds);
            else if (item < O4) p0_transpose(p.in[18], 512, 512, (bf16_t*)(ws + WS_WGLU), item - O3, lds);
            else if (item < O5) p0_transpose(p.in[20], 1024, 1024, (bf16_t*)(ws + WS_WEOUT), item - O4, lds);
            else if (item < O6) p0_transpose(p.in[21], 1024, ODD_IN, (bf16_t*)(ws + WS_WOIN), item - O5, lds);
            else if (item < O7) p0_transpose(p.in[26], 1024, 1024, (bf16_t*)(ws + WS_WOOUT), item - O6, lds);
            else if (item < O8) p0_transpose(p.in[27], 1024, 2048, (bf16_t*)(ws + WS_WQ0), item - O7, lds);
            else if (item < O9) p0_transpose(p.in[27] + (size_t)1024 * 2048, 1024, 2048, (bf16_t*)(ws + WS_WQ1), item - O8, lds);
            else if (item < O10) cvt_chunk(p.in[28], (bf16_t*)(ws + WS_SK), item - O9);
            else peer_tables_item(p, item - O10, 0);
        }
    }
    grid.sync();
    if (PH(1)) FOR_ITEMS(2080 + 2048) {
        if (item < 2080) norm_rows_item(p, item, 0, p.in[6], 0, true);
        else s5_mintra_item(p, item - 2080);
    }
    xcd_barrier(xbar);
    if (PH(2)) FOR_ITEMS(130 * 16) {
        EpiEvenIn e{(bf16_t*)(ws + WS_PA), (bf16_t*)(ws + WS_UG)};
        gemm_tile((const bf16_t*)(ws + WS_ACT), 1024, R, (const bf16_t*)(ws + WS_WEIN), 1024, 2048, 1024, (item >> 4) * 128, (item & 15) * 128, e, lds);
    }
    xcd_barrier(xbar);
    if (PH(3)) FOR_ITEMS(32 * 30) {
        const int g = item / 30, r = item % 30, tm = r / 10, tn = r % 10;
        EpiS5Local e{(float*)(ws + WS_YL), (float*)(ws + WS_LST), g};
        gemm_tile((const bf16_t*)(ws + WS_UG) + (size_t)g * NCH * 1024, 1024, NCH, (const bf16_t*)(ws + WS_MS5) + (size_t)g * 1280 * 1024, 1024, 1280, 1024, tm * 128, tn * 128, e, lds);
    }
    xcd_barrier(xbar);
    if (PH(4)) s5_scan(p);
    xcd_barrier(xbar);
    if (PH(5)) FOR_ITEMS(32 * 24) {
        const int g = item / 24, r = item % 24, tm = r / 8, tn = r % 8;
        EpiS5Out e{(const float*)(ws + WS_YL), (bf16_t*)(ws + WS_GS), g};
        gemm_tile((const bf16_t*)(ws + WS_A5) + (size_t)g * NCH * 256, 256, NCH, (const bf16_t*)(ws + WS_O5) + (size_t)g * 1024 * 256, 256, 1024, 256, tm * 128, tn * 128, e, lds);
    }
    xcd_barrier(xbar);
    if (PH(6)) FOR_ITEMS(130 * 4 + NCH) {
        if (item < 520) {
            EpiGlu e{(const bf16_t*)(ws + WS_GS), p.in[19], (bf16_t*)(ws + WS_CB)};
            gemm_tile((const bf16_t*)(ws + WS_GS), 512, R, (const bf16_t*)(ws + WS_WGLU), 512, 512, 512, (item >> 2) * 128, (item & 3) * 128, e, lds);
        } else even_conv_item(p, item - 520);
    }
    xcd_barrier(xbar);
    if (PH(7)) FOR_ITEMS(130 * 8) {
        EpiResid e{p.in[0], p.in[2], (float*)(ws + WS_H), (const float*)(ws + WS_MOD), 0, true};
        gemm_tile((const bf16_t*)(ws + WS_CB), 1024, R, (const bf16_t*)(ws + WS_WEOUT), 1024, 1024, 1024, (item >> 3) * 128, (item & 7) * 128, e, lds);
    }
    xcd_barrier(xbar);
#pragma unroll 1
    for (int l = 0; l < 2; ++l) {
        const int nrows = l == 0 ? R : SEQ, ntm = nrows / 128;
        if (l == 1) {
            if (PH(13)) FOR_ITEMS(2080) norm_rows_item(p, item, 1, p.in[6] + 1024, 0, false);
            xcd_barrier(xbar);
            if (PH(14)) FOR_ITEMS(130 * 33) {
                EpiOddIn e{(bf16_t*)(ws + WS_QKVR), (bf16_t*)(ws + WS_Z), (float*)(ws + WS_AB)};
                gemm_tile((const bf16_t*)(ws + WS_ACT), 1024, R, (const bf16_t*)(ws + WS_WOIN), 1024, ODD_IN, 1024, (item / 33) * 128, (item % 33) * 128, e, lds);
            }
            xcd_barrier(xbar);
            if (PH(15)) FOR_ITEMS(R / 16) gdn_prep_item(p, item);
            xcd_barrier(xbar);
            if (PH(16)) FOR_ITEMS(NUNITS) gdn_unit(p, item, lds);
            xcd_barrier(xbar);
            if (PH(17)) {
                FOR_ITEMS(256) { if ((item & 15) != 15) gdn_seg_ab(p, item >> 4, item & 15, lds); }
                xcd_barrier(xbar);
                if (blockIdx.x < 16) gdn_seg_chain(p, blockIdx.x, lds);
                xcd_barrier(xbar);
                FOR_ITEMS(256) gdn_seq(p, item >> 4, item & 15, lds);
            }
            xcd_barrier(xbar);
            if (PH(18)) FOR_ITEMS(SEQ / 8) gdn_readout_row(p, item * 8 + (tid_() >> 6));
            xcd_barrier(xbar);
            if (PH(19)) FOR_ITEMS(128 * 8 + 4096) {
                if (item < 1024) {
                    EpiResid e{p.in[0], p.in[2], (float*)(ws + WS_H), (const float*)(ws + WS_MOD), 1, false};
                    gemm_tile((const bf16_t*)(ws + WS_VN), 1024, SEQ, (const bf16_t*)(ws + WS_WOOUT), 1024, 1024, 1024, (item >> 3) * 128, (item & 7) * 128, e, lds);
                } else peer_tables_item(p, item - 1024, 1);
            }
            xcd_barrier(xbar);
        }
        if (PH(8)) FOR_ITEMS(nrows / 8) norm_rows_item(p, item, l, p.in[7] + l * 1024, 3, false);
        xcd_barrier(xbar);
        if (PH(9)) FOR_ITEMS(ntm * 16) {
            EpiBf16 e{(bf16_t*)(ws + WS_Q), 2048};
            gemm_tile((const bf16_t*)(ws + WS_ACT), 1024, nrows, (const bf16_t*)(ws + (l == 0 ? WS_WQ0 : WS_WQ1)), 1024, 2048, 1024, (item >> 4) * 128, (item & 15) * 128, e, lds);
        }
        xcd_barrier(xbar);
        if (PH(10)) FOR_ITEMS(ntm * 16) {
            const int b = item & 15;
            EpiScore e{(unsigned short*)(ws + WS_SC), b * 128};
            gemm_tile((const bf16_t*)(ws + WS_Q) + b * 128, 2048, nrows, (const bf16_t*)(ws + WS_SK) + (size_t)(l * 2 + (b & 1)) * 128 * 128, 128, 128, 128, (item >> 4) * 128, 0, e, lds);
        }
        xcd_barrier(xbar);
        if (PH(11)) FOR_ITEMS(nrows / 64) peer_route_item(p, item, nrows, lds);
        xcd_barrier(xbar);
        if (PH(12)) FOR_ITEMS(nrows / 8) peer_gather_row(p, item * 8 + (tid_() >> 6), l, l == 1);
        if (l == 0) xcd_barrier(xbar);
    }
}

extern "C" void kernel_launch(void* const* d_in, const int* in_sizes, int n_in, void* d_out, int out_size, void* d_ws, size_t ws_size, hipStream_t stream) {
    static int grid_blocks = 0;
    if (grid_blocks == 0) {
        if (n_in != 32 || out_size != SEQ * D || ws_size < WS_NEED) {
            fprintf(stderr, "kernel_launch: unexpected problem (n_in %d, out %d, ws %zu, need %zu); nothing launched\n", n_in, out_size, ws_size, (size_t)WS_NEED);
            grid_blocks = -1; return;
        }
        int dev = 0, cus = 0, per_cu = 0;
        hipGetDevice(&dev);
        hipDeviceGetAttribute(&cus, hipDeviceAttributeMultiprocessorCount, dev);
        hipFuncSetAttribute((const void*)fwd_megakernel, hipFuncAttributeMaxDynamicSharedMemorySize, LDS_BYTES);
        hipOccupancyMaxActiveBlocksPerMultiprocessor(&per_cu, (const void*)fwd_megakernel, NTHREADS, LDS_BYTES);
        if (per_cu < 1) { fprintf(stderr, "kernel_launch: occupancy query says %d blocks per CU; nothing launched\n", per_cu); grid_blocks = -1; return; }
        grid_blocks = cus;
    }
    if (grid_blocks < 0) return;
    (void)hipMemsetAsync((unsigned char*)d_ws + WS_BAR, 0, XCD_BAR_WORDS * 4, stream);
    Params prm{};
    for (int i = 0; i < 32; ++i) prm.in[i] = (const float*)d_in[i];
    prm.out = (float*)d_out; prm.ws = (unsigned char*)d_ws;
    void* args[] = {&prm};
    hipError_t e = hipLaunchCooperativeKernel((const void*)fwd_megakernel, dim3(grid_blocks), dim3(NTHREADS), args, LDS_BYTES, stream);
    if (e != hipSuccess) fprintf(stderr, "cooperative launch failed: %s (grid %d)\n", hipGetErrorString(e), grid_blocks);
}
```

```cpp
#include <hip/hip_runtime.h>
#include <hip/hip_cooperative_groups.h>
#include <cstdio>
#include <cstdint>
namespace cg = cooperative_groups;

typedef unsigned short bf16_t;
typedef short bf16x8 __attribute__((ext_vector_type(8)));
typedef float f32x4 __attribute__((ext_vector_type(4)));
typedef float f32x16 __attribute__((ext_vector_type(16)));
typedef unsigned u32x4 __attribute__((ext_vector_type(4)));

constexpr int D = 1024, SEQ = 16384, CTX = 256, R = SEQ + CTX;
constexpr int NCH = R / 64;
constexpr int NCH_LAT = SEQ / 64;
constexpr int NTHREADS = 512;
constexpr int ODD_IN = 4128;
constexpr int NUNITS = 16 * NCH;

constexpr size_t al256(size_t x) { return (x + 255) & ~(size_t)255; }
constexpr size_t WS_BAR   = 0;
constexpr size_t WS_PARAMS = 14336;
constexpr size_t WS_MOD   = 16384;
constexpr size_t WS_A64   = WS_MOD + al256(2 * 2 * 6 * 1024 * 4);
constexpr size_t WS_SK    = WS_A64 + al256(2 * 32 * 64 * 8);
constexpr size_t WS_PSC   = WS_SK + al256(2 * 2 * 128 * 128 * 2);
constexpr size_t WS_WEIN  = WS_PSC + al256(2 * 16384 * 4);
constexpr size_t WS_WGLU  = WS_WEIN + (size_t)2048 * 1024 * 2;
constexpr size_t WS_WEOUT = WS_WGLU + (size_t)512 * 512 * 2;
constexpr size_t WS_WQ0   = WS_WEOUT + (size_t)1024 * 1024 * 2;
constexpr size_t WS_WQ1   = WS_WQ0 + (size_t)2048 * 1024 * 2;
constexpr size_t WS_WOIN  = WS_WQ1 + (size_t)2048 * 1024 * 2;
constexpr size_t WS_WOOUT = WS_WOIN + al256((size_t)ODD_IN * 1024 * 2);
constexpr size_t WS_H     = WS_WOOUT + (size_t)1024 * 1024 * 2;
constexpr size_t WS_PUV   = WS_H + (size_t)R * 1024 * 4;
constexpr size_t WS_ACT   = WS_PUV + (size_t)2 * 16384 * 1024 * 2;
constexpr size_t WS_ARENA = WS_ACT + (size_t)R * 1024 * 2;
constexpr size_t WS_GG    = WS_WEIN;
constexpr size_t WS_BETA  = WS_GG + (size_t)16 * R * 4;
constexpr size_t WS_GC    = WS_BETA + (size_t)16 * R * 4;
constexpr size_t WS_AB    = WS_GC + (size_t)NUNITS * 64 * 4;
static_assert(WS_AB + (size_t)R * 32 * 4 <= WS_WQ1, "layer-1 small buffers overflow the dead layer-0 weights");
constexpr size_t WS_PA    = WS_ARENA;
constexpr size_t WS_WQB   = WS_PA;
constexpr size_t WS_UG    = WS_PA + (size_t)R * 1536 * 2;
constexpr size_t WS_MS5   = WS_UG + (size_t)32 * NCH * 1024 * 2;
constexpr size_t WS_O5    = WS_MS5 + (size_t)32 * 1280 * 1024 * 2;
constexpr size_t WS_KTAB  = WS_O5 + (size_t)32 * 1024 * 256 * 2;
constexpr size_t WS_YL    = WS_KTAB + (size_t)2 * 32 * 64 * 256 * 4;
constexpr size_t WS_LST   = WS_YL + (size_t)R * 512 * 4;
constexpr size_t WS_A5    = WS_LST + (size_t)32 * NCH * 256 * 4;
constexpr size_t WS_GS    = WS_A5 + (size_t)32 * NCH * 256 * 2;
constexpr size_t WS_CB    = WS_GS + (size_t)R * 512 * 2;
constexpr size_t WS_END_L0 = WS_CB + (size_t)R * 1024 * 2;
constexpr size_t WS_Q     = WS_ARENA;
constexpr size_t WS_SC    = WS_Q + (size_t)R * 2048 * 2;
constexpr size_t WS_IDX   = WS_SC + (size_t)R * 2048 * 2;
constexpr size_t WS_GATE  = WS_IDX + (size_t)R * 128 * 4;
constexpr size_t WS_END_PEER = WS_GATE + (size_t)R * 128 * 4;
constexpr size_t WS_QKVR  = WS_ARENA;
constexpr size_t WS_W     = WS_QKVR;
constexpr size_t WS_ATT   = WS_W + (size_t)NUNITS * 64 * 128 * 2;
static_assert(WS_ATT + (size_t)NUNITS * 64 * 64 * 2 <= WS_QKVR + (size_t)R * 3072 * 2, "W+ATT must fit in QKVR");
constexpr size_t WS_Z     = WS_QKVR + (size_t)R * 3072 * 2;
constexpr size_t WS_QN    = WS_Z + (size_t)R * 1024 * 2;
constexpr size_t WS_KN    = WS_QN + (size_t)R * 1024 * 2;
constexpr size_t WS_VN    = WS_KN + (size_t)R * 1024 * 2;
constexpr size_t WS_UT    = WS_VN + (size_t)R * 1024 * 2;
constexpr size_t WS_END_L1 = WS_UT + (size_t)NUNITS * 128 * 64 * 2;
constexpr size_t WS_OF    = WS_PUV;
constexpr size_t WS_SIN   = WS_ACT;
constexpr size_t WS_BSEG  = WS_SIN + (size_t)256 * 65536;
constexpr size_t WS_ASEG  = WS_VN;
static_assert(WS_BSEG + (size_t)256 * 65536 <= WS_ARENA, "SIN+BSEG must fit in ACT");
constexpr size_t cmax(size_t a, size_t b) { return a > b ? a : b; }
constexpr size_t WS_NEED  = cmax(cmax(WS_END_L0, WS_END_PEER), WS_END_L1);
static_assert(WS_NEED <= (size_t)512 * 1024 * 1024, "workspace plan exceeds 512 MiB");

constexpr int LDS_BYTES = 140 * 1024;

struct Params {
    const float* in[32];
    float* out;
    unsigned char* ws;
};

__device__ __forceinline__ int tid_() { int t = threadIdx.x; asm volatile("" : "+v"(t)); return t; }
__device__ __forceinline__ float bf2f(bf16_t b) { return __uint_as_float((unsigned)b << 16); }
__device__ __forceinline__ bf16_t f2bf(float f) { const __bf16 b = (__bf16)f; return __builtin_bit_cast(bf16_t, b); }
typedef float f32x2_t __attribute__((ext_vector_type(2)));
typedef __bf16 bf16x2_t __attribute__((ext_vector_type(2)));
__device__ __forceinline__ unsigned pack2(float lo, float hi) { const f32x2_t v = {lo, hi}; const bf16x2_t b = __builtin_convertvector(v, bf16x2_t); return __builtin_bit_cast(unsigned, b); }
__device__ __forceinline__ float lo2f(unsigned p) { return __uint_as_float(p << 16); }
__device__ __forceinline__ float hi2f(unsigned p) { return __uint_as_float(p & 0xFFFF0000u); }
__device__ __forceinline__ float sigmoidf_(float x) { return 1.f / (1.f + __expf(-x)); }
__device__ __forceinline__ float siluf_(float x) { return x * sigmoidf_(x); }
__device__ __forceinline__ float gelu_tanh(float x) {
    const float u = 0.7978845608028654f * (x + 0.044715f * x * x * x);
    const float t = 1.f - 2.f / (1.f + __expf(2.f * u));
    return 0.5f * x * (1.f + t);
}
__device__ __forceinline__ float wave_sum(float v) {
#pragma unroll
    for (int o = 32; o > 0; o >>= 1) v += __shfl_xor(v, o, 64);
    return v;
}

__device__ __forceinline__ float wave_sum_dpp(float v) {
    v += __int_as_float(__builtin_amdgcn_update_dpp(0, __float_as_int(v), 0xB1, 0xF, 0xF, true));
    v += __int_as_float(__builtin_amdgcn_update_dpp(0, __float_as_int(v), 0x4E, 0xF, 0xF, true));
    v += __int_as_float(__builtin_amdgcn_update_dpp(0, __float_as_int(v), 0x141, 0xF, 0xF, true));
    v += __int_as_float(__builtin_amdgcn_update_dpp(0, __float_as_int(v), 0x140, 0xF, 0xF, true));
    v += __int_as_float(__builtin_amdgcn_update_dpp(0, __float_as_int(v), 0x142, 0xA, 0xF, false));
    v += __int_as_float(__builtin_amdgcn_update_dpp(0, __float_as_int(v), 0x143, 0xC, 0xF, false));
    return __int_as_float(__builtin_amdgcn_readlane(__float_as_int(v), 63));
}
__device__ __forceinline__ void unpack8(const uint4& p, float* f) {
    f[0] = lo2f(p.x); f[1] = hi2f(p.x); f[2] = lo2f(p.y); f[3] = hi2f(p.y);
    f[4] = lo2f(p.z); f[5] = hi2f(p.z); f[6] = lo2f(p.w); f[7] = hi2f(p.w);
}
__device__ __forceinline__ uint4 pack8(const float* f) {
    uint4 p; p.x = pack2(f[0], f[1]); p.y = pack2(f[2], f[3]); p.z = pack2(f[4], f[5]); p.w = pack2(f[6], f[7]); return p;
}
__device__ __forceinline__ const float* modp(const Params& p, int l, int row, int j) {
    const float* m = (const float*)(p.ws + WS_MOD);
    return m + ((l * 2 + (row >= SEQ ? 1 : 0)) * 6 + j) * 1024;
}

#define LAS __attribute__((address_space(3)))
constexpr int GT_STAGE = 32768;
template <class Epi>
__device__ __forceinline__ void gemm_tile(const bf16_t* __restrict__ A, int lda, int M, const bf16_t* __restrict__ Bt, int ldb, int N, int K,
                                          int row0, int col0, Epi epi, unsigned char* lds_generic) {
    LAS unsigned char* lds = (LAS unsigned char*)lds_generic;
    const int tid = tid_(), lane = tid & 63, wave = __builtin_amdgcn_readfirstlane(tid >> 6);
    const int wm = wave >> 2, wn = wave & 3, r = lane & 31, h = lane >> 5;
    const bf16_t* ga[2]; const bf16_t* gb[2];
#pragma unroll
    for (int i = 0; i < 2; ++i) {
        const int trow = 8 * (wave + 8 * i) + (lane >> 3), kp = (lane & 7) ^ ((trow >> 1) & 7);
        int ra = row0 + trow, rb = col0 + trow; ra = ra < M ? ra : M - 1; rb = rb < N ? rb : N - 1;
        ga[i] = A + (size_t)ra * lda + kp * 8; gb[i] = Bt + (size_t)rb * ldb + kp * 8;
    }
    f32x16 acc0, acc1;
#pragma unroll
    for (int i = 0; i < 16; ++i) { acc0[i] = 0.f; acc1[i] = 0.f; }
    const int nk = K >> 6;
#define GT_ISSUE(kt_) do { const int st_ = ((kt_) & 3) * GT_STAGE; _Pragma("unroll") for (int i_ = 0; i_ < 2; ++i_) { \
        __builtin_amdgcn_global_load_lds((const unsigned*)(ga[i_] + (kt_) * 64), (LAS unsigned*)(lds + st_ + (wave + 8 * i_) * 1024), 16, 0, 0); \
        __builtin_amdgcn_global_load_lds((const unsigned*)(gb[i_] + (kt_) * 64), (LAS unsigned*)(lds + st_ + 16384 + (wave + 8 * i_) * 1024), 16, 0, 0); } } while (0)
    __syncthreads();
    GT_ISSUE(0);
    if (nk > 1) GT_ISSUE(1);
    if (nk > 2) GT_ISSUE(2);
    const int xs = (r >> 1) & 7;
    const int aoff = (wm * 64 + r) * 128, boff = 16384 + (wn * 32 + r) * 128;
#pragma unroll 1
    for (int kt = 0; kt < nk; ++kt) {
        const int ahead = nk - 1 - kt;
        if (ahead >= 2) asm volatile("s_waitcnt vmcnt(8)" ::: "memory");
        else if (ahead == 1) asm volatile("s_waitcnt vmcnt(4)" ::: "memory");
        else asm volatile("s_waitcnt vmcnt(0)" ::: "memory");
        __builtin_amdgcn_s_barrier();
        asm volatile("" ::: "memory");
        if (kt + 3 < nk) GT_ISSUE(kt + 3);
        const LAS unsigned char* sb = lds + (kt & 3) * GT_STAGE;
#pragma unroll
        for (int s = 0; s < 4; ++s) {
            const int ko = ((2 * s + h) ^ xs) * 16;
            const bf16x8 a0 = *(const LAS bf16x8*)(sb + aoff + ko);
            const bf16x8 a1 = *(const LAS bf16x8*)(sb + aoff + 32 * 128 + ko);
            const bf16x8 b  = *(const LAS bf16x8*)(sb + boff + ko);
            acc0 = __builtin_amdgcn_mfma_f32_32x32x16_bf16(a0, b, acc0, 0, 0, 0);
            acc1 = __builtin_amdgcn_mfma_f32_32x32x16_bf16(a1, b, acc1, 0, 0, 0);
        }
    }
#undef GT_ISSUE
    __builtin_amdgcn_s_barrier();
    asm volatile("" ::: "memory");
    {
        LAS float* sc = (LAS float*)lds;
#pragma unroll
        for (int i = 0; i < 16; ++i) {
            const int rr = wm * 64 + (i & 3) + 8 * (i >> 2) + 4 * h;
            sc[rr * 132 + wn * 32 + r] = acc0[i];
            sc[(rr + 32) * 132 + wn * 32 + r] = acc1[i];
        }
    }
    __syncthreads();
    {
        const LAS float* sc = (const LAS float*)lds;
        const int c8 = (tid & 15) * 8, col = col0 + c8;
#pragma unroll
        for (int ps = 0; ps < 4; ++ps) {
            const int rl = (tid >> 4) + 32 * ps, row = row0 + rl;
            const f32x4 v0 = *(const LAS f32x4*)(sc + rl * 132 + c8), v1 = *(const LAS f32x4*)(sc + rl * 132 + c8 + 4);
            if (row < M && col < N) { const float v[8] = {v0[0], v0[1], v0[2], v0[3], v1[0], v1[1], v1[2], v1[3]}; epi(row, col, v); }
        }
    }
}

namespace pg8 {
#define PG8_LAS __attribute__((address_space(3)))
typedef unsigned short bf16_t;
typedef short bf16x8 __attribute__((ext_vector_type(8)));
typedef float f32x4 __attribute__((ext_vector_type(4)));
typedef unsigned u32x4 __attribute__((ext_vector_type(4)));
constexpr int BM = 256, BK = 64, HALF = 128, HTB = HALF * BK * 2  , STAGE_BYTES = 8 * HTB, NXCD = 8, WGM = 8;

__host__ __device__ __forceinline__ int lds_byte(int r, int c) { const int st = (r >> 4) * 2 + (c >> 5), rr = r & 15, cc = c & 31, ob = rr * 64 + cc * 2; return st * 1024 + (ob ^ (((ob >> 9) & 1) << 5)); }
__host__ __device__ __forceinline__ void stage_rc(int b, int& R, int& C) { const int st = b / 1024, sb = b % 1024, swz = sb ^ (((sb >> 9) & 1) << 5); R = (st >> 1) * 16 + swz / 64; C = (st & 1) * 32 + (swz % 64) / 2; }
__host__ __device__ __forceinline__ int perm32(int rho) { const int n = rho >> 4, i = rho & 15; return 8 * (i >> 2) + 4 * n + (i & 3); }

struct Unit { int pm, pn; };
struct Gemm { const bf16_t* A; const bf16_t* Bt; int M, N, K; };

struct StaticOrder {
    int nM, nN, nwg, G, c;
    __host__ __device__ void init(int M, int N, int G_, int c_) { nM = M / BM; nN = N / BM; nwg = nM * nN; G = G_; c = c_; }
    __host__ __device__ bool next(int i, Unit& u) const {
        const long L = (long)i * G + c; if (L >= nwg) return false;
        int wgid = (int)L; { const int q = nwg / NXCD, r = nwg % NXCD, xcd = wgid % NXCD, off = wgid / NXCD; wgid = (xcd < r ? xcd * (q + 1) : r * (q + 1) + (xcd - r) * q) + off; }
        const int nig = WGM * nN, gid = wgid / nig, fm = gid * WGM, gsz = (nM - fm) < WGM ? (nM - fm) : WGM;
        u.pm = fm + ((wgid % nig) % gsz); u.pn = (wgid % nig) / gsz; return true;
    }
    __device__ __forceinline__ void a_ready(const Unit&) const {}
    __device__ __forceinline__ void done(const Unit&) const {}
};
template <class Epi, class Sched, bool STAMP = false>
__device__ __forceinline__ void gemm_phase(PG8_LAS unsigned char* lds, const Gemm g, const Sched& S, const Epi& E, unsigned long long* stamps) {
    const int tid = tid_(), wid = __builtin_amdgcn_readfirstlane(tid >> 6), lane = tid & 63, wr = wid >> 2, wc = wid & 3, fr = lane & 15, fq = lane >> 4;
    const int K = g.K, nt = K / BK;
    int ts_lo = 0, ts_hi = 0, nts = 0; const unsigned long long rt_entry = STAMP ? (unsigned long long)0ull : 0ull;
#define PG8_STAMP() do { if (STAMP && wid == 0 && nts < 64) { const unsigned long long _c = (unsigned long long)0ull; \
        ts_lo = (lane == nts) ? (int)(unsigned)_c : ts_lo; ts_hi = (lane == nts) ? (int)(unsigned)(_c >> 32) : ts_hi; ++nts; } } while (0)
    PG8_STAMP();
    unsigned voffA[2], voffB[2];
#pragma unroll
    for (int i = 0; i < 2; ++i) { int R, C; stage_rc(tid * 16 + i * 8192, R, C); const int Rb = Epi::PERM ? ((R & ~31) + perm32(R & 31)) : R;
        voffA[i] = (unsigned)(R * K + C) * 2u; voffB[i] = (unsigned)(Rb * K + C) * 2u; }
    const size_t kstep = (size_t)(BK * 2);
    const size_t hstep = (size_t)HALF * K * 2;
    const size_t tstep = 2 * hstep;
    const unsigned ldsw = (unsigned)wid * 1024u;
    const int aoff = lds_byte(wr * 64 + fr, fq * 8), boff = lds_byte(wc * 32 + fr, fq * 8);
#define PG8_SA(b, h) (((b) * 2 + (h)) * HTB)
#define PG8_SB(b, h) ((4 + (b) * 2 + (h)) * HTB)
#define PG8_STAGE(bufoff, gbase, voff) do { _Pragma("unroll") for (int _i = 0; _i < 2; ++_i) { unsigned vo_ = (voff)[_i]; asm volatile("" : "+v"(vo_));   \
        __builtin_amdgcn_global_load_lds((const unsigned*)((const char*)(gbase) + vo_), (PG8_LAS unsigned*)(lds + (bufoff) + ldsw + _i * 8192), 16, 0, 0); } } while (0)
#define PG8_LDA(dst, b, h) do { _Pragma("unroll") for (int m = 0; m < 4; ++m) _Pragma("unroll") for (int k = 0; k < 2; ++k) dst[m][k] = *(const PG8_LAS bf16x8*)(lds + PG8_SA(b, h) + aoff + m * 2048 + k * 1024); } while (0)
#define PG8_LDB(dst, b, h) do { _Pragma("unroll") for (int n = 0; n < 2; ++n) _Pragma("unroll") for (int k = 0; k < 2; ++k) dst[n][k] = *(const PG8_LAS bf16x8*)(lds + PG8_SB(b, h) + boff + n * 2048 + k * 1024); } while (0)
#define PG8_MMA(ai, bj, At, Bt) do { __builtin_amdgcn_s_setprio(1); _Pragma("unroll") for (int m = 0; m < 4; ++m) _Pragma("unroll") for (int n = 0; n < 2; ++n) _Pragma("unroll") for (int k = 0; k < 2; ++k) \
        acc[ai][bj][m][n] = __builtin_amdgcn_mfma_f32_16x16x32_bf16(Bt[n][k], At[m][k], acc[ai][bj][m][n], 0, 0, 0); __builtin_amdgcn_s_setprio(0); } while (0)
#define PG8_WAIT_V(n) asm volatile("s_waitcnt vmcnt(" #n ")" ::: "memory")
#define PG8_WAIT_L(n) asm volatile("s_waitcnt lgkmcnt(" #n ")" ::: "memory")
#define PG8_BAR __builtin_amdgcn_s_barrier()
#define PG8_SCHED __builtin_amdgcn_sched_barrier(0)
    Unit cur, nxt; int ui = 0;
    if (!S.next(0, cur)) return;
    f32x4 acc[2][2][4][2];
#pragma unroll
    for (int a = 0; a < 2; ++a)
#pragma unroll
        for (int b = 0; b < 2; ++b)
#pragma unroll
            for (int m = 0; m < 4; ++m)
#pragma unroll
                for (int n = 0; n < 2; ++n) acc[a][b][m][n] = (f32x4){0.f, 0.f, 0.f, 0.f};
    bf16x8 At[4][2], B0[2][2], B1[2][2];
    const char* cA = (const char*)g.A + (size_t)cur.pm * tstep; const char* cB = (const char*)g.Bt + (size_t)cur.pn * tstep;
    S.a_ready(cur);
    PG8_STAGE(PG8_SB(0, 0), cB, voffB); PG8_STAGE(PG8_SA(0, 0), cA, voffA); PG8_STAGE(PG8_SB(0, 1), cB + hstep, voffB); PG8_STAGE(PG8_SA(0, 1), cA + hstep, voffA);
    if (wr == 1) PG8_BAR;
    PG8_WAIT_V(4); PG8_BAR;
    PG8_STAGE(PG8_SB(1, 0), cB + kstep, voffB); PG8_STAGE(PG8_SA(1, 0), cA + kstep, voffA); PG8_STAGE(PG8_SB(1, 1), cB + hstep + kstep, voffB);
    PG8_WAIT_V(6); PG8_BAR;
    PG8_STAMP();
    for (;;) {
        const bool has_next = S.next(ui + 1, nxt);
        const char* nA = has_next ? (const char*)g.A + (size_t)nxt.pm * tstep : cA; const char* nB = has_next ? (const char*)g.Bt + (size_t)nxt.pn * tstep : cB;
        for (int t = 0; t < nt; t += 2) {
            const bool last = (t == nt - 2);
            const char* a1 = cA + (size_t)(t + 1) * kstep;
            const char* a2 = last ? nA : cA + (size_t)(t + 2) * kstep; const char* b2 = last ? nB : cB + (size_t)(t + 2) * kstep;
            const char* a3 = a2 + kstep; const char* b3 = b2 + kstep;
            if (last && has_next) S.a_ready(nxt);
            PG8_LDB(B0, 0, 0); PG8_SCHED; PG8_LDA(At, 0, 0); PG8_STAGE(PG8_SA(1, 1), a1 + hstep, voffA);
            PG8_WAIT_L(8); PG8_BAR; PG8_WAIT_L(0); PG8_MMA(0, 0, At, B0); PG8_BAR; PG8_SCHED;
            PG8_LDB(B1, 0, 1); PG8_STAGE(PG8_SB(0, 0), b2, voffB);
            PG8_BAR; PG8_WAIT_L(0); PG8_MMA(0, 1, At, B1); PG8_BAR;
            PG8_LDA(At, 0, 1); PG8_STAGE(PG8_SA(0, 0), a2, voffA);
            PG8_BAR; PG8_WAIT_L(0); PG8_MMA(1, 0, At, B0); PG8_BAR; PG8_SCHED;
            PG8_STAGE(PG8_SB(0, 1), b2 + hstep, voffB);
            PG8_WAIT_V(6); PG8_BAR; PG8_MMA(1, 1, At, B1); PG8_BAR;
            PG8_LDB(B0, 1, 0); PG8_SCHED; PG8_LDA(At, 1, 0); PG8_STAGE(PG8_SA(0, 1), a2 + hstep, voffA);
            PG8_WAIT_L(8); PG8_BAR; PG8_WAIT_L(0); PG8_MMA(0, 0, At, B0); PG8_BAR; PG8_SCHED;
            PG8_LDB(B1, 1, 1); PG8_STAGE(PG8_SB(1, 0), b3, voffB);
            PG8_BAR; PG8_WAIT_L(0); PG8_MMA(0, 1, At, B1); PG8_BAR;
            PG8_LDA(At, 1, 1); PG8_STAGE(PG8_SA(1, 0), a3, voffA);
            PG8_BAR; PG8_WAIT_L(0); PG8_MMA(1, 0, At, B0); PG8_BAR; PG8_SCHED;
            PG8_STAGE(PG8_SB(1, 1), b3 + hstep, voffB);
            PG8_WAIT_V(6); PG8_BAR; PG8_MMA(1, 1, At, B1); PG8_BAR;
        }
        PG8_STAMP();
        if constexpr (!Epi::AFTER_DRAIN) { E(acc, cur, wr, wc, fr, fq); S.done(cur); }
        PG8_STAMP();
        if (!has_next) break;
#pragma unroll
        for (int a = 0; a < 2; ++a)
#pragma unroll
            for (int b = 0; b < 2; ++b)
#pragma unroll
                for (int m = 0; m < 4; ++m)
#pragma unroll
                    for (int n = 0; n < 2; ++n) acc[a][b][m][n] = (f32x4){0.f, 0.f, 0.f, 0.f};
        cur = nxt; cA = nA; cB = nB; ++ui;
    }
    PG8_WAIT_V(0);
    if (wr == 0) PG8_BAR;
    PG8_BAR;
    if constexpr (Epi::AFTER_DRAIN) { E.fused(acc, cur, wr, wc, fr, fq, lds, wid, lane); S.done(cur); }
    PG8_STAMP();
    if (STAMP && wid == 0) { stamps[lane] = lane < nts ? (((unsigned long long)(unsigned)ts_hi << 32) | (unsigned)ts_lo) : 0ull;
        if (lane == 62) stamps[62] = rt_entry; if (lane == 63) stamps[63] = (unsigned long long)0ull; }
#undef PG8_STAMP
#undef PG8_SA
#undef PG8_SB
#undef PG8_STAGE
#undef PG8_LDA
#undef PG8_LDB
#undef PG8_MMA
#undef PG8_WAIT_V
#undef PG8_WAIT_L
#undef PG8_BAR
#undef PG8_SCHED
}
}

template <class F> struct EpiAdapt {
    static constexpr bool PERM = true, AFTER_DRAIN = false;
    F f;
    __device__ __forceinline__ void operator()(const pg8::f32x4 (&acc)[2][2][4][2], const pg8::Unit& u, int wr, int wc, int fr, int fq) const {
#pragma unroll
        for (int ai = 0; ai < 2; ++ai)
#pragma unroll
            for (int m = 0; m < 4; ++m) {
                const int row = u.pm * 256 + ai * 128 + wr * 64 + m * 16 + fr;
#pragma unroll
                for (int bj = 0; bj < 2; ++bj) {
                    const int col = u.pn * 256 + bj * 128 + wc * 32 + 8 * fq;
                    const float v[8] = {acc[ai][bj][m][0][0], acc[ai][bj][m][0][1], acc[ai][bj][m][0][2], acc[ai][bj][m][0][3],
                                        acc[ai][bj][m][1][0], acc[ai][bj][m][1][1], acc[ai][bj][m][1][2], acc[ai][bj][m][1][3]};
                    f(row, col, v);
                    asm volatile("" ::: "memory");
                }
            }
    }
};
template <class F>
__device__ __forceinline__ void gemm_big(const bf16_t* A, const bf16_t* Bt, int M, int N, int K, F f, unsigned char* lds_generic) {
    __syncthreads();
    pg8::Gemm g{A, Bt, M, N, K};
    pg8::StaticOrder S; S.init(M, N, (int)gridDim.x, (int)blockIdx.x);
    EpiAdapt<F> E{f};
    pg8::gemm_phase<EpiAdapt<F>, pg8::StaticOrder, false>((LAS unsigned char*)lds_generic, g, S, E, nullptr);
    __syncthreads();
}

__device__ __forceinline__ void p0_adaln(const Params& p, int item, unsigned char* lds) {
    const int l = item / 96, cb = item % 96, tid = tid_();
    const int kq = tid >> 4, c4 = tid & 15;
    const float* W = p.in[4] + (size_t)l * 1024 * 6144 + cb * 64 + c4 * 4;
    const float* c = p.in[1]; const float* cc = p.in[3];
    float al[4] = {0, 0, 0, 0}, ac[4] = {0, 0, 0, 0};
#pragma unroll 8
    for (int k = kq; k < 1024; k += 32) {
        const float4 w = *(const float4*)(W + (size_t)k * 6144);
        const float sl = siluf_(c[k]), sc = siluf_(cc[k]);
        al[0] += sl * w.x; al[1] += sl * w.y; al[2] += sl * w.z; al[3] += sl * w.w;
        ac[0] += sc * w.x; ac[1] += sc * w.y; ac[2] += sc * w.z; ac[3] += sc * w.w;
    }
    float* red = (float*)lds;
    __syncthreads();
#pragma unroll
    for (int e = 0; e < 4; ++e) { red[(kq * 2 + 0) * 64 + c4 * 4 + e] = al[e]; red[(kq * 2 + 1) * 64 + c4 * 4 + e] = ac[e]; }
    __syncthreads();
    if (tid < 128) {
        const int s = tid >> 6, cidx = tid & 63;
        float sum = 0.f;
        for (int q = 0; q < 32; ++q) sum += red[(q * 2 + s) * 64 + cidx];
        const int col = cb * 64 + cidx;
        sum += p.in[5][l * 6144 + col];
        ((float*)(p.ws + WS_MOD))[(l * 2 + s) * 6144 + col] = sum;
    }
}
__device__ __forceinline__ void p0_transpose(const float* __restrict__ src, int K, int N, bf16_t* __restrict__ dst, int tile, unsigned char* lds) {
    const int ntn = (N + 63) / 64, tk = tile / ntn, tn = tile % ntn, tid = tid_();
    float* s = (float*)lds;
    __syncthreads();
    for (int e = tid; e < 64 * 64; e += NTHREADS) {
        const int kk = e >> 6, nn = e & 63; const int n = tn * 64 + nn;
        s[kk * 65 + nn] = n < N ? src[(size_t)(tk * 64 + kk) * N + n] : 0.f;
    }
    __syncthreads();
    {
        const int nn = tid >> 3, kg = (tid & 7) * 8; const int n = tn * 64 + nn;
        if (n < N) {
            float f[8];
#pragma unroll
            for (int e = 0; e < 8; ++e) f[e] = s[(kg + e) * 65 + nn];
            *(uint4*)(dst + (size_t)n * K + tk * 64 + kg) = pack8(f);
        }
    }
}
__device__ __forceinline__ void cvt_chunk(const float* __restrict__ src, bf16_t* __restrict__ dst, size_t item) {
    const size_t o = item * 4096 + (size_t)tid_() * 8;
    const float4 a = *(const float4*)(src + o), b = *(const float4*)(src + o + 4);
    uint4 q; q.x = pack2(a.x, a.y); q.y = pack2(a.z, a.w); q.z = pack2(b.x, b.y); q.w = pack2(b.z, b.w);
    *(uint4*)(dst + o) = q;
}
typedef float v32f_t __attribute__((ext_vector_type(32)));
typedef _Float16 v32h_t __attribute__((ext_vector_type(32)));
typedef unsigned v6u_t __attribute__((ext_vector_type(6)));
struct __attribute__((packed, aligned(8))) U6 { unsigned a, b, c, d, e, f; };
constexpr int PREC = 1536;
__device__ __forceinline__ void peer_tables_item(const Params& p, int item, int l) {
    const int lane = tid_() & 63, ex = item * 8 + (tid_() >> 6);
    const float* su = p.in[29] + ((size_t)l * 16384 + ex) * 1024 + lane * 16;
    const float* sv = p.in[30] + ((size_t)l * 16384 + ex) * 1024 + lane * 16;
    float4 u[4], v[4]; float amu = 0.f, amv = 0.f;
#pragma unroll
    for (int q = 0; q < 4; ++q) { u[q] = *(const float4*)(su + q * 4); v[q] = *(const float4*)(sv + q * 4); }
#pragma unroll
    for (int q = 0; q < 4; ++q) {
        amu = fmaxf(amu, fmaxf(fmaxf(fabsf(u[q].x), fabsf(u[q].y)), fmaxf(fabsf(u[q].z), fabsf(u[q].w))));
        amv = fmaxf(amv, fmaxf(fmaxf(fabsf(v[q].x), fabsf(v[q].y)), fmaxf(fabsf(v[q].z), fabsf(v[q].w))));
    }
#pragma unroll
    for (int o = 32; o > 0; o >>= 1) { amu = fmaxf(amu, __shfl_xor(amu, o, 64)); amv = fmaxf(amv, __shfl_xor(amv, o, 64)); }
    const float scu = amu > 0.f ? 7.0f / amu : 1.f, scv = amv > 0.f ? 7.0f / amv : 1.f;
    v32h_t x;
#pragma unroll
    for (int q = 0; q < 4; ++q) {
        x[4 * q + 0] = (_Float16)(u[q].x * scu); x[4 * q + 1] = (_Float16)(u[q].y * scu); x[4 * q + 2] = (_Float16)(u[q].z * scu); x[4 * q + 3] = (_Float16)(u[q].w * scu);
        x[16 + 4 * q + 0] = (_Float16)(v[q].x * scv); x[16 + 4 * q + 1] = (_Float16)(v[q].y * scv); x[16 + 4 * q + 2] = (_Float16)(v[q].z * scv); x[16 + 4 * q + 3] = (_Float16)(v[q].w * scv);
    }
    const v6u_t pk = __builtin_amdgcn_cvt_scalef32_pk32_fp6_f16(x, 1.0f);
    U6 o; o.a = pk[0]; o.b = pk[1]; o.c = pk[2]; o.d = pk[3]; o.e = pk[4]; o.f = pk[5];
    *(U6*)(p.ws + WS_PUV + (size_t)ex * PREC + lane * 24) = o;
    if (lane == 0) { float* psc = (float*)(p.ws + WS_PSC); psc[ex] = amu > 0.f ? amu / 7.0f : 1.f; psc[16384 + ex] = amv > 0.f ? amv / 7.0f : 1.f; }
}

__device__ __forceinline__ void sincos_d(double x, double& s, double& c) {
    const double TWO_OVER_PI = 0.63661977236758134308, PIO2_HI = 1.57079632679489655800e+00, PIO2_LO = 6.12323399573676603587e-17;
    const double kf = rint(x * TWO_OVER_PI);
    const double y = (x - kf * PIO2_HI) - kf * PIO2_LO;
    const double y2 = y * y;
    double sp = -1.0 / 1307674368000.0;
    sp = sp * y2 + 1.0 / 6227020800.0; sp = sp * y2 - 1.0 / 39916800.0; sp = sp * y2 + 1.0 / 362880.0; sp = sp * y2 - 1.0 / 5040.0;
    sp = sp * y2 + 1.0 / 120.0; sp = sp * y2 - 1.0 / 6.0; sp = sp * y2 + 1.0; sp *= y;
    double cp = 1.0 / 20922789888000.0;
    cp = cp * y2 - 1.0 / 87178291200.0; cp = cp * y2 + 1.0 / 479001600.0; cp = cp * y2 - 1.0 / 3628800.0; cp = cp * y2 + 1.0 / 40320.0;
    cp = cp * y2 - 1.0 / 720.0; cp = cp * y2 + 1.0 / 24.0; cp = cp * y2 - 0.5; cp = cp * y2 + 1.0;
    const int q = ((int)kf) & 3;
    s = (q == 0) ? sp : (q == 1) ? cp : (q == 2) ? -sp : -cp;
    c = (q == 0) ? cp : (q == 1) ? -sp : (q == 2) ? -cp : sp;
}
__device__ __forceinline__ void p0_s5_tables(const Params& p, int item4, unsigned char* lds) {
    const int item = item4 >> 2, qt = item4 & 3;
    const int di = item >> 5, g = item & 31, tid = tid_();
    float2* apw = (float2*)lds;
    float2* Bb = apw + 64 * 65;
    float2* Cc = Bb + 64 * 16;
    __syncthreads();
    if (tid < 64) {
        const int pidx = (di * 32 + g) * 64 + tid;
        float lr = p.in[10][pidx]; lr = lr < -1e-4f ? lr : -1e-4f;
        const float li = p.in[11][pidx];
        const float dt = expf(p.in[12][di * 32 + g]);
        const double mag = (double)expf(lr * dt);
        double sn, cs; sincos_d((double)li * (double)dt, sn, cs);
        const double are = mag * cs, aim = mag * sn;
        double pr = 1.0, pi_ = 0.0;
        for (int t = 0; t <= 64; ++t) {
            apw[tid * 65 + t] = make_float2((float)pr, (float)pi_);
            const double nr = pr * are - pi_ * aim, ni = pr * aim + pi_ * are; pr = nr; pi_ = ni;
        }
        if (qt == 0) ((float2*)(p.ws + WS_A64))[(di * 32 + g) * 64 + tid] = apw[tid * 65 + 64];
        const double den = (double)lr * lr + (double)li * li;
        const double fre = ((are - 1.0) * lr + aim * li) / den, fim = (aim * lr - (are - 1.0) * li) / den;
        for (int hh = 0; hh < 16; ++hh) {
            const double br = p.in[13][(size_t)pidx * 16 + hh], bi = p.in[14][(size_t)pidx * 16 + hh];
            Bb[tid * 16 + hh] = make_float2((float)(fre * br - fim * bi), (float)(fre * bi + fim * br));
        }
    }
    for (int e = tid; e < 1024; e += NTHREADS) {
        const size_t gi = ((size_t)(di * 32 + g) * 16) * 64 + e;
        Cc[e] = make_float2(p.in[15][gi], p.in[16][gi]);
    }
    __syncthreads();
    float* ktab = (float*)(p.ws + WS_KTAB) + (size_t)(di * 32 + g) * 64 * 256;
    for (int o = qt * 4096 + tid; o < (qt + 1) * 4096; o += NTHREADS) {
        const int tau = o >> 8, hh = (o >> 4) & 15, h2 = o & 15;
        float acc = 0.f;
        for (int pp = 0; pp < 64; ++pp) {
            const float2 a = apw[pp * 65 + tau], c = Cc[hh * 64 + pp], b = Bb[pp * 16 + h2];
            const float cr = c.x * a.x - c.y * a.y, ci = c.x * a.y + c.y * a.x;
            acc += cr * b.x - ci * b.y;
        }
        ktab[o] = acc;
    }
    bf16_t* ms5 = (bf16_t*)(p.ws + WS_MS5) + (size_t)g * 1280 * 1024;
    for (int t = qt * 4096 + tid; t < (qt + 1) * 4096; t += NTHREADS) {
        const int row = t >> 7, k8 = t & 127; const int ri = row >> 6, pp = row & 63, j = k8 >> 1, h0 = (k8 & 1) * 8;
        const float2 a = apw[pp * 65 + (di == 0 ? 63 - j : j)];
        float f[8];
#pragma unroll
        for (int e = 0; e < 8; ++e) { const float2 b = Bb[pp * 16 + h0 + e]; f[e] = ri == 0 ? (a.x * b.x - a.y * b.y) : (a.x * b.y + a.y * b.x); }
        *(uint4*)(ms5 + (size_t)(1024 + di * 128 + row) * 1024 + k8 * 8) = pack8(f);
    }
    bf16_t* o5 = (bf16_t*)(p.ws + WS_O5) + (size_t)g * 1024 * 256;
    for (int t = qt * 4096 + tid; t < (qt + 1) * 4096; t += NTHREADS) {
        const int n = t >> 4, q = t & 15; const int ri = q >> 3, p0 = (q & 7) * 8, i = n >> 4, hh = n & 15;
        float f[8];
#pragma unroll
        for (int e = 0; e < 8; ++e) {
            const float2 a = apw[(p0 + e) * 65 + (di == 0 ? i + 1 : 64 - i)], c = Cc[hh * 64 + p0 + e];
            f[e] = ri == 0 ? (c.x * a.x - c.y * a.y) : -(c.x * a.y + c.y * a.x);
        }
        *(uint4*)(o5 + (size_t)n * 256 + di * 128 + ri * 64 + p0) = pack8(f);
    }
}

template <bool SRC_BF16>
__device__ __forceinline__ void norm_mod_row(const void* __restrict__ srcv, const float* __restrict__ g, const float* __restrict__ shift,
                                             const float* __restrict__ scale, bf16_t* __restrict__ dst, int lane) {
    float4 v[4]; float ss = 0.f;
#pragma unroll
    for (int k = 0; k < 4; ++k) {
        if (SRC_BF16) { const uint2 q = *(const uint2*)((const bf16_t*)srcv + k * 256 + lane * 4); v[k] = make_float4(lo2f(q.x), hi2f(q.x), lo2f(q.y), hi2f(q.y)); }
        else v[k] = *(const float4*)((const float*)srcv + k * 256 + lane * 4);
        ss += v[k].x * v[k].x + v[k].y * v[k].y + v[k].z * v[k].z + v[k].w * v[k].w;
    }
    ss = wave_sum(ss);
    const float rs = rsqrtf(ss * (1.f / 1024.f) + 1e-6f);
#pragma unroll
    for (int k = 0; k < 4; ++k) {
        const int c = k * 256 + lane * 4;
        const float4 gg = *(const float4*)(g + c), sh = *(const float4*)(shift + c), sc = *(const float4*)(scale + c);
        uint2 o;
        o.x = pack2(v[k].x * rs * gg.x * (1.f + sc.x) + sh.x, v[k].y * rs * gg.y * (1.f + sc.y) + sh.y);
        o.y = pack2(v[k].z * rs * gg.z * (1.f + sc.z) + sh.z, v[k].w * rs * gg.w * (1.f + sc.w) + sh.w);
        *(uint2*)(dst + c) = o;
    }
}
__device__ __forceinline__ void norm_rows_item(const Params& p, int item, int l, const float* g, int js, bool from_inputs) {
    const int row = item * 8 + (tid_() >> 6), lane = tid_() & 63;
    bf16_t* dst = (bf16_t*)(p.ws + WS_ACT) + (size_t)row * 1024;
    if (from_inputs) norm_mod_row<false>(row < SEQ ? p.in[0] + (size_t)row * 1024 : p.in[2] + (size_t)(row - SEQ) * 1024, g, modp(p, l, row, js), modp(p, l, row, js + 1), dst, lane);
    else norm_mod_row<true>((const bf16_t*)(p.ws + WS_H) + (size_t)row * 1024, g, modp(p, l, row, js), modp(p, l, row, js + 1), dst, lane);
}
__device__ __forceinline__ void s5_mintra_item(const Params& p, int item) {
    const int g = item >> 6, i = item & 63;
    const float* kt0 = (const float*)(p.ws + WS_KTAB) + (size_t)(0 * 32 + g) * 64 * 256;
    const float* kt1 = (const float*)(p.ws + WS_KTAB) + (size_t)(1 * 32 + g) * 64 * 256;
    const float* dsk = p.in[17] + g * 16;
    bf16_t* ms5 = (bf16_t*)(p.ws + WS_MS5) + (size_t)g * 1280 * 1024;
    for (int t = tid_(); t < 16 * 128; t += NTHREADS) {
        const int hh = t >> 7, k8 = t & 127, j = k8 >> 1, h0 = (k8 & 1) * 8;
        float f[8];
        if (j < i) { const float* s = kt0 + ((i - j) * 16 + hh) * 16 + h0;
#pragma unroll
            for (int e = 0; e < 8; ++e) f[e] = s[e]; }
        else if (j > i) { const float* s = kt1 + ((j - i) * 16 + hh) * 16 + h0;
#pragma unroll
            for (int e = 0; e < 8; ++e) f[e] = s[e]; }
        else { const float* s0 = kt0 + hh * 16 + h0; const float* s1 = kt1 + hh * 16 + h0;
#pragma unroll
            for (int e = 0; e < 8; ++e) f[e] = s0[e] + s1[e] + ((h0 + e) == hh ? dsk[hh] : 0.f); }
        *(uint4*)(ms5 + (size_t)(i * 16 + hh) * 1024 + k8 * 8) = pack8(f);
    }
}

struct EpiEvenIn {
    bf16_t* pa; bf16_t* ug;
    __device__ __forceinline__ void operator()(int row, int col, const float* v) const {
        if (col < 1536) *(uint4*)(pa + (size_t)row * 1536 + col) = pack8(v);
        else { const int c2 = col - 1536; *(uint4*)(ug + ((size_t)(c2 >> 4) * NCH + (row >> 6)) * 1024 + (row & 63) * 16 + (c2 & 15)) = pack8(v); }
    }
};
struct EpiS5Local {
    bf16_t* yl; float* lst; int g;
    __device__ __forceinline__ void operator()(int row, int col, const float* v) const {
        if (col < 1024) *(uint4*)(yl + (size_t)(row * 64 + (col >> 4)) * 512 + g * 16 + (col & 15)) = pack8(v);
        else { float* d = lst + ((size_t)g * NCH + row) * 256 + (col - 1024);
               *(float4*)d = make_float4(v[0], v[1], v[2], v[3]); *(float4*)(d + 4) = make_float4(v[4], v[5], v[6], v[7]); }
    }
};
struct EpiS5Out {
    const bf16_t* yl; bf16_t* gs; int g;
    __device__ __forceinline__ void operator()(int row, int col, const float* v) const {
        const size_t o = (size_t)(row * 64 + (col >> 4)) * 512 + g * 16 + (col & 15);
        float y[8]; unpack8(*(const uint4*)(yl + o), y);
        float f[8];
#pragma unroll
        for (int e = 0; e < 8; ++e) f[e] = gelu_tanh(v[e] + y[e]);
        *(uint4*)(gs + o) = pack8(f);
    }
};
struct EpiGlu {
    const bf16_t* gs; const float* b; bf16_t* cb;
    __device__ __forceinline__ void operator()(int row, int col, const float* v) const {
        float g[8], f[8]; unpack8(*(const uint4*)(gs + (size_t)row * 512 + col), g);
#pragma unroll
        for (int e = 0; e < 8; ++e) f[e] = g[e] * sigmoidf_(v[e] + b[col + e]);
        *(uint4*)(cb + (size_t)row * 1024 + 512 + col) = pack8(f);
    }
};
struct EpiResid {
    const float* x; const float* ctx; bf16_t* hbuf; const float* mod; int l; bool from_inputs;
    __device__ __forceinline__ void operator()(int row, int col, const float* v) const {
        bf16_t* h = hbuf + (size_t)row * 1024 + col;
        float b[8];
        if (from_inputs) {
            const float* bp = row < SEQ ? x + (size_t)row * 1024 + col : ctx + (size_t)(row - SEQ) * 1024 + col;
            const float4 b0 = *(const float4*)bp, b1 = *(const float4*)(bp + 4);
            b[0] = b0.x; b[1] = b0.y; b[2] = b0.z; b[3] = b0.w; b[4] = b1.x; b[5] = b1.y; b[6] = b1.z; b[7] = b1.w;
        } else unpack8(*(const uint4*)h, b);
        const float* mp = mod + ((l * 2 + (row >= SEQ ? 1 : 0)) * 6 + 2) * 1024 + col;
        const float4 m0 = *(const float4*)mp, m1 = *(const float4*)(mp + 4);
        const float o[8] = {b[0] + m0.x * v[0], b[1] + m0.y * v[1], b[2] + m0.z * v[2], b[3] + m0.w * v[3], b[4] + m1.x * v[4], b[5] + m1.y * v[5], b[6] + m1.z * v[6], b[7] + m1.w * v[7]};
        *(uint4*)h = pack8(o);
    }
};
struct EpiBf16 {
    bf16_t* dst; int ld;
    __device__ __forceinline__ void operator()(int row, int col, const float* v) const { *(uint4*)(dst + (size_t)row * ld + col) = pack8(v); }
};
struct EpiScore {
    unsigned short* dst; int coff;
    __device__ __forceinline__ void operator()(int row, int col, const float* v) const {
        typedef _Float16 h2 __attribute__((ext_vector_type(2)));
        u32x4 o;
#pragma unroll
        for (int e = 0; e < 4; ++e) { const h2 hv = {(_Float16)v[2 * e], (_Float16)v[2 * e + 1]}; o[e] = __builtin_bit_cast(unsigned, hv); }
        *(u32x4*)(dst + (size_t)row * 2048 + coff + col) = o;
    }
};
struct EpiOddIn {
    bf16_t* qkvr; bf16_t* z; float* ab;
    __device__ __forceinline__ void operator()(int row, int col, const float* v) const {
        if (col < 3072) *(uint4*)(qkvr + (size_t)row * 3072 + col) = pack8(v);
        else if (col < 4096) *(uint4*)(z + (size_t)row * 1024 + (col - 3072)) = pack8(v);
        else { float* d = ab + (size_t)row * 32 + (col - 4096); *(float4*)d = make_float4(v[0], v[1], v[2], v[3]); *(float4*)(d + 4) = make_float4(v[4], v[5], v[6], v[7]); }
    }
};

__device__ __forceinline__ void s5_scan(const Params& p) {
    const int gt = blockIdx.x * NTHREADS + tid_();
    if (gt >= 4096) return;
    const int di = gt >> 11, g = (gt >> 6) & 31, pp = gt & 63;
    const float2 a = ((const float2*)(p.ws + WS_A64))[(di * 32 + g) * 64 + pp];
    const float* lst = (const float*)(p.ws + WS_LST) + (size_t)g * NCH * 256 + di * 128 + pp;
    bf16_t* a5 = (bf16_t*)(p.ws + WS_A5) + (size_t)g * NCH * 256 + di * 128 + pp;
    float sr = 0.f, si = 0.f;
    for (int s0 = 0; s0 < NCH; s0 += 4) {
        int c[4]; float lr[4], li[4];
#pragma unroll
        for (int u = 0; u < 4; ++u) {
            const int s = s0 + u;
            c[u] = di == 0 ? (s < 4 ? NCH_LAT + s : s - 4) : (s < 4 ? NCH - 1 - s : NCH - 1 - s);
            lr[u] = lst[(size_t)c[u] * 256]; li[u] = lst[(size_t)c[u] * 256 + 64];
        }
#pragma unroll
        for (int u = 0; u < 4; ++u) {
            a5[(size_t)c[u] * 256] = f2bf(sr); a5[(size_t)c[u] * 256 + 64] = f2bf(si);
            const float nr = a.x * sr - a.y * si + lr[u], ni = a.x * si + a.y * sr + li[u]; sr = nr; si = ni;
        }
    }
}

__device__ __forceinline__ void even_conv_item(const Params& p, int item) {
    const bf16_t* pa = (const bf16_t*)(p.ws + WS_PA); bf16_t* cb = (bf16_t*)(p.ws + WS_CB);
    const float* cw = p.in[9];
    for (int t = tid_(); t < 64 * 64; t += NTHREADS) {
        const int row = item * 64 + (t >> 6), c0 = (t & 63) * 8;
        bool hasp, hasn;
        if (row < SEQ) { hasp = (row & 63) != 0; hasn = (row & 63) != 63; } else { hasp = row != SEQ; hasn = row != R - 1; }
        float m[3][8];
#pragma unroll
        for (int d = 0; d < 3; ++d) {
            const bool ok = d == 1 || (d == 0 ? hasp : hasn);
            if (ok) {
                const bf16_t* rp = pa + (size_t)(row + d - 1) * 1536 + c0;
                float u[8], gi[8]; unpack8(*(const uint4*)rp, u); unpack8(*(const uint4*)(rp + 512), gi);
#pragma unroll
                for (int e = 0; e < 8; ++e) m[d][e] = u[e] * gi[e];
            } else {
#pragma unroll
                for (int e = 0; e < 8; ++e) m[d][e] = 0.f;
            }
        }
        float go[8], f[8]; unpack8(*(const uint4*)(pa + (size_t)row * 1536 + 1024 + c0), go);
#pragma unroll
        for (int e = 0; e < 8; ++e) f[e] = go[e] * (m[0][e] * cw[c0 + e] + m[1][e] * cw[512 + c0 + e] + m[2][e] * cw[1024 + c0 + e]);
        *(uint4*)(cb + (size_t)row * 1024 + c0) = pack8(f);
    }
}

__device__ __forceinline__ unsigned ord_enc(float v) { const unsigned u = __float_as_uint(v); return (u & 0x80000000u) ? ~u : (u | 0x80000000u); }
__device__ __forceinline__ float ord_dec(unsigned e) { const unsigned u = (e & 0x80000000u) ? (e & 0x7FFFFFFFu) : ~e; return __uint_as_float(u); }
#define TOP_INSERT(key) { unsigned x_ = (key); _Pragma("unroll") for (int k_ = 0; k_ < 16; ++k_) { const unsigned hi_ = top[k_] > x_ ? top[k_] : x_; x_ = top[k_] > x_ ? x_ : top[k_]; top[k_] = hi_; } }
__device__ __forceinline__ void peer_route_item(const Params& p, int item, int nrows, unsigned char* lds) {
    const int tid = tid_();
    const int row = item * 64 + (tid >> 3), head = tid & 7;
    unsigned* sIdx = (unsigned*)lds;
    __syncthreads();
    if (row < nrows) {
        const unsigned short* sc = (const unsigned short*)(p.ws + WS_SC) + (size_t)row * 2048 + head * 256;
        float fa[16], fb[16];
        {
#define CE_DESC(a_, b_) { const unsigned hi_ = (a_) > (b_) ? (a_) : (b_); const unsigned lo_ = (a_) > (b_) ? (b_) : (a_); (a_) = hi_; (b_) = lo_; }
            unsigned topa[16], topb[16];
#pragma unroll 1
            for (int blk = 0; blk < 8; ++blk) {
                unsigned ka[16], kb[16];
#pragma unroll
                for (int c2 = 0; c2 < 2; ++c2) {
                    const int c = blk * 2 + c2;
                    const uint4 qa = *(const uint4*)(sc + c * 8), qb = *(const uint4*)(sc + 128 + c * 8);
                    const unsigned wa[4] = {qa.x, qa.y, qa.z, qa.w}, wb[4] = {qb.x, qb.y, qb.z, qb.w};
#pragma unroll
                    for (int e = 0; e < 8; ++e) {
                        const unsigned short ha = (unsigned short)((e & 1) ? (wa[e >> 1] >> 16) : (wa[e >> 1] & 0xFFFFu));
                        const unsigned short hb = (unsigned short)((e & 1) ? (wb[e >> 1] >> 16) : (wb[e >> 1] & 0xFFFFu));
                        ka[c2 * 8 + e] = (ord_enc((float)__builtin_bit_cast(_Float16, ha)) & ~0x7Fu) | (unsigned)(c * 8 + e);
                        kb[c2 * 8 + e] = (ord_enc((float)__builtin_bit_cast(_Float16, hb)) & ~0x7Fu) | (unsigned)(c * 8 + e);
                    }
                }
#pragma unroll
                for (int k = 2; k <= 16; k <<= 1) {
#pragma unroll
                    for (int j = k >> 1; j > 0; j >>= 1) {
#pragma unroll
                        for (int i = 0; i < 16; ++i) {
                            const int l2 = i ^ j;
                            if (l2 > i) {
                                if ((i & k) == 0) { CE_DESC(ka[i], ka[l2]); CE_DESC(kb[i], kb[l2]); }
                                else { CE_DESC(ka[l2], ka[i]); CE_DESC(kb[l2], kb[i]); }
                            }
                        }
                    }
                }
                if (blk == 0) {
#pragma unroll
                    for (int i = 0; i < 16; ++i) { topa[i] = ka[i]; topb[i] = kb[i]; }
                } else {
#pragma unroll
                    for (int i = 0; i < 16; ++i) { topa[i] = topa[i] > ka[15 - i] ? topa[i] : ka[15 - i]; topb[i] = topb[i] > kb[15 - i] ? topb[i] : kb[15 - i]; }
#pragma unroll
                    for (int j = 8; j > 0; j >>= 1) {
#pragma unroll
                        for (int i = 0; i < 16; ++i) { const int l2 = i ^ j; if (l2 > i) { CE_DESC(topa[i], topa[l2]); CE_DESC(topb[i], topb[l2]); } }
                    }
                }
            }
#undef CE_DESC
#pragma unroll
            for (int k = 0; k < 16; ++k) {
                sIdx[k * NTHREADS + tid] = topa[k] & 0x7Fu; sIdx[(16 + k) * NTHREADS + tid] = topb[k] & 0x7Fu;
                fa[k] = ord_dec(topa[k] & ~0x7Fu); fb[k] = ord_dec(topb[k] & ~0x7Fu);
            }
        }
        unsigned top[16];
#pragma unroll
        for (int k = 0; k < 16; ++k) top[k] = 0u;
#pragma unroll
        for (int i = 0; i < 16; ++i) {
#pragma unroll
            for (int j = 0; j < 16; ++j) {
                if ((i + 1) * (j + 1) <= 16) { TOP_INSERT((ord_enc(fa[i] + fb[j]) & ~0xFFu) | (unsigned)(i * 16 + j)); }
            }
        }
        float ev[16]; float m = ord_dec(top[0] & ~0xFFu), sum = 0.f;
        int* idxo = (int*)(p.ws + WS_IDX) + (size_t)row * 128 + head * 16;
        float* go = (float*)(p.ws + WS_GATE) + (size_t)row * 128 + head * 16;
#pragma unroll
        for (int k = 0; k < 16; ++k) { ev[k] = __expf(ord_dec(top[k] & ~0xFFu) - m); sum += ev[k]; }
        const float inv = 1.f / sum;
#pragma unroll
        for (int k = 0; k < 16; ++k) {
            const unsigned pos = top[k] & 0xFFu;
            const unsigned ia = sIdx[(pos >> 4) * NTHREADS + tid], ib = sIdx[(16 + (pos & 15)) * NTHREADS + tid];
            idxo[k] = (int)(ia * 128u + ib); go[k] = ev[k] * inv;
        }
    }
}

__device__ __forceinline__ void peer_gather_experts(const Params& p, int row, int h_beg, int h_end, int e_beg, int e_end, float (&y)[16]) {
    const int lane = tid_() & 63;
    const bf16_t* xr = (const bf16_t*)(p.ws + WS_ACT) + (size_t)row * 1024 + lane * 16;
    const unsigned char* PE = p.ws + WS_PUV + lane * 24;
    const float* psc = (const float*)(p.ws + WS_PSC);
    float x[16];
    unpack8(*(const uint4*)xr, x); unpack8(*(const uint4*)(xr + 8), x + 8);
    const int* idxp = (const int*)(p.ws + WS_IDX) + (size_t)row * 128; const float* gp = (const float*)(p.ws + WS_GATE) + (size_t)row * 128;
#pragma unroll 1
    for (int half = h_beg; half < h_end; ++half) {
        const int myidx = idxp[half * 64 + lane];
        const float myus = psc[myidx], mygv = gp[half * 64 + lane] * psc[16384 + myidx];
#pragma unroll 1
        for (int e0 = e_beg; e0 < e_end; e0 += 4) {
            U6 er[4];
#pragma unroll
            for (int u = 0; u < 4; ++u) {
                const int id = __builtin_amdgcn_readlane(myidx, e0 + u);
                er[u] = *(const U6*)(PE + (size_t)id * PREC);
            }
#pragma unroll
            for (int u = 0; u < 4; ++u) {
                const v6u_t pk = {er[u].a, er[u].b, er[u].c, er[u].d, er[u].e, er[u].f};
                const v32f_t f = __builtin_amdgcn_cvt_scalef32_pk32_f32_fp6(pk, 1.0f);
                float a0 = 0.f, a1 = 0.f;
#pragma unroll
                for (int e = 0; e < 16; e += 2) { a0 += f[e] * x[e]; a1 += f[e + 1] * x[e + 1]; }
                const float dsum = wave_sum_dpp(a0 + a1);
                const float us = __int_as_float(__builtin_amdgcn_readlane(__float_as_int(myus), e0 + u));
                const float gv = __int_as_float(__builtin_amdgcn_readlane(__float_as_int(mygv), e0 + u));
                const float coef = gelu_tanh(dsum * us) * gv;
#pragma unroll
                for (int e = 0; e < 16; ++e) y[e] += coef * f[16 + e];
                __builtin_amdgcn_sched_barrier(0);
            }
        }
    }
}
__device__ __forceinline__ void peer_gather_finish(const Params& p, int row, int l, bool last, const float (&y)[16]) {
    const int lane = tid_() & 63;
    bf16_t* h = (bf16_t*)(p.ws + WS_H) + (size_t)row * 1024 + lane * 16;
    const float* m5 = modp(p, l, row, 5) + lane * 16;
    float hv[16];
    unpack8(*(const uint4*)h, hv); unpack8(*(const uint4*)(h + 8), hv + 8);
#pragma unroll
    for (int q = 0; q < 4; ++q) {
        const float4 g0 = *(const float4*)(m5 + q * 4);
        hv[q * 4 + 0] += g0.x * y[q * 4 + 0]; hv[q * 4 + 1] += g0.y * y[q * 4 + 1];
        hv[q * 4 + 2] += g0.z * y[q * 4 + 2]; hv[q * 4 + 3] += g0.w * y[q * 4 + 3];
    }
    if (!last) {
        *(uint4*)h = pack8(hv); *(uint4*)(h + 8) = pack8(hv + 8);
        float ss = 0.f;
#pragma unroll
        for (int e = 0; e < 16; ++e) ss += hv[e] * hv[e];
        ss = wave_sum(ss);
        const float rs = rsqrtf(ss * (1.f / 1024.f) + 1e-6f);
        const float* g1 = p.in[6] + (l + 1) * 1024 + lane * 16; const float* sh = modp(p, l + 1, row, 0) + lane * 16; const float* sc = modp(p, l + 1, row, 1) + lane * 16;
        float o[16];
#pragma unroll
        for (int q = 0; q < 4; ++q) {
            const float4 gg = *(const float4*)(g1 + q * 4), s4 = *(const float4*)(sh + q * 4), c4 = *(const float4*)(sc + q * 4);
            o[q * 4 + 0] = hv[q * 4 + 0] * rs * gg.x * (1.f + c4.x) + s4.x; o[q * 4 + 1] = hv[q * 4 + 1] * rs * gg.y * (1.f + c4.y) + s4.y;
            o[q * 4 + 2] = hv[q * 4 + 2] * rs * gg.z * (1.f + c4.z) + s4.z; o[q * 4 + 3] = hv[q * 4 + 3] * rs * gg.w * (1.f + c4.w) + s4.w;
        }
        bf16_t* act = (bf16_t*)(p.ws + WS_ACT) + (size_t)row * 1024 + lane * 16;
        *(uint4*)act = pack8(o); *(uint4*)(act + 8) = pack8(o + 8);
    } else {
        float ss = 0.f;
#pragma unroll
        for (int e = 0; e < 16; ++e) ss += hv[e] * hv[e];
        ss = wave_sum(ss);
        const float rs = rsqrtf(ss * (1.f / 1024.f) + 1e-6f);
        const float* fg = p.in[31] + lane * 16; float* o = p.out + (size_t)row * 1024 + lane * 16;
#pragma unroll
        for (int q = 0; q < 4; ++q) {
            const float4 g0 = *(const float4*)(fg + q * 4);
            *(float4*)(o + q * 4) = make_float4(hv[q * 4 + 0] * rs * g0.x, hv[q * 4 + 1] * rs * g0.y, hv[q * 4 + 2] * rs * g0.z, hv[q * 4 + 3] * rs * g0.w);
        }
    }
}

__device__ __forceinline__ void peer_gather_row(const Params& p, int row, int l, bool last) {
    float y[16];
#pragma unroll
    for (int e = 0; e < 16; ++e) y[e] = 0.f;
    peer_gather_experts(p, row, 0, 2, 0, 64, y);
    peer_gather_finish(p, row, l, last, y);
}
__device__ __forceinline__ void peer_gather_row_split(const Params& p, int row, int l, unsigned char* lds) {
    const int tid = tid_(), lane = tid & 63, wave = tid >> 6;
    float y[16];
#pragma unroll
    for (int e = 0; e < 16; ++e) y[e] = 0.f;
    peer_gather_experts(p, row, wave >> 2, (wave >> 2) + 1, 16 * (wave & 3), 16 * (wave & 3) + 16, y);
    float* part = (float*)lds;
    __syncthreads();
#pragma unroll
    for (int q = 0; q < 4; ++q) *(float4*)(part + wave * 1024 + lane * 16 + q * 4) = make_float4(y[q * 4 + 0], y[q * 4 + 1], y[q * 4 + 2], y[q * 4 + 3]);
    __syncthreads();
    if (wave == 0) {
#pragma unroll
        for (int w = 1; w < 8; ++w)
#pragma unroll
            for (int q = 0; q < 4; ++q) { const float4 v = *(const float4*)(part + w * 1024 + lane * 16 + q * 4); y[q * 4 + 0] += v.x; y[q * 4 + 1] += v.y; y[q * 4 + 2] += v.z; y[q * 4 + 3] += v.w; }
        peer_gather_finish(p, row, l, false, y);
    }
}

__device__ __forceinline__ void gdn_prep_item(const Params& p, int item) {
    const int tid = tid_();
    const int r0 = item * 16;
    if (tid < 384) {
        const int part = tid >> 7, ch = tid * 8;
        const bf16_t* src = (const bf16_t*)(p.ws + WS_QKVR) + ch;
        bf16_t* dst = (bf16_t*)(p.ws + (part == 0 ? WS_QN : part == 1 ? WS_KN : WS_VN)) + (ch & 1023);
        const float* cw = p.in[22] + ch;
        float w0[8], w1[8], w2[8];
#pragma unroll
        for (int e = 0; e < 8; ++e) { w0[e] = cw[e]; w1[e] = cw[3072 + e]; w2[e] = cw[6144 + e]; }
        bool hasp0, hasn15;
        if (r0 < SEQ) { hasp0 = (r0 & 63) != 0; hasn15 = ((r0 + 15) & 63) != 63; } else { hasp0 = r0 != SEQ; hasn15 = (r0 + 15) != R - 1; }
        u32x4 rw[18];
#pragma unroll
        for (int i = 0; i < 18; ++i) {
            const bool ok = (i == 0) ? hasp0 : (i == 17) ? hasn15 : true;
            rw[i] = ok ? *(const u32x4*)(src + (size_t)(r0 + i - 1) * 3072) : (u32x4){0u, 0u, 0u, 0u};
        }
#pragma unroll
        for (int i = 0; i < 16; ++i) {
            const u32x4 a = rw[i], bq = rw[i + 1], cq = rw[i + 2];
            const float xm[8] = {lo2f(a.x), hi2f(a.x), lo2f(a.y), hi2f(a.y), lo2f(a.z), hi2f(a.z), lo2f(a.w), hi2f(a.w)};
            const float x0[8] = {lo2f(bq.x), hi2f(bq.x), lo2f(bq.y), hi2f(bq.y), lo2f(bq.z), hi2f(bq.z), lo2f(bq.w), hi2f(bq.w)};
            const float xp[8] = {lo2f(cq.x), hi2f(cq.x), lo2f(cq.y), hi2f(cq.y), lo2f(cq.z), hi2f(cq.z), lo2f(cq.w), hi2f(cq.w)};
            float f[8], ss = 0.f;
#pragma unroll
            for (int e = 0; e < 8; ++e) { const float v = siluf_(xm[e] * w0[e] + x0[e] * w1[e] + xp[e] * w2[e]); f[e] = v; ss += v * v; }
            if (part < 2) {
                ss += __shfl_xor(ss, 1, 64); ss += __shfl_xor(ss, 2, 64); ss += __shfl_xor(ss, 4, 64); ss += __shfl_xor(ss, 8, 64);
                const float sc = rsqrtf(ss + 1e-6f) * (part == 0 ? 0.08838834764831845f : 1.f);
#pragma unroll
                for (int e = 0; e < 8; ++e) f[e] *= sc;
            }
            *(uint4*)(dst + (size_t)(r0 + i) * 1024) = pack8(f);
        }
    } else if (tid < 384 + 64) {
        const int l = tid - 384;
#pragma unroll
        for (int q = 0; q < 4; ++q) {
            const int v = l * 4 + q, i = v >> 4, dh = v & 15, row = r0 + i;
            const float* ab = (const float*)(p.ws + WS_AB) + (size_t)row * 32;
            const float a = ab[dh] + p.in[24][dh], b = ab[16 + dh];
            const float sp = a > 20.f ? a : log1pf(__expf(a));
            ((float*)(p.ws + WS_GG))[(size_t)dh * R + row] = -__expf(p.in[23][dh]) * sp;
            ((float*)(p.ws + WS_BETA))[(size_t)dh * R + row] = sigmoidf_(b);
        }
    }
}

constexpr int GU_LDQ = 136, GU_LDT = 72, GU_LDA = 68;
constexpr int GU_SQ = 0, GU_SK = 17408, GU_SKB = 34816, GU_SVBT = 52224, GU_SKGT = 70656, GU_SA = 89088, GU_SAT = 106496, GU_ST = 123904, GU_SG = 133120;
__device__ __forceinline__ int perm_slot64(int pos) { return 32 * (pos >> 5) + 8 * ((pos >> 2) & 3) + 4 * ((pos >> 4) & 1) + (pos & 3); }
struct GuPre { u32x4 q[2], k[2], v[2]; float g, beta; };
__device__ __forceinline__ void gu_prefetch(const Params& p, int u, GuPre& pre) {
    const int tid = tid_(), lane = tid & 63;
    const int dh = u / NCH, c = u % NCH, dir = dh >> 3, head = dh & 7;
#pragma unroll
    for (int q = 0; q < 2; ++q) {
        const int t = tid + q * NTHREADS, i = t >> 4, d8 = (t & 15) * 8;
        const size_t ro = (size_t)(c * 64 + (dir ? 63 - i : i)) * 1024 + head * 128 + d8;
        pre.q[q] = *(const u32x4*)((const bf16_t*)(p.ws + WS_QN) + ro);
        pre.k[q] = *(const u32x4*)((const bf16_t*)(p.ws + WS_KN) + ro);
        pre.v[q] = *(const u32x4*)((const bf16_t*)(p.ws + WS_VN) + ro);
    }
    const int row = c * 64 + (dir ? 63 - lane : lane);
    pre.g = ((const float*)(p.ws + WS_GG))[(size_t)dh * R + row];
    pre.beta = ((const float*)(p.ws + WS_BETA))[(size_t)dh * R + row];
}
__device__ __forceinline__ void gdn_unit(const Params& p, int u, int u_next, GuPre& pre, unsigned char* lds) {
    const int tid = tid_(), lane = tid & 63, wave = tid >> 6;
    const int dh = u / NCH, c = u % NCH, dir = dh >> 3, head = dh & 7;
    bf16_t* sQ = (bf16_t*)(lds + GU_SQ); bf16_t* sK = (bf16_t*)(lds + GU_SK); bf16_t* sKB = (bf16_t*)(lds + GU_SKB);
    bf16_t* sVBT = (bf16_t*)(lds + GU_SVBT); bf16_t* sKGT = (bf16_t*)(lds + GU_SKGT);
    float* sA = (float*)(lds + GU_SA); float* sAT = (float*)(lds + GU_SAT); bf16_t* sT = (bf16_t*)(lds + GU_ST);
    float* sG = (float*)(lds + GU_SG); float* sBeta = sG + 64;
    __syncthreads();
    if (wave == 0) {
        float g = pre.g;
#pragma unroll
        for (int o = 1; o < 64; o <<= 1) { const float t = __shfl_up(g, o, 64); if (lane >= o) g += t; }
        sG[lane] = g; sBeta[lane] = pre.beta;
        ((float*)(p.ws + WS_GC))[(size_t)u * 64 + lane] = g;
    }
    __syncthreads();
#pragma unroll
    for (int qq = 0; qq < 2; ++qq) {
        const int t = tid + qq * NTHREADS, i = t >> 4, d8 = (t & 15) * 8;
        const u32x4 q = pre.q[qq], k = pre.k[qq], v = pre.v[qq];
        const float beta = sBeta[i], eg = __expf(sG[i]);
        const float kf[8] = {lo2f(k.x), hi2f(k.x), lo2f(k.y), hi2f(k.y), lo2f(k.z), hi2f(k.z), lo2f(k.w), hi2f(k.w)};
        const float vf[8] = {lo2f(v.x), hi2f(v.x), lo2f(v.y), hi2f(v.y), lo2f(v.z), hi2f(v.z), lo2f(v.w), hi2f(v.w)};
        float kb[8];
#pragma unroll
        for (int e = 0; e < 8; ++e) kb[e] = kf[e] * beta;
        const u32x4 kbp = {pack2(kb[0], kb[1]), pack2(kb[2], kb[3]), pack2(kb[4], kb[5]), pack2(kb[6], kb[7])};
        *(u32x4*)(sQ + i * GU_LDQ + d8) = q; *(u32x4*)(sK + i * GU_LDQ + d8) = k; *(u32x4*)(sKB + i * GU_LDQ + d8) = kbp;
        const int isw = i ^ (((d8 >> 3) & 7) << 3);
#pragma unroll
        for (int e = 0; e < 8; ++e) { sVBT[(d8 + e) * GU_LDT + isw] = f2bf(vf[e] * beta); sKGT[(d8 + e) * GU_LDT + isw] = f2bf(kb[e] * eg); }
    }
    if (u_next < NUNITS) gu_prefetch(p, u_next, pre);
    __syncthreads();
    {
        const int mat = wave >> 2, mt = wave & 3, rr = lane & 15, q4 = lane >> 4;
        const bf16_t* sX = mat ? sQ : sKB;
        f32x4 acc[4];
#pragma unroll
        for (int nt = 0; nt < 4; ++nt) acc[nt] = (f32x4){0.f, 0.f, 0.f, 0.f};
#pragma unroll
        for (int kk = 0; kk < 4; ++kk) {
            const bf16x8 a = *(const bf16x8*)(sX + (16 * mt + rr) * GU_LDQ + kk * 32 + 8 * q4);
#pragma unroll
            for (int nt = 0; nt < 4; ++nt) {
                const bf16x8 b = *(const bf16x8*)(sK + (16 * nt + rr) * GU_LDQ + kk * 32 + 8 * q4);
                acc[nt] = __builtin_amdgcn_mfma_f32_16x16x32_bf16(a, b, acc[nt], 0, 0, 0);
            }
        }
        float* dstm = mat ? sAT : sA;
#pragma unroll
        for (int nt = 0; nt < 4; ++nt) {
            const int j = 16 * nt + rr; const float gj = sG[j];
#pragma unroll
            for (int jj = 0; jj < 4; ++jj) {
                const int i = 16 * mt + 4 * q4 + jj;
                const bool keep = mat ? (j <= i) : (j < i);
                dstm[i * GU_LDA + j] = keep ? acc[nt][jj] * __expf(sG[i] - gj) : 0.f;
            }
        }
    }
    __syncthreads();
    float* sD = (float*)(lds + GU_SQ);
    if (wave < 4) {
        if (lane < 16) {
            float d[16];
#pragma unroll
            for (int i = 0; i < 16; ++i) {
                float a = (i == lane) ? 1.f : 0.f;
                const float* Ai = sA + (16 * wave + i) * GU_LDA + 16 * wave;
#pragma unroll
                for (int j = 0; j < i; ++j) a -= Ai[j] * d[j];
                d[i] = a;
                sD[(wave * 16 + i) * 16 + lane] = a;
            }
        }
    } else {
        bf16_t* att = (bf16_t*)(p.ws + WS_ATT) + (size_t)u * 64 * 64;
        for (int t = tid - 256; t < 512; t += 256) {
            const int i = t >> 3, kk2 = (t >> 2) & 1, qq = t & 3;
            const float4 lo = *(const float4*)(sAT + i * GU_LDA + 32 * kk2 + 4 * qq), hi = *(const float4*)(sAT + i * GU_LDA + 32 * kk2 + 16 + 4 * qq);
            uint4 o; o.x = pack2(lo.x, lo.y); o.y = pack2(lo.z, lo.w); o.z = pack2(hi.x, hi.y); o.w = pack2(hi.z, hi.w);
            *(uint4*)(att + i * 64 + 32 * kk2 + 8 * qq) = o;
        }
    }
    __syncthreads();
    if (wave < 4) {
        const int rr = lane & 15, q4 = lane >> 4;
        f32x4 Tt[4];
#pragma unroll
        for (int m = 0; m < 4; ++m) Tt[m] = (f32x4){0.f, 0.f, 0.f, 0.f};
#pragma unroll
        for (int b = 0; b < 4; ++b) {
            if (b >= wave) {
                f32x4 X = (f32x4){0.f, 0.f, 0.f, 0.f};
#pragma unroll
                for (int kk = 0; kk < 2; ++kk) {
                    if (2 * kk < b) {
                        const float* Ar = sA + (16 * b + rr) * GU_LDA + 32 * kk + 4 * q4;
                        const float4 lo = *(const float4*)Ar;
                        float4 hi = make_float4(0.f, 0.f, 0.f, 0.f);
                        if (2 * kk + 1 < b) hi = *(const float4*)(Ar + 16);
                        const u32x4 ap = {pack2(lo.x, lo.y), pack2(lo.z, lo.w), pack2(hi.x, hi.y), pack2(hi.z, hi.w)};
                        const u32x4 bp = {pack2(Tt[2 * kk][0], Tt[2 * kk][1]), pack2(Tt[2 * kk][2], Tt[2 * kk][3]),
                                          pack2(Tt[2 * kk + 1][0], Tt[2 * kk + 1][1]), pack2(Tt[2 * kk + 1][2], Tt[2 * kk + 1][3])};
                        X = __builtin_amdgcn_mfma_f32_16x16x32_bf16(__builtin_bit_cast(bf16x8, ap), __builtin_bit_cast(bf16x8, bp), X, 0, 0, 0);
                    }
                }
                float y[4];
#pragma unroll
                for (int jj = 0; jj < 4; ++jj) y[jj] = ((b == wave && 4 * q4 + jj == rr) ? 1.f : 0.f) - X[jj];
                const float4 dv4 = *(const float4*)(sD + (b * 16 + rr) * 16 + 4 * q4);
                const u32x4 ap = {pack2(dv4.x, dv4.y), pack2(dv4.z, dv4.w), 0u, 0u};
                const u32x4 bp = {pack2(y[0], y[1]), pack2(y[2], y[3]), 0u, 0u};
                const f32x4 z4 = (f32x4){0.f, 0.f, 0.f, 0.f};
                Tt[b] = __builtin_amdgcn_mfma_f32_16x16x32_bf16(__builtin_bit_cast(bf16x8, ap), __builtin_bit_cast(bf16x8, bp), z4, 0, 0, 0);
            }
#pragma unroll
            for (int jj = 0; jj < 4; ++jj) sT[(16 * b + 4 * q4 + jj) * GU_LDT + 16 * wave + rr] = f2bf(Tt[b][jj]);
        }
    }
    __syncthreads();
    {
        const int rr = lane & 15, q4 = lane >> 4;
        bf16_t* ut = (bf16_t*)(p.ws + WS_UT) + (size_t)u * 128 * 64;
        bf16_t* wg = (bf16_t*)(p.ws + WS_W) + (size_t)u * 64 * 128;
        f32x4 au[4], aw[4];
#pragma unroll
        for (int m = 0; m < 4; ++m) { au[m] = (f32x4){0.f, 0.f, 0.f, 0.f}; aw[m] = (f32x4){0.f, 0.f, 0.f, 0.f}; }
#pragma unroll
        for (int kk2 = 0; kk2 < 2; ++kk2) {
            const int tsw = (kk2 * 32 + 8 * q4) ^ ((((16 * wave + rr) >> 3) & 7) << 3);
            const bf16x8 bv = *(const bf16x8*)(sVBT + (16 * wave + rr) * GU_LDT + tsw);
            const bf16x8 ak = *(const bf16x8*)(sKGT + (16 * wave + rr) * GU_LDT + tsw);
#pragma unroll
            for (int m = 0; m < 4; ++m) {
                const bf16x8 tf = *(const bf16x8*)(sT + (16 * m + rr) * GU_LDT + kk2 * 32 + 8 * q4);
                au[m] = __builtin_amdgcn_mfma_f32_16x16x32_bf16(tf, bv, au[m], 0, 0, 0);
                aw[m] = __builtin_amdgcn_mfma_f32_16x16x32_bf16(ak, tf, aw[m], 0, 0, 0);
            }
        }
#pragma unroll
        for (int m = 0; m < 4; ++m) {
            uint2 o; o.x = pack2(au[m][0], au[m][1]); o.y = pack2(au[m][2], au[m][3]);
            *(uint2*)(ut + (size_t)(16 * wave + rr) * 64 + 16 * m + 4 * q4) = o;
            uint2 w2; w2.x = pack2(aw[m][0], aw[m][1]); w2.y = pack2(aw[m][2], aw[m][3]);
            *(uint2*)(wg + (size_t)(16 * m + rr) * 128 + 32 * (wave >> 1) + 8 * q4 + 4 * (wave & 1)) = w2;
        }
    }
}

constexpr int GS_SW = 0, GS_SQD = 17408, GS_SKDT = 34816, GS_SATT = 53248, GS_BUF = 62464;
typedef unsigned u32x2 __attribute__((ext_vector_type(2)));
__device__ __forceinline__ int gdn_chain_chunk(int dir, int s) { return dir == 0 ? (s < 4 ? NCH_LAT + s : s - 4) : NCH - 1 - s; }
struct GsG1 { u32x4 w[2]; u32x4 att; };
struct GsG2 { u32x2 qlo[2], qhi[2]; float gq[2]; };
struct GsG3 { u32x4 kd[2]; float gk[2]; float gl; u32x2 ut[4]; };
__device__ __forceinline__ void gs_load1(const Params& p, int dh, int c, GsG1& st) {
    const int tid = tid_(); const size_t u = (size_t)dh * NCH + c;
    const bf16_t* wg = (const bf16_t*)(p.ws + WS_W) + u * 64 * 128; const bf16_t* att = (const bf16_t*)(p.ws + WS_ATT) + u * 64 * 64;
#pragma unroll
    for (int q = 0; q < 2; ++q) { const int t = tid + q * NTHREADS; st.w[q] = *(const u32x4*)(wg + (size_t)(t >> 4) * 128 + (t & 15) * 8); }
    st.att = *(const u32x4*)(att + (size_t)(tid >> 3) * 64 + (tid & 7) * 8);
}
__device__ __forceinline__ void gs_store1(const GsG1& st, unsigned char* buf) {
    const int tid = tid_(); bf16_t* sW = (bf16_t*)(buf + GS_SW); bf16_t* sATT = (bf16_t*)(buf + GS_SATT);
#pragma unroll
    for (int q = 0; q < 2; ++q) { const int t = tid + q * NTHREADS; *(u32x4*)(sW + (t >> 4) * GU_LDQ + (t & 15) * 8) = st.w[q]; }
    *(u32x4*)(sATT + (tid >> 3) * GU_LDT + (tid & 7) * 8) = st.att;
}
__device__ __forceinline__ void gs_load2(const Params& p, int dh, int c, GsG2& st) {
    const int tid = tid_(), dir = dh >> 3, head = dh & 7; const size_t u = (size_t)dh * NCH + c;
    const float* gc = (const float*)(p.ws + WS_GC) + u * 64; const bf16_t* qn = (const bf16_t*)(p.ws + WS_QN);
#pragma unroll
    for (int q = 0; q < 2; ++q) {
        const int t = tid + q * NTHREADS, i = t >> 4, kk = (t >> 2) & 3, qq = t & 3;
        const bf16_t* src = qn + (size_t)(c * 64 + (dir ? 63 - i : i)) * 1024 + head * 128 + 32 * kk + 4 * qq;
        st.qlo[q] = *(const u32x2*)src; st.qhi[q] = *(const u32x2*)(src + 16); st.gq[q] = gc[i];
    }
}
__device__ __forceinline__ void gs_store2(const GsG2& st, unsigned char* buf) {
    const int tid = tid_(); bf16_t* sQD = (bf16_t*)(buf + GS_SQD);
#pragma unroll
    for (int q = 0; q < 2; ++q) {
        const int t = tid + q * NTHREADS, i = t >> 4, kk = (t >> 2) & 3, qq = t & 3; const float e = __expf(st.gq[q]);
        u32x4 o; o.x = pack2(lo2f(st.qlo[q].x) * e, hi2f(st.qlo[q].x) * e); o.y = pack2(lo2f(st.qlo[q].y) * e, hi2f(st.qlo[q].y) * e);
        o.z = pack2(lo2f(st.qhi[q].x) * e, hi2f(st.qhi[q].x) * e); o.w = pack2(lo2f(st.qhi[q].y) * e, hi2f(st.qhi[q].y) * e);
        *(u32x4*)(sQD + i * GU_LDQ + 32 * kk + 8 * qq) = o;
    }
}
__device__ __forceinline__ void gs_load3(const Params& p, int dh, int c, GsG3& st) {
    const int tid = tid_(), lane = tid & 63, wave = tid >> 6, dir = dh >> 3, head = dh & 7; const size_t u = (size_t)dh * NCH + c;
    const float* gc = (const float*)(p.ws + WS_GC) + u * 64; const bf16_t* kn = (const bf16_t*)(p.ws + WS_KN);
    st.gl = gc[63];
#pragma unroll
    for (int q = 0; q < 2; ++q) {
        const int t = tid + q * NTHREADS, pos = t >> 4, d8 = (t & 15) * 8;
        st.kd[q] = *(const u32x4*)(kn + (size_t)(c * 64 + (dir ? 63 - pos : pos)) * 1024 + head * 128 + d8); st.gk[q] = gc[pos];
    }
    const bf16_t* ut = (const bf16_t*)(p.ws + WS_UT) + u * 128 * 64 + (size_t)(16 * wave + (lane & 15)) * 64 + 4 * (lane >> 4);
#pragma unroll
    for (int m = 0; m < 4; ++m) st.ut[m] = *(const u32x2*)(ut + 16 * m);
}
__device__ __forceinline__ void gs_store3(const GsG3& st, unsigned char* buf) {
    const int tid = tid_(); bf16_t* sKDT = (bf16_t*)(buf + GS_SKDT);
#pragma unroll
    for (int q = 0; q < 2; ++q) {
        const int t = tid + q * NTHREADS, pos = t >> 4, d8 = (t & 15) * 8; const float e = __expf(st.gl - st.gk[q]);
        const u32x4 kq = st.kd[q]; const int sl = perm_slot64(pos) ^ (((d8 >> 3) & 7) << 3);
        sKDT[(d8 + 0) * GU_LDT + sl] = f2bf(lo2f(kq.x) * e); sKDT[(d8 + 1) * GU_LDT + sl] = f2bf(hi2f(kq.x) * e);
        sKDT[(d8 + 2) * GU_LDT + sl] = f2bf(lo2f(kq.y) * e); sKDT[(d8 + 3) * GU_LDT + sl] = f2bf(hi2f(kq.y) * e);
        sKDT[(d8 + 4) * GU_LDT + sl] = f2bf(lo2f(kq.z) * e); sKDT[(d8 + 5) * GU_LDT + sl] = f2bf(hi2f(kq.z) * e);
        sKDT[(d8 + 6) * GU_LDT + sl] = f2bf(lo2f(kq.w) * e); sKDT[(d8 + 7) * GU_LDT + sl] = f2bf(hi2f(kq.w) * e);
    }
}
__device__ __forceinline__ void gdn_seg_ab(const Params& p, int dh, int k, unsigned char* lds) {
    const int tid = tid_(), lane = tid & 63, wave = tid >> 6, rr = lane & 15, q4 = lane >> 4, dir = dh >> 3;
    const bool first = (k == 0);
    const int s_begin = first ? 0 : 4 + 16 * k, nsteps = first ? 20 : 16;
    f32x4 ScB[8], ScA[8]; bf16x8 SbB[4], SbA[4];
#pragma unroll
    for (int m = 0; m < 8; ++m) {
        ScB[m] = (f32x4){0.f, 0.f, 0.f, 0.f};
#pragma unroll
        for (int jj = 0; jj < 4; ++jj) ScA[m][jj] = (16 * m + 4 * q4 + jj == 16 * wave + rr) ? 1.f : 0.f;
    }
#pragma unroll
    for (int kk = 0; kk < 4; ++kk) {
        SbB[kk] = (bf16x8){0, 0, 0, 0, 0, 0, 0, 0};
        const u32x4 pk = {pack2(ScA[2 * kk][0], ScA[2 * kk][1]), pack2(ScA[2 * kk][2], ScA[2 * kk][3]),
                          pack2(ScA[2 * kk + 1][0], ScA[2 * kk + 1][1]), pack2(ScA[2 * kk + 1][2], ScA[2 * kk + 1][3])};
        SbA[kk] = __builtin_bit_cast(bf16x8, pk);
    }
    u32x2 ucur[4]; float glcur;
    float4* sin_img = (float4*)(p.ws + WS_SIN) + (size_t)(dh * 16) * 4096;
    __syncthreads();
    {
        const int c0 = gdn_chain_chunk(dir, s_begin);
        GsG1 g1; gs_load1(p, dh, c0, g1); gs_store1(g1, lds);
        GsG3 g3; gs_load3(p, dh, c0, g3); gs_store3(g3, lds);
#pragma unroll
        for (int m = 0; m < 4; ++m) ucur[m] = g3.ut[m];
        glcur = g3.gl;
    }
    __syncthreads();
#pragma unroll 1
    for (int t = 0; t < nsteps; ++t) {
        const int s = s_begin + t;
        const int cn = gdn_chain_chunk(dir, t + 1 < nsteps ? s + 1 : s);
        const unsigned char* buf = lds + (t & 1) * GS_BUF; unsigned char* nbuf = lds + ((t + 1) & 1) * GS_BUF;
        const bf16_t* sW = (const bf16_t*)(buf + GS_SW); const bf16_t* sKDT = (const bf16_t*)(buf + GS_SKDT);
        GsG1 g1; gs_load1(p, dh, cn, g1);
        GsG3 g3; gs_load3(p, dh, cn, g3);
        f32x4 vb_[4], va_[4];
#pragma unroll
        for (int m = 0; m < 4; ++m) {
            f32x4 accb = (f32x4){0.f, 0.f, 0.f, 0.f}, acca = (f32x4){0.f, 0.f, 0.f, 0.f};
#pragma unroll
            for (int kk = 0; kk < 4; ++kk) {
                const bf16x8 a = *(const bf16x8*)(sW + (16 * m + rr) * GU_LDQ + kk * 32 + 8 * q4);
                accb = __builtin_amdgcn_mfma_f32_16x16x32_bf16(a, SbB[kk], accb, 0, 0, 0);
                if (!first) acca = __builtin_amdgcn_mfma_f32_16x16x32_bf16(a, SbA[kk], acca, 0, 0, 0);
            }
            vb_[m][0] = lo2f(ucur[m].x) - accb[0]; vb_[m][1] = hi2f(ucur[m].x) - accb[1]; vb_[m][2] = lo2f(ucur[m].y) - accb[2]; vb_[m][3] = hi2f(ucur[m].y) - accb[3];
            va_[m] = -acca;
        }
        bf16x8 VBb[2], VBa[2];
#pragma unroll
        for (int k2 = 0; k2 < 2; ++k2) {
            const u32x4 pb = {pack2(vb_[2 * k2][0], vb_[2 * k2][1]), pack2(vb_[2 * k2][2], vb_[2 * k2][3]), pack2(vb_[2 * k2 + 1][0], vb_[2 * k2 + 1][1]), pack2(vb_[2 * k2 + 1][2], vb_[2 * k2 + 1][3])};
            const u32x4 pa = {pack2(va_[2 * k2][0], va_[2 * k2][1]), pack2(va_[2 * k2][2], va_[2 * k2][3]), pack2(va_[2 * k2 + 1][0], va_[2 * k2 + 1][1]), pack2(va_[2 * k2 + 1][2], va_[2 * k2 + 1][3])};
            VBb[k2] = __builtin_bit_cast(bf16x8, pb); VBa[k2] = __builtin_bit_cast(bf16x8, pa);
        }
        const float egl = __expf(glcur);
#pragma unroll
        for (int m = 0; m < 8; ++m) {
            f32x4 accb = ScB[m] * egl, acca = ScA[m] * egl;
#pragma unroll
            for (int k2 = 0; k2 < 2; ++k2) {
                const bf16x8 a = *(const bf16x8*)(sKDT + (16 * m + rr) * GU_LDT + ((k2 * 32 + 8 * q4) ^ ((((16 * m + rr) >> 3) & 7) << 3)));
                accb = __builtin_amdgcn_mfma_f32_16x16x32_bf16(a, VBb[k2], accb, 0, 0, 0);
                if (!first) acca = __builtin_amdgcn_mfma_f32_16x16x32_bf16(a, VBa[k2], acca, 0, 0, 0);
            }
            ScB[m] = accb; ScA[m] = acca;
        }
#pragma unroll
        for (int kk = 0; kk < 4; ++kk) {
            const u32x4 pb = {pack2(ScB[2 * kk][0], ScB[2 * kk][1]), pack2(ScB[2 * kk][2], ScB[2 * kk][3]), pack2(ScB[2 * kk + 1][0], ScB[2 * kk + 1][1]), pack2(ScB[2 * kk + 1][2], ScB[2 * kk + 1][3])};
            const u32x4 pa = {pack2(ScA[2 * kk][0], ScA[2 * kk][1]), pack2(ScA[2 * kk][2], ScA[2 * kk][3]), pack2(ScA[2 * kk + 1][0], ScA[2 * kk + 1][1]), pack2(ScA[2 * kk + 1][2], ScA[2 * kk + 1][3])};
            SbB[kk] = __builtin_bit_cast(bf16x8, pb); SbA[kk] = __builtin_bit_cast(bf16x8, pa);
        }
        gs_store1(g1, nbuf); gs_store3(g3, nbuf);
#pragma unroll
        for (int m = 0; m < 4; ++m) ucur[m] = g3.ut[m];
        glcur = g3.gl;
        if (first && t == 3) {
#pragma unroll
            for (int m = 0; m < 8; ++m) sin_img[(wave * 8 + m) * 64 + lane] = make_float4(ScB[m][0], ScB[m][1], ScB[m][2], ScB[m][3]);
        }
        __syncthreads();
    }
    if (first) {
#pragma unroll
        for (int m = 0; m < 8; ++m) sin_img[4096 + (wave * 8 + m) * 64 + lane] = make_float4(ScB[m][0], ScB[m][1], ScB[m][2], ScB[m][3]);
    } else {
        float4* bimg = (float4*)(p.ws + WS_BSEG) + (size_t)(dh * 16 + k) * 4096;
        bf16_t* aseg = (bf16_t*)(p.ws + WS_ASEG) + (size_t)(dh * 16 + k) * 128 * 128;
        const int pc = perm_slot64(16 * wave + rr);
#pragma unroll
        for (int m = 0; m < 8; ++m) {
            bimg[(wave * 8 + m) * 64 + lane] = make_float4(ScB[m][0], ScB[m][1], ScB[m][2], ScB[m][3]);
#pragma unroll
            for (int jj = 0; jj < 4; ++jj) aseg[(size_t)(16 * m + 4 * q4 + jj) * 128 + pc] = f2bf(ScA[m][jj]);
        }
    }
}
__device__ __forceinline__ void gdn_seg_chain(const Params& p, int dh, unsigned char* lds) {
    const int tid = tid_(), lane = tid & 63, wave = tid >> 6, rr = lane & 15, q4 = lane >> 4;
    float4* sin_img = (float4*)(p.ws + WS_SIN) + (size_t)(dh * 16) * 4096;
    const float4* bimg = (const float4*)(p.ws + WS_BSEG) + (size_t)(dh * 16) * 4096;
    const bf16_t* aseg = (const bf16_t*)(p.ws + WS_ASEG) + (size_t)(dh * 16) * 128 * 128;
    f32x4 Sc[8]; bf16x8 Sb[4];
#pragma unroll
    for (int m = 0; m < 8; ++m) { const float4 v = sin_img[4096 + (wave * 8 + m) * 64 + lane]; Sc[m] = (f32x4){v.x, v.y, v.z, v.w}; }
    u32x4 ar[4];
    __syncthreads();
#pragma unroll
    for (int q = 0; q < 4; ++q) { const int t = tid + q * NTHREADS; ar[q] = *(const u32x4*)(aseg + (size_t)1 * 16384 + (size_t)(t >> 4) * 128 + (t & 15) * 8); }
#pragma unroll
    for (int q = 0; q < 4; ++q) { const int t = tid + q * NTHREADS; *(u32x4*)((bf16_t*)lds + (t >> 4) * GU_LDQ + (t & 15) * 8) = ar[q]; }
    __syncthreads();
#pragma unroll 1
    for (int k = 1; k <= 14; ++k) {
        const bf16_t* sA = (const bf16_t*)(lds + ((k - 1) & 1) * 34816);
        if (k < 14) {
#pragma unroll
            for (int q = 0; q < 4; ++q) { const int t = tid + q * NTHREADS; ar[q] = *(const u32x4*)(aseg + (size_t)(k + 1) * 16384 + (size_t)(t >> 4) * 128 + (t & 15) * 8); }
        }
#pragma unroll
        for (int kk = 0; kk < 4; ++kk) {
            const u32x4 pk = {pack2(Sc[2 * kk][0], Sc[2 * kk][1]), pack2(Sc[2 * kk][2], Sc[2 * kk][3]), pack2(Sc[2 * kk + 1][0], Sc[2 * kk + 1][1]), pack2(Sc[2 * kk + 1][2], Sc[2 * kk + 1][3])};
            Sb[kk] = __builtin_bit_cast(bf16x8, pk);
        }
#pragma unroll
        for (int m = 0; m < 8; ++m) {
            const float4 bv = bimg[(size_t)k * 4096 + (wave * 8 + m) * 64 + lane];
            f32x4 acc = (f32x4){bv.x, bv.y, bv.z, bv.w};
#pragma unroll
            for (int kk = 0; kk < 4; ++kk)
                acc = __builtin_amdgcn_mfma_f32_16x16x32_bf16(*(const bf16x8*)(sA + (16 * m + rr) * GU_LDQ + kk * 32 + 8 * q4), Sb[kk], acc, 0, 0, 0);
            Sc[m] = acc;
            sin_img[(size_t)(k + 1) * 4096 + (wave * 8 + m) * 64 + lane] = make_float4(acc[0], acc[1], acc[2], acc[3]);
        }
        if (k < 14) {
#pragma unroll
            for (int q = 0; q < 4; ++q) { const int t = tid + q * NTHREADS; *(u32x4*)((bf16_t*)(lds + (k & 1) * 34816) + (t >> 4) * GU_LDQ + (t & 15) * 8) = ar[q]; }
        }
        __syncthreads();
    }
}
__device__ __forceinline__ void gdn_seq(const Params& p, int dh, int k, unsigned char* lds) {
    const int tid = tid_(), lane = tid & 63, wave = tid >> 6, rr = lane & 15, q4 = lane >> 4, dir = dh >> 3, head = dh & 7;
    const int s_begin = 4 + 16 * k;
    f32x4 Sc[8]; bf16x8 Sb[4];
    {
        const float4* sin_img = (const float4*)(p.ws + WS_SIN) + (size_t)(dh * 16 + k) * 4096;
#pragma unroll
        for (int m = 0; m < 8; ++m) { const float4 v = sin_img[(wave * 8 + m) * 64 + lane]; Sc[m] = (f32x4){v.x, v.y, v.z, v.w}; }
#pragma unroll
        for (int kk = 0; kk < 4; ++kk) {
            const u32x4 pk = {pack2(Sc[2 * kk][0], Sc[2 * kk][1]), pack2(Sc[2 * kk][2], Sc[2 * kk][3]), pack2(Sc[2 * kk + 1][0], Sc[2 * kk + 1][1]), pack2(Sc[2 * kk + 1][2], Sc[2 * kk + 1][3])};
            Sb[kk] = __builtin_bit_cast(bf16x8, pk);
        }
    }
    u32x2 ucur[4]; float glcur;
    __syncthreads();
    {
        const int c0 = gdn_chain_chunk(dir, s_begin);
        GsG1 g1; gs_load1(p, dh, c0, g1); gs_store1(g1, lds);
        GsG2 g2; gs_load2(p, dh, c0, g2); gs_store2(g2, lds);
        GsG3 g3; gs_load3(p, dh, c0, g3); gs_store3(g3, lds);
#pragma unroll
        for (int m = 0; m < 4; ++m) ucur[m] = g3.ut[m];
        glcur = g3.gl;
    }
    __syncthreads();
    bf16_t* of = (bf16_t*)(p.ws + WS_OF) + (size_t)dir * SEQ * 1024;
#pragma unroll 1
    for (int t = 0; t < 16; ++t) {
        const int s = s_begin + t;
        const int c = gdn_chain_chunk(dir, s);
        const int cn = gdn_chain_chunk(dir, t + 1 < 16 ? s + 1 : s);
        const unsigned char* buf = lds + (t & 1) * GS_BUF; unsigned char* nbuf = lds + ((t + 1) & 1) * GS_BUF;
        const bf16_t* sW = (const bf16_t*)(buf + GS_SW); const bf16_t* sQD = (const bf16_t*)(buf + GS_SQD);
        const bf16_t* sKDT = (const bf16_t*)(buf + GS_SKDT); const bf16_t* sATT = (const bf16_t*)(buf + GS_SATT);
        GsG1 g1; gs_load1(p, dh, cn, g1);
        GsG2 g2; gs_load2(p, dh, cn, g2);
        GsG3 g3; gs_load3(p, dh, cn, g3);
        f32x4 vn[4];
#pragma unroll
        for (int m = 0; m < 4; ++m) {
            f32x4 acc = (f32x4){0.f, 0.f, 0.f, 0.f};
#pragma unroll
            for (int kk = 0; kk < 4; ++kk)
                acc = __builtin_amdgcn_mfma_f32_16x16x32_bf16(*(const bf16x8*)(sW + (16 * m + rr) * GU_LDQ + kk * 32 + 8 * q4), Sb[kk], acc, 0, 0, 0);
            vn[m][0] = lo2f(ucur[m].x) - acc[0]; vn[m][1] = hi2f(ucur[m].x) - acc[1]; vn[m][2] = lo2f(ucur[m].y) - acc[2]; vn[m][3] = hi2f(ucur[m].y) - acc[3];
        }
        bf16x8 VB[2];
#pragma unroll
        for (int k2 = 0; k2 < 2; ++k2) {
            const unsigned a0 = pack2(vn[2 * k2][0], vn[2 * k2][1]), a1 = pack2(vn[2 * k2][2], vn[2 * k2][3]);
            const unsigned a2 = pack2(vn[2 * k2 + 1][0], vn[2 * k2 + 1][1]), a3 = pack2(vn[2 * k2 + 1][2], vn[2 * k2 + 1][3]);
            const u32x4 pk = {a0, a1, a2, a3}; VB[k2] = __builtin_bit_cast(bf16x8, pk);
        }
#pragma unroll
        for (int m = 0; m < 4; ++m) {
            f32x4 acc = (f32x4){0.f, 0.f, 0.f, 0.f};
#pragma unroll
            for (int kk = 0; kk < 4; ++kk)
                acc = __builtin_amdgcn_mfma_f32_16x16x32_bf16(*(const bf16x8*)(sQD + (16 * m + rr) * GU_LDQ + kk * 32 + 8 * q4), Sb[kk], acc, 0, 0, 0);
#pragma unroll
            for (int k2 = 0; k2 < 2; ++k2)
                acc = __builtin_amdgcn_mfma_f32_16x16x32_bf16(*(const bf16x8*)(sATT + (16 * m + rr) * GU_LDT + k2 * 32 + 8 * q4), VB[k2], acc, 0, 0, 0);
#pragma unroll
            for (int jj = 0; jj < 4; ++jj) {
                const int pos = 16 * m + 4 * q4 + jj;
                of[(size_t)(c * 64 + (dir ? 63 - pos : pos)) * 1024 + head * 128 + 16 * wave + rr] = f2bf(acc[jj]);
            }
        }
        const float egl = __expf(glcur);
#pragma unroll
        for (int m = 0; m < 8; ++m) {
            f32x4 acc = Sc[m] * egl;
#pragma unroll
            for (int k2 = 0; k2 < 2; ++k2)
                acc = __builtin_amdgcn_mfma_f32_16x16x32_bf16(*(const bf16x8*)(sKDT + (16 * m + rr) * GU_LDT + ((k2 * 32 + 8 * q4) ^ ((((16 * m + rr) >> 3) & 7) << 3))), VB[k2], acc, 0, 0, 0);
            Sc[m] = acc;
        }
#pragma unroll
        for (int kk = 0; kk < 4; ++kk) {
            const u32x4 pk = {pack2(Sc[2 * kk][0], Sc[2 * kk][1]), pack2(Sc[2 * kk][2], Sc[2 * kk][3]),
                              pack2(Sc[2 * kk + 1][0], Sc[2 * kk + 1][1]), pack2(Sc[2 * kk + 1][2], Sc[2 * kk + 1][3])};
            Sb[kk] = __builtin_bit_cast(bf16x8, pk);
        }
        gs_store1(g1, nbuf); gs_store2(g2, nbuf); gs_store3(g3, nbuf);
#pragma unroll
        for (int m = 0; m < 4; ++m) ucur[m] = g3.ut[m];
        glcur = g3.gl;
        __syncthreads();
    }
}

__device__ __forceinline__ void gdn_readout_row(const Params& p, int row) {
    const int lane = tid_() & 63, head = lane >> 3, d0 = (lane & 7) * 16;
    const bf16_t* of0 = (const bf16_t*)(p.ws + WS_OF) + (size_t)row * 1024 + head * 128 + d0;
    const bf16_t* of1 = of0 + (size_t)SEQ * 1024;
    const bf16_t* zp = (const bf16_t*)(p.ws + WS_Z) + (size_t)row * 1024 + head * 128 + d0;
    float a[16], b[16], z[16];
    unpack8(*(const uint4*)of0, a); unpack8(*(const uint4*)(of0 + 8), a + 8);
    unpack8(*(const uint4*)of1, b); unpack8(*(const uint4*)(of1 + 8), b + 8);
    unpack8(*(const uint4*)zp, z); unpack8(*(const uint4*)(zp + 8), z + 8);
    float ss = 0.f;
#pragma unroll
    for (int e = 0; e < 16; ++e) { a[e] += b[e]; ss += a[e] * a[e]; }
    ss += __shfl_xor(ss, 1, 64); ss += __shfl_xor(ss, 2, 64); ss += __shfl_xor(ss, 4, 64);
    const float rs = rsqrtf(ss * (1.f / 128.f) + 1e-6f);
    const float* ng = p.in[25] + d0;
    float f[16];
#pragma unroll
    for (int e = 0; e < 16; ++e) f[e] = a[e] * rs * ng[e] * siluf_(z[e]);
    bf16_t* dst = (bf16_t*)(p.ws + WS_VN) + (size_t)row * 1024 + head * 128 + d0;
    *(uint4*)dst = pack8(f); *(uint4*)(dst + 8) = pack8(f + 8);
}

#define XB_TMO      128
#define XB_XCNT(j)  (256  + 64 * (j))
#define XB_XSUB(j)  (1280 + 64 * (j))
#define XB_XGEN(j)  (2304 + 64 * (j))
#define XB_TOP      3328
#define XB_TOPGEN   3392
#define XCD_BAR_WORDS 3456
#define XB_SPIN_CAP (1u << 22)
__device__ __forceinline__ unsigned xb_ld(unsigned* p)              { return __hip_atomic_load(p, __ATOMIC_RELAXED, __HIP_MEMORY_SCOPE_AGENT); }
__device__ __forceinline__ unsigned xb_add(unsigned* p, unsigned v) { return __hip_atomic_fetch_add(p, v, __ATOMIC_RELAXED, __HIP_MEMORY_SCOPE_AGENT); }
__device__ __forceinline__ unsigned xb_xcc_id() { return (unsigned)__builtin_amdgcn_s_getreg((3 << 11) | 20) & 0xFu; }
#define XB_SPIN(cond, bar) do { unsigned _sp = 0; while (cond) { __builtin_amdgcn_s_sleep(1); \
    if ((++_sp & 255u) == 0u) { if (xb_ld(&(bar)[XB_TMO])) break; if (_sp > XB_SPIN_CAP) { atomicAdd(&(bar)[XB_TMO], 1u); break; } } } } while (0)
struct XcdBarrier { unsigned* bar; unsigned x; volatile LAS unsigned* st; };
__device__ __forceinline__ XcdBarrier xcd_barrier_post(unsigned* bar, volatile LAS unsigned* st) {
    XcdBarrier b; b.bar = bar; b.x = xb_xcc_id(); b.st = st;
    if (threadIdx.x == 0) (void)xb_add(&bar[XB_XCNT(b.x)], 1u);
    return b;
}
__device__ __forceinline__ void xcd_barrier_complete(unsigned* bar, unsigned x, unsigned& nloc, unsigned& nx) {
    const unsigned G = gridDim.x * gridDim.y * gridDim.z;
    unsigned sum, cnt, mine, sp = 0u;
    for (;;) {
        sum = 0u; cnt = 0u; mine = 0u;
#pragma unroll
        for (unsigned j = 0; j < 16; ++j) { const unsigned c = xb_ld(&bar[XB_XCNT(j)]); sum += c; cnt += (c > 0u) ? 1u : 0u; mine = (j == x) ? c : mine; }
        if (sum == G) break;
        __builtin_amdgcn_s_sleep(1);
        if ((++sp & 255u) == 0u) { if (xb_ld(&bar[XB_TMO])) break; if (sp > XB_SPIN_CAP) { atomicAdd(&bar[XB_TMO], 1u); break; } }
    }
    nloc = mine > 0u ? mine : 1u; nx = cnt > 0u ? cnt : 1u;
}
__device__ __forceinline__ void xcd_barrier(const XcdBarrier& b) {
    asm volatile("s_waitcnt vmcnt(0)" ::: "memory");
    __syncthreads();
    if (threadIdx.x == 0) {
        unsigned* bar = b.bar;
        __builtin_amdgcn_s_waitcnt(0);
        unsigned nloc = b.st[0], nx = b.st[1];
        if (nloc == 0u) { xcd_barrier_complete(bar, b.x, nloc, nx); b.st[0] = nloc; b.st[1] = nx; }
        const unsigned old = xb_add(&bar[XB_XSUB(b.x)], 1u);
        const unsigned gen = old / nloc;
        if (old + 1u == (gen + 1u) * nloc) {
            __builtin_amdgcn_fence(__ATOMIC_RELEASE, "agent");
            asm volatile("s_waitcnt vmcnt(0)" ::: "memory");
            const unsigned og = xb_add(&bar[XB_TOP], 1u);
            const unsigned tg = og / nx;
            if (og + 1u == (tg + 1u) * nx) xb_add(&bar[XB_TOPGEN], 1u);
            else XB_SPIN(xb_ld(&bar[XB_TOPGEN]) == tg, bar);
            __builtin_amdgcn_fence(__ATOMIC_ACQUIRE, "agent");
            xb_add(&bar[XB_XGEN(b.x)], 1u);
            asm volatile("s_waitcnt vmcnt(0)" ::: "memory");
        } else {
            XB_SPIN(xb_ld(&bar[XB_XGEN(b.x)]) == gen, bar);
            __builtin_amdgcn_fence(__ATOMIC_ACQUIRE, "agent");
            asm volatile("s_waitcnt vmcnt(0)" ::: "memory");
        }
    }
    __syncthreads();
}

#ifndef PHMASK
#define PHMASK 0xFFFFFFFFull
#endif
#define PH(n) (((PHMASK) >> (n)) & 1ull)
#define FOR_ITEMS(n) for (int item = blockIdx.x; item < (n); item += gridDim.x)
__device__ __forceinline__ void mixer1_phases(const Params& p, unsigned char* ws, unsigned char* lds, const XcdBarrier& xbar) {
    if (PH(14)) {
        EpiOddIn e{(bf16_t*)(ws + WS_QKVR), (bf16_t*)(ws + WS_Z), (float*)(ws + WS_AB)};
        gemm_big((const bf16_t*)(ws + WS_ACT), (const bf16_t*)(ws + WS_WOIN), SEQ, 4096, 1024, e, lds);
        FOR_ITEMS(128 + 2 * 33) {
            if (item < 128) gemm_tile((const bf16_t*)(ws + WS_ACT), 1024, R, (const bf16_t*)(ws + WS_WOIN), 1024, ODD_IN, 1024, item * 128, 4096, e, lds);
            else { const int q = item - 128; gemm_tile((const bf16_t*)(ws + WS_ACT), 1024, R, (const bf16_t*)(ws + WS_WOIN), 1024, ODD_IN, 1024, SEQ + (q / 33) * 128, (q % 33) * 128, e, lds); }
        }
    }
    xcd_barrier(xbar);
    if (PH(15)) FOR_ITEMS(R / 16) gdn_prep_item(p, item);
    xcd_barrier(xbar);
    if (PH(16)) {
        GuPre pre;
        int item = blockIdx.x;
        if (item < NUNITS) gu_prefetch(p, item, pre);
        for (; item < NUNITS; item += gridDim.x) gdn_unit(p, item, item + (int)gridDim.x, pre, lds);
    }
    xcd_barrier(xbar);
    if (PH(17)) {
        FOR_ITEMS(256) { if ((item & 15) != 15) gdn_seg_ab(p, item >> 4, item & 15, lds); }
        xcd_barrier(xbar);
        if (blockIdx.x < 16) gdn_seg_chain(p, blockIdx.x, lds);
        else {
            for (int item = (int)blockIdx.x - 16; item < 256; item += (int)gridDim.x - 16)
                p0_transpose(p.in[26], 1024, 1024, (bf16_t*)(ws + WS_WOOUT), item, lds);
        }
        xcd_barrier(xbar);
        FOR_ITEMS(256) gdn_seq(p, item >> 4, item & 15, lds);
    }
    xcd_barrier(xbar);
    if (PH(18)) FOR_ITEMS(SEQ / 8) gdn_readout_row(p, item * 8 + (tid_() >> 6));
    xcd_barrier(xbar);
    if (PH(19)) {
        EpiResid e{p.in[0], p.in[2], (bf16_t*)(ws + WS_H), (const float*)(ws + WS_MOD), 1, false};
        gemm_big((const bf16_t*)(ws + WS_VN), (const bf16_t*)(ws + WS_WOOUT), SEQ, 1024, 1024, e, lds);
        FOR_ITEMS(2048) peer_tables_item(p, item, 1);
    }
    xcd_barrier(xbar);
}

template <int L>
__device__ __forceinline__ void peer_phases(const Params& p, unsigned char* ws, unsigned char* lds, const XcdBarrier& xbar) {
    constexpr int l = L;
    constexpr int nrows = L == 0 ? R : SEQ, ntm = nrows / 128;
    if (PH(8)) FOR_ITEMS(nrows / 8) norm_rows_item(p, item, l, p.in[7] + l * 1024, 3, false);
    xcd_barrier(xbar);
    if (PH(9)) {
        EpiScore e{(unsigned short*)(ws + WS_SC), 0};
        const bf16_t* wq = (const bf16_t*)(ws + (l == 0 ? WS_WQ0 : WS_WQ1));
        gemm_big((const bf16_t*)(ws + WS_ACT), wq, SEQ, 2048, 1024, e, lds);
        if (l == 0) { FOR_ITEMS(2 * 16) gemm_tile((const bf16_t*)(ws + WS_ACT), 1024, R, wq, 1024, 2048, 1024, SEQ + (item >> 4) * 128, (item & 15) * 128, e, lds); }
    }
    xcd_barrier(xbar);
    if (PH(11)) FOR_ITEMS(nrows / 64) peer_route_item(p, item, nrows, lds);
    xcd_barrier(xbar);
    if (PH(12)) {
        if (l == 0) { FOR_ITEMS(CTX) peer_gather_row_split(p, SEQ + item, 0, lds); }
        FOR_ITEMS(SEQ / 8) peer_gather_row(p, item * 8 + (tid_() >> 6), l, l == 1);
    }
}

__global__ void __launch_bounds__(NTHREADS) fwd_megakernel(Params p) {
    extern __shared__ __attribute__((aligned(16))) unsigned char lds[];
    cg::grid_group grid = cg::this_grid();
    unsigned char* ws = p.ws;
    volatile LAS unsigned* xbst = (volatile LAS unsigned*)(LAS unsigned char*)(lds + LDS_BYTES - 16);
    if (threadIdx.x == 0) { xbst[0] = 0u; xbst[1] = 0u; }
    __syncthreads();
    const XcdBarrier xbar = xcd_barrier_post((unsigned*)(ws + WS_BAR), xbst);

    if (PH(0)) {
        constexpr int N_S5 = 256, N_ADA = 192, N_T0 = 512, N_T1 = 64, N_T2 = 256, N_T5 = 1024, N_SK = 16;
        constexpr int O1 = N_S5, O2 = O1 + N_ADA, O3 = O2 + N_T0, O4 = O3 + N_T1, O5 = O4 + N_T2, O6 = O5 + N_T5, O7 = O6 + N_SK;
        FOR_ITEMS(O7) {
            if (item < O1) p0_s5_tables(p, item, lds);
            else if (item < O2) p0_adaln(p, item - O1, lds);
            else if (item < O3) p0_transpose(p.in[8], 1024, 2048, (bf16_t*)(ws + WS_WEIN), item - O2, lds);
            else if (item < O4) p0_transpose(p.in[18], 512, 512, (bf16_t*)(ws + WS_WGLU), item - O3, lds);
            else if (item < O5) p0_transpose(p.in[20], 1024, 1024, (bf16_t*)(ws + WS_WEOUT), item - O4, lds);
            else if (item < O6) cvt_chunk(p.in[27], (bf16_t*)(ws + WS_WQB), item - O5);
            else cvt_chunk(p.in[28], (bf16_t*)(ws + WS_SK), item - O6);
        }
    }
    grid.sync();
    if (PH(1)) FOR_ITEMS(2080 + 2048 + 256) {
        if (item < 2080) norm_rows_item(p, item, 0, p.in[6], 0, true);
        else if (item < 2080 + 2048) s5_mintra_item(p, item - 2080);
        else {
            const int q = item - 4128, l = q >> 7, b = (q >> 3) & 15, tn = q & 7;
            EpiBf16 e{(bf16_t*)(ws + (l == 0 ? WS_WQ0 : WS_WQ1)) + (size_t)b * 128 * 1024, 1024};
            gemm_tile((const bf16_t*)(ws + WS_SK) + (size_t)(l * 2 + (b & 1)) * 128 * 128, 128, 128,
                      (const bf16_t*)(ws + WS_WQB) + (size_t)l * 1024 * 2048 + b * 128, 2048, 1024, 128, 0, tn * 128, e, lds);
        }
    }
    xcd_barrier(xbar);
    if (PH(2)) {
        EpiEvenIn e{(bf16_t*)(ws + WS_PA), (bf16_t*)(ws + WS_UG)};
        gemm_big((const bf16_t*)(ws + WS_ACT), (const bf16_t*)(ws + WS_WEIN), SEQ, 2048, 1024, e, lds);
        FOR_ITEMS(2 * 16) gemm_tile((const bf16_t*)(ws + WS_ACT), 1024, R, (const bf16_t*)(ws + WS_WEIN), 1024, 2048, 1024, SEQ + (item >> 4) * 128, (item & 15) * 128, e, lds);
    }
    xcd_barrier(xbar);
    if (PH(3)) FOR_ITEMS(32 * 30) {
        const int g = item / 30, r = item % 30, tm = r / 10, tn = r % 10;
        EpiS5Local e{(bf16_t*)(ws + WS_YL), (float*)(ws + WS_LST), g};
        gemm_tile((const bf16_t*)(ws + WS_UG) + (size_t)g * NCH * 1024, 1024, NCH, (const bf16_t*)(ws + WS_MS5) + (size_t)g * 1280 * 1024, 1024, 1280, 1024, tm * 128, tn * 128, e, lds);
    }
    xcd_barrier(xbar);
    if (PH(4)) {
        s5_scan(p);
        if (blockIdx.x >= 8) {
            for (int item = (int)blockIdx.x - 8; item < 2048 + 16 * 65; item += (int)gridDim.x - 8) {
                if (item < 2048) peer_tables_item(p, item, 0);
                else p0_transpose(p.in[21], 1024, ODD_IN, (bf16_t*)(ws + WS_WOIN), item - 2048, lds);
            }
        }
    }
    xcd_barrier(xbar);
    if (PH(5)) FOR_ITEMS(32 * 24) {
        const int g = item / 24, r = item % 24, tm = r / 8, tn = r % 8;
        EpiS5Out e{(const bf16_t*)(ws + WS_YL), (bf16_t*)(ws + WS_GS), g};
        gemm_tile((const bf16_t*)(ws + WS_A5) + (size_t)g * NCH * 256, 256, NCH, (const bf16_t*)(ws + WS_O5) + (size_t)g * 1024 * 256, 256, 1024, 256, tm * 128, tn * 128, e, lds);
    }
    xcd_barrier(xbar);
    if (PH(6)) {
        EpiGlu e{(const bf16_t*)(ws + WS_GS), p.in[19], (bf16_t*)(ws + WS_CB)};
        gemm_big((const bf16_t*)(ws + WS_GS), (const bf16_t*)(ws + WS_WGLU), SEQ, 512, 512, e, lds);
        for (int item = (int)gridDim.x - 1 - (int)blockIdx.x; item < 2 * 4 + NCH; item += gridDim.x) {
            if (item < 8) gemm_tile((const bf16_t*)(ws + WS_GS), 512, R, (const bf16_t*)(ws + WS_WGLU), 512, 512, 512, SEQ + (item >> 2) * 128, (item & 3) * 128, e, lds);
            else even_conv_item(p, item - 8);
        }
    }
    xcd_barrier(xbar);
    if (PH(7)) {
        EpiResid e{p.in[0], p.in[2], (bf16_t*)(ws + WS_H), (const float*)(ws + WS_MOD), 0, true};
        gemm_big((const bf16_t*)(ws + WS_CB), (const bf16_t*)(ws + WS_WEOUT), SEQ, 1024, 1024, e, lds);
        FOR_ITEMS(2 * 8) gemm_tile((const bf16_t*)(ws + WS_CB), 1024, R, (const bf16_t*)(ws + WS_WEOUT), 1024, 1024, 1024, SEQ + (item >> 3) * 128, (item & 7) * 128, e, lds);
    }
    xcd_barrier(xbar);
    peer_phases<0>(p, ws, lds, xbar);
    xcd_barrier(xbar);
    mixer1_phases(p, ws, lds, xbar);
    peer_phases<1>(p, ws, lds, xbar);
}

extern "C" void kernel_launch(void* const* d_in, const int* in_sizes, int n_in, void* d_out, int out_size, void* d_ws, size_t ws_size, hipStream_t stream) {
    static int grid_blocks = 0;
    if (grid_blocks == 0) {
        if (n_in != 32 || out_size != SEQ * D || ws_size < WS_NEED) {
            fprintf(stderr, "kernel_launch: unexpected problem (n_in %d, out %d, ws %zu, need %zu); nothing launched\n", n_in, out_size, ws_size, (size_t)WS_NEED);
            grid_blocks = -1; return;
        }
        int dev = 0, cus = 0, per_cu = 0;
        hipGetDevice(&dev);
        hipDeviceGetAttribute(&cus, hipDeviceAttributeMultiprocessorCount, dev);
        hipFuncSetAttribute((const void*)fwd_megakernel, hipFuncAttributeMaxDynamicSharedMemorySize, LDS_BYTES);
        hipOccupancyMaxActiveBlocksPerMultiprocessor(&per_cu, (const void*)fwd_megakernel, NTHREADS, LDS_BYTES);
        if (per_cu < 1) { fprintf(stderr, "kernel_launch: occupancy query says %d blocks per CU; nothing launched\n", per_cu); grid_blocks = -1; return; }
        grid_blocks = cus;
    }
    if (grid_blocks < 0) return;
    (void)hipMemsetAsync((unsigned char*)d_ws + WS_BAR, 0, XCD_BAR_WORDS * 4, stream);
    Params prm{};
    for (int i = 0; i < 32; ++i) prm.in[i] = (const float*)d_in[i];
    prm.out = (float*)d_out; prm.ws = (unsigned char*)d_ws;
    void* args[] = {&prm};
    hipError_t e = hipLaunchCooperativeKernel((const void*)fwd_megakernel, dim3(grid_blocks), dim3(NTHREADS), args, LDS_BYTES, stream);
    if (e != hipSuccess) fprintf(stderr, "cooperative launch failed: %s (grid %d)\n", hipGetErrorString(e), grid_blocks);
}
```

```cpp
#include <hip/hip_runtime.h>
#include <hip/hip_cooperative_groups.h>
#include <cstdio>
#include <cstdint>
namespace cg = cooperative_groups;

typedef unsigned short bf16_t;
typedef short bf16x8 __attribute__((ext_vector_type(8)));
typedef float f32x4 __attribute__((ext_vector_type(4)));
typedef float f32x16 __attribute__((ext_vector_type(16)));
typedef unsigned u32x4 __attribute__((ext_vector_type(4)));

constexpr int D = 1024, SEQ = 16384, CTX = 256, R = SEQ + CTX;
constexpr int NCH = R / 64;
constexpr int NCH_LAT = SEQ / 64;
constexpr int NTHREADS = 512;
constexpr int ODD_IN = 4128;
constexpr int NUNITS = 16 * NCH;

constexpr size_t al256(size_t x) { return (x + 255) & ~(size_t)255; }
constexpr size_t WS_BAR   = 0;
constexpr size_t WS_PARAMS = 14336;
constexpr size_t WS_MOD   = 16384;
constexpr size_t WS_A64   = WS_MOD + al256(2 * 2 * 6 * 1024 * 4);
constexpr size_t WS_SK    = WS_A64 + al256(2 * 32 * 64 * 8);
constexpr size_t WS_PSC   = WS_SK + al256(2 * 2 * 128 * 128 * 2);
constexpr size_t WS_WEIN  = WS_PSC + al256(2 * 16384 * 4);
constexpr size_t WS_WGLU  = WS_WEIN + (size_t)2048 * 1024 * 2;
constexpr size_t WS_WEOUT = WS_WGLU + (size_t)512 * 512 * 2;
constexpr size_t WS_WQ0   = WS_WEOUT + (size_t)1024 * 1024 * 2;
constexpr size_t WS_WQ1   = WS_WQ0 + (size_t)2048 * 1024 * 2;
constexpr size_t WS_WOIN  = WS_WQ1 + (size_t)2048 * 1024 * 2;
constexpr size_t WS_WOOUT = WS_WOIN + al256((size_t)ODD_IN * 1024 * 2);
constexpr size_t WS_H     = WS_WOOUT + (size_t)1024 * 1024 * 2;
constexpr size_t WS_PUV   = WS_H + (size_t)R * 1024 * 4;
constexpr size_t WS_ACT   = WS_PUV + (size_t)2 * 16384 * 1024 * 2;
constexpr size_t WS_ARENA = WS_ACT + (size_t)R * 1024 * 2;
constexpr size_t WS_GG    = WS_WEIN;
constexpr size_t WS_BETA  = WS_GG + (size_t)16 * R * 4;
constexpr size_t WS_GC    = WS_BETA + (size_t)16 * R * 4;
constexpr size_t WS_AB    = WS_GC + (size_t)NUNITS * 64 * 4;
static_assert(WS_AB + (size_t)R * 32 * 4 <= WS_WQ1, "layer-1 small buffers overflow the dead layer-0 weights");
constexpr size_t WS_PA    = WS_ARENA;
constexpr size_t WS_WQB   = WS_PA;
constexpr size_t WS_UG    = WS_PA + (size_t)R * 1536 * 2;
constexpr size_t WS_MS5   = WS_UG + (size_t)32 * NCH * 1024 * 2;
constexpr size_t WS_O5    = WS_MS5 + (size_t)32 * 1280 * 1024 * 2;
constexpr size_t WS_KTAB  = WS_O5 + (size_t)32 * 1024 * 256 * 2;
constexpr size_t WS_YL    = WS_KTAB + (size_t)2 * 32 * 64 * 256 * 4;
constexpr size_t WS_LST   = WS_YL + (size_t)R * 512 * 4;
constexpr size_t WS_A5    = WS_LST + (size_t)32 * NCH * 256 * 4;
constexpr size_t WS_GS    = WS_A5 + (size_t)32 * NCH * 256 * 2;
constexpr size_t WS_CB    = WS_GS + (size_t)R * 512 * 2;
constexpr size_t WS_END_L0 = WS_CB + (size_t)R * 1024 * 2;
constexpr size_t WS_Q     = WS_ARENA;
constexpr size_t WS_SC    = WS_Q + (size_t)R * 2048 * 2;
constexpr size_t WS_IDX   = WS_SC + (size_t)R * 2048 * 2;
constexpr size_t WS_GATE  = WS_IDX + (size_t)R * 128 * 4;
constexpr size_t WS_END_PEER = WS_GATE + (size_t)R * 128 * 4;
constexpr size_t WS_QKVR  = WS_ARENA;
constexpr size_t WS_W     = WS_QKVR;
constexpr size_t WS_ATT   = WS_W + (size_t)NUNITS * 64 * 128 * 2;
static_assert(WS_ATT + (size_t)NUNITS * 64 * 64 * 2 <= WS_QKVR + (size_t)R * 3072 * 2, "W+ATT must fit in QKVR");
constexpr size_t WS_Z     = WS_QKVR + (size_t)R * 3072 * 2;
constexpr size_t WS_QN    = WS_Z + (size_t)R * 1024 * 2;
constexpr size_t WS_KN    = WS_QN + (size_t)R * 1024 * 2;
constexpr size_t WS_VN    = WS_KN + (size_t)R * 1024 * 2;
constexpr size_t WS_UT    = WS_VN + (size_t)R * 1024 * 2;
constexpr size_t WS_END_L1 = WS_UT + (size_t)NUNITS * 128 * 64 * 2;
constexpr size_t WS_OF    = WS_PUV;
constexpr size_t WS_SIN   = WS_ACT;
constexpr size_t WS_BSEG  = WS_SIN + (size_t)256 * 65536;
constexpr size_t WS_ASEG  = WS_VN;
static_assert(WS_BSEG + (size_t)256 * 65536 <= WS_ARENA, "SIN+BSEG must fit in ACT");
constexpr size_t cmax(size_t a, size_t b) { return a > b ? a : b; }
constexpr size_t WS_NEED  = cmax(cmax(WS_END_L0, WS_END_PEER), WS_END_L1);
static_assert(WS_NEED <= (size_t)512 * 1024 * 1024, "workspace plan exceeds 512 MiB");

constexpr int LDS_BYTES = 140 * 1024;

struct Params {
    const float* in[32];
    float* out;
    unsigned char* ws;
};

__device__ __forceinline__ int tid_() { int t = threadIdx.x; asm volatile("" : "+v"(t)); return t; }
__device__ __forceinline__ float bf2f(bf16_t b) { return __uint_as_float((unsigned)b << 16); }
__device__ __forceinline__ bf16_t f2bf(float f) { const __bf16 b = (__bf16)f; return __builtin_bit_cast(bf16_t, b); }
typedef float f32x2_t __attribute__((ext_vector_type(2)));
typedef __bf16 bf16x2_t __attribute__((ext_vector_type(2)));
__device__ __forceinline__ unsigned pack2(float lo, float hi) { const f32x2_t v = {lo, hi}; const bf16x2_t b = __builtin_convertvector(v, bf16x2_t); return __builtin_bit_cast(unsigned, b); }
__device__ __forceinline__ float lo2f(unsigned p) { return __uint_as_float(p << 16); }
__device__ __forceinline__ float hi2f(unsigned p) { return __uint_as_float(p & 0xFFFF0000u); }
__device__ __forceinline__ float sigmoidf_(float x) { return 1.f / (1.f + __expf(-x)); }
__device__ __forceinline__ float siluf_(float x) { return x * sigmoidf_(x); }
__device__ __forceinline__ float gelu_tanh(float x) {
    const float u = 0.7978845608028654f * (x + 0.044715f * x * x * x);
    const float t = 1.f - 2.f / (1.f + __expf(2.f * u));
    return 0.5f * x * (1.f + t);
}
__device__ __forceinline__ float wave_sum(float v) {
#pragma unroll
    for (int o = 32; o > 0; o >>= 1) v += __shfl_xor(v, o, 64);
    return v;
}

__device__ __forceinline__ float wave_sum_dpp(float v) {
    v += __int_as_float(__builtin_amdgcn_update_dpp(0, __float_as_int(v), 0xB1, 0xF, 0xF, true));
    v += __int_as_float(__builtin_amdgcn_update_dpp(0, __float_as_int(v), 0x4E, 0xF, 0xF, true));
    v += __int_as_float(__builtin_amdgcn_update_dpp(0, __float_as_int(v), 0x141, 0xF, 0xF, true));
    v += __int_as_float(__builtin_amdgcn_update_dpp(0, __float_as_int(v), 0x140, 0xF, 0xF, true));
    v += __int_as_float(__builtin_amdgcn_update_dpp(0, __float_as_int(v), 0x142, 0xA, 0xF, false));
    v += __int_as_float(__builtin_amdgcn_update_dpp(0, __float_as_int(v), 0x143, 0xC, 0xF, false));
    return __int_as_float(__builtin_amdgcn_readlane(__float_as_int(v), 63));
}
__device__ __forceinline__ void unpack8(const uint4& p, float* f) {
    f[0] = lo2f(p.x); f[1] = hi2f(p.x); f[2] = lo2f(p.y); f[3] = hi2f(p.y);
    f[4] = lo2f(p.z); f[5] = hi2f(p.z); f[6] = lo2f(p.w); f[7] = hi2f(p.w);
}
__device__ __forceinline__ uint4 pack8(const float* f) {
    uint4 p; p.x = pack2(f[0], f[1]); p.y = pack2(f[2], f[3]); p.z = pack2(f[4], f[5]); p.w = pack2(f[6], f[7]); return p;
}
__device__ __forceinline__ const float* modp(const Params& p, int l, int row, int j) {
    const float* m = (const float*)(p.ws + WS_MOD);
    return m + ((l * 2 + (row >= SEQ ? 1 : 0)) * 6 + j) * 1024;
}

#define LAS __attribute__((address_space(3)))
constexpr int GT_STAGE = 32768;
template <class Epi>
__device__ __forceinline__ void gemm_tile(const bf16_t* __restrict__ A, int lda, int M, const bf16_t* __restrict__ Bt, int ldb, int N, int K,
                                          int row0, int col0, Epi epi, unsigned char* lds_generic) {
    LAS unsigned char* lds = (LAS unsigned char*)lds_generic;
    const int tid = tid_(), lane = tid & 63, wave = __builtin_amdgcn_readfirstlane(tid >> 6);
    const int wm = wave >> 2, wn = wave & 3, r = lane & 31, h = lane >> 5;
    const bf16_t* ga[2]; const bf16_t* gb[2];
#pragma unroll
    for (int i = 0; i < 2; ++i) {
        const int trow = 8 * (wave + 8 * i) + (lane >> 3), kp = (lane & 7) ^ ((trow >> 1) & 7);
        int ra = row0 + trow, rb = col0 + trow; ra = ra < M ? ra : M - 1; rb = rb < N ? rb : N - 1;
        ga[i] = A + (size_t)ra * lda + kp * 8; gb[i] = Bt + (size_t)rb * ldb + kp * 8;
    }
    f32x16 acc0, acc1;
#pragma unroll
    for (int i = 0; i < 16; ++i) { acc0[i] = 0.f; acc1[i] = 0.f; }
    const int nk = K >> 6;
#define GT_ISSUE(kt_) do { const int st_ = ((kt_) & 3) * GT_STAGE; _Pragma("unroll") for (int i_ = 0; i_ < 2; ++i_) { \
        __builtin_amdgcn_global_load_lds((const unsigned*)(ga[i_] + (kt_) * 64), (LAS unsigned*)(lds + st_ + (wave + 8 * i_) * 1024), 16, 0, 0); \
        __builtin_amdgcn_global_load_lds((const unsigned*)(gb[i_] + (kt_) * 64), (LAS unsigned*)(lds + st_ + 16384 + (wave + 8 * i_) * 1024), 16, 0, 0); } } while (0)
    __syncthreads();
    GT_ISSUE(0);
    if (nk > 1) GT_ISSUE(1);
    if (nk > 2) GT_ISSUE(2);
    const int xs = (r >> 1) & 7;
    const int aoff = (wm * 64 + r) * 128, boff = 16384 + (wn * 32 + r) * 128;
#pragma unroll 1
    for (int kt = 0; kt < nk; ++kt) {
        const int ahead = nk - 1 - kt;
        if (ahead >= 2) asm volatile("s_waitcnt vmcnt(8)" ::: "memory");
        else if (ahead == 1) asm volatile("s_waitcnt vmcnt(4)" ::: "memory");
        else asm volatile("s_waitcnt vmcnt(0)" ::: "memory");
        __builtin_amdgcn_s_barrier();
        asm volatile("" ::: "memory");
        if (kt + 3 < nk) GT_ISSUE(kt + 3);
        const LAS unsigned char* sb = lds + (kt & 3) * GT_STAGE;
#pragma unroll
        for (int s = 0; s < 4; ++s) {
            const int ko = ((2 * s + h) ^ xs) * 16;
            const bf16x8 a0 = *(const LAS bf16x8*)(sb + aoff + ko);
            const bf16x8 a1 = *(const LAS bf16x8*)(sb + aoff + 32 * 128 + ko);
            const bf16x8 b  = *(const LAS bf16x8*)(sb + boff + ko);
            acc0 = __builtin_amdgcn_mfma_f32_32x32x16_bf16(a0, b, acc0, 0, 0, 0);
            acc1 = __builtin_amdgcn_mfma_f32_32x32x16_bf16(a1, b, acc1, 0, 0, 0);
        }
    }
#undef GT_ISSUE
    __builtin_amdgcn_s_barrier();
    asm volatile("" ::: "memory");
    {
        LAS float* sc = (LAS float*)lds;
#pragma unroll
        for (int i = 0; i < 16; ++i) {
            const int rr = wm * 64 + (i & 3) + 8 * (i >> 2) + 4 * h;
            sc[rr * 132 + wn * 32 + r] = acc0[i];
            sc[(rr + 32) * 132 + wn * 32 + r] = acc1[i];
        }
    }
    __syncthreads();
    {
        const LAS float* sc = (const LAS float*)lds;
        const int c8 = (tid & 15) * 8, col = col0 + c8;
#pragma unroll
        for (int ps = 0; ps < 4; ++ps) {
            const int rl = (tid >> 4) + 32 * ps, row = row0 + rl;
            const f32x4 v0 = *(const LAS f32x4*)(sc + rl * 132 + c8), v1 = *(const LAS f32x4*)(sc + rl * 132 + c8 + 4);
            if (row < M && col < N) { const float v[8] = {v0[0], v0[1], v0[2], v0[3], v1[0], v1[1], v1[2], v1[3]}; epi(row, col, v); }
        }
    }
}

namespace pg8 {
#define PG8_LAS __attribute__((address_space(3)))
typedef unsigned short bf16_t;
typedef short bf16x8 __attribute__((ext_vector_type(8)));
typedef float f32x4 __attribute__((ext_vector_type(4)));
typedef unsigned u32x4 __attribute__((ext_vector_type(4)));
constexpr int BM = 256, BK = 64, HALF = 128, HTB = HALF * BK * 2  , STAGE_BYTES = 8 * HTB, NXCD = 8, WGM = 8;

__host__ __device__ __forceinline__ int lds_byte(int r, int c) { const int st = (r >> 4) * 2 + (c >> 5), rr = r & 15, cc = c & 31, ob = rr * 64 + cc * 2; return st * 1024 + (ob ^ (((ob >> 9) & 1) << 5)); }
__host__ __device__ __forceinline__ void stage_rc(int b, int& R, int& C) { const int st = b / 1024, sb = b % 1024, swz = sb ^ (((sb >> 9) & 1) << 5); R = (st >> 1) * 16 + swz / 64; C = (st & 1) * 32 + (swz % 64) / 2; }
__host__ __device__ __forceinline__ int perm32(int rho) { const int n = rho >> 4, i = rho & 15; return 8 * (i >> 2) + 4 * n + (i & 3); }

struct Unit { int pm, pn; };
struct Gemm { const bf16_t* A; const bf16_t* Bt; int M, N, K; };

struct StaticOrder {
    int nM, nN, nwg, G, c;
    __host__ __device__ void init(int M, int N, int G_, int c_) { nM = M / BM; nN = N / BM; nwg = nM * nN; G = G_; c = c_; }
    __host__ __device__ bool next(int i, Unit& u) const {
        const long L = (long)i * G + c; if (L >= nwg) return false;
        int wgid = (int)L; { const int q = nwg / NXCD, r = nwg % NXCD, xcd = wgid % NXCD, off = wgid / NXCD; wgid = (xcd < r ? xcd * (q + 1) : r * (q + 1) + (xcd - r) * q) + off; }
        const int nig = WGM * nN, gid = wgid / nig, fm = gid * WGM, gsz = (nM - fm) < WGM ? (nM - fm) : WGM;
        u.pm = fm + ((wgid % nig) % gsz); u.pn = (wgid % nig) / gsz; return true;
    }
    __device__ __forceinline__ void a_ready(const Unit&) const {}
    __device__ __forceinline__ void done(const Unit&) const {}
};
template <class Epi, class Sched, bool STAMP = false>
__device__ __forceinline__ void gemm_phase(PG8_LAS unsigned char* lds, const Gemm g, const Sched& S, const Epi& E, unsigned long long* stamps) {
    const int tid = tid_(), wid = __builtin_amdgcn_readfirstlane(tid >> 6), lane = tid & 63, wr = wid >> 2, wc = wid & 3, fr = lane & 15, fq = lane >> 4;
    const int K = g.K, nt = K / BK;
    int ts_lo = 0, ts_hi = 0, nts = 0; const unsigned long long rt_entry = STAMP ? (unsigned long long)0ull : 0ull;
#define PG8_STAMP() do { if (STAMP && wid == 0 && nts < 64) { const unsigned long long _c = (unsigned long long)0ull; \
        ts_lo = (lane == nts) ? (int)(unsigned)_c : ts_lo; ts_hi = (lane == nts) ? (int)(unsigned)(_c >> 32) : ts_hi; ++nts; } } while (0)
    PG8_STAMP();
    unsigned voffA[2], voffB[2];
#pragma unroll
    for (int i = 0; i < 2; ++i) { int R, C; stage_rc(tid * 16 + i * 8192, R, C); const int Rb = Epi::PERM ? ((R & ~31) + perm32(R & 31)) : R;
        voffA[i] = (unsigned)(R * K + C) * 2u; voffB[i] = (unsigned)(Rb * K + C) * 2u; }
    const size_t kstep = (size_t)(BK * 2);
    const size_t hstep = (size_t)HALF * K * 2;
    const size_t tstep = 2 * hstep;
    const unsigned ldsw = (unsigned)wid * 1024u;
    const int aoff = lds_byte(wr * 64 + fr, fq * 8), boff = lds_byte(wc * 32 + fr, fq * 8);
#define PG8_SA(b, h) (((b) * 2 + (h)) * HTB)
#define PG8_SB(b, h) ((4 + (b) * 2 + (h)) * HTB)
#define PG8_STAGE(bufoff, gbase, voff) do { _Pragma("unroll") for (int _i = 0; _i < 2; ++_i) { unsigned vo_ = (voff)[_i]; asm volatile("" : "+v"(vo_));   \
        __builtin_amdgcn_global_load_lds((const unsigned*)((const char*)(gbase) + vo_), (PG8_LAS unsigned*)(lds + (bufoff) + ldsw + _i * 8192), 16, 0, 0); } } while (0)
#define PG8_LDA(dst, b, h) do { _Pragma("unroll") for (int m = 0; m < 4; ++m) _Pragma("unroll") for (int k = 0; k < 2; ++k) dst[m][k] = *(const PG8_LAS bf16x8*)(lds + PG8_SA(b, h) + aoff + m * 2048 + k * 1024); } while (0)
#define PG8_LDB(dst, b, h) do { _Pragma("unroll") for (int n = 0; n < 2; ++n) _Pragma("unroll") for (int k = 0; k < 2; ++k) dst[n][k] = *(const PG8_LAS bf16x8*)(lds + PG8_SB(b, h) + boff + n * 2048 + k * 1024); } while (0)
#define PG8_MMA(ai, bj, At, Bt) do { __builtin_amdgcn_s_setprio(1); _Pragma("unroll") for (int m = 0; m < 4; ++m) _Pragma("unroll") for (int n = 0; n < 2; ++n) _Pragma("unroll") for (int k = 0; k < 2; ++k) \
        acc[ai][bj][m][n] = __builtin_amdgcn_mfma_f32_16x16x32_bf16(Bt[n][k], At[m][k], acc[ai][bj][m][n], 0, 0, 0); __builtin_amdgcn_s_setprio(0); } while (0)
#define PG8_WAIT_V(n) asm volatile("s_waitcnt vmcnt(" #n ")" ::: "memory")
#define PG8_WAIT_L(n) asm volatile("s_waitcnt lgkmcnt(" #n ")" ::: "memory")
#define PG8_BAR __builtin_amdgcn_s_barrier()
#define PG8_SCHED __builtin_amdgcn_sched_barrier(0)
    Unit cur, nxt; int ui = 0;
    if (!S.next(0, cur)) return;
    f32x4 acc[2][2][4][2];
#pragma unroll
    for (int a = 0; a < 2; ++a)
#pragma unroll
        for (int b = 0; b < 2; ++b)
#pragma unroll
            for (int m = 0; m < 4; ++m)
#pragma unroll
                for (int n = 0; n < 2; ++n) acc[a][b][m][n] = (f32x4){0.f, 0.f, 0.f, 0.f};
    bf16x8 At[4][2], B0[2][2], B1[2][2];
    const char* cA = (const char*)g.A + (size_t)cur.pm * tstep; const char* cB = (const char*)g.Bt + (size_t)cur.pn * tstep;
    S.a_ready(cur);
    PG8_STAGE(PG8_SB(0, 0), cB, voffB); PG8_STAGE(PG8_SA(0, 0), cA, voffA); PG8_STAGE(PG8_SB(0, 1), cB + hstep, voffB); PG8_STAGE(PG8_SA(0, 1), cA + hstep, voffA);
    if (wr == 1) PG8_BAR;
    PG8_WAIT_V(4); PG8_BAR;
    PG8_STAGE(PG8_SB(1, 0), cB + kstep, voffB); PG8_STAGE(PG8_SA(1, 0), cA + kstep, voffA); PG8_STAGE(PG8_SB(1, 1), cB + hstep + kstep, voffB);
    PG8_WAIT_V(6); PG8_BAR;
    PG8_STAMP();
    for (;;) {
        const bool has_next = S.next(ui + 1, nxt);
        const char* nA = has_next ? (const char*)g.A + (size_t)nxt.pm * tstep : cA; const char* nB = has_next ? (const char*)g.Bt + (size_t)nxt.pn * tstep : cB;
        for (int t = 0; t < nt; t += 2) {
            const bool last = (t == nt - 2);
            const char* a1 = cA + (size_t)(t + 1) * kstep;
            const char* a2 = last ? nA : cA + (size_t)(t + 2) * kstep; const char* b2 = last ? nB : cB + (size_t)(t + 2) * kstep;
            const char* a3 = a2 + kstep; const char* b3 = b2 + kstep;
            if (last && has_next) S.a_ready(nxt);
            PG8_LDB(B0, 0, 0); PG8_SCHED; PG8_LDA(At, 0, 0); PG8_STAGE(PG8_SA(1, 1), a1 + hstep, voffA);
            PG8_WAIT_L(8); PG8_BAR; PG8_WAIT_L(0); PG8_MMA(0, 0, At, B0); PG8_BAR; PG8_SCHED;
            PG8_LDB(B1, 0, 1); PG8_STAGE(PG8_SB(0, 0), b2, voffB);
            PG8_BAR; PG8_WAIT_L(0); PG8_MMA(0, 1, At, B1); PG8_BAR;
            PG8_LDA(At, 0, 1); PG8_STAGE(PG8_SA(0, 0), a2, voffA);
            PG8_BAR; PG8_WAIT_L(0); PG8_MMA(1, 0, At, B0); PG8_BAR; PG8_SCHED;
            PG8_STAGE(PG8_SB(0, 1), b2 + hstep, voffB);
            PG8_WAIT_V(6); PG8_BAR; PG8_MMA(1, 1, At, B1); PG8_BAR;
            PG8_LDB(B0, 1, 0); PG8_SCHED; PG8_LDA(At, 1, 0); PG8_STAGE(PG8_SA(0, 1), a2 + hstep, voffA);
            PG8_WAIT_L(8); PG8_BAR; PG8_WAIT_L(0); PG8_MMA(0, 0, At, B0); PG8_BAR; PG8_SCHED;
            PG8_LDB(B1, 1, 1); PG8_STAGE(PG8_SB(1, 0), b3, voffB);
            PG8_BAR; PG8_WAIT_L(0); PG8_MMA(0, 1, At, B1); PG8_BAR;
            PG8_LDA(At, 1, 1); PG8_STAGE(PG8_SA(1, 0), a3, voffA);
            PG8_BAR; PG8_WAIT_L(0); PG8_MMA(1, 0, At, B0); PG8_BAR; PG8_SCHED;
            PG8_STAGE(PG8_SB(1, 1), b3 + hstep, voffB);
            PG8_WAIT_V(6); PG8_BAR; PG8_MMA(1, 1, At, B1); PG8_BAR;
        }
        PG8_STAMP();
        if constexpr (!Epi::AFTER_DRAIN) { E(acc, cur, wr, wc, fr, fq); S.done(cur); }
        PG8_STAMP();
        if (!has_next) break;
#pragma unroll
        for (int a = 0; a < 2; ++a)
#pragma unroll
            for (int b = 0; b < 2; ++b)
#pragma unroll
                for (int m = 0; m < 4; ++m)
#pragma unroll
                    for (int n = 0; n < 2; ++n) acc[a][b][m][n] = (f32x4){0.f, 0.f, 0.f, 0.f};
        cur = nxt; cA = nA; cB = nB; ++ui;
    }
    PG8_WAIT_V(0);
    if (wr == 0) PG8_BAR;
    PG8_BAR;
    if constexpr (Epi::AFTER_DRAIN) { E.fused(acc, cur, wr, wc, fr, fq, lds, wid, lane); S.done(cur); }
    PG8_STAMP();
    if (STAMP && wid == 0) { stamps[lane] = lane < nts ? (((unsigned long long)(unsigned)ts_hi << 32) | (unsigned)ts_lo) : 0ull;
        if (lane == 62) stamps[62] = rt_entry; if (lane == 63) stamps[63] = (unsigned long long)0ull; }
#undef PG8_STAMP
#undef PG8_SA
#undef PG8_SB
#undef PG8_STAGE
#undef PG8_LDA
#undef PG8_LDB
#undef PG8_MMA
#undef PG8_WAIT_V
#undef PG8_WAIT_L
#undef PG8_BAR
#undef PG8_SCHED
}
}

template <class F> struct EpiAdapt {
    static constexpr bool PERM = true, AFTER_DRAIN = false;
    F f;
    __device__ __forceinline__ void operator()(const pg8::f32x4 (&acc)[2][2][4][2], const pg8::Unit& u, int wr, int wc, int fr, int fq) const {
#pragma unroll
        for (int ai = 0; ai < 2; ++ai)
#pragma unroll
            for (int m = 0; m < 4; ++m) {
                const int row = u.pm * 256 + ai * 128 + wr * 64 + m * 16 + fr;
#pragma unroll
                for (int bj = 0; bj < 2; ++bj) {
                    const int col = u.pn * 256 + bj * 128 + wc * 32 + 8 * fq;
                    const float v[8] = {acc[ai][bj][m][0][0], acc[ai][bj][m][0][1], acc[ai][bj][m][0][2], acc[ai][bj][m][0][3],
                                        acc[ai][bj][m][1][0], acc[ai][bj][m][1][1], acc[ai][bj][m][1][2], acc[ai][bj][m][1][3]};
                    f(row, col, v);
                    asm volatile("" ::: "memory");
                }
            }
    }
};
template <class F>
__device__ __forceinline__ void gemm_big(const bf16_t* A, const bf16_t* Bt, int M, int N, int K, F f, unsigned char* lds_generic) {
    __syncthreads();
    pg8::Gemm g{A, Bt, M, N, K};
    pg8::StaticOrder S; S.init(M, N, (int)gridDim.x, (int)blockIdx.x);
    EpiAdapt<F> E{f};
    pg8::gemm_phase<EpiAdapt<F>, pg8::StaticOrder, false>((LAS unsigned char*)lds_generic, g, S, E, nullptr);
    __syncthreads();
}

__device__ __forceinline__ void p0_adaln(const Params& p, int item, unsigned char* lds) {
    const int l = item / 96, cb = item % 96, tid = tid_();
    const int kq = tid >> 4, c4 = tid & 15;
    const float* W = p.in[4] + (size_t)l * 1024 * 6144 + cb * 64 + c4 * 4;
    const float* c = p.in[1]; const float* cc = p.in[3];
    float al[4] = {0, 0, 0, 0}, ac[4] = {0, 0, 0, 0};
#pragma unroll 8
    for (int k = kq; k < 1024; k += 32) {
        const float4 w = *(const float4*)(W + (size_t)k * 6144);
        const float sl = siluf_(c[k]), sc = siluf_(cc[k]);
        al[0] += sl * w.x; al[1] += sl * w.y; al[2] += sl * w.z; al[3] += sl * w.w;
        ac[0] += sc * w.x; ac[1] += sc * w.y; ac[2] += sc * w.z; ac[3] += sc * w.w;
    }
    float* red = (float*)lds;
    __syncthreads();
#pragma unroll
    for (int e = 0; e < 4; ++e) { red[(kq * 2 + 0) * 64 + c4 * 4 + e] = al[e]; red[(kq * 2 + 1) * 64 + c4 * 4 + e] = ac[e]; }
    __syncthreads();
    if (tid < 128) {
        const int s = tid >> 6, cidx = tid & 63;
        float sum = 0.f;
        for (int q = 0; q < 32; ++q) sum += red[(q * 2 + s) * 64 + cidx];
        const int col = cb * 64 + cidx;
        sum += p.in[5][l * 6144 + col];
        ((float*)(p.ws + WS_MOD))[(l * 2 + s) * 6144 + col] = sum;
    }
}
__device__ __forceinline__ void p0_transpose(const float* __restrict__ src, int K, int N, bf16_t* __restrict__ dst, int tile, unsigned char* lds) {
    const int ntn = (N + 63) / 64, tk = tile / ntn, tn = tile % ntn, tid = tid_();
    float* s = (float*)lds;
    __syncthreads();
    for (int e = tid; e < 64 * 64; e += NTHREADS) {
        const int kk = e >> 6, nn = e & 63; const int n = tn * 64 + nn;
        s[kk * 65 + nn] = n < N ? src[(size_t)(tk * 64 + kk) * N + n] : 0.f;
    }
    __syncthreads();
    {
        const int nn = tid >> 3, kg = (tid & 7) * 8; const int n = tn * 64 + nn;
        if (n < N) {
            float f[8];
#pragma unroll
            for (int e = 0; e < 8; ++e) f[e] = s[(kg + e) * 65 + nn];
            *(uint4*)(dst + (size_t)n * K + tk * 64 + kg) = pack8(f);
        }
    }
}
__device__ __forceinline__ void cvt_chunk(const float* __restrict__ src, bf16_t* __restrict__ dst, size_t item) {
    const size_t o = item * 4096 + (size_t)tid_() * 8;
    const float4 a = *(const float4*)(src + o), b = *(const float4*)(src + o + 4);
    uint4 q; q.x = pack2(a.x, a.y); q.y = pack2(a.z, a.w); q.z = pack2(b.x, b.y); q.w = pack2(b.z, b.w);
    *(uint4*)(dst + o) = q;
}
typedef float v32f_t __attribute__((ext_vector_type(32)));
typedef _Float16 v32h_t __attribute__((ext_vector_type(32)));
typedef unsigned v6u_t __attribute__((ext_vector_type(6)));
struct __attribute__((packed, aligned(8))) U6 { unsigned a, b, c, d, e, f; };
constexpr int PREC = 1536;
__device__ __forceinline__ void peer_tables_item(const Params& p, int item, int l) {
    const int lane = tid_() & 63, ex = item * 8 + (tid_() >> 6);
    const float* su = p.in[29] + ((size_t)l * 16384 + ex) * 1024 + lane * 16;
    const float* sv = p.in[30] + ((size_t)l * 16384 + ex) * 1024 + lane * 16;
    float4 u[4], v[4]; float amu = 0.f, amv = 0.f;
#pragma unroll
    for (int q = 0; q < 4; ++q) { u[q] = *(const float4*)(su + q * 4); v[q] = *(const float4*)(sv + q * 4); }
#pragma unroll
    for (int q = 0; q < 4; ++q) {
        amu = fmaxf(amu, fmaxf(fmaxf(fabsf(u[q].x), fabsf(u[q].y)), fmaxf(fabsf(u[q].z), fabsf(u[q].w))));
        amv = fmaxf(amv, fmaxf(fmaxf(fabsf(v[q].x), fabsf(v[q].y)), fmaxf(fabsf(v[q].z), fabsf(v[q].w))));
    }
#pragma unroll
    for (int o = 32; o > 0; o >>= 1) { amu = fmaxf(amu, __shfl_xor(amu, o, 64)); amv = fmaxf(amv, __shfl_xor(amv, o, 64)); }
    const float scu = amu > 0.f ? 7.0f / amu : 1.f, scv = amv > 0.f ? 7.0f / amv : 1.f;
    v32h_t x;
#pragma unroll
    for (int q = 0; q < 4; ++q) {
        x[4 * q + 0] = (_Float16)(u[q].x * scu); x[4 * q + 1] = (_Float16)(u[q].y * scu); x[4 * q + 2] = (_Float16)(u[q].z * scu); x[4 * q + 3] = (_Float16)(u[q].w * scu);
        x[16 + 4 * q + 0] = (_Float16)(v[q].x * scv); x[16 + 4 * q + 1] = (_Float16)(v[q].y * scv); x[16 + 4 * q + 2] = (_Float16)(v[q].z * scv); x[16 + 4 * q + 3] = (_Float16)(v[q].w * scv);
    }
    const v6u_t pk = __builtin_amdgcn_cvt_scalef32_pk32_fp6_f16(x, 1.0f);
    U6 o; o.a = pk[0]; o.b = pk[1]; o.c = pk[2]; o.d = pk[3]; o.e = pk[4]; o.f = pk[5];
    *(U6*)(p.ws + WS_PUV + (size_t)ex * PREC + lane * 24) = o;
    if (lane == 0) { float* psc = (float*)(p.ws + WS_PSC); psc[ex] = amu > 0.f ? amu / 7.0f : 1.f; psc[16384 + ex] = amv > 0.f ? amv / 7.0f : 1.f; }
}

__device__ __forceinline__ void sincos_d(double x, double& s, double& c) {
    const double TWO_OVER_PI = 0.63661977236758134308, PIO2_HI = 1.57079632679489655800e+00, PIO2_LO = 6.12323399573676603587e-17;
    const double kf = rint(x * TWO_OVER_PI);
    const double y = (x - kf * PIO2_HI) - kf * PIO2_LO;
    const double y2 = y * y;
    double sp = -1.0 / 1307674368000.0;
    sp = sp * y2 + 1.0 / 6227020800.0; sp = sp * y2 - 1.0 / 39916800.0; sp = sp * y2 + 1.0 / 362880.0; sp = sp * y2 - 1.0 / 5040.0;
    sp = sp * y2 + 1.0 / 120.0; sp = sp * y2 - 1.0 / 6.0; sp = sp * y2 + 1.0; sp *= y;
    double cp = 1.0 / 20922789888000.0;
    cp = cp * y2 - 1.0 / 87178291200.0; cp = cp * y2 + 1.0 / 479001600.0; cp = cp * y2 - 1.0 / 3628800.0; cp = cp * y2 + 1.0 / 40320.0;
    cp = cp * y2 - 1.0 / 720.0; cp = cp * y2 + 1.0 / 24.0; cp = cp * y2 - 0.5; cp = cp * y2 + 1.0;
    const int q = ((int)kf) & 3;
    s = (q == 0) ? sp : (q == 1) ? cp : (q == 2) ? -sp : -cp;
    c = (q == 0) ? cp : (q == 1) ? -sp : (q == 2) ? -cp : sp;
}
__device__ __forceinline__ void p0_s5_tables(const Params& p, int item4, unsigned char* lds) {
    const int item = item4 >> 2, qt = item4 & 3;
    const int di = item >> 5, g = item & 31, tid = tid_();
    float2* apw = (float2*)lds;
    float2* Bb = apw + 64 * 65;
    float2* Cc = Bb + 64 * 16;
    __syncthreads();
    if (tid < 64) {
        const int pidx = (di * 32 + g) * 64 + tid;
        float lr = p.in[10][pidx]; lr = lr < -1e-4f ? lr : -1e-4f;
        const float li = p.in[11][pidx];
        const float dt = expf(p.in[12][di * 32 + g]);
        const double mag = (double)expf(lr * dt);
        double sn, cs; sincos_d((double)li * (double)dt, sn, cs);
        const double are = mag * cs, aim = mag * sn;
        double pr = 1.0, pi_ = 0.0;
        for (int t = 0; t <= 64; ++t) {
            apw[tid * 65 + t] = make_float2((float)pr, (float)pi_);
            const double nr = pr * are - pi_ * aim, ni = pr * aim + pi_ * are; pr = nr; pi_ = ni;
        }
        if (qt == 0) ((float2*)(p.ws + WS_A64))[(di * 32 + g) * 64 + tid] = apw[tid * 65 + 64];
        const double den = (double)lr * lr + (double)li * li;
        const double fre = ((are - 1.0) * lr + aim * li) / den, fim = (aim * lr - (are - 1.0) * li) / den;
        for (int hh = 0; hh < 16; ++hh) {
            const double br = p.in[13][(size_t)pidx * 16 + hh], bi = p.in[14][(size_t)pidx * 16 + hh];
            Bb[tid * 16 + hh] = make_float2((float)(fre * br - fim * bi), (float)(fre * bi + fim * br));
        }
    }
    for (int e = tid; e < 1024; e += NTHREADS) {
        const size_t gi = ((size_t)(di * 32 + g) * 16) * 64 + e;
        Cc[e] = make_float2(p.in[15][gi], p.in[16][gi]);
    }
    __syncthreads();
    float* ktab = (float*)(p.ws + WS_KTAB) + (size_t)(di * 32 + g) * 64 * 256;
    for (int o = qt * 4096 + tid; o < (qt + 1) * 4096; o += NTHREADS) {
        const int tau = o >> 8, hh = (o >> 4) & 15, h2 = o & 15;
        float acc = 0.f;
        for (int pp = 0; pp < 64; ++pp) {
            const float2 a = apw[pp * 65 + tau], c = Cc[hh * 64 + pp], b = Bb[pp * 16 + h2];
            const float cr = c.x * a.x - c.y * a.y, ci = c.x * a.y + c.y * a.x;
            acc += cr * b.x - ci * b.y;
        }
        ktab[o] = acc;
    }
    bf16_t* ms5 = (bf16_t*)(p.ws + WS_MS5) + (size_t)g * 1280 * 1024;
    for (int t = qt * 4096 + tid; t < (qt + 1) * 4096; t += NTHREADS) {
        const int row = t >> 7, k8 = t & 127; const int ri = row >> 6, pp = row & 63, j = k8 >> 1, h0 = (k8 & 1) * 8;
        const float2 a = apw[pp * 65 + (di == 0 ? 63 - j : j)];
        float f[8];
#pragma unroll
        for (int e = 0; e < 8; ++e) { const float2 b = Bb[pp * 16 + h0 + e]; f[e] = ri == 0 ? (a.x * b.x - a.y * b.y) : (a.x * b.y + a.y * b.x); }
        *(uint4*)(ms5 + (size_t)(1024 + di * 128 + row) * 1024 + k8 * 8) = pack8(f);
    }
    bf16_t* o5 = (bf16_t*)(p.ws + WS_O5) + (size_t)g * 1024 * 256;
    for (int t = qt * 4096 + tid; t < (qt + 1) * 4096; t += NTHREADS) {
        const int n = t >> 4, q = t & 15; const int ri = q >> 3, p0 = (q & 7) * 8, i = n >> 4, hh = n & 15;
        float f[8];
#pragma unroll
        for (int e = 0; e < 8; ++e) {
            const float2 a = apw[(p0 + e) * 65 + (di == 0 ? i + 1 : 64 - i)], c = Cc[hh * 64 + p0 + e];
            f[e] = ri == 0 ? (c.x * a.x - c.y * a.y) : -(c.x * a.y + c.y * a.x);
        }
        *(uint4*)(o5 + (size_t)n * 256 + di * 128 + ri * 64 + p0) = pack8(f);
    }
}

template <bool SRC_BF16>
__device__ __forceinline__ void norm_mod_row(const void* __restrict__ srcv, const float* __restrict__ g, const float* __restrict__ shift,
                                             const float* __restrict__ scale, bf16_t* __restrict__ dst, int lane) {
    float4 v[4]; float ss = 0.f;
#pragma unroll
    for (int k = 0; k < 4; ++k) {
        if (SRC_BF16) { const uint2 q = *(const uint2*)((const bf16_t*)srcv + k * 256 + lane * 4); v[k] = make_float4(lo2f(q.x), hi2f(q.x), lo2f(q.y), hi2f(q.y)); }
        else v[k] = *(const float4*)((const float*)srcv + k * 256 + lane * 4);
        ss += v[k].x * v[k].x + v[k].y * v[k].y + v[k].z * v[k].z + v[k].w * v[k].w;
    }
    ss = wave_sum(ss);
    const float rs = rsqrtf(ss * (1.f / 1024.f) + 1e-6f);
#pragma unroll
    for (int k = 0; k < 4; ++k) {
        const int c = k * 256 + lane * 4;
        const float4 gg = *(const float4*)(g + c), sh = *(const float4*)(shift + c), sc = *(const float4*)(scale + c);
        uint2 o;
        o.x = pack2(v[k].x * rs * gg.x * (1.f + sc.x) + sh.x, v[k].y * rs * gg.y * (1.f + sc.y) + sh.y);
        o.y = pack2(v[k].z * rs * gg.z * (1.f + sc.z) + sh.z, v[k].w * rs * gg.w * (1.f + sc.w) + sh.w);
        *(uint2*)(dst + c) = o;
    }
}
__device__ __forceinline__ void norm_rows_item(const Params& p, int item, int l, const float* g, int js, bool from_inputs) {
    const int row = item * 8 + (tid_() >> 6), lane = tid_() & 63;
    bf16_t* dst = (bf16_t*)(p.ws + WS_ACT) + (size_t)row * 1024;
    if (from_inputs) norm_mod_row<false>(row < SEQ ? p.in[0] + (size_t)row * 1024 : p.in[2] + (size_t)(row - SEQ) * 1024, g, modp(p, l, row, js), modp(p, l, row, js + 1), dst, lane);
    else norm_mod_row<true>((const bf16_t*)(p.ws + WS_H) + (size_t)row * 1024, g, modp(p, l, row, js), modp(p, l, row, js + 1), dst, lane);
}
__device__ __forceinline__ void s5_mintra_item(const Params& p, int item) {
    const int g = item >> 6, i = item & 63;
    const float* kt0 = (const float*)(p.ws + WS_KTAB) + (size_t)(0 * 32 + g) * 64 * 256;
    const float* kt1 = (const float*)(p.ws + WS_KTAB) + (size_t)(1 * 32 + g) * 64 * 256;
    const float* dsk = p.in[17] + g * 16;
    bf16_t* ms5 = (bf16_t*)(p.ws + WS_MS5) + (size_t)g * 1280 * 1024;
    for (int t = tid_(); t < 16 * 128; t += NTHREADS) {
        const int hh = t >> 7, k8 = t & 127, j = k8 >> 1, h0 = (k8 & 1) * 8;
        float f[8];
        if (j < i) { const float* s = kt0 + ((i - j) * 16 + hh) * 16 + h0;
#pragma unroll
            for (int e = 0; e < 8; ++e) f[e] = s[e]; }
        else if (j > i) { const float* s = kt1 + ((j - i) * 16 + hh) * 16 + h0;
#pragma unroll
            for (int e = 0; e < 8; ++e) f[e] = s[e]; }
        else { const float* s0 = kt0 + hh * 16 + h0; const float* s1 = kt1 + hh * 16 + h0;
#pragma unroll
            for (int e = 0; e < 8; ++e) f[e] = s0[e] + s1[e] + ((h0 + e) == hh ? dsk[hh] : 0.f); }
        *(uint4*)(ms5 + (size_t)(i * 16 + hh) * 1024 + k8 * 8) = pack8(f);
    }
}

struct EpiEvenIn {
    bf16_t* pa; bf16_t* ug;
    __device__ __forceinline__ void operator()(int row, int col, const float* v) const {
        if (col < 1536) *(uint4*)(pa + (size_t)row * 1536 + col) = pack8(v);
        else { const int c2 = col - 1536; *(uint4*)(ug + ((size_t)(c2 >> 4) * NCH + (row >> 6)) * 1024 + (row & 63) * 16 + (c2 & 15)) = pack8(v); }
    }
};
struct EpiS5Local {
    bf16_t* yl; float* lst; int g;
    __device__ __forceinline__ void operator()(int row, int col, const float* v) const {
        if (col < 1024) *(uint4*)(yl + (size_t)(row * 64 + (col >> 4)) * 512 + g * 16 + (col & 15)) = pack8(v);
        else { float* d = lst + ((size_t)g * NCH + row) * 256 + (col - 1024);
               *(float4*)d = make_float4(v[0], v[1], v[2], v[3]); *(float4*)(d + 4) = make_float4(v[4], v[5], v[6], v[7]); }
    }
};
struct EpiS5Out {
    const bf16_t* yl; bf16_t* gs; int g;
    __device__ __forceinline__ void operator()(int row, int col, const float* v) const {
        const size_t o = (size_t)(row * 64 + (col >> 4)) * 512 + g * 16 + (col & 15);
        float y[8]; unpack8(*(const uint4*)(yl + o), y);
        float f[8];
#pragma unroll
        for (int e = 0; e < 8; ++e) f[e] = gelu_tanh(v[e] + y[e]);
        *(uint4*)(gs + o) = pack8(f);
    }
};
struct EpiGlu {
    const bf16_t* gs; const float* b; bf16_t* cb;
    __device__ __forceinline__ void operator()(int row, int col, const float* v) const {
        float g[8], f[8]; unpack8(*(const uint4*)(gs + (size_t)row * 512 + col), g);
#pragma unroll
        for (int e = 0; e < 8; ++e) f[e] = g[e] * sigmoidf_(v[e] + b[col + e]);
        *(uint4*)(cb + (size_t)row * 1024 + 512 + col) = pack8(f);
    }
};
struct EpiResid {
    const float* x; const float* ctx; bf16_t* hbuf; const float* mod; int l; bool from_inputs;
    __device__ __forceinline__ void operator()(int row, int col, const float* v) const {
        bf16_t* h = hbuf + (size_t)row * 1024 + col;
        float b[8];
        if (from_inputs) {
            const float* bp = row < SEQ ? x + (size_t)row * 1024 + col : ctx + (size_t)(row - SEQ) * 1024 + col;
            const float4 b0 = *(const float4*)bp, b1 = *(const float4*)(bp + 4);
            b[0] = b0.x; b[1] = b0.y; b[2] = b0.z; b[3] = b0.w; b[4] = b1.x; b[5] = b1.y; b[6] = b1.z; b[7] = b1.w;
        } else unpack8(*(const uint4*)h, b);
        const float* mp = mod + ((l * 2 + (row >= SEQ ? 1 : 0)) * 6 + 2) * 1024 + col;
        const float4 m0 = *(const float4*)mp, m1 = *(const float4*)(mp + 4);
        const float o[8] = {b[0] + m0.x * v[0], b[1] + m0.y * v[1], b[2] + m0.z * v[2], b[3] + m0.w * v[3], b[4] + m1.x * v[4], b[5] + m1.y * v[5], b[6] + m1.z * v[6], b[7] + m1.w * v[7]};
        *(uint4*)h = pack8(o);
    }
};
struct EpiBf16 {
    bf16_t* dst; int ld;
    __device__ __forceinline__ void operator()(int row, int col, const float* v) const { *(uint4*)(dst + (size_t)row * ld + col) = pack8(v); }
};
struct EpiScore {
    unsigned short* dst; int coff;
    __device__ __forceinline__ void operator()(int row, int col, const float* v) const {
        typedef _Float16 h2 __attribute__((ext_vector_type(2)));
        u32x4 o;
#pragma unroll
        for (int e = 0; e < 4; ++e) { const h2 hv = {(_Float16)v[2 * e], (_Float16)v[2 * e + 1]}; o[e] = __builtin_bit_cast(unsigned, hv); }
        *(u32x4*)(dst + (size_t)row * 2048 + coff + col) = o;
    }
};
struct EpiOddIn {
    bf16_t* qkvr; bf16_t* z; float* ab;
    __device__ __forceinline__ void operator()(int row, int col, const float* v) const {
        if (col < 3072) *(uint4*)(qkvr + (size_t)row * 3072 + col) = pack8(v);
        else if (col < 4096) *(uint4*)(z + (size_t)row * 1024 + (col - 3072)) = pack8(v);
        else { float* d = ab + (size_t)row * 32 + (col - 4096); *(float4*)d = make_float4(v[0], v[1], v[2], v[3]); *(float4*)(d + 4) = make_float4(v[4], v[5], v[6], v[7]); }
    }
};

__device__ __forceinline__ void s5_scan(const Params& p) {
    const int gt = blockIdx.x * NTHREADS + tid_();
    if (gt >= 4096) return;
    const int di = gt >> 11, g = (gt >> 6) & 31, pp = gt & 63;
    const float2 a = ((const float2*)(p.ws + WS_A64))[(di * 32 + g) * 64 + pp];
    const float* lst = (const float*)(p.ws + WS_LST) + (size_t)g * NCH * 256 + di * 128 + pp;
    bf16_t* a5 = (bf16_t*)(p.ws + WS_A5) + (size_t)g * NCH * 256 + di * 128 + pp;
    float sr = 0.f, si = 0.f;
    for (int s0 = 0; s0 < NCH; s0 += 4) {
        int c[4]; float lr[4], li[4];
#pragma unroll
        for (int u = 0; u < 4; ++u) {
            const int s = s0 + u;
            c[u] = di == 0 ? (s < 4 ? NCH_LAT + s : s - 4) : (s < 4 ? NCH - 1 - s : NCH - 1 - s);
            lr[u] = lst[(size_t)c[u] * 256]; li[u] = lst[(size_t)c[u] * 256 + 64];
        }
#pragma unroll
        for (int u = 0; u < 4; ++u) {
            a5[(size_t)c[u] * 256] = f2bf(sr); a5[(size_t)c[u] * 256 + 64] = f2bf(si);
            const float nr = a.x * sr - a.y * si + lr[u], ni = a.x * si + a.y * sr + li[u]; sr = nr; si = ni;
        }
    }
}

__device__ __forceinline__ void even_conv_item(const Params& p, int item) {
    const bf16_t* pa = (const bf16_t*)(p.ws + WS_PA); bf16_t* cb = (bf16_t*)(p.ws + WS_CB);
    const float* cw = p.in[9];
    for (int t = tid_(); t < 64 * 64; t += NTHREADS) {
        const int row = item * 64 + (t >> 6), c0 = (t & 63) * 8;
        bool hasp, hasn;
        if (row < SEQ) { hasp = (row & 63) != 0; hasn = (row & 63) != 63; } else { hasp = row != SEQ; hasn = row != R - 1; }
        float m[3][8];
#pragma unroll
        for (int d = 0; d < 3; ++d) {
            const bool ok = d == 1 || (d == 0 ? hasp : hasn);
            if (ok) {
                const bf16_t* rp = pa + (size_t)(row + d - 1) * 1536 + c0;
                float u[8], gi[8]; unpack8(*(const uint4*)rp, u); unpack8(*(const uint4*)(rp + 512), gi);
#pragma unroll
                for (int e = 0; e < 8; ++e) m[d][e] = u[e] * gi[e];
            } else {
#pragma unroll
                for (int e = 0; e < 8; ++e) m[d][e] = 0.f;
            }
        }
        float go[8], f[8]; unpack8(*(const uint4*)(pa + (size_t)row * 1536 + 1024 + c0), go);
#pragma unroll
        for (int e = 0; e < 8; ++e) f[e] = go[e] * (m[0][e] * cw[c0 + e] + m[1][e] * cw[512 + c0 + e] + m[2][e] * cw[1024 + c0 + e]);
        *(uint4*)(cb + (size_t)row * 1024 + c0) = pack8(f);
    }
}

__device__ __forceinline__ unsigned ord_enc(float v) { const unsigned u = __float_as_uint(v); return (u & 0x80000000u) ? ~u : (u | 0x80000000u); }
__device__ __forceinline__ float ord_dec(unsigned e) { const unsigned u = (e & 0x80000000u) ? (e & 0x7FFFFFFFu) : ~e; return __uint_as_float(u); }
#define TOP_INSERT(key) { unsigned x_ = (key); _Pragma("unroll") for (int k_ = 0; k_ < 16; ++k_) { const unsigned hi_ = top[k_] > x_ ? top[k_] : x_; x_ = top[k_] > x_ ? x_ : top[k_]; top[k_] = hi_; } }
__device__ __forceinline__ void peer_route_item(const Params& p, int item, int nrows, unsigned char* lds) {
    const int tid = tid_();
    const int row = item * 64 + (tid >> 3), head = tid & 7;
    unsigned* sIdx = (unsigned*)lds;
    __syncthreads();
    if (row < nrows) {
        const unsigned short* sc = (const unsigned short*)(p.ws + WS_SC) + (size_t)row * 2048 + head * 256;
        float fa[16], fb[16];
        {
#define CE_DESC(a_, b_) { const unsigned hi_ = (a_) > (b_) ? (a_) : (b_); const unsigned lo_ = (a_) > (b_) ? (b_) : (a_); (a_) = hi_; (b_) = lo_; }
            unsigned topa[16], topb[16];
#pragma unroll 1
            for (int blk = 0; blk < 8; ++blk) {
                unsigned ka[16], kb[16];
#pragma unroll
                for (int c2 = 0; c2 < 2; ++c2) {
                    const int c = blk * 2 + c2;
                    const uint4 qa = *(const uint4*)(sc + c * 8), qb = *(const uint4*)(sc + 128 + c * 8);
                    const unsigned wa[4] = {qa.x, qa.y, qa.z, qa.w}, wb[4] = {qb.x, qb.y, qb.z, qb.w};
#pragma unroll
                    for (int e = 0; e < 8; ++e) {
                        const unsigned short ha = (unsigned short)((e & 1) ? (wa[e >> 1] >> 16) : (wa[e >> 1] & 0xFFFFu));
                        const unsigned short hb = (unsigned short)((e & 1) ? (wb[e >> 1] >> 16) : (wb[e >> 1] & 0xFFFFu));
                        ka[c2 * 8 + e] = (ord_enc((float)__builtin_bit_cast(_Float16, ha)) & ~0x7Fu) | (unsigned)(c * 8 + e);
                        kb[c2 * 8 + e] = (ord_enc((float)__builtin_bit_cast(_Float16, hb)) & ~0x7Fu) | (unsigned)(c * 8 + e);
                    }
                }
#pragma unroll
                for (int k = 2; k <= 16; k <<= 1) {
#pragma unroll
                    for (int j = k >> 1; j > 0; j >>= 1) {
#pragma unroll
                        for (int i = 0; i < 16; ++i) {
                            const int l2 = i ^ j;
                            if (l2 > i) {
                                if ((i & k) == 0) { CE_DESC(ka[i], ka[l2]); CE_DESC(kb[i], kb[l2]); }
                                else { CE_DESC(ka[l2], ka[i]); CE_DESC(kb[l2], kb[i]); }
                            }
                        }
                    }
                }
                if (blk == 0) {
#pragma unroll
                    for (int i = 0; i < 16; ++i) { topa[i] = ka[i]; topb[i] = kb[i]; }
                } else {
#pragma unroll
                    for (int i = 0; i < 16; ++i) { topa[i] = topa[i] > ka[15 - i] ? topa[i] : ka[15 - i]; topb[i] = topb[i] > kb[15 - i] ? topb[i] : kb[15 - i]; }
#pragma unroll
                    for (int j = 8; j > 0; j >>= 1) {
#pragma unroll
                        for (int i = 0; i < 16; ++i) { const int l2 = i ^ j; if (l2 > i) { CE_DESC(topa[i], topa[l2]); CE_DESC(topb[i], topb[l2]); } }
                    }
                }
            }
#undef CE_DESC
#pragma unroll
            for (int k = 0; k < 16; ++k) {
                sIdx[k * NTHREADS + tid] = topa[k] & 0x7Fu; sIdx[(16 + k) * NTHREADS + tid] = topb[k] & 0x7Fu;
                fa[k] = ord_dec(topa[k] & ~0x7Fu); fb[k] = ord_dec(topb[k] & ~0x7Fu);
            }
        }
        unsigned top[16];
#pragma unroll
        for (int k = 0; k < 16; ++k) top[k] = 0u;
#pragma unroll
        for (int i = 0; i < 16; ++i) {
#pragma unroll
            for (int j = 0; j < 16; ++j) {
                if ((i + 1) * (j + 1) <= 16) { TOP_INSERT((ord_enc(fa[i] + fb[j]) & ~0xFFu) | (unsigned)(i * 16 + j)); }
            }
        }
        float ev[16]; float m = ord_dec(top[0] & ~0xFFu), sum = 0.f;
        int* idxo = (int*)(p.ws + WS_IDX) + (size_t)row * 128 + head * 16;
        float* go = (float*)(p.ws + WS_GATE) + (size_t)row * 128 + head * 16;
#pragma unroll
        for (int k = 0; k < 16; ++k) { ev[k] = __expf(ord_dec(top[k] & ~0xFFu) - m); sum += ev[k]; }
        const float inv = 1.f / sum;
#pragma unroll
        for (int k = 0; k < 16; ++k) {
            const unsigned pos = top[k] & 0xFFu;
            const unsigned ia = sIdx[(pos >> 4) * NTHREADS + tid], ib = sIdx[(16 + (pos & 15)) * NTHREADS + tid];
            idxo[k] = (int)(ia * 128u + ib); go[k] = ev[k] * inv;
        }
    }
}

__device__ __forceinline__ void peer_gather_experts(const Params& p, int row, int h_beg, int h_end, int e_beg, int e_end, float (&y)[16]) {
    const int lane = tid_() & 63;
    const bf16_t* xr = (const bf16_t*)(p.ws + WS_ACT) + (size_t)row * 1024 + lane * 16;
    const unsigned char* PE = p.ws + WS_PUV + lane * 24;
    const float* psc = (const float*)(p.ws + WS_PSC);
    float x[16];
    unpack8(*(const uint4*)xr, x); unpack8(*(const uint4*)(xr + 8), x + 8);
    const int* idxp = (const int*)(p.ws + WS_IDX) + (size_t)row * 128; const float* gp = (const float*)(p.ws + WS_GATE) + (size_t)row * 128;
#pragma unroll 1
    for (int half = h_beg; half < h_end; ++half) {
        const int myidx = idxp[half * 64 + lane];
        const float myus = psc[myidx], mygv = gp[half * 64 + lane] * psc[16384 + myidx];
        U6 ea[4], eb[4];
#define PG_LOAD(arr, e0_) do { _Pragma("unroll") for (int u_ = 0; u_ < 4; ++u_) { const int id_ = __builtin_amdgcn_readlane(myidx, (e0_) + u_); arr[u_] = *(const U6*)(PE + (size_t)id_ * PREC); } } while (0)
#define PG_PROC(arr, e0_) do { _Pragma("unroll") for (int u_ = 0; u_ < 4; ++u_) { \
            const v6u_t pk_ = {arr[u_].a, arr[u_].b, arr[u_].c, arr[u_].d, arr[u_].e, arr[u_].f}; \
            const v32f_t f_ = __builtin_amdgcn_cvt_scalef32_pk32_f32_fp6(pk_, 1.0f); \
            float a0_ = 0.f, a1_ = 0.f; \
            _Pragma("unroll") for (int e_ = 0; e_ < 16; e_ += 2) { a0_ += f_[e_] * x[e_]; a1_ += f_[e_ + 1] * x[e_ + 1]; } \
            const float dsum_ = wave_sum_dpp(a0_ + a1_); \
            const float us_ = __int_as_float(__builtin_amdgcn_readlane(__float_as_int(myus), (e0_) + u_)); \
            const float gv_ = __int_as_float(__builtin_amdgcn_readlane(__float_as_int(mygv), (e0_) + u_)); \
            const float coef_ = gelu_tanh(dsum_ * us_) * gv_; \
            _Pragma("unroll") for (int e_ = 0; e_ < 16; ++e_) y[e_] += coef_ * f_[16 + e_]; \
            __builtin_amdgcn_sched_barrier(0); } } while (0)
        PG_LOAD(ea, e_beg);
#pragma unroll 1
        for (int e0 = e_beg; e0 < e_end; e0 += 8) {
            PG_LOAD(eb, e0 + 4);
            PG_PROC(ea, e0);
            if (e0 + 8 < e_end) PG_LOAD(ea, e0 + 8);
            PG_PROC(eb, e0 + 4);
        }
#undef PG_LOAD
#undef PG_PROC
    }
}
__device__ __forceinline__ void peer_gather_finish(const Params& p, int row, int l, bool last, const float (&y)[16]) {
    const int lane = tid_() & 63;
    bf16_t* h = (bf16_t*)(p.ws + WS_H) + (size_t)row * 1024 + lane * 16;
    const float* m5 = modp(p, l, row, 5) + lane * 16;
    float hv[16];
    unpack8(*(const uint4*)h, hv); unpack8(*(const uint4*)(h + 8), hv + 8);
#pragma unroll
    for (int q = 0; q < 4; ++q) {
        const float4 g0 = *(const float4*)(m5 + q * 4);
        hv[q * 4 + 0] += g0.x * y[q * 4 + 0]; hv[q * 4 + 1] += g0.y * y[q * 4 + 1];
        hv[q * 4 + 2] += g0.z * y[q * 4 + 2]; hv[q * 4 + 3] += g0.w * y[q * 4 + 3];
    }
    if (!last) {
        *(uint4*)h = pack8(hv); *(uint4*)(h + 8) = pack8(hv + 8);
        float ss = 0.f;
#pragma unroll
        for (int e = 0; e < 16; ++e) ss += hv[e] * hv[e];
        ss = wave_sum(ss);
        const float rs = rsqrtf(ss * (1.f / 1024.f) + 1e-6f);
        const float* g1 = p.in[6] + (l + 1) * 1024 + lane * 16; const float* sh = modp(p, l + 1, row, 0) + lane * 16; const float* sc = modp(p, l + 1, row, 1) + lane * 16;
        float o[16];
#pragma unroll
        for (int q = 0; q < 4; ++q) {
            const float4 gg = *(const float4*)(g1 + q * 4), s4 = *(const float4*)(sh + q * 4), c4 = *(const float4*)(sc + q * 4);
            o[q * 4 + 0] = hv[q * 4 + 0] * rs * gg.x * (1.f + c4.x) + s4.x; o[q * 4 + 1] = hv[q * 4 + 1] * rs * gg.y * (1.f + c4.y) + s4.y;
            o[q * 4 + 2] = hv[q * 4 + 2] * rs * gg.z * (1.f + c4.z) + s4.z; o[q * 4 + 3] = hv[q * 4 + 3] * rs * gg.w * (1.f + c4.w) + s4.w;
        }
        bf16_t* act = (bf16_t*)(p.ws + WS_ACT) + (size_t)row * 1024 + lane * 16;
        *(uint4*)act = pack8(o); *(uint4*)(act + 8) = pack8(o + 8);
    } else {
        float ss = 0.f;
#pragma unroll
        for (int e = 0; e < 16; ++e) ss += hv[e] * hv[e];
        ss = wave_sum(ss);
        const float rs = rsqrtf(ss * (1.f / 1024.f) + 1e-6f);
        const float* fg = p.in[31] + lane * 16; float* o = p.out + (size_t)row * 1024 + lane * 16;
#pragma unroll
        for (int q = 0; q < 4; ++q) {
            const float4 g0 = *(const float4*)(fg + q * 4);
            *(float4*)(o + q * 4) = make_float4(hv[q * 4 + 0] * rs * g0.x, hv[q * 4 + 1] * rs * g0.y, hv[q * 4 + 2] * rs * g0.z, hv[q * 4 + 3] * rs * g0.w);
        }
    }
}

__device__ __forceinline__ void peer_gather_row(const Params& p, int row, int l, bool last) {
    float y[16];
#pragma unroll
    for (int e = 0; e < 16; ++e) y[e] = 0.f;
    peer_gather_experts(p, row, 0, 2, 0, 64, y);
    peer_gather_finish(p, row, l, last, y);
}
__device__ __forceinline__ void peer_gather_row_split(const Params& p, int row, int l, unsigned char* lds) {
    const int tid = tid_(), lane = tid & 63, wave = tid >> 6;
    float y[16];
#pragma unroll
    for (int e = 0; e < 16; ++e) y[e] = 0.f;
    peer_gather_experts(p, row, wave >> 2, (wave >> 2) + 1, 16 * (wave & 3), 16 * (wave & 3) + 16, y);
    float* part = (float*)lds;
    __syncthreads();
#pragma unroll
    for (int q = 0; q < 4; ++q) *(float4*)(part + wave * 1024 + lane * 16 + q * 4) = make_float4(y[q * 4 + 0], y[q * 4 + 1], y[q * 4 + 2], y[q * 4 + 3]);
    __syncthreads();
    if (wave == 0) {
#pragma unroll
        for (int w = 1; w < 8; ++w)
#pragma unroll
            for (int q = 0; q < 4; ++q) { const float4 v = *(const float4*)(part + w * 1024 + lane * 16 + q * 4); y[q * 4 + 0] += v.x; y[q * 4 + 1] += v.y; y[q * 4 + 2] += v.z; y[q * 4 + 3] += v.w; }
        peer_gather_finish(p, row, l, false, y);
    }
}

__device__ __forceinline__ void gdn_prep_item(const Params& p, int item) {
    const int tid = tid_();
    const int r0 = item * 16;
    if (tid < 384) {
        const int part = tid >> 7, ch = tid * 8;
        const bf16_t* src = (const bf16_t*)(p.ws + WS_QKVR) + ch;
        bf16_t* dst = (bf16_t*)(p.ws + (part == 0 ? WS_QN : part == 1 ? WS_KN : WS_VN)) + (ch & 1023);
        const float* cw = p.in[22] + ch;
        float w0[8], w1[8], w2[8];
#pragma unroll
        for (int e = 0; e < 8; ++e) { w0[e] = cw[e]; w1[e] = cw[3072 + e]; w2[e] = cw[6144 + e]; }
        bool hasp0, hasn15;
        if (r0 < SEQ) { hasp0 = (r0 & 63) != 0; hasn15 = ((r0 + 15) & 63) != 63; } else { hasp0 = r0 != SEQ; hasn15 = (r0 + 15) != R - 1; }
        u32x4 rw[18];
#pragma unroll
        for (int i = 0; i < 18; ++i) {
            const bool ok = (i == 0) ? hasp0 : (i == 17) ? hasn15 : true;
            rw[i] = ok ? *(const u32x4*)(src + (size_t)(r0 + i - 1) * 3072) : (u32x4){0u, 0u, 0u, 0u};
        }
#pragma unroll
        for (int i = 0; i < 16; ++i) {
            const u32x4 a = rw[i], bq = rw[i + 1], cq = rw[i + 2];
            const float xm[8] = {lo2f(a.x), hi2f(a.x), lo2f(a.y), hi2f(a.y), lo2f(a.z), hi2f(a.z), lo2f(a.w), hi2f(a.w)};
            const float x0[8] = {lo2f(bq.x), hi2f(bq.x), lo2f(bq.y), hi2f(bq.y), lo2f(bq.z), hi2f(bq.z), lo2f(bq.w), hi2f(bq.w)};
            const float xp[8] = {lo2f(cq.x), hi2f(cq.x), lo2f(cq.y), hi2f(cq.y), lo2f(cq.z), hi2f(cq.z), lo2f(cq.w), hi2f(cq.w)};
            float f[8], ss = 0.f;
#pragma unroll
            for (int e = 0; e < 8; ++e) { const float v = siluf_(xm[e] * w0[e] + x0[e] * w1[e] + xp[e] * w2[e]); f[e] = v; ss += v * v; }
            if (part < 2) {
                ss += __shfl_xor(ss, 1, 64); ss += __shfl_xor(ss, 2, 64); ss += __shfl_xor(ss, 4, 64); ss += __shfl_xor(ss, 8, 64);
                const float sc = rsqrtf(ss + 1e-6f) * (part == 0 ? 0.08838834764831845f : 1.f);
#pragma unroll
                for (int e = 0; e < 8; ++e) f[e] *= sc;
            }
            *(uint4*)(dst + (size_t)(r0 + i) * 1024) = pack8(f);
        }
    } else if (tid < 384 + 64) {
        const int l = tid - 384;
#pragma unroll
        for (int q = 0; q < 4; ++q) {
            const int v = l * 4 + q, i = v >> 4, dh = v & 15, row = r0 + i;
            const float* ab = (const float*)(p.ws + WS_AB) + (size_t)row * 32;
            const float a = ab[dh] + p.in[24][dh], b = ab[16 + dh];
            const float sp = a > 20.f ? a : log1pf(__expf(a));
            ((float*)(p.ws + WS_GG))[(size_t)dh * R + row] = -__expf(p.in[23][dh]) * sp;
            ((float*)(p.ws + WS_BETA))[(size_t)dh * R + row] = sigmoidf_(b);
        }
    }
}

constexpr int GU_LDQ = 136, GU_LDT = 72, GU_LDA = 68;
constexpr int GU_SQ = 0, GU_SK = 17408, GU_SKB = 34816, GU_SVBT = 52224, GU_SKGT = 70656, GU_SA = 89088, GU_SAT = 106496, GU_ST = 123904, GU_SG = 133120;
__device__ __forceinline__ int perm_slot64(int pos) { return 32 * (pos >> 5) + 8 * ((pos >> 2) & 3) + 4 * ((pos >> 4) & 1) + (pos & 3); }
struct GuPre { u32x4 q[2], k[2], v[2]; float g, beta; };
__device__ __forceinline__ void gu_prefetch(const Params& p, int u, GuPre& pre) {
    const int tid = tid_(), lane = tid & 63;
    const int dh = u / NCH, c = u % NCH, dir = dh >> 3, head = dh & 7;
#pragma unroll
    for (int q = 0; q < 2; ++q) {
        const int t = tid + q * NTHREADS, i = t >> 4, d8 = (t & 15) * 8;
        const size_t ro = (size_t)(c * 64 + (dir ? 63 - i : i)) * 1024 + head * 128 + d8;
        pre.q[q] = *(const u32x4*)((const bf16_t*)(p.ws + WS_QN) + ro);
        pre.k[q] = *(const u32x4*)((const bf16_t*)(p.ws + WS_KN) + ro);
        pre.v[q] = *(const u32x4*)((const bf16_t*)(p.ws + WS_VN) + ro);
    }
    const int row = c * 64 + (dir ? 63 - lane : lane);
    pre.g = ((const float*)(p.ws + WS_GG))[(size_t)dh * R + row];
    pre.beta = ((const float*)(p.ws + WS_BETA))[(size_t)dh * R + row];
}
__device__ __forceinline__ void gdn_unit(const Params& p, int u, int u_next, GuPre& pre, unsigned char* lds) {
    const int tid = tid_(), lane = tid & 63, wave = tid >> 6;
    const int dh = u / NCH, c = u % NCH, dir = dh >> 3, head = dh & 7;
    bf16_t* sQ = (bf16_t*)(lds + GU_SQ); bf16_t* sK = (bf16_t*)(lds + GU_SK); bf16_t* sKB = (bf16_t*)(lds + GU_SKB);
    bf16_t* sVBT = (bf16_t*)(lds + GU_SVBT); bf16_t* sKGT = (bf16_t*)(lds + GU_SKGT);
    float* sA = (float*)(lds + GU_SA); float* sAT = (float*)(lds + GU_SAT); bf16_t* sT = (bf16_t*)(lds + GU_ST);
    float* sG = (float*)(lds + GU_SG); float* sBeta = sG + 64;
    __syncthreads();
    if (wave == 0) {
        float g = pre.g;
#pragma unroll
        for (int o = 1; o < 64; o <<= 1) { const float t = __shfl_up(g, o, 64); if (lane >= o) g += t; }
        sG[lane] = g; sBeta[lane] = pre.beta;
        ((float*)(p.ws + WS_GC))[(size_t)u * 64 + lane] = g;
    }
    __syncthreads();
#pragma unroll
    for (int qq = 0; qq < 2; ++qq) {
        const int t = tid + qq * NTHREADS, i = t >> 4, d8 = (t & 15) * 8;
        const u32x4 q = pre.q[qq], k = pre.k[qq], v = pre.v[qq];
        const float beta = sBeta[i], eg = __expf(sG[i]);
        const float kf[8] = {lo2f(k.x), hi2f(k.x), lo2f(k.y), hi2f(k.y), lo2f(k.z), hi2f(k.z), lo2f(k.w), hi2f(k.w)};
        const float vf[8] = {lo2f(v.x), hi2f(v.x), lo2f(v.y), hi2f(v.y), lo2f(v.z), hi2f(v.z), lo2f(v.w), hi2f(v.w)};
        float kb[8];
#pragma unroll
        for (int e = 0; e < 8; ++e) kb[e] = kf[e] * beta;
        const u32x4 kbp = {pack2(kb[0], kb[1]), pack2(kb[2], kb[3]), pack2(kb[4], kb[5]), pack2(kb[6], kb[7])};
        *(u32x4*)(sQ + i * GU_LDQ + d8) = q; *(u32x4*)(sK + i * GU_LDQ + d8) = k; *(u32x4*)(sKB + i * GU_LDQ + d8) = kbp;
        const int isw = i ^ (((d8 >> 3) & 7) << 3);
#pragma unroll
        for (int e = 0; e < 8; ++e) { sVBT[(d8 + e) * GU_LDT + isw] = f2bf(vf[e] * beta); sKGT[(d8 + e) * GU_LDT + isw] = f2bf(kb[e] * eg); }
    }
    if (u_next < NUNITS) gu_prefetch(p, u_next, pre);
    __syncthreads();
    {
        const int mat = wave >> 2, mt = wave & 3, rr = lane & 15, q4 = lane >> 4;
        const bf16_t* sX = mat ? sQ : sKB;
        f32x4 acc[4];
#pragma unroll
        for (int nt = 0; nt < 4; ++nt) acc[nt] = (f32x4){0.f, 0.f, 0.f, 0.f};
#pragma unroll
        for (int kk = 0; kk < 4; ++kk) {
            const bf16x8 a = *(const bf16x8*)(sX + (16 * mt + rr) * GU_LDQ + kk * 32 + 8 * q4);
#pragma unroll
            for (int nt = 0; nt < 4; ++nt) {
                const bf16x8 b = *(const bf16x8*)(sK + (16 * nt + rr) * GU_LDQ + kk * 32 + 8 * q4);
                acc[nt] = __builtin_amdgcn_mfma_f32_16x16x32_bf16(a, b, acc[nt], 0, 0, 0);
            }
        }
        float* dstm = mat ? sAT : sA;
#pragma unroll
        for (int nt = 0; nt < 4; ++nt) {
            const int j = 16 * nt + rr; const float gj = sG[j];
#pragma unroll
            for (int jj = 0; jj < 4; ++jj) {
                const int i = 16 * mt + 4 * q4 + jj;
                const bool keep = mat ? (j <= i) : (j < i);
                dstm[i * GU_LDA + j] = keep ? acc[nt][jj] * __expf(sG[i] - gj) : 0.f;
            }
        }
    }
    __syncthreads();
    float* sD = (float*)(lds + GU_SQ);
    if (wave < 4) {
        if (lane < 16) {
            float d[16];
#pragma unroll
            for (int i = 0; i < 16; ++i) {
                float a = (i == lane) ? 1.f : 0.f;
                const float* Ai = sA + (16 * wave + i) * GU_LDA + 16 * wave;
#pragma unroll
                for (int j = 0; j < i; ++j) a -= Ai[j] * d[j];
                d[i] = a;
                sD[(wave * 16 + i) * 16 + lane] = a;
            }
        }
    } else {
        bf16_t* att = (bf16_t*)(p.ws + WS_ATT) + (size_t)u * 64 * 64;
        for (int t = tid - 256; t < 512; t += 256) {
            const int i = t >> 3, kk2 = (t >> 2) & 1, qq = t & 3;
            const float4 lo = *(const float4*)(sAT + i * GU_LDA + 32 * kk2 + 4 * qq), hi = *(const float4*)(sAT + i * GU_LDA + 32 * kk2 + 16 + 4 * qq);
            uint4 o; o.x = pack2(lo.x, lo.y); o.y = pack2(lo.z, lo.w); o.z = pack2(hi.x, hi.y); o.w = pack2(hi.z, hi.w);
            *(uint4*)(att + i * 64 + 32 * kk2 + 8 * qq) = o;
        }
    }
    __syncthreads();
    if (wave < 4) {
        const int rr = lane & 15, q4 = lane >> 4;
        f32x4 Tt[4];
#pragma unroll
        for (int m = 0; m < 4; ++m) Tt[m] = (f32x4){0.f, 0.f, 0.f, 0.f};
#pragma unroll
        for (int b = 0; b < 4; ++b) {
            if (b >= wave) {
                f32x4 X = (f32x4){0.f, 0.f, 0.f, 0.f};
#pragma unroll
                for (int kk = 0; kk < 2; ++kk) {
                    if (2 * kk < b) {
                        const float* Ar = sA + (16 * b + rr) * GU_LDA + 32 * kk + 4 * q4;
                        const float4 lo = *(const float4*)Ar;
                        float4 hi = make_float4(0.f, 0.f, 0.f, 0.f);
                        if (2 * kk + 1 < b) hi = *(const float4*)(Ar + 16);
                        const u32x4 ap = {pack2(lo.x, lo.y), pack2(lo.z, lo.w), pack2(hi.x, hi.y), pack2(hi.z, hi.w)};
                        const u32x4 bp = {pack2(Tt[2 * kk][0], Tt[2 * kk][1]), pack2(Tt[2 * kk][2], Tt[2 * kk][3]),
                                          pack2(Tt[2 * kk + 1][0], Tt[2 * kk + 1][1]), pack2(Tt[2 * kk + 1][2], Tt[2 * kk + 1][3])};
                        X = __builtin_amdgcn_mfma_f32_16x16x32_bf16(__builtin_bit_cast(bf16x8, ap), __builtin_bit_cast(bf16x8, bp), X, 0, 0, 0);
                    }
                }
                float y[4];
#pragma unroll
                for (int jj = 0; jj < 4; ++jj) y[jj] = ((b == wave && 4 * q4 + jj == rr) ? 1.f : 0.f) - X[jj];
                const float4 dv4 = *(const float4*)(sD + (b * 16 + rr) * 16 + 4 * q4);
                const u32x4 ap = {pack2(dv4.x, dv4.y), pack2(dv4.z, dv4.w), 0u, 0u};
                const u32x4 bp = {pack2(y[0], y[1]), pack2(y[2], y[3]), 0u, 0u};
                const f32x4 z4 = (f32x4){0.f, 0.f, 0.f, 0.f};
                Tt[b] = __builtin_amdgcn_mfma_f32_16x16x32_bf16(__builtin_bit_cast(bf16x8, ap), __builtin_bit_cast(bf16x8, bp), z4, 0, 0, 0);
            }
#pragma unroll
            for (int jj = 0; jj < 4; ++jj) sT[(16 * b + 4 * q4 + jj) * GU_LDT + 16 * wave + rr] = f2bf(Tt[b][jj]);
        }
    }
    __syncthreads();
    {
        const int rr = lane & 15, q4 = lane >> 4;
        bf16_t* ut = (bf16_t*)(p.ws + WS_UT) + (size_t)u * 128 * 64;
        bf16_t* wg = (bf16_t*)(p.ws + WS_W) + (size_t)u * 64 * 128;
        f32x4 au[4], aw[4];
#pragma unroll
        for (int m = 0; m < 4; ++m) { au[m] = (f32x4){0.f, 0.f, 0.f, 0.f}; aw[m] = (f32x4){0.f, 0.f, 0.f, 0.f}; }
#pragma unroll
        for (int kk2 = 0; kk2 < 2; ++kk2) {
            const int tsw = (kk2 * 32 + 8 * q4) ^ ((((16 * wave + rr) >> 3) & 7) << 3);
            const bf16x8 bv = *(const bf16x8*)(sVBT + (16 * wave + rr) * GU_LDT + tsw);
            const bf16x8 ak = *(const bf16x8*)(sKGT + (16 * wave + rr) * GU_LDT + tsw);
#pragma unroll
            for (int m = 0; m < 4; ++m) {
                const bf16x8 tf = *(const bf16x8*)(sT + (16 * m + rr) * GU_LDT + kk2 * 32 + 8 * q4);
                au[m] = __builtin_amdgcn_mfma_f32_16x16x32_bf16(tf, bv, au[m], 0, 0, 0);
                aw[m] = __builtin_amdgcn_mfma_f32_16x16x32_bf16(ak, tf, aw[m], 0, 0, 0);
            }
        }
#pragma unroll
        for (int m = 0; m < 4; ++m) {
            uint2 o; o.x = pack2(au[m][0], au[m][1]); o.y = pack2(au[m][2], au[m][3]);
            *(uint2*)(ut + (size_t)(16 * wave + rr) * 64 + 16 * m + 4 * q4) = o;
            uint2 w2; w2.x = pack2(aw[m][0], aw[m][1]); w2.y = pack2(aw[m][2], aw[m][3]);
            *(uint2*)(wg + (size_t)(16 * m + rr) * 128 + 32 * (wave >> 1) + 8 * q4 + 4 * (wave & 1)) = w2;
        }
    }
}

constexpr int GS_SW = 0, GS_SQD = 17408, GS_SKDT = 34816, GS_SATT = 53248, GS_BUF = 62464;
typedef unsigned u32x2 __attribute__((ext_vector_type(2)));
__device__ __forceinline__ int gdn_chain_chunk(int dir, int s) { return dir == 0 ? (s < 4 ? NCH_LAT + s : s - 4) : NCH - 1 - s; }
struct GsG1 { u32x4 w[2]; u32x4 att; };
struct GsG2 { u32x2 qlo[2], qhi[2]; float gq[2]; };
struct GsG3 { u32x4 kd[2]; float gk[2]; float gl; u32x2 ut[4]; };
__device__ __forceinline__ void gs_load1(const Params& p, int dh, int c, GsG1& st) {
    const int tid = tid_(); const size_t u = (size_t)dh * NCH + c;
    const bf16_t* wg = (const bf16_t*)(p.ws + WS_W) + u * 64 * 128; const bf16_t* att = (const bf16_t*)(p.ws + WS_ATT) + u * 64 * 64;
#pragma unroll
    for (int q = 0; q < 2; ++q) { const int t = tid + q * NTHREADS; st.w[q] = *(const u32x4*)(wg + (size_t)(t >> 4) * 128 + (t & 15) * 8); }
    st.att = *(const u32x4*)(att + (size_t)(tid >> 3) * 64 + (tid & 7) * 8);
}
__device__ __forceinline__ void gs_store1(const GsG1& st, unsigned char* buf) {
    const int tid = tid_(); bf16_t* sW = (bf16_t*)(buf + GS_SW); bf16_t* sATT = (bf16_t*)(buf + GS_SATT);
#pragma unroll
    for (int q = 0; q < 2; ++q) { const int t = tid + q * NTHREADS; *(u32x4*)(sW + (t >> 4) * GU_LDQ + (t & 15) * 8) = st.w[q]; }
    *(u32x4*)(sATT + (tid >> 3) * GU_LDT + (tid & 7) * 8) = st.att;
}
__device__ __forceinline__ void gs_load2(const Params& p, int dh, int c, GsG2& st) {
    const int tid = tid_(), dir = dh >> 3, head = dh & 7; const size_t u = (size_t)dh * NCH + c;
    const float* gc = (const float*)(p.ws + WS_GC) + u * 64; const bf16_t* qn = (const bf16_t*)(p.ws + WS_QN);
#pragma unroll
    for (int q = 0; q < 2; ++q) {
        const int t = tid + q * NTHREADS, i = t >> 4, kk = (t >> 2) & 3, qq = t & 3;
        const bf16_t* src = qn + (size_t)(c * 64 + (dir ? 63 - i : i)) * 1024 + head * 128 + 32 * kk + 4 * qq;
        st.qlo[q] = *(const u32x2*)src; st.qhi[q] = *(const u32x2*)(src + 16); st.gq[q] = gc[i];
    }
}
__device__ __forceinline__ void gs_store2(const GsG2& st, unsigned char* buf) {
    const int tid = tid_(); bf16_t* sQD = (bf16_t*)(buf + GS_SQD);
#pragma unroll
    for (int q = 0; q < 2; ++q) {
        const int t = tid + q * NTHREADS, i = t >> 4, kk = (t >> 2) & 3, qq = t & 3; const float e = __expf(st.gq[q]);
        u32x4 o; o.x = pack2(lo2f(st.qlo[q].x) * e, hi2f(st.qlo[q].x) * e); o.y = pack2(lo2f(st.qlo[q].y) * e, hi2f(st.qlo[q].y) * e);
        o.z = pack2(lo2f(st.qhi[q].x) * e, hi2f(st.qhi[q].x) * e); o.w = pack2(lo2f(st.qhi[q].y) * e, hi2f(st.qhi[q].y) * e);
        *(u32x4*)(sQD + i * GU_LDQ + 32 * kk + 8 * qq) = o;
    }
}
__device__ __forceinline__ void gs_load3(const Params& p, int dh, int c, GsG3& st) {
    const int tid = tid_(), lane = tid & 63, wave = tid >> 6, dir = dh >> 3, head = dh & 7; const size_t u = (size_t)dh * NCH + c;
    const float* gc = (const float*)(p.ws + WS_GC) + u * 64; const bf16_t* kn = (const bf16_t*)(p.ws + WS_KN);
    st.gl = gc[63];
#pragma unroll
    for (int q = 0; q < 2; ++q) {
        const int t = tid + q * NTHREADS, pos = t >> 4, d8 = (t & 15) * 8;
        st.kd[q] = *(const u32x4*)(kn + (size_t)(c * 64 + (dir ? 63 - pos : pos)) * 1024 + head * 128 + d8); st.gk[q] = gc[pos];
    }
    const bf16_t* ut = (const bf16_t*)(p.ws + WS_UT) + u * 128 * 64 + (size_t)(16 * wave + (lane & 15)) * 64 + 4 * (lane >> 4);
#pragma unroll
    for (int m = 0; m < 4; ++m) st.ut[m] = *(const u32x2*)(ut + 16 * m);
}
__device__ __forceinline__ void gs_store3(const GsG3& st, unsigned char* buf) {
    const int tid = tid_(); bf16_t* sKDT = (bf16_t*)(buf + GS_SKDT);
#pragma unroll
    for (int q = 0; q < 2; ++q) {
        const int t = tid + q * NTHREADS, pos = t >> 4, d8 = (t & 15) * 8; const float e = __expf(st.gl - st.gk[q]);
        const u32x4 kq = st.kd[q]; const int sl = perm_slot64(pos) ^ (((d8 >> 3) & 7) << 3);
        sKDT[(d8 + 0) * GU_LDT + sl] = f2bf(lo2f(kq.x) * e); sKDT[(d8 + 1) * GU_LDT + sl] = f2bf(hi2f(kq.x) * e);
        sKDT[(d8 + 2) * GU_LDT + sl] = f2bf(lo2f(kq.y) * e); sKDT[(d8 + 3) * GU_LDT + sl] = f2bf(hi2f(kq.y) * e);
        sKDT[(d8 + 4) * GU_LDT + sl] = f2bf(lo2f(kq.z) * e); sKDT[(d8 + 5) * GU_LDT + sl] = f2bf(hi2f(kq.z) * e);
        sKDT[(d8 + 6) * GU_LDT + sl] = f2bf(lo2f(kq.w) * e); sKDT[(d8 + 7) * GU_LDT + sl] = f2bf(hi2f(kq.w) * e);
    }
}
__device__ __forceinline__ void gdn_seg_ab(const Params& p, int dh, int k, unsigned char* lds) {
    const int tid = tid_(), lane = tid & 63, wave = tid >> 6, rr = lane & 15, q4 = lane >> 4, dir = dh >> 3;
    const bool first = (k == 0);
    const int s_begin = first ? 0 : 4 + 16 * k, nsteps = first ? 20 : 16;
    f32x4 ScB[8], ScA[8]; bf16x8 SbB[4], SbA[4];
#pragma unroll
    for (int m = 0; m < 8; ++m) {
        ScB[m] = (f32x4){0.f, 0.f, 0.f, 0.f};
#pragma unroll
        for (int jj = 0; jj < 4; ++jj) ScA[m][jj] = (16 * m + 4 * q4 + jj == 16 * wave + rr) ? 1.f : 0.f;
    }
#pragma unroll
    for (int kk = 0; kk < 4; ++kk) {
        SbB[kk] = (bf16x8){0, 0, 0, 0, 0, 0, 0, 0};
        const u32x4 pk = {pack2(ScA[2 * kk][0], ScA[2 * kk][1]), pack2(ScA[2 * kk][2], ScA[2 * kk][3]),
                          pack2(ScA[2 * kk + 1][0], ScA[2 * kk + 1][1]), pack2(ScA[2 * kk + 1][2], ScA[2 * kk + 1][3])};
        SbA[kk] = __builtin_bit_cast(bf16x8, pk);
    }
    u32x2 ucur[4]; float glcur;
    float4* sin_img = (float4*)(p.ws + WS_SIN) + (size_t)(dh * 16) * 4096;
    __syncthreads();
    {
        const int c0 = gdn_chain_chunk(dir, s_begin);
        GsG1 g1; gs_load1(p, dh, c0, g1); gs_store1(g1, lds);
        GsG3 g3; gs_load3(p, dh, c0, g3); gs_store3(g3, lds);
#pragma unroll
        for (int m = 0; m < 4; ++m) ucur[m] = g3.ut[m];
        glcur = g3.gl;
    }
    __syncthreads();
#pragma unroll 1
    for (int t = 0; t < nsteps; ++t) {
        const int s = s_begin + t;
        const int cn = gdn_chain_chunk(dir, t + 1 < nsteps ? s + 1 : s);
        const unsigned char* buf = lds + (t & 1) * GS_BUF; unsigned char* nbuf = lds + ((t + 1) & 1) * GS_BUF;
        const bf16_t* sW = (const bf16_t*)(buf + GS_SW); const bf16_t* sKDT = (const bf16_t*)(buf + GS_SKDT);
        GsG1 g1; gs_load1(p, dh, cn, g1);
        GsG3 g3; gs_load3(p, dh, cn, g3);
        f32x4 vb_[4], va_[4];
#pragma unroll
        for (int m = 0; m < 4; ++m) {
            f32x4 accb = (f32x4){0.f, 0.f, 0.f, 0.f}, acca = (f32x4){0.f, 0.f, 0.f, 0.f};
#pragma unroll
            for (int kk = 0; kk < 4; ++kk) {
                const bf16x8 a = *(const bf16x8*)(sW + (16 * m + rr) * GU_LDQ + kk * 32 + 8 * q4);
                accb = __builtin_amdgcn_mfma_f32_16x16x32_bf16(a, SbB[kk], accb, 0, 0, 0);
                if (!first) acca = __builtin_amdgcn_mfma_f32_16x16x32_bf16(a, SbA[kk], acca, 0, 0, 0);
            }
            vb_[m][0] = lo2f(ucur[m].x) - accb[0]; vb_[m][1] = hi2f(ucur[m].x) - accb[1]; vb_[m][2] = lo2f(ucur[m].y) - accb[2]; vb_[m][3] = hi2f(ucur[m].y) - accb[3];
            va_[m] = -acca;
        }
        bf16x8 VBb[2], VBa[2];
#pragma unroll
        for (int k2 = 0; k2 < 2; ++k2) {
            const u32x4 pb = {pack2(vb_[2 * k2][0], vb_[2 * k2][1]), pack2(vb_[2 * k2][2], vb_[2 * k2][3]), pack2(vb_[2 * k2 + 1][0], vb_[2 * k2 + 1][1]), pack2(vb_[2 * k2 + 1][2], vb_[2 * k2 + 1][3])};
            const u32x4 pa = {pack2(va_[2 * k2][0], va_[2 * k2][1]), pack2(va_[2 * k2][2], va_[2 * k2][3]), pack2(va_[2 * k2 + 1][0], va_[2 * k2 + 1][1]), pack2(va_[2 * k2 + 1][2], va_[2 * k2 + 1][3])};
            VBb[k2] = __builtin_bit_cast(bf16x8, pb); VBa[k2] = __builtin_bit_cast(bf16x8, pa);
        }
        const float egl = __expf(glcur);
#pragma unroll
        for (int m = 0; m < 8; ++m) {
            f32x4 accb = ScB[m] * egl, acca = ScA[m] * egl;
#pragma unroll
            for (int k2 = 0; k2 < 2; ++k2) {
                const bf16x8 a = *(const bf16x8*)(sKDT + (16 * m + rr) * GU_LDT + ((k2 * 32 + 8 * q4) ^ ((((16 * m + rr) >> 3) & 7) << 3)));
                accb = __builtin_amdgcn_mfma_f32_16x16x32_bf16(a, VBb[k2], accb, 0, 0, 0);
                if (!first) acca = __builtin_amdgcn_mfma_f32_16x16x32_bf16(a, VBa[k2], acca, 0, 0, 0);
            }
            ScB[m] = accb; ScA[m] = acca;
        }
#pragma unroll
        for (int kk = 0; kk < 4; ++kk) {
            const u32x4 pb = {pack2(ScB[2 * kk][0], ScB[2 * kk][1]), pack2(ScB[2 * kk][2], ScB[2 * kk][3]), pack2(ScB[2 * kk + 1][0], ScB[2 * kk + 1][1]), pack2(ScB[2 * kk + 1][2], ScB[2 * kk + 1][3])};
            const u32x4 pa = {pack2(ScA[2 * kk][0], ScA[2 * kk][1]), pack2(ScA[2 * kk][2], ScA[2 * kk][3]), pack2(ScA[2 * kk + 1][0], ScA[2 * kk + 1][1]), pack2(ScA[2 * kk + 1][2], ScA[2 * kk + 1][3])};
            SbB[kk] = __builtin_bit_cast(bf16x8, pb); SbA[kk] = __builtin_bit_cast(bf16x8, pa);
        }
        gs_store1(g1, nbuf); gs_store3(g3, nbuf);
#pragma unroll
        for (int m = 0; m < 4; ++m) ucur[m] = g3.ut[m];
        glcur = g3.gl;
        if (first && t == 3) {
#pragma unroll
            for (int m = 0; m < 8; ++m) sin_img[(wave * 8 + m) * 64 + lane] = make_float4(ScB[m][0], ScB[m][1], ScB[m][2], ScB[m][3]);
        }
        __syncthreads();
    }
    if (first) {
#pragma unroll
        for (int m = 0; m < 8; ++m) sin_img[4096 + (wave * 8 + m) * 64 + lane] = make_float4(ScB[m][0], ScB[m][1], ScB[m][2], ScB[m][3]);
    } else {
        float4* bimg = (float4*)(p.ws + WS_BSEG) + (size_t)(dh * 16 + k) * 4096;
        bf16_t* aseg = (bf16_t*)(p.ws + WS_ASEG) + (size_t)(dh * 16 + k) * 128 * 128;
        const int pc = perm_slot64(16 * wave + rr);
#pragma unroll
        for (int m = 0; m < 8; ++m) {
            bimg[(wave * 8 + m) * 64 + lane] = make_float4(ScB[m][0], ScB[m][1], ScB[m][2], ScB[m][3]);
#pragma unroll
            for (int jj = 0; jj < 4; ++jj) aseg[(size_t)(16 * m + 4 * q4 + jj) * 128 + pc] = f2bf(ScA[m][jj]);
        }
    }
}
__device__ __forceinline__ void gdn_seg_chain(const Params& p, int dh, unsigned char* lds) {
    const int tid = tid_(), lane = tid & 63, wave = tid >> 6, rr = lane & 15, q4 = lane >> 4;
    float4* sin_img = (float4*)(p.ws + WS_SIN) + (size_t)(dh * 16) * 4096;
    const float4* bimg = (const float4*)(p.ws + WS_BSEG) + (size_t)(dh * 16) * 4096;
    const bf16_t* aseg = (const bf16_t*)(p.ws + WS_ASEG) + (size_t)(dh * 16) * 128 * 128;
    f32x4 Sc[8]; bf16x8 Sb[4];
#pragma unroll
    for (int m = 0; m < 8; ++m) { const float4 v = sin_img[4096 + (wave * 8 + m) * 64 + lane]; Sc[m] = (f32x4){v.x, v.y, v.z, v.w}; }
    u32x4 ar[4];
    __syncthreads();
#pragma unroll
    for (int q = 0; q < 4; ++q) { const int t = tid + q * NTHREADS; ar[q] = *(const u32x4*)(aseg + (size_t)1 * 16384 + (size_t)(t >> 4) * 128 + (t & 15) * 8); }
#pragma unroll
    for (int q = 0; q < 4; ++q) { const int t = tid + q * NTHREADS; *(u32x4*)((bf16_t*)lds + (t >> 4) * GU_LDQ + (t & 15) * 8) = ar[q]; }
    __syncthreads();
#pragma unroll 1
    for (int k = 1; k <= 14; ++k) {
        const bf16_t* sA = (const bf16_t*)(lds + ((k - 1) & 1) * 34816);
        if (k < 14) {
#pragma unroll
            for (int q = 0; q < 4; ++q) { const int t = tid + q * NTHREADS; ar[q] = *(const u32x4*)(aseg + (size_t)(k + 1) * 16384 + (size_t)(t >> 4) * 128 + (t & 15) * 8); }
        }
#pragma unroll
        for (int kk = 0; kk < 4; ++kk) {
            const u32x4 pk = {pack2(Sc[2 * kk][0], Sc[2 * kk][1]), pack2(Sc[2 * kk][2], Sc[2 * kk][3]), pack2(Sc[2 * kk + 1][0], Sc[2 * kk + 1][1]), pack2(Sc[2 * kk + 1][2], Sc[2 * kk + 1][3])};
            Sb[kk] = __builtin_bit_cast(bf16x8, pk);
        }
#pragma unroll
        for (int m = 0; m < 8; ++m) {
            const float4 bv = bimg[(size_t)k * 4096 + (wave * 8 + m) * 64 + lane];
            f32x4 acc = (f32x4){bv.x, bv.y, bv.z, bv.w};
#pragma unroll
            for (int kk = 0; kk < 4; ++kk)
                acc = __builtin_amdgcn_mfma_f32_16x16x32_bf16(*(const bf16x8*)(sA + (16 * m + rr) * GU_LDQ + kk * 32 + 8 * q4), Sb[kk], acc, 0, 0, 0);
            Sc[m] = acc;
            sin_img[(size_t)(k + 1) * 4096 + (wave * 8 + m) * 64 + lane] = make_float4(acc[0], acc[1], acc[2], acc[3]);
        }
        if (k < 14) {
#pragma unroll
            for (int q = 0; q < 4; ++q) { const int t = tid + q * NTHREADS; *(u32x4*)((bf16_t*)(lds + (k & 1) * 34816) + (t >> 4) * GU_LDQ + (t & 15) * 8) = ar[q]; }
        }
        __syncthreads();
    }
}
__device__ __forceinline__ void gdn_seq(const Params& p, int dh, int k, unsigned char* lds) {
    const int tid = tid_(), lane = tid & 63, wave = tid >> 6, rr = lane & 15, q4 = lane >> 4, dir = dh >> 3, head = dh & 7;
    const int s_begin = 4 + 16 * k;
    f32x4 Sc[8]; bf16x8 Sb[4];
    {
        const float4* sin_img = (const float4*)(p.ws + WS_SIN) + (size_t)(dh * 16 + k) * 4096;
#pragma unroll
        for (int m = 0; m < 8; ++m) { const float4 v = sin_img[(wave * 8 + m) * 64 + lane]; Sc[m] = (f32x4){v.x, v.y, v.z, v.w}; }
#pragma unroll
        for (int kk = 0; kk < 4; ++kk) {
            const u32x4 pk = {pack2(Sc[2 * kk][0], Sc[2 * kk][1]), pack2(Sc[2 * kk][2], Sc[2 * kk][3]), pack2(Sc[2 * kk + 1][0], Sc[2 * kk + 1][1]), pack2(Sc[2 * kk + 1][2], Sc[2 * kk + 1][3])};
            Sb[kk] = __builtin_bit_cast(bf16x8, pk);
        }
    }
    u32x2 ucur[4]; float glcur;
    __syncthreads();
    {
        const int c0 = gdn_chain_chunk(dir, s_begin);
        GsG1 g1; gs_load1(p, dh, c0, g1); gs_store1(g1, lds);
        GsG2 g2; gs_load2(p, dh, c0, g2); gs_store2(g2, lds);
        GsG3 g3; gs_load3(p, dh, c0, g3); gs_store3(g3, lds);
#pragma unroll
        for (int m = 0; m < 4; ++m) ucur[m] = g3.ut[m];
        glcur = g3.gl;
    }
    __syncthreads();
    bf16_t* of = (bf16_t*)(p.ws + WS_OF) + (size_t)dir * SEQ * 1024;
#pragma unroll 1
    for (int t = 0; t < 16; ++t) {
        const int s = s_begin + t;
        const int c = gdn_chain_chunk(dir, s);
        const int cn = gdn_chain_chunk(dir, t + 1 < 16 ? s + 1 : s);
        const unsigned char* buf = lds + (t & 1) * GS_BUF; unsigned char* nbuf = lds + ((t + 1) & 1) * GS_BUF;
        const bf16_t* sW = (const bf16_t*)(buf + GS_SW); const bf16_t* sQD = (const bf16_t*)(buf + GS_SQD);
        const bf16_t* sKDT = (const bf16_t*)(buf + GS_SKDT); const bf16_t* sATT = (const bf16_t*)(buf + GS_SATT);
        GsG1 g1; gs_load1(p, dh, cn, g1);
        GsG2 g2; gs_load2(p, dh, cn, g2);
        GsG3 g3; gs_load3(p, dh, cn, g3);
        f32x4 vn[4];
#pragma unroll
        for (int m = 0; m < 4; ++m) {
            f32x4 acc = (f32x4){0.f, 0.f, 0.f, 0.f};
#pragma unroll
            for (int kk = 0; kk < 4; ++kk)
                acc = __builtin_amdgcn_mfma_f32_16x16x32_bf16(*(const bf16x8*)(sW + (16 * m + rr) * GU_LDQ + kk * 32 + 8 * q4), Sb[kk], acc, 0, 0, 0);
            vn[m][0] = lo2f(ucur[m].x) - acc[0]; vn[m][1] = hi2f(ucur[m].x) - acc[1]; vn[m][2] = lo2f(ucur[m].y) - acc[2]; vn[m][3] = hi2f(ucur[m].y) - acc[3];
        }
        bf16x8 VB[2];
#pragma unroll
        for (int k2 = 0; k2 < 2; ++k2) {
            const unsigned a0 = pack2(vn[2 * k2][0], vn[2 * k2][1]), a1 = pack2(vn[2 * k2][2], vn[2 * k2][3]);
            const unsigned a2 = pack2(vn[2 * k2 + 1][0], vn[2 * k2 + 1][1]), a3 = pack2(vn[2 * k2 + 1][2], vn[2 * k2 + 1][3]);
            const u32x4 pk = {a0, a1, a2, a3}; VB[k2] = __builtin_bit_cast(bf16x8, pk);
        }
#pragma unroll
        for (int m = 0; m < 4; ++m) {
            f32x4 acc = (f32x4){0.f, 0.f, 0.f, 0.f};
#pragma unroll
            for (int kk = 0; kk < 4; ++kk)
                acc = __builtin_amdgcn_mfma_f32_16x16x32_bf16(*(const bf16x8*)(sQD + (16 * m + rr) * GU_LDQ + kk * 32 + 8 * q4), Sb[kk], acc, 0, 0, 0);
#pragma unroll
            for (int k2 = 0; k2 < 2; ++k2)
                acc = __builtin_amdgcn_mfma_f32_16x16x32_bf16(*(const bf16x8*)(sATT + (16 * m + rr) * GU_LDT + k2 * 32 + 8 * q4), VB[k2], acc, 0, 0, 0);
#pragma unroll
            for (int jj = 0; jj < 4; ++jj) {
                const int pos = 16 * m + 4 * q4 + jj;
                of[(size_t)(c * 64 + (dir ? 63 - pos : pos)) * 1024 + head * 128 + 16 * wave + rr] = f2bf(acc[jj]);
            }
        }
        const float egl = __expf(glcur);
#pragma unroll
        for (int m = 0; m < 8; ++m) {
            f32x4 acc = Sc[m] * egl;
#pragma unroll
            for (int k2 = 0; k2 < 2; ++k2)
                acc = __builtin_amdgcn_mfma_f32_16x16x32_bf16(*(const bf16x8*)(sKDT + (16 * m + rr) * GU_LDT + ((k2 * 32 + 8 * q4) ^ ((((16 * m + rr) >> 3) & 7) << 3))), VB[k2], acc, 0, 0, 0);
            Sc[m] = acc;
        }
#pragma unroll
        for (int kk = 0; kk < 4; ++kk) {
            const u32x4 pk = {pack2(Sc[2 * kk][0], Sc[2 * kk][1]), pack2(Sc[2 * kk][2], Sc[2 * kk][3]),
                              pack2(Sc[2 * kk + 1][0], Sc[2 * kk + 1][1]), pack2(Sc[2 * kk + 1][2], Sc[2 * kk + 1][3])};
            Sb[kk] = __builtin_bit_cast(bf16x8, pk);
        }
        gs_store1(g1, nbuf); gs_store2(g2, nbuf); gs_store3(g3, nbuf);
#pragma unroll
        for (int m = 0; m < 4; ++m) ucur[m] = g3.ut[m];
        glcur = g3.gl;
        __syncthreads();
    }
}

__device__ __forceinline__ void gdn_readout_row(const Params& p, int row) {
    const int lane = tid_() & 63, head = lane >> 3, d0 = (lane & 7) * 16;
    const bf16_t* of0 = (const bf16_t*)(p.ws + WS_OF) + (size_t)row * 1024 + head * 128 + d0;
    const bf16_t* of1 = of0 + (size_t)SEQ * 1024;
    const bf16_t* zp = (const bf16_t*)(p.ws + WS_Z) + (size_t)row * 1024 + head * 128 + d0;
    float a[16], b[16], z[16];
    unpack8(*(const uint4*)of0, a); unpack8(*(const uint4*)(of0 + 8), a + 8);
    unpack8(*(const uint4*)of1, b); unpack8(*(const uint4*)(of1 + 8), b + 8);
    unpack8(*(const uint4*)zp, z); unpack8(*(const uint4*)(zp + 8), z + 8);
    float ss = 0.f;
#pragma unroll
    for (int e = 0; e < 16; ++e) { a[e] += b[e]; ss += a[e] * a[e]; }
    ss += __shfl_xor(ss, 1, 64); ss += __shfl_xor(ss, 2, 64); ss += __shfl_xor(ss, 4, 64);
    const float rs = rsqrtf(ss * (1.f / 128.f) + 1e-6f);
    const float* ng = p.in[25] + d0;
    float f[16];
#pragma unroll
    for (int e = 0; e < 16; ++e) f[e] = a[e] * rs * ng[e] * siluf_(z[e]);
    bf16_t* dst = (bf16_t*)(p.ws + WS_VN) + (size_t)row * 1024 + head * 128 + d0;
    *(uint4*)dst = pack8(f); *(uint4*)(dst + 8) = pack8(f + 8);
}

#define XB_TMO      128
#define XB_XCNT(j)  (256  + 64 * (j))
#define XB_XSUB(j)  (1280 + 64 * (j))
#define XB_XGEN(j)  (2304 + 64 * (j))
#define XB_TOP      3328
#define XB_TOPGEN   3392
#define XCD_BAR_WORDS 3456
#define XB_SPIN_CAP (1u << 22)
__device__ __forceinline__ unsigned xb_ld(unsigned* p)              { return __hip_atomic_load(p, __ATOMIC_RELAXED, __HIP_MEMORY_SCOPE_AGENT); }
__device__ __forceinline__ unsigned xb_add(unsigned* p, unsigned v) { return __hip_atomic_fetch_add(p, v, __ATOMIC_RELAXED, __HIP_MEMORY_SCOPE_AGENT); }
__device__ __forceinline__ unsigned xb_xcc_id() { return (unsigned)__builtin_amdgcn_s_getreg((3 << 11) | 20) & 0xFu; }
#define XB_SPIN(cond, bar) do { unsigned _sp = 0; while (cond) { __builtin_amdgcn_s_sleep(1); \
    if ((++_sp & 255u) == 0u) { if (xb_ld(&(bar)[XB_TMO])) break; if (_sp > XB_SPIN_CAP) { atomicAdd(&(bar)[XB_TMO], 1u); break; } } } } while (0)
struct XcdBarrier { unsigned* bar; unsigned x; volatile LAS unsigned* st; };
__device__ __forceinline__ XcdBarrier xcd_barrier_post(unsigned* bar, volatile LAS unsigned* st) {
    XcdBarrier b; b.bar = bar; b.x = xb_xcc_id(); b.st = st;
    if (threadIdx.x == 0) (void)xb_add(&bar[XB_XCNT(b.x)], 1u);
    return b;
}
__device__ __forceinline__ void xcd_barrier_complete(unsigned* bar, unsigned x, unsigned& nloc, unsigned& nx) {
    const unsigned G = gridDim.x * gridDim.y * gridDim.z;
    unsigned sum, cnt, mine, sp = 0u;
    for (;;) {
        sum = 0u; cnt = 0u; mine = 0u;
#pragma unroll
        for (unsigned j = 0; j < 16; ++j) { const unsigned c = xb_ld(&bar[XB_XCNT(j)]); sum += c; cnt += (c > 0u) ? 1u : 0u; mine = (j == x) ? c : mine; }
        if (sum == G) break;
        __builtin_amdgcn_s_sleep(1);
        if ((++sp & 255u) == 0u) { if (xb_ld(&bar[XB_TMO])) break; if (sp > XB_SPIN_CAP) { atomicAdd(&bar[XB_TMO], 1u); break; } }
    }
    nloc = mine > 0u ? mine : 1u; nx = cnt > 0u ? cnt : 1u;
}
__device__ __forceinline__ void xcd_barrier(const XcdBarrier& b) {
    asm volatile("s_waitcnt vmcnt(0)" ::: "memory");
    __syncthreads();
    if (threadIdx.x == 0) {
        unsigned* bar = b.bar;
        __builtin_amdgcn_s_waitcnt(0);
        unsigned nloc = b.st[0], nx = b.st[1];
        if (nloc == 0u) { xcd_barrier_complete(bar, b.x, nloc, nx); b.st[0] = nloc; b.st[1] = nx; }
        const unsigned old = xb_add(&bar[XB_XSUB(b.x)], 1u);
        const unsigned gen = old / nloc;
        if (old + 1u == (gen + 1u) * nloc) {
            __builtin_amdgcn_fence(__ATOMIC_RELEASE, "agent");
            asm volatile("s_waitcnt vmcnt(0)" ::: "memory");
            const unsigned og = xb_add(&bar[XB_TOP], 1u);
            const unsigned tg = og / nx;
            if (og + 1u == (tg + 1u) * nx) xb_add(&bar[XB_TOPGEN], 1u);
            else XB_SPIN(xb_ld(&bar[XB_TOPGEN]) == tg, bar);
            __builtin_amdgcn_fence(__ATOMIC_ACQUIRE, "agent");
            xb_add(&bar[XB_XGEN(b.x)], 1u);
            asm volatile("s_waitcnt vmcnt(0)" ::: "memory");
        } else {
            XB_SPIN(xb_ld(&bar[XB_XGEN(b.x)]) == gen, bar);
            __builtin_amdgcn_fence(__ATOMIC_ACQUIRE, "agent");
            asm volatile("s_waitcnt vmcnt(0)" ::: "memory");
        }
    }
    __syncthreads();
}

#ifndef PHMASK
#define PHMASK 0xFFFFFFFFull
#endif
#define PH(n) (((PHMASK) >> (n)) & 1ull)
#define FOR_ITEMS(n) for (int item = blockIdx.x; item < (n); item += gridDim.x)
__device__ __forceinline__ void mixer1_phases(const Params& p, unsigned char* ws, unsigned char* lds, const XcdBarrier& xbar) {
    if (PH(14)) {
        EpiOddIn e{(bf16_t*)(ws + WS_QKVR), (bf16_t*)(ws + WS_Z), (float*)(ws + WS_AB)};
        gemm_big((const bf16_t*)(ws + WS_ACT), (const bf16_t*)(ws + WS_WOIN), SEQ, 4096, 1024, e, lds);
        FOR_ITEMS(128 + 2 * 33) {
            if (item < 128) gemm_tile((const bf16_t*)(ws + WS_ACT), 1024, R, (const bf16_t*)(ws + WS_WOIN), 1024, ODD_IN, 1024, item * 128, 4096, e, lds);
            else { const int q = item - 128; gemm_tile((const bf16_t*)(ws + WS_ACT), 1024, R, (const bf16_t*)(ws + WS_WOIN), 1024, ODD_IN, 1024, SEQ + (q / 33) * 128, (q % 33) * 128, e, lds); }
        }
    }
    xcd_barrier(xbar);
    if (PH(15)) FOR_ITEMS(R / 16) gdn_prep_item(p, item);
    xcd_barrier(xbar);
    if (PH(16)) {
        GuPre pre;
        int item = blockIdx.x;
        if (item < NUNITS) gu_prefetch(p, item, pre);
        for (; item < NUNITS; item += gridDim.x) gdn_unit(p, item, item + (int)gridDim.x, pre, lds);
    }
    xcd_barrier(xbar);
    if (PH(17)) {
        FOR_ITEMS(256) { if ((item & 15) != 15) gdn_seg_ab(p, item >> 4, item & 15, lds); }
        xcd_barrier(xbar);
        if (blockIdx.x < 16) gdn_seg_chain(p, blockIdx.x, lds);
        else {
            for (int item = (int)blockIdx.x - 16; item < 256; item += (int)gridDim.x - 16)
                p0_transpose(p.in[26], 1024, 1024, (bf16_t*)(ws + WS_WOOUT), item, lds);
        }
        xcd_barrier(xbar);
        FOR_ITEMS(256) gdn_seq(p, item >> 4, item & 15, lds);
    }
    xcd_barrier(xbar);
    if (PH(18)) FOR_ITEMS(SEQ / 8) gdn_readout_row(p, item * 8 + (tid_() >> 6));
    xcd_barrier(xbar);
    if (PH(19)) {
        EpiResid e{p.in[0], p.in[2], (bf16_t*)(ws + WS_H), (const float*)(ws + WS_MOD), 1, false};
        gemm_big((const bf16_t*)(ws + WS_VN), (const bf16_t*)(ws + WS_WOOUT), SEQ, 1024, 1024, e, lds);
        FOR_ITEMS(2048) peer_tables_item(p, item, 1);
    }
    xcd_barrier(xbar);
}

template <int L>
__device__ __forceinline__ void peer_phases(const Params& p, unsigned char* ws, unsigned char* lds, const XcdBarrier& xbar) {
    constexpr int l = L;
    constexpr int nrows = L == 0 ? R : SEQ, ntm = nrows / 128;
    if (PH(8)) FOR_ITEMS(nrows / 8) norm_rows_item(p, item, l, p.in[7] + l * 1024, 3, false);
    xcd_barrier(xbar);
    if (PH(9)) {
        EpiScore e{(unsigned short*)(ws + WS_SC), 0};
        const bf16_t* wq = (const bf16_t*)(ws + (l == 0 ? WS_WQ0 : WS_WQ1));
        gemm_big((const bf16_t*)(ws + WS_ACT), wq, SEQ, 2048, 1024, e, lds);
        if (l == 0) { FOR_ITEMS(2 * 16) gemm_tile((const bf16_t*)(ws + WS_ACT), 1024, R, wq, 1024, 2048, 1024, SEQ + (item >> 4) * 128, (item & 15) * 128, e, lds); }
    }
    xcd_barrier(xbar);
    if (PH(11)) FOR_ITEMS(nrows / 64) peer_route_item(p, item, nrows, lds);
    xcd_barrier(xbar);
    if (PH(12)) {
        if (l == 0) { FOR_ITEMS(CTX) peer_gather_row_split(p, SEQ + item, 0, lds); }
        FOR_ITEMS(SEQ / 8) peer_gather_row(p, item * 8 + (tid_() >> 6), l, l == 1);
    }
}

__global__ void __launch_bounds__(NTHREADS) fwd_megakernel(Params p) {
    extern __shared__ __attribute__((aligned(16))) unsigned char lds[];
    cg::grid_group grid = cg::this_grid();
    unsigned char* ws = p.ws;
    volatile LAS unsigned* xbst = (volatile LAS unsigned*)(LAS unsigned char*)(lds + LDS_BYTES - 16);
    if (threadIdx.x == 0) { xbst[0] = 0u; xbst[1] = 0u; }
    __syncthreads();
    const XcdBarrier xbar = xcd_barrier_post((unsigned*)(ws + WS_BAR), xbst);

    if (PH(0)) {
        constexpr int N_S5 = 256, N_ADA = 192, N_T0 = 512, N_T1 = 64, N_T2 = 256, N_T5 = 1024, N_SK = 16;
        constexpr int O1 = N_S5, O2 = O1 + N_ADA, O3 = O2 + N_T0, O4 = O3 + N_T1, O5 = O4 + N_T2, O6 = O5 + N_T5, O7 = O6 + N_SK;
        FOR_ITEMS(O7) {
            if (item < O1) p0_s5_tables(p, item, lds);
            else if (item < O2) p0_adaln(p, item - O1, lds);
            else if (item < O3) p0_transpose(p.in[8], 1024, 2048, (bf16_t*)(ws + WS_WEIN), item - O2, lds);
            else if (item < O4) p0_transpose(p.in[18], 512, 512, (bf16_t*)(ws + WS_WGLU), item - O3, lds);
            else if (item < O5) p0_transpose(p.in[20], 1024, 1024, (bf16_t*)(ws + WS_WEOUT), item - O4, lds);
            else if (item < O6) cvt_chunk(p.in[27], (bf16_t*)(ws + WS_WQB), item - O5);
            else cvt_chunk(p.in[28], (bf16_t*)(ws + WS_SK), item - O6);
        }
    }
    grid.sync();
    if (PH(1)) FOR_ITEMS(2080 + 2048 + 256) {
        if (item < 2080) norm_rows_item(p, item, 0, p.in[6], 0, true);
        else if (item < 2080 + 2048) s5_mintra_item(p, item - 2080);
        else {
            const int q = item - 4128, l = q >> 7, b = (q >> 3) & 15, tn = q & 7;
            EpiBf16 e{(bf16_t*)(ws + (l == 0 ? WS_WQ0 : WS_WQ1)) + (size_t)b * 128 * 1024, 1024};
            gemm_tile((const bf16_t*)(ws + WS_SK) + (size_t)(l * 2 + (b & 1)) * 128 * 128, 128, 128,
                      (const bf16_t*)(ws + WS_WQB) + (size_t)l * 1024 * 2048 + b * 128, 2048, 1024, 128, 0, tn * 128, e, lds);
        }
    }
    xcd_barrier(xbar);
    if (PH(2)) {
        EpiEvenIn e{(bf16_t*)(ws + WS_PA), (bf16_t*)(ws + WS_UG)};
        gemm_big((const bf16_t*)(ws + WS_ACT), (const bf16_t*)(ws + WS_WEIN), SEQ, 2048, 1024, e, lds);
        FOR_ITEMS(2 * 16) gemm_tile((const bf16_t*)(ws + WS_ACT), 1024, R, (const bf16_t*)(ws + WS_WEIN), 1024, 2048, 1024, SEQ + (item >> 4) * 128, (item & 15) * 128, e, lds);
    }
    xcd_barrier(xbar);
    if (PH(3)) FOR_ITEMS(32 * 30) {
        const int g = item / 30, r = item % 30, tm = r / 10, tn = r % 10;
        EpiS5Local e{(bf16_t*)(ws + WS_YL), (float*)(ws + WS_LST), g};
        gemm_tile((const bf16_t*)(ws + WS_UG) + (size_t)g * NCH * 1024, 1024, NCH, (const bf16_t*)(ws + WS_MS5) + (size_t)g * 1280 * 1024, 1024, 1280, 1024, tm * 128, tn * 128, e, lds);
    }
    xcd_barrier(xbar);
    if (PH(4)) {
        s5_scan(p);
        if (blockIdx.x >= 8) {
            for (int item = (int)blockIdx.x - 8; item < 2048 + 16 * 65; item += (int)gridDim.x - 8) {
                if (item < 2048) peer_tables_item(p, item, 0);
                else p0_transpose(p.in[21], 1024, ODD_IN, (bf16_t*)(ws + WS_WOIN), item - 2048, lds);
            }
        }
    }
    xcd_barrier(xbar);
    if (PH(5)) FOR_ITEMS(32 * 24) {
        const int g = item / 24, r = item % 24, tm = r / 8, tn = r % 8;
        EpiS5Out e{(const bf16_t*)(ws + WS_YL), (bf16_t*)(ws + WS_GS), g};
        gemm_tile((const bf16_t*)(ws + WS_A5) + (size_t)g * NCH * 256, 256, NCH, (const bf16_t*)(ws + WS_O5) + (size_t)g * 1024 * 256, 256, 1024, 256, tm * 128, tn * 128, e, lds);
    }
    xcd_barrier(xbar);
    if (PH(6)) {
        EpiGlu e{(const bf16_t*)(ws + WS_GS), p.in[19], (bf16_t*)(ws + WS_CB)};
        gemm_big((const bf16_t*)(ws + WS_GS), (const bf16_t*)(ws + WS_WGLU), SEQ, 512, 512, e, lds);
        for (int item = (int)gridDim.x - 1 - (int)blockIdx.x; item < 2 * 4 + NCH; item += gridDim.x) {
            if (item < 8) gemm_tile((const bf16_t*)(ws + WS_GS), 512, R, (const bf16_t*)(ws + WS_WGLU), 512, 512, 512, SEQ + (item >> 2) * 128, (item & 3) * 128, e, lds);
            else even_conv_item(p, item - 8);
        }
    }
    xcd_barrier(xbar);
    if (PH(7)) {
        EpiResid e{p.in[0], p.in[2], (bf16_t*)(ws + WS_H), (const float*)(ws + WS_MOD), 0, true};
        gemm_big((const bf16_t*)(ws + WS_CB), (const bf16_t*)(ws + WS_WEOUT), SEQ, 1024, 1024, e, lds);
        FOR_ITEMS(2 * 8) gemm_tile((const bf16_t*)(ws + WS_CB), 1024, R, (const bf16_t*)(ws + WS_WEOUT), 1024, 1024, 1024, SEQ + (item >> 3) * 128, (item & 7) * 128, e, lds);
    }
    xcd_barrier(xbar);
    peer_phases<0>(p, ws, lds, xbar);
    xcd_barrier(xbar);
    mixer1_phases(p, ws, lds, xbar);
    peer_phases<1>(p, ws, lds, xbar);
}

extern "C" void kernel_launch(void* const* d_in, const int* in_sizes, int n_in, void* d_out, int out_size, void* d_ws, size_t ws_size, hipStream_t stream) {
    static int grid_blocks = 0;
    if (grid_blocks == 0) {
        if (n_in != 32 || out_size != SEQ * D || ws_size < WS_NEED) {
            fprintf(stderr, "kernel_launch: unexpected problem (n_in %d, out %d, ws %zu, need %zu); nothing launched\n", n_in, out_size, ws_size, (size_t)WS_NEED);
            grid_blocks = -1; return;
        }
        int dev = 0, cus = 0, per_cu = 0;
        hipGetDevice(&dev);
        hipDeviceGetAttribute(&cus, hipDeviceAttributeMultiprocessorCount, dev);
        hipFuncSetAttribute((const void*)fwd_megakernel, hipFuncAttributeMaxDynamicSharedMemorySize, LDS_BYTES);
        hipOccupancyMaxActiveBlocksPerMultiprocessor(&per_cu, (const void*)fwd_megakernel, NTHREADS, LDS_BYTES);
        if (per_cu < 1) { fprintf(stderr, "kernel_launch: occupancy query says %d blocks per CU; nothing launched\n", per_cu); grid_blocks = -1; return; }
        grid_blocks = cus;
    }
    if (grid_blocks < 0) return;
    (void)hipMemsetAsync((unsigned char*)d_ws + WS_BAR, 0, XCD_BAR_WORDS * 4, stream);
    Params prm{};
    for (int i = 0; i < 32; ++i) prm.in[i] = (const float*)d_in[i];
    prm.out = (float*)d_out; prm.ws = (unsigned char*)d_ws;
    void* args[] = {&prm};
    hipError_t e = hipLaunchCooperativeKernel((const void*)fwd_megakernel, dim3(grid_blocks), dim3(NTHREADS), args, LDS_BYTES, stream);
    if (e != hipSuccess) fprintf(stderr, "cooperative launch failed: %s (grid %d)\n", hipGetErrorString(e), grid_blocks);
}
```

```cpp
#include <hip/hip_runtime.h>
#include <hip/hip_cooperative_groups.h>
#include <cstdio>
#include <cstdint>
namespace cg = cooperative_groups;

typedef unsigned short bf16_t;
typedef short bf16x8 __attribute__((ext_vector_type(8)));
typedef float f32x4 __attribute__((ext_vector_type(4)));
typedef float f32x16 __attribute__((ext_vector_type(16)));
typedef unsigned u32x4 __attribute__((ext_vector_type(4)));

constexpr int D = 1024, SEQ = 16384, CTX = 256, R = SEQ + CTX;
constexpr int NCH = R / 64;
constexpr int NCH_LAT = SEQ / 64;
constexpr int NTHREADS = 512;
constexpr int ODD_IN = 4128;
constexpr int NUNITS = 16 * NCH;

constexpr size_t al256(size_t x) { return (x + 255) & ~(size_t)255; }
constexpr size_t WS_BAR   = 0;
constexpr size_t WS_PARAMS = 14336;
constexpr size_t WS_MOD   = 16384;
constexpr size_t WS_A64   = WS_MOD + al256(2 * 2 * 6 * 1024 * 4);
constexpr size_t WS_SK    = WS_A64 + al256(2 * 32 * 64 * 8);
constexpr size_t WS_PSC   = WS_SK + al256(2 * 2 * 128 * 128 * 2);
constexpr size_t WS_WEIN  = WS_PSC + al256(2 * 16384 * 4);
constexpr size_t WS_WGLU  = WS_WEIN + (size_t)2048 * 1024 * 2;
constexpr size_t WS_WEOUT = WS_WGLU + (size_t)512 * 512 * 2;
constexpr size_t WS_WQ0   = WS_WEOUT + (size_t)1024 * 1024 * 2;
constexpr size_t WS_WQ1   = WS_WQ0 + (size_t)2048 * 1024 * 2;
constexpr size_t WS_WOIN  = WS_WQ1 + (size_t)2048 * 1024 * 2;
constexpr size_t WS_WOOUT = WS_WOIN + al256((size_t)ODD_IN * 1024 * 2);
constexpr size_t WS_H     = WS_WOOUT + (size_t)1024 * 1024 * 2;
constexpr size_t WS_PUV   = WS_H + (size_t)R * 1024 * 4;
constexpr size_t WS_ACT   = WS_PUV + (size_t)2 * 16384 * 1024 * 2;
constexpr size_t WS_ARENA = WS_ACT + (size_t)R * 1024 * 2;
constexpr size_t WS_GG    = WS_WEIN;
constexpr size_t WS_BETA  = WS_GG + (size_t)16 * R * 4;
constexpr size_t WS_GC    = WS_BETA + (size_t)16 * R * 4;
constexpr size_t WS_AB    = WS_GC + (size_t)NUNITS * 64 * 4;
static_assert(WS_AB + (size_t)R * 32 * 4 <= WS_WQ1, "layer-1 small buffers overflow the dead layer-0 weights");
constexpr size_t WS_PA    = WS_ARENA;
constexpr size_t WS_WQB   = WS_PA;
constexpr size_t WS_UG    = WS_PA + (size_t)R * 1536 * 2;
constexpr size_t WS_MS5   = WS_UG + (size_t)32 * NCH * 1024 * 2;
constexpr size_t WS_O5    = WS_MS5 + (size_t)32 * 1280 * 1024 * 2;
constexpr size_t WS_KTAB  = WS_O5 + (size_t)32 * 1024 * 256 * 2;
constexpr size_t WS_YL    = WS_KTAB + (size_t)2 * 32 * 64 * 256 * 4;
constexpr size_t WS_LST   = WS_YL + (size_t)R * 512 * 4;
constexpr size_t WS_A5    = WS_LST + (size_t)32 * NCH * 256 * 4;
constexpr size_t WS_GS    = WS_A5 + (size_t)32 * NCH * 256 * 2;
constexpr size_t WS_CB    = WS_GS + (size_t)R * 512 * 2;
constexpr size_t WS_END_L0 = WS_CB + (size_t)R * 1024 * 2;
constexpr size_t WS_Q     = WS_ARENA;
constexpr size_t WS_SC    = WS_Q + (size_t)R * 2048 * 2;
constexpr size_t WS_IDX   = WS_SC + (size_t)R * 2048 * 2;
constexpr size_t WS_GATE  = WS_IDX + (size_t)R * 128 * 4;
constexpr size_t WS_END_PEER = WS_GATE + (size_t)R * 128 * 4;
constexpr size_t WS_QKVR  = WS_ARENA;
constexpr size_t WS_W     = WS_QKVR;
constexpr size_t WS_ATT   = WS_W + (size_t)NUNITS * 64 * 128 * 2;
static_assert(WS_ATT + (size_t)NUNITS * 64 * 64 * 2 <= WS_QKVR + (size_t)R * 3072 * 2, "W+ATT must fit in QKVR");
constexpr size_t WS_Z     = WS_QKVR + (size_t)R * 3072 * 2;
constexpr size_t WS_QN    = WS_Z + (size_t)R * 1024 * 2;
constexpr size_t WS_KN    = WS_QN + (size_t)R * 1024 * 2;
constexpr size_t WS_VN    = WS_KN + (size_t)R * 1024 * 2;
constexpr size_t WS_UT    = WS_VN + (size_t)R * 1024 * 2;
constexpr size_t WS_END_L1 = WS_UT + (size_t)NUNITS * 128 * 64 * 2;
constexpr size_t WS_OF    = WS_PUV;
constexpr size_t WS_SIN   = WS_ACT;
constexpr size_t WS_BSEG  = WS_SIN + (size_t)256 * 65536;
constexpr size_t WS_ASEG  = WS_VN;
static_assert(WS_BSEG + (size_t)256 * 65536 <= WS_ARENA, "SIN+BSEG must fit in ACT");
constexpr size_t cmax(size_t a, size_t b) { return a > b ? a : b; }
constexpr size_t WS_NEED  = cmax(cmax(WS_END_L0, WS_END_PEER), WS_END_L1);
static_assert(WS_NEED <= (size_t)512 * 1024 * 1024, "workspace plan exceeds 512 MiB");

constexpr int LDS_BYTES = 140 * 1024;

struct Params {
    const float* in[32];
    float* out;
    unsigned char* ws;
};

__device__ __forceinline__ int tid_() { int t = threadIdx.x; asm volatile("" : "+v"(t)); return t; }
__device__ __forceinline__ float bf2f(bf16_t b) { return __uint_as_float((unsigned)b << 16); }
__device__ __forceinline__ bf16_t f2bf(float f) { const __bf16 b = (__bf16)f; return __builtin_bit_cast(bf16_t, b); }
typedef float f32x2_t __attribute__((ext_vector_type(2)));
typedef __bf16 bf16x2_t __attribute__((ext_vector_type(2)));
__device__ __forceinline__ unsigned pack2(float lo, float hi) { const f32x2_t v = {lo, hi}; const bf16x2_t b = __builtin_convertvector(v, bf16x2_t); return __builtin_bit_cast(unsigned, b); }
__device__ __forceinline__ float lo2f(unsigned p) { return __uint_as_float(p << 16); }
__device__ __forceinline__ float hi2f(unsigned p) { return __uint_as_float(p & 0xFFFF0000u); }
__device__ __forceinline__ float sigmoidf_(float x) { return 1.f / (1.f + __expf(-x)); }
__device__ __forceinline__ float siluf_(float x) { return x * sigmoidf_(x); }
__device__ __forceinline__ float gelu_tanh(float x) {
    const float u = 0.7978845608028654f * (x + 0.044715f * x * x * x);
    const float t = 1.f - 2.f / (1.f + __expf(2.f * u));
    return 0.5f * x * (1.f + t);
}
__device__ __forceinline__ float gelu_fast(float x) {
    const float w = __builtin_fmaf(x * x, -0.10294324f, -2.30220819f);
    return x * __builtin_amdgcn_rcpf(1.f + __builtin_amdgcn_exp2f(x * w));
}
__device__ __forceinline__ float wave_sum(float v) {
#pragma unroll
    for (int o = 32; o > 0; o >>= 1) v += __shfl_xor(v, o, 64);
    return v;
}

__device__ __forceinline__ float wave_sum_dpp(float v) {
    v += __int_as_float(__builtin_amdgcn_update_dpp(0, __float_as_int(v), 0xB1, 0xF, 0xF, true));
    v += __int_as_float(__builtin_amdgcn_update_dpp(0, __float_as_int(v), 0x4E, 0xF, 0xF, true));
    v += __int_as_float(__builtin_amdgcn_update_dpp(0, __float_as_int(v), 0x141, 0xF, 0xF, true));
    v += __int_as_float(__builtin_amdgcn_update_dpp(0, __float_as_int(v), 0x140, 0xF, 0xF, true));
    v += __int_as_float(__builtin_amdgcn_update_dpp(0, __float_as_int(v), 0x142, 0xA, 0xF, false));
    v += __int_as_float(__builtin_amdgcn_update_dpp(0, __float_as_int(v), 0x143, 0xC, 0xF, false));
    return __int_as_float(__builtin_amdgcn_readlane(__float_as_int(v), 63));
}
__device__ __forceinline__ void unpack8(const uint4& p, float* f) {
    f[0] = lo2f(p.x); f[1] = hi2f(p.x); f[2] = lo2f(p.y); f[3] = hi2f(p.y);
    f[4] = lo2f(p.z); f[5] = hi2f(p.z); f[6] = lo2f(p.w); f[7] = hi2f(p.w);
}
__device__ __forceinline__ uint4 pack8(const float* f) {
    uint4 p; p.x = pack2(f[0], f[1]); p.y = pack2(f[2], f[3]); p.z = pack2(f[4], f[5]); p.w = pack2(f[6], f[7]); return p;
}
__device__ __forceinline__ const float* modp(const Params& p, int l, int row, int j) {
    const float* m = (const float*)(p.ws + WS_MOD);
    return m + ((l * 2 + (row >= SEQ ? 1 : 0)) * 6 + j) * 1024;
}

#define LAS __attribute__((address_space(3)))
constexpr int GT_STAGE = 32768;
template <class Epi>
__device__ __forceinline__ void gemm_tile(const bf16_t* __restrict__ A, int lda, int M, const bf16_t* __restrict__ Bt, int ldb, int N, int K,
                                          int row0, int col0, Epi epi, unsigned char* lds_generic) {
    LAS unsigned char* lds = (LAS unsigned char*)lds_generic;
    const int tid = tid_(), lane = tid & 63, wave = __builtin_amdgcn_readfirstlane(tid >> 6);
    const int wm = wave >> 2, wn = wave & 3, r = lane & 31, h = lane >> 5;
    const bf16_t* ga[2]; const bf16_t* gb[2];
#pragma unroll
    for (int i = 0; i < 2; ++i) {
        const int trow = 8 * (wave + 8 * i) + (lane >> 3), kp = (lane & 7) ^ ((trow >> 1) & 7);
        int ra = row0 + trow, rb = col0 + trow; ra = ra < M ? ra : M - 1; rb = rb < N ? rb : N - 1;
        ga[i] = A + (size_t)ra * lda + kp * 8; gb[i] = Bt + (size_t)rb * ldb + kp * 8;
    }
    f32x16 acc0, acc1;
#pragma unroll
    for (int i = 0; i < 16; ++i) { acc0[i] = 0.f; acc1[i] = 0.f; }
    const int nk = K >> 6;
#define GT_ISSUE(kt_) do { const int st_ = ((kt_) & 3) * GT_STAGE; _Pragma("unroll") for (int i_ = 0; i_ < 2; ++i_) { \
        __builtin_amdgcn_global_load_lds((const unsigned*)(ga[i_] + (kt_) * 64), (LAS unsigned*)(lds + st_ + (wave + 8 * i_) * 1024), 16, 0, 0); \
        __builtin_amdgcn_global_load_lds((const unsigned*)(gb[i_] + (kt_) * 64), (LAS unsigned*)(lds + st_ + 16384 + (wave + 8 * i_) * 1024), 16, 0, 0); } } while (0)
    __syncthreads();
    GT_ISSUE(0);
    if (nk > 1) GT_ISSUE(1);
    if (nk > 2) GT_ISSUE(2);
    const int xs = (r >> 1) & 7;
    const int aoff = (wm * 64 + r) * 128, boff = 16384 + (wn * 32 + r) * 128;
#pragma unroll 1
    for (int kt = 0; kt < nk; ++kt) {
        const int ahead = nk - 1 - kt;
        if (ahead >= 2) asm volatile("s_waitcnt vmcnt(8)" ::: "memory");
        else if (ahead == 1) asm volatile("s_waitcnt vmcnt(4)" ::: "memory");
        else asm volatile("s_waitcnt vmcnt(0)" ::: "memory");
        __builtin_amdgcn_s_barrier();
        asm volatile("" ::: "memory");
        if (kt + 3 < nk) GT_ISSUE(kt + 3);
        const LAS unsigned char* sb = lds + (kt & 3) * GT_STAGE;
#pragma unroll
        for (int s = 0; s < 4; ++s) {
            const int ko = ((2 * s + h) ^ xs) * 16;
            const bf16x8 a0 = *(const LAS bf16x8*)(sb + aoff + ko);
            const bf16x8 a1 = *(const LAS bf16x8*)(sb + aoff + 32 * 128 + ko);
            const bf16x8 b  = *(const LAS bf16x8*)(sb + boff + ko);
            acc0 = __builtin_amdgcn_mfma_f32_32x32x16_bf16(a0, b, acc0, 0, 0, 0);
            acc1 = __builtin_amdgcn_mfma_f32_32x32x16_bf16(a1, b, acc1, 0, 0, 0);
        }
    }
#undef GT_ISSUE
    __builtin_amdgcn_s_barrier();
    asm volatile("" ::: "memory");
    {
        LAS float* sc = (LAS float*)lds;
#pragma unroll
        for (int i = 0; i < 16; ++i) {
            const int rr = wm * 64 + (i & 3) + 8 * (i >> 2) + 4 * h;
            sc[rr * 132 + wn * 32 + r] = acc0[i];
            sc[(rr + 32) * 132 + wn * 32 + r] = acc1[i];
        }
    }
    __syncthreads();
    {
        const LAS float* sc = (const LAS float*)lds;
        const int c8 = (tid & 15) * 8, col = col0 + c8;
#pragma unroll
        for (int ps = 0; ps < 4; ++ps) {
            const int rl = (tid >> 4) + 32 * ps, row = row0 + rl;
            const f32x4 v0 = *(const LAS f32x4*)(sc + rl * 132 + c8), v1 = *(const LAS f32x4*)(sc + rl * 132 + c8 + 4);
            if (row < M && col < N) { const float v[8] = {v0[0], v0[1], v0[2], v0[3], v1[0], v1[1], v1[2], v1[3]}; epi(row, col, v); }
        }
    }
}

namespace pg8 {
#define PG8_LAS __attribute__((address_space(3)))
typedef unsigned short bf16_t;
typedef short bf16x8 __attribute__((ext_vector_type(8)));
typedef float f32x4 __attribute__((ext_vector_type(4)));
typedef unsigned u32x4 __attribute__((ext_vector_type(4)));
constexpr int BM = 256, BK = 64, HALF = 128, HTB = HALF * BK * 2  , STAGE_BYTES = 8 * HTB, NXCD = 8, WGM = 8;

__host__ __device__ __forceinline__ int lds_byte(int r, int c) { const int st = (r >> 4) * 2 + (c >> 5), rr = r & 15, cc = c & 31, ob = rr * 64 + cc * 2; return st * 1024 + (ob ^ (((ob >> 9) & 1) << 5)); }
__host__ __device__ __forceinline__ void stage_rc(int b, int& R, int& C) { const int st = b / 1024, sb = b % 1024, swz = sb ^ (((sb >> 9) & 1) << 5); R = (st >> 1) * 16 + swz / 64; C = (st & 1) * 32 + (swz % 64) / 2; }
__host__ __device__ __forceinline__ int perm32(int rho) { const int n = rho >> 4, i = rho & 15; return 8 * (i >> 2) + 4 * n + (i & 3); }

struct Unit { int pm, pn; };
struct Gemm { const bf16_t* A; const bf16_t* Bt; int M, N, K; };

struct StaticOrder {
    int nM, nN, nwg, G, c;
    __host__ __device__ void init(int M, int N, int G_, int c_) { nM = M / BM; nN = N / BM; nwg = nM * nN; G = G_; c = c_; }
    __host__ __device__ bool next(int i, Unit& u) const {
        const long L = (long)i * G + c; if (L >= nwg) return false;
        int wgid = (int)L; { const int q = nwg / NXCD, r = nwg % NXCD, xcd = wgid % NXCD, off = wgid / NXCD; wgid = (xcd < r ? xcd * (q + 1) : r * (q + 1) + (xcd - r) * q) + off; }
        const int nig = WGM * nN, gid = wgid / nig, fm = gid * WGM, gsz = (nM - fm) < WGM ? (nM - fm) : WGM;
        u.pm = fm + ((wgid % nig) % gsz); u.pn = (wgid % nig) / gsz; return true;
    }
    __device__ __forceinline__ void a_ready(const Unit&) const {}
    __device__ __forceinline__ void done(const Unit&) const {}
};
template <class Epi, class Sched, bool STAMP = false>
__device__ __forceinline__ void gemm_phase(PG8_LAS unsigned char* lds, const Gemm g, const Sched& S, const Epi& E, unsigned long long* stamps) {
    const int tid = tid_(), wid = __builtin_amdgcn_readfirstlane(tid >> 6), lane = tid & 63, wr = wid >> 2, wc = wid & 3, fr = lane & 15, fq = lane >> 4;
    const int K = g.K, nt = K / BK;
    int ts_lo = 0, ts_hi = 0, nts = 0; const unsigned long long rt_entry = STAMP ? (unsigned long long)0ull : 0ull;
#define PG8_STAMP() do { if (STAMP && wid == 0 && nts < 64) { const unsigned long long _c = (unsigned long long)0ull; \
        ts_lo = (lane == nts) ? (int)(unsigned)_c : ts_lo; ts_hi = (lane == nts) ? (int)(unsigned)(_c >> 32) : ts_hi; ++nts; } } while (0)
    PG8_STAMP();
    unsigned voffA[2], voffB[2];
#pragma unroll
    for (int i = 0; i < 2; ++i) { int R, C; stage_rc(tid * 16 + i * 8192, R, C); const int Rb = Epi::PERM ? ((R & ~31) + perm32(R & 31)) : R;
        voffA[i] = (unsigned)(R * K + C) * 2u; voffB[i] = (unsigned)(Rb * K + C) * 2u; }
    const size_t kstep = (size_t)(BK * 2);
    const size_t hstep = (size_t)HALF * K * 2;
    const size_t tstep = 2 * hstep;
    const unsigned ldsw = (unsigned)wid * 1024u;
    const int aoff = lds_byte(wr * 64 + fr, fq * 8), boff = lds_byte(wc * 32 + fr, fq * 8);
#define PG8_SA(b, h) (((b) * 2 + (h)) * HTB)
#define PG8_SB(b, h) ((4 + (b) * 2 + (h)) * HTB)
#define PG8_STAGE(bufoff, gbase, voff) do { _Pragma("unroll") for (int _i = 0; _i < 2; ++_i) { unsigned vo_ = (voff)[_i]; asm volatile("" : "+v"(vo_));   \
        __builtin_amdgcn_global_load_lds((const unsigned*)((const char*)(gbase) + vo_), (PG8_LAS unsigned*)(lds + (bufoff) + ldsw + _i * 8192), 16, 0, 0); } } while (0)
#define PG8_LDA(dst, b, h) do { _Pragma("unroll") for (int m = 0; m < 4; ++m) _Pragma("unroll") for (int k = 0; k < 2; ++k) dst[m][k] = *(const PG8_LAS bf16x8*)(lds + PG8_SA(b, h) + aoff + m * 2048 + k * 1024); } while (0)
#define PG8_LDB(dst, b, h) do { _Pragma("unroll") for (int n = 0; n < 2; ++n) _Pragma("unroll") for (int k = 0; k < 2; ++k) dst[n][k] = *(const PG8_LAS bf16x8*)(lds + PG8_SB(b, h) + boff + n * 2048 + k * 1024); } while (0)
#define PG8_MMA(ai, bj, At, Bt) do { __builtin_amdgcn_s_setprio(1); _Pragma("unroll") for (int m = 0; m < 4; ++m) _Pragma("unroll") for (int n = 0; n < 2; ++n) _Pragma("unroll") for (int k = 0; k < 2; ++k) \
        acc[ai][bj][m][n] = __builtin_amdgcn_mfma_f32_16x16x32_bf16(Bt[n][k], At[m][k], acc[ai][bj][m][n], 0, 0, 0); __builtin_amdgcn_s_setprio(0); } while (0)
#define PG8_WAIT_V(n) asm volatile("s_waitcnt vmcnt(" #n ")" ::: "memory")
#define PG8_WAIT_L(n) asm volatile("s_waitcnt lgkmcnt(" #n ")" ::: "memory")
#define PG8_BAR __builtin_amdgcn_s_barrier()
#define PG8_SCHED __builtin_amdgcn_sched_barrier(0)
    Unit cur, nxt; int ui = 0;
    if (!S.next(0, cur)) return;
    f32x4 acc[2][2][4][2];
#pragma unroll
    for (int a = 0; a < 2; ++a)
#pragma unroll
        for (int b = 0; b < 2; ++b)
#pragma unroll
            for (int m = 0; m < 4; ++m)
#pragma unroll
                for (int n = 0; n < 2; ++n) acc[a][b][m][n] = (f32x4){0.f, 0.f, 0.f, 0.f};
    bf16x8 At[4][2], B0[2][2], B1[2][2];
    const char* cA = (const char*)g.A + (size_t)cur.pm * tstep; const char* cB = (const char*)g.Bt + (size_t)cur.pn * tstep;
    S.a_ready(cur);
    PG8_STAGE(PG8_SB(0, 0), cB, voffB); PG8_STAGE(PG8_SA(0, 0), cA, voffA); PG8_STAGE(PG8_SB(0, 1), cB + hstep, voffB); PG8_STAGE(PG8_SA(0, 1), cA + hstep, voffA);
    if (wr == 1) PG8_BAR;
    PG8_WAIT_V(4); PG8_BAR;
    PG8_STAGE(PG8_SB(1, 0), cB + kstep, voffB); PG8_STAGE(PG8_SA(1, 0), cA + kstep, voffA); PG8_STAGE(PG8_SB(1, 1), cB + hstep + kstep, voffB);
    PG8_WAIT_V(6); PG8_BAR;
    PG8_STAMP();
    for (;;) {
        const bool has_next = S.next(ui + 1, nxt);
        const char* nA = has_next ? (const char*)g.A + (size_t)nxt.pm * tstep : cA; const char* nB = has_next ? (const char*)g.Bt + (size_t)nxt.pn * tstep : cB;
        for (int t = 0; t < nt; t += 2) {
            const bool last = (t == nt - 2);
            const char* a1 = cA + (size_t)(t + 1) * kstep;
            const char* a2 = last ? nA : cA + (size_t)(t + 2) * kstep; const char* b2 = last ? nB : cB + (size_t)(t + 2) * kstep;
            const char* a3 = a2 + kstep; const char* b3 = b2 + kstep;
            if (last && has_next) S.a_ready(nxt);
            PG8_LDB(B0, 0, 0); PG8_SCHED; PG8_LDA(At, 0, 0); PG8_STAGE(PG8_SA(1, 1), a1 + hstep, voffA);
            PG8_WAIT_L(8); PG8_BAR; PG8_WAIT_L(0); PG8_MMA(0, 0, At, B0); PG8_BAR; PG8_SCHED;
            PG8_LDB(B1, 0, 1); PG8_STAGE(PG8_SB(0, 0), b2, voffB);
            PG8_BAR; PG8_WAIT_L(0); PG8_MMA(0, 1, At, B1); PG8_BAR;
            PG8_LDA(At, 0, 1); PG8_STAGE(PG8_SA(0, 0), a2, voffA);
            PG8_BAR; PG8_WAIT_L(0); PG8_MMA(1, 0, At, B0); PG8_BAR; PG8_SCHED;
            PG8_STAGE(PG8_SB(0, 1), b2 + hstep, voffB);
            PG8_WAIT_V(6); PG8_BAR; PG8_MMA(1, 1, At, B1); PG8_BAR;
            PG8_LDB(B0, 1, 0); PG8_SCHED; PG8_LDA(At, 1, 0); PG8_STAGE(PG8_SA(0, 1), a2 + hstep, voffA);
            PG8_WAIT_L(8); PG8_BAR; PG8_WAIT_L(0); PG8_MMA(0, 0, At, B0); PG8_BAR; PG8_SCHED;
            PG8_LDB(B1, 1, 1); PG8_STAGE(PG8_SB(1, 0), b3, voffB);
            PG8_BAR; PG8_WAIT_L(0); PG8_MMA(0, 1, At, B1); PG8_BAR;
            PG8_LDA(At, 1, 1); PG8_STAGE(PG8_SA(1, 0), a3, voffA);
            PG8_BAR; PG8_WAIT_L(0); PG8_MMA(1, 0, At, B0); PG8_BAR; PG8_SCHED;
            PG8_STAGE(PG8_SB(1, 1), b3 + hstep, voffB);
            PG8_WAIT_V(6); PG8_BAR; PG8_MMA(1, 1, At, B1); PG8_BAR;
        }
        PG8_STAMP();
        if constexpr (!Epi::AFTER_DRAIN) { E(acc, cur, wr, wc, fr, fq); S.done(cur); }
        PG8_STAMP();
        if (!has_next) break;
#pragma unroll
        for (int a = 0; a < 2; ++a)
#pragma unroll
            for (int b = 0; b < 2; ++b)
#pragma unroll
                for (int m = 0; m < 4; ++m)
#pragma unroll
                    for (int n = 0; n < 2; ++n) acc[a][b][m][n] = (f32x4){0.f, 0.f, 0.f, 0.f};
        cur = nxt; cA = nA; cB = nB; ++ui;
    }
    PG8_WAIT_V(0);
    if (wr == 0) PG8_BAR;
    PG8_BAR;
    if constexpr (Epi::AFTER_DRAIN) { E.fused(acc, cur, wr, wc, fr, fq, lds, wid, lane); S.done(cur); }
    PG8_STAMP();
    if (STAMP && wid == 0) { stamps[lane] = lane < nts ? (((unsigned long long)(unsigned)ts_hi << 32) | (unsigned)ts_lo) : 0ull;
        if (lane == 62) stamps[62] = rt_entry; if (lane == 63) stamps[63] = (unsigned long long)0ull; }
#undef PG8_STAMP
#undef PG8_SA
#undef PG8_SB
#undef PG8_STAGE
#undef PG8_LDA
#undef PG8_LDB
#undef PG8_MMA
#undef PG8_WAIT_V
#undef PG8_WAIT_L
#undef PG8_BAR
#undef PG8_SCHED
}
}

template <class F> struct EpiAdapt {
    static constexpr bool PERM = true, AFTER_DRAIN = false;
    F f;
    __device__ __forceinline__ void operator()(const pg8::f32x4 (&acc)[2][2][4][2], const pg8::Unit& u, int wr, int wc, int fr, int fq) const {
#pragma unroll
        for (int ai = 0; ai < 2; ++ai)
#pragma unroll
            for (int m = 0; m < 4; ++m) {
                const int row = u.pm * 256 + ai * 128 + wr * 64 + m * 16 + fr;
#pragma unroll
                for (int bj = 0; bj < 2; ++bj) {
                    const int col = u.pn * 256 + bj * 128 + wc * 32 + 8 * fq;
                    const float v[8] = {acc[ai][bj][m][0][0], acc[ai][bj][m][0][1], acc[ai][bj][m][0][2], acc[ai][bj][m][0][3],
                                        acc[ai][bj][m][1][0], acc[ai][bj][m][1][1], acc[ai][bj][m][1][2], acc[ai][bj][m][1][3]};
                    f(row, col, v);
                    asm volatile("" ::: "memory");
                }
            }
    }
};
template <class F>
__device__ __forceinline__ void gemm_big(const bf16_t* A, const bf16_t* Bt, int M, int N, int K, F f, unsigned char* lds_generic) {
    __syncthreads();
    pg8::Gemm g{A, Bt, M, N, K};
    pg8::StaticOrder S; S.init(M, N, (int)gridDim.x, (int)blockIdx.x);
    EpiAdapt<F> E{f};
    pg8::gemm_phase<EpiAdapt<F>, pg8::StaticOrder, false>((LAS unsigned char*)lds_generic, g, S, E, nullptr);
    __syncthreads();
}

__device__ __forceinline__ void p0_adaln(const Params& p, int item, unsigned char* lds) {
    const int l = item / 96, cb = item % 96, tid = tid_();
    const int kq = tid >> 4, c4 = tid & 15;
    const float* W = p.in[4] + (size_t)l * 1024 * 6144 + cb * 64 + c4 * 4;
    const float* c = p.in[1]; const float* cc = p.in[3];
    float al[4] = {0, 0, 0, 0}, ac[4] = {0, 0, 0, 0};
#pragma unroll 8
    for (int k = kq; k < 1024; k += 32) {
        const float4 w = *(const float4*)(W + (size_t)k * 6144);
        const float sl = siluf_(c[k]), sc = siluf_(cc[k]);
        al[0] += sl * w.x; al[1] += sl * w.y; al[2] += sl * w.z; al[3] += sl * w.w;
        ac[0] += sc * w.x; ac[1] += sc * w.y; ac[2] += sc * w.z; ac[3] += sc * w.w;
    }
    float* red = (float*)lds;
    __syncthreads();
#pragma unroll
    for (int e = 0; e < 4; ++e) { red[(kq * 2 + 0) * 64 + c4 * 4 + e] = al[e]; red[(kq * 2 + 1) * 64 + c4 * 4 + e] = ac[e]; }
    __syncthreads();
    if (tid < 128) {
        const int s = tid >> 6, cidx = tid & 63;
        float sum = 0.f;
        for (int q = 0; q < 32; ++q) sum += red[(q * 2 + s) * 64 + cidx];
        const int col = cb * 64 + cidx;
        sum += p.in[5][l * 6144 + col];
        ((float*)(p.ws + WS_MOD))[(l * 2 + s) * 6144 + col] = sum;
    }
}
__device__ __forceinline__ void p0_transpose(const float* __restrict__ src, int K, int N, bf16_t* __restrict__ dst, int tile, unsigned char* lds) {
    const int ntn = (N + 63) / 64, tk = tile / ntn, tn = tile % ntn, tid = tid_();
    float* s = (float*)lds;
    __syncthreads();
    for (int e = tid; e < 64 * 64; e += NTHREADS) {
        const int kk = e >> 6, nn = e & 63; const int n = tn * 64 + nn;
        s[kk * 65 + nn] = n < N ? src[(size_t)(tk * 64 + kk) * N + n] : 0.f;
    }
    __syncthreads();
    {
        const int nn = tid >> 3, kg = (tid & 7) * 8; const int n = tn * 64 + nn;
        if (n < N) {
            float f[8];
#pragma unroll
            for (int e = 0; e < 8; ++e) f[e] = s[(kg + e) * 65 + nn];
            *(uint4*)(dst + (size_t)n * K + tk * 64 + kg) = pack8(f);
        }
    }
}
__device__ __forceinline__ void cvt_chunk(const float* __restrict__ src, bf16_t* __restrict__ dst, size_t item) {
    const size_t o = item * 4096 + (size_t)tid_() * 8;
    const float4 a = *(const float4*)(src + o), b = *(const float4*)(src + o + 4);
    uint4 q; q.x = pack2(a.x, a.y); q.y = pack2(a.z, a.w); q.z = pack2(b.x, b.y); q.w = pack2(b.z, b.w);
    *(uint4*)(dst + o) = q;
}
typedef float v32f_t __attribute__((ext_vector_type(32)));
typedef _Float16 v32h_t __attribute__((ext_vector_type(32)));
typedef unsigned v6u_t __attribute__((ext_vector_type(6)));
struct __attribute__((packed, aligned(8))) U6 { unsigned a, b, c, d, e, f; };
constexpr int PREC = 1536;
__device__ __forceinline__ void peer_tables_item(const Params& p, int item, int l) {
    const int lane = tid_() & 63, ex = item * 8 + (tid_() >> 6);
    const float* su = p.in[29] + ((size_t)l * 16384 + ex) * 1024 + lane * 16;
    const float* sv = p.in[30] + ((size_t)l * 16384 + ex) * 1024 + lane * 16;
    float4 u[4], v[4]; float amu = 0.f, amv = 0.f;
#pragma unroll
    for (int q = 0; q < 4; ++q) { u[q] = *(const float4*)(su + q * 4); v[q] = *(const float4*)(sv + q * 4); }
#pragma unroll
    for (int q = 0; q < 4; ++q) {
        amu = fmaxf(amu, fmaxf(fmaxf(fabsf(u[q].x), fabsf(u[q].y)), fmaxf(fabsf(u[q].z), fabsf(u[q].w))));
        amv = fmaxf(amv, fmaxf(fmaxf(fabsf(v[q].x), fabsf(v[q].y)), fmaxf(fabsf(v[q].z), fabsf(v[q].w))));
    }
#pragma unroll
    for (int o = 32; o > 0; o >>= 1) { amu = fmaxf(amu, __shfl_xor(amu, o, 64)); amv = fmaxf(amv, __shfl_xor(amv, o, 64)); }
    const float scu = amu > 0.f ? 7.0f / amu : 1.f, scv = amv > 0.f ? 7.0f / amv : 1.f;
    v32h_t x;
#pragma unroll
    for (int q = 0; q < 4; ++q) {
        x[4 * q + 0] = (_Float16)(u[q].x * scu); x[4 * q + 1] = (_Float16)(u[q].y * scu); x[4 * q + 2] = (_Float16)(u[q].z * scu); x[4 * q + 3] = (_Float16)(u[q].w * scu);
        x[16 + 4 * q + 0] = (_Float16)(v[q].x * scv); x[16 + 4 * q + 1] = (_Float16)(v[q].y * scv); x[16 + 4 * q + 2] = (_Float16)(v[q].z * scv); x[16 + 4 * q + 3] = (_Float16)(v[q].w * scv);
    }
    const v6u_t pk = __builtin_amdgcn_cvt_scalef32_pk32_fp6_f16(x, 1.0f);
    U6 o; o.a = pk[0]; o.b = pk[1]; o.c = pk[2]; o.d = pk[3]; o.e = pk[4]; o.f = pk[5];
    *(U6*)(p.ws + WS_PUV + (size_t)ex * PREC + lane * 24) = o;
    if (lane == 0) { float* psc = (float*)(p.ws + WS_PSC); psc[ex] = amu > 0.f ? amu / 7.0f : 1.f; psc[16384 + ex] = amv > 0.f ? amv / 7.0f : 1.f; }
}

__device__ __forceinline__ void sincos_d(double x, double& s, double& c) {
    const double TWO_OVER_PI = 0.63661977236758134308, PIO2_HI = 1.57079632679489655800e+00, PIO2_LO = 6.12323399573676603587e-17;
    const double kf = rint(x * TWO_OVER_PI);
    const double y = (x - kf * PIO2_HI) - kf * PIO2_LO;
    const double y2 = y * y;
    double sp = -1.0 / 1307674368000.0;
    sp = sp * y2 + 1.0 / 6227020800.0; sp = sp * y2 - 1.0 / 39916800.0; sp = sp * y2 + 1.0 / 362880.0; sp = sp * y2 - 1.0 / 5040.0;
    sp = sp * y2 + 1.0 / 120.0; sp = sp * y2 - 1.0 / 6.0; sp = sp * y2 + 1.0; sp *= y;
    double cp = 1.0 / 20922789888000.0;
    cp = cp * y2 - 1.0 / 87178291200.0; cp = cp * y2 + 1.0 / 479001600.0; cp = cp * y2 - 1.0 / 3628800.0; cp = cp * y2 + 1.0 / 40320.0;
    cp = cp * y2 - 1.0 / 720.0; cp = cp * y2 + 1.0 / 24.0; cp = cp * y2 - 0.5; cp = cp * y2 + 1.0;
    const int q = ((int)kf) & 3;
    s = (q == 0) ? sp : (q == 1) ? cp : (q == 2) ? -sp : -cp;
    c = (q == 0) ? cp : (q == 1) ? -sp : (q == 2) ? -cp : sp;
}
__device__ __forceinline__ void p0_s5_tables(const Params& p, int item4, unsigned char* lds) {
    const int item = item4 >> 2, qt = item4 & 3;
    const int di = item >> 5, g = item & 31, tid = tid_();
    float2* apw = (float2*)lds;
    float2* Bb = apw + 64 * 65;
    float2* Cc = Bb + 64 * 16;
    __syncthreads();
    if (tid < 64) {
        const int pidx = (di * 32 + g) * 64 + tid;
        float lr = p.in[10][pidx]; lr = lr < -1e-4f ? lr : -1e-4f;
        const float li = p.in[11][pidx];
        const float dt = expf(p.in[12][di * 32 + g]);
        const double mag = (double)expf(lr * dt);
        double sn, cs; sincos_d((double)li * (double)dt, sn, cs);
        const double are = mag * cs, aim = mag * sn;
        double pr = 1.0, pi_ = 0.0;
        for (int t = 0; t <= 64; ++t) {
            apw[tid * 65 + t] = make_float2((float)pr, (float)pi_);
            const double nr = pr * are - pi_ * aim, ni = pr * aim + pi_ * are; pr = nr; pi_ = ni;
        }
        if (qt == 0) ((float2*)(p.ws + WS_A64))[(di * 32 + g) * 64 + tid] = apw[tid * 65 + 64];
        const double den = (double)lr * lr + (double)li * li;
        const double fre = ((are - 1.0) * lr + aim * li) / den, fim = (aim * lr - (are - 1.0) * li) / den;
        for (int hh = 0; hh < 16; ++hh) {
            const double br = p.in[13][(size_t)pidx * 16 + hh], bi = p.in[14][(size_t)pidx * 16 + hh];
            Bb[tid * 16 + hh] = make_float2((float)(fre * br - fim * bi), (float)(fre * bi + fim * br));
        }
    }
    for (int e = tid; e < 1024; e += NTHREADS) {
        const size_t gi = ((size_t)(di * 32 + g) * 16) * 64 + e;
        Cc[e] = make_float2(p.in[15][gi], p.in[16][gi]);
    }
    __syncthreads();
    float* ktab = (float*)(p.ws + WS_KTAB) + (size_t)(di * 32 + g) * 64 * 256;
    for (int o = qt * 4096 + tid; o < (qt + 1) * 4096; o += NTHREADS) {
        const int tau = o >> 8, hh = (o >> 4) & 15, h2 = o & 15;
        float acc = 0.f;
        for (int pp = 0; pp < 64; ++pp) {
            const float2 a = apw[pp * 65 + tau], c = Cc[hh * 64 + pp], b = Bb[pp * 16 + h2];
            const float cr = c.x * a.x - c.y * a.y, ci = c.x * a.y + c.y * a.x;
            acc += cr * b.x - ci * b.y;
        }
        ktab[o] = acc;
    }
    bf16_t* ms5 = (bf16_t*)(p.ws + WS_MS5) + (size_t)g * 1280 * 1024;
    for (int t = qt * 4096 + tid; t < (qt + 1) * 4096; t += NTHREADS) {
        const int row = t >> 7, k8 = t & 127; const int ri = row >> 6, pp = row & 63, j = k8 >> 1, h0 = (k8 & 1) * 8;
        const float2 a = apw[pp * 65 + (di == 0 ? 63 - j : j)];
        float f[8];
#pragma unroll
        for (int e = 0; e < 8; ++e) { const float2 b = Bb[pp * 16 + h0 + e]; f[e] = ri == 0 ? (a.x * b.x - a.y * b.y) : (a.x * b.y + a.y * b.x); }
        *(uint4*)(ms5 + (size_t)(1024 + di * 128 + row) * 1024 + k8 * 8) = pack8(f);
    }
    bf16_t* o5 = (bf16_t*)(p.ws + WS_O5) + (size_t)g * 1024 * 256;
    for (int t = qt * 4096 + tid; t < (qt + 1) * 4096; t += NTHREADS) {
        const int n = t >> 4, q = t & 15; const int ri = q >> 3, p0 = (q & 7) * 8, i = n >> 4, hh = n & 15;
        float f[8];
#pragma unroll
        for (int e = 0; e < 8; ++e) {
            const float2 a = apw[(p0 + e) * 65 + (di == 0 ? i + 1 : 64 - i)], c = Cc[hh * 64 + p0 + e];
            f[e] = ri == 0 ? (c.x * a.x - c.y * a.y) : -(c.x * a.y + c.y * a.x);
        }
        *(uint4*)(o5 + (size_t)n * 256 + di * 128 + ri * 64 + p0) = pack8(f);
    }
}

template <bool SRC_BF16>
__device__ __forceinline__ void norm_mod_row(const void* __restrict__ srcv, const float* __restrict__ g, const float* __restrict__ shift,
                                             const float* __restrict__ scale, bf16_t* __restrict__ dst, int lane) {
    float4 v[4]; float ss = 0.f;
#pragma unroll
    for (int k = 0; k < 4; ++k) {
        if (SRC_BF16) { const uint2 q = *(const uint2*)((const bf16_t*)srcv + k * 256 + lane * 4); v[k] = make_float4(lo2f(q.x), hi2f(q.x), lo2f(q.y), hi2f(q.y)); }
        else v[k] = *(const float4*)((const float*)srcv + k * 256 + lane * 4);
        ss += v[k].x * v[k].x + v[k].y * v[k].y + v[k].z * v[k].z + v[k].w * v[k].w;
    }
    ss = wave_sum(ss);
    const float rs = rsqrtf(ss * (1.f / 1024.f) + 1e-6f);
#pragma unroll
    for (int k = 0; k < 4; ++k) {
        const int c = k * 256 + lane * 4;
        const float4 gg = *(const float4*)(g + c), sh = *(const float4*)(shift + c), sc = *(const float4*)(scale + c);
        uint2 o;
        o.x = pack2(v[k].x * rs * gg.x * (1.f + sc.x) + sh.x, v[k].y * rs * gg.y * (1.f + sc.y) + sh.y);
        o.y = pack2(v[k].z * rs * gg.z * (1.f + sc.z) + sh.z, v[k].w * rs * gg.w * (1.f + sc.w) + sh.w);
        *(uint2*)(dst + c) = o;
    }
}
__device__ __forceinline__ void norm_rows_item(const Params& p, int item, int l, const float* g, int js, bool from_inputs) {
    const int row = item * 8 + (tid_() >> 6), lane = tid_() & 63;
    bf16_t* dst = (bf16_t*)(p.ws + WS_ACT) + (size_t)row * 1024;
    if (from_inputs) norm_mod_row<false>(row < SEQ ? p.in[0] + (size_t)row * 1024 : p.in[2] + (size_t)(row - SEQ) * 1024, g, modp(p, l, row, js), modp(p, l, row, js + 1), dst, lane);
    else norm_mod_row<true>((const bf16_t*)(p.ws + WS_H) + (size_t)row * 1024, g, modp(p, l, row, js), modp(p, l, row, js + 1), dst, lane);
}
__device__ __forceinline__ void s5_mintra_item(const Params& p, int item) {
    const int g = item >> 6, i = item & 63;
    const float* kt0 = (const float*)(p.ws + WS_KTAB) + (size_t)(0 * 32 + g) * 64 * 256;
    const float* kt1 = (const float*)(p.ws + WS_KTAB) + (size_t)(1 * 32 + g) * 64 * 256;
    const float* dsk = p.in[17] + g * 16;
    bf16_t* ms5 = (bf16_t*)(p.ws + WS_MS5) + (size_t)g * 1280 * 1024;
    for (int t = tid_(); t < 16 * 128; t += NTHREADS) {
        const int hh = t >> 7, k8 = t & 127, j = k8 >> 1, h0 = (k8 & 1) * 8;
        float f[8];
        if (j < i) { const float* s = kt0 + ((i - j) * 16 + hh) * 16 + h0;
#pragma unroll
            for (int e = 0; e < 8; ++e) f[e] = s[e]; }
        else if (j > i) { const float* s = kt1 + ((j - i) * 16 + hh) * 16 + h0;
#pragma unroll
            for (int e = 0; e < 8; ++e) f[e] = s[e]; }
        else { const float* s0 = kt0 + hh * 16 + h0; const float* s1 = kt1 + hh * 16 + h0;
#pragma unroll
            for (int e = 0; e < 8; ++e) f[e] = s0[e] + s1[e] + ((h0 + e) == hh ? dsk[hh] : 0.f); }
        *(uint4*)(ms5 + (size_t)(i * 16 + hh) * 1024 + k8 * 8) = pack8(f);
    }
}

struct EpiEvenIn {
    bf16_t* pa; bf16_t* ug;
    __device__ __forceinline__ void operator()(int row, int col, const float* v) const {
        if (col < 1536) *(uint4*)(pa + (size_t)row * 1536 + col) = pack8(v);
        else { const int c2 = col - 1536; *(uint4*)(ug + ((size_t)(c2 >> 4) * NCH + (row >> 6)) * 1024 + (row & 63) * 16 + (c2 & 15)) = pack8(v); }
    }
};
struct EpiS5Local {
    bf16_t* yl; float* lst; int g;
    __device__ __forceinline__ void operator()(int row, int col, const float* v) const {
        if (col < 1024) *(uint4*)(yl + (size_t)(row * 64 + (col >> 4)) * 512 + g * 16 + (col & 15)) = pack8(v);
        else { float* d = lst + ((size_t)g * NCH + row) * 256 + (col - 1024);
               *(float4*)d = make_float4(v[0], v[1], v[2], v[3]); *(float4*)(d + 4) = make_float4(v[4], v[5], v[6], v[7]); }
    }
};
struct EpiS5Out {
    const bf16_t* yl; bf16_t* gs; int g;
    __device__ __forceinline__ void operator()(int row, int col, const float* v) const {
        const size_t o = (size_t)(row * 64 + (col >> 4)) * 512 + g * 16 + (col & 15);
        float y[8]; unpack8(*(const uint4*)(yl + o), y);
        float f[8];
#pragma unroll
        for (int e = 0; e < 8; ++e) f[e] = gelu_tanh(v[e] + y[e]);
        *(uint4*)(gs + o) = pack8(f);
    }
};
struct EpiGlu {
    const bf16_t* gs; const float* b; bf16_t* cb;
    __device__ __forceinline__ void operator()(int row, int col, const float* v) const {
        float g[8], f[8]; unpack8(*(const uint4*)(gs + (size_t)row * 512 + col), g);
#pragma unroll
        for (int e = 0; e < 8; ++e) f[e] = g[e] * sigmoidf_(v[e] + b[col + e]);
        *(uint4*)(cb + (size_t)row * 1024 + 512 + col) = pack8(f);
    }
};
struct EpiResid {
    const float* x; const float* ctx; bf16_t* hbuf; const float* mod; int l; bool from_inputs;
    __device__ __forceinline__ void operator()(int row, int col, const float* v) const {
        bf16_t* h = hbuf + (size_t)row * 1024 + col;
        float b[8];
        if (from_inputs) {
            const float* bp = row < SEQ ? x + (size_t)row * 1024 + col : ctx + (size_t)(row - SEQ) * 1024 + col;
            const float4 b0 = *(const float4*)bp, b1 = *(const float4*)(bp + 4);
            b[0] = b0.x; b[1] = b0.y; b[2] = b0.z; b[3] = b0.w; b[4] = b1.x; b[5] = b1.y; b[6] = b1.z; b[7] = b1.w;
        } else unpack8(*(const uint4*)h, b);
        const float* mp = mod + ((l * 2 + (row >= SEQ ? 1 : 0)) * 6 + 2) * 1024 + col;
        const float4 m0 = *(const float4*)mp, m1 = *(const float4*)(mp + 4);
        const float o[8] = {b[0] + m0.x * v[0], b[1] + m0.y * v[1], b[2] + m0.z * v[2], b[3] + m0.w * v[3], b[4] + m1.x * v[4], b[5] + m1.y * v[5], b[6] + m1.z * v[6], b[7] + m1.w * v[7]};
        *(uint4*)h = pack8(o);
    }
};
struct EpiBf16 {
    bf16_t* dst; int ld;
    __device__ __forceinline__ void operator()(int row, int col, const float* v) const { *(uint4*)(dst + (size_t)row * ld + col) = pack8(v); }
};
struct EpiScore {
    unsigned short* dst; int coff;
    __device__ __forceinline__ void operator()(int row, int col, const float* v) const {
        typedef _Float16 h2 __attribute__((ext_vector_type(2)));
        u32x4 o;
#pragma unroll
        for (int e = 0; e < 4; ++e) { const h2 hv = {(_Float16)v[2 * e], (_Float16)v[2 * e + 1]}; o[e] = __builtin_bit_cast(unsigned, hv); }
        *(u32x4*)(dst + (size_t)row * 2048 + coff + col) = o;
    }
};
struct EpiOddIn {
    bf16_t* qkvr; bf16_t* z; float* ab;
    __device__ __forceinline__ void operator()(int row, int col, const float* v) const {
        if (col < 3072) *(uint4*)(qkvr + (size_t)row * 3072 + col) = pack8(v);
        else if (col < 4096) *(uint4*)(z + (size_t)row * 1024 + (col - 3072)) = pack8(v);
        else { float* d = ab + (size_t)row * 32 + (col - 4096); *(float4*)d = make_float4(v[0], v[1], v[2], v[3]); *(float4*)(d + 4) = make_float4(v[4], v[5], v[6], v[7]); }
    }
};

__device__ __forceinline__ void s5_scan(const Params& p) {
    const int gt = blockIdx.x * NTHREADS + tid_();
    if (gt >= 4096) return;
    const int di = gt >> 11, g = (gt >> 6) & 31, pp = gt & 63;
    const float2 a = ((const float2*)(p.ws + WS_A64))[(di * 32 + g) * 64 + pp];
    const float* lst = (const float*)(p.ws + WS_LST) + (size_t)g * NCH * 256 + di * 128 + pp;
    bf16_t* a5 = (bf16_t*)(p.ws + WS_A5) + (size_t)g * NCH * 256 + di * 128 + pp;
    float sr = 0.f, si = 0.f;
    for (int s0 = 0; s0 < NCH; s0 += 4) {
        int c[4]; float lr[4], li[4];
#pragma unroll
        for (int u = 0; u < 4; ++u) {
            const int s = s0 + u;
            c[u] = di == 0 ? (s < 4 ? NCH_LAT + s : s - 4) : (s < 4 ? NCH - 1 - s : NCH - 1 - s);
            lr[u] = lst[(size_t)c[u] * 256]; li[u] = lst[(size_t)c[u] * 256 + 64];
        }
#pragma unroll
        for (int u = 0; u < 4; ++u) {
            a5[(size_t)c[u] * 256] = f2bf(sr); a5[(size_t)c[u] * 256 + 64] = f2bf(si);
            const float nr = a.x * sr - a.y * si + lr[u], ni = a.x * si + a.y * sr + li[u]; sr = nr; si = ni;
        }
    }
}

__device__ __forceinline__ void even_conv_item(const Params& p, int item) {
    const bf16_t* pa = (const bf16_t*)(p.ws + WS_PA); bf16_t* cb = (bf16_t*)(p.ws + WS_CB);
    const float* cw = p.in[9];
    for (int t = tid_(); t < 64 * 64; t += NTHREADS) {
        const int row = item * 64 + (t >> 6), c0 = (t & 63) * 8;
        bool hasp, hasn;
        if (row < SEQ) { hasp = (row & 63) != 0; hasn = (row & 63) != 63; } else { hasp = row != SEQ; hasn = row != R - 1; }
        float m[3][8];
#pragma unroll
        for (int d = 0; d < 3; ++d) {
            const bool ok = d == 1 || (d == 0 ? hasp : hasn);
            if (ok) {
                const bf16_t* rp = pa + (size_t)(row + d - 1) * 1536 + c0;
                float u[8], gi[8]; unpack8(*(const uint4*)rp, u); unpack8(*(const uint4*)(rp + 512), gi);
#pragma unroll
                for (int e = 0; e < 8; ++e) m[d][e] = u[e] * gi[e];
            } else {
#pragma unroll
                for (int e = 0; e < 8; ++e) m[d][e] = 0.f;
            }
        }
        float go[8], f[8]; unpack8(*(const uint4*)(pa + (size_t)row * 1536 + 1024 + c0), go);
#pragma unroll
        for (int e = 0; e < 8; ++e) f[e] = go[e] * (m[0][e] * cw[c0 + e] + m[1][e] * cw[512 + c0 + e] + m[2][e] * cw[1024 + c0 + e]);
        *(uint4*)(cb + (size_t)row * 1024 + c0) = pack8(f);
    }
}

__device__ __forceinline__ unsigned ord_enc(float v) { const unsigned u = __float_as_uint(v); return (u & 0x80000000u) ? ~u : (u | 0x80000000u); }
__device__ __forceinline__ float ord_dec(unsigned e) { const unsigned u = (e & 0x80000000u) ? (e & 0x7FFFFFFFu) : ~e; return __uint_as_float(u); }
#define TOP_INSERT(key) { unsigned x_ = (key); _Pragma("unroll") for (int k_ = 0; k_ < 16; ++k_) { const unsigned hi_ = top[k_] > x_ ? top[k_] : x_; x_ = top[k_] > x_ ? x_ : top[k_]; top[k_] = hi_; } }
__device__ __forceinline__ void peer_route_item(const Params& p, int item, int nrows, unsigned char* lds) {
    const int tid = tid_();
    const int row = item * 64 + (tid >> 3), head = tid & 7;
    unsigned* sIdx = (unsigned*)lds;
    __syncthreads();
    if (row < nrows) {
        const unsigned short* sc = (const unsigned short*)(p.ws + WS_SC) + (size_t)row * 2048 + head * 256;
        float fa[16], fb[16];
        {
#define CE_DESC(a_, b_) { const unsigned hi_ = (a_) > (b_) ? (a_) : (b_); const unsigned lo_ = (a_) > (b_) ? (b_) : (a_); (a_) = hi_; (b_) = lo_; }
            unsigned topa[16], topb[16];
#pragma unroll 1
            for (int blk = 0; blk < 8; ++blk) {
                unsigned ka[16], kb[16];
#pragma unroll
                for (int c2 = 0; c2 < 2; ++c2) {
                    const int c = blk * 2 + c2;
                    const uint4 qa = *(const uint4*)(sc + c * 8), qb = *(const uint4*)(sc + 128 + c * 8);
                    const unsigned wa[4] = {qa.x, qa.y, qa.z, qa.w}, wb[4] = {qb.x, qb.y, qb.z, qb.w};
#pragma unroll
                    for (int e = 0; e < 8; ++e) {
                        const unsigned short ha = (unsigned short)((e & 1) ? (wa[e >> 1] >> 16) : (wa[e >> 1] & 0xFFFFu));
                        const unsigned short hb = (unsigned short)((e & 1) ? (wb[e >> 1] >> 16) : (wb[e >> 1] & 0xFFFFu));
                        ka[c2 * 8 + e] = (ord_enc((float)__builtin_bit_cast(_Float16, ha)) & ~0x7Fu) | (unsigned)(c * 8 + e);
                        kb[c2 * 8 + e] = (ord_enc((float)__builtin_bit_cast(_Float16, hb)) & ~0x7Fu) | (unsigned)(c * 8 + e);
                    }
                }
#pragma unroll
                for (int k = 2; k <= 16; k <<= 1) {
#pragma unroll
                    for (int j = k >> 1; j > 0; j >>= 1) {
#pragma unroll
                        for (int i = 0; i < 16; ++i) {
                            const int l2 = i ^ j;
                            if (l2 > i) {
                                if ((i & k) == 0) { CE_DESC(ka[i], ka[l2]); CE_DESC(kb[i], kb[l2]); }
                                else { CE_DESC(ka[l2], ka[i]); CE_DESC(kb[l2], kb[i]); }
                            }
                        }
                    }
                }
                if (blk == 0) {
#pragma unroll
                    for (int i = 0; i < 16; ++i) { topa[i] = ka[i]; topb[i] = kb[i]; }
                } else {
#pragma unroll
                    for (int i = 0; i < 16; ++i) { topa[i] = topa[i] > ka[15 - i] ? topa[i] : ka[15 - i]; topb[i] = topb[i] > kb[15 - i] ? topb[i] : kb[15 - i]; }
#pragma unroll
                    for (int j = 8; j > 0; j >>= 1) {
#pragma unroll
                        for (int i = 0; i < 16; ++i) { const int l2 = i ^ j; if (l2 > i) { CE_DESC(topa[i], topa[l2]); CE_DESC(topb[i], topb[l2]); } }
                    }
                }
            }
#undef CE_DESC
#pragma unroll
            for (int k = 0; k < 16; ++k) {
                sIdx[k * NTHREADS + tid] = topa[k] & 0x7Fu; sIdx[(16 + k) * NTHREADS + tid] = topb[k] & 0x7Fu;
                fa[k] = ord_dec(topa[k] & ~0x7Fu); fb[k] = ord_dec(topb[k] & ~0x7Fu);
            }
        }
        unsigned top[16];
#pragma unroll
        for (int k = 0; k < 16; ++k) top[k] = 0u;
#pragma unroll
        for (int i = 0; i < 16; ++i) {
#pragma unroll
            for (int j = 0; j < 16; ++j) {
                if ((i + 1) * (j + 1) <= 16) { TOP_INSERT((ord_enc(fa[i] + fb[j]) & ~0xFFu) | (unsigned)(i * 16 + j)); }
            }
        }
        float ev[16]; float m = ord_dec(top[0] & ~0xFFu), sum = 0.f;
        int* idxo = (int*)(p.ws + WS_IDX) + (size_t)row * 128 + head * 16;
        float* go = (float*)(p.ws + WS_GATE) + (size_t)row * 128 + head * 16;
#pragma unroll
        for (int k = 0; k < 16; ++k) { ev[k] = __expf(ord_dec(top[k] & ~0xFFu) - m); sum += ev[k]; }
        const float inv = 1.f / sum;
#pragma unroll
        for (int k = 0; k < 16; ++k) {
            const unsigned pos = top[k] & 0xFFu;
            const unsigned ia = sIdx[(pos >> 4) * NTHREADS + tid], ib = sIdx[(16 + (pos & 15)) * NTHREADS + tid];
            idxo[k] = (int)(ia * 128u + ib); go[k] = ev[k] * inv;
        }
    }
}

__device__ __forceinline__ void peer_gather_experts(const Params& p, int row, int h_beg, int h_end, int e_beg, int e_end, float (&y)[16]) {
    const int lane = tid_() & 63;
    const bf16_t* xr = (const bf16_t*)(p.ws + WS_ACT) + (size_t)row * 1024 + lane * 16;
    const unsigned char* PE = p.ws + WS_PUV + lane * 24;
    const float* psc = (const float*)(p.ws + WS_PSC);
    float x[16];
    unpack8(*(const uint4*)xr, x); unpack8(*(const uint4*)(xr + 8), x + 8);
    const int* idxp = (const int*)(p.ws + WS_IDX) + (size_t)row * 128; const float* gp = (const float*)(p.ws + WS_GATE) + (size_t)row * 128;
#pragma unroll 1
    for (int half = h_beg; half < h_end; ++half) {
        const int myidx = idxp[half * 64 + lane];
        const float myus = psc[myidx], mygv = gp[half * 64 + lane] * psc[16384 + myidx];
        U6 ea[4], eb[4];
#define PG_LOAD(arr, e0_) do { _Pragma("unroll") for (int u_ = 0; u_ < 4; ++u_) { const int id_ = __builtin_amdgcn_readlane(myidx, (e0_) + u_); arr[u_] = *(const U6*)(PE + (size_t)id_ * PREC); } } while (0)
#define PG_PROC(arr, e0_) do { _Pragma("unroll") for (int u_ = 0; u_ < 4; ++u_) { \
            const v6u_t pk_ = {arr[u_].a, arr[u_].b, arr[u_].c, arr[u_].d, arr[u_].e, arr[u_].f}; \
            const v32f_t f_ = __builtin_amdgcn_cvt_scalef32_pk32_f32_fp6(pk_, 1.0f); \
            f32x2_t a2_ = {0.f, 0.f}; \
            _Pragma("unroll") for (int e_ = 0; e_ < 16; e_ += 2) { const f32x2_t fv_ = {f_[e_], f_[e_ + 1]}; const f32x2_t xv_ = {x[e_], x[e_ + 1]}; a2_ = __builtin_elementwise_fma(fv_, xv_, a2_); } \
            const float dsum_ = wave_sum_dpp(a2_.x + a2_.y); \
            const float us_ = __int_as_float(__builtin_amdgcn_readlane(__float_as_int(myus), (e0_) + u_)); \
            const float gv_ = __int_as_float(__builtin_amdgcn_readlane(__float_as_int(mygv), (e0_) + u_)); \
            const float coef_ = gelu_fast(dsum_ * us_) * gv_; \
            _Pragma("unroll") for (int e_ = 0; e_ < 16; e_ += 2) { const f32x2_t fv_ = {f_[16 + e_], f_[17 + e_]}; const f32x2_t cv_ = {coef_, coef_}; f32x2_t yv_ = {y[e_], y[e_ + 1]}; \
                yv_ = __builtin_elementwise_fma(cv_, fv_, yv_); y[e_] = yv_.x; y[e_ + 1] = yv_.y; } \
            if (u_ & 1) __builtin_amdgcn_sched_barrier(0); } } while (0)
        PG_LOAD(ea, e_beg);
#pragma unroll 1
        for (int e0 = e_beg; e0 < e_end; e0 += 8) {
            PG_LOAD(eb, e0 + 4);
            PG_PROC(ea, e0);
            if (e0 + 8 < e_end) PG_LOAD(ea, e0 + 8);
            PG_PROC(eb, e0 + 4);
        }
#undef PG_LOAD
#undef PG_PROC
    }
}
__device__ __forceinline__ void peer_gather_finish(const Params& p, int row, int l, bool last, const float (&y)[16]) {
    const int lane = tid_() & 63;
    bf16_t* h = (bf16_t*)(p.ws + WS_H) + (size_t)row * 1024 + lane * 16;
    const float* m5 = modp(p, l, row, 5) + lane * 16;
    float hv[16];
    unpack8(*(const uint4*)h, hv); unpack8(*(const uint4*)(h + 8), hv + 8);
#pragma unroll
    for (int q = 0; q < 4; ++q) {
        const float4 g0 = *(const float4*)(m5 + q * 4);
        hv[q * 4 + 0] += g0.x * y[q * 4 + 0]; hv[q * 4 + 1] += g0.y * y[q * 4 + 1];
        hv[q * 4 + 2] += g0.z * y[q * 4 + 2]; hv[q * 4 + 3] += g0.w * y[q * 4 + 3];
    }
    if (!last) {
        *(uint4*)h = pack8(hv); *(uint4*)(h + 8) = pack8(hv + 8);
        float ss = 0.f;
#pragma unroll
        for (int e = 0; e < 16; ++e) ss += hv[e] * hv[e];
        ss = wave_sum(ss);
        const float rs = rsqrtf(ss * (1.f / 1024.f) + 1e-6f);
        const float* g1 = p.in[6] + (l + 1) * 1024 + lane * 16; const float* sh = modp(p, l + 1, row, 0) + lane * 16; const float* sc = modp(p, l + 1, row, 1) + lane * 16;
        float o[16];
#pragma unroll
        for (int q = 0; q < 4; ++q) {
            const float4 gg = *(const float4*)(g1 + q * 4), s4 = *(const float4*)(sh + q * 4), c4 = *(const float4*)(sc + q * 4);
            o[q * 4 + 0] = hv[q * 4 + 0] * rs * gg.x * (1.f + c4.x) + s4.x; o[q * 4 + 1] = hv[q * 4 + 1] * rs * gg.y * (1.f + c4.y) + s4.y;
            o[q * 4 + 2] = hv[q * 4 + 2] * rs * gg.z * (1.f + c4.z) + s4.z; o[q * 4 + 3] = hv[q * 4 + 3] * rs * gg.w * (1.f + c4.w) + s4.w;
        }
        bf16_t* act = (bf16_t*)(p.ws + WS_ACT) + (size_t)row * 1024 + lane * 16;
        *(uint4*)act = pack8(o); *(uint4*)(act + 8) = pack8(o + 8);
    } else {
        float ss = 0.f;
#pragma unroll
        for (int e = 0; e < 16; ++e) ss += hv[e] * hv[e];
        ss = wave_sum(ss);
        const float rs = rsqrtf(ss * (1.f / 1024.f) + 1e-6f);
        const float* fg = p.in[31] + lane * 16; float* o = p.out + (size_t)row * 1024 + lane * 16;
#pragma unroll
        for (int q = 0; q < 4; ++q) {
            const float4 g0 = *(const float4*)(fg + q * 4);
            *(float4*)(o + q * 4) = make_float4(hv[q * 4 + 0] * rs * g0.x, hv[q * 4 + 1] * rs * g0.y, hv[q * 4 + 2] * rs * g0.z, hv[q * 4 + 3] * rs * g0.w);
        }
    }
}

__device__ __forceinline__ void peer_gather_row(const Params& p, int row, int l, bool last) {
    float y[16];
#pragma unroll
    for (int e = 0; e < 16; ++e) y[e] = 0.f;
    peer_gather_experts(p, row, 0, 2, 0, 64, y);
    peer_gather_finish(p, row, l, last, y);
}
__device__ __forceinline__ void peer_gather_row_split(const Params& p, int row, int l, unsigned char* lds) {
    const int tid = tid_(), lane = tid & 63, wave = tid >> 6;
    float y[16];
#pragma unroll
    for (int e = 0; e < 16; ++e) y[e] = 0.f;
    peer_gather_experts(p, row, wave >> 2, (wave >> 2) + 1, 16 * (wave & 3), 16 * (wave & 3) + 16, y);
    float* part = (float*)lds;
    __syncthreads();
#pragma unroll
    for (int q = 0; q < 4; ++q) *(float4*)(part + wave * 1024 + lane * 16 + q * 4) = make_float4(y[q * 4 + 0], y[q * 4 + 1], y[q * 4 + 2], y[q * 4 + 3]);
    __syncthreads();
    if (wave == 0) {
#pragma unroll
        for (int w = 1; w < 8; ++w)
#pragma unroll
            for (int q = 0; q < 4; ++q) { const float4 v = *(const float4*)(part + w * 1024 + lane * 16 + q * 4); y[q * 4 + 0] += v.x; y[q * 4 + 1] += v.y; y[q * 4 + 2] += v.z; y[q * 4 + 3] += v.w; }
        peer_gather_finish(p, row, l, false, y);
    }
}

__device__ __forceinline__ void gdn_prep_item(const Params& p, int item) {
    const int tid = tid_();
    const int r0 = item * 16;
    if (tid < 384) {
        const int part = tid >> 7, ch = tid * 8;
        const bf16_t* src = (const bf16_t*)(p.ws + WS_QKVR) + ch;
        bf16_t* dst = (bf16_t*)(p.ws + (part == 0 ? WS_QN : part == 1 ? WS_KN : WS_VN)) + (ch & 1023);
        const float* cw = p.in[22] + ch;
        float w0[8], w1[8], w2[8];
#pragma unroll
        for (int e = 0; e < 8; ++e) { w0[e] = cw[e]; w1[e] = cw[3072 + e]; w2[e] = cw[6144 + e]; }
        bool hasp0, hasn15;
        if (r0 < SEQ) { hasp0 = (r0 & 63) != 0; hasn15 = ((r0 + 15) & 63) != 63; } else { hasp0 = r0 != SEQ; hasn15 = (r0 + 15) != R - 1; }
        u32x4 rw[18];
#pragma unroll
        for (int i = 0; i < 18; ++i) {
            const bool ok = (i == 0) ? hasp0 : (i == 17) ? hasn15 : true;
            rw[i] = ok ? *(const u32x4*)(src + (size_t)(r0 + i - 1) * 3072) : (u32x4){0u, 0u, 0u, 0u};
        }
#pragma unroll
        for (int i = 0; i < 16; ++i) {
            const u32x4 a = rw[i], bq = rw[i + 1], cq = rw[i + 2];
            const float xm[8] = {lo2f(a.x), hi2f(a.x), lo2f(a.y), hi2f(a.y), lo2f(a.z), hi2f(a.z), lo2f(a.w), hi2f(a.w)};
            const float x0[8] = {lo2f(bq.x), hi2f(bq.x), lo2f(bq.y), hi2f(bq.y), lo2f(bq.z), hi2f(bq.z), lo2f(bq.w), hi2f(bq.w)};
            const float xp[8] = {lo2f(cq.x), hi2f(cq.x), lo2f(cq.y), hi2f(cq.y), lo2f(cq.z), hi2f(cq.z), lo2f(cq.w), hi2f(cq.w)};
            float f[8], ss = 0.f;
#pragma unroll
            for (int e = 0; e < 8; ++e) { const float v = siluf_(xm[e] * w0[e] + x0[e] * w1[e] + xp[e] * w2[e]); f[e] = v; ss += v * v; }
            if (part < 2) {
                ss += __shfl_xor(ss, 1, 64); ss += __shfl_xor(ss, 2, 64); ss += __shfl_xor(ss, 4, 64); ss += __shfl_xor(ss, 8, 64);
                const float sc = rsqrtf(ss + 1e-6f) * (part == 0 ? 0.08838834764831845f : 1.f);
#pragma unroll
                for (int e = 0; e < 8; ++e) f[e] *= sc;
            }
            *(uint4*)(dst + (size_t)(r0 + i) * 1024) = pack8(f);
        }
    } else if (tid < 384 + 64) {
        const int l = tid - 384;
#pragma unroll
        for (int q = 0; q < 4; ++q) {
            const int v = l * 4 + q, i = v >> 4, dh = v & 15, row = r0 + i;
            const float* ab = (const float*)(p.ws + WS_AB) + (size_t)row * 32;
            const float a = ab[dh] + p.in[24][dh], b = ab[16 + dh];
            const float sp = a > 20.f ? a : log1pf(__expf(a));
            ((float*)(p.ws + WS_GG))[(size_t)dh * R + row] = -__expf(p.in[23][dh]) * sp;
            ((float*)(p.ws + WS_BETA))[(size_t)dh * R + row] = sigmoidf_(b);
        }
    }
}

constexpr int GU_LDQ = 136, GU_LDT = 72, GU_LDA = 68;
constexpr int GU_SQ = 0, GU_SK = 17408, GU_SKB = 34816, GU_SVBT = 52224, GU_SKGT = 70656, GU_SA = 89088, GU_SAT = 106496, GU_ST = 123904, GU_SG = 133120;
__device__ __forceinline__ int perm_slot64(int pos) { return 32 * (pos >> 5) + 8 * ((pos >> 2) & 3) + 4 * ((pos >> 4) & 1) + (pos & 3); }
struct GuPre { u32x4 q[2], k[2], v[2]; float g, beta; };
__device__ __forceinline__ void gu_prefetch(const Params& p, int u, GuPre& pre) {
    const int tid = tid_(), lane = tid & 63;
    const int dh = u / NCH, c = u % NCH, dir = dh >> 3, head = dh & 7;
#pragma unroll
    for (int q = 0; q < 2; ++q) {
        const int t = tid + q * NTHREADS, i = t >> 4, d8 = (t & 15) * 8;
        const size_t ro = (size_t)(c * 64 + (dir ? 63 - i : i)) * 1024 + head * 128 + d8;
        pre.q[q] = *(const u32x4*)((const bf16_t*)(p.ws + WS_QN) + ro);
        pre.k[q] = *(const u32x4*)((const bf16_t*)(p.ws + WS_KN) + ro);
        pre.v[q] = *(const u32x4*)((const bf16_t*)(p.ws + WS_VN) + ro);
    }
    const int row = c * 64 + (dir ? 63 - lane : lane);
    pre.g = ((const float*)(p.ws + WS_GG))[(size_t)dh * R + row];
    pre.beta = ((const float*)(p.ws + WS_BETA))[(size_t)dh * R + row];
}
__device__ __forceinline__ void gdn_unit(const Params& p, int u, int u_next, GuPre& pre, unsigned char* lds) {
    const int tid = tid_(), lane = tid & 63, wave = tid >> 6;
    const int dh = u / NCH, c = u % NCH, dir = dh >> 3, head = dh & 7;
    bf16_t* sQ = (bf16_t*)(lds + GU_SQ); bf16_t* sK = (bf16_t*)(lds + GU_SK); bf16_t* sKB = (bf16_t*)(lds + GU_SKB);
    bf16_t* sVBT = (bf16_t*)(lds + GU_SVBT); bf16_t* sKGT = (bf16_t*)(lds + GU_SKGT);
    float* sA = (float*)(lds + GU_SA); float* sAT = (float*)(lds + GU_SAT); bf16_t* sT = (bf16_t*)(lds + GU_ST);
    float* sG = (float*)(lds + GU_SG); float* sBeta = sG + 64;
    __syncthreads();
    if (wave == 0) {
        float g = pre.g;
#pragma unroll
        for (int o = 1; o < 64; o <<= 1) { const float t = __shfl_up(g, o, 64); if (lane >= o) g += t; }
        sG[lane] = g; sBeta[lane] = pre.beta;
        ((float*)(p.ws + WS_GC))[(size_t)u * 64 + lane] = g;
    }
    __syncthreads();
#pragma unroll
    for (int qq = 0; qq < 2; ++qq) {
        const int t = tid + qq * NTHREADS, i = t >> 4, d8 = (t & 15) * 8;
        const u32x4 q = pre.q[qq], k = pre.k[qq], v = pre.v[qq];
        const float beta = sBeta[i], eg = __expf(sG[i]);
        const float kf[8] = {lo2f(k.x), hi2f(k.x), lo2f(k.y), hi2f(k.y), lo2f(k.z), hi2f(k.z), lo2f(k.w), hi2f(k.w)};
        const float vf[8] = {lo2f(v.x), hi2f(v.x), lo2f(v.y), hi2f(v.y), lo2f(v.z), hi2f(v.z), lo2f(v.w), hi2f(v.w)};
        float kb[8];
#pragma unroll
        for (int e = 0; e < 8; ++e) kb[e] = kf[e] * beta;
        const u32x4 kbp = {pack2(kb[0], kb[1]), pack2(kb[2], kb[3]), pack2(kb[4], kb[5]), pack2(kb[6], kb[7])};
        *(u32x4*)(sQ + i * GU_LDQ + d8) = q; *(u32x4*)(sK + i * GU_LDQ + d8) = k; *(u32x4*)(sKB + i * GU_LDQ + d8) = kbp;
        const int isw = i ^ (((d8 >> 3) & 7) << 3);
#pragma unroll
        for (int e = 0; e < 8; ++e) { sVBT[(d8 + e) * GU_LDT + isw] = f2bf(vf[e] * beta); sKGT[(d8 + e) * GU_LDT + isw] = f2bf(kb[e] * eg); }
    }
    if (u_next < NUNITS) gu_prefetch(p, u_next, pre);
    __syncthreads();
    {
        const int mat = wave >> 2, mt = wave & 3, rr = lane & 15, q4 = lane >> 4;
        const bf16_t* sX = mat ? sQ : sKB;
        f32x4 acc[4];
#pragma unroll
        for (int nt = 0; nt < 4; ++nt) acc[nt] = (f32x4){0.f, 0.f, 0.f, 0.f};
#pragma unroll
        for (int kk = 0; kk < 4; ++kk) {
            const bf16x8 a = *(const bf16x8*)(sX + (16 * mt + rr) * GU_LDQ + kk * 32 + 8 * q4);
#pragma unroll
            for (int nt = 0; nt < 4; ++nt) {
                const bf16x8 b = *(const bf16x8*)(sK + (16 * nt + rr) * GU_LDQ + kk * 32 + 8 * q4);
                acc[nt] = __builtin_amdgcn_mfma_f32_16x16x32_bf16(a, b, acc[nt], 0, 0, 0);
            }
        }
        float* dstm = mat ? sAT : sA;
#pragma unroll
        for (int nt = 0; nt < 4; ++nt) {
            const int j = 16 * nt + rr; const float gj = sG[j];
#pragma unroll
            for (int jj = 0; jj < 4; ++jj) {
                const int i = 16 * mt + 4 * q4 + jj;
                const bool keep = mat ? (j <= i) : (j < i);
                dstm[i * GU_LDA + j] = keep ? acc[nt][jj] * __expf(sG[i] - gj) : 0.f;
            }
        }
    }
    __syncthreads();
    float* sD = (float*)(lds + GU_SQ);
    if (wave < 4) {
        if (lane < 16) {
            float d[16];
#pragma unroll
            for (int i = 0; i < 16; ++i) {
                float a = (i == lane) ? 1.f : 0.f;
                const float* Ai = sA + (16 * wave + i) * GU_LDA + 16 * wave;
#pragma unroll
                for (int j = 0; j < i; ++j) a -= Ai[j] * d[j];
                d[i] = a;
                sD[(wave * 16 + i) * 16 + lane] = a;
            }
        }
    } else {
        bf16_t* att = (bf16_t*)(p.ws + WS_ATT) + (size_t)u * 64 * 64;
        for (int t = tid - 256; t < 512; t += 256) {
            const int i = t >> 3, kk2 = (t >> 2) & 1, qq = t & 3;
            const float4 lo = *(const float4*)(sAT + i * GU_LDA + 32 * kk2 + 4 * qq), hi = *(const float4*)(sAT + i * GU_LDA + 32 * kk2 + 16 + 4 * qq);
            uint4 o; o.x = pack2(lo.x, lo.y); o.y = pack2(lo.z, lo.w); o.z = pack2(hi.x, hi.y); o.w = pack2(hi.z, hi.w);
            *(uint4*)(att + i * 64 + 32 * kk2 + 8 * qq) = o;
        }
    }
    __syncthreads();
    if (wave < 4) {
        const int rr = lane & 15, q4 = lane >> 4;
        f32x4 Tt[4];
#pragma unroll
        for (int m = 0; m < 4; ++m) Tt[m] = (f32x4){0.f, 0.f, 0.f, 0.f};
#pragma unroll
        for (int b = 0; b < 4; ++b) {
            if (b >= wave) {
                f32x4 X = (f32x4){0.f, 0.f, 0.f, 0.f};
#pragma unroll
                for (int kk = 0; kk < 2; ++kk) {
                    if (2 * kk < b) {
                        const float* Ar = sA + (16 * b + rr) * GU_LDA + 32 * kk + 4 * q4;
                        const float4 lo = *(const float4*)Ar;
                        float4 hi = make_float4(0.f, 0.f, 0.f, 0.f);
                        if (2 * kk + 1 < b) hi = *(const float4*)(Ar + 16);
                        const u32x4 ap = {pack2(lo.x, lo.y), pack2(lo.z, lo.w), pack2(hi.x, hi.y), pack2(hi.z, hi.w)};
                        const u32x4 bp = {pack2(Tt[2 * kk][0], Tt[2 * kk][1]), pack2(Tt[2 * kk][2], Tt[2 * kk][3]),
                                          pack2(Tt[2 * kk + 1][0], Tt[2 * kk + 1][1]), pack2(Tt[2 * kk + 1][2], Tt[2 * kk + 1][3])};
                        X = __builtin_amdgcn_mfma_f32_16x16x32_bf16(__builtin_bit_cast(bf16x8, ap), __builtin_bit_cast(bf16x8, bp), X, 0, 0, 0);
                    }
                }
                float y[4];
#pragma unroll
                for (int jj = 0; jj < 4; ++jj) y[jj] = ((b == wave && 4 * q4 + jj == rr) ? 1.f : 0.f) - X[jj];
                const float4 dv4 = *(const float4*)(sD + (b * 16 + rr) * 16 + 4 * q4);
                const u32x4 ap = {pack2(dv4.x, dv4.y), pack2(dv4.z, dv4.w), 0u, 0u};
                const u32x4 bp = {pack2(y[0], y[1]), pack2(y[2], y[3]), 0u, 0u};
                const f32x4 z4 = (f32x4){0.f, 0.f, 0.f, 0.f};
                Tt[b] = __builtin_amdgcn_mfma_f32_16x16x32_bf16(__builtin_bit_cast(bf16x8, ap), __builtin_bit_cast(bf16x8, bp), z4, 0, 0, 0);
            }
#pragma unroll
            for (int jj = 0; jj < 4; ++jj) sT[(16 * b + 4 * q4 + jj) * GU_LDT + 16 * wave + rr] = f2bf(Tt[b][jj]);
        }
    }
    __syncthreads();
    {
        const int rr = lane & 15, q4 = lane >> 4;
        bf16_t* ut = (bf16_t*)(p.ws + WS_UT) + (size_t)u * 128 * 64;
        bf16_t* wg = (bf16_t*)(p.ws + WS_W) + (size_t)u * 64 * 128;
        f32x4 au[4], aw[4];
#pragma unroll
        for (int m = 0; m < 4; ++m) { au[m] = (f32x4){0.f, 0.f, 0.f, 0.f}; aw[m] = (f32x4){0.f, 0.f, 0.f, 0.f}; }
#pragma unroll
        for (int kk2 = 0; kk2 < 2; ++kk2) {
            const int tsw = (kk2 * 32 + 8 * q4) ^ ((((16 * wave + rr) >> 3) & 7) << 3);
            const bf16x8 bv = *(const bf16x8*)(sVBT + (16 * wave + rr) * GU_LDT + tsw);
            const bf16x8 ak = *(const bf16x8*)(sKGT + (16 * wave + rr) * GU_LDT + tsw);
#pragma unroll
            for (int m = 0; m < 4; ++m) {
                const bf16x8 tf = *(const bf16x8*)(sT + (16 * m + rr) * GU_LDT + kk2 * 32 + 8 * q4);
                au[m] = __builtin_amdgcn_mfma_f32_16x16x32_bf16(tf, bv, au[m], 0, 0, 0);
                aw[m] = __builtin_amdgcn_mfma_f32_16x16x32_bf16(ak, tf, aw[m], 0, 0, 0);
            }
        }
#pragma unroll
        for (int m = 0; m < 4; ++m) {
            uint2 o; o.x = pack2(au[m][0], au[m][1]); o.y = pack2(au[m][2], au[m][3]);
            *(uint2*)(ut + (size_t)(16 * wave + rr) * 64 + 16 * m + 4 * q4) = o;
            uint2 w2; w2.x = pack2(aw[m][0], aw[m][1]); w2.y = pack2(aw[m][2], aw[m][3]);
            *(uint2*)(wg + (size_t)(16 * m + rr) * 128 + 32 * (wave >> 1) + 8 * q4 + 4 * (wave & 1)) = w2;
        }
    }
}

constexpr int GS_SW = 0, GS_SQD = 17408, GS_SKDT = 34816, GS_SATT = 53248, GS_BUF = 62464;
typedef unsigned u32x2 __attribute__((ext_vector_type(2)));
__device__ __forceinline__ int gdn_chain_chunk(int dir, int s) { return dir == 0 ? (s < 4 ? NCH_LAT + s : s - 4) : NCH - 1 - s; }
struct GsG1 { u32x4 w[2]; u32x4 att; };
struct GsG2 { u32x2 qlo[2], qhi[2]; float gq[2]; };
struct GsG3 { u32x4 kd[2]; float gk[2]; float gl; u32x2 ut[4]; };
__device__ __forceinline__ void gs_load1(const Params& p, int dh, int c, GsG1& st) {
    const int tid = tid_(); const size_t u = (size_t)dh * NCH + c;
    const bf16_t* wg = (const bf16_t*)(p.ws + WS_W) + u * 64 * 128; const bf16_t* att = (const bf16_t*)(p.ws + WS_ATT) + u * 64 * 64;
#pragma unroll
    for (int q = 0; q < 2; ++q) { const int t = tid + q * NTHREADS; st.w[q] = *(const u32x4*)(wg + (size_t)(t >> 4) * 128 + (t & 15) * 8); }
    st.att = *(const u32x4*)(att + (size_t)(tid >> 3) * 64 + (tid & 7) * 8);
}
__device__ __forceinline__ void gs_store1(const GsG1& st, unsigned char* buf) {
    const int tid = tid_(); bf16_t* sW = (bf16_t*)(buf + GS_SW); bf16_t* sATT = (bf16_t*)(buf + GS_SATT);
#pragma unroll
    for (int q = 0; q < 2; ++q) { const int t = tid + q * NTHREADS; *(u32x4*)(sW + (t >> 4) * GU_LDQ + (t & 15) * 8) = st.w[q]; }
    *(u32x4*)(sATT + (tid >> 3) * GU_LDT + (tid & 7) * 8) = st.att;
}
__device__ __forceinline__ void gs_load2(const Params& p, int dh, int c, GsG2& st) {
    const int tid = tid_(), dir = dh >> 3, head = dh & 7; const size_t u = (size_t)dh * NCH + c;
    const float* gc = (const float*)(p.ws + WS_GC) + u * 64; const bf16_t* qn = (const bf16_t*)(p.ws + WS_QN);
#pragma unroll
    for (int q = 0; q < 2; ++q) {
        const int t = tid + q * NTHREADS, i = t >> 4, kk = (t >> 2) & 3, qq = t & 3;
        const bf16_t* src = qn + (size_t)(c * 64 + (dir ? 63 - i : i)) * 1024 + head * 128 + 32 * kk + 4 * qq;
        st.qlo[q] = *(const u32x2*)src; st.qhi[q] = *(const u32x2*)(src + 16); st.gq[q] = gc[i];
    }
}
__device__ __forceinline__ void gs_store2(const GsG2& st, unsigned char* buf) {
    const int tid = tid_(); bf16_t* sQD = (bf16_t*)(buf + GS_SQD);
#pragma unroll
    for (int q = 0; q < 2; ++q) {
        const int t = tid + q * NTHREADS, i = t >> 4, kk = (t >> 2) & 3, qq = t & 3; const float e = __expf(st.gq[q]);
        u32x4 o; o.x = pack2(lo2f(st.qlo[q].x) * e, hi2f(st.qlo[q].x) * e); o.y = pack2(lo2f(st.qlo[q].y) * e, hi2f(st.qlo[q].y) * e);
        o.z = pack2(lo2f(st.qhi[q].x) * e, hi2f(st.qhi[q].x) * e); o.w = pack2(lo2f(st.qhi[q].y) * e, hi2f(st.qhi[q].y) * e);
        *(u32x4*)(sQD + i * GU_LDQ + 32 * kk + 8 * qq) = o;
    }
}
__device__ __forceinline__ void gs_load3(const Params& p, int dh, int c, GsG3& st) {
    const int tid = tid_(), lane = tid & 63, wave = tid >> 6, dir = dh >> 3, head = dh & 7; const size_t u = (size_t)dh * NCH + c;
    const float* gc = (const float*)(p.ws + WS_GC) + u * 64; const bf16_t* kn = (const bf16_t*)(p.ws + WS_KN);
    st.gl = gc[63];
#pragma unroll
    for (int q = 0; q < 2; ++q) {
        const int t = tid + q * NTHREADS, pos = t >> 4, d8 = (t & 15) * 8;
        st.kd[q] = *(const u32x4*)(kn + (size_t)(c * 64 + (dir ? 63 - pos : pos)) * 1024 + head * 128 + d8); st.gk[q] = gc[pos];
    }
    const bf16_t* ut = (const bf16_t*)(p.ws + WS_UT) + u * 128 * 64 + (size_t)(16 * wave + (lane & 15)) * 64 + 4 * (lane >> 4);
#pragma unroll
    for (int m = 0; m < 4; ++m) st.ut[m] = *(const u32x2*)(ut + 16 * m);
}
__device__ __forceinline__ void gs_store3(const GsG3& st, unsigned char* buf) {
    const int tid = tid_(); bf16_t* sKDT = (bf16_t*)(buf + GS_SKDT);
#pragma unroll
    for (int q = 0; q < 2; ++q) {
        const int t = tid + q * NTHREADS, pos = t >> 4, d8 = (t & 15) * 8; const float e = __expf(st.gl - st.gk[q]);
        const u32x4 kq = st.kd[q]; const int sl = perm_slot64(pos) ^ (((d8 >> 3) & 7) << 3);
        sKDT[(d8 + 0) * GU_LDT + sl] = f2bf(lo2f(kq.x) * e); sKDT[(d8 + 1) * GU_LDT + sl] = f2bf(hi2f(kq.x) * e);
        sKDT[(d8 + 2) * GU_LDT + sl] = f2bf(lo2f(kq.y) * e); sKDT[(d8 + 3) * GU_LDT + sl] = f2bf(hi2f(kq.y) * e);
        sKDT[(d8 + 4) * GU_LDT + sl] = f2bf(lo2f(kq.z) * e); sKDT[(d8 + 5) * GU_LDT + sl] = f2bf(hi2f(kq.z) * e);
        sKDT[(d8 + 6) * GU_LDT + sl] = f2bf(lo2f(kq.w) * e); sKDT[(d8 + 7) * GU_LDT + sl] = f2bf(hi2f(kq.w) * e);
    }
}
__device__ __forceinline__ void gdn_seg_ab(const Params& p, int dh, int k, unsigned char* lds) {
    const int tid = tid_(), lane = tid & 63, wave = tid >> 6, rr = lane & 15, q4 = lane >> 4, dir = dh >> 3;
    const bool first = (k == 0);
    const int s_begin = first ? 0 : 4 + 16 * k, nsteps = first ? 20 : 16;
    f32x4 ScB[8], ScA[8]; bf16x8 SbB[4], SbA[4];
#pragma unroll
    for (int m = 0; m < 8; ++m) {
        ScB[m] = (f32x4){0.f, 0.f, 0.f, 0.f};
#pragma unroll
        for (int jj = 0; jj < 4; ++jj) ScA[m][jj] = (16 * m + 4 * q4 + jj == 16 * wave + rr) ? 1.f : 0.f;
    }
#pragma unroll
    for (int kk = 0; kk < 4; ++kk) {
        SbB[kk] = (bf16x8){0, 0, 0, 0, 0, 0, 0, 0};
        const u32x4 pk = {pack2(ScA[2 * kk][0], ScA[2 * kk][1]), pack2(ScA[2 * kk][2], ScA[2 * kk][3]),
                          pack2(ScA[2 * kk + 1][0], ScA[2 * kk + 1][1]), pack2(ScA[2 * kk + 1][2], ScA[2 * kk + 1][3])};
        SbA[kk] = __builtin_bit_cast(bf16x8, pk);
    }
    u32x2 ucur[4]; float glcur;
    float4* sin_img = (float4*)(p.ws + WS_SIN) + (size_t)(dh * 16) * 4096;
    __syncthreads();
    {
        const int c0 = gdn_chain_chunk(dir, s_begin);
        GsG1 g1; gs_load1(p, dh, c0, g1); gs_store1(g1, lds);
        GsG3 g3; gs_load3(p, dh, c0, g3); gs_store3(g3, lds);
#pragma unroll
        for (int m = 0; m < 4; ++m) ucur[m] = g3.ut[m];
        glcur = g3.gl;
    }
    __syncthreads();
#pragma unroll 1
    for (int t = 0; t < nsteps; ++t) {
        const int s = s_begin + t;
        const int cn = gdn_chain_chunk(dir, t + 1 < nsteps ? s + 1 : s);
        const unsigned char* buf = lds + (t & 1) * GS_BUF; unsigned char* nbuf = lds + ((t + 1) & 1) * GS_BUF;
        const bf16_t* sW = (const bf16_t*)(buf + GS_SW); const bf16_t* sKDT = (const bf16_t*)(buf + GS_SKDT);
        GsG1 g1; gs_load1(p, dh, cn, g1);
        GsG3 g3; gs_load3(p, dh, cn, g3);
        f32x4 vb_[4], va_[4];
#pragma unroll
        for (int m = 0; m < 4; ++m) {
            f32x4 accb = (f32x4){0.f, 0.f, 0.f, 0.f}, acca = (f32x4){0.f, 0.f, 0.f, 0.f};
#pragma unroll
            for (int kk = 0; kk < 4; ++kk) {
                const bf16x8 a = *(const bf16x8*)(sW + (16 * m + rr) * GU_LDQ + kk * 32 + 8 * q4);
                accb = __builtin_amdgcn_mfma_f32_16x16x32_bf16(a, SbB[kk], accb, 0, 0, 0);
                if (!first) acca = __builtin_amdgcn_mfma_f32_16x16x32_bf16(a, SbA[kk], acca, 0, 0, 0);
            }
            vb_[m][0] = lo2f(ucur[m].x) - accb[0]; vb_[m][1] = hi2f(ucur[m].x) - accb[1]; vb_[m][2] = lo2f(ucur[m].y) - accb[2]; vb_[m][3] = hi2f(ucur[m].y) - accb[3];
            va_[m] = -acca;
        }
        bf16x8 VBb[2], VBa[2];
#pragma unroll
        for (int k2 = 0; k2 < 2; ++k2) {
            const u32x4 pb = {pack2(vb_[2 * k2][0], vb_[2 * k2][1]), pack2(vb_[2 * k2][2], vb_[2 * k2][3]), pack2(vb_[2 * k2 + 1][0], vb_[2 * k2 + 1][1]), pack2(vb_[2 * k2 + 1][2], vb_[2 * k2 + 1][3])};
            const u32x4 pa = {pack2(va_[2 * k2][0], va_[2 * k2][1]), pack2(va_[2 * k2][2], va_[2 * k2][3]), pack2(va_[2 * k2 + 1][0], va_[2 * k2 + 1][1]), pack2(va_[2 * k2 + 1][2], va_[2 * k2 + 1][3])};
            VBb[k2] = __builtin_bit_cast(bf16x8, pb); VBa[k2] = __builtin_bit_cast(bf16x8, pa);
        }
        const float egl = __expf(glcur);
#pragma unroll
        for (int m = 0; m < 8; ++m) {
            f32x4 accb = ScB[m] * egl, acca = ScA[m] * egl;
#pragma unroll
            for (int k2 = 0; k2 < 2; ++k2) {
                const bf16x8 a = *(const bf16x8*)(sKDT + (16 * m + rr) * GU_LDT + ((k2 * 32 + 8 * q4) ^ ((((16 * m + rr) >> 3) & 7) << 3)));
                accb = __builtin_amdgcn_mfma_f32_16x16x32_bf16(a, VBb[k2], accb, 0, 0, 0);
                if (!first) acca = __builtin_amdgcn_mfma_f32_16x16x32_bf16(a, VBa[k2], acca, 0, 0, 0);
            }
            ScB[m] = accb; ScA[m] = acca;
        }
#pragma unroll
        for (int kk = 0; kk < 4; ++kk) {
            const u32x4 pb = {pack2(ScB[2 * kk][0], ScB[2 * kk][1]), pack2(ScB[2 * kk][2], ScB[2 * kk][3]), pack2(ScB[2 * kk + 1][0], ScB[2 * kk + 1][1]), pack2(ScB[2 * kk + 1][2], ScB[2 * kk + 1][3])};
            const u32x4 pa = {pack2(ScA[2 * kk][0], ScA[2 * kk][1]), pack2(ScA[2 * kk][2], ScA[2 * kk][3]), pack2(ScA[2 * kk + 1][0], ScA[2 * kk + 1][1]), pack2(ScA[2 * kk + 1][2], ScA[2 * kk + 1][3])};
            SbB[kk] = __builtin_bit_cast(bf16x8, pb); SbA[kk] = __builtin_bit_cast(bf16x8, pa);
        }
        gs_store1(g1, nbuf); gs_store3(g3, nbuf);
#pragma unroll
        for (int m = 0; m < 4; ++m) ucur[m] = g3.ut[m];
        glcur = g3.gl;
        if (first && t == 3) {
#pragma unroll
            for (int m = 0; m < 8; ++m) sin_img[(wave * 8 + m) * 64 + lane] = make_float4(ScB[m][0], ScB[m][1], ScB[m][2], ScB[m][3]);
        }
        __syncthreads();
    }
    if (first) {
#pragma unroll
        for (int m = 0; m < 8; ++m) sin_img[4096 + (wave * 8 + m) * 64 + lane] = make_float4(ScB[m][0], ScB[m][1], ScB[m][2], ScB[m][3]);
    } else {
        float4* bimg = (float4*)(p.ws + WS_BSEG) + (size_t)(dh * 16 + k) * 4096;
        bf16_t* aseg = (bf16_t*)(p.ws + WS_ASEG) + (size_t)(dh * 16 + k) * 128 * 128;
        const int pc = perm_slot64(16 * wave + rr);
#pragma unroll
        for (int m = 0; m < 8; ++m) {
            bimg[(wave * 8 + m) * 64 + lane] = make_float4(ScB[m][0], ScB[m][1], ScB[m][2], ScB[m][3]);
#pragma unroll
            for (int jj = 0; jj < 4; ++jj) aseg[(size_t)(16 * m + 4 * q4 + jj) * 128 + pc] = f2bf(ScA[m][jj]);
        }
    }
}
__device__ __forceinline__ void gdn_seg_chain(const Params& p, int dh, unsigned char* lds) {
    const int tid = tid_(), lane = tid & 63, wave = tid >> 6, rr = lane & 15, q4 = lane >> 4;
    float4* sin_img = (float4*)(p.ws + WS_SIN) + (size_t)(dh * 16) * 4096;
    const float4* bimg = (const float4*)(p.ws + WS_BSEG) + (size_t)(dh * 16) * 4096;
    const bf16_t* aseg = (const bf16_t*)(p.ws + WS_ASEG) + (size_t)(dh * 16) * 128 * 128;
    f32x4 Sc[8]; bf16x8 Sb[4];
#pragma unroll
    for (int m = 0; m < 8; ++m) { const float4 v = sin_img[4096 + (wave * 8 + m) * 64 + lane]; Sc[m] = (f32x4){v.x, v.y, v.z, v.w}; }
    u32x4 ar[4];
    __syncthreads();
#pragma unroll
    for (int q = 0; q < 4; ++q) { const int t = tid + q * NTHREADS; ar[q] = *(const u32x4*)(aseg + (size_t)1 * 16384 + (size_t)(t >> 4) * 128 + (t & 15) * 8); }
#pragma unroll
    for (int q = 0; q < 4; ++q) { const int t = tid + q * NTHREADS; *(u32x4*)((bf16_t*)lds + (t >> 4) * GU_LDQ + (t & 15) * 8) = ar[q]; }
    __syncthreads();
#pragma unroll 1
    for (int k = 1; k <= 14; ++k) {
        const bf16_t* sA = (const bf16_t*)(lds + ((k - 1) & 1) * 34816);
        if (k < 14) {
#pragma unroll
            for (int q = 0; q < 4; ++q) { const int t = tid + q * NTHREADS; ar[q] = *(const u32x4*)(aseg + (size_t)(k + 1) * 16384 + (size_t)(t >> 4) * 128 + (t & 15) * 8); }
        }
#pragma unroll
        for (int kk = 0; kk < 4; ++kk) {
            const u32x4 pk = {pack2(Sc[2 * kk][0], Sc[2 * kk][1]), pack2(Sc[2 * kk][2], Sc[2 * kk][3]), pack2(Sc[2 * kk + 1][0], Sc[2 * kk + 1][1]), pack2(Sc[2 * kk + 1][2], Sc[2 * kk + 1][3])};
            Sb[kk] = __builtin_bit_cast(bf16x8, pk);
        }
#pragma unroll
        for (int m = 0; m < 8; ++m) {
            const float4 bv = bimg[(size_t)k * 4096 + (wave * 8 + m) * 64 + lane];
            f32x4 acc = (f32x4){bv.x, bv.y, bv.z, bv.w};
#pragma unroll
            for (int kk = 0; kk < 4; ++kk)
                acc = __builtin_amdgcn_mfma_f32_16x16x32_bf16(*(const bf16x8*)(sA + (16 * m + rr) * GU_LDQ + kk * 32 + 8 * q4), Sb[kk], acc, 0, 0, 0);
            Sc[m] = acc;
            sin_img[(size_t)(k + 1) * 4096 + (wave * 8 + m) * 64 + lane] = make_float4(acc[0], acc[1], acc[2], acc[3]);
        }
        if (k < 14) {
#pragma unroll
            for (int q = 0; q < 4; ++q) { const int t = tid + q * NTHREADS; *(u32x4*)((bf16_t*)(lds + (k & 1) * 34816) + (t >> 4) * GU_LDQ + (t & 15) * 8) = ar[q]; }
        }
        __syncthreads();
    }
}
__device__ __forceinline__ void gdn_seq(const Params& p, int dh, int k, unsigned char* lds) {
    const int tid = tid_(), lane = tid & 63, wave = tid >> 6, rr = lane & 15, q4 = lane >> 4, dir = dh >> 3, head = dh & 7;
    const int s_begin = 4 + 16 * k;
    f32x4 Sc[8]; bf16x8 Sb[4];
    {
        const float4* sin_img = (const float4*)(p.ws + WS_SIN) + (size_t)(dh * 16 + k) * 4096;
#pragma unroll
        for (int m = 0; m < 8; ++m) { const float4 v = sin_img[(wave * 8 + m) * 64 + lane]; Sc[m] = (f32x4){v.x, v.y, v.z, v.w}; }
#pragma unroll
        for (int kk = 0; kk < 4; ++kk) {
            const u32x4 pk = {pack2(Sc[2 * kk][0], Sc[2 * kk][1]), pack2(Sc[2 * kk][2], Sc[2 * kk][3]), pack2(Sc[2 * kk + 1][0], Sc[2 * kk + 1][1]), pack2(Sc[2 * kk + 1][2], Sc[2 * kk + 1][3])};
            Sb[kk] = __builtin_bit_cast(bf16x8, pk);
        }
    }
    u32x2 ucur[4]; float glcur;
    __syncthreads();
    {
        const int c0 = gdn_chain_chunk(dir, s_begin);
        GsG1 g1; gs_load1(p, dh, c0, g1); gs_store1(g1, lds);
        GsG2 g2; gs_load2(p, dh, c0, g2); gs_store2(g2, lds);
        GsG3 g3; gs_load3(p, dh, c0, g3); gs_store3(g3, lds);
#pragma unroll
        for (int m = 0; m < 4; ++m) ucur[m] = g3.ut[m];
        glcur = g3.gl;
    }
    __syncthreads();
    bf16_t* of = (bf16_t*)(p.ws + WS_OF) + (size_t)dir * SEQ * 1024;
#pragma unroll 1
    for (int t = 0; t < 16; ++t) {
        const int s = s_begin + t;
        const int c = gdn_chain_chunk(dir, s);
        const int cn = gdn_chain_chunk(dir, t + 1 < 16 ? s + 1 : s);
        const unsigned char* buf = lds + (t & 1) * GS_BUF; unsigned char* nbuf = lds + ((t + 1) & 1) * GS_BUF;
        const bf16_t* sW = (const bf16_t*)(buf + GS_SW); const bf16_t* sQD = (const bf16_t*)(buf + GS_SQD);
        const bf16_t* sKDT = (const bf16_t*)(buf + GS_SKDT); const bf16_t* sATT = (const bf16_t*)(buf + GS_SATT);
        GsG1 g1; gs_load1(p, dh, cn, g1);
        GsG2 g2; gs_load2(p, dh, cn, g2);
        GsG3 g3; gs_load3(p, dh, cn, g3);
        f32x4 vn[4];
#pragma unroll
        for (int m = 0; m < 4; ++m) {
            f32x4 acc = (f32x4){0.f, 0.f, 0.f, 0.f};
#pragma unroll
            for (int kk = 0; kk < 4; ++kk)
                acc = __builtin_amdgcn_mfma_f32_16x16x32_bf16(*(const bf16x8*)(sW + (16 * m + rr) * GU_LDQ + kk * 32 + 8 * q4), Sb[kk], acc, 0, 0, 0);
            vn[m][0] = lo2f(ucur[m].x) - acc[0]; vn[m][1] = hi2f(ucur[m].x) - acc[1]; vn[m][2] = lo2f(ucur[m].y) - acc[2]; vn[m][3] = hi2f(ucur[m].y) - acc[3];
        }
        bf16x8 VB[2];
#pragma unroll
        for (int k2 = 0; k2 < 2; ++k2) {
            const unsigned a0 = pack2(vn[2 * k2][0], vn[2 * k2][1]), a1 = pack2(vn[2 * k2][2], vn[2 * k2][3]);
            const unsigned a2 = pack2(vn[2 * k2 + 1][0], vn[2 * k2 + 1][1]), a3 = pack2(vn[2 * k2 + 1][2], vn[2 * k2 + 1][3]);
            const u32x4 pk = {a0, a1, a2, a3}; VB[k2] = __builtin_bit_cast(bf16x8, pk);
        }
#pragma unroll
        for (int m = 0; m < 4; ++m) {
            f32x4 acc = (f32x4){0.f, 0.f, 0.f, 0.f};
#pragma unroll
            for (int kk = 0; kk < 4; ++kk)
                acc = __builtin_amdgcn_mfma_f32_16x16x32_bf16(*(const bf16x8*)(sQD + (16 * m + rr) * GU_LDQ + kk * 32 + 8 * q4), Sb[kk], acc, 0, 0, 0);
#pragma unroll
            for (int k2 = 0; k2 < 2; ++k2)
                acc = __builtin_amdgcn_mfma_f32_16x16x32_bf16(*(const bf16x8*)(sATT + (16 * m + rr) * GU_LDT + k2 * 32 + 8 * q4), VB[k2], acc, 0, 0, 0);
#pragma unroll
            for (int jj = 0; jj < 4; ++jj) {
                const int pos = 16 * m + 4 * q4 + jj;
                of[(size_t)(c * 64 + (dir ? 63 - pos : pos)) * 1024 + head * 128 + 16 * wave + rr] = f2bf(acc[jj]);
            }
        }
        const float egl = __expf(glcur);
#pragma unroll
        for (int m = 0; m < 8; ++m) {
            f32x4 acc = Sc[m] * egl;
#pragma unroll
            for (int k2 = 0; k2 < 2; ++k2)
                acc = __builtin_amdgcn_mfma_f32_16x16x32_bf16(*(const bf16x8*)(sKDT + (16 * m + rr) * GU_LDT + ((k2 * 32 + 8 * q4) ^ ((((16 * m + rr) >> 3) & 7) << 3))), VB[k2], acc, 0, 0, 0);
            Sc[m] = acc;
        }
#pragma unroll
        for (int kk = 0; kk < 4; ++kk) {
            const u32x4 pk = {pack2(Sc[2 * kk][0], Sc[2 * kk][1]), pack2(Sc[2 * kk][2], Sc[2 * kk][3]),
                              pack2(Sc[2 * kk + 1][0], Sc[2 * kk + 1][1]), pack2(Sc[2 * kk + 1][2], Sc[2 * kk + 1][3])};
            Sb[kk] = __builtin_bit_cast(bf16x8, pk);
        }
        gs_store1(g1, nbuf); gs_store2(g2, nbuf); gs_store3(g3, nbuf);
#pragma unroll
        for (int m = 0; m < 4; ++m) ucur[m] = g3.ut[m];
        glcur = g3.gl;
        __syncthreads();
    }
}

__device__ __forceinline__ void gdn_readout_row(const Params& p, int row) {
    const int lane = tid_() & 63, head = lane >> 3, d0 = (lane & 7) * 16;
    const bf16_t* of0 = (const bf16_t*)(p.ws + WS_OF) + (size_t)row * 1024 + head * 128 + d0;
    const bf16_t* of1 = of0 + (size_t)SEQ * 1024;
    const bf16_t* zp = (const bf16_t*)(p.ws + WS_Z) + (size_t)row * 1024 + head * 128 + d0;
    float a[16], b[16], z[16];
    unpack8(*(const uint4*)of0, a); unpack8(*(const uint4*)(of0 + 8), a + 8);
    unpack8(*(const uint4*)of1, b); unpack8(*(const uint4*)(of1 + 8), b + 8);
    unpack8(*(const uint4*)zp, z); unpack8(*(const uint4*)(zp + 8), z + 8);
    float ss = 0.f;
#pragma unroll
    for (int e = 0; e < 16; ++e) { a[e] += b[e]; ss += a[e] * a[e]; }
    ss += __shfl_xor(ss, 1, 64); ss += __shfl_xor(ss, 2, 64); ss += __shfl_xor(ss, 4, 64);
    const float rs = rsqrtf(ss * (1.f / 128.f) + 1e-6f);
    const float* ng = p.in[25] + d0;
    float f[16];
#pragma unroll
    for (int e = 0; e < 16; ++e) f[e] = a[e] * rs * ng[e] * siluf_(z[e]);
    bf16_t* dst = (bf16_t*)(p.ws + WS_VN) + (size_t)row * 1024 + head * 128 + d0;
    *(uint4*)dst = pack8(f); *(uint4*)(dst + 8) = pack8(f + 8);
}

#define XB_TMO      128
#define XB_XCNT(j)  (256  + 64 * (j))
#define XB_XSUB(j)  (1280 + 64 * (j))
#define XB_XGEN(j)  (2304 + 64 * (j))
#define XB_TOP      3328
#define XB_TOPGEN   3392
#define XCD_BAR_WORDS 3456
#define XB_SPIN_CAP (1u << 22)
__device__ __forceinline__ unsigned xb_ld(unsigned* p)              { return __hip_atomic_load(p, __ATOMIC_RELAXED, __HIP_MEMORY_SCOPE_AGENT); }
__device__ __forceinline__ unsigned xb_add(unsigned* p, unsigned v) { return __hip_atomic_fetch_add(p, v, __ATOMIC_RELAXED, __HIP_MEMORY_SCOPE_AGENT); }
__device__ __forceinline__ unsigned xb_xcc_id() { return (unsigned)__builtin_amdgcn_s_getreg((3 << 11) | 20) & 0xFu; }
#define XB_SPIN(cond, bar) do { unsigned _sp = 0; while (cond) { __builtin_amdgcn_s_sleep(1); \
    if ((++_sp & 255u) == 0u) { if (xb_ld(&(bar)[XB_TMO])) break; if (_sp > XB_SPIN_CAP) { atomicAdd(&(bar)[XB_TMO], 1u); break; } } } } while (0)
struct XcdBarrier { unsigned* bar; unsigned x; volatile LAS unsigned* st; };
__device__ __forceinline__ XcdBarrier xcd_barrier_post(unsigned* bar, volatile LAS unsigned* st) {
    XcdBarrier b; b.bar = bar; b.x = xb_xcc_id(); b.st = st;
    if (threadIdx.x == 0) (void)xb_add(&bar[XB_XCNT(b.x)], 1u);
    return b;
}
__device__ __forceinline__ void xcd_barrier_complete(unsigned* bar, unsigned x, unsigned& nloc, unsigned& nx) {
    const unsigned G = gridDim.x * gridDim.y * gridDim.z;
    unsigned sum, cnt, mine, sp = 0u;
    for (;;) {
        sum = 0u; cnt = 0u; mine = 0u;
#pragma unroll
        for (unsigned j = 0; j < 16; ++j) { const unsigned c = xb_ld(&bar[XB_XCNT(j)]); sum += c; cnt += (c > 0u) ? 1u : 0u; mine = (j == x) ? c : mine; }
        if (sum == G) break;
        __builtin_amdgcn_s_sleep(1);
        if ((++sp & 255u) == 0u) { if (xb_ld(&bar[XB_TMO])) break; if (sp > XB_SPIN_CAP) { atomicAdd(&bar[XB_TMO], 1u); break; } }
    }
    nloc = mine > 0u ? mine : 1u; nx = cnt > 0u ? cnt : 1u;
}
__device__ __forceinline__ void xcd_barrier(const XcdBarrier& b) {
    asm volatile("s_waitcnt vmcnt(0)" ::: "memory");
    __syncthreads();
    if (threadIdx.x == 0) {
        unsigned* bar = b.bar;
        __builtin_amdgcn_s_waitcnt(0);
        unsigned nloc = b.st[0], nx = b.st[1];
        if (nloc == 0u) { xcd_barrier_complete(bar, b.x, nloc, nx); b.st[0] = nloc; b.st[1] = nx; }
        const unsigned old = xb_add(&bar[XB_XSUB(b.x)], 1u);
        const unsigned gen = old / nloc;
        if (old + 1u == (gen + 1u) * nloc) {
            __builtin_amdgcn_fence(__ATOMIC_RELEASE, "agent");
            asm volatile("s_waitcnt vmcnt(0)" ::: "memory");
            const unsigned og = xb_add(&bar[XB_TOP], 1u);
            const unsigned tg = og / nx;
            if (og + 1u == (tg + 1u) * nx) xb_add(&bar[XB_TOPGEN], 1u);
            else XB_SPIN(xb_ld(&bar[XB_TOPGEN]) == tg, bar);
            __builtin_amdgcn_fence(__ATOMIC_ACQUIRE, "agent");
            xb_add(&bar[XB_XGEN(b.x)], 1u);
            asm volatile("s_waitcnt vmcnt(0)" ::: "memory");
        } else {
            XB_SPIN(xb_ld(&bar[XB_XGEN(b.x)]) == gen, bar);
            __builtin_amdgcn_fence(__ATOMIC_ACQUIRE, "agent");
            asm volatile("s_waitcnt vmcnt(0)" ::: "memory");
        }
    }
    __syncthreads();
}

#ifndef PHMASK
#define PHMASK 0xFFFFFFFFull
#endif
#define PH(n) (((PHMASK) >> (n)) & 1ull)
#define FOR_ITEMS(n) for (int item = blockIdx.x; item < (n); item += gridDim.x)
__device__ __forceinline__ void mixer1_phases(const Params& p, unsigned char* ws, unsigned char* lds, const XcdBarrier& xbar) {
    if (PH(14)) {
        EpiOddIn e{(bf16_t*)(ws + WS_QKVR), (bf16_t*)(ws + WS_Z), (float*)(ws + WS_AB)};
        gemm_big((const bf16_t*)(ws + WS_ACT), (const bf16_t*)(ws + WS_WOIN), SEQ, 4096, 1024, e, lds);
        FOR_ITEMS(128 + 2 * 33) {
            if (item < 128) gemm_tile((const bf16_t*)(ws + WS_ACT), 1024, R, (const bf16_t*)(ws + WS_WOIN), 1024, ODD_IN, 1024, item * 128, 4096, e, lds);
            else { const int q = item - 128; gemm_tile((const bf16_t*)(ws + WS_ACT), 1024, R, (const bf16_t*)(ws + WS_WOIN), 1024, ODD_IN, 1024, SEQ + (q / 33) * 128, (q % 33) * 128, e, lds); }
        }
    }
    xcd_barrier(xbar);
    if (PH(15)) FOR_ITEMS(R / 16) gdn_prep_item(p, item);
    xcd_barrier(xbar);
    if (PH(16)) {
        GuPre pre;
        int item = blockIdx.x;
        if (item < NUNITS) gu_prefetch(p, item, pre);
        for (; item < NUNITS; item += gridDim.x) gdn_unit(p, item, item + (int)gridDim.x, pre, lds);
    }
    xcd_barrier(xbar);
    if (PH(17)) {
        FOR_ITEMS(256) { if ((item & 15) != 15) gdn_seg_ab(p, item >> 4, item & 15, lds); }
        xcd_barrier(xbar);
        if (blockIdx.x < 16) gdn_seg_chain(p, blockIdx.x, lds);
        else {
            for (int item = (int)blockIdx.x - 16; item < 256; item += (int)gridDim.x - 16)
                p0_transpose(p.in[26], 1024, 1024, (bf16_t*)(ws + WS_WOOUT), item, lds);
        }
        xcd_barrier(xbar);
        FOR_ITEMS(256) gdn_seq(p, item >> 4, item & 15, lds);
    }
    xcd_barrier(xbar);
    if (PH(18)) FOR_ITEMS(SEQ / 8) gdn_readout_row(p, item * 8 + (tid_() >> 6));
    xcd_barrier(xbar);
    if (PH(19)) {
        EpiResid e{p.in[0], p.in[2], (bf16_t*)(ws + WS_H), (const float*)(ws + WS_MOD), 1, false};
        gemm_big((const bf16_t*)(ws + WS_VN), (const bf16_t*)(ws + WS_WOOUT), SEQ, 1024, 1024, e, lds);
        FOR_ITEMS(2048) peer_tables_item(p, item, 1);
    }
    xcd_barrier(xbar);
}

template <int L>
__device__ __forceinline__ void peer_phases(const Params& p, unsigned char* ws, unsigned char* lds, const XcdBarrier& xbar) {
    constexpr int l = L;
    constexpr int nrows = L == 0 ? R : SEQ, ntm = nrows / 128;
    if (PH(8)) FOR_ITEMS(nrows / 8) norm_rows_item(p, item, l, p.in[7] + l * 1024, 3, false);
    xcd_barrier(xbar);
    if (PH(9)) {
        EpiScore e{(unsigned short*)(ws + WS_SC), 0};
        const bf16_t* wq = (const bf16_t*)(ws + (l == 0 ? WS_WQ0 : WS_WQ1));
        gemm_big((const bf16_t*)(ws + WS_ACT), wq, SEQ, 2048, 1024, e, lds);
        if (l == 0) { FOR_ITEMS(2 * 16) gemm_tile((const bf16_t*)(ws + WS_ACT), 1024, R, wq, 1024, 2048, 1024, SEQ + (item >> 4) * 128, (item & 15) * 128, e, lds); }
    }
    xcd_barrier(xbar);
    if (PH(11)) FOR_ITEMS(nrows / 64) peer_route_item(p, item, nrows, lds);
    xcd_barrier(xbar);
    if (PH(12)) {
        if (l == 0) { FOR_ITEMS(CTX) peer_gather_row_split(p, SEQ + item, 0, lds); }
        FOR_ITEMS(SEQ / 8) peer_gather_row(p, item * 8 + (tid_() >> 6), l, l == 1);
    }
}

__global__ void __launch_bounds__(NTHREADS) fwd_megakernel(Params p) {
    extern __shared__ __attribute__((aligned(16))) unsigned char lds[];
    cg::grid_group grid = cg::this_grid();
    unsigned char* ws = p.ws;
    volatile LAS unsigned* xbst = (volatile LAS unsigned*)(LAS unsigned char*)(lds + LDS_BYTES - 16);
    if (threadIdx.x == 0) { xbst[0] = 0u; xbst[1] = 0u; }
    __syncthreads();
    const XcdBarrier xbar = xcd_barrier_post((unsigned*)(ws + WS_BAR), xbst);

    if (PH(0)) {
        constexpr int N_S5 = 256, N_ADA = 192, N_T0 = 512, N_T1 = 64, N_T2 = 256, N_T5 = 1024, N_SK = 16;
        constexpr int O1 = N_S5, O2 = O1 + N_ADA, O3 = O2 + N_T0, O4 = O3 + N_T1, O5 = O4 + N_T2, O6 = O5 + N_T5, O7 = O6 + N_SK;
        FOR_ITEMS(O7) {
            if (item < O1) p0_s5_tables(p, item, lds);
            else if (item < O2) p0_adaln(p, item - O1, lds);
            else if (item < O3) p0_transpose(p.in[8], 1024, 2048, (bf16_t*)(ws + WS_WEIN), item - O2, lds);
            else if (item < O4) p0_transpose(p.in[18], 512, 512, (bf16_t*)(ws + WS_WGLU), item - O3, lds);
            else if (item < O5) p0_transpose(p.in[20], 1024, 1024, (bf16_t*)(ws + WS_WEOUT), item - O4, lds);
            else if (item < O6) cvt_chunk(p.in[27], (bf16_t*)(ws + WS_WQB), item - O5);
            else cvt_chunk(p.in[28], (bf16_t*)(ws + WS_SK), item - O6);
        }
    }
    grid.sync();
    if (PH(1)) FOR_ITEMS(2080 + 2048 + 256) {
        if (item < 2080) norm_rows_item(p, item, 0, p.in[6], 0, true);
        else if (item < 2080 + 2048) s5_mintra_item(p, item - 2080);
        else {
            const int q = item - 4128, l = q >> 7, b = (q >> 3) & 15, tn = q & 7;
            EpiBf16 e{(bf16_t*)(ws + (l == 0 ? WS_WQ0 : WS_WQ1)) + (size_t)b * 128 * 1024, 1024};
            gemm_tile((const bf16_t*)(ws + WS_SK) + (size_t)(l * 2 + (b & 1)) * 128 * 128, 128, 128,
                      (const bf16_t*)(ws + WS_WQB) + (size_t)l * 1024 * 2048 + b * 128, 2048, 1024, 128, 0, tn * 128, e, lds);
        }
    }
    xcd_barrier(xbar);
    if (PH(2)) {
        EpiEvenIn e{(bf16_t*)(ws + WS_PA), (bf16_t*)(ws + WS_UG)};
        gemm_big((const bf16_t*)(ws + WS_ACT), (const bf16_t*)(ws + WS_WEIN), SEQ, 2048, 1024, e, lds);
        FOR_ITEMS(2 * 16) gemm_tile((const bf16_t*)(ws + WS_ACT), 1024, R, (const bf16_t*)(ws + WS_WEIN), 1024, 2048, 1024, SEQ + (item >> 4) * 128, (item & 15) * 128, e, lds);
    }
    xcd_barrier(xbar);
    if (PH(3)) FOR_ITEMS(32 * 30) {
        const int g = item / 30, r = item % 30, tm = r / 10, tn = r % 10;
        EpiS5Local e{(bf16_t*)(ws + WS_YL), (float*)(ws + WS_LST), g};
        gemm_tile((const bf16_t*)(ws + WS_UG) + (size_t)g * NCH * 1024, 1024, NCH, (const bf16_t*)(ws + WS_MS5) + (size_t)g * 1280 * 1024, 1024, 1280, 1024, tm * 128, tn * 128, e, lds);
    }
    xcd_barrier(xbar);
    if (PH(4)) {
        s5_scan(p);
        if (blockIdx.x >= 8) {
            for (int item = (int)blockIdx.x - 8; item < 2048 + 16 * 65; item += (int)gridDim.x - 8) {
                if (item < 2048) peer_tables_item(p, item, 0);
                else p0_transpose(p.in[21], 1024, ODD_IN, (bf16_t*)(ws + WS_WOIN), item - 2048, lds);
            }
        }
    }
    xcd_barrier(xbar);
    if (PH(5)) FOR_ITEMS(32 * 24) {
        const int g = item / 24, r = item % 24, tm = r / 8, tn = r % 8;
        EpiS5Out e{(const bf16_t*)(ws + WS_YL), (bf16_t*)(ws + WS_GS), g};
        gemm_tile((const bf16_t*)(ws + WS_A5) + (size_t)g * NCH * 256, 256, NCH, (const bf16_t*)(ws + WS_O5) + (size_t)g * 1024 * 256, 256, 1024, 256, tm * 128, tn * 128, e, lds);
    }
    xcd_barrier(xbar);
    if (PH(6)) {
        EpiGlu e{(const bf16_t*)(ws + WS_GS), p.in[19], (bf16_t*)(ws + WS_CB)};
        gemm_big((const bf16_t*)(ws + WS_GS), (const bf16_t*)(ws + WS_WGLU), SEQ, 512, 512, e, lds);
        for (int item = (int)gridDim.x - 1 - (int)blockIdx.x; item < 2 * 4 + NCH; item += gridDim.x) {
            if (item < 8) gemm_tile((const bf16_t*)(ws + WS_GS), 512, R, (const bf16_t*)(ws + WS_WGLU), 512, 512, 512, SEQ + (item >> 2) * 128, (item & 3) * 128, e, lds);
            else even_conv_item(p, item - 8);
        }
    }
    xcd_barrier(xbar);
    if (PH(7)) {
        EpiResid e{p.in[0], p.in[2], (bf16_t*)(ws + WS_H), (const float*)(ws + WS_MOD), 0, true};
        gemm_big((const bf16_t*)(ws + WS_CB), (const bf16_t*)(ws + WS_WEOUT), SEQ, 1024, 1024, e, lds);
        FOR_ITEMS(2 * 8) gemm_tile((const bf16_t*)(ws + WS_CB), 1024, R, (const bf16_t*)(ws + WS_WEOUT), 1024, 1024, 1024, SEQ + (item >> 3) * 128, (item & 7) * 128, e, lds);
    }
    xcd_barrier(xbar);
    peer_phases<0>(p, ws, lds, xbar);
    xcd_barrier(xbar);
    mixer1_phases(p, ws, lds, xbar);
    peer_phases<1>(p, ws, lds, xbar);
}

extern "C" void kernel_launch(void* const* d_in, const int* in_sizes, int n_in, void* d_out, int out_size, void* d_ws, size_t ws_size, hipStream_t stream) {
    static int grid_blocks = 0;
    if (grid_blocks == 0) {
        if (n_in != 32 || out_size != SEQ * D || ws_size < WS_NEED) {
            fprintf(stderr, "kernel_launch: unexpected problem (n_in %d, out %d, ws %zu, need %zu); nothing launched\n", n_in, out_size, ws_size, (size_t)WS_NEED);
            grid_blocks = -1; return;
        }
        int dev = 0, cus = 0, per_cu = 0;
        hipGetDevice(&dev);
        hipDeviceGetAttribute(&cus, hipDeviceAttributeMultiprocessorCount, dev);
        hipFuncSetAttribute((const void*)fwd_megakernel, hipFuncAttributeMaxDynamicSharedMemorySize, LDS_BYTES);
        hipOccupancyMaxActiveBlocksPerMultiprocessor(&per_cu, (const void*)fwd_megakernel, NTHREADS, LDS_BYTES);
        if (per_cu < 1) { fprintf(stderr, "kernel_launch: occupancy query says %d blocks per CU; nothing launched\n", per_cu); grid_blocks = -1; return; }
        grid_blocks = cus;
    }
    if (grid_blocks < 0) return;
    (void)hipMemsetAsync((unsigned char*)d_ws + WS_BAR, 0, XCD_BAR_WORDS * 4, stream);
    Params prm{};
    for (int i = 0; i < 32; ++i) prm.in[i] = (const float*)d_in[i];
    prm.out = (float*)d_out; prm.ws = (unsigned char*)d_ws;
    void* args[] = {&prm};
    hipError_t e = hipLaunchCooperativeKernel((const void*)fwd_megakernel, dim3(grid_blocks), dim3(NTHREADS), args, LDS_BYTES, stream);
    if (e != hipSuccess) fprintf(stderr, "cooperative launch failed: %s (grid %d)\n", hipGetErrorString(e), grid_blocks);
}
```

```cpp
#include <hip/hip_runtime.h>
#include <hip/hip_cooperative_groups.h>
#include <cstdio>
#include <cstdint>
namespace cg = cooperative_groups;

typedef unsigned short bf16_t;
typedef short bf16x8 __attribute__((ext_vector_type(8)));
typedef float f32x4 __attribute__((ext_vector_type(4)));
typedef float f32x16 __attribute__((ext_vector_type(16)));
typedef unsigned u32x4 __attribute__((ext_vector_type(4)));
typedef unsigned u32x2 __attribute__((ext_vector_type(2)));

constexpr int D = 1024, SEQ = 16384, CTX = 256, R = SEQ + CTX;
constexpr int NCH = R / 64;
constexpr int NCH_LAT = SEQ / 64;
constexpr int NTHREADS = 512;
constexpr int ODD_IN = 4128;
constexpr int NUNITS = 16 * NCH;

constexpr size_t al256(size_t x) { return (x + 255) & ~(size_t)255; }
constexpr size_t WS_BAR   = 0;
constexpr size_t WS_PARAMS = 14336;
constexpr size_t WS_MOD   = 16384;
constexpr size_t WS_A64   = WS_MOD + al256(2 * 2 * 6 * 1024 * 4);
constexpr size_t WS_SK    = WS_A64 + al256(2 * 32 * 64 * 8);
constexpr size_t WS_PSC   = WS_SK + al256(2 * 2 * 128 * 128 * 2);
constexpr size_t WS_WEIN  = WS_PSC + al256(2 * 16384 * 4);
constexpr size_t WS_WGLU  = WS_WEIN + (size_t)2048 * 1024 * 2;
constexpr size_t WS_WEOUT = WS_WGLU + (size_t)512 * 512 * 2;
constexpr size_t WS_WQ0   = WS_WEOUT + (size_t)1024 * 1024 * 2;
constexpr size_t WS_WQ1   = WS_WQ0 + (size_t)2048 * 1024 * 2;
constexpr size_t WS_WOIN  = WS_WQ1 + (size_t)2048 * 1024 * 2;
constexpr size_t WS_WOOUT = WS_WOIN + al256((size_t)ODD_IN * 1024 * 2);
constexpr size_t WS_H     = WS_WOOUT + (size_t)1024 * 1024 * 2;
constexpr size_t WS_PUV   = WS_H + (size_t)R * 1024 * 4;
constexpr size_t WS_ACT   = WS_PUV + (size_t)2 * 16384 * 1024 * 2;
constexpr size_t WS_ARENA = WS_ACT + (size_t)R * 1024 * 2;
constexpr size_t WS_GG    = WS_WEIN;
constexpr size_t WS_BETA  = WS_GG + (size_t)16 * R * 4;
constexpr size_t WS_GC    = WS_BETA + (size_t)16 * R * 4;
constexpr size_t WS_AB    = WS_GC + (size_t)NUNITS * 64 * 4;
static_assert(WS_AB + (size_t)R * 32 * 4 <= WS_WQ1, "layer-1 small buffers overflow the dead layer-0 weights");
constexpr size_t WS_PA    = WS_ARENA;
constexpr size_t WS_WQB   = WS_PA;
constexpr size_t WS_UG    = WS_PA + (size_t)R * 1536 * 2;
constexpr size_t WS_MS5   = WS_UG + (size_t)32 * NCH * 1024 * 2;
constexpr size_t WS_O5    = WS_MS5 + (size_t)32 * 1280 * 1024 * 2;
constexpr size_t WS_KTAB  = WS_O5 + (size_t)32 * 1024 * 256 * 2;
constexpr size_t WS_YL    = WS_KTAB + (size_t)2 * 32 * 64 * 256 * 4;
constexpr size_t WS_LST   = WS_YL + (size_t)R * 512 * 4;
constexpr size_t WS_A5    = WS_LST + (size_t)32 * NCH * 256 * 4;
constexpr size_t WS_GS    = WS_A5 + (size_t)32 * NCH * 256 * 2;
constexpr size_t WS_CB    = WS_GS + (size_t)R * 512 * 2;
constexpr size_t WS_END_L0 = WS_CB + (size_t)R * 1024 * 2;
constexpr size_t WS_Q     = WS_ARENA;
constexpr size_t WS_SC    = WS_Q + (size_t)R * 2048 * 2;
constexpr size_t WS_IDX   = WS_SC + (size_t)R * 2048 * 2;
constexpr size_t WS_GATE  = WS_IDX + (size_t)R * 128 * 4;
constexpr size_t WS_END_PEER = WS_GATE + (size_t)R * 128 * 4;
constexpr size_t WS_QKVR  = WS_ARENA;
constexpr size_t WS_W     = WS_QKVR;
constexpr size_t WS_ATT   = WS_W + (size_t)NUNITS * 64 * 128 * 2;
static_assert(WS_ATT + (size_t)NUNITS * 64 * 64 * 2 <= WS_QKVR + (size_t)R * 3072 * 2, "W+ATT must fit in QKVR");
constexpr size_t WS_Z     = WS_QKVR + (size_t)R * 3072 * 2;
constexpr size_t WS_QN    = WS_Z + (size_t)R * 1024 * 2;
constexpr size_t WS_KN    = WS_QN + (size_t)R * 1024 * 2;
constexpr size_t WS_VN    = WS_KN + (size_t)R * 1024 * 2;
constexpr size_t WS_UT    = WS_VN + (size_t)R * 1024 * 2;
constexpr size_t WS_END_L1 = WS_UT + (size_t)NUNITS * 128 * 64 * 2;
constexpr size_t WS_OF    = WS_PUV;
constexpr size_t WS_SIN   = WS_ACT;
constexpr size_t WS_BSEG  = WS_SIN + (size_t)256 * 65536;
constexpr size_t WS_ASEG  = WS_VN;
static_assert(WS_BSEG + (size_t)256 * 65536 <= WS_ARENA, "SIN+BSEG must fit in ACT");
constexpr size_t cmax(size_t a, size_t b) { return a > b ? a : b; }
constexpr size_t WS_NEED  = cmax(cmax(WS_END_L0, WS_END_PEER), WS_END_L1);
static_assert(WS_NEED <= (size_t)512 * 1024 * 1024, "workspace plan exceeds 512 MiB");

constexpr int LDS_BYTES = 160 * 1024;

struct Params {
    const float* in[32];
    float* out;
    unsigned char* ws;
};

__device__ __forceinline__ int tid_() { int t = threadIdx.x; asm volatile("" : "+v"(t)); return t; }
__device__ __forceinline__ float bf2f(bf16_t b) { return __uint_as_float((unsigned)b << 16); }
__device__ __forceinline__ bf16_t f2bf(float f) { const __bf16 b = (__bf16)f; return __builtin_bit_cast(bf16_t, b); }
typedef float f32x2_t __attribute__((ext_vector_type(2)));
typedef __bf16 bf16x2_t __attribute__((ext_vector_type(2)));
__device__ __forceinline__ unsigned pack2(float lo, float hi) { const f32x2_t v = {lo, hi}; const bf16x2_t b = __builtin_convertvector(v, bf16x2_t); return __builtin_bit_cast(unsigned, b); }
__device__ __forceinline__ float lo2f(unsigned p) { return __uint_as_float(p << 16); }
__device__ __forceinline__ float hi2f(unsigned p) { return __uint_as_float(p & 0xFFFF0000u); }
__device__ __forceinline__ float sigmoidf_(float x) { return 1.f / (1.f + __expf(-x)); }
__device__ __forceinline__ float siluf_(float x) { return x * sigmoidf_(x); }
__device__ __forceinline__ float gelu_tanh(float x) {
    const float u = 0.7978845608028654f * (x + 0.044715f * x * x * x);
    const float t = 1.f - 2.f / (1.f + __expf(2.f * u));
    return 0.5f * x * (1.f + t);
}
__device__ __forceinline__ float gelu_fast(float x) {
    const float w = __builtin_fmaf(x * x, -0.10294324f, -2.30220819f);
    return x * __builtin_amdgcn_rcpf(1.f + __builtin_amdgcn_exp2f(x * w));
}
__device__ __forceinline__ void lds_barrier() {
    asm volatile("s_waitcnt lgkmcnt(0)" ::: "memory");
    __builtin_amdgcn_s_barrier();
    asm volatile("" ::: "memory");
}
__device__ __forceinline__ float wave_sum(float v) {
#pragma unroll
    for (int o = 32; o > 0; o >>= 1) v += __shfl_xor(v, o, 64);
    return v;
}

__device__ __forceinline__ float wave_sum_dpp(float v) {
    v += __int_as_float(__builtin_amdgcn_update_dpp(0, __float_as_int(v), 0xB1, 0xF, 0xF, true));
    v += __int_as_float(__builtin_amdgcn_update_dpp(0, __float_as_int(v), 0x4E, 0xF, 0xF, true));
    v += __int_as_float(__builtin_amdgcn_update_dpp(0, __float_as_int(v), 0x141, 0xF, 0xF, true));
    v += __int_as_float(__builtin_amdgcn_update_dpp(0, __float_as_int(v), 0x140, 0xF, 0xF, true));
    v += __int_as_float(__builtin_amdgcn_update_dpp(0, __float_as_int(v), 0x142, 0xA, 0xF, false));
    v += __int_as_float(__builtin_amdgcn_update_dpp(0, __float_as_int(v), 0x143, 0xC, 0xF, false));
    return __int_as_float(__builtin_amdgcn_readlane(__float_as_int(v), 63));
}
__device__ __forceinline__ void unpack8(const uint4& p, float* f) {
    f[0] = lo2f(p.x); f[1] = hi2f(p.x); f[2] = lo2f(p.y); f[3] = hi2f(p.y);
    f[4] = lo2f(p.z); f[5] = hi2f(p.z); f[6] = lo2f(p.w); f[7] = hi2f(p.w);
}
__device__ __forceinline__ uint4 pack8(const float* f) {
    uint4 p; p.x = pack2(f[0], f[1]); p.y = pack2(f[2], f[3]); p.z = pack2(f[4], f[5]); p.w = pack2(f[6], f[7]); return p;
}
__device__ __forceinline__ const float* modp(const Params& p, int l, int row, int j) {
    const float* m = (const float*)(p.ws + WS_MOD);
    return m + ((l * 2 + (row >= SEQ ? 1 : 0)) * 6 + j) * 1024;
}

#define LAS __attribute__((address_space(3)))
constexpr int GT_STAGE = 32768;
template <class Epi>
__device__ __forceinline__ void gemm_tile(const bf16_t* __restrict__ A, int lda, int M, const bf16_t* __restrict__ Bt, int ldb, int N, int K,
                                          int row0, int col0, Epi epi, unsigned char* lds_generic) {
    LAS unsigned char* lds = (LAS unsigned char*)lds_generic;
    const int tid = tid_(), lane = tid & 63, wave = __builtin_amdgcn_readfirstlane(tid >> 6);
    const int wm = wave >> 2, wn = wave & 3, r = lane & 31, h = lane >> 5;
    const bf16_t* ga[2]; const bf16_t* gb[2];
#pragma unroll
    for (int i = 0; i < 2; ++i) {
        const int trow = 8 * (wave + 8 * i) + (lane >> 3), kp = (lane & 7) ^ ((trow >> 1) & 7);
        int ra = row0 + trow, rb = col0 + trow; ra = ra < M ? ra : M - 1; rb = rb < N ? rb : N - 1;
        ga[i] = A + (size_t)ra * lda + kp * 8; gb[i] = Bt + (size_t)rb * ldb + kp * 8;
    }
    f32x16 acc0, acc1;
#pragma unroll
    for (int i = 0; i < 16; ++i) { acc0[i] = 0.f; acc1[i] = 0.f; }
    const int nk = K >> 6;
#define GT_ISSUE(kt_) do { const int st_ = ((kt_) & 3) * GT_STAGE; _Pragma("unroll") for (int i_ = 0; i_ < 2; ++i_) { \
        __builtin_amdgcn_global_load_lds((const unsigned*)(ga[i_] + (kt_) * 64), (LAS unsigned*)(lds + st_ + (wave + 8 * i_) * 1024), 16, 0, 0); \
        __builtin_amdgcn_global_load_lds((const unsigned*)(gb[i_] + (kt_) * 64), (LAS unsigned*)(lds + st_ + 16384 + (wave + 8 * i_) * 1024), 16, 0, 0); } } while (0)
    __syncthreads();
    GT_ISSUE(0);
    if (nk > 1) GT_ISSUE(1);
    if (nk > 2) GT_ISSUE(2);
    const int xs = (r >> 1) & 7;
    const int aoff = (wm * 64 + r) * 128, boff = 16384 + (wn * 32 + r) * 128;
#pragma unroll 1
    for (int kt = 0; kt < nk; ++kt) {
        const int ahead = nk - 1 - kt;
        if (ahead >= 2) asm volatile("s_waitcnt vmcnt(8)" ::: "memory");
        else if (ahead == 1) asm volatile("s_waitcnt vmcnt(4)" ::: "memory");
        else asm volatile("s_waitcnt vmcnt(0)" ::: "memory");
        __builtin_amdgcn_s_barrier();
        asm volatile("" ::: "memory");
        if (kt + 3 < nk) GT_ISSUE(kt + 3);
        const LAS unsigned char* sb = lds + (kt & 3) * GT_STAGE;
#pragma unroll
        for (int s = 0; s < 4; ++s) {
            const int ko = ((2 * s + h) ^ xs) * 16;
            const bf16x8 a0 = *(const LAS bf16x8*)(sb + aoff + ko);
            const bf16x8 a1 = *(const LAS bf16x8*)(sb + aoff + 32 * 128 + ko);
            const bf16x8 b  = *(const LAS bf16x8*)(sb + boff + ko);
            acc0 = __builtin_amdgcn_mfma_f32_32x32x16_bf16(a0, b, acc0, 0, 0, 0);
            acc1 = __builtin_amdgcn_mfma_f32_32x32x16_bf16(a1, b, acc1, 0, 0, 0);
        }
    }
#undef GT_ISSUE
    __builtin_amdgcn_s_barrier();
    asm volatile("" ::: "memory");
    {
        LAS float* sc = (LAS float*)lds;
#pragma unroll
        for (int i = 0; i < 16; ++i) {
            const int rr = wm * 64 + (i & 3) + 8 * (i >> 2) + 4 * h;
            sc[rr * 132 + wn * 32 + r] = acc0[i];
            sc[(rr + 32) * 132 + wn * 32 + r] = acc1[i];
        }
    }
    __syncthreads();
    {
        const LAS float* sc = (const LAS float*)lds;
        const int c8 = (tid & 15) * 8, col = col0 + c8;
#pragma unroll
        for (int ps = 0; ps < 4; ++ps) {
            const int rl = (tid >> 4) + 32 * ps, row = row0 + rl;
            const f32x4 v0 = *(const LAS f32x4*)(sc + rl * 132 + c8), v1 = *(const LAS f32x4*)(sc + rl * 132 + c8 + 4);
            if (row < M && col < N) { const float v[8] = {v0[0], v0[1], v0[2], v0[3], v1[0], v1[1], v1[2], v1[3]}; epi(row, col, v); }
        }
    }
}

namespace pg8 {
#define PG8_LAS __attribute__((address_space(3)))
typedef unsigned short bf16_t;
typedef short bf16x8 __attribute__((ext_vector_type(8)));
typedef float f32x4 __attribute__((ext_vector_type(4)));
typedef unsigned u32x4 __attribute__((ext_vector_type(4)));
constexpr int BM = 256, BK = 64, HALF = 128, HTB = HALF * BK * 2  , STAGE_BYTES = 8 * HTB, NXCD = 8, WGM = 8;

__host__ __device__ __forceinline__ int lds_byte(int r, int c) { const int st = (r >> 4) * 2 + (c >> 5), rr = r & 15, cc = c & 31, ob = rr * 64 + cc * 2; return st * 1024 + (ob ^ (((ob >> 9) & 1) << 5)); }
__host__ __device__ __forceinline__ void stage_rc(int b, int& R, int& C) { const int st = b / 1024, sb = b % 1024, swz = sb ^ (((sb >> 9) & 1) << 5); R = (st >> 1) * 16 + swz / 64; C = (st & 1) * 32 + (swz % 64) / 2; }
__host__ __device__ __forceinline__ int perm32(int rho) { const int n = rho >> 4, i = rho & 15; return 8 * (i >> 2) + 4 * n + (i & 3); }

struct Unit { int pm, pn; };
struct Gemm { const bf16_t* A; const bf16_t* Bt; int M, N, K; };

struct StaticOrder {
    int nM, nN, nwg, G, c;
    __host__ __device__ void init(int M, int N, int G_, int c_) { nM = M / BM; nN = N / BM; nwg = nM * nN; G = G_; c = c_; }
    __host__ __device__ bool next(int i, Unit& u) const {
        const long L = (long)i * G + c; if (L >= nwg) return false;
        int wgid = (int)L; { const int q = nwg / NXCD, r = nwg % NXCD, xcd = wgid % NXCD, off = wgid / NXCD; wgid = (xcd < r ? xcd * (q + 1) : r * (q + 1) + (xcd - r) * q) + off; }
        const int nig = WGM * nN, gid = wgid / nig, fm = gid * WGM, gsz = (nM - fm) < WGM ? (nM - fm) : WGM;
        u.pm = fm + ((wgid % nig) % gsz); u.pn = (wgid % nig) / gsz; return true;
    }
    __device__ __forceinline__ void a_ready(const Unit&) const {}
    __device__ __forceinline__ void done(const Unit&) const {}
};
template <class Epi, class Sched, bool STAMP = false>
__device__ __forceinline__ void gemm_phase(PG8_LAS unsigned char* lds, const Gemm g, const Sched& S, const Epi& E, unsigned long long* stamps) {
    const int tid = tid_(), wid = __builtin_amdgcn_readfirstlane(tid >> 6), lane = tid & 63, wr = wid >> 2, wc = wid & 3, fr = lane & 15, fq = lane >> 4;
    const int K = g.K, nt = K / BK;
    int ts_lo = 0, ts_hi = 0, nts = 0; const unsigned long long rt_entry = STAMP ? (unsigned long long)0ull : 0ull;
#define PG8_STAMP() do { if (STAMP && wid == 0 && nts < 64) { const unsigned long long _c = (unsigned long long)0ull; \
        ts_lo = (lane == nts) ? (int)(unsigned)_c : ts_lo; ts_hi = (lane == nts) ? (int)(unsigned)(_c >> 32) : ts_hi; ++nts; } } while (0)
    PG8_STAMP();
    unsigned voffA[2], voffB[2];
#pragma unroll
    for (int i = 0; i < 2; ++i) { int R, C; stage_rc(tid * 16 + i * 8192, R, C); const int Rb = Epi::PERM ? ((R & ~31) + perm32(R & 31)) : R;
        voffA[i] = (unsigned)(R * K + C) * 2u; voffB[i] = (unsigned)(Rb * K + C) * 2u; }
    const size_t kstep = (size_t)(BK * 2);
    const size_t hstep = (size_t)HALF * K * 2;
    const size_t tstep = 2 * hstep;
    const unsigned ldsw = (unsigned)wid * 1024u;
    const int aoff = lds_byte(wr * 64 + fr, fq * 8), boff = lds_byte(wc * 32 + fr, fq * 8);
#define PG8_SA(b, h) (((b) * 2 + (h)) * HTB)
#define PG8_SB(b, h) ((4 + (b) * 2 + (h)) * HTB)
#define PG8_STAGE(bufoff, gbase, voff) do { _Pragma("unroll") for (int _i = 0; _i < 2; ++_i) { unsigned vo_ = (voff)[_i]; asm volatile("" : "+v"(vo_));   \
        __builtin_amdgcn_global_load_lds((const unsigned*)((const char*)(gbase) + vo_), (PG8_LAS unsigned*)(lds + (bufoff) + ldsw + _i * 8192), 16, 0, 0); } } while (0)
#define PG8_LDA(dst, b, h) do { _Pragma("unroll") for (int m = 0; m < 4; ++m) _Pragma("unroll") for (int k = 0; k < 2; ++k) dst[m][k] = *(const PG8_LAS bf16x8*)(lds + PG8_SA(b, h) + aoff + m * 2048 + k * 1024); } while (0)
#define PG8_LDB(dst, b, h) do { _Pragma("unroll") for (int n = 0; n < 2; ++n) _Pragma("unroll") for (int k = 0; k < 2; ++k) dst[n][k] = *(const PG8_LAS bf16x8*)(lds + PG8_SB(b, h) + boff + n * 2048 + k * 1024); } while (0)
#define PG8_MMA(ai, bj, At, Bt) do { __builtin_amdgcn_s_setprio(1); _Pragma("unroll") for (int m = 0; m < 4; ++m) _Pragma("unroll") for (int n = 0; n < 2; ++n) _Pragma("unroll") for (int k = 0; k < 2; ++k) \
        acc[ai][bj][m][n] = __builtin_amdgcn_mfma_f32_16x16x32_bf16(Bt[n][k], At[m][k], acc[ai][bj][m][n], 0, 0, 0); __builtin_amdgcn_s_setprio(0); } while (0)
#define PG8_WAIT_V(n) asm volatile("s_waitcnt vmcnt(" #n ")" ::: "memory")
#define PG8_WAIT_L(n) asm volatile("s_waitcnt lgkmcnt(" #n ")" ::: "memory")
#define PG8_BAR __builtin_amdgcn_s_barrier()
#define PG8_SCHED __builtin_amdgcn_sched_barrier(0)
    Unit cur, nxt; int ui = 0;
    if (!S.next(0, cur)) return;
    f32x4 acc[2][2][4][2];
#pragma unroll
    for (int a = 0; a < 2; ++a)
#pragma unroll
        for (int b = 0; b < 2; ++b)
#pragma unroll
            for (int m = 0; m < 4; ++m)
#pragma unroll
                for (int n = 0; n < 2; ++n) acc[a][b][m][n] = (f32x4){0.f, 0.f, 0.f, 0.f};
    bf16x8 At[4][2], B0[2][2], B1[2][2];
    const char* cA = (const char*)g.A + (size_t)cur.pm * tstep; const char* cB = (const char*)g.Bt + (size_t)cur.pn * tstep;
    S.a_ready(cur);
    PG8_STAGE(PG8_SB(0, 0), cB, voffB); PG8_STAGE(PG8_SA(0, 0), cA, voffA); PG8_STAGE(PG8_SB(0, 1), cB + hstep, voffB); PG8_STAGE(PG8_SA(0, 1), cA + hstep, voffA);
    if (wr == 1) PG8_BAR;
    PG8_WAIT_V(4); PG8_BAR;
    PG8_STAGE(PG8_SB(1, 0), cB + kstep, voffB); PG8_STAGE(PG8_SA(1, 0), cA + kstep, voffA); PG8_STAGE(PG8_SB(1, 1), cB + hstep + kstep, voffB);
    PG8_WAIT_V(6); PG8_BAR;
    PG8_STAMP();
    for (;;) {
        const bool has_next = S.next(ui + 1, nxt);
        const char* nA = has_next ? (const char*)g.A + (size_t)nxt.pm * tstep : cA; const char* nB = has_next ? (const char*)g.Bt + (size_t)nxt.pn * tstep : cB;
        for (int t = 0; t < nt; t += 2) {
            const bool last = (t == nt - 2);
            const char* a1 = cA + (size_t)(t + 1) * kstep;
            const char* a2 = last ? nA : cA + (size_t)(t + 2) * kstep; const char* b2 = last ? nB : cB + (size_t)(t + 2) * kstep;
            const char* a3 = a2 + kstep; const char* b3 = b2 + kstep;
            if (last && has_next) S.a_ready(nxt);
            PG8_LDB(B0, 0, 0); PG8_SCHED; PG8_LDA(At, 0, 0); PG8_STAGE(PG8_SA(1, 1), a1 + hstep, voffA);
            PG8_WAIT_L(8); PG8_BAR; PG8_WAIT_L(0); PG8_MMA(0, 0, At, B0); PG8_BAR; PG8_SCHED;
            PG8_LDB(B1, 0, 1); PG8_STAGE(PG8_SB(0, 0), b2, voffB);
            PG8_BAR; PG8_WAIT_L(0); PG8_MMA(0, 1, At, B1); PG8_BAR;
            PG8_LDA(At, 0, 1); PG8_STAGE(PG8_SA(0, 0), a2, voffA);
            PG8_BAR; PG8_WAIT_L(0); PG8_MMA(1, 0, At, B0); PG8_BAR; PG8_SCHED;
            PG8_STAGE(PG8_SB(0, 1), b2 + hstep, voffB);
            PG8_WAIT_V(6); PG8_BAR; PG8_MMA(1, 1, At, B1); PG8_BAR;
            PG8_LDB(B0, 1, 0); PG8_SCHED; PG8_LDA(At, 1, 0); PG8_STAGE(PG8_SA(0, 1), a2 + hstep, voffA);
            PG8_WAIT_L(8); PG8_BAR; PG8_WAIT_L(0); PG8_MMA(0, 0, At, B0); PG8_BAR; PG8_SCHED;
            PG8_LDB(B1, 1, 1); PG8_STAGE(PG8_SB(1, 0), b3, voffB);
            PG8_BAR; PG8_WAIT_L(0); PG8_MMA(0, 1, At, B1); PG8_BAR;
            PG8_LDA(At, 1, 1); PG8_STAGE(PG8_SA(1, 0), a3, voffA);
            PG8_BAR; PG8_WAIT_L(0); PG8_MMA(1, 0, At, B0); PG8_BAR; PG8_SCHED;
            PG8_STAGE(PG8_SB(1, 1), b3 + hstep, voffB);
            PG8_WAIT_V(6); PG8_BAR; PG8_MMA(1, 1, At, B1); PG8_BAR;
        }
        PG8_STAMP();
        if constexpr (!Epi::AFTER_DRAIN) { E(acc, cur, wr, wc, fr, fq); S.done(cur); }
        PG8_STAMP();
        if (!has_next) break;
#pragma unroll
        for (int a = 0; a < 2; ++a)
#pragma unroll
            for (int b = 0; b < 2; ++b)
#pragma unroll
                for (int m = 0; m < 4; ++m)
#pragma unroll
                    for (int n = 0; n < 2; ++n) acc[a][b][m][n] = (f32x4){0.f, 0.f, 0.f, 0.f};
        cur = nxt; cA = nA; cB = nB; ++ui;
    }
    PG8_WAIT_V(0);
    if (wr == 0) PG8_BAR;
    PG8_BAR;
    if constexpr (Epi::AFTER_DRAIN) { E.fused(acc, cur, wr, wc, fr, fq, lds, wid, lane); S.done(cur); }
    PG8_STAMP();
    if (STAMP && wid == 0) { stamps[lane] = lane < nts ? (((unsigned long long)(unsigned)ts_hi << 32) | (unsigned)ts_lo) : 0ull;
        if (lane == 62) stamps[62] = rt_entry; if (lane == 63) stamps[63] = (unsigned long long)0ull; }
#undef PG8_STAMP
#undef PG8_SA
#undef PG8_SB
#undef PG8_STAGE
#undef PG8_LDA
#undef PG8_LDB
#undef PG8_MMA
#undef PG8_WAIT_V
#undef PG8_WAIT_L
#undef PG8_BAR
#undef PG8_SCHED
}
}

template <class F> struct EpiAdapt {
    static constexpr bool PERM = true, AFTER_DRAIN = false;
    F f;
    __device__ __forceinline__ void operator()(const pg8::f32x4 (&acc)[2][2][4][2], const pg8::Unit& u, int wr, int wc, int fr, int fq) const {
#pragma unroll
        for (int ai = 0; ai < 2; ++ai)
#pragma unroll
            for (int m = 0; m < 4; ++m) {
                const int row = u.pm * 256 + ai * 128 + wr * 64 + m * 16 + fr;
#pragma unroll
                for (int bj = 0; bj < 2; ++bj) {
                    const int col = u.pn * 256 + bj * 128 + wc * 32 + 8 * fq;
                    const float v[8] = {acc[ai][bj][m][0][0], acc[ai][bj][m][0][1], acc[ai][bj][m][0][2], acc[ai][bj][m][0][3],
                                        acc[ai][bj][m][1][0], acc[ai][bj][m][1][1], acc[ai][bj][m][1][2], acc[ai][bj][m][1][3]};
                    f(row, col, v);
                    asm volatile("" ::: "memory");
                }
            }
    }
};
template <class F>
__device__ __forceinline__ void gemm_big(const bf16_t* A, const bf16_t* Bt, int M, int N, int K, F f, unsigned char* lds_generic) {
    __syncthreads();
    pg8::Gemm g{A, Bt, M, N, K};
    pg8::StaticOrder S; S.init(M, N, (int)gridDim.x, (int)blockIdx.x);
    EpiAdapt<F> E{f};
    pg8::gemm_phase<EpiAdapt<F>, pg8::StaticOrder, false>((LAS unsigned char*)lds_generic, g, S, E, nullptr);
    __syncthreads();
}

__device__ __forceinline__ void p0_adaln(const Params& p, int item, unsigned char* lds) {
    const int l = item / 96, cb = item % 96, tid = tid_();
    const int kq = tid >> 4, c4 = tid & 15;
    const float* W = p.in[4] + (size_t)l * 1024 * 6144 + cb * 64 + c4 * 4;
    const float* c = p.in[1]; const float* cc = p.in[3];
    float al[4] = {0, 0, 0, 0}, ac[4] = {0, 0, 0, 0};
#pragma unroll 8
    for (int k = kq; k < 1024; k += 32) {
        const float4 w = *(const float4*)(W + (size_t)k * 6144);
        const float sl = siluf_(c[k]), sc = siluf_(cc[k]);
        al[0] += sl * w.x; al[1] += sl * w.y; al[2] += sl * w.z; al[3] += sl * w.w;
        ac[0] += sc * w.x; ac[1] += sc * w.y; ac[2] += sc * w.z; ac[3] += sc * w.w;
    }
    float* red = (float*)lds;
    __syncthreads();
#pragma unroll
    for (int e = 0; e < 4; ++e) { red[(kq * 2 + 0) * 64 + c4 * 4 + e] = al[e]; red[(kq * 2 + 1) * 64 + c4 * 4 + e] = ac[e]; }
    __syncthreads();
    if (tid < 128) {
        const int s = tid >> 6, cidx = tid & 63;
        float sum = 0.f;
        for (int q = 0; q < 32; ++q) sum += red[(q * 2 + s) * 64 + cidx];
        const int col = cb * 64 + cidx;
        sum += p.in[5][l * 6144 + col];
        ((float*)(p.ws + WS_MOD))[(l * 2 + s) * 6144 + col] = sum;
    }
}
__device__ __forceinline__ void p0_transpose(const float* __restrict__ src, int K, int N, bf16_t* __restrict__ dst, int tile, unsigned char* lds) {
    const int ntn = (N + 63) / 64, tk = tile / ntn, tn = tile % ntn, tid = tid_();
    float* s = (float*)lds;
    __syncthreads();
    for (int e = tid; e < 64 * 64; e += NTHREADS) {
        const int kk = e >> 6, nn = e & 63; const int n = tn * 64 + nn;
        s[kk * 65 + nn] = n < N ? src[(size_t)(tk * 64 + kk) * N + n] : 0.f;
    }
    __syncthreads();
    {
        const int nn = tid >> 3, kg = (tid & 7) * 8; const int n = tn * 64 + nn;
        if (n < N) {
            float f[8];
#pragma unroll
            for (int e = 0; e < 8; ++e) f[e] = s[(kg + e) * 65 + nn];
            *(uint4*)(dst + (size_t)n * K + tk * 64 + kg) = pack8(f);
        }
    }
}
__device__ __forceinline__ void cvt_chunk(const float* __restrict__ src, bf16_t* __restrict__ dst, size_t item) {
    const size_t o = item * 4096 + (size_t)tid_() * 8;
    const float4 a = *(const float4*)(src + o), b = *(const float4*)(src + o + 4);
    uint4 q; q.x = pack2(a.x, a.y); q.y = pack2(a.z, a.w); q.z = pack2(b.x, b.y); q.w = pack2(b.z, b.w);
    *(uint4*)(dst + o) = q;
}
typedef float v32f_t __attribute__((ext_vector_type(32)));
typedef _Float16 v32h_t __attribute__((ext_vector_type(32)));
typedef unsigned v6u_t __attribute__((ext_vector_type(6)));
struct __attribute__((packed, aligned(8))) U6 { unsigned a, b, c, d, e, f; };
constexpr int PREC = 1536;
__device__ __forceinline__ void peer_tables_item(const Params& p, int item, int l) {
    const int lane = tid_() & 63, ex = item * 8 + (tid_() >> 6);
    const float* su = p.in[29] + ((size_t)l * 16384 + ex) * 1024 + lane * 16;
    const float* sv = p.in[30] + ((size_t)l * 16384 + ex) * 1024 + lane * 16;
    float4 u[4], v[4]; float amu = 0.f, amv = 0.f;
#pragma unroll
    for (int q = 0; q < 4; ++q) { u[q] = *(const float4*)(su + q * 4); v[q] = *(const float4*)(sv + q * 4); }
#pragma unroll
    for (int q = 0; q < 4; ++q) {
        amu = fmaxf(amu, fmaxf(fmaxf(fabsf(u[q].x), fabsf(u[q].y)), fmaxf(fabsf(u[q].z), fabsf(u[q].w))));
        amv = fmaxf(amv, fmaxf(fmaxf(fabsf(v[q].x), fabsf(v[q].y)), fmaxf(fabsf(v[q].z), fabsf(v[q].w))));
    }
#pragma unroll
    for (int o = 32; o > 0; o >>= 1) { amu = fmaxf(amu, __shfl_xor(amu, o, 64)); amv = fmaxf(amv, __shfl_xor(amv, o, 64)); }
    const float scu = amu > 0.f ? 7.0f / amu : 1.f, scv = amv > 0.f ? 7.0f / amv : 1.f;
    v32h_t x;
#pragma unroll
    for (int q = 0; q < 4; ++q) {
        x[4 * q + 0] = (_Float16)(u[q].x * scu); x[4 * q + 1] = (_Float16)(u[q].y * scu); x[4 * q + 2] = (_Float16)(u[q].z * scu); x[4 * q + 3] = (_Float16)(u[q].w * scu);
        x[16 + 4 * q + 0] = (_Float16)(v[q].x * scv); x[16 + 4 * q + 1] = (_Float16)(v[q].y * scv); x[16 + 4 * q + 2] = (_Float16)(v[q].z * scv); x[16 + 4 * q + 3] = (_Float16)(v[q].w * scv);
    }
    const v6u_t pk = __builtin_amdgcn_cvt_scalef32_pk32_fp6_f16(x, 1.0f);
    U6 o; o.a = pk[0]; o.b = pk[1]; o.c = pk[2]; o.d = pk[3]; o.e = pk[4]; o.f = pk[5];
    *(U6*)(p.ws + WS_PUV + (size_t)ex * PREC + lane * 24) = o;
    if (lane == 0) { float* psc = (float*)(p.ws + WS_PSC); psc[ex] = amu > 0.f ? amu / 7.0f : 1.f; psc[16384 + ex] = amv > 0.f ? amv / 7.0f : 1.f; }
}

__device__ __forceinline__ void sincos_d(double x, double& s, double& c) {
    const double TWO_OVER_PI = 0.63661977236758134308, PIO2_HI = 1.57079632679489655800e+00, PIO2_LO = 6.12323399573676603587e-17;
    const double kf = rint(x * TWO_OVER_PI);
    const double y = (x - kf * PIO2_HI) - kf * PIO2_LO;
    const double y2 = y * y;
    double sp = -1.0 / 1307674368000.0;
    sp = sp * y2 + 1.0 / 6227020800.0; sp = sp * y2 - 1.0 / 39916800.0; sp = sp * y2 + 1.0 / 362880.0; sp = sp * y2 - 1.0 / 5040.0;
    sp = sp * y2 + 1.0 / 120.0; sp = sp * y2 - 1.0 / 6.0; sp = sp * y2 + 1.0; sp *= y;
    double cp = 1.0 / 20922789888000.0;
    cp = cp * y2 - 1.0 / 87178291200.0; cp = cp * y2 + 1.0 / 479001600.0; cp = cp * y2 - 1.0 / 3628800.0; cp = cp * y2 + 1.0 / 40320.0;
    cp = cp * y2 - 1.0 / 720.0; cp = cp * y2 + 1.0 / 24.0; cp = cp * y2 - 0.5; cp = cp * y2 + 1.0;
    const int q = ((int)kf) & 3;
    s = (q == 0) ? sp : (q == 1) ? cp : (q == 2) ? -sp : -cp;
    c = (q == 0) ? cp : (q == 1) ? -sp : (q == 2) ? -cp : sp;
}
__device__ __forceinline__ void p0_s5_tables(const Params& p, int item4, unsigned char* lds) {
    const int item = item4 >> 2, qt = item4 & 3;
    const int di = item >> 5, g = item & 31, tid = tid_();
    float2* apw = (float2*)lds;
    float2* Bb = apw + 64 * 65;
    float2* Cc = Bb + 64 * 16;
    __syncthreads();
    if (tid < 64) {
        const int pidx = (di * 32 + g) * 64 + tid;
        float lr = p.in[10][pidx]; lr = lr < -1e-4f ? lr : -1e-4f;
        const float li = p.in[11][pidx];
        const float dt = expf(p.in[12][di * 32 + g]);
        const double mag = (double)expf(lr * dt);
        double sn, cs; sincos_d((double)li * (double)dt, sn, cs);
        const double are = mag * cs, aim = mag * sn;
        double pr = 1.0, pi_ = 0.0;
        for (int t = 0; t <= 64; ++t) {
            apw[tid * 65 + t] = make_float2((float)pr, (float)pi_);
            const double nr = pr * are - pi_ * aim, ni = pr * aim + pi_ * are; pr = nr; pi_ = ni;
        }
        if (qt == 0) ((float2*)(p.ws + WS_A64))[(di * 32 + g) * 64 + tid] = apw[tid * 65 + 64];
        const double den = (double)lr * lr + (double)li * li;
        const double fre = ((are - 1.0) * lr + aim * li) / den, fim = (aim * lr - (are - 1.0) * li) / den;
        for (int hh = 0; hh < 16; ++hh) {
            const double br = p.in[13][(size_t)pidx * 16 + hh], bi = p.in[14][(size_t)pidx * 16 + hh];
            Bb[tid * 16 + hh] = make_float2((float)(fre * br - fim * bi), (float)(fre * bi + fim * br));
        }
    }
    for (int e = tid; e < 1024; e += NTHREADS) {
        const size_t gi = ((size_t)(di * 32 + g) * 16) * 64 + e;
        Cc[e] = make_float2(p.in[15][gi], p.in[16][gi]);
    }
    __syncthreads();
    float* ktab = (float*)(p.ws + WS_KTAB) + (size_t)(di * 32 + g) * 64 * 256;
    for (int o = qt * 4096 + tid; o < (qt + 1) * 4096; o += NTHREADS) {
        const int tau = o >> 8, hh = (o >> 4) & 15, h2 = o & 15;
        float acc = 0.f;
        for (int pp = 0; pp < 64; ++pp) {
            const float2 a = apw[pp * 65 + tau], c = Cc[hh * 64 + pp], b = Bb[pp * 16 + h2];
            const float cr = c.x * a.x - c.y * a.y, ci = c.x * a.y + c.y * a.x;
            acc += cr * b.x - ci * b.y;
        }
        ktab[o] = acc;
    }
    bf16_t* ms5 = (bf16_t*)(p.ws + WS_MS5) + (size_t)g * 1280 * 1024;
    for (int t = qt * 4096 + tid; t < (qt + 1) * 4096; t += NTHREADS) {
        const int row = t >> 7, k8 = t & 127; const int ri = row >> 6, pp = row & 63, j = k8 >> 1, h0 = (k8 & 1) * 8;
        const float2 a = apw[pp * 65 + (di == 0 ? 63 - j : j)];
        float f[8];
#pragma unroll
        for (int e = 0; e < 8; ++e) { const float2 b = Bb[pp * 16 + h0 + e]; f[e] = ri == 0 ? (a.x * b.x - a.y * b.y) : (a.x * b.y + a.y * b.x); }
        *(uint4*)(ms5 + (size_t)(1024 + di * 128 + row) * 1024 + k8 * 8) = pack8(f);
    }
    bf16_t* o5 = (bf16_t*)(p.ws + WS_O5) + (size_t)g * 1024 * 256;
    for (int t = qt * 4096 + tid; t < (qt + 1) * 4096; t += NTHREADS) {
        const int n = t >> 4, q = t & 15; const int ri = q >> 3, p0 = (q & 7) * 8, i = n >> 4, hh = n & 15;
        float f[8];
#pragma unroll
        for (int e = 0; e < 8; ++e) {
            const float2 a = apw[(p0 + e) * 65 + (di == 0 ? i + 1 : 64 - i)], c = Cc[hh * 64 + p0 + e];
            f[e] = ri == 0 ? (c.x * a.x - c.y * a.y) : -(c.x * a.y + c.y * a.x);
        }
        *(uint4*)(o5 + (size_t)n * 256 + di * 128 + ri * 64 + p0) = pack8(f);
    }
}

template <bool SRC_BF16>
__device__ __forceinline__ void norm_mod_row(const void* __restrict__ srcv, const float* __restrict__ g, const float* __restrict__ shift,
                                             const float* __restrict__ scale, bf16_t* __restrict__ dst, int lane) {
    float4 v[4]; float ss = 0.f;
#pragma unroll
    for (int k = 0; k < 4; ++k) {
        if (SRC_BF16) { const uint2 q = *(const uint2*)((const bf16_t*)srcv + k * 256 + lane * 4); v[k] = make_float4(lo2f(q.x), hi2f(q.x), lo2f(q.y), hi2f(q.y)); }
        else v[k] = *(const float4*)((const float*)srcv + k * 256 + lane * 4);
        ss += v[k].x * v[k].x + v[k].y * v[k].y + v[k].z * v[k].z + v[k].w * v[k].w;
    }
    ss = wave_sum(ss);
    const float rs = rsqrtf(ss * (1.f / 1024.f) + 1e-6f);
#pragma unroll
    for (int k = 0; k < 4; ++k) {
        const int c = k * 256 + lane * 4;
        const float4 gg = *(const float4*)(g + c), sh = *(const float4*)(shift + c), sc = *(const float4*)(scale + c);
        uint2 o;
        o.x = pack2(v[k].x * rs * gg.x * (1.f + sc.x) + sh.x, v[k].y * rs * gg.y * (1.f + sc.y) + sh.y);
        o.y = pack2(v[k].z * rs * gg.z * (1.f + sc.z) + sh.z, v[k].w * rs * gg.w * (1.f + sc.w) + sh.w);
        *(uint2*)(dst + c) = o;
    }
}
__device__ __forceinline__ void norm_rows_item(const Params& p, int item, int l, const float* g, int js, bool from_inputs) {
    const int row = item * 8 + (tid_() >> 6), lane = tid_() & 63;
    bf16_t* dst = (bf16_t*)(p.ws + WS_ACT) + (size_t)row * 1024;
    if (from_inputs) norm_mod_row<false>(row < SEQ ? p.in[0] + (size_t)row * 1024 : p.in[2] + (size_t)(row - SEQ) * 1024, g, modp(p, l, row, js), modp(p, l, row, js + 1), dst, lane);
    else norm_mod_row<true>((const bf16_t*)(p.ws + WS_H) + (size_t)row * 1024, g, modp(p, l, row, js), modp(p, l, row, js + 1), dst, lane);
}
__device__ __forceinline__ void s5_mintra_item(const Params& p, int item) {
    const int g = item >> 6, i = item & 63;
    const float* kt0 = (const float*)(p.ws + WS_KTAB) + (size_t)(0 * 32 + g) * 64 * 256;
    const float* kt1 = (const float*)(p.ws + WS_KTAB) + (size_t)(1 * 32 + g) * 64 * 256;
    const float* dsk = p.in[17] + g * 16;
    bf16_t* ms5 = (bf16_t*)(p.ws + WS_MS5) + (size_t)g * 1280 * 1024;
    for (int t = tid_(); t < 16 * 128; t += NTHREADS) {
        const int hh = t >> 7, k8 = t & 127, j = k8 >> 1, h0 = (k8 & 1) * 8;
        float f[8];
        if (j < i) { const float* s = kt0 + ((i - j) * 16 + hh) * 16 + h0;
#pragma unroll
            for (int e = 0; e < 8; ++e) f[e] = s[e]; }
        else if (j > i) { const float* s = kt1 + ((j - i) * 16 + hh) * 16 + h0;
#pragma unroll
            for (int e = 0; e < 8; ++e) f[e] = s[e]; }
        else { const float* s0 = kt0 + hh * 16 + h0; const float* s1 = kt1 + hh * 16 + h0;
#pragma unroll
            for (int e = 0; e < 8; ++e) f[e] = s0[e] + s1[e] + ((h0 + e) == hh ? dsk[hh] : 0.f); }
        *(uint4*)(ms5 + (size_t)(i * 16 + hh) * 1024 + k8 * 8) = pack8(f);
    }
}

struct EpiEvenIn {
    bf16_t* pa; bf16_t* ug;
    __device__ __forceinline__ void operator()(int row, int col, const float* v) const {
        if (col < 1536) *(uint4*)(pa + (size_t)row * 1536 + col) = pack8(v);
        else { const int c2 = col - 1536; *(uint4*)(ug + ((size_t)(c2 >> 4) * NCH + (row >> 6)) * 1024 + (row & 63) * 16 + (c2 & 15)) = pack8(v); }
    }
};
struct EpiS5Local {
    bf16_t* yl; float* lst; int g;
    __device__ __forceinline__ void operator()(int row, int col, const float* v) const {
        if (col < 1024) *(uint4*)(yl + (size_t)(row * 64 + (col >> 4)) * 512 + g * 16 + (col & 15)) = pack8(v);
        else { float* d = lst + ((size_t)g * NCH + row) * 256 + (col - 1024);
               *(float4*)d = make_float4(v[0], v[1], v[2], v[3]); *(float4*)(d + 4) = make_float4(v[4], v[5], v[6], v[7]); }
    }
};
struct EpiS5Out {
    const bf16_t* yl; bf16_t* gs; int g;
    __device__ __forceinline__ void operator()(int row, int col, const float* v) const {
        const size_t o = (size_t)(row * 64 + (col >> 4)) * 512 + g * 16 + (col & 15);
        float y[8]; unpack8(*(const uint4*)(yl + o), y);
        float f[8];
#pragma unroll
        for (int e = 0; e < 8; ++e) f[e] = gelu_tanh(v[e] + y[e]);
        *(uint4*)(gs + o) = pack8(f);
    }
};
struct EpiGlu {
    const bf16_t* gs; const float* b; bf16_t* cb;
    __device__ __forceinline__ void operator()(int row, int col, const float* v) const {
        float g[8], f[8]; unpack8(*(const uint4*)(gs + (size_t)row * 512 + col), g);
#pragma unroll
        for (int e = 0; e < 8; ++e) f[e] = g[e] * sigmoidf_(v[e] + b[col + e]);
        *(uint4*)(cb + (size_t)row * 1024 + 512 + col) = pack8(f);
    }
};
struct EpiResid {
    const float* x; const float* ctx; bf16_t* hbuf; const float* mod; int l; bool from_inputs;
    __device__ __forceinline__ void operator()(int row, int col, const float* v) const {
        bf16_t* h = hbuf + (size_t)row * 1024 + col;
        float b[8];
        if (from_inputs) {
            const float* bp = row < SEQ ? x + (size_t)row * 1024 + col : ctx + (size_t)(row - SEQ) * 1024 + col;
            const float4 b0 = *(const float4*)bp, b1 = *(const float4*)(bp + 4);
            b[0] = b0.x; b[1] = b0.y; b[2] = b0.z; b[3] = b0.w; b[4] = b1.x; b[5] = b1.y; b[6] = b1.z; b[7] = b1.w;
        } else unpack8(*(const uint4*)h, b);
        const float* mp = mod + ((l * 2 + (row >= SEQ ? 1 : 0)) * 6 + 2) * 1024 + col;
        const float4 m0 = *(const float4*)mp, m1 = *(const float4*)(mp + 4);
        const float o[8] = {b[0] + m0.x * v[0], b[1] + m0.y * v[1], b[2] + m0.z * v[2], b[3] + m0.w * v[3], b[4] + m1.x * v[4], b[5] + m1.y * v[5], b[6] + m1.z * v[6], b[7] + m1.w * v[7]};
        *(uint4*)h = pack8(o);
    }
};
struct EpiBf16 {
    bf16_t* dst; int ld;
    __device__ __forceinline__ void operator()(int row, int col, const float* v) const { *(uint4*)(dst + (size_t)row * ld + col) = pack8(v); }
};
struct EpiScore {
    unsigned short* dst; int coff;
    __device__ __forceinline__ void operator()(int row, int col, const float* v) const {
        typedef _Float16 h2 __attribute__((ext_vector_type(2)));
        u32x4 o;
#pragma unroll
        for (int e = 0; e < 4; ++e) { const h2 hv = {(_Float16)v[2 * e], (_Float16)v[2 * e + 1]}; o[e] = __builtin_bit_cast(unsigned, hv); }
        *(u32x4*)(dst + (size_t)row * 2048 + coff + col) = o;
    }
};
struct EpiOddIn {
    bf16_t* qkvr; bf16_t* z; float* ab;
    __device__ __forceinline__ void operator()(int row, int col, const float* v) const {
        if (col < 3072) *(uint4*)(qkvr + (size_t)row * 3072 + col) = pack8(v);
        else if (col < 4096) *(uint4*)(z + (size_t)row * 1024 + (col - 3072)) = pack8(v);
        else { float* d = ab + (size_t)row * 32 + (col - 4096); *(float4*)d = make_float4(v[0], v[1], v[2], v[3]); *(float4*)(d + 4) = make_float4(v[4], v[5], v[6], v[7]); }
    }
};

__device__ __forceinline__ void s5_scan(const Params& p) {
    const int gt = blockIdx.x * NTHREADS + tid_();
    if (gt >= 4096) return;
    const int di = gt >> 11, g = (gt >> 6) & 31, pp = gt & 63;
    const float2 a = ((const float2*)(p.ws + WS_A64))[(di * 32 + g) * 64 + pp];
    const float* lst = (const float*)(p.ws + WS_LST) + (size_t)g * NCH * 256 + di * 128 + pp;
    bf16_t* a5 = (bf16_t*)(p.ws + WS_A5) + (size_t)g * NCH * 256 + di * 128 + pp;
    float sr = 0.f, si = 0.f;
    for (int s0 = 0; s0 < NCH; s0 += 4) {
        int c[4]; float lr[4], li[4];
#pragma unroll
        for (int u = 0; u < 4; ++u) {
            const int s = s0 + u;
            c[u] = di == 0 ? (s < 4 ? NCH_LAT + s : s - 4) : (s < 4 ? NCH - 1 - s : NCH - 1 - s);
            lr[u] = lst[(size_t)c[u] * 256]; li[u] = lst[(size_t)c[u] * 256 + 64];
        }
#pragma unroll
        for (int u = 0; u < 4; ++u) {
            a5[(size_t)c[u] * 256] = f2bf(sr); a5[(size_t)c[u] * 256 + 64] = f2bf(si);
            const float nr = a.x * sr - a.y * si + lr[u], ni = a.x * si + a.y * sr + li[u]; sr = nr; si = ni;
        }
    }
}

__device__ __forceinline__ void even_conv_item(const Params& p, int item) {
    const bf16_t* pa = (const bf16_t*)(p.ws + WS_PA); bf16_t* cb = (bf16_t*)(p.ws + WS_CB);
    const float* cw = p.in[9];
    for (int t = tid_(); t < 64 * 64; t += NTHREADS) {
        const int row = item * 64 + (t >> 6), c0 = (t & 63) * 8;
        bool hasp, hasn;
        if (row < SEQ) { hasp = (row & 63) != 0; hasn = (row & 63) != 63; } else { hasp = row != SEQ; hasn = row != R - 1; }
        float m[3][8];
#pragma unroll
        for (int d = 0; d < 3; ++d) {
            const bool ok = d == 1 || (d == 0 ? hasp : hasn);
            if (ok) {
                const bf16_t* rp = pa + (size_t)(row + d - 1) * 1536 + c0;
                float u[8], gi[8]; unpack8(*(const uint4*)rp, u); unpack8(*(const uint4*)(rp + 512), gi);
#pragma unroll
                for (int e = 0; e < 8; ++e) m[d][e] = u[e] * gi[e];
            } else {
#pragma unroll
                for (int e = 0; e < 8; ++e) m[d][e] = 0.f;
            }
        }
        float go[8], f[8]; unpack8(*(const uint4*)(pa + (size_t)row * 1536 + 1024 + c0), go);
#pragma unroll
        for (int e = 0; e < 8; ++e) f[e] = go[e] * (m[0][e] * cw[c0 + e] + m[1][e] * cw[512 + c0 + e] + m[2][e] * cw[1024 + c0 + e]);
        *(uint4*)(cb + (size_t)row * 1024 + c0) = pack8(f);
    }
}

__device__ __forceinline__ unsigned ord_enc(float v) { const unsigned u = __float_as_uint(v); return (u & 0x80000000u) ? ~u : (u | 0x80000000u); }
__device__ __forceinline__ float ord_dec(unsigned e) { const unsigned u = (e & 0x80000000u) ? (e & 0x7FFFFFFFu) : ~e; return __uint_as_float(u); }
#define TOP_INSERT(key) { unsigned x_ = (key); _Pragma("unroll") for (int k_ = 0; k_ < 16; ++k_) { const unsigned hi_ = top[k_] > x_ ? top[k_] : x_; x_ = top[k_] > x_ ? x_ : top[k_]; top[k_] = hi_; } }
__device__ __forceinline__ void peer_route_item(const Params& p, int item, int nrows, unsigned char* lds) {
    const int tid = tid_();
    const int row = item * 64 + (tid >> 3), head = tid & 7;
    unsigned* sIdx = (unsigned*)lds;
    __syncthreads();
    if (row < nrows) {
        const unsigned short* sc = (const unsigned short*)(p.ws + WS_SC) + (size_t)row * 2048 + head * 256;
        float fa[16], fb[16];
        {
#define CE_DESC(a_, b_) { const unsigned hi_ = (a_) > (b_) ? (a_) : (b_); const unsigned lo_ = (a_) > (b_) ? (b_) : (a_); (a_) = hi_; (b_) = lo_; }
            unsigned topa[16], topb[16];
#pragma unroll 1
            for (int blk = 0; blk < 8; ++blk) {
                unsigned ka[16], kb[16];
#pragma unroll
                for (int c2 = 0; c2 < 2; ++c2) {
                    const int c = blk * 2 + c2;
                    const uint4 qa = *(const uint4*)(sc + c * 8), qb = *(const uint4*)(sc + 128 + c * 8);
                    const unsigned wa[4] = {qa.x, qa.y, qa.z, qa.w}, wb[4] = {qb.x, qb.y, qb.z, qb.w};
#pragma unroll
                    for (int e = 0; e < 8; ++e) {
                        const unsigned short ha = (unsigned short)((e & 1) ? (wa[e >> 1] >> 16) : (wa[e >> 1] & 0xFFFFu));
                        const unsigned short hb = (unsigned short)((e & 1) ? (wb[e >> 1] >> 16) : (wb[e >> 1] & 0xFFFFu));
                        ka[c2 * 8 + e] = (ord_enc((float)__builtin_bit_cast(_Float16, ha)) & ~0x7Fu) | (unsigned)(c * 8 + e);
                        kb[c2 * 8 + e] = (ord_enc((float)__builtin_bit_cast(_Float16, hb)) & ~0x7Fu) | (unsigned)(c * 8 + e);
                    }
                }
#pragma unroll
                for (int k = 2; k <= 16; k <<= 1) {
#pragma unroll
                    for (int j = k >> 1; j > 0; j >>= 1) {
#pragma unroll
                        for (int i = 0; i < 16; ++i) {
                            const int l2 = i ^ j;
                            if (l2 > i) {
                                if ((i & k) == 0) { CE_DESC(ka[i], ka[l2]); CE_DESC(kb[i], kb[l2]); }
                                else { CE_DESC(ka[l2], ka[i]); CE_DESC(kb[l2], kb[i]); }
                            }
                        }
                    }
                }
                if (blk == 0) {
#pragma unroll
                    for (int i = 0; i < 16; ++i) { topa[i] = ka[i]; topb[i] = kb[i]; }
                } else {
#pragma unroll
                    for (int i = 0; i < 16; ++i) { topa[i] = topa[i] > ka[15 - i] ? topa[i] : ka[15 - i]; topb[i] = topb[i] > kb[15 - i] ? topb[i] : kb[15 - i]; }
#pragma unroll
                    for (int j = 8; j > 0; j >>= 1) {
#pragma unroll
                        for (int i = 0; i < 16; ++i) { const int l2 = i ^ j; if (l2 > i) { CE_DESC(topa[i], topa[l2]); CE_DESC(topb[i], topb[l2]); } }
                    }
                }
            }
#undef CE_DESC
#pragma unroll
            for (int k = 0; k < 16; ++k) {
                sIdx[k * NTHREADS + tid] = topa[k] & 0x7Fu; sIdx[(16 + k) * NTHREADS + tid] = topb[k] & 0x7Fu;
                fa[k] = ord_dec(topa[k] & ~0x7Fu); fb[k] = ord_dec(topb[k] & ~0x7Fu);
            }
        }
        unsigned top[16];
#pragma unroll
        for (int k = 0; k < 16; ++k) top[k] = 0u;
#pragma unroll
        for (int i = 0; i < 16; ++i) {
#pragma unroll
            for (int j = 0; j < 16; ++j) {
                if ((i + 1) * (j + 1) <= 16) { TOP_INSERT((ord_enc(fa[i] + fb[j]) & ~0xFFu) | (unsigned)(i * 16 + j)); }
            }
        }
        float ev[16]; float m = ord_dec(top[0] & ~0xFFu), sum = 0.f;
        int* idxo = (int*)(p.ws + WS_IDX) + (size_t)row * 128 + head * 16;
        float* go = (float*)(p.ws + WS_GATE) + (size_t)row * 128 + head * 16;
#pragma unroll
        for (int k = 0; k < 16; ++k) { ev[k] = __expf(ord_dec(top[k] & ~0xFFu) - m); sum += ev[k]; }
        const float inv = 1.f / sum;
#pragma unroll
        for (int k = 0; k < 16; ++k) {
            const unsigned pos = top[k] & 0xFFu;
            const unsigned ia = sIdx[(pos >> 4) * NTHREADS + tid], ib = sIdx[(16 + (pos & 15)) * NTHREADS + tid];
            idxo[k] = (int)(ia * 128u + ib); go[k] = ev[k] * inv;
        }
    }
}

__device__ __forceinline__ void peer_gather_experts(const Params& p, int row, int h_beg, int h_end, int e_beg, int e_end, float (&y)[16]) {
    const int lane = tid_() & 63;
    const bf16_t* xr = (const bf16_t*)(p.ws + WS_ACT) + (size_t)row * 1024 + lane * 16;
    const unsigned char* PE = p.ws + WS_PUV + lane * 24;
    const float* psc = (const float*)(p.ws + WS_PSC);
    float x[16];
    unpack8(*(const uint4*)xr, x); unpack8(*(const uint4*)(xr + 8), x + 8);
    const int* idxp = (const int*)(p.ws + WS_IDX) + (size_t)row * 128; const float* gp = (const float*)(p.ws + WS_GATE) + (size_t)row * 128;
#pragma unroll 1
    for (int half = h_beg; half < h_end; ++half) {
        const int myidx = idxp[half * 64 + lane];
        const float myus = psc[myidx], mygv = gp[half * 64 + lane] * psc[16384 + myidx];
        U6 ea[4], eb[4];
#define PG_LOAD(arr, e0_) do { _Pragma("unroll") for (int u_ = 0; u_ < 4; ++u_) { const int id_ = __builtin_amdgcn_readlane(myidx, (e0_) + u_); arr[u_] = *(const U6*)(PE + (size_t)id_ * PREC); } } while (0)
#define PG_PROC(arr, e0_) do { _Pragma("unroll") for (int u_ = 0; u_ < 4; ++u_) { \
            const v6u_t pk_ = {arr[u_].a, arr[u_].b, arr[u_].c, arr[u_].d, arr[u_].e, arr[u_].f}; \
            const v32f_t f_ = __builtin_amdgcn_cvt_scalef32_pk32_f32_fp6(pk_, 1.0f); \
            f32x2_t a2_ = {0.f, 0.f}; \
            _Pragma("unroll") for (int e_ = 0; e_ < 16; e_ += 2) { const f32x2_t fv_ = {f_[e_], f_[e_ + 1]}; const f32x2_t xv_ = {x[e_], x[e_ + 1]}; a2_ = __builtin_elementwise_fma(fv_, xv_, a2_); } \
            const float dsum_ = wave_sum_dpp(a2_.x + a2_.y); \
            const float us_ = __int_as_float(__builtin_amdgcn_readlane(__float_as_int(myus), (e0_) + u_)); \
            const float gv_ = __int_as_float(__builtin_amdgcn_readlane(__float_as_int(mygv), (e0_) + u_)); \
            const float coef_ = gelu_fast(dsum_ * us_) * gv_; \
            _Pragma("unroll") for (int e_ = 0; e_ < 16; e_ += 2) { const f32x2_t fv_ = {f_[16 + e_], f_[17 + e_]}; const f32x2_t cv_ = {coef_, coef_}; f32x2_t yv_ = {y[e_], y[e_ + 1]}; \
                yv_ = __builtin_elementwise_fma(cv_, fv_, yv_); y[e_] = yv_.x; y[e_ + 1] = yv_.y; } \
            if (u_ & 1) __builtin_amdgcn_sched_barrier(0); } } while (0)
        PG_LOAD(ea, e_beg);
#pragma unroll 1
        for (int e0 = e_beg; e0 < e_end; e0 += 8) {
            PG_LOAD(eb, e0 + 4);
            PG_PROC(ea, e0);
            if (e0 + 8 < e_end) PG_LOAD(ea, e0 + 8);
            PG_PROC(eb, e0 + 4);
        }
#undef PG_LOAD
#undef PG_PROC
    }
}
__device__ __forceinline__ void peer_gather_finish(const Params& p, int row, int l, bool last, const float (&y)[16]) {
    const int lane = tid_() & 63;
    bf16_t* h = (bf16_t*)(p.ws + WS_H) + (size_t)row * 1024 + lane * 16;
    const float* m5 = modp(p, l, row, 5) + lane * 16;
    float hv[16];
    unpack8(*(const uint4*)h, hv); unpack8(*(const uint4*)(h + 8), hv + 8);
#pragma unroll
    for (int q = 0; q < 4; ++q) {
        const float4 g0 = *(const float4*)(m5 + q * 4);
        hv[q * 4 + 0] += g0.x * y[q * 4 + 0]; hv[q * 4 + 1] += g0.y * y[q * 4 + 1];
        hv[q * 4 + 2] += g0.z * y[q * 4 + 2]; hv[q * 4 + 3] += g0.w * y[q * 4 + 3];
    }
    if (!last) {
        *(uint4*)h = pack8(hv); *(uint4*)(h + 8) = pack8(hv + 8);
        float ss = 0.f;
#pragma unroll
        for (int e = 0; e < 16; ++e) ss += hv[e] * hv[e];
        ss = wave_sum(ss);
        const float rs = rsqrtf(ss * (1.f / 1024.f) + 1e-6f);
        const float* g1 = p.in[6] + (l + 1) * 1024 + lane * 16; const float* sh = modp(p, l + 1, row, 0) + lane * 16; const float* sc = modp(p, l + 1, row, 1) + lane * 16;
        float o[16];
#pragma unroll
        for (int q = 0; q < 4; ++q) {
            const float4 gg = *(const float4*)(g1 + q * 4), s4 = *(const float4*)(sh + q * 4), c4 = *(const float4*)(sc + q * 4);
            o[q * 4 + 0] = hv[q * 4 + 0] * rs * gg.x * (1.f + c4.x) + s4.x; o[q * 4 + 1] = hv[q * 4 + 1] * rs * gg.y * (1.f + c4.y) + s4.y;
            o[q * 4 + 2] = hv[q * 4 + 2] * rs * gg.z * (1.f + c4.z) + s4.z; o[q * 4 + 3] = hv[q * 4 + 3] * rs * gg.w * (1.f + c4.w) + s4.w;
        }
        bf16_t* act = (bf16_t*)(p.ws + WS_ACT) + (size_t)row * 1024 + lane * 16;
        *(uint4*)act = pack8(o); *(uint4*)(act + 8) = pack8(o + 8);
    } else {
        float ss = 0.f;
#pragma unroll
        for (int e = 0; e < 16; ++e) ss += hv[e] * hv[e];
        ss = wave_sum(ss);
        const float rs = rsqrtf(ss * (1.f / 1024.f) + 1e-6f);
        const float* fg = p.in[31] + lane * 16; float* o = p.out + (size_t)row * 1024 + lane * 16;
#pragma unroll
        for (int q = 0; q < 4; ++q) {
            const float4 g0 = *(const float4*)(fg + q * 4);
            *(float4*)(o + q * 4) = make_float4(hv[q * 4 + 0] * rs * g0.x, hv[q * 4 + 1] * rs * g0.y, hv[q * 4 + 2] * rs * g0.z, hv[q * 4 + 3] * rs * g0.w);
        }
    }
}

__device__ __forceinline__ void peer_gather_row(const Params& p, int row, int l, bool last) {
    float y[16];
#pragma unroll
    for (int e = 0; e < 16; ++e) y[e] = 0.f;
    peer_gather_experts(p, row, 0, 2, 0, 64, y);
    peer_gather_finish(p, row, l, last, y);
}
__device__ __forceinline__ void peer_gather_row_split(const Params& p, int row, int l, unsigned char* lds) {
    const int tid = tid_(), lane = tid & 63, wave = tid >> 6;
    float y[16];
#pragma unroll
    for (int e = 0; e < 16; ++e) y[e] = 0.f;
    peer_gather_experts(p, row, wave >> 2, (wave >> 2) + 1, 16 * (wave & 3), 16 * (wave & 3) + 16, y);
    float* part = (float*)lds;
    __syncthreads();
#pragma unroll
    for (int q = 0; q < 4; ++q) *(float4*)(part + wave * 1024 + lane * 16 + q * 4) = make_float4(y[q * 4 + 0], y[q * 4 + 1], y[q * 4 + 2], y[q * 4 + 3]);
    __syncthreads();
    if (wave == 0) {
#pragma unroll
        for (int w = 1; w < 8; ++w)
#pragma unroll
            for (int q = 0; q < 4; ++q) { const float4 v = *(const float4*)(part + w * 1024 + lane * 16 + q * 4); y[q * 4 + 0] += v.x; y[q * 4 + 1] += v.y; y[q * 4 + 2] += v.z; y[q * 4 + 3] += v.w; }
        peer_gather_finish(p, row, l, false, y);
    }
}

__device__ __forceinline__ void gdn_prep_item(const Params& p, int item) {
    const int tid = tid_();
    const int r0 = item * 16;
    if (tid < 384) {
        const int part = tid >> 7, ch = tid * 8;
        const bf16_t* src = (const bf16_t*)(p.ws + WS_QKVR) + ch;
        bf16_t* dst = (bf16_t*)(p.ws + (part == 0 ? WS_QN : part == 1 ? WS_KN : WS_VN)) + (ch & 1023);
        const float* cw = p.in[22] + ch;
        float w0[8], w1[8], w2[8];
#pragma unroll
        for (int e = 0; e < 8; ++e) { w0[e] = cw[e]; w1[e] = cw[3072 + e]; w2[e] = cw[6144 + e]; }
        bool hasp0, hasn15;
        if (r0 < SEQ) { hasp0 = (r0 & 63) != 0; hasn15 = ((r0 + 15) & 63) != 63; } else { hasp0 = r0 != SEQ; hasn15 = (r0 + 15) != R - 1; }
        u32x4 rw[18];
#pragma unroll
        for (int i = 0; i < 18; ++i) {
            const bool ok = (i == 0) ? hasp0 : (i == 17) ? hasn15 : true;
            rw[i] = ok ? *(const u32x4*)(src + (size_t)(r0 + i - 1) * 3072) : (u32x4){0u, 0u, 0u, 0u};
        }
#pragma unroll
        for (int i = 0; i < 16; ++i) {
            const u32x4 a = rw[i], bq = rw[i + 1], cq = rw[i + 2];
            const float xm[8] = {lo2f(a.x), hi2f(a.x), lo2f(a.y), hi2f(a.y), lo2f(a.z), hi2f(a.z), lo2f(a.w), hi2f(a.w)};
            const float x0[8] = {lo2f(bq.x), hi2f(bq.x), lo2f(bq.y), hi2f(bq.y), lo2f(bq.z), hi2f(bq.z), lo2f(bq.w), hi2f(bq.w)};
            const float xp[8] = {lo2f(cq.x), hi2f(cq.x), lo2f(cq.y), hi2f(cq.y), lo2f(cq.z), hi2f(cq.z), lo2f(cq.w), hi2f(cq.w)};
            float f[8], ss = 0.f;
#pragma unroll
            for (int e = 0; e < 8; ++e) { const float v = siluf_(xm[e] * w0[e] + x0[e] * w1[e] + xp[e] * w2[e]); f[e] = v; ss += v * v; }
            if (part < 2) {
                ss += __shfl_xor(ss, 1, 64); ss += __shfl_xor(ss, 2, 64); ss += __shfl_xor(ss, 4, 64); ss += __shfl_xor(ss, 8, 64);
                const float sc = rsqrtf(ss + 1e-6f) * (part == 0 ? 0.08838834764831845f : 1.f);
#pragma unroll
                for (int e = 0; e < 8; ++e) f[e] *= sc;
            }
            if (part == 0) {
                const uint4 pk = pack8(f);
                const int cl = ch & 127, blk = cl & ~31, pc = (cl & 31) >> 2;
                bf16_t* d0 = dst - cl + blk + 8 * (pc & 3) + 4 * (pc >> 2) + (size_t)(r0 + i) * 1024;
                bf16_t* d1 = dst - cl + blk + 8 * ((pc + 1) & 3) + 4 * ((pc + 1) >> 2) + (size_t)(r0 + i) * 1024;
                *(uint2*)d0 = make_uint2(pk.x, pk.y); *(uint2*)d1 = make_uint2(pk.z, pk.w);
            } else *(uint4*)(dst + (size_t)(r0 + i) * 1024) = pack8(f);
        }
    } else if (tid < 384 + 64) {
        const int l = tid - 384;
#pragma unroll
        for (int q = 0; q < 4; ++q) {
            const int v = l * 4 + q, i = v >> 4, dh = v & 15, row = r0 + i;
            const float* ab = (const float*)(p.ws + WS_AB) + (size_t)row * 32;
            const float a = ab[dh] + p.in[24][dh], b = ab[16 + dh];
            const float sp = a > 20.f ? a : log1pf(__expf(a));
            ((float*)(p.ws + WS_GG))[(size_t)dh * R + row] = -__expf(p.in[23][dh]) * sp;
            ((float*)(p.ws + WS_BETA))[(size_t)dh * R + row] = sigmoidf_(b);
        }
    }
}

constexpr int GU_LDQ = 136, GU_LDT = 72, GU_LDA = 68;
constexpr int GU_SQ = 0, GU_SK = 17408, GU_SKB = 34816, GU_SVBT = 52224, GU_SKGT = 70656, GU_SA = 89088, GU_SAT = 106496, GU_ST = 123904, GU_SG = 133120;
__device__ __forceinline__ int perm_slot64(int pos) { return 32 * (pos >> 5) + 8 * ((pos >> 2) & 3) + 4 * ((pos >> 4) & 1) + (pos & 3); }
struct GuPre { u32x4 q[2], k[2], v[2]; float g, beta; };
__device__ __forceinline__ void gu_prefetch(const Params& p, int u, GuPre& pre) {
    const int tid = tid_(), lane = tid & 63;
    const int dh = u / NCH, c = u % NCH, dir = dh >> 3, head = dh & 7;
#pragma unroll
    for (int q = 0; q < 2; ++q) {
        const int t = tid + q * NTHREADS, i = t >> 4, d8 = (t & 15) * 8;
        const size_t ro = (size_t)(c * 64 + (dir ? 63 - i : i)) * 1024 + head * 128 + d8;
        pre.q[q] = *(const u32x4*)((const bf16_t*)(p.ws + WS_QN) + ro);
        pre.k[q] = *(const u32x4*)((const bf16_t*)(p.ws + WS_KN) + ro);
        pre.v[q] = *(const u32x4*)((const bf16_t*)(p.ws + WS_VN) + ro);
    }
    const int row = c * 64 + (dir ? 63 - lane : lane);
    pre.g = ((const float*)(p.ws + WS_GG))[(size_t)dh * R + row];
    pre.beta = ((const float*)(p.ws + WS_BETA))[(size_t)dh * R + row];
}
__device__ __forceinline__ void gdn_unit(const Params& p, int u, int u_next, GuPre& pre, unsigned char* lds) {
    const int tid = tid_(), lane = tid & 63, wave = tid >> 6;
    const int dh = u / NCH, c = u % NCH, dir = dh >> 3, head = dh & 7;
    bf16_t* sQ = (bf16_t*)(lds + GU_SQ); bf16_t* sK = (bf16_t*)(lds + GU_SK); bf16_t* sKB = (bf16_t*)(lds + GU_SKB);
    bf16_t* sVBT = (bf16_t*)(lds + GU_SVBT); bf16_t* sKGT = (bf16_t*)(lds + GU_SKGT);
    float* sA = (float*)(lds + GU_SA); float* sAT = (float*)(lds + GU_SAT); bf16_t* sT = (bf16_t*)(lds + GU_ST);
    float* sG = (float*)(lds + GU_SG); float* sBeta = sG + 64;
    __syncthreads();
    if (wave == 0) {
        float g = pre.g;
#pragma unroll
        for (int o = 1; o < 64; o <<= 1) { const float t = __shfl_up(g, o, 64); if (lane >= o) g += t; }
        sG[lane] = g; sBeta[lane] = pre.beta;
        ((float*)(p.ws + WS_GC))[(size_t)u * 64 + lane] = g;
    }
    __syncthreads();
#pragma unroll
    for (int qq = 0; qq < 2; ++qq) {
        const int t = tid + qq * NTHREADS, i = t >> 4, d8 = (t & 15) * 8;
        const u32x4 q = pre.q[qq], k = pre.k[qq], v = pre.v[qq];
        const float beta = sBeta[i], eg = __expf(sG[i]);
        const float kf[8] = {lo2f(k.x), hi2f(k.x), lo2f(k.y), hi2f(k.y), lo2f(k.z), hi2f(k.z), lo2f(k.w), hi2f(k.w)};
        const float vf[8] = {lo2f(v.x), hi2f(v.x), lo2f(v.y), hi2f(v.y), lo2f(v.z), hi2f(v.z), lo2f(v.w), hi2f(v.w)};
        float kb[8];
#pragma unroll
        for (int e = 0; e < 8; ++e) kb[e] = kf[e] * beta;
        const u32x4 kbp = {pack2(kb[0], kb[1]), pack2(kb[2], kb[3]), pack2(kb[4], kb[5]), pack2(kb[6], kb[7])};
        {
            const int blk = d8 & ~31, qp = (d8 & 31) >> 3;
            *(u32x2*)(sQ + i * GU_LDQ + blk + 4 * qp) = (u32x2){q.x, q.y}; *(u32x2*)(sQ + i * GU_LDQ + blk + 16 + 4 * qp) = (u32x2){q.z, q.w};
        }
        *(u32x4*)(sK + i * GU_LDQ + d8) = k; *(u32x4*)(sKB + i * GU_LDQ + d8) = kbp;
        const int isw = i ^ (((d8 >> 3) & 7) << 3);
#pragma unroll
        for (int e = 0; e < 8; ++e) { sVBT[(d8 + e) * GU_LDT + isw] = f2bf(vf[e] * beta); sKGT[(d8 + e) * GU_LDT + isw] = f2bf(kb[e] * eg); }
    }
    if (u_next < NUNITS) gu_prefetch(p, u_next, pre);
    __syncthreads();
    {
        const int mat = wave >> 2, mt = wave & 3, rr = lane & 15, q4 = lane >> 4;
        const bf16_t* sX = mat ? sQ : sKB;
        f32x4 acc[4];
#pragma unroll
        for (int nt = 0; nt < 4; ++nt) acc[nt] = (f32x4){0.f, 0.f, 0.f, 0.f};
#pragma unroll
        for (int kk = 0; kk < 4; ++kk) {
            const bf16x8 a = *(const bf16x8*)(sX + (16 * mt + rr) * GU_LDQ + kk * 32 + 8 * q4);
#pragma unroll
            for (int nt = 0; nt < 4; ++nt) {
                const bf16x8 b = *(const bf16x8*)(sK + (16 * nt + rr) * GU_LDQ + kk * 32 + 8 * q4);
                acc[nt] = __builtin_amdgcn_mfma_f32_16x16x32_bf16(a, b, acc[nt], 0, 0, 0);
            }
        }
        float* dstm = mat ? sAT : sA;
#pragma unroll
        for (int nt = 0; nt < 4; ++nt) {
            const int j = 16 * nt + rr; const float gj = sG[j];
#pragma unroll
            for (int jj = 0; jj < 4; ++jj) {
                const int i = 16 * mt + 4 * q4 + jj;
                const bool keep = mat ? (j <= i) : (j < i);
                dstm[i * GU_LDA + j] = keep ? acc[nt][jj] * __expf(sG[i] - gj) : 0.f;
            }
        }
    }
    __syncthreads();
    float* sD = (float*)(lds + GU_SQ);
    if (wave < 4) {
        if (lane < 16) {
            float d[16];
#pragma unroll
            for (int i = 0; i < 16; ++i) {
                float a = (i == lane) ? 1.f : 0.f;
                const float* Ai = sA + (16 * wave + i) * GU_LDA + 16 * wave;
#pragma unroll
                for (int j = 0; j < i; ++j) a -= Ai[j] * d[j];
                d[i] = a;
                sD[(wave * 16 + i) * 16 + lane] = a;
            }
        }
    } else {
        bf16_t* att = (bf16_t*)(p.ws + WS_ATT) + (size_t)u * 64 * 64;
        for (int t = tid - 256; t < 512; t += 256) {
            const int i = t >> 3, kk2 = (t >> 2) & 1, qq = t & 3;
            const float4 lo = *(const float4*)(sAT + i * GU_LDA + 32 * kk2 + 4 * qq), hi = *(const float4*)(sAT + i * GU_LDA + 32 * kk2 + 16 + 4 * qq);
            uint4 o; o.x = pack2(lo.x, lo.y); o.y = pack2(lo.z, lo.w); o.z = pack2(hi.x, hi.y); o.w = pack2(hi.z, hi.w);
            *(uint4*)(att + i * 64 + 32 * kk2 + 8 * qq) = o;
        }
    }
    __syncthreads();
    if (wave < 4) {
        const int rr = lane & 15, q4 = lane >> 4;
        f32x4 Tt[4];
#pragma unroll
        for (int m = 0; m < 4; ++m) Tt[m] = (f32x4){0.f, 0.f, 0.f, 0.f};
#pragma unroll
        for (int b = 0; b < 4; ++b) {
            if (b >= wave) {
                f32x4 X = (f32x4){0.f, 0.f, 0.f, 0.f};
#pragma unroll
                for (int kk = 0; kk < 2; ++kk) {
                    if (2 * kk < b) {
                        const float* Ar = sA + (16 * b + rr) * GU_LDA + 32 * kk + 4 * q4;
                        const float4 lo = *(const float4*)Ar;
                        float4 hi = make_float4(0.f, 0.f, 0.f, 0.f);
                        if (2 * kk + 1 < b) hi = *(const float4*)(Ar + 16);
                        const u32x4 ap = {pack2(lo.x, lo.y), pack2(lo.z, lo.w), pack2(hi.x, hi.y), pack2(hi.z, hi.w)};
                        const u32x4 bp = {pack2(Tt[2 * kk][0], Tt[2 * kk][1]), pack2(Tt[2 * kk][2], Tt[2 * kk][3]),
                                          pack2(Tt[2 * kk + 1][0], Tt[2 * kk + 1][1]), pack2(Tt[2 * kk + 1][2], Tt[2 * kk + 1][3])};
                        X = __builtin_amdgcn_mfma_f32_16x16x32_bf16(__builtin_bit_cast(bf16x8, ap), __builtin_bit_cast(bf16x8, bp), X, 0, 0, 0);
                    }
                }
                float y[4];
#pragma unroll
                for (int jj = 0; jj < 4; ++jj) y[jj] = ((b == wave && 4 * q4 + jj == rr) ? 1.f : 0.f) - X[jj];
                const float4 dv4 = *(const float4*)(sD + (b * 16 + rr) * 16 + 4 * q4);
                const u32x4 ap = {pack2(dv4.x, dv4.y), pack2(dv4.z, dv4.w), 0u, 0u};
                const u32x4 bp = {pack2(y[0], y[1]), pack2(y[2], y[3]), 0u, 0u};
                const f32x4 z4 = (f32x4){0.f, 0.f, 0.f, 0.f};
                Tt[b] = __builtin_amdgcn_mfma_f32_16x16x32_bf16(__builtin_bit_cast(bf16x8, ap), __builtin_bit_cast(bf16x8, bp), z4, 0, 0, 0);
            }
#pragma unroll
            for (int jj = 0; jj < 4; ++jj) sT[(16 * b + 4 * q4 + jj) * GU_LDT + 16 * wave + rr] = f2bf(Tt[b][jj]);
        }
    }
    __syncthreads();
    {
        const int rr = lane & 15, q4 = lane >> 4;
        bf16_t* ut = (bf16_t*)(p.ws + WS_UT) + (size_t)u * 128 * 64;
        bf16_t* wg = (bf16_t*)(p.ws + WS_W) + (size_t)u * 64 * 128;
        f32x4 au[4], aw[4];
#pragma unroll
        for (int m = 0; m < 4; ++m) { au[m] = (f32x4){0.f, 0.f, 0.f, 0.f}; aw[m] = (f32x4){0.f, 0.f, 0.f, 0.f}; }
#pragma unroll
        for (int kk2 = 0; kk2 < 2; ++kk2) {
            const int tsw = (kk2 * 32 + 8 * q4) ^ ((((16 * wave + rr) >> 3) & 7) << 3);
            const bf16x8 bv = *(const bf16x8*)(sVBT + (16 * wave + rr) * GU_LDT + tsw);
            const bf16x8 ak = *(const bf16x8*)(sKGT + (16 * wave + rr) * GU_LDT + tsw);
#pragma unroll
            for (int m = 0; m < 4; ++m) {
                const bf16x8 tf = *(const bf16x8*)(sT + (16 * m + rr) * GU_LDT + kk2 * 32 + 8 * q4);
                au[m] = __builtin_amdgcn_mfma_f32_16x16x32_bf16(tf, bv, au[m], 0, 0, 0);
                aw[m] = __builtin_amdgcn_mfma_f32_16x16x32_bf16(ak, tf, aw[m], 0, 0, 0);
            }
        }
#pragma unroll
        for (int m = 0; m < 4; ++m) {
            uint2 o; o.x = pack2(au[m][0], au[m][1]); o.y = pack2(au[m][2], au[m][3]);
            *(uint2*)(ut + (size_t)(16 * wave + rr) * 64 + 16 * q4 + 4 * m) = o;
            uint2 w2; w2.x = pack2(aw[m][0], aw[m][1]); w2.y = pack2(aw[m][2], aw[m][3]);
            *(uint2*)(wg + (size_t)(16 * m + rr) * 128 + 32 * (wave >> 1) + 8 * q4 + 4 * (wave & 1)) = w2;
        }
    }
}

constexpr int GS_SW = 0, GS_SQD = 17408, GS_SKDT = 34816, GS_SATT = 53248, GS_BUF = 62464, GS_OT = 64 * 136 * 2;
__device__ __forceinline__ int gdn_chain_chunk(int dir, int s) { return dir == 0 ? (s < 4 ? NCH_LAT + s : s - 4) : NCH - 1 - s; }
struct GsG1 { u32x4 w[2]; u32x4 att; };
struct GsG2 { u32x2 qlo[2], qhi[2]; float gq[2]; };
struct GsG3 { u32x4 kd[2]; float gk[2]; float gl; u32x2 ut[4]; };
__device__ __forceinline__ void gs_load1(const Params& p, int dh, int c, GsG1& st) {
    const int tid = tid_(); const size_t u = (size_t)dh * NCH + c;
    const bf16_t* wg = (const bf16_t*)(p.ws + WS_W) + u * 64 * 128; const bf16_t* att = (const bf16_t*)(p.ws + WS_ATT) + u * 64 * 64;
#pragma unroll
    for (int q = 0; q < 2; ++q) { const int t = tid + q * NTHREADS; st.w[q] = *(const u32x4*)(wg + (size_t)(t >> 4) * 128 + (t & 15) * 8); }
    st.att = *(const u32x4*)(att + (size_t)(tid >> 3) * 64 + (tid & 7) * 8);
}
__device__ __forceinline__ void gs_store1(const GsG1& st, unsigned char* buf) {
    const int tid = tid_(); bf16_t* sW = (bf16_t*)(buf + GS_SW); bf16_t* sATT = (bf16_t*)(buf + GS_SATT);
#pragma unroll
    for (int q = 0; q < 2; ++q) { const int t = tid + q * NTHREADS; *(u32x4*)(sW + (t >> 4) * GU_LDQ + (t & 15) * 8) = st.w[q]; }
    *(u32x4*)(sATT + (tid >> 3) * GU_LDT + (tid & 7) * 8) = st.att;
}
__device__ __forceinline__ void gs_load2(const Params& p, int dh, int c, GsG2& st) {
    const int tid = tid_(), dir = dh >> 3, head = dh & 7; const size_t u = (size_t)dh * NCH + c;
    const float* gc = (const float*)(p.ws + WS_GC) + u * 64; const bf16_t* qn = (const bf16_t*)(p.ws + WS_QN);
#pragma unroll
    for (int q = 0; q < 2; ++q) {
        const int t = tid + q * NTHREADS, i = t >> 4, kk = (t >> 2) & 3, qq = t & 3;
        const bf16_t* src = qn + (size_t)(c * 64 + (dir ? 63 - i : i)) * 1024 + head * 128 + 32 * kk + 8 * qq;
        st.qlo[q] = *(const u32x2*)src; st.qhi[q] = *(const u32x2*)(src + 4); st.gq[q] = gc[i];
    }
}
__device__ __forceinline__ void gs_store2(const GsG2& st, unsigned char* buf) {
    const int tid = tid_(); bf16_t* sQD = (bf16_t*)(buf + GS_SQD);
#pragma unroll
    for (int q = 0; q < 2; ++q) {
        const int t = tid + q * NTHREADS, i = t >> 4, kk = (t >> 2) & 3, qq = t & 3; const float e = __expf(st.gq[q]);
        u32x4 o; o.x = pack2(lo2f(st.qlo[q].x) * e, hi2f(st.qlo[q].x) * e); o.y = pack2(lo2f(st.qlo[q].y) * e, hi2f(st.qlo[q].y) * e);
        o.z = pack2(lo2f(st.qhi[q].x) * e, hi2f(st.qhi[q].x) * e); o.w = pack2(lo2f(st.qhi[q].y) * e, hi2f(st.qhi[q].y) * e);
        *(u32x4*)(sQD + i * GU_LDQ + 32 * kk + 8 * qq) = o;
    }
}
__device__ __forceinline__ void gs_load3(const Params& p, int dh, int c, GsG3& st) {
    const int tid = tid_(), lane = tid & 63, wave = tid >> 6, dir = dh >> 3, head = dh & 7; const size_t u = (size_t)dh * NCH + c;
    const float* gc = (const float*)(p.ws + WS_GC) + u * 64; const bf16_t* kn = (const bf16_t*)(p.ws + WS_KN);
    st.gl = gc[63];
#pragma unroll
    for (int q = 0; q < 2; ++q) {
        const int t = tid + q * NTHREADS, pos = t >> 4, d8 = (t & 15) * 8;
        st.kd[q] = *(const u32x4*)(kn + (size_t)(c * 64 + (dir ? 63 - pos : pos)) * 1024 + head * 128 + d8); st.gk[q] = gc[pos];
    }
    const bf16_t* ut = (const bf16_t*)(p.ws + WS_UT) + u * 128 * 64 + (size_t)(16 * wave + (lane & 15)) * 64 + 16 * (lane >> 4);
#pragma unroll
    for (int m = 0; m < 4; ++m) st.ut[m] = *(const u32x2*)(ut + 4 * m);
}
__device__ __forceinline__ void gs_store3(const GsG3& st, unsigned char* buf) {
    const int tid = tid_(); bf16_t* sKDT = (bf16_t*)(buf + GS_SKDT);
#pragma unroll
    for (int q = 0; q < 2; ++q) {
        const int t = tid + q * NTHREADS, pos = t >> 4, d8 = (t & 15) * 8; const float e = __expf(st.gl - st.gk[q]);
        const u32x4 kq = st.kd[q]; const int sl = perm_slot64(pos) ^ (((d8 >> 3) & 7) << 3);
        sKDT[(d8 + 0) * GU_LDT + sl] = f2bf(lo2f(kq.x) * e); sKDT[(d8 + 1) * GU_LDT + sl] = f2bf(hi2f(kq.x) * e);
        sKDT[(d8 + 2) * GU_LDT + sl] = f2bf(lo2f(kq.y) * e); sKDT[(d8 + 3) * GU_LDT + sl] = f2bf(hi2f(kq.y) * e);
        sKDT[(d8 + 4) * GU_LDT + sl] = f2bf(lo2f(kq.z) * e); sKDT[(d8 + 5) * GU_LDT + sl] = f2bf(hi2f(kq.z) * e);
        sKDT[(d8 + 6) * GU_LDT + sl] = f2bf(lo2f(kq.w) * e); sKDT[(d8 + 7) * GU_LDT + sl] = f2bf(hi2f(kq.w) * e);
    }
}
template <bool first>
__device__ __forceinline__ void gdn_seg_ab(const Params& p, int dh, int k, unsigned char* lds) {
    const int tid = tid_(), lane = tid & 63, wave = tid >> 6, rr = lane & 15, q4 = lane >> 4, dir = dh >> 3;
    const int s_begin = first ? 0 : 4 + 16 * k, nsteps = first ? 20 : 16;
    f32x4 ScB[8], ScA[8]; bf16x8 SbB[4], SbA[4];
#pragma unroll
    for (int m = 0; m < 8; ++m) {
        ScB[m] = (f32x4){0.f, 0.f, 0.f, 0.f};
#pragma unroll
        for (int jj = 0; jj < 4; ++jj) ScA[m][jj] = (16 * m + 4 * q4 + jj == 16 * wave + rr) ? 1.f : 0.f;
    }
#pragma unroll
    for (int kk = 0; kk < 4; ++kk) {
        SbB[kk] = (bf16x8){0, 0, 0, 0, 0, 0, 0, 0};
        const u32x4 pk = {pack2(ScA[2 * kk][0], ScA[2 * kk][1]), pack2(ScA[2 * kk][2], ScA[2 * kk][3]),
                          pack2(ScA[2 * kk + 1][0], ScA[2 * kk + 1][1]), pack2(ScA[2 * kk + 1][2], ScA[2 * kk + 1][3])};
        SbA[kk] = __builtin_bit_cast(bf16x8, pk);
    }
    u32x2 ucur[4]; float glcur;
    float4* sin_img = (float4*)(p.ws + WS_SIN) + (size_t)(dh * 16) * 4096;
    __syncthreads();
    {
        const int c0 = gdn_chain_chunk(dir, s_begin);
        GsG1 g1; gs_load1(p, dh, c0, g1); gs_store1(g1, lds);
        GsG3 g3; gs_load3(p, dh, c0, g3); gs_store3(g3, lds);
#pragma unroll
        for (int m = 0; m < 4; ++m) ucur[m] = g3.ut[m];
        glcur = g3.gl;
    }
    __syncthreads();
#pragma unroll 1
    for (int t = 0; t < nsteps; ++t) {
        const int s = s_begin + t;
        const int cn = gdn_chain_chunk(dir, t + 1 < nsteps ? s + 1 : s);
        const unsigned char* buf = lds + (t & 1) * GS_BUF; unsigned char* nbuf = lds + ((t + 1) & 1) * GS_BUF;
        const bf16_t* sW = (const bf16_t*)(buf + GS_SW); const bf16_t* sKDT = (const bf16_t*)(buf + GS_SKDT);
        GsG1 g1; gs_load1(p, dh, cn, g1);
        GsG3 g3; gs_load3(p, dh, cn, g3);
        f32x4 vb_[4], va_[4];
#pragma unroll
        for (int m = 0; m < 4; ++m) {
            f32x4 accb = (f32x4){0.f, 0.f, 0.f, 0.f}, acca = (f32x4){0.f, 0.f, 0.f, 0.f};
#pragma unroll
            for (int kk = 0; kk < 4; ++kk) {
                const bf16x8 a = *(const bf16x8*)(sW + (16 * m + rr) * GU_LDQ + kk * 32 + 8 * q4);
                accb = __builtin_amdgcn_mfma_f32_16x16x32_bf16(a, SbB[kk], accb, 0, 0, 0);
                if (!first) acca = __builtin_amdgcn_mfma_f32_16x16x32_bf16(a, SbA[kk], acca, 0, 0, 0);
            }
            vb_[m][0] = lo2f(ucur[m].x) - accb[0]; vb_[m][1] = hi2f(ucur[m].x) - accb[1]; vb_[m][2] = lo2f(ucur[m].y) - accb[2]; vb_[m][3] = hi2f(ucur[m].y) - accb[3];
            va_[m] = -acca;
        }
        bf16x8 VBb[2], VBa[2];
#pragma unroll
        for (int k2 = 0; k2 < 2; ++k2) {
            const u32x4 pb = {pack2(vb_[2 * k2][0], vb_[2 * k2][1]), pack2(vb_[2 * k2][2], vb_[2 * k2][3]), pack2(vb_[2 * k2 + 1][0], vb_[2 * k2 + 1][1]), pack2(vb_[2 * k2 + 1][2], vb_[2 * k2 + 1][3])};
            const u32x4 pa = {pack2(va_[2 * k2][0], va_[2 * k2][1]), pack2(va_[2 * k2][2], va_[2 * k2][3]), pack2(va_[2 * k2 + 1][0], va_[2 * k2 + 1][1]), pack2(va_[2 * k2 + 1][2], va_[2 * k2 + 1][3])};
            VBb[k2] = __builtin_bit_cast(bf16x8, pb); VBa[k2] = __builtin_bit_cast(bf16x8, pa);
        }
        const float egl = __expf(glcur);
#pragma unroll
        for (int m = 0; m < 8; ++m) {
            f32x4 accb = ScB[m] * egl, acca = ScA[m] * egl;
#pragma unroll
            for (int k2 = 0; k2 < 2; ++k2) {
                const bf16x8 a = *(const bf16x8*)(sKDT + (16 * m + rr) * GU_LDT + ((k2 * 32 + 8 * q4) ^ ((((16 * m + rr) >> 3) & 7) << 3)));
                accb = __builtin_amdgcn_mfma_f32_16x16x32_bf16(a, VBb[k2], accb, 0, 0, 0);
                if (!first) acca = __builtin_amdgcn_mfma_f32_16x16x32_bf16(a, VBa[k2], acca, 0, 0, 0);
            }
            ScB[m] = accb; ScA[m] = acca;
        }
#pragma unroll
        for (int kk = 0; kk < 4; ++kk) {
            const u32x4 pb = {pack2(ScB[2 * kk][0], ScB[2 * kk][1]), pack2(ScB[2 * kk][2], ScB[2 * kk][3]), pack2(ScB[2 * kk + 1][0], ScB[2 * kk + 1][1]), pack2(ScB[2 * kk + 1][2], ScB[2 * kk + 1][3])};
            const u32x4 pa = {pack2(ScA[2 * kk][0], ScA[2 * kk][1]), pack2(ScA[2 * kk][2], ScA[2 * kk][3]), pack2(ScA[2 * kk + 1][0], ScA[2 * kk + 1][1]), pack2(ScA[2 * kk + 1][2], ScA[2 * kk + 1][3])};
            SbB[kk] = __builtin_bit_cast(bf16x8, pb); SbA[kk] = __builtin_bit_cast(bf16x8, pa);
        }
        gs_store1(g1, nbuf); gs_store3(g3, nbuf);
#pragma unroll
        for (int m = 0; m < 4; ++m) ucur[m] = g3.ut[m];
        glcur = g3.gl;
        if (first && t == 3) {
#pragma unroll
            for (int m = 0; m < 8; ++m) sin_img[(wave * 8 + m) * 64 + lane] = make_float4(ScB[m][0], ScB[m][1], ScB[m][2], ScB[m][3]);
        }
        lds_barrier();
    }
    if (first) {
#pragma unroll
        for (int m = 0; m < 8; ++m) sin_img[4096 + (wave * 8 + m) * 64 + lane] = make_float4(ScB[m][0], ScB[m][1], ScB[m][2], ScB[m][3]);
    } else {
        float4* bimg = (float4*)(p.ws + WS_BSEG) + (size_t)(dh * 16 + k) * 4096;
        bf16_t* aseg = (bf16_t*)(p.ws + WS_ASEG) + (size_t)(dh * 16 + k) * 128 * 128;
        const int pc = perm_slot64(16 * wave + rr);
#pragma unroll
        for (int m = 0; m < 8; ++m) {
            bimg[(wave * 8 + m) * 64 + lane] = make_float4(ScB[m][0], ScB[m][1], ScB[m][2], ScB[m][3]);
#pragma unroll
            for (int jj = 0; jj < 4; ++jj) aseg[(size_t)(16 * m + 4 * q4 + jj) * 128 + pc] = f2bf(ScA[m][jj]);
        }
    }
}
__device__ __forceinline__ void gdn_seg_chain(const Params& p, int dh, unsigned char* lds) {
    const int tid = tid_(), lane = tid & 63, wave = tid >> 6, rr = lane & 15, q4 = lane >> 4;
    float4* sin_img = (float4*)(p.ws + WS_SIN) + (size_t)(dh * 16) * 4096;
    const float4* bimg = (const float4*)(p.ws + WS_BSEG) + (size_t)(dh * 16) * 4096;
    const bf16_t* aseg = (const bf16_t*)(p.ws + WS_ASEG) + (size_t)(dh * 16) * 128 * 128;
    f32x4 Sc[8]; bf16x8 Sb[4];
#pragma unroll
    for (int m = 0; m < 8; ++m) { const float4 v = sin_img[4096 + (wave * 8 + m) * 64 + lane]; Sc[m] = (f32x4){v.x, v.y, v.z, v.w}; }
    u32x4 ar[4];
    __syncthreads();
#pragma unroll
    for (int q = 0; q < 4; ++q) { const int t = tid + q * NTHREADS; ar[q] = *(const u32x4*)(aseg + (size_t)1 * 16384 + (size_t)(t >> 4) * 128 + (t & 15) * 8); }
#pragma unroll
    for (int q = 0; q < 4; ++q) { const int t = tid + q * NTHREADS; *(u32x4*)((bf16_t*)lds + (t >> 4) * GU_LDQ + (t & 15) * 8) = ar[q]; }
    __syncthreads();
#pragma unroll 1
    for (int k = 1; k <= 14; ++k) {
        const bf16_t* sA = (const bf16_t*)(lds + ((k - 1) & 1) * 34816);
        if (k < 14) {
#pragma unroll
            for (int q = 0; q < 4; ++q) { const int t = tid + q * NTHREADS; ar[q] = *(const u32x4*)(aseg + (size_t)(k + 1) * 16384 + (size_t)(t >> 4) * 128 + (t & 15) * 8); }
        }
#pragma unroll
        for (int kk = 0; kk < 4; ++kk) {
            const u32x4 pk = {pack2(Sc[2 * kk][0], Sc[2 * kk][1]), pack2(Sc[2 * kk][2], Sc[2 * kk][3]), pack2(Sc[2 * kk + 1][0], Sc[2 * kk + 1][1]), pack2(Sc[2 * kk + 1][2], Sc[2 * kk + 1][3])};
            Sb[kk] = __builtin_bit_cast(bf16x8, pk);
        }
#pragma unroll
        for (int m = 0; m < 8; ++m) {
            const float4 bv = bimg[(size_t)k * 4096 + (wave * 8 + m) * 64 + lane];
            f32x4 acc = (f32x4){bv.x, bv.y, bv.z, bv.w};
#pragma unroll
            for (int kk = 0; kk < 4; ++kk)
                acc = __builtin_amdgcn_mfma_f32_16x16x32_bf16(*(const bf16x8*)(sA + (16 * m + rr) * GU_LDQ + kk * 32 + 8 * q4), Sb[kk], acc, 0, 0, 0);
            Sc[m] = acc;
            sin_img[(size_t)(k + 1) * 4096 + (wave * 8 + m) * 64 + lane] = make_float4(acc[0], acc[1], acc[2], acc[3]);
        }
        if (k < 14) {
#pragma unroll
            for (int q = 0; q < 4; ++q) { const int t = tid + q * NTHREADS; *(u32x4*)((bf16_t*)(lds + (k & 1) * 34816) + (t >> 4) * GU_LDQ + (t & 15) * 8) = ar[q]; }
        }
        __syncthreads();
    }
}
__device__ __forceinline__ void gdn_seq(const Params& p, int dh, int k, unsigned char* lds) {
    const int tid = tid_(), lane = tid & 63, wave = tid >> 6, rr = lane & 15, q4 = lane >> 4, dir = dh >> 3, head = dh & 7;
    const int s_begin = 4 + 16 * k;
    f32x4 Sc[8]; bf16x8 Sb[4];
    {
        const float4* sin_img = (const float4*)(p.ws + WS_SIN) + (size_t)(dh * 16 + k) * 4096;
#pragma unroll
        for (int m = 0; m < 8; ++m) { const float4 v = sin_img[(wave * 8 + m) * 64 + lane]; Sc[m] = (f32x4){v.x, v.y, v.z, v.w}; }
#pragma unroll
        for (int kk = 0; kk < 4; ++kk) {
            const u32x4 pk = {pack2(Sc[2 * kk][0], Sc[2 * kk][1]), pack2(Sc[2 * kk][2], Sc[2 * kk][3]), pack2(Sc[2 * kk + 1][0], Sc[2 * kk + 1][1]), pack2(Sc[2 * kk + 1][2], Sc[2 * kk + 1][3])};
            Sb[kk] = __builtin_bit_cast(bf16x8, pk);
        }
    }
    u32x2 ucur[4]; float glcur;
    __syncthreads();
    {
        const int c0 = gdn_chain_chunk(dir, s_begin);
        GsG1 g1; gs_load1(p, dh, c0, g1); gs_store1(g1, lds);
        GsG2 g2; gs_load2(p, dh, c0, g2); gs_store2(g2, lds);
        GsG3 g3; gs_load3(p, dh, c0, g3); gs_store3(g3, lds);
#pragma unroll
        for (int m = 0; m < 4; ++m) ucur[m] = g3.ut[m];
        glcur = g3.gl;
    }
    __syncthreads();
    bf16_t* of = (bf16_t*)(p.ws + WS_OF) + (size_t)dir * SEQ * 1024;
#pragma unroll 1
    for (int t = 0; t < 16; ++t) {
        const int s = s_begin + t;
        const int c = gdn_chain_chunk(dir, s);
        const int cn = gdn_chain_chunk(dir, t + 1 < 16 ? s + 1 : s);
        const unsigned char* buf = lds + (t & 1) * GS_BUF; unsigned char* nbuf = lds + ((t + 1) & 1) * GS_BUF;
        const bf16_t* sW = (const bf16_t*)(buf + GS_SW); const bf16_t* sQD = (const bf16_t*)(buf + GS_SQD);
        const bf16_t* sKDT = (const bf16_t*)(buf + GS_SKDT); const bf16_t* sATT = (const bf16_t*)(buf + GS_SATT);
        GsG1 g1; gs_load1(p, dh, cn, g1);
        GsG2 g2; gs_load2(p, dh, cn, g2);
        GsG3 g3; gs_load3(p, dh, cn, g3);
        f32x4 vn[4];
#pragma unroll
        for (int m = 0; m < 4; ++m) {
            f32x4 acc = (f32x4){0.f, 0.f, 0.f, 0.f};
#pragma unroll
            for (int kk = 0; kk < 4; ++kk)
                acc = __builtin_amdgcn_mfma_f32_16x16x32_bf16(*(const bf16x8*)(sW + (16 * m + rr) * GU_LDQ + kk * 32 + 8 * q4), Sb[kk], acc, 0, 0, 0);
            vn[m][0] = lo2f(ucur[m].x) - acc[0]; vn[m][1] = hi2f(ucur[m].x) - acc[1]; vn[m][2] = lo2f(ucur[m].y) - acc[2]; vn[m][3] = hi2f(ucur[m].y) - acc[3];
        }
        bf16x8 VB[2];
#pragma unroll
        for (int k2 = 0; k2 < 2; ++k2) {
            const unsigned a0 = pack2(vn[2 * k2][0], vn[2 * k2][1]), a1 = pack2(vn[2 * k2][2], vn[2 * k2][3]);
            const unsigned a2 = pack2(vn[2 * k2 + 1][0], vn[2 * k2 + 1][1]), a3 = pack2(vn[2 * k2 + 1][2], vn[2 * k2 + 1][3]);
            const u32x4 pk = {a0, a1, a2, a3}; VB[k2] = __builtin_bit_cast(bf16x8, pk);
        }
#pragma unroll
        for (int m = 0; m < 4; ++m) {
            f32x4 acc = (f32x4){0.f, 0.f, 0.f, 0.f};
#pragma unroll
            for (int kk = 0; kk < 4; ++kk)
                acc = __builtin_amdgcn_mfma_f32_16x16x32_bf16(*(const bf16x8*)(sQD + (16 * m + rr) * GU_LDQ + kk * 32 + 8 * q4), Sb[kk], acc, 0, 0, 0);
#pragma unroll
            for (int k2 = 0; k2 < 2; ++k2)
                acc = __builtin_amdgcn_mfma_f32_16x16x32_bf16(*(const bf16x8*)(sATT + (16 * m + rr) * GU_LDT + k2 * 32 + 8 * q4), VB[k2], acc, 0, 0, 0);
#pragma unroll
            for (int jj = 0; jj < 4; ++jj) {
                const int pos = 16 * m + 4 * q4 + jj;
                of[(size_t)(c * 64 + (dir ? 63 - pos : pos)) * 1024 + head * 128 + 16 * wave + rr] = f2bf(acc[jj]);
            }
        }
        const float egl = __expf(glcur);
#pragma unroll
        for (int m = 0; m < 8; ++m) {
            f32x4 acc = Sc[m] * egl;
#pragma unroll
            for (int k2 = 0; k2 < 2; ++k2)
                acc = __builtin_amdgcn_mfma_f32_16x16x32_bf16(*(const bf16x8*)(sKDT + (16 * m + rr) * GU_LDT + ((k2 * 32 + 8 * q4) ^ ((((16 * m + rr) >> 3) & 7) << 3))), VB[k2], acc, 0, 0, 0);
            Sc[m] = acc;
        }
#pragma unroll
        for (int kk = 0; kk < 4; ++kk) {
            const u32x4 pk = {pack2(Sc[2 * kk][0], Sc[2 * kk][1]), pack2(Sc[2 * kk][2], Sc[2 * kk][3]),
                              pack2(Sc[2 * kk + 1][0], Sc[2 * kk + 1][1]), pack2(Sc[2 * kk + 1][2], Sc[2 * kk + 1][3])};
            Sb[kk] = __builtin_bit_cast(bf16x8, pk);
        }
        gs_store1(g1, nbuf); gs_store2(g2, nbuf); gs_store3(g3, nbuf);
#pragma unroll
        for (int m = 0; m < 4; ++m) ucur[m] = g3.ut[m];
        glcur = g3.gl;
        lds_barrier();
    }
}

struct LdSet { u32x4 w[4]; u32x4 att[2]; u32x4 qv[4]; u32x4 kd[4]; float gcv; };
__device__ __forceinline__ void ld_load(const Params& p, int dh, int c, int ltid, LdSet& st) {
    const int dir = dh >> 3, head = dh & 7; const size_t u = (size_t)dh * NCH + c;
    const bf16_t* wg = (const bf16_t*)(p.ws + WS_W) + u * 64 * 128; const bf16_t* att = (const bf16_t*)(p.ws + WS_ATT) + u * 64 * 64;
    const float* gc = (const float*)(p.ws + WS_GC) + u * 64; const bf16_t* qn = (const bf16_t*)(p.ws + WS_QN); const bf16_t* kn = (const bf16_t*)(p.ws + WS_KN);
    st.gcv = gc[ltid & 63];
#pragma unroll
    for (int q = 0; q < 4; ++q) {
        const int t = ltid + q * 256, i = t >> 4, d8 = (t & 15) * 8;
        const size_t rowoff = (size_t)(c * 64 + (dir ? 63 - i : i)) * 1024 + head * 128 + d8;
        st.w[q] = *(const u32x4*)(wg + (size_t)i * 128 + d8);
        st.qv[q] = *(const u32x4*)(qn + rowoff);
        st.kd[q] = *(const u32x4*)(kn + rowoff);
    }
#pragma unroll
    for (int q = 0; q < 2; ++q) { const int t = ltid + q * 256; st.att[q] = *(const u32x4*)(att + (size_t)(t >> 3) * 64 + (t & 7) * 8); }
}
__device__ __forceinline__ void ld_store(const LdSet& st, int ltid, unsigned char* buf) {
    bf16_t* sW = (bf16_t*)(buf + GS_SW); bf16_t* sQD = (bf16_t*)(buf + GS_SQD); bf16_t* sKDT = (bf16_t*)(buf + GS_SKDT); bf16_t* sATT = (bf16_t*)(buf + GS_SATT);
    const float gl = __shfl(st.gcv, 63, 64);
#pragma unroll
    for (int q = 0; q < 4; ++q) {
        const int t = ltid + q * 256, i = t >> 4, d8 = (t & 15) * 8;
        const float gci = __shfl(st.gcv, i, 64);
        *(u32x4*)(sW + i * GU_LDQ + d8) = st.w[q];
        {
            const float e = __expf(gci); const u32x4 v = st.qv[q];
            u32x4 o; o.x = pack2(lo2f(v.x) * e, hi2f(v.x) * e); o.y = pack2(lo2f(v.y) * e, hi2f(v.y) * e); o.z = pack2(lo2f(v.z) * e, hi2f(v.z) * e); o.w = pack2(lo2f(v.w) * e, hi2f(v.w) * e);
            *(u32x4*)(sQD + i * GU_LDQ + d8) = o;
        }
        {
            const float e = __expf(gl - gci);
            const u32x4 kq = st.kd[q]; const int sl = perm_slot64(i) ^ (((d8 >> 3) & 7) << 3);
            sKDT[(d8 + 0) * GU_LDT + sl] = f2bf(lo2f(kq.x) * e); sKDT[(d8 + 1) * GU_LDT + sl] = f2bf(hi2f(kq.x) * e);
            sKDT[(d8 + 2) * GU_LDT + sl] = f2bf(lo2f(kq.y) * e); sKDT[(d8 + 3) * GU_LDT + sl] = f2bf(hi2f(kq.y) * e);
            sKDT[(d8 + 4) * GU_LDT + sl] = f2bf(lo2f(kq.z) * e); sKDT[(d8 + 5) * GU_LDT + sl] = f2bf(hi2f(kq.z) * e);
            sKDT[(d8 + 6) * GU_LDT + sl] = f2bf(lo2f(kq.w) * e); sKDT[(d8 + 7) * GU_LDT + sl] = f2bf(hi2f(kq.w) * e);
        }
    }
#pragma unroll
    for (int q = 0; q < 2; ++q) { const int t = ltid + q * 256; *(u32x4*)(sATT + (t >> 3) * GU_LDT + (t & 7) * 8) = st.att[q]; }
}
__device__ __forceinline__ void gdn_seq_rs(const Params& p, int dh, int k, unsigned char* lds) {
    const int tid = tid_(), lane = tid & 63, wave = __builtin_amdgcn_readfirstlane(tid >> 6), rr = lane & 15, q4 = lane >> 4, dir = dh >> 3, head = dh & 7;
    const int s_begin = 4 + 16 * k;
    const bool loader = wave >= 4;
    __syncthreads();
    {
        const int c0 = gdn_chain_chunk(dir, s_begin);
        GsG1 g1; gs_load1(p, dh, c0, g1); gs_store1(g1, lds);
        GsG2 g2; gs_load2(p, dh, c0, g2); gs_store2(g2, lds);
        GsG3 g3; gs_load3(p, dh, c0, g3); gs_store3(g3, lds);
    }
    if (loader) {
        const int ltid = tid - 256;
        LdSet cur;
        ld_load(p, dh, gdn_chain_chunk(dir, s_begin + 1), ltid, cur);
        __syncthreads();
        bf16_t* of = (bf16_t*)(p.ws + WS_OF) + (size_t)dir * SEQ * 1024 + head * 128;
#pragma unroll 1
        for (int t = 0; t <= 16; ++t) {
            LdSet nxt;
            ld_load(p, dh, gdn_chain_chunk(dir, s_begin + (t + 2 < 16 ? t + 2 : 15)), ltid, nxt);
            if (t > 0) {
                const bf16_t* sO = (const bf16_t*)(lds + 2 * GS_BUF + ((t - 1) & 1) * GS_OT);
                const int c = gdn_chain_chunk(dir, s_begin + t - 1);
#pragma unroll
                for (int q = 0; q < 4; ++q) {
                    const int tt = ltid + q * 256, pos = tt >> 4, c8 = (tt & 15) * 8;
                    *(u32x4*)(of + (size_t)(c * 64 + (dir ? 63 - pos : pos)) * 1024 + c8) = *(const u32x4*)(sO + pos * GU_LDQ + c8);
                }
            }
            if (t == 16) break;
            if (t + 1 < 16) ld_store(cur, ltid, lds + ((t + 1) & 1) * GS_BUF);
            cur = nxt;
            lds_barrier();
        }
    } else {
        f32x4 Sc[2][8]; bf16x8 Sb[2][4];
        {
            const float4* sin_img = (const float4*)(p.ws + WS_SIN) + (size_t)(dh * 16 + k) * 4096;
#pragma unroll
            for (int sl = 0; sl < 2; ++sl) {
#pragma unroll
                for (int m = 0; m < 8; ++m) { const float4 v = sin_img[((2 * wave + sl) * 8 + m) * 64 + lane]; Sc[sl][m] = (f32x4){v.x, v.y, v.z, v.w}; }
#pragma unroll
                for (int kk = 0; kk < 4; ++kk) {
                    const u32x4 pk = {pack2(Sc[sl][2 * kk][0], Sc[sl][2 * kk][1]), pack2(Sc[sl][2 * kk][2], Sc[sl][2 * kk][3]), pack2(Sc[sl][2 * kk + 1][0], Sc[sl][2 * kk + 1][1]), pack2(Sc[sl][2 * kk + 1][2], Sc[sl][2 * kk + 1][3])};
                    Sb[sl][kk] = __builtin_bit_cast(bf16x8, pk);
                }
            }
        }
        const bf16_t* utbase = (const bf16_t*)(p.ws + WS_UT) + (size_t)(32 * wave + rr) * 64 + 16 * q4;
        const float* gcb = (const float*)(p.ws + WS_GC);
        u32x4 ucur[2][2]; float glcur;
        {
            const size_t u0 = (size_t)dh * NCH + gdn_chain_chunk(dir, s_begin);
#pragma unroll
            for (int sl = 0; sl < 2; ++sl)
#pragma unroll
                for (int hh = 0; hh < 2; ++hh) ucur[sl][hh] = *(const u32x4*)(utbase + u0 * 128 * 64 + sl * 16 * 64 + 8 * hh);
            glcur = gcb[u0 * 64 + 63];
        }
        __syncthreads();
#pragma unroll 1
        for (int t = 0; t < 16; ++t) {
            const size_t un = (size_t)dh * NCH + gdn_chain_chunk(dir, s_begin + (t + 1 < 16 ? t + 1 : t));
            u32x4 unext[2][2];
#pragma unroll
            for (int sl = 0; sl < 2; ++sl)
#pragma unroll
                for (int hh = 0; hh < 2; ++hh) unext[sl][hh] = *(const u32x4*)(utbase + un * 128 * 64 + sl * 16 * 64 + 8 * hh);
            const float glnext = gcb[un * 64 + 63];
            __builtin_amdgcn_sched_barrier(0);
            const unsigned char* buf = lds + (t & 1) * GS_BUF;
            const bf16_t* sW = (const bf16_t*)(buf + GS_SW); const bf16_t* sQD = (const bf16_t*)(buf + GS_SQD);
            const bf16_t* sKDT = (const bf16_t*)(buf + GS_SKDT); const bf16_t* sATT = (const bf16_t*)(buf + GS_SATT);
            bf16_t* sO = (bf16_t*)(lds + 2 * GS_BUF + (t & 1) * GS_OT);
            f32x4 vn[2][4];
#pragma unroll
            for (int m = 0; m < 4; ++m) {
                f32x4 a0 = (f32x4){0.f, 0.f, 0.f, 0.f}, a1 = (f32x4){0.f, 0.f, 0.f, 0.f};
#pragma unroll
                for (int kk = 0; kk < 4; ++kk) {
                    const bf16x8 a = *(const bf16x8*)(sW + (16 * m + rr) * GU_LDQ + kk * 32 + 8 * q4);
                    a0 = __builtin_amdgcn_mfma_f32_16x16x32_bf16(a, Sb[0][kk], a0, 0, 0, 0);
                    a1 = __builtin_amdgcn_mfma_f32_16x16x32_bf16(a, Sb[1][kk], a1, 0, 0, 0);
                }
                {
                    const unsigned u0a = (m & 1) ? ucur[0][m >> 1].z : ucur[0][m >> 1].x, u0b = (m & 1) ? ucur[0][m >> 1].w : ucur[0][m >> 1].y;
                    const unsigned u1a = (m & 1) ? ucur[1][m >> 1].z : ucur[1][m >> 1].x, u1b = (m & 1) ? ucur[1][m >> 1].w : ucur[1][m >> 1].y;
                    vn[0][m][0] = lo2f(u0a) - a0[0]; vn[0][m][1] = hi2f(u0a) - a0[1]; vn[0][m][2] = lo2f(u0b) - a0[2]; vn[0][m][3] = hi2f(u0b) - a0[3];
                    vn[1][m][0] = lo2f(u1a) - a1[0]; vn[1][m][1] = hi2f(u1a) - a1[1]; vn[1][m][2] = lo2f(u1b) - a1[2]; vn[1][m][3] = hi2f(u1b) - a1[3];
                }
            }
            bf16x8 VB[2][2];
#pragma unroll
            for (int sl = 0; sl < 2; ++sl)
#pragma unroll
                for (int k2 = 0; k2 < 2; ++k2) {
                    const u32x4 pk = {pack2(vn[sl][2 * k2][0], vn[sl][2 * k2][1]), pack2(vn[sl][2 * k2][2], vn[sl][2 * k2][3]), pack2(vn[sl][2 * k2 + 1][0], vn[sl][2 * k2 + 1][1]), pack2(vn[sl][2 * k2 + 1][2], vn[sl][2 * k2 + 1][3])};
                    VB[sl][k2] = __builtin_bit_cast(bf16x8, pk);
                }
#pragma unroll
            for (int m = 0; m < 4; ++m) {
                f32x4 a0 = (f32x4){0.f, 0.f, 0.f, 0.f}, a1 = (f32x4){0.f, 0.f, 0.f, 0.f};
#pragma unroll
                for (int kk = 0; kk < 4; ++kk) {
                    const bf16x8 a = *(const bf16x8*)(sQD + (16 * m + rr) * GU_LDQ + kk * 32 + 8 * q4);
                    a0 = __builtin_amdgcn_mfma_f32_16x16x32_bf16(a, Sb[0][kk], a0, 0, 0, 0);
                    a1 = __builtin_amdgcn_mfma_f32_16x16x32_bf16(a, Sb[1][kk], a1, 0, 0, 0);
                }
#pragma unroll
                for (int k2 = 0; k2 < 2; ++k2) {
                    const bf16x8 a = *(const bf16x8*)(sATT + (16 * m + rr) * GU_LDT + k2 * 32 + 8 * q4);
                    a0 = __builtin_amdgcn_mfma_f32_16x16x32_bf16(a, VB[0][k2], a0, 0, 0, 0);
                    a1 = __builtin_amdgcn_mfma_f32_16x16x32_bf16(a, VB[1][k2], a1, 0, 0, 0);
                }
#pragma unroll
                for (int jj = 0; jj < 4; ++jj) {
                    bf16_t* orow = sO + (16 * m + 4 * q4 + jj) * GU_LDQ + 32 * wave + rr;
                    orow[0] = f2bf(a0[jj]); orow[16] = f2bf(a1[jj]);
                }
            }
            const float egl = __expf(glcur);
#pragma unroll
            for (int m = 0; m < 8; ++m) {
                f32x4 a0 = Sc[0][m] * egl, a1 = Sc[1][m] * egl;
#pragma unroll
                for (int k2 = 0; k2 < 2; ++k2) {
                    const bf16x8 a = *(const bf16x8*)(sKDT + (16 * m + rr) * GU_LDT + ((k2 * 32 + 8 * q4) ^ ((((16 * m + rr) >> 3) & 7) << 3)));
                    a0 = __builtin_amdgcn_mfma_f32_16x16x32_bf16(a, VB[0][k2], a0, 0, 0, 0);
                    a1 = __builtin_amdgcn_mfma_f32_16x16x32_bf16(a, VB[1][k2], a1, 0, 0, 0);
                }
                Sc[0][m] = a0; Sc[1][m] = a1;
            }
#pragma unroll
            for (int sl = 0; sl < 2; ++sl)
#pragma unroll
                for (int kk = 0; kk < 4; ++kk) {
                    const u32x4 pk = {pack2(Sc[sl][2 * kk][0], Sc[sl][2 * kk][1]), pack2(Sc[sl][2 * kk][2], Sc[sl][2 * kk][3]), pack2(Sc[sl][2 * kk + 1][0], Sc[sl][2 * kk + 1][1]), pack2(Sc[sl][2 * kk + 1][2], Sc[sl][2 * kk + 1][3])};
                    Sb[sl][kk] = __builtin_bit_cast(bf16x8, pk);
                }
#pragma unroll
            for (int sl = 0; sl < 2; ++sl)
#pragma unroll
                for (int hh = 0; hh < 2; ++hh) ucur[sl][hh] = unext[sl][hh];
            glcur = glnext;
            lds_barrier();
        }
    }
}

__device__ __forceinline__ void gdn_readout_row(const Params& p, int row) {
    const int lane = tid_() & 63, head = lane >> 3, d0 = (lane & 7) * 16;
    const bf16_t* of0 = (const bf16_t*)(p.ws + WS_OF) + (size_t)row * 1024 + head * 128 + d0;
    const bf16_t* of1 = of0 + (size_t)SEQ * 1024;
    const bf16_t* zp = (const bf16_t*)(p.ws + WS_Z) + (size_t)row * 1024 + head * 128 + d0;
    float a[16], b[16], z[16];
    unpack8(*(const uint4*)of0, a); unpack8(*(const uint4*)(of0 + 8), a + 8);
    unpack8(*(const uint4*)of1, b); unpack8(*(const uint4*)(of1 + 8), b + 8);
    unpack8(*(const uint4*)zp, z); unpack8(*(const uint4*)(zp + 8), z + 8);
    float ss = 0.f;
#pragma unroll
    for (int e = 0; e < 16; ++e) { a[e] += b[e]; ss += a[e] * a[e]; }
    ss += __shfl_xor(ss, 1, 64); ss += __shfl_xor(ss, 2, 64); ss += __shfl_xor(ss, 4, 64);
    const float rs = rsqrtf(ss * (1.f / 128.f) + 1e-6f);
    const float* ng = p.in[25] + d0;
    float f[16];
#pragma unroll
    for (int e = 0; e < 16; ++e) f[e] = a[e] * rs * ng[e] * siluf_(z[e]);
    bf16_t* dst = (bf16_t*)(p.ws + WS_VN) + (size_t)row * 1024 + head * 128 + d0;
    *(uint4*)dst = pack8(f); *(uint4*)(dst + 8) = pack8(f + 8);
}

#define XB_TMO      128
#define XB_XCNT(j)  (256  + 64 * (j))
#define XB_XSUB(j)  (1280 + 64 * (j))
#define XB_XGEN(j)  (2304 + 64 * (j))
#define XB_TOP      3328
#define XB_TOPGEN   3392
#define XCD_BAR_WORDS 3456
#define XB_SPIN_CAP (1u << 22)
__device__ __forceinline__ unsigned xb_ld(unsigned* p)              { return __hip_atomic_load(p, __ATOMIC_RELAXED, __HIP_MEMORY_SCOPE_AGENT); }
__device__ __forceinline__ unsigned xb_add(unsigned* p, unsigned v) { return __hip_atomic_fetch_add(p, v, __ATOMIC_RELAXED, __HIP_MEMORY_SCOPE_AGENT); }
__device__ __forceinline__ unsigned xb_xcc_id() { return (unsigned)__builtin_amdgcn_s_getreg((3 << 11) | 20) & 0xFu; }
#define XB_SPIN(cond, bar) do { unsigned _sp = 0; while (cond) { __builtin_amdgcn_s_sleep(1); \
    if ((++_sp & 255u) == 0u) { if (xb_ld(&(bar)[XB_TMO])) break; if (_sp > XB_SPIN_CAP) { atomicAdd(&(bar)[XB_TMO], 1u); break; } } } } while (0)
struct XcdBarrier { unsigned* bar; unsigned x; volatile LAS unsigned* st; };
__device__ __forceinline__ XcdBarrier xcd_barrier_post(unsigned* bar, volatile LAS unsigned* st) {
    XcdBarrier b; b.bar = bar; b.x = xb_xcc_id(); b.st = st;
    if (threadIdx.x == 0) (void)xb_add(&bar[XB_XCNT(b.x)], 1u);
    return b;
}
__device__ __forceinline__ void xcd_barrier_complete(unsigned* bar, unsigned x, unsigned& nloc, unsigned& nx) {
    const unsigned G = gridDim.x * gridDim.y * gridDim.z;
    unsigned sum, cnt, mine, sp = 0u;
    for (;;) {
        sum = 0u; cnt = 0u; mine = 0u;
#pragma unroll
        for (unsigned j = 0; j < 16; ++j) { const unsigned c = xb_ld(&bar[XB_XCNT(j)]); sum += c; cnt += (c > 0u) ? 1u : 0u; mine = (j == x) ? c : mine; }
        if (sum == G) break;
        __builtin_amdgcn_s_sleep(1);
        if ((++sp & 255u) == 0u) { if (xb_ld(&bar[XB_TMO])) break; if (sp > XB_SPIN_CAP) { atomicAdd(&bar[XB_TMO], 1u); break; } }
    }
    nloc = mine > 0u ? mine : 1u; nx = cnt > 0u ? cnt : 1u;
}
__device__ __forceinline__ void xcd_barrier(const XcdBarrier& b) {
    asm volatile("s_waitcnt vmcnt(0)" ::: "memory");
    __syncthreads();
    if (threadIdx.x == 0) {
        unsigned* bar = b.bar;
        __builtin_amdgcn_s_waitcnt(0);
        unsigned nloc = b.st[0], nx = b.st[1];
        if (nloc == 0u) { xcd_barrier_complete(bar, b.x, nloc, nx); b.st[0] = nloc; b.st[1] = nx; }
        const unsigned old = xb_add(&bar[XB_XSUB(b.x)], 1u);
        const unsigned gen = old / nloc;
        if (old + 1u == (gen + 1u) * nloc) {
            __builtin_amdgcn_fence(__ATOMIC_RELEASE, "agent");
            asm volatile("s_waitcnt vmcnt(0)" ::: "memory");
            const unsigned og = xb_add(&bar[XB_TOP], 1u);
            const unsigned tg = og / nx;
            if (og + 1u == (tg + 1u) * nx) xb_add(&bar[XB_TOPGEN], 1u);
            else XB_SPIN(xb_ld(&bar[XB_TOPGEN]) == tg, bar);
            __builtin_amdgcn_fence(__ATOMIC_ACQUIRE, "agent");
            xb_add(&bar[XB_XGEN(b.x)], 1u);
            asm volatile("s_waitcnt vmcnt(0)" ::: "memory");
        } else {
            XB_SPIN(xb_ld(&bar[XB_XGEN(b.x)]) == gen, bar);
            __builtin_amdgcn_fence(__ATOMIC_ACQUIRE, "agent");
            asm volatile("s_waitcnt vmcnt(0)" ::: "memory");
        }
    }
    __syncthreads();
}

#ifndef PHMASK
#define PHMASK 0xFFFFFFFFull
#endif
#define PH(n) (((PHMASK) >> (n)) & 1ull)
#define FOR_ITEMS(n) for (int item = blockIdx.x; item < (n); item += gridDim.x)
__device__ __forceinline__ void mixer1_phases(const Params& p, unsigned char* ws, unsigned char* lds, const XcdBarrier& xbar) {
    if (PH(14)) {
        EpiOddIn e{(bf16_t*)(ws + WS_QKVR), (bf16_t*)(ws + WS_Z), (float*)(ws + WS_AB)};
        gemm_big((const bf16_t*)(ws + WS_ACT), (const bf16_t*)(ws + WS_WOIN), SEQ, 4096, 1024, e, lds);
        FOR_ITEMS(128 + 2 * 33) {
            if (item < 128) gemm_tile((const bf16_t*)(ws + WS_ACT), 1024, R, (const bf16_t*)(ws + WS_WOIN), 1024, ODD_IN, 1024, item * 128, 4096, e, lds);
            else { const int q = item - 128; gemm_tile((const bf16_t*)(ws + WS_ACT), 1024, R, (const bf16_t*)(ws + WS_WOIN), 1024, ODD_IN, 1024, SEQ + (q / 33) * 128, (q % 33) * 128, e, lds); }
        }
    }
    xcd_barrier(xbar);
    if (PH(15)) FOR_ITEMS(R / 16) gdn_prep_item(p, item);
    xcd_barrier(xbar);
    if (PH(16)) {
        GuPre pre;
        int item = blockIdx.x;
        if (item < NUNITS) gu_prefetch(p, item, pre);
        for (; item < NUNITS; item += gridDim.x) gdn_unit(p, item, item + (int)gridDim.x, pre, lds);
    }
    xcd_barrier(xbar);
    if (PH(17)) {
        FOR_ITEMS(256) { const int kk_ = item & 15; if (kk_ == 0) gdn_seg_ab<true>(p, item >> 4, 0, lds); else if (kk_ != 15) gdn_seg_ab<false>(p, item >> 4, kk_, lds); }
        xcd_barrier(xbar);
        if (blockIdx.x < 16) gdn_seg_chain(p, blockIdx.x, lds);
        else {
            for (int item = (int)blockIdx.x - 16; item < 256; item += (int)gridDim.x - 16)
                p0_transpose(p.in[26], 1024, 1024, (bf16_t*)(ws + WS_WOOUT), item, lds);
        }
        xcd_barrier(xbar);
        FOR_ITEMS(256) gdn_seq_rs(p, item >> 4, item & 15, lds);
    }
    xcd_barrier(xbar);
    if (PH(18)) FOR_ITEMS(SEQ / 8) gdn_readout_row(p, item * 8 + (tid_() >> 6));
    xcd_barrier(xbar);
    if (PH(19)) {
        EpiResid e{p.in[0], p.in[2], (bf16_t*)(ws + WS_H), (const float*)(ws + WS_MOD), 1, false};
        gemm_big((const bf16_t*)(ws + WS_VN), (const bf16_t*)(ws + WS_WOOUT), SEQ, 1024, 1024, e, lds);
        FOR_ITEMS(2048) peer_tables_item(p, item, 1);
    }
    xcd_barrier(xbar);
}

template <int L>
__device__ __forceinline__ void peer_phases(const Params& p, unsigned char* ws, unsigned char* lds, const XcdBarrier& xbar) {
    constexpr int l = L;
    constexpr int nrows = L == 0 ? R : SEQ, ntm = nrows / 128;
    if (PH(8)) FOR_ITEMS(nrows / 8) norm_rows_item(p, item, l, p.in[7] + l * 1024, 3, false);
    xcd_barrier(xbar);
    if (PH(9)) {
        EpiScore e{(unsigned short*)(ws + WS_SC), 0};
        const bf16_t* wq = (const bf16_t*)(ws + (l == 0 ? WS_WQ0 : WS_WQ1));
        gemm_big((const bf16_t*)(ws + WS_ACT), wq, SEQ, 2048, 1024, e, lds);
        if (l == 0) { FOR_ITEMS(2 * 16) gemm_tile((const bf16_t*)(ws + WS_ACT), 1024, R, wq, 1024, 2048, 1024, SEQ + (item >> 4) * 128, (item & 15) * 128, e, lds); }
    }
    xcd_barrier(xbar);
    if (PH(11)) FOR_ITEMS(nrows / 64) peer_route_item(p, item, nrows, lds);
    xcd_barrier(xbar);
    if (PH(12)) {
        if (l == 0) { FOR_ITEMS(CTX) peer_gather_row_split(p, SEQ + item, 0, lds); }
        FOR_ITEMS(SEQ / 8) peer_gather_row(p, item * 8 + (tid_() >> 6), l, l == 1);
    }
}

__global__ void __launch_bounds__(NTHREADS) fwd_megakernel(Params p) {
    extern __shared__ __attribute__((aligned(16))) unsigned char lds[];
    cg::grid_group grid = cg::this_grid();
    unsigned char* ws = p.ws;
    volatile LAS unsigned* xbst = (volatile LAS unsigned*)(LAS unsigned char*)(lds + LDS_BYTES - 16);
    if (threadIdx.x == 0) { xbst[0] = 0u; xbst[1] = 0u; }
    __syncthreads();
    const XcdBarrier xbar = xcd_barrier_post((unsigned*)(ws + WS_BAR), xbst);

    if (PH(0)) {
        constexpr int N_S5 = 256, N_ADA = 192, N_T0 = 512, N_T1 = 64, N_T2 = 256, N_T5 = 1024, N_SK = 16;
        constexpr int O1 = N_S5, O2 = O1 + N_ADA, O3 = O2 + N_T0, O4 = O3 + N_T1, O5 = O4 + N_T2, O6 = O5 + N_T5, O7 = O6 + N_SK;
        FOR_ITEMS(O7) {
            if (item < O1) p0_s5_tables(p, item, lds);
            else if (item < O2) p0_adaln(p, item - O1, lds);
            else if (item < O3) p0_transpose(p.in[8], 1024, 2048, (bf16_t*)(ws + WS_WEIN), item - O2, lds);
            else if (item < O4) p0_transpose(p.in[18], 512, 512, (bf16_t*)(ws + WS_WGLU), item - O3, lds);
            else if (item < O5) p0_transpose(p.in[20], 1024, 1024, (bf16_t*)(ws + WS_WEOUT), item - O4, lds);
            else if (item < O6) cvt_chunk(p.in[27], (bf16_t*)(ws + WS_WQB), item - O5);
            else cvt_chunk(p.in[28], (bf16_t*)(ws + WS_SK), item - O6);
        }
    }
    grid.sync();
    if (PH(1)) FOR_ITEMS(2080 + 2048 + 256) {
        if (item < 2080) norm_rows_item(p, item, 0, p.in[6], 0, true);
        else if (item < 2080 + 2048) s5_mintra_item(p, item - 2080);
        else {
            const int q = item - 4128, l = q >> 7, b = (q >> 3) & 15, tn = q & 7;
            EpiBf16 e{(bf16_t*)(ws + (l == 0 ? WS_WQ0 : WS_WQ1)) + (size_t)b * 128 * 1024, 1024};
            gemm_tile((const bf16_t*)(ws + WS_SK) + (size_t)(l * 2 + (b & 1)) * 128 * 128, 128, 128,
                      (const bf16_t*)(ws + WS_WQB) + (size_t)l * 1024 * 2048 + b * 128, 2048, 1024, 128, 0, tn * 128, e, lds);
        }
    }
    xcd_barrier(xbar);
    if (PH(2)) {
        EpiEvenIn e{(bf16_t*)(ws + WS_PA), (bf16_t*)(ws + WS_UG)};
        gemm_big((const bf16_t*)(ws + WS_ACT), (const bf16_t*)(ws + WS_WEIN), SEQ, 2048, 1024, e, lds);
        FOR_ITEMS(2 * 16) gemm_tile((const bf16_t*)(ws + WS_ACT), 1024, R, (const bf16_t*)(ws + WS_WEIN), 1024, 2048, 1024, SEQ + (item >> 4) * 128, (item & 15) * 128, e, lds);
    }
    xcd_barrier(xbar);
    if (PH(3)) FOR_ITEMS(32 * 30) {
        const int g = item / 30, r = item % 30, tm = r / 10, tn = r % 10;
        EpiS5Local e{(bf16_t*)(ws + WS_YL), (float*)(ws + WS_LST), g};
        gemm_tile((const bf16_t*)(ws + WS_UG) + (size_t)g * NCH * 1024, 1024, NCH, (const bf16_t*)(ws + WS_MS5) + (size_t)g * 1280 * 1024, 1024, 1280, 1024, tm * 128, tn * 128, e, lds);
    }
    xcd_barrier(xbar);
    if (PH(4)) {
        s5_scan(p);
        if (blockIdx.x >= 8) {
            for (int item = (int)blockIdx.x - 8; item < 2048 + 16 * 65; item += (int)gridDim.x - 8) {
                if (item < 2048) peer_tables_item(p, item, 0);
                else p0_transpose(p.in[21], 1024, ODD_IN, (bf16_t*)(ws + WS_WOIN), item - 2048, lds);
            }
        }
    }
    xcd_barrier(xbar);
    if (PH(5)) FOR_ITEMS(32 * 24) {
        const int g = item / 24, r = item % 24, tm = r / 8, tn = r % 8;
        EpiS5Out e{(const bf16_t*)(ws + WS_YL), (bf16_t*)(ws + WS_GS), g};
        gemm_tile((const bf16_t*)(ws + WS_A5) + (size_t)g * NCH * 256, 256, NCH, (const bf16_t*)(ws + WS_O5) + (size_t)g * 1024 * 256, 256, 1024, 256, tm * 128, tn * 128, e, lds);
    }
    xcd_barrier(xbar);
    if (PH(6)) {
        EpiGlu e{(const bf16_t*)(ws + WS_GS), p.in[19], (bf16_t*)(ws + WS_CB)};
        gemm_big((const bf16_t*)(ws + WS_GS), (const bf16_t*)(ws + WS_WGLU), SEQ, 512, 512, e, lds);
        for (int item = (int)gridDim.x - 1 - (int)blockIdx.x; item < 2 * 4 + NCH; item += gridDim.x) {
            if (item < 8) gemm_tile((const bf16_t*)(ws + WS_GS), 512, R, (const bf16_t*)(ws + WS_WGLU), 512, 512, 512, SEQ + (item >> 2) * 128, (item & 3) * 128, e, lds);
            else even_conv_item(p, item - 8);
        }
    }
    xcd_barrier(xbar);
    if (PH(7)) {
        EpiResid e{p.in[0], p.in[2], (bf16_t*)(ws + WS_H), (const float*)(ws + WS_MOD), 0, true};
        gemm_big((const bf16_t*)(ws + WS_CB), (const bf16_t*)(ws + WS_WEOUT), SEQ, 1024, 1024, e, lds);
        FOR_ITEMS(2 * 8) gemm_tile((const bf16_t*)(ws + WS_CB), 1024, R, (const bf16_t*)(ws + WS_WEOUT), 1024, 1024, 1024, SEQ + (item >> 3) * 128, (item & 7) * 128, e, lds);
    }
    xcd_barrier(xbar);
    peer_phases<0>(p, ws, lds, xbar);
    xcd_barrier(xbar);
    mixer1_phases(p, ws, lds, xbar);
    peer_phases<1>(p, ws, lds, xbar);
}

extern "C" void kernel_launch(void* const* d_in, const int* in_sizes, int n_in, void* d_out, int out_size, void* d_ws, size_t ws_size, hipStream_t stream) {
    static int grid_blocks = 0;
    if (grid_blocks == 0) {
        if (n_in != 32 || out_size != SEQ * D || ws_size < WS_NEED) {
            fprintf(stderr, "kernel_launch: unexpected problem (n_in %d, out %d, ws %zu, need %zu); nothing launched\n", n_in, out_size, ws_size, (size_t)WS_NEED);
            grid_blocks = -1; return;
        }
        int dev = 0, cus = 0, per_cu = 0;
        hipGetDevice(&dev);
        hipDeviceGetAttribute(&cus, hipDeviceAttributeMultiprocessorCount, dev);
        hipFuncSetAttribute((const void*)fwd_megakernel, hipFuncAttributeMaxDynamicSharedMemorySize, LDS_BYTES);
        hipOccupancyMaxActiveBlocksPerMultiprocessor(&per_cu, (const void*)fwd_megakernel, NTHREADS, LDS_BYTES);
        if (per_cu < 1) { fprintf(stderr, "kernel_launch: occupancy query says %d blocks per CU; nothing launched\n", per_cu); grid_blocks = -1; return; }
        grid_blocks = cus;
    }
    if (grid_blocks < 0) return;
    (void)hipMemsetAsync((unsigned char*)d_ws + WS_BAR, 0, XCD_BAR_WORDS * 4, stream);
    Params prm{};
    for (int i = 0; i < 32; ++i) prm.in[i] = (const float*)d_in[i];
    prm.out = (float*)d_out; prm.ws = (unsigned char*)d_ws;
    void* args[] = {&prm};
    hipError_t e = hipLaunchCooperativeKernel((const void*)fwd_megakernel, dim3(grid_blocks), dim3(NTHREADS), args, LDS_BYTES, stream);
    if (e != hipSuccess) fprintf(stderr, "cooperative launch failed: %s (grid %d)\n", hipGetErrorString(e), grid_blocks);
}
```

```cpp
#include <hip/hip_runtime.h>
#include <hip/hip_cooperative_groups.h>
#include <cstdio>
#include <cstdint>
namespace cg = cooperative_groups;

typedef unsigned short bf16_t;
typedef short bf16x8 __attribute__((ext_vector_type(8)));
typedef float f32x4 __attribute__((ext_vector_type(4)));
typedef float f32x16 __attribute__((ext_vector_type(16)));
typedef unsigned u32x4 __attribute__((ext_vector_type(4)));
typedef unsigned u32x2 __attribute__((ext_vector_type(2)));

constexpr int D = 1024, SEQ = 16384, CTX = 256, R = SEQ + CTX;
constexpr int NCH = R / 64;
constexpr int NCH_LAT = SEQ / 64;
constexpr int NTHREADS = 512;
constexpr int ODD_IN = 4128;
constexpr int NUNITS = 16 * NCH;

constexpr size_t al256(size_t x) { return (x + 255) & ~(size_t)255; }
constexpr size_t WS_BAR   = 0;
constexpr size_t WS_PARAMS = 14336;
constexpr size_t WS_MOD   = 16384;
constexpr size_t WS_A64   = WS_MOD + al256(2 * 2 * 6 * 1024 * 4);
constexpr size_t WS_SK    = WS_A64 + al256(2 * 32 * 64 * 8);
constexpr size_t WS_PSC   = WS_SK + al256(2 * 2 * 128 * 128 * 2);
constexpr size_t WS_WEIN  = WS_PSC + al256(2 * 16384 * 4);
constexpr size_t WS_WGLU  = WS_WEIN + (size_t)2048 * 1024 * 2;
constexpr size_t WS_WEOUT = WS_WGLU + (size_t)512 * 512 * 2;
constexpr size_t WS_WQ0   = WS_WEOUT + (size_t)1024 * 1024 * 2;
constexpr size_t WS_WQ1   = WS_WQ0 + (size_t)2048 * 1024 * 2;
constexpr size_t WS_WOIN  = WS_WQ1 + (size_t)2048 * 1024 * 2;
constexpr size_t WS_WOOUT = WS_WOIN + al256((size_t)ODD_IN * 1024 * 2);
constexpr size_t WS_H     = WS_WOOUT + (size_t)1024 * 1024 * 2;
constexpr size_t WS_PUV   = WS_H + (size_t)R * 1024 * 4;
constexpr size_t WS_ACT   = WS_PUV + (size_t)2 * 16384 * 1024 * 2;
constexpr size_t WS_ARENA = WS_ACT + (size_t)R * 1024 * 2;
constexpr size_t WS_GG    = WS_WEIN;
constexpr size_t WS_BETA  = WS_GG + (size_t)16 * R * 4;
constexpr size_t WS_GC    = WS_BETA + (size_t)16 * R * 4;
constexpr size_t WS_AB    = WS_GC + (size_t)NUNITS * 64 * 4;
static_assert(WS_AB + (size_t)R * 32 * 4 <= WS_WQ1, "layer-1 small buffers overflow the dead layer-0 weights");
constexpr size_t WS_PA    = WS_ARENA;
constexpr size_t WS_WQB   = WS_PA;
constexpr size_t WS_UG    = WS_PA + (size_t)R * 1536 * 2;
constexpr size_t WS_MS5   = WS_UG + (size_t)32 * NCH * 1024 * 2;
constexpr size_t WS_O5    = WS_MS5 + (size_t)32 * 1280 * 1024 * 2;
constexpr size_t WS_KTAB  = WS_O5 + (size_t)32 * 1024 * 256 * 2;
constexpr size_t WS_YL    = WS_KTAB + (size_t)2 * 32 * 64 * 256 * 4;
constexpr size_t WS_LST   = WS_YL + (size_t)R * 512 * 4;
constexpr size_t WS_A5    = WS_LST + (size_t)32 * NCH * 256 * 4;
constexpr size_t WS_GS    = WS_A5 + (size_t)32 * NCH * 256 * 2;
constexpr size_t WS_CB    = WS_GS + (size_t)R * 512 * 2;
constexpr size_t WS_END_L0 = WS_CB + (size_t)R * 1024 * 2;
constexpr size_t WS_Q     = WS_ARENA;
constexpr size_t WS_SC    = WS_Q + (size_t)R * 2048 * 2;
constexpr size_t WS_IDX   = WS_SC + (size_t)R * 2048 * 2;
constexpr size_t WS_GATE  = WS_IDX + (size_t)R * 128 * 4;
constexpr size_t WS_END_PEER = WS_GATE + (size_t)R * 128 * 4;
constexpr size_t WS_QKVR  = WS_ARENA;
constexpr size_t WS_W     = WS_QKVR;
constexpr size_t WS_ATT   = WS_W + (size_t)NUNITS * 64 * 128 * 2;
static_assert(WS_ATT + (size_t)NUNITS * 64 * 64 * 2 <= WS_QKVR + (size_t)R * 3072 * 2, "W+ATT must fit in QKVR");
constexpr size_t WS_Z     = WS_QKVR + (size_t)R * 3072 * 2;
constexpr size_t WS_QN    = WS_Z + (size_t)R * 1024 * 2;
constexpr size_t WS_KN    = WS_QN + (size_t)R * 1024 * 2;
constexpr size_t WS_VN    = WS_KN + (size_t)R * 1024 * 2;
constexpr size_t WS_UT    = WS_VN + (size_t)R * 1024 * 2;
constexpr size_t WS_END_L1 = WS_UT + (size_t)NUNITS * 128 * 64 * 2;
constexpr size_t WS_OF    = WS_PUV;
constexpr size_t WS_SIN   = WS_ACT;
constexpr size_t WS_BSEG  = WS_SIN + (size_t)256 * 65536;
constexpr size_t WS_ASEG  = WS_VN;
static_assert(WS_BSEG + (size_t)256 * 65536 <= WS_ARENA, "SIN+BSEG must fit in ACT");
constexpr size_t cmax(size_t a, size_t b) { return a > b ? a : b; }
constexpr size_t WS_PUV1  = al256(cmax(cmax(WS_END_L0, WS_END_PEER), WS_END_L1));
constexpr size_t WS_PSC1  = WS_PUV1 + (size_t)16384 * 1536;
constexpr size_t WS_NEED  = WS_PSC1 + al256(2 * 16384 * 4);
static_assert(WS_NEED <= (size_t)512 * 1024 * 1024, "workspace plan exceeds 512 MiB");

constexpr int LDS_BYTES = 160 * 1024;

struct Params {
    const float* in[32];
    float* out;
    unsigned char* ws;
};

__device__ __forceinline__ int tid_() { int t = threadIdx.x; asm volatile("" : "+v"(t)); return t; }
__device__ __forceinline__ float bf2f(bf16_t b) { return __uint_as_float((unsigned)b << 16); }
__device__ __forceinline__ bf16_t f2bf(float f) { const __bf16 b = (__bf16)f; return __builtin_bit_cast(bf16_t, b); }
typedef float f32x2_t __attribute__((ext_vector_type(2)));
typedef __bf16 bf16x2_t __attribute__((ext_vector_type(2)));
__device__ __forceinline__ unsigned pack2(float lo, float hi) { const f32x2_t v = {lo, hi}; const bf16x2_t b = __builtin_convertvector(v, bf16x2_t); return __builtin_bit_cast(unsigned, b); }
__device__ __forceinline__ float lo2f(unsigned p) { return __uint_as_float(p << 16); }
__device__ __forceinline__ float hi2f(unsigned p) { return __uint_as_float(p & 0xFFFF0000u); }
__device__ __forceinline__ float sigmoidf_(float x) { return 1.f / (1.f + __expf(-x)); }
__device__ __forceinline__ float siluf_(float x) { return x * sigmoidf_(x); }
__device__ __forceinline__ float gelu_tanh(float x) {
    const float u = 0.7978845608028654f * (x + 0.044715f * x * x * x);
    const float t = 1.f - 2.f / (1.f + __expf(2.f * u));
    return 0.5f * x * (1.f + t);
}
__device__ __forceinline__ float gelu_fast(float x) {
    const float w = __builtin_fmaf(x * x, -0.10294324f, -2.30220819f);
    return x * __builtin_amdgcn_rcpf(1.f + __builtin_amdgcn_exp2f(x * w));
}
__device__ __forceinline__ void lds_barrier() {
    asm volatile("s_waitcnt lgkmcnt(0)" ::: "memory");
    __builtin_amdgcn_s_barrier();
    asm volatile("" ::: "memory");
}
__device__ __forceinline__ float wave_sum(float v) {
#pragma unroll
    for (int o = 32; o > 0; o >>= 1) v += __shfl_xor(v, o, 64);
    return v;
}

__device__ __forceinline__ float wave_sum_dpp(float v) {
    v += __int_as_float(__builtin_amdgcn_update_dpp(0, __float_as_int(v), 0xB1, 0xF, 0xF, true));
    v += __int_as_float(__builtin_amdgcn_update_dpp(0, __float_as_int(v), 0x4E, 0xF, 0xF, true));
    v += __int_as_float(__builtin_amdgcn_update_dpp(0, __float_as_int(v), 0x141, 0xF, 0xF, true));
    v += __int_as_float(__builtin_amdgcn_update_dpp(0, __float_as_int(v), 0x140, 0xF, 0xF, true));
    v += __int_as_float(__builtin_amdgcn_update_dpp(0, __float_as_int(v), 0x142, 0xA, 0xF, false));
    v += __int_as_float(__builtin_amdgcn_update_dpp(0, __float_as_int(v), 0x143, 0xC, 0xF, false));
    return __int_as_float(__builtin_amdgcn_readlane(__float_as_int(v), 63));
}
__device__ __forceinline__ void unpack8(const uint4& p, float* f) {
    f[0] = lo2f(p.x); f[1] = hi2f(p.x); f[2] = lo2f(p.y); f[3] = hi2f(p.y);
    f[4] = lo2f(p.z); f[5] = hi2f(p.z); f[6] = lo2f(p.w); f[7] = hi2f(p.w);
}
__device__ __forceinline__ uint4 pack8(const float* f) {
    uint4 p; p.x = pack2(f[0], f[1]); p.y = pack2(f[2], f[3]); p.z = pack2(f[4], f[5]); p.w = pack2(f[6], f[7]); return p;
}
__device__ __forceinline__ const float* modp(const Params& p, int l, int row, int j) {
    const float* m = (const float*)(p.ws + WS_MOD);
    return m + ((l * 2 + (row >= SEQ ? 1 : 0)) * 6 + j) * 1024;
}

#define LAS __attribute__((address_space(3)))
constexpr int GT_STAGE = 32768;
template <class Epi>
__device__ __forceinline__ void gemm_tile(const bf16_t* __restrict__ A, int lda, int M, const bf16_t* __restrict__ Bt, int ldb, int N, int K,
                                          int row0, int col0, Epi epi, unsigned char* lds_generic) {
    LAS unsigned char* lds = (LAS unsigned char*)lds_generic;
    const int tid = tid_(), lane = tid & 63, wave = __builtin_amdgcn_readfirstlane(tid >> 6);
    const int wm = wave >> 2, wn = wave & 3, r = lane & 31, h = lane >> 5;
    const bf16_t* ga[2]; const bf16_t* gb[2];
#pragma unroll
    for (int i = 0; i < 2; ++i) {
        const int trow = 8 * (wave + 8 * i) + (lane >> 3), kp = (lane & 7) ^ ((trow >> 1) & 7);
        int ra = row0 + trow, rb = col0 + trow; ra = ra < M ? ra : M - 1; rb = rb < N ? rb : N - 1;
        ga[i] = A + (size_t)ra * lda + kp * 8; gb[i] = Bt + (size_t)rb * ldb + kp * 8;
    }
    f32x16 acc0, acc1;
#pragma unroll
    for (int i = 0; i < 16; ++i) { acc0[i] = 0.f; acc1[i] = 0.f; }
    const int nk = K >> 6;
#define GT_ISSUE(kt_) do { const int st_ = ((kt_) & 3) * GT_STAGE; _Pragma("unroll") for (int i_ = 0; i_ < 2; ++i_) { \
        __builtin_amdgcn_global_load_lds((const unsigned*)(ga[i_] + (kt_) * 64), (LAS unsigned*)(lds + st_ + (wave + 8 * i_) * 1024), 16, 0, 0); \
        __builtin_amdgcn_global_load_lds((const unsigned*)(gb[i_] + (kt_) * 64), (LAS unsigned*)(lds + st_ + 16384 + (wave + 8 * i_) * 1024), 16, 0, 0); } } while (0)
    __syncthreads();
    GT_ISSUE(0);
    if (nk > 1) GT_ISSUE(1);
    if (nk > 2) GT_ISSUE(2);
    const int xs = (r >> 1) & 7;
    const int aoff = (wm * 64 + r) * 128, boff = 16384 + (wn * 32 + r) * 128;
#pragma unroll 1
    for (int kt = 0; kt < nk; ++kt) {
        const int ahead = nk - 1 - kt;
        if (ahead >= 2) asm volatile("s_waitcnt vmcnt(8)" ::: "memory");
        else if (ahead == 1) asm volatile("s_waitcnt vmcnt(4)" ::: "memory");
        else asm volatile("s_waitcnt vmcnt(0)" ::: "memory");
        __builtin_amdgcn_s_barrier();
        asm volatile("" ::: "memory");
        if (kt + 3 < nk) GT_ISSUE(kt + 3);
        const LAS unsigned char* sb = lds + (kt & 3) * GT_STAGE;
#pragma unroll
        for (int s = 0; s < 4; ++s) {
            const int ko = ((2 * s + h) ^ xs) * 16;
            const bf16x8 a0 = *(const LAS bf16x8*)(sb + aoff + ko);
            const bf16x8 a1 = *(const LAS bf16x8*)(sb + aoff + 32 * 128 + ko);
            const bf16x8 b  = *(const LAS bf16x8*)(sb + boff + ko);
            acc0 = __builtin_amdgcn_mfma_f32_32x32x16_bf16(a0, b, acc0, 0, 0, 0);
            acc1 = __builtin_amdgcn_mfma_f32_32x32x16_bf16(a1, b, acc1, 0, 0, 0);
        }
    }
#undef GT_ISSUE
    __builtin_amdgcn_s_barrier();
    asm volatile("" ::: "memory");
    {
        LAS float* sc = (LAS float*)lds;
#pragma unroll
        for (int i = 0; i < 16; ++i) {
            const int rr = wm * 64 + (i & 3) + 8 * (i >> 2) + 4 * h;
            sc[rr * 132 + wn * 32 + r] = acc0[i];
            sc[(rr + 32) * 132 + wn * 32 + r] = acc1[i];
        }
    }
    __syncthreads();
    {
        const LAS float* sc = (const LAS float*)lds;
        const int c8 = (tid & 15) * 8, col = col0 + c8;
        if constexpr (Epi::PRE) {
            typename Epi::L ld[4];
#pragma unroll
            for (int ps = 0; ps < 4; ++ps) { const int row = row0 + (tid >> 4) + 32 * ps; if (row < M && col < N) epi.pre(row, col, ld[ps]); }
#pragma unroll
            for (int ps = 0; ps < 4; ++ps) {
                const int rl = (tid >> 4) + 32 * ps, row = row0 + rl;
                const f32x4 v0 = *(const LAS f32x4*)(sc + rl * 132 + c8), v1 = *(const LAS f32x4*)(sc + rl * 132 + c8 + 4);
                if (row < M && col < N) { const float v[8] = {v0[0], v0[1], v0[2], v0[3], v1[0], v1[1], v1[2], v1[3]}; epi.post(row, col, v, ld[ps]); }
            }
        } else {
#pragma unroll
        for (int ps = 0; ps < 4; ++ps) {
            const int rl = (tid >> 4) + 32 * ps, row = row0 + rl;
            const f32x4 v0 = *(const LAS f32x4*)(sc + rl * 132 + c8), v1 = *(const LAS f32x4*)(sc + rl * 132 + c8 + 4);
            if (row < M && col < N) { const float v[8] = {v0[0], v0[1], v0[2], v0[3], v1[0], v1[1], v1[2], v1[3]}; epi(row, col, v); }
        }
        }
    }
}

constexpr int GW_STAGE = 49152;
template <class Epi>
__device__ __forceinline__ void gemm_tile_n256(const bf16_t* __restrict__ A, int lda, int M, const bf16_t* __restrict__ Bt, int ldb, int N, int K,
                                               int row0, int col0, Epi epi, unsigned char* lds_generic) {
    LAS unsigned char* lds = (LAS unsigned char*)lds_generic;
    const int tid = tid_(), lane = tid & 63, wave = __builtin_amdgcn_readfirstlane(tid >> 6);
    const int wm = wave >> 2, wn = wave & 3, r = lane & 31, h = lane >> 5;
    const bf16_t* ga[2]; const bf16_t* gb[4];
#pragma unroll
    for (int i = 0; i < 4; ++i) {
        const int trow = 8 * (wave + 8 * i) + (lane >> 3), kp = (lane & 7) ^ ((trow >> 1) & 7);
        int ra = row0 + trow, rb = col0 + trow; ra = ra < M ? ra : M - 1; rb = rb < N ? rb : N - 1;
        if (i < 2) ga[i] = A + (size_t)ra * lda + kp * 8;
        gb[i] = Bt + (size_t)rb * ldb + kp * 8;
    }
    f32x16 acc[2][2];
#pragma unroll
    for (int a = 0; a < 2; ++a)
#pragma unroll
        for (int b = 0; b < 2; ++b)
#pragma unroll
            for (int i = 0; i < 16; ++i) acc[a][b][i] = 0.f;
    const int nk = K >> 6;
#define GW_ISSUE(kt_) do { const int st_ = ((kt_) % 3) * GW_STAGE; \
        _Pragma("unroll") for (int i_ = 0; i_ < 2; ++i_) __builtin_amdgcn_global_load_lds((const unsigned*)(ga[i_] + (kt_) * 64), (LAS unsigned*)(lds + st_ + (wave + 8 * i_) * 1024), 16, 0, 0); \
        _Pragma("unroll") for (int i_ = 0; i_ < 4; ++i_) __builtin_amdgcn_global_load_lds((const unsigned*)(gb[i_] + (kt_) * 64), (LAS unsigned*)(lds + st_ + 16384 + (wave + 8 * i_) * 1024), 16, 0, 0); } while (0)
    __syncthreads();
    GW_ISSUE(0);
    if (nk > 1) GW_ISSUE(1);
    const int xs = (r >> 1) & 7;
    const int aoff = (wm * 64 + r) * 128, boff = 16384 + (wn * 64 + r) * 128;
#pragma unroll 1
    for (int kt = 0; kt < nk; ++kt) {
        if (kt + 1 < nk) asm volatile("s_waitcnt vmcnt(6)" ::: "memory");
        else asm volatile("s_waitcnt vmcnt(0)" ::: "memory");
        __builtin_amdgcn_s_barrier();
        asm volatile("" ::: "memory");
        if (kt + 2 < nk) GW_ISSUE(kt + 2);
        const LAS unsigned char* sb = lds + (kt % 3) * GW_STAGE;
#pragma unroll
        for (int s = 0; s < 4; ++s) {
            const int ko = ((2 * s + h) ^ xs) * 16;
            const bf16x8 a0 = *(const LAS bf16x8*)(sb + aoff + ko);
            const bf16x8 a1 = *(const LAS bf16x8*)(sb + aoff + 32 * 128 + ko);
            const bf16x8 b0 = *(const LAS bf16x8*)(sb + boff + ko);
            const bf16x8 b1 = *(const LAS bf16x8*)(sb + boff + 32 * 128 + ko);
            acc[0][0] = __builtin_amdgcn_mfma_f32_32x32x16_bf16(a0, b0, acc[0][0], 0, 0, 0);
            acc[1][0] = __builtin_amdgcn_mfma_f32_32x32x16_bf16(a1, b0, acc[1][0], 0, 0, 0);
            acc[0][1] = __builtin_amdgcn_mfma_f32_32x32x16_bf16(a0, b1, acc[0][1], 0, 0, 0);
            acc[1][1] = __builtin_amdgcn_mfma_f32_32x32x16_bf16(a1, b1, acc[1][1], 0, 0, 0);
        }
    }
#undef GW_ISSUE
    __builtin_amdgcn_s_barrier();
    asm volatile("" ::: "memory");
    {
        LAS float* sc = (LAS float*)lds;
#pragma unroll
        for (int a = 0; a < 2; ++a)
#pragma unroll
            for (int b = 0; b < 2; ++b)
#pragma unroll
                for (int i = 0; i < 16; ++i) {
                    const int rr = wm * 64 + a * 32 + (i & 3) + 8 * (i >> 2) + 4 * h;
                    sc[rr * 260 + wn * 64 + b * 32 + r] = acc[a][b][i];
                }
    }
    __syncthreads();
    {
        const LAS float* sc = (const LAS float*)lds;
        const int c8 = (tid & 31) * 8, col = col0 + c8;
#pragma unroll
        for (int ps = 0; ps < 8; ++ps) {
            const int rl = (tid >> 5) + 16 * ps, row = row0 + rl;
            const f32x4 v0 = *(const LAS f32x4*)(sc + rl * 260 + c8), v1 = *(const LAS f32x4*)(sc + rl * 260 + c8 + 4);
            if (row < M && col < N) { const float v[8] = {v0[0], v0[1], v0[2], v0[3], v1[0], v1[1], v1[2], v1[3]}; epi(row, col, v); }
        }
    }
}

namespace pg8 {
#define PG8_LAS __attribute__((address_space(3)))
typedef unsigned short bf16_t;
typedef short bf16x8 __attribute__((ext_vector_type(8)));
typedef float f32x4 __attribute__((ext_vector_type(4)));
typedef unsigned u32x4 __attribute__((ext_vector_type(4)));
constexpr int BM = 256, BK = 64, HALF = 128, HTB = HALF * BK * 2  , STAGE_BYTES = 8 * HTB, NXCD = 8, WGM = 4;

__host__ __device__ __forceinline__ int lds_byte(int r, int c) { const int st = (r >> 4) * 2 + (c >> 5), rr = r & 15, cc = c & 31, ob = rr * 64 + cc * 2; return st * 1024 + (ob ^ (((ob >> 9) & 1) << 5)); }
__host__ __device__ __forceinline__ void stage_rc(int b, int& R, int& C) { const int st = b / 1024, sb = b % 1024, swz = sb ^ (((sb >> 9) & 1) << 5); R = (st >> 1) * 16 + swz / 64; C = (st & 1) * 32 + (swz % 64) / 2; }
__host__ __device__ __forceinline__ int perm32(int rho) { const int n = rho >> 4, i = rho & 15; return 8 * (i >> 2) + 4 * n + (i & 3); }

struct Unit { int pm, pn; };
struct Gemm { const bf16_t* A; const bf16_t* Bt; int M, N, K; };

struct StaticOrder {
    int nM, nN, nwg, G, c;
    __host__ __device__ void init(int M, int N, int G_, int c_) { nM = M / BM; nN = N / BM; nwg = nM * nN; G = G_; c = c_; }
    __host__ __device__ bool next(int i, Unit& u) const {
        const long L = (long)i * G + c; if (L >= nwg) return false;
        int wgid = (int)L; { const int q = nwg / NXCD, r = nwg % NXCD, xcd = wgid % NXCD, off = wgid / NXCD; wgid = (xcd < r ? xcd * (q + 1) : r * (q + 1) + (xcd - r) * q) + off; }
        const int nig = WGM * nN, gid = wgid / nig, fm = gid * WGM, gsz = (nM - fm) < WGM ? (nM - fm) : WGM;
        u.pm = fm + ((wgid % nig) % gsz); u.pn = (wgid % nig) / gsz; return true;
    }
    __device__ __forceinline__ void a_ready(const Unit&) const {}
    __device__ __forceinline__ void done(const Unit&) const {}
};
template <class Epi, class Sched, bool STAMP = false>
__device__ __forceinline__ void gemm_phase(PG8_LAS unsigned char* lds, const Gemm g, const Sched& S, const Epi& E, unsigned long long* stamps) {
    const int tid = tid_(), wid = __builtin_amdgcn_readfirstlane(tid >> 6), lane = tid & 63, wr = wid >> 2, wc = wid & 3, fr = lane & 15, fq = lane >> 4;
    const int K = g.K, nt = K / BK;
    int ts_lo = 0, ts_hi = 0, nts = 0; const unsigned long long rt_entry = STAMP ? (unsigned long long)0ull : 0ull;
#define PG8_STAMP() do { if (STAMP && wid == 0 && nts < 64) { const unsigned long long _c = (unsigned long long)0ull; \
        ts_lo = (lane == nts) ? (int)(unsigned)_c : ts_lo; ts_hi = (lane == nts) ? (int)(unsigned)(_c >> 32) : ts_hi; ++nts; } } while (0)
    PG8_STAMP();
    unsigned voffA[2], voffB[2];
#pragma unroll
    for (int i = 0; i < 2; ++i) { int R, C; stage_rc(tid * 16 + i * 8192, R, C); const int Rb = Epi::PERM ? ((R & ~31) + perm32(R & 31)) : R;
        voffA[i] = (unsigned)(R * K + C) * 2u; voffB[i] = (unsigned)(Rb * K + C) * 2u; }
    const size_t kstep = (size_t)(BK * 2);
    const size_t hstep = (size_t)HALF * K * 2;
    const size_t tstep = 2 * hstep;
    const unsigned ldsw = (unsigned)wid * 1024u;
    const int aoff = lds_byte(wr * 64 + fr, fq * 8), boff = lds_byte(wc * 32 + fr, fq * 8);
#define PG8_SA(b, h) (((b) * 2 + (h)) * HTB)
#define PG8_SB(b, h) ((4 + (b) * 2 + (h)) * HTB)
#define PG8_STAGE(bufoff, gbase, voff) do { _Pragma("unroll") for (int _i = 0; _i < 2; ++_i) { unsigned vo_ = (voff)[_i]; asm volatile("" : "+v"(vo_));   \
        __builtin_amdgcn_global_load_lds((const unsigned*)((const char*)(gbase) + vo_), (PG8_LAS unsigned*)(lds + (bufoff) + ldsw + _i * 8192), 16, 0, 0); } } while (0)
#define PG8_LDA(dst, b, h) do { _Pragma("unroll") for (int m = 0; m < 4; ++m) _Pragma("unroll") for (int k = 0; k < 2; ++k) dst[m][k] = *(const PG8_LAS bf16x8*)(lds + PG8_SA(b, h) + aoff + m * 2048 + k * 1024); } while (0)
#define PG8_LDB(dst, b, h) do { _Pragma("unroll") for (int n = 0; n < 2; ++n) _Pragma("unroll") for (int k = 0; k < 2; ++k) dst[n][k] = *(const PG8_LAS bf16x8*)(lds + PG8_SB(b, h) + boff + n * 2048 + k * 1024); } while (0)
#define PG8_MMA(ai, bj, At, Bt) do { __builtin_amdgcn_s_setprio(1); _Pragma("unroll") for (int m = 0; m < 4; ++m) _Pragma("unroll") for (int n = 0; n < 2; ++n) _Pragma("unroll") for (int k = 0; k < 2; ++k) \
        acc[ai][bj][m][n] = __builtin_amdgcn_mfma_f32_16x16x32_bf16(Bt[n][k], At[m][k], acc[ai][bj][m][n], 0, 0, 0); __builtin_amdgcn_s_setprio(0); } while (0)
#define PG8_WAIT_V(n) asm volatile("s_waitcnt vmcnt(" #n ")" ::: "memory")
#define PG8_WAIT_L(n) asm volatile("s_waitcnt lgkmcnt(" #n ")" ::: "memory")
#define PG8_BAR __builtin_amdgcn_s_barrier()
#define PG8_SCHED __builtin_amdgcn_sched_barrier(0)
    Unit cur, nxt; int ui = 0;
    if (!S.next(0, cur)) return;
    f32x4 acc[2][2][4][2];
#pragma unroll
    for (int a = 0; a < 2; ++a)
#pragma unroll
        for (int b = 0; b < 2; ++b)
#pragma unroll
            for (int m = 0; m < 4; ++m)
#pragma unroll
                for (int n = 0; n < 2; ++n) acc[a][b][m][n] = (f32x4){0.f, 0.f, 0.f, 0.f};
    bf16x8 At[4][2], B0[2][2], B1[2][2];
    const char* cA = (const char*)g.A + (size_t)cur.pm * tstep; const char* cB = (const char*)g.Bt + (size_t)cur.pn * tstep;
    S.a_ready(cur);
    PG8_STAGE(PG8_SB(0, 0), cB, voffB); PG8_STAGE(PG8_SA(0, 0), cA, voffA); PG8_STAGE(PG8_SB(0, 1), cB + hstep, voffB); PG8_STAGE(PG8_SA(0, 1), cA + hstep, voffA);
    if (wr == 1) PG8_BAR;
    PG8_WAIT_V(4); PG8_BAR;
    PG8_STAGE(PG8_SB(1, 0), cB + kstep, voffB); PG8_STAGE(PG8_SA(1, 0), cA + kstep, voffA); PG8_STAGE(PG8_SB(1, 1), cB + hstep + kstep, voffB);
    PG8_WAIT_V(6); PG8_BAR;
    PG8_STAMP();
    for (;;) {
        const bool has_next = S.next(ui + 1, nxt);
        const char* nA = has_next ? (const char*)g.A + (size_t)nxt.pm * tstep : cA; const char* nB = has_next ? (const char*)g.Bt + (size_t)nxt.pn * tstep : cB;
        for (int t = 0; t < nt; t += 2) {
            const bool last = (t == nt - 2);
            const char* a1 = cA + (size_t)(t + 1) * kstep;
            const char* a2 = last ? nA : cA + (size_t)(t + 2) * kstep; const char* b2 = last ? nB : cB + (size_t)(t + 2) * kstep;
            const char* a3 = a2 + kstep; const char* b3 = b2 + kstep;
            if (last && has_next) S.a_ready(nxt);
            PG8_LDB(B0, 0, 0); PG8_SCHED; PG8_LDA(At, 0, 0); PG8_STAGE(PG8_SA(1, 1), a1 + hstep, voffA);
            PG8_WAIT_L(8); PG8_BAR; PG8_WAIT_L(0); PG8_MMA(0, 0, At, B0); PG8_BAR; PG8_SCHED;
            PG8_LDB(B1, 0, 1); PG8_STAGE(PG8_SB(0, 0), b2, voffB);
            PG8_BAR; PG8_WAIT_L(0); PG8_MMA(0, 1, At, B1); PG8_BAR;
            PG8_LDA(At, 0, 1); PG8_STAGE(PG8_SA(0, 0), a2, voffA);
            PG8_BAR; PG8_WAIT_L(0); PG8_MMA(1, 0, At, B0); PG8_BAR; PG8_SCHED;
            PG8_STAGE(PG8_SB(0, 1), b2 + hstep, voffB);
            PG8_WAIT_V(6); PG8_BAR; PG8_MMA(1, 1, At, B1); PG8_BAR;
            PG8_LDB(B0, 1, 0); PG8_SCHED; PG8_LDA(At, 1, 0); PG8_STAGE(PG8_SA(0, 1), a2 + hstep, voffA);
            PG8_WAIT_L(8); PG8_BAR; PG8_WAIT_L(0); PG8_MMA(0, 0, At, B0); PG8_BAR; PG8_SCHED;
            PG8_LDB(B1, 1, 1); PG8_STAGE(PG8_SB(1, 0), b3, voffB);
            PG8_BAR; PG8_WAIT_L(0); PG8_MMA(0, 1, At, B1); PG8_BAR;
            PG8_LDA(At, 1, 1); PG8_STAGE(PG8_SA(1, 0), a3, voffA);
            PG8_BAR; PG8_WAIT_L(0); PG8_MMA(1, 0, At, B0); PG8_BAR; PG8_SCHED;
            PG8_STAGE(PG8_SB(1, 1), b3 + hstep, voffB);
            PG8_WAIT_V(6); PG8_BAR; PG8_MMA(1, 1, At, B1); PG8_BAR;
        }
        PG8_STAMP();
        if constexpr (!Epi::AFTER_DRAIN) { E(acc, cur, wr, wc, fr, fq); S.done(cur); }
        PG8_STAMP();
        if (!has_next) break;
#pragma unroll
        for (int a = 0; a < 2; ++a)
#pragma unroll
            for (int b = 0; b < 2; ++b)
#pragma unroll
                for (int m = 0; m < 4; ++m)
#pragma unroll
                    for (int n = 0; n < 2; ++n) acc[a][b][m][n] = (f32x4){0.f, 0.f, 0.f, 0.f};
        cur = nxt; cA = nA; cB = nB; ++ui;
    }
    PG8_WAIT_V(0);
    if (wr == 0) PG8_BAR;
    PG8_BAR;
    if constexpr (Epi::AFTER_DRAIN) { E.fused(acc, cur, wr, wc, fr, fq, lds, wid, lane); S.done(cur); }
    PG8_STAMP();
    if (STAMP && wid == 0) { stamps[lane] = lane < nts ? (((unsigned long long)(unsigned)ts_hi << 32) | (unsigned)ts_lo) : 0ull;
        if (lane == 62) stamps[62] = rt_entry; if (lane == 63) stamps[63] = (unsigned long long)0ull; }
#undef PG8_STAMP
#undef PG8_SA
#undef PG8_SB
#undef PG8_STAGE
#undef PG8_LDA
#undef PG8_LDB
#undef PG8_MMA
#undef PG8_WAIT_V
#undef PG8_WAIT_L
#undef PG8_BAR
#undef PG8_SCHED
}
}

template <class F> struct EpiAdapt {
    static constexpr bool PERM = true, AFTER_DRAIN = false;
    F f;
    __device__ __forceinline__ void operator()(const pg8::f32x4 (&acc)[2][2][4][2], const pg8::Unit& u, int wr, int wc, int fr, int fq) const {
        if constexpr (F::PRE) {
#pragma unroll
            for (int ai = 0; ai < 2; ++ai)
#pragma unroll
                for (int mh = 0; mh < 2; ++mh) {
                    typename F::L ld[4];
#pragma unroll
                    for (int j = 0; j < 4; ++j) f.pre(u.pm * 256 + ai * 128 + wr * 64 + (2 * mh + (j >> 1)) * 16 + fr, u.pn * 256 + (j & 1) * 128 + wc * 32 + 8 * fq, ld[j]);
#pragma unroll
                    for (int j = 0; j < 4; ++j) {
                        const int m = 2 * mh + (j >> 1), bj = j & 1;
                        const float v[8] = {acc[ai][bj][m][0][0], acc[ai][bj][m][0][1], acc[ai][bj][m][0][2], acc[ai][bj][m][0][3],
                                            acc[ai][bj][m][1][0], acc[ai][bj][m][1][1], acc[ai][bj][m][1][2], acc[ai][bj][m][1][3]};
                        f.post(u.pm * 256 + ai * 128 + wr * 64 + m * 16 + fr, u.pn * 256 + bj * 128 + wc * 32 + 8 * fq, v, ld[j]);
                    }
                    asm volatile("" ::: "memory");
                }
            return;
        }
#pragma unroll
        for (int ai = 0; ai < 2; ++ai)
#pragma unroll
            for (int m = 0; m < 4; ++m) {
                const int row = u.pm * 256 + ai * 128 + wr * 64 + m * 16 + fr;
#pragma unroll
                for (int bj = 0; bj < 2; ++bj) {
                    const int col = u.pn * 256 + bj * 128 + wc * 32 + 8 * fq;
                    const float v[8] = {acc[ai][bj][m][0][0], acc[ai][bj][m][0][1], acc[ai][bj][m][0][2], acc[ai][bj][m][0][3],
                                        acc[ai][bj][m][1][0], acc[ai][bj][m][1][1], acc[ai][bj][m][1][2], acc[ai][bj][m][1][3]};
                    f(row, col, v);
                    asm volatile("" ::: "memory");
                }
            }
    }
};
template <class F>
__device__ __forceinline__ void gemm_big(const bf16_t* A, const bf16_t* Bt, int M, int N, int K, F f, unsigned char* lds_generic) {
    __syncthreads();
    pg8::Gemm g{A, Bt, M, N, K};
    pg8::StaticOrder S; S.init(M, N, (int)gridDim.x, (int)blockIdx.x);
    EpiAdapt<F> E{f};
    pg8::gemm_phase<EpiAdapt<F>, pg8::StaticOrder, false>((LAS unsigned char*)lds_generic, g, S, E, nullptr);
    __syncthreads();
}

__device__ __forceinline__ void p0_adaln(const Params& p, int item, unsigned char* lds) {
    const int l = item / 96, cb = item % 96, tid = tid_();
    const int kq = tid >> 4, c4 = tid & 15;
    const float* W = p.in[4] + (size_t)l * 1024 * 6144 + cb * 64 + c4 * 4;
    const float* c = p.in[1]; const float* cc = p.in[3];
    float al[4] = {0, 0, 0, 0}, ac[4] = {0, 0, 0, 0};
    float* sS = (float*)lds;
    float* red = sS + 2048;
    __syncthreads();
    for (int e = tid; e < 1024; e += NTHREADS) { sS[e] = siluf_(c[e]); sS[1024 + e] = siluf_(cc[e]); }
    __syncthreads();
#pragma unroll 1
    for (int k0 = kq; k0 < 1024; k0 += 32 * 8) {
        float4 w[8];
#pragma unroll
        for (int j = 0; j < 8; ++j) w[j] = *(const float4*)(W + (size_t)(k0 + 32 * j) * 6144);
#pragma unroll
        for (int j = 0; j < 8; ++j) {
            const float sl = sS[k0 + 32 * j], sc = sS[1024 + k0 + 32 * j];
            al[0] += sl * w[j].x; al[1] += sl * w[j].y; al[2] += sl * w[j].z; al[3] += sl * w[j].w;
            ac[0] += sc * w[j].x; ac[1] += sc * w[j].y; ac[2] += sc * w[j].z; ac[3] += sc * w[j].w;
        }
    }
#pragma unroll
    for (int e = 0; e < 4; ++e) { red[(kq * 2 + 0) * 64 + c4 * 4 + e] = al[e]; red[(kq * 2 + 1) * 64 + c4 * 4 + e] = ac[e]; }
    __syncthreads();
    if (tid < 128) {
        const int s = tid >> 6, cidx = tid & 63;
        float sum = 0.f;
        for (int q = 0; q < 32; ++q) sum += red[(q * 2 + s) * 64 + cidx];
        const int col = cb * 64 + cidx;
        sum += p.in[5][l * 6144 + col];
        ((float*)(p.ws + WS_MOD))[(l * 2 + s) * 6144 + col] = sum;
    }
}
__device__ __forceinline__ void p0_transpose_load(const float* __restrict__ src, int N, int tile, float (&v)[8]) {
    const int ntn = (N + 63) / 64, tk = tile / ntn, tn = tile % ntn, tid = tid_();
#pragma unroll
    for (int q = 0; q < 8; ++q) {
        const int e = tid + q * NTHREADS, kk = e >> 6, nn = e & 63; const int n = tn * 64 + nn;
        const float t_ = src[(size_t)(tk * 64 + kk) * N + (n < N ? n : N - 1)];
        v[q] = n < N ? t_ : 0.f;
    }
}
__device__ __forceinline__ void p0_transpose_finish(int K, int N, bf16_t* __restrict__ dst, int tile, const float (&v)[8], unsigned char* lds) {
    const int ntn = (N + 63) / 64, tk = tile / ntn, tn = tile % ntn, tid = tid_();
    float* s = (float*)lds;
    lds_barrier();
#pragma unroll
    for (int q = 0; q < 8; ++q) { const int e = tid + q * NTHREADS; s[(e >> 6) * 65 + (e & 63)] = v[q]; }
    lds_barrier();
    {
        const int nn = tid >> 3, kg = (tid & 7) * 8; const int n = tn * 64 + nn;
        if (n < N) {
            float f[8];
#pragma unroll
            for (int e = 0; e < 8; ++e) f[e] = s[(kg + e) * 65 + nn];
            *(uint4*)(dst + (size_t)n * K + tk * 64 + kg) = pack8(f);
        }
    }
}
__device__ __forceinline__ void p0_transpose(const float* __restrict__ src, int K, int N, bf16_t* __restrict__ dst, int tile, unsigned char* lds) {
    float v[8];
    p0_transpose_load(src, N, tile, v);
    p0_transpose_finish(K, N, dst, tile, v, lds);
}
__device__ __forceinline__ void p0_transpose_run(const float* __restrict__ src, int K, int N, bf16_t* __restrict__ dst, int first, int last, int st, unsigned char* lds) {
    if (first >= last) return;
    float va[8], vb[8];
    p0_transpose_load(src, N, first, va);
#pragma unroll 1
    for (int t = first; t < last; t += st) {
        const int nx = t + st < last ? t + st : t;
        p0_transpose_load(src, N, nx, vb);
        p0_transpose_finish(K, N, dst, t, va, lds);
#pragma unroll
        for (int q = 0; q < 8; ++q) va[q] = vb[q];
    }
}
__device__ __forceinline__ void cvt_chunk(const float* __restrict__ src, bf16_t* __restrict__ dst, size_t item) {
    const size_t o = item * 4096 + (size_t)tid_() * 8;
    const float4 a = *(const float4*)(src + o), b = *(const float4*)(src + o + 4);
    uint4 q; q.x = pack2(a.x, a.y); q.y = pack2(a.z, a.w); q.z = pack2(b.x, b.y); q.w = pack2(b.z, b.w);
    *(uint4*)(dst + o) = q;
}
typedef float v32f_t __attribute__((ext_vector_type(32)));
typedef _Float16 v32h_t __attribute__((ext_vector_type(32)));
typedef __bf16 v32b_t __attribute__((ext_vector_type(32)));
typedef __bf16 v2b_t __attribute__((ext_vector_type(2)));
typedef unsigned v6u_t __attribute__((ext_vector_type(6)));
struct __attribute__((packed, aligned(8))) U6 { unsigned a, b, c, d, e, f; };
constexpr int PREC = 1536;
__device__ __forceinline__ void peer_tables_item(const Params& p, int item, int l) {
    const int lane = tid_() & 63, ex = item * 8 + (tid_() >> 6), hv = lane >> 5, blk = lane & 31;
    const float* src = p.in[hv ? 30 : 29] + ((size_t)l * 16384 + ex) * 1024 + blk * 32;
    float4 u[8]; float am = 0.f;
#pragma unroll
    for (int q = 0; q < 8; ++q) u[q] = *(const float4*)(src + q * 4);
#pragma unroll
    for (int q = 0; q < 8; ++q) am = fmaxf(am, fmaxf(fmaxf(fabsf(u[q].x), fabsf(u[q].y)), fmaxf(fabsf(u[q].z), fabsf(u[q].w))));
#pragma unroll
    for (int o = 16; o > 0; o >>= 1) am = fmaxf(am, __shfl_xor(am, o, 64));
    const float sc = am > 0.f ? 7.0f / am : 1.f;
    v32h_t x;
#pragma unroll
    for (int q = 0; q < 8; ++q) { x[4 * q + 0] = (_Float16)(u[q].x * sc); x[4 * q + 1] = (_Float16)(u[q].y * sc); x[4 * q + 2] = (_Float16)(u[q].z * sc); x[4 * q + 3] = (_Float16)(u[q].w * sc); }
    const v6u_t pk = __builtin_amdgcn_cvt_scalef32_pk32_fp6_f16(x, 1.0f);
    U6 o; o.a = pk[0]; o.b = pk[1]; o.c = pk[2]; o.d = pk[3]; o.e = pk[4]; o.f = pk[5];
    *(U6*)(p.ws + (l ? WS_PUV1 : WS_PUV) + (size_t)ex * PREC + hv * 768 + blk * 24) = o;
    if (blk == 0) { float* psc = (float*)(p.ws + (l ? WS_PSC1 : WS_PSC)); psc[hv * 16384 + ex] = am > 0.f ? am / 7.0f : 1.f; }
}

__device__ __forceinline__ void sincos_d(double x, double& s, double& c) {
    const double TWO_OVER_PI = 0.63661977236758134308, PIO2_HI = 1.57079632679489655800e+00, PIO2_LO = 6.12323399573676603587e-17;
    const double kf = rint(x * TWO_OVER_PI);
    const double y = (x - kf * PIO2_HI) - kf * PIO2_LO;
    const double y2 = y * y;
    double sp = -1.0 / 1307674368000.0;
    sp = sp * y2 + 1.0 / 6227020800.0; sp = sp * y2 - 1.0 / 39916800.0; sp = sp * y2 + 1.0 / 362880.0; sp = sp * y2 - 1.0 / 5040.0;
    sp = sp * y2 + 1.0 / 120.0; sp = sp * y2 - 1.0 / 6.0; sp = sp * y2 + 1.0; sp *= y;
    double cp = 1.0 / 20922789888000.0;
    cp = cp * y2 - 1.0 / 87178291200.0; cp = cp * y2 + 1.0 / 479001600.0; cp = cp * y2 - 1.0 / 3628800.0; cp = cp * y2 + 1.0 / 40320.0;
    cp = cp * y2 - 1.0 / 720.0; cp = cp * y2 + 1.0 / 24.0; cp = cp * y2 - 0.5; cp = cp * y2 + 1.0;
    const int q = ((int)kf) & 3;
    s = (q == 0) ? sp : (q == 1) ? cp : (q == 2) ? -sp : -cp;
    c = (q == 0) ? cp : (q == 1) ? -sp : (q == 2) ? -cp : sp;
}
__device__ __forceinline__ void p0_s5_tables(const Params& p, int item4, unsigned char* lds) {
    const int item = item4 >> 2, qt = item4 & 3;
    const int di = item >> 5, g = item & 31, tid = tid_();
    float2* apw = (float2*)lds;
    float2* Bb = apw + 64 * 65;
    float2* Cc = Bb + 64 * 16;
    __syncthreads();
    {
        const int pp = tid & 63, k = tid >> 6;
        const int pidx = (di * 32 + g) * 64 + pp;
        float lr = p.in[10][pidx]; lr = lr < -1e-4f ? lr : -1e-4f;
        const float li = p.in[11][pidx];
        const float dt = expf(p.in[12][di * 32 + g]);
        const double mag = (double)expf(lr * dt);
        double sn, cs; sincos_d((double)li * (double)dt, sn, cs);
        const double are = mag * cs, aim = mag * sn;
        double sk, ck; sincos_d((double)li * (double)dt * (double)(8 * k), sk, ck);
        const double mk = (double)expf(lr * dt * (float)(8 * k));
        double pr = mk * ck, pi_ = mk * sk;
        const int nt = k == 7 ? 9 : 8;
        for (int t = 0; t < nt; ++t) {
            apw[pp * 65 + 8 * k + t] = make_float2((float)pr, (float)pi_);
            if (qt == 0 && 8 * k + t == 64) ((float2*)(p.ws + WS_A64))[(di * 32 + g) * 64 + pp] = make_float2((float)pr, (float)pi_);
            const double nr = pr * are - pi_ * aim, ni = pr * aim + pi_ * are; pr = nr; pi_ = ni;
        }
        const double den = (double)lr * lr + (double)li * li;
        const double fre = ((are - 1.0) * lr + aim * li) / den, fim = (aim * lr - (are - 1.0) * li) / den;
#pragma unroll
        for (int h2 = 0; h2 < 2; ++h2) {
            const int hh = 2 * k + h2;
            const double br = p.in[13][(size_t)pidx * 16 + hh], bi = p.in[14][(size_t)pidx * 16 + hh];
            Bb[pp * 16 + hh] = make_float2((float)(fre * br - fim * bi), (float)(fre * bi + fim * br));
        }
    }
    for (int e = tid; e < 1024; e += NTHREADS) {
        const size_t gi = ((size_t)(di * 32 + g) * 16) * 64 + e;
        Cc[(e >> 6) * 65 + (e & 63)] = make_float2(p.in[15][gi], p.in[16][gi]);
    }
    __syncthreads();
    float* ktab = (float*)(p.ws + WS_KTAB) + (size_t)(di * 32 + g) * 64 * 256;
    {
        const int tau = qt * 16 + (tid >> 5), hh = (tid >> 1) & 15, h0 = (tid & 1) * 8;
        float acc[8];
#pragma unroll
        for (int e = 0; e < 8; ++e) acc[e] = 0.f;
#pragma unroll 4
        for (int pp = 0; pp < 64; ++pp) {
            const float2 a = apw[pp * 65 + tau], c = Cc[hh * 65 + pp];
            const float cr = c.x * a.x - c.y * a.y, ci = c.x * a.y + c.y * a.x;
            const float4* bp = (const float4*)(Bb + pp * 16 + h0);
#pragma unroll
            for (int q = 0; q < 4; ++q) { const float4 b = bp[q]; acc[2 * q] += cr * b.x - ci * b.y; acc[2 * q + 1] += cr * b.z - ci * b.w; }
        }
        float* kd = ktab + tau * 256 + hh * 16 + h0;
        *(float4*)kd = make_float4(acc[0], acc[1], acc[2], acc[3]); *(float4*)(kd + 4) = make_float4(acc[4], acc[5], acc[6], acc[7]);
    }
    bf16_t* ms5 = (bf16_t*)(p.ws + WS_MS5) + (size_t)g * 1280 * 1024;
    for (int t = qt * 4096 + tid; t < (qt + 1) * 4096; t += NTHREADS) {
        const int row = t >> 7, k8 = t & 127; const int ri = row >> 6, pp = row & 63, j = k8 >> 1, h0 = (k8 & 1) * 8;
        const float2 a = apw[pp * 65 + (di == 0 ? 63 - j : j)];
        float f[8];
#pragma unroll
        for (int e = 0; e < 8; ++e) { const float2 b = Bb[pp * 16 + h0 + e]; f[e] = ri == 0 ? (a.x * b.x - a.y * b.y) : (a.x * b.y + a.y * b.x); }
        *(uint4*)(ms5 + (size_t)(1024 + di * 128 + row) * 1024 + k8 * 8) = pack8(f);
    }
    bf16_t* o5 = (bf16_t*)(p.ws + WS_O5) + (size_t)g * 1024 * 256;
    for (int t = qt * 4096 + tid; t < (qt + 1) * 4096; t += NTHREADS) {
        const int n = t >> 4, q = t & 15; const int ri = q >> 3, p0 = (q & 7) * 8, i = n >> 4, hh = n & 15;
        float f[8];
#pragma unroll
        for (int e = 0; e < 8; ++e) {
            const float2 a = apw[(p0 + e) * 65 + (di == 0 ? i + 1 : 64 - i)], c = Cc[hh * 65 + p0 + e];
            f[e] = ri == 0 ? (c.x * a.x - c.y * a.y) : -(c.x * a.y + c.y * a.x);
        }
        *(uint4*)(o5 + (size_t)n * 256 + di * 128 + ri * 64 + p0) = pack8(f);
    }
}

template <bool SRC_BF16>
__device__ __forceinline__ void norm_mod_row(const void* __restrict__ srcv, const float* __restrict__ g, const float* __restrict__ shift,
                                             const float* __restrict__ scale, bf16_t* __restrict__ dst, int lane) {
    float4 v[4]; float ss = 0.f;
#pragma unroll
    for (int k = 0; k < 4; ++k) {
        if (SRC_BF16) { const uint2 q = *(const uint2*)((const bf16_t*)srcv + k * 256 + lane * 4); v[k] = make_float4(lo2f(q.x), hi2f(q.x), lo2f(q.y), hi2f(q.y)); }
        else v[k] = *(const float4*)((const float*)srcv + k * 256 + lane * 4);
        ss += v[k].x * v[k].x + v[k].y * v[k].y + v[k].z * v[k].z + v[k].w * v[k].w;
    }
    ss = wave_sum(ss);
    const float rs = rsqrtf(ss * (1.f / 1024.f) + 1e-6f);
#pragma unroll
    for (int k = 0; k < 4; ++k) {
        const int c = k * 256 + lane * 4;
        const float4 gg = *(const float4*)(g + c), sh = *(const float4*)(shift + c), sc = *(const float4*)(scale + c);
        uint2 o;
        o.x = pack2(v[k].x * rs * gg.x * (1.f + sc.x) + sh.x, v[k].y * rs * gg.y * (1.f + sc.y) + sh.y);
        o.y = pack2(v[k].z * rs * gg.z * (1.f + sc.z) + sh.z, v[k].w * rs * gg.w * (1.f + sc.w) + sh.w);
        *(uint2*)(dst + c) = o;
    }
}
__device__ __forceinline__ void norm_rows_item(const Params& p, int item, int l, const float* g, int js, bool from_inputs) {
    const int row = item * 8 + (tid_() >> 6), lane = tid_() & 63;
    bf16_t* dst = (bf16_t*)(p.ws + WS_ACT) + (size_t)row * 1024;
    if (from_inputs) norm_mod_row<false>(row < SEQ ? p.in[0] + (size_t)row * 1024 : p.in[2] + (size_t)(row - SEQ) * 1024, g, modp(p, l, row, js), modp(p, l, row, js + 1), dst, lane);
    else norm_mod_row<true>((const bf16_t*)(p.ws + WS_H) + (size_t)row * 1024, g, modp(p, l, row, js), modp(p, l, row, js + 1), dst, lane);
}
__device__ __forceinline__ void norm_rows_batch8(const Params& p, int first, int last, int st, int l, const float* g, int js) {
    const int wave = tid_() >> 6, lane = tid_() & 63;
    float4 gs[4], sh[4];
    {
        const float* shp = modp(p, l, 0, js); const float* scp = modp(p, l, 0, js + 1);
#pragma unroll
        for (int k = 0; k < 4; ++k) {
            const int c = k * 256 + lane * 4;
            const float4 gg = *(const float4*)(g + c), sc = *(const float4*)(scp + c);
            gs[k] = make_float4(gg.x * (1.f + sc.x), gg.y * (1.f + sc.y), gg.z * (1.f + sc.z), gg.w * (1.f + sc.w));
            sh[k] = *(const float4*)(shp + c);
        }
    }
#pragma unroll 1
    for (int it0 = first; it0 < last; it0 += 8 * st) {
        u32x2 raw[8][4];
#pragma unroll
        for (int r = 0; r < 8; ++r) {
            const int it = it0 + r * st < last ? it0 + r * st : it0;
            const bf16_t* src = (const bf16_t*)(p.ws + WS_H) + (size_t)(it * 8 + wave) * 1024 + lane * 4;
#pragma unroll
            for (int k = 0; k < 4; ++k) raw[r][k] = *(const u32x2*)(src + k * 256);
        }
#pragma unroll
        for (int r = 0; r < 8; ++r) {
            const int it = it0 + r * st;
            float4 v[4]; float ss = 0.f;
#pragma unroll
            for (int k = 0; k < 4; ++k) { v[k] = make_float4(lo2f(raw[r][k].x), hi2f(raw[r][k].x), lo2f(raw[r][k].y), hi2f(raw[r][k].y)); ss += v[k].x * v[k].x + v[k].y * v[k].y + v[k].z * v[k].z + v[k].w * v[k].w; }
            ss = wave_sum(ss);
            const float rs = rsqrtf(ss * (1.f / 1024.f) + 1e-6f);
            if (it < last) {
                bf16_t* dst = (bf16_t*)(p.ws + WS_ACT) + (size_t)(it * 8 + wave) * 1024 + lane * 4;
#pragma unroll
                for (int k = 0; k < 4; ++k) {
                    u32x2 o;
                    o.x = pack2(v[k].x * rs * gs[k].x + sh[k].x, v[k].y * rs * gs[k].y + sh[k].y);
                    o.y = pack2(v[k].z * rs * gs[k].z + sh[k].z, v[k].w * rs * gs[k].w + sh[k].w);
                    *(u32x2*)(dst + k * 256) = o;
                }
            }
        }
    }
}
__device__ __forceinline__ void s5_mintra_item(const Params& p, int item) {
    const int g = item >> 6, i = item & 63;
    const float* kt0 = (const float*)(p.ws + WS_KTAB) + (size_t)(0 * 32 + g) * 64 * 256;
    const float* kt1 = (const float*)(p.ws + WS_KTAB) + (size_t)(1 * 32 + g) * 64 * 256;
    const float* dsk = p.in[17] + g * 16;
    bf16_t* ms5 = (bf16_t*)(p.ws + WS_MS5) + (size_t)g * 1280 * 1024;
    for (int t = tid_(); t < 16 * 128; t += NTHREADS) {
        const int hh = t >> 7, k8 = t & 127, j = k8 >> 1, h0 = (k8 & 1) * 8;
        const float* s = j < i ? kt0 + ((i - j) * 16 + hh) * 16 + h0 : kt1 + ((j - i) * 16 + hh) * 16 + h0;
        const float* s0 = kt0 + hh * 16 + h0;
        const float4 a0 = *(const float4*)s, a1 = *(const float4*)(s + 4), d0 = *(const float4*)s0, d1 = *(const float4*)(s0 + 4);
        const float dk = dsk[hh]; const float dm = j == i ? 1.f : 0.f;
        float f[8] = {a0.x, a0.y, a0.z, a0.w, a1.x, a1.y, a1.z, a1.w};
        const float dd[8] = {d0.x, d0.y, d0.z, d0.w, d1.x, d1.y, d1.z, d1.w};
#pragma unroll
        for (int e = 0; e < 8; ++e) f[e] += dm * (dd[e] + ((h0 + e) == hh ? dk : 0.f));
        *(uint4*)(ms5 + (size_t)(i * 16 + hh) * 1024 + k8 * 8) = pack8(f);
    }
}

struct EpiEvenIn {
    static constexpr bool PRE = false;
    bf16_t* pa; bf16_t* ug;
    __device__ __forceinline__ void operator()(int row, int col, const float* v) const {
        if (col < 1536) *(uint4*)(pa + (size_t)row * 1536 + col) = pack8(v);
        else { const int c2 = col - 1536; *(uint4*)(ug + ((size_t)(c2 >> 4) * NCH + (row >> 6)) * 1024 + (row & 63) * 16 + (c2 & 15)) = pack8(v); }
    }
};
struct EpiS5Local {
    static constexpr bool PRE = false;
    bf16_t* yl; float* lst; int g;
    __device__ __forceinline__ void operator()(int row, int col, const float* v) const {
        if (col < 1024) *(uint4*)(yl + (size_t)(row * 64 + (col >> 4)) * 512 + g * 16 + (col & 15)) = pack8(v);
        else { float* d = lst + ((size_t)g * NCH + row) * 256 + (col - 1024);
               *(float4*)d = make_float4(v[0], v[1], v[2], v[3]); *(float4*)(d + 4) = make_float4(v[4], v[5], v[6], v[7]); }
    }
};
struct EpiS5Out {
    static constexpr bool PRE = true;
    struct L { u32x4 y; };
    const bf16_t* yl; bf16_t* gs; int g;
    __device__ __forceinline__ size_t off(int row, int col) const { return (size_t)(row * 64 + (col >> 4)) * 512 + g * 16 + (col & 15); }
    __device__ __forceinline__ void pre(int row, int col, L& l) const { l.y = *(const u32x4*)(yl + off(row, col)); }
    __device__ __forceinline__ void post(int row, int col, const float* v, const L& l) const {
        const float y[8] = {lo2f(l.y.x), hi2f(l.y.x), lo2f(l.y.y), hi2f(l.y.y), lo2f(l.y.z), hi2f(l.y.z), lo2f(l.y.w), hi2f(l.y.w)};
        float f[8];
#pragma unroll
        for (int e = 0; e < 8; ++e) f[e] = gelu_tanh(v[e] + y[e]);
        *(uint4*)(gs + off(row, col)) = pack8(f);
    }
    __device__ __forceinline__ void operator()(int row, int col, const float* v) const { L l; pre(row, col, l); post(row, col, v, l); }
};
struct EpiGlu {
    static constexpr bool PRE = true;
    struct L { u32x4 g; float4 b0, b1; };
    const bf16_t* gs; const float* b; bf16_t* cb;
    __device__ __forceinline__ void pre(int row, int col, L& l) const { l.g = *(const u32x4*)(gs + (size_t)row * 512 + col); l.b0 = *(const float4*)(b + col); l.b1 = *(const float4*)(b + col + 4); }
    __device__ __forceinline__ void post(int row, int col, const float* v, const L& l) const {
        const float g[8] = {lo2f(l.g.x), hi2f(l.g.x), lo2f(l.g.y), hi2f(l.g.y), lo2f(l.g.z), hi2f(l.g.z), lo2f(l.g.w), hi2f(l.g.w)};
        const float bb[8] = {l.b0.x, l.b0.y, l.b0.z, l.b0.w, l.b1.x, l.b1.y, l.b1.z, l.b1.w};
        float f[8];
#pragma unroll
        for (int e = 0; e < 8; ++e) f[e] = g[e] * sigmoidf_(v[e] + bb[e]);
        *(uint4*)(cb + (size_t)row * 1024 + 512 + col) = pack8(f);
    }
    __device__ __forceinline__ void operator()(int row, int col, const float* v) const { L l; pre(row, col, l); post(row, col, v, l); }
};
struct EpiResid {
    static constexpr bool PRE = true;
    struct L { float4 b0, b1; u32x4 hb; float4 m0, m1; };
    const float* x; const float* ctx; bf16_t* hbuf; const float* mod; int l; bool from_inputs;
    __device__ __forceinline__ void pre(int row, int col, L& q) const {
        if (from_inputs) { const float* bp = row < SEQ ? x + (size_t)row * 1024 + col : ctx + (size_t)(row - SEQ) * 1024 + col; q.b0 = *(const float4*)bp; q.b1 = *(const float4*)(bp + 4); }
        else q.hb = *(const u32x4*)(hbuf + (size_t)row * 1024 + col);
        const float* mp = mod + ((l * 2 + (row >= SEQ ? 1 : 0)) * 6 + 2) * 1024 + col;
        q.m0 = *(const float4*)mp; q.m1 = *(const float4*)(mp + 4);
    }
    __device__ __forceinline__ void post(int row, int col, const float* v, const L& q) const {
        float b[8];
        if (from_inputs) { b[0] = q.b0.x; b[1] = q.b0.y; b[2] = q.b0.z; b[3] = q.b0.w; b[4] = q.b1.x; b[5] = q.b1.y; b[6] = q.b1.z; b[7] = q.b1.w; }
        else { b[0] = lo2f(q.hb.x); b[1] = hi2f(q.hb.x); b[2] = lo2f(q.hb.y); b[3] = hi2f(q.hb.y); b[4] = lo2f(q.hb.z); b[5] = hi2f(q.hb.z); b[6] = lo2f(q.hb.w); b[7] = hi2f(q.hb.w); }
        const float o[8] = {b[0] + q.m0.x * v[0], b[1] + q.m0.y * v[1], b[2] + q.m0.z * v[2], b[3] + q.m0.w * v[3], b[4] + q.m1.x * v[4], b[5] + q.m1.y * v[5], b[6] + q.m1.z * v[6], b[7] + q.m1.w * v[7]};
        *(uint4*)(hbuf + (size_t)row * 1024 + col) = pack8(o);
    }
    __device__ __forceinline__ void operator()(int row, int col, const float* v) const { L q; pre(row, col, q); post(row, col, v, q); }
};
struct EpiBf16 {
    static constexpr bool PRE = false;
    bf16_t* dst; int ld;
    __device__ __forceinline__ void operator()(int row, int col, const float* v) const { *(uint4*)(dst + (size_t)row * ld + col) = pack8(v); }
};
struct EpiScore {
    static constexpr bool PRE = false;
    unsigned short* dst; int coff;
    __device__ __forceinline__ void operator()(int row, int col, const float* v) const {
        typedef _Float16 h2 __attribute__((ext_vector_type(2)));
        u32x4 o;
#pragma unroll
        for (int e = 0; e < 4; ++e) { const h2 hv = {(_Float16)v[2 * e], (_Float16)v[2 * e + 1]}; o[e] = __builtin_bit_cast(unsigned, hv); }
        *(u32x4*)(dst + (size_t)row * 2048 + coff + col) = o;
    }
};
struct EpiOddIn {
    static constexpr bool PRE = false;
    bf16_t* qkvr; bf16_t* z; float* ab;
    __device__ __forceinline__ void operator()(int row, int col, const float* v) const {
        if (col < 3072) *(uint4*)(qkvr + (size_t)row * 3072 + col) = pack8(v);
        else if (col < 4096) *(uint4*)(z + (size_t)row * 1024 + (col - 3072)) = pack8(v);
        else { float* d = ab + (size_t)row * 32 + (col - 4096); *(float4*)d = make_float4(v[0], v[1], v[2], v[3]); *(float4*)(d + 4) = make_float4(v[4], v[5], v[6], v[7]); }
    }
};

__device__ __forceinline__ void s5_scan(const Params& p) {
    const int gt = blockIdx.x * NTHREADS + tid_();
    if (gt >= 4096) return;
    const int di = gt >> 11, g = (gt >> 6) & 31, pp = gt & 63;
    const float2 a = ((const float2*)(p.ws + WS_A64))[(di * 32 + g) * 64 + pp];
    const float* lst = (const float*)(p.ws + WS_LST) + (size_t)g * NCH * 256 + di * 128 + pp;
    bf16_t* a5 = (bf16_t*)(p.ws + WS_A5) + (size_t)g * NCH * 256 + di * 128 + pp;
    float sr = 0.f, si = 0.f;
    static_assert(NCH % 20 == 0, "scan block");
#pragma unroll 1
    for (int s0 = 0; s0 < NCH; s0 += 20) {
        int c[20]; float lr[20], li[20];
#pragma unroll
        for (int u = 0; u < 20; ++u) {
            const int s = s0 + u;
            c[u] = di == 0 ? (s < 4 ? NCH_LAT + s : s - 4) : (s < 4 ? NCH - 1 - s : NCH - 1 - s);
            lr[u] = lst[(size_t)c[u] * 256]; li[u] = lst[(size_t)c[u] * 256 + 64];
        }
#pragma unroll
        for (int u = 0; u < 20; ++u) {
            a5[(size_t)c[u] * 256] = f2bf(sr); a5[(size_t)c[u] * 256 + 64] = f2bf(si);
            const float nr = a.x * sr - a.y * si + lr[u], ni = a.x * si + a.y * sr + li[u]; sr = nr; si = ni;
        }
    }
}

__device__ __forceinline__ bool gp_has_prev(int r) { return r < SEQ ? (r & 63) != 0 : r != SEQ; }
__device__ __forceinline__ bool gp_has_next(int r) { return r < SEQ ? (r & 63) != 63 : r != R - 1; }
__device__ __forceinline__ void even_conv_item(const Params& p, int item) {
    const bf16_t* pa = (const bf16_t*)(p.ws + WS_PA); bf16_t* cb = (bf16_t*)(p.ws + WS_CB);
    const int tid = tid_(), c0 = (tid & 63) * 8, r0 = item * 32 + (tid >> 6) * 4;
    u32x4 wu[6], wg[6], wo[4];
#pragma unroll
    for (int i = 0; i < 6; ++i) {
        int rr = r0 + i - 1; rr = rr < 0 ? 0 : (rr > R - 1 ? R - 1 : rr);
        const bf16_t* rp = pa + (size_t)rr * 1536 + c0;
        wu[i] = *(const u32x4*)rp; wg[i] = *(const u32x4*)(rp + 512);
    }
#pragma unroll
    for (int j = 0; j < 4; ++j) wo[j] = *(const u32x4*)(pa + (size_t)(r0 + j) * 1536 + 1024 + c0);
    const float* cw = p.in[9] + c0;
    float w0[8], w1[8], w2[8];
#pragma unroll
    for (int e = 0; e < 8; ++e) { w0[e] = cw[e]; w1[e] = cw[512 + e]; w2[e] = cw[1024 + e]; }
#define EC_PROD(dst, i_) do { const u32x4 a_ = wu[i_], b_ = wg[i_]; \
        dst[0] = lo2f(a_.x) * lo2f(b_.x); dst[1] = hi2f(a_.x) * hi2f(b_.x); dst[2] = lo2f(a_.y) * lo2f(b_.y); dst[3] = hi2f(a_.y) * hi2f(b_.y); \
        dst[4] = lo2f(a_.z) * lo2f(b_.z); dst[5] = hi2f(a_.z) * hi2f(b_.z); dst[6] = lo2f(a_.w) * lo2f(b_.w); dst[7] = hi2f(a_.w) * hi2f(b_.w); } while (0)
    float mp[8], mc[8], mn[8];
    EC_PROD(mp, 0); EC_PROD(mc, 1);
#pragma unroll
    for (int j = 0; j < 4; ++j) {
        EC_PROD(mn, j + 2);
        const bool hp = gp_has_prev(r0 + j), hn = gp_has_next(r0 + j);
        const u32x4 o4 = wo[j];
        const float go[8] = {lo2f(o4.x), hi2f(o4.x), lo2f(o4.y), hi2f(o4.y), lo2f(o4.z), hi2f(o4.z), lo2f(o4.w), hi2f(o4.w)};
        float f[8];
#pragma unroll
        for (int e = 0; e < 8; ++e) f[e] = go[e] * ((hp ? mp[e] : 0.f) * w0[e] + mc[e] * w1[e] + (hn ? mn[e] : 0.f) * w2[e]);
        *(uint4*)(cb + (size_t)(r0 + j) * 1024 + c0) = pack8(f);
#pragma unroll
        for (int e = 0; e < 8; ++e) { mp[e] = mc[e]; mc[e] = mn[e]; }
    }
#undef EC_PROD
}

__device__ __forceinline__ unsigned ord_enc(float v) { const unsigned u = __float_as_uint(v); return (u & 0x80000000u) ? ~u : (u | 0x80000000u); }
__device__ __forceinline__ float ord_dec(unsigned e) { const unsigned u = (e & 0x80000000u) ? (e & 0x7FFFFFFFu) : ~e; return __uint_as_float(u); }
#define TOP_INSERT(key) { unsigned x_ = (key); _Pragma("unroll") for (int k_ = 0; k_ < 16; ++k_) { const unsigned hi_ = top[k_] > x_ ? top[k_] : x_; x_ = top[k_] > x_ ? x_ : top[k_]; top[k_] = hi_; } }
__device__ __forceinline__ void peer_route_item(const Params& p, int item, int nrows, unsigned char* lds) {
    const int tid = tid_();
    const int row = item * 64 + (tid >> 3), head = tid & 7;
    unsigned* sIdx = (unsigned*)lds;
    __syncthreads();
    if (row < nrows) {
        const unsigned short* sc = (const unsigned short*)(p.ws + WS_SC) + (size_t)row * 2048 + head * 256;
        float fa[16], fb[16];
        {
#define CE_DESC(a_, b_) { const unsigned hi_ = (a_) > (b_) ? (a_) : (b_); const unsigned lo_ = (a_) > (b_) ? (b_) : (a_); (a_) = hi_; (b_) = lo_; }
            unsigned topa[16], topb[16];
            u32x4 nqa[2], nqb[2];
#pragma unroll
            for (int c2 = 0; c2 < 2; ++c2) { nqa[c2] = *(const u32x4*)(sc + c2 * 8); nqb[c2] = *(const u32x4*)(sc + 128 + c2 * 8); }
#pragma unroll 1
            for (int blk = 0; blk < 8; ++blk) {
                unsigned ka[16], kb[16];
                u32x4 cqa[2], cqb[2];
#pragma unroll
                for (int c2 = 0; c2 < 2; ++c2) { cqa[c2] = nqa[c2]; cqb[c2] = nqb[c2]; }
                {
                    const int nb = blk < 7 ? blk + 1 : 7;
#pragma unroll
                    for (int c2 = 0; c2 < 2; ++c2) { nqa[c2] = *(const u32x4*)(sc + (nb * 2 + c2) * 8); nqb[c2] = *(const u32x4*)(sc + 128 + (nb * 2 + c2) * 8); }
                }
#pragma unroll
                for (int c2 = 0; c2 < 2; ++c2) {
                    const int c = blk * 2 + c2;
                    const u32x4 qa = cqa[c2], qb = cqb[c2];
                    const unsigned wa[4] = {qa.x, qa.y, qa.z, qa.w}, wb[4] = {qb.x, qb.y, qb.z, qb.w};
#pragma unroll
                    for (int e2 = 0; e2 < 4; ++e2) {
                        typedef short s16x2_t __attribute__((ext_vector_type(2)));
                        const s16x2_t ma = __builtin_bit_cast(s16x2_t, wa[e2]) >> (short)15, mb = __builtin_bit_cast(s16x2_t, wb[e2]) >> (short)15;
                        const unsigned ea = wa[e2] ^ (__builtin_bit_cast(unsigned, ma) | 0x80008000u), eb = wb[e2] ^ (__builtin_bit_cast(unsigned, mb) | 0x80008000u);
                        ka[c2 * 8 + 2 * e2] = (ea << 16) | (unsigned)(c * 8 + 2 * e2); ka[c2 * 8 + 2 * e2 + 1] = (ea & 0xFFFF0000u) | (unsigned)(c * 8 + 2 * e2 + 1);
                        kb[c2 * 8 + 2 * e2] = (eb << 16) | (unsigned)(c * 8 + 2 * e2); kb[c2 * 8 + 2 * e2 + 1] = (eb & 0xFFFF0000u) | (unsigned)(c * 8 + 2 * e2 + 1);
                    }
                }
#define CE2(i_, j_) { CE_DESC(ka[i_], ka[j_]); CE_DESC(kb[i_], kb[j_]); }
                CE2(0, 1) CE2(2, 3) CE2(0, 2) CE2(1, 3) CE2(1, 2) CE2(4, 5) CE2(6, 7) CE2(4, 6) CE2(5, 7)
                CE2(5, 6) CE2(0, 4) CE2(2, 6) CE2(2, 4) CE2(1, 5) CE2(3, 7) CE2(3, 5) CE2(1, 2) CE2(3, 4)
                CE2(5, 6) CE2(8, 9) CE2(10, 11) CE2(8, 10) CE2(9, 11) CE2(9, 10) CE2(12, 13) CE2(14, 15) CE2(12, 14)
                CE2(13, 15) CE2(13, 14) CE2(8, 12) CE2(10, 14) CE2(10, 12) CE2(9, 13) CE2(11, 15) CE2(11, 13) CE2(9, 10)
                CE2(11, 12) CE2(13, 14) CE2(0, 8) CE2(4, 12) CE2(4, 8) CE2(2, 10) CE2(6, 14) CE2(6, 10) CE2(2, 4)
                CE2(6, 8) CE2(10, 12) CE2(1, 9) CE2(5, 13) CE2(5, 9) CE2(3, 11) CE2(7, 15) CE2(7, 11) CE2(3, 5)
                CE2(7, 9) CE2(11, 13) CE2(1, 2) CE2(3, 4) CE2(5, 6) CE2(7, 8) CE2(9, 10) CE2(11, 12) CE2(13, 14)
#undef CE2
                if (blk == 0) {
#pragma unroll
                    for (int i = 0; i < 16; ++i) { topa[i] = ka[i]; topb[i] = kb[i]; }
                } else {
#pragma unroll
                    for (int i = 0; i < 16; ++i) { topa[i] = topa[i] > ka[15 - i] ? topa[i] : ka[15 - i]; topb[i] = topb[i] > kb[15 - i] ? topb[i] : kb[15 - i]; }
#pragma unroll
                    for (int j = 8; j > 0; j >>= 1) {
#pragma unroll
                        for (int i = 0; i < 16; ++i) { const int l2 = i ^ j; if (l2 > i) { CE_DESC(topa[i], topa[l2]); CE_DESC(topb[i], topb[l2]); } }
                    }
                }
            }
#undef CE_DESC
#pragma unroll
            for (int k = 0; k < 16; ++k) {
                sIdx[k * NTHREADS + tid] = topa[k] & 0x7Fu; sIdx[(16 + k) * NTHREADS + tid] = topb[k] & 0x7Fu;
                {
                    const unsigned xa = topa[k] >> 16, xb = topb[k] >> 16;
                    const unsigned short ha = (unsigned short)(xa ^ ((xa & 0x8000u) ? 0x8000u : 0xFFFFu)), hb = (unsigned short)(xb ^ ((xb & 0x8000u) ? 0x8000u : 0xFFFFu));
                    fa[k] = (float)__builtin_bit_cast(_Float16, ha); fb[k] = (float)__builtin_bit_cast(_Float16, hb);
                }
            }
        }
        unsigned top[16];
#pragma unroll
        for (int k = 0; k < 16; ++k) top[k] = (ord_enc(fa[0] + fb[k]) & ~0xFFu) | (unsigned)k;
#pragma unroll
        for (int i = 1; i < 16; ++i) {
#pragma unroll
            for (int j = 0; j < 16; ++j) {
                if ((i + 1) * (j + 1) <= 16) { TOP_INSERT((ord_enc(fa[i] + fb[j]) & ~0xFFu) | (unsigned)(i * 16 + j)); }
            }
        }
        float ev[16]; float m = ord_dec(top[0] & ~0xFFu), sum = 0.f;
#pragma unroll
        for (int k = 0; k < 16; ++k) { ev[k] = __expf(ord_dec(top[k] & ~0xFFu) - m); sum += ev[k]; }
        const float inv = 1.f / sum;
        unsigned eidx[16], cw[4] = {0u, 0u, 0u, 0u};
#pragma unroll
        for (int k = 0; k < 16; ++k) {
            const unsigned pos = top[k] & 0xFFu;
            const unsigned ia = sIdx[(pos >> 4) * NTHREADS + tid], ib = sIdx[(16 + (pos & 15)) * NTHREADS + tid];
            eidx[k] = ia * 128u + ib;
            const unsigned b = eidx[k] >> 10, inc = 1u << (8u * (b & 3u)), ws_ = b >> 2;
#pragma unroll
            for (int q = 0; q < 4; ++q) cw[q] += ws_ == (unsigned)q ? inc : 0u;
        }
        unsigned pw[4], tw[4], st[4];
#pragma unroll
        for (int q = 0; q < 4; ++q) pw[q] = cw[q];
#pragma unroll
        for (int d = 1; d < 8; d <<= 1)
#pragma unroll
            for (int q = 0; q < 4; ++q) { const unsigned t = __shfl_up(pw[q], d, 8); if (head >= d) pw[q] += t; }
#pragma unroll
        for (int q = 0; q < 4; ++q) tw[q] = __shfl(pw[q], 7, 8);
        {
            unsigned run = 0u;
#pragma unroll
            for (int b = 0; b < 16; ++b) {
                const unsigned c = (tw[b >> 2] >> (8 * (b & 3))) & 0xFFu;
                if ((b & 3) == 0) st[b >> 2] = run; else st[b >> 2] |= run << (8 * (b & 3));
                run += c;
            }
        }
#pragma unroll
        for (int q = 0; q < 4; ++q) st[q] += pw[q] - cw[q];
        int* idxr = (int*)(p.ws + WS_IDX) + (size_t)row * 128; float* gr = (float*)(p.ws + WS_GATE) + (size_t)row * 128;
#pragma unroll
        for (int k = 0; k < 16; ++k) {
            const unsigned b = eidx[k] >> 10, sh = 8u * (b & 3u), inc = 1u << sh, ws_ = b >> 2;
            const unsigned w = ws_ == 0u ? st[0] : ws_ == 1u ? st[1] : ws_ == 2u ? st[2] : st[3];
            const unsigned slot = (w >> sh) & 0xFFu;
#pragma unroll
            for (int q = 0; q < 4; ++q) st[q] += ws_ == (unsigned)q ? inc : 0u;
            idxr[slot] = (int)eidx[k]; gr[slot] = ev[k] * inv;
        }
    }
}

__device__ __forceinline__ float row16_sum_dpp(float v) {
    v += __int_as_float(__builtin_amdgcn_update_dpp(0, __float_as_int(v), 0xB1, 0xF, 0xF, true));
    v += __int_as_float(__builtin_amdgcn_update_dpp(0, __float_as_int(v), 0x4E, 0xF, 0xF, true));
    v += __int_as_float(__builtin_amdgcn_update_dpp(0, __float_as_int(v), 0x141, 0xF, 0xF, true));
    v += __int_as_float(__builtin_amdgcn_update_dpp(0, __float_as_int(v), 0x140, 0xF, 0xF, true));
    return v;
}
__device__ __forceinline__ void peer_route_pair_wave(const Params& p, int row, int head, unsigned* sl) {
    const int lane = tid_() & 63;
    const unsigned short* sc = (const unsigned short*)(p.ws + WS_SC) + (size_t)row * 2048 + head * 256;
    unsigned k4[4];
#pragma unroll
    for (int q = 0; q < 4; ++q) {
        const int pos = (q & 1) * 64 + lane;
        const unsigned short hv = sc[(q >> 1) * 128 + pos];
        k4[q] = (ord_enc((float)__builtin_bit_cast(_Float16, hv)) & ~0x7Fu) | (unsigned)pos;
    }
    unsigned rk[4] = {0u, 0u, 0u, 0u};
#pragma unroll 2
    for (int j = 0; j < 64; ++j) {
#pragma unroll
        for (int q = 0; q < 4; ++q) {
            const unsigned x = (unsigned)__builtin_amdgcn_readlane((int)k4[q], j);
            rk[q & 2] += x > k4[q & 2] ? 1u : 0u; rk[(q & 2) + 1] += x > k4[(q & 2) + 1] ? 1u : 0u;
        }
    }
#pragma unroll
    for (int q = 0; q < 4; ++q) if (rk[q] < 16u) sl[(q >> 1) * 16 + rk[q]] = k4[q];
    asm volatile("s_waitcnt lgkmcnt(0)" ::: "memory");
    int ci = 0, cbase = 0;
    {
        const int pre[16] = {0, 16, 24, 29, 33, 36, 38, 40, 42, 43, 44, 45, 46, 47, 48, 49};
#pragma unroll
        for (int i = 1; i < 16; ++i) if (lane >= pre[i]) { ci = i; cbase = pre[i]; }
    }
    const int cj = lane - cbase;
    unsigned ck = 0u;
    if (lane < 50) {
        const float fa = ord_dec(sl[ci] & ~0x7Fu), fb = ord_dec(sl[16 + cj] & ~0x7Fu);
        ck = (ord_enc(fa + fb) & ~0xFFu) | (unsigned)(ci * 16 + cj);
    }
    unsigned cr = 0u;
#pragma unroll 2
    for (int j = 0; j < 50; ++j) { const unsigned x = (unsigned)__builtin_amdgcn_readlane((int)ck, j); cr += x > ck ? 1u : 0u; }
    if (lane < 50 && cr < 16u) sl[32 + cr] = ck;
    asm volatile("s_waitcnt lgkmcnt(0)" ::: "memory");
    const unsigned top = sl[32 + (lane & 15)], top0 = sl[32];
    const float ev = __expf(ord_dec(top & ~0xFFu) - ord_dec(top0 & ~0xFFu));
    const float sum = row16_sum_dpp(ev);
    if (lane < 16) {
        const unsigned pos = top & 0xFFu;
        const unsigned ia = sl[pos >> 4] & 0x7Fu, ib = sl[16 + (pos & 15)] & 0x7Fu;
        ((int*)(p.ws + WS_IDX))[(size_t)row * 128 + head * 16 + lane] = (int)(ia * 128u + ib);
        ((float*)(p.ws + WS_GATE))[(size_t)row * 128 + head * 16 + lane] = ev / sum;
    }
}

struct PgBuf { u32x4 u0, u1, u2, v0, v1, v2; };
__device__ __forceinline__ void peer_gather_batches(const Params& p, int row, int b_beg, int b_end, float (&y)[64]) {
    const int lane = tid_() & 63, g = lane >> 4, i = lane & 15;
    const unsigned char* PE = p.ws + WS_PUV;
    const float* psc = (const float*)(p.ws + WS_PSC);
    const int* idxp = (const int*)(p.ws + WS_IDX) + (size_t)row * 128; const float* gp = (const float*)(p.ws + WS_GATE) + (size_t)row * 128;
    const int idx0 = idxp[lane], idx1 = idxp[64 + lane];
    const float us0 = psc[idx0], us1 = psc[idx1], gv0 = gp[lane] * psc[16384 + idx0], gv1 = gp[64 + lane] * psc[16384 + idx1];
    unsigned x[32];
    {
        const u32x4* xr = (const u32x4*)((const bf16_t*)(p.ws + WS_ACT) + (size_t)row * 1024 + i * 64);
#pragma unroll
        for (int q = 0; q < 8; ++q) { const u32x4 t = xr[q]; x[4 * q] = t.x; x[4 * q + 1] = t.y; x[4 * q + 2] = t.z; x[4 * q + 3] = t.w; }
    }
#define PG_SRC(bb) const int bq_ = (bb); const int b_ = bq_ < b_end ? bq_ : b_end - 1; const int src_ = (((b_ & 15) << 2) + g) << 2; const bool h1_ = (b_ >> 4) != 0
#define PG_ISSUE_U(B, bb) do { PG_SRC(bb); const int id_ = __builtin_amdgcn_ds_bpermute(src_, h1_ ? idx1 : idx0); \
        const unsigned char* rp_ = PE + (size_t)(unsigned)(id_ * PREC + i * 48); \
        B.u0 = *(const u32x4*)rp_; B.u1 = *(const u32x4*)(rp_ + 16); B.u2 = *(const u32x4*)(rp_ + 32); } while (0)
#define PG_ISSUE_V(B, bb) do { PG_SRC(bb); const int id_ = __builtin_amdgcn_ds_bpermute(src_, h1_ ? idx1 : idx0); \
        const unsigned char* rp_ = PE + (size_t)(unsigned)(id_ * PREC + i * 48 + 768); \
        B.v0 = *(const u32x4*)rp_; B.v1 = *(const u32x4*)(rp_ + 16); B.v2 = *(const u32x4*)(rp_ + 32); } while (0)
#define PG_DOT(pk_, xo_) do { const v32b_t f_ = __builtin_amdgcn_cvt_scalef32_pk32_bf16_fp6(pk_, 1.0f); \
        _Pragma("unroll") for (int j_ = 0; j_ < 16; j_ += 2) { \
            const v2b_t fa_ = {f_[2 * j_], f_[2 * j_ + 1]}, fb_ = {f_[2 * j_ + 2], f_[2 * j_ + 3]}; \
            a0_ = __builtin_amdgcn_fdot2_f32_bf16(fa_, __builtin_bit_cast(v2b_t, x[(xo_) + j_]), a0_, false); \
            a1_ = __builtin_amdgcn_fdot2_f32_bf16(fb_, __builtin_bit_cast(v2b_t, x[(xo_) + j_ + 1]), a1_, false); } } while (0)
#define PG_ACC(pk_, yo_) do { const v32f_t w_ = __builtin_amdgcn_cvt_scalef32_pk32_f32_fp6(pk_, 1.0f); \
        _Pragma("unroll") for (int e_ = 0; e_ < 32; e_ += 2) { const f32x2_t fv_ = {w_[e_], w_[e_ + 1]}; f32x2_t yv_ = {y[(yo_) + e_], y[(yo_) + e_ + 1]}; \
            yv_ = __builtin_elementwise_fma(cv_, fv_, yv_); y[(yo_) + e_] = yv_.x; y[(yo_) + e_ + 1] = yv_.y; } } while (0)
#define PG_STEP(Bc, Bn, bb) do { float a0_ = 0.f, a1_ = 0.f, us_, gv_; \
        PG_ISSUE_U(Bn, (bb) + 2); \
        { PG_SRC(bb); us_ = __int_as_float(__builtin_amdgcn_ds_bpermute(src_, __float_as_int(h1_ ? us1 : us0))); \
          gv_ = __int_as_float(__builtin_amdgcn_ds_bpermute(src_, __float_as_int(h1_ ? gv1 : gv0))); gv_ = bq_ < b_end ? gv_ : 0.f; } \
        __builtin_amdgcn_sched_barrier(0); \
        { const v6u_t pk_ = {Bc.u0.x, Bc.u0.y, Bc.u0.z, Bc.u0.w, Bc.u1.x, Bc.u1.y}; PG_DOT(pk_, 0); } \
        { const v6u_t pk_ = {Bc.u1.z, Bc.u1.w, Bc.u2.x, Bc.u2.y, Bc.u2.z, Bc.u2.w}; PG_DOT(pk_, 16); } \
        __builtin_amdgcn_sched_barrier(0); \
        PG_ISSUE_V(Bn, (bb) + 2); \
        const float d_ = row16_sum_dpp(a0_ + a1_); \
        const float coef_ = gelu_fast(d_ * us_) * gv_; const f32x2_t cv_ = {coef_, coef_}; \
        __builtin_amdgcn_sched_barrier(0); \
        { const v6u_t pk_ = {Bc.v0.x, Bc.v0.y, Bc.v0.z, Bc.v0.w, Bc.v1.x, Bc.v1.y}; PG_ACC(pk_, 0); } \
        __builtin_amdgcn_sched_barrier(0); \
        { const v6u_t pk_ = {Bc.v1.z, Bc.v1.w, Bc.v2.x, Bc.v2.y, Bc.v2.z, Bc.v2.w}; PG_ACC(pk_, 32); } \
        __builtin_amdgcn_sched_barrier(0); } while (0)
    PgBuf B0, B1, B2;
    PG_ISSUE_U(B0, b_beg); PG_ISSUE_V(B0, b_beg); PG_ISSUE_U(B1, b_beg + 1); PG_ISSUE_V(B1, b_beg + 1);
#pragma unroll 1
    for (int b = b_beg; b < b_end; b += 3) {
        PG_STEP(B0, B2, b);
        PG_STEP(B1, B0, b + 1);
        PG_STEP(B2, B1, b + 2);
    }
#undef PG_SRC
#undef PG_ISSUE_U
#undef PG_ISSUE_V
#undef PG_DOT
#undef PG_ACC
#undef PG_STEP
}
__device__ __forceinline__ void pg_reduce_groups(const float (&y)[64], float (&y16)[16], unsigned char* ldsw) {
    const int lane = tid_() & 63, g = lane >> 4, i = lane & 15, i2 = lane >> 2;
#pragma unroll
    for (int k = 0; k < 16; ++k) *(float4*)(ldsw + g * 4096 + i * 256 + ((k ^ i) << 4)) = make_float4(y[4 * k], y[4 * k + 1], y[4 * k + 2], y[4 * k + 3]);
#pragma unroll
    for (int j = 0; j < 4; ++j) {
        const int k = (lane & 3) * 4 + j;
        float4 s = *(const float4*)(ldsw + i2 * 256 + ((k ^ i2) << 4));
#pragma unroll
        for (int g2 = 1; g2 < 4; ++g2) { const float4 t = *(const float4*)(ldsw + g2 * 4096 + i2 * 256 + ((k ^ i2) << 4)); s.x += t.x; s.y += t.y; s.z += t.z; s.w += t.w; }
        y16[4 * j] = s.x; y16[4 * j + 1] = s.y; y16[4 * j + 2] = s.z; y16[4 * j + 3] = s.w;
    }
}
__device__ __forceinline__ void peer_gather_finish(const Params& p, int row, int l, bool last, const float (&y)[16]) {
    const int lane = tid_() & 63;
    bf16_t* h = (bf16_t*)(p.ws + WS_H) + (size_t)row * 1024 + lane * 16;
    const float* m5 = modp(p, l, row, 5) + lane * 16;
    float hv[16];
    unpack8(*(const uint4*)h, hv); unpack8(*(const uint4*)(h + 8), hv + 8);
#pragma unroll
    for (int q = 0; q < 4; ++q) {
        const float4 g0 = *(const float4*)(m5 + q * 4);
        hv[q * 4 + 0] += g0.x * y[q * 4 + 0]; hv[q * 4 + 1] += g0.y * y[q * 4 + 1];
        hv[q * 4 + 2] += g0.z * y[q * 4 + 2]; hv[q * 4 + 3] += g0.w * y[q * 4 + 3];
    }
    if (!last) {
        *(uint4*)h = pack8(hv); *(uint4*)(h + 8) = pack8(hv + 8);
        float ss = 0.f;
#pragma unroll
        for (int e = 0; e < 16; ++e) ss += hv[e] * hv[e];
        ss = wave_sum(ss);
        const float rs = rsqrtf(ss * (1.f / 1024.f) + 1e-6f);
        const float* g1 = p.in[6] + (l + 1) * 1024 + lane * 16; const float* sh = modp(p, l + 1, row, 0) + lane * 16; const float* sc = modp(p, l + 1, row, 1) + lane * 16;
        float o[16];
#pragma unroll
        for (int q = 0; q < 4; ++q) {
            const float4 gg = *(const float4*)(g1 + q * 4), s4 = *(const float4*)(sh + q * 4), c4 = *(const float4*)(sc + q * 4);
            o[q * 4 + 0] = hv[q * 4 + 0] * rs * gg.x * (1.f + c4.x) + s4.x; o[q * 4 + 1] = hv[q * 4 + 1] * rs * gg.y * (1.f + c4.y) + s4.y;
            o[q * 4 + 2] = hv[q * 4 + 2] * rs * gg.z * (1.f + c4.z) + s4.z; o[q * 4 + 3] = hv[q * 4 + 3] * rs * gg.w * (1.f + c4.w) + s4.w;
        }
        bf16_t* act = (bf16_t*)(p.ws + WS_ACT) + (size_t)row * 1024 + lane * 16;
        *(uint4*)act = pack8(o); *(uint4*)(act + 8) = pack8(o + 8);
    } else {
        float ss = 0.f;
#pragma unroll
        for (int e = 0; e < 16; ++e) ss += hv[e] * hv[e];
        ss = wave_sum(ss);
        const float rs = rsqrtf(ss * (1.f / 1024.f) + 1e-6f);
        const float* fg = p.in[31] + lane * 16; float* o = p.out + (size_t)row * 1024 + lane * 16;
#pragma unroll
        for (int q = 0; q < 4; ++q) {
            const float4 g0 = *(const float4*)(fg + q * 4);
            *(float4*)(o + q * 4) = make_float4(hv[q * 4 + 0] * rs * g0.x, hv[q * 4 + 1] * rs * g0.y, hv[q * 4 + 2] * rs * g0.z, hv[q * 4 + 3] * rs * g0.w);
        }
    }
}

__device__ __forceinline__ void peer_gather_rows4(const Params& p, int row_g, bool valid, int l, bool last, unsigned char* ldsw, const float* cst) {
    const int lane = tid_() & 63, g = lane >> 4, i = lane & 15;
    const unsigned char* PE = p.ws + (l ? WS_PUV1 : WS_PUV);
    const float* psc = (const float*)(p.ws + (l ? WS_PSC1 : WS_PSC));
    int* idxL = (int*)ldsw; float* usL = (float*)(ldsw + 2048); float* gvL = (float*)(ldsw + 4096);
#pragma unroll
    for (int q = 0; q < 4; ++q) {
        const int rq = __shfl(row_g, 16 * q, 64);
#pragma unroll
        for (int hh = 0; hh < 2; ++hh) {
            const int e = hh * 64 + lane;
            const int id = ((const int*)(p.ws + WS_IDX))[(size_t)rq * 128 + e];
            const float gt = ((const float*)(p.ws + WS_GATE))[(size_t)rq * 128 + e];
            idxL[q * 128 + e] = id; usL[q * 128 + e] = psc[id]; gvL[q * 128 + e] = gt * psc[16384 + id];
        }
    }
    unsigned x[32];
    {
        const u32x4* xr = (const u32x4*)((const bf16_t*)(p.ws + WS_ACT) + (size_t)row_g * 1024 + i * 64);
#pragma unroll
        for (int q = 0; q < 8; ++q) { const u32x4 t = xr[q]; x[4 * q] = t.x; x[4 * q + 1] = t.y; x[4 * q + 2] = t.z; x[4 * q + 3] = t.w; }
    }
    float y[64];
#pragma unroll
    for (int e = 0; e < 64; ++e) y[e] = 0.f;
    asm volatile("s_waitcnt lgkmcnt(0)" ::: "memory");
    const int lbase = g * 128;
#define PR_ID(bb) idxL[lbase + ((bb) < 127 ? (bb) : 127)]
#define PR_ISSUE_U(B, id_) do { const unsigned char* rp_ = PE + (size_t)(unsigned)((id_) * PREC + i * 48); \
        B.u0 = *(const u32x4*)rp_; B.u1 = *(const u32x4*)(rp_ + 16); B.u2 = *(const u32x4*)(rp_ + 32); } while (0)
#define PR_ISSUE_V(B, id_) do { const unsigned char* rp_ = PE + (size_t)(unsigned)((id_) * PREC + i * 48 + 768); \
        B.v0 = *(const u32x4*)rp_; B.v1 = *(const u32x4*)(rp_ + 16); B.v2 = *(const u32x4*)(rp_ + 32); } while (0)
#define PR_DOT(pk_, xo_) do { const v32b_t f_ = __builtin_amdgcn_cvt_scalef32_pk32_bf16_fp6(pk_, 1.0f); \
        _Pragma("unroll") for (int j_ = 0; j_ < 16; j_ += 2) { \
            const v2b_t fa_ = {f_[2 * j_], f_[2 * j_ + 1]}, fb_ = {f_[2 * j_ + 2], f_[2 * j_ + 3]}; \
            a0_ = __builtin_amdgcn_fdot2_f32_bf16(fa_, __builtin_bit_cast(v2b_t, x[(xo_) + j_]), a0_, false); \
            a1_ = __builtin_amdgcn_fdot2_f32_bf16(fb_, __builtin_bit_cast(v2b_t, x[(xo_) + j_ + 1]), a1_, false); } } while (0)
#define PR_ACC(pk_, yo_) do { const v32f_t w_ = __builtin_amdgcn_cvt_scalef32_pk32_f32_fp6(pk_, 1.0f); \
        _Pragma("unroll") for (int e_ = 0; e_ < 32; e_ += 2) { const f32x2_t fv_ = {w_[e_], w_[e_ + 1]}; f32x2_t yv_ = {y[(yo_) + e_], y[(yo_) + e_ + 1]}; \
            yv_ = __builtin_elementwise_fma(cv_, fv_, yv_); y[(yo_) + e_] = yv_.x; y[(yo_) + e_ + 1] = yv_.y; } } while (0)
#define PR_STEP(Bc, Bn, bb) do { float a0_ = 0.f, a1_ = 0.f; \
        const int idn_ = id2; \
        PR_ISSUE_U(Bn, idn_); \
        id2 = PR_ID((bb) + 3); \
        const int bq_ = (bb) < 127 ? (bb) : 127; \
        const float us_ = usL[lbase + bq_]; float gv_ = gvL[lbase + bq_]; gv_ = (bb) < 128 ? gv_ : 0.f; \
        __builtin_amdgcn_sched_barrier(0); \
        { const v6u_t pk_ = {Bc.u0.x, Bc.u0.y, Bc.u0.z, Bc.u0.w, Bc.u1.x, Bc.u1.y}; PR_DOT(pk_, 0); } \
        { const v6u_t pk_ = {Bc.u1.z, Bc.u1.w, Bc.u2.x, Bc.u2.y, Bc.u2.z, Bc.u2.w}; PR_DOT(pk_, 16); } \
        __builtin_amdgcn_sched_barrier(0); \
        PR_ISSUE_V(Bn, idn_); \
        const float d_ = row16_sum_dpp(a0_ + a1_); \
        const float coef_ = gelu_fast(d_ * us_) * gv_; const f32x2_t cv_ = {coef_, coef_}; \
        __builtin_amdgcn_sched_barrier(0); \
        { const v6u_t pk_ = {Bc.v0.x, Bc.v0.y, Bc.v0.z, Bc.v0.w, Bc.v1.x, Bc.v1.y}; PR_ACC(pk_, 0); } \
        __builtin_amdgcn_sched_barrier(0); \
        { const v6u_t pk_ = {Bc.v1.z, Bc.v1.w, Bc.v2.x, Bc.v2.y, Bc.v2.z, Bc.v2.w}; PR_ACC(pk_, 32); } \
        __builtin_amdgcn_sched_barrier(0); } while (0)
    PgBuf B0, B1, B2;
    { const int ida = PR_ID(0), idb = PR_ID(1); PR_ISSUE_U(B0, ida); PR_ISSUE_V(B0, ida); PR_ISSUE_U(B1, idb); PR_ISSUE_V(B1, idb); }
    int id2 = PR_ID(2);
#pragma unroll 1
    for (int b = 0; b < 128; b += 3) {
        PR_STEP(B0, B2, b);
        PR_STEP(B1, B0, b + 1);
        PR_STEP(B2, B1, b + 2);
        if ((b & 7) == 7) __builtin_amdgcn_s_barrier();
    }
#undef PR_ID
#undef PR_ISSUE_U
#undef PR_ISSUE_V
#undef PR_DOT
#undef PR_ACC
#undef PR_STEP
    bf16_t* h = (bf16_t*)(p.ws + WS_H) + (size_t)row_g * 1024 + i * 64;
    const float* m5 = cst + i * 64;
    float ss = 0.f;
#pragma unroll
    for (int q = 0; q < 8; ++q) {
        float hv[8]; unpack8(*(const uint4*)(h + 8 * q), hv);
        const float4 ma = *(const float4*)(m5 + 8 * q), mb = *(const float4*)(m5 + 8 * q + 4);
        const float mm[8] = {ma.x, ma.y, ma.z, ma.w, mb.x, mb.y, mb.z, mb.w};
#pragma unroll
        for (int e = 0; e < 8; ++e) { const float v = hv[e] + mm[e] * y[8 * q + e]; y[8 * q + e] = v; ss += v * v; }
    }
    ss = row16_sum_dpp(ss);
    const float rs = rsqrtf(ss * (1.f / 1024.f) + 1e-6f);
    if (valid) {
        if (!last) {
            const float* gsl = cst + 1024 + i * 64; const float* shl = cst + 2048 + i * 64;
            bf16_t* act = (bf16_t*)(p.ws + WS_ACT) + (size_t)row_g * 1024 + i * 64;
#pragma unroll
            for (int q = 0; q < 8; ++q) {
                *(uint4*)(h + 8 * q) = pack8(&y[8 * q]);
                float o[8];
#pragma unroll
                for (int hq = 0; hq < 2; ++hq) {
                    const float4 gg = *(const float4*)(gsl + 8 * q + 4 * hq), s4 = *(const float4*)(shl + 8 * q + 4 * hq);
                    o[4 * hq + 0] = y[8 * q + 4 * hq + 0] * rs * gg.x + s4.x; o[4 * hq + 1] = y[8 * q + 4 * hq + 1] * rs * gg.y + s4.y;
                    o[4 * hq + 2] = y[8 * q + 4 * hq + 2] * rs * gg.z + s4.z; o[4 * hq + 3] = y[8 * q + 4 * hq + 3] * rs * gg.w + s4.w;
                }
                *(uint4*)(act + 8 * q) = pack8(o);
            }
        } else {
            const float* fg = cst + 1024 + i * 64; float* o = p.out + (size_t)row_g * 1024 + i * 64;
            float4 g0[16];
#pragma unroll
            for (int q = 0; q < 16; ++q) g0[q] = *(const float4*)(fg + q * 4);
#pragma unroll
            for (int q = 0; q < 16; ++q)
                *(float4*)(o + q * 4) = make_float4(y[4 * q + 0] * rs * g0[q].x, y[4 * q + 1] * rs * g0[q].y, y[4 * q + 2] * rs * g0[q].z, y[4 * q + 3] * rs * g0[q].w);
        }
    }
}
__device__ __forceinline__ void peer_gather_row(const Params& p, int row, int l, bool last, unsigned char* lds) {
    float y[64], y16[16];
#pragma unroll
    for (int e = 0; e < 64; ++e) y[e] = 0.f;
    peer_gather_batches(p, row, 0, 32, y);
    pg_reduce_groups(y, y16, lds + (tid_() >> 6) * 16384);
    peer_gather_finish(p, row, l, last, y16);
}
__device__ __forceinline__ void peer_gather_row_split(const Params& p, int row, int l, unsigned char* lds) {
    const int tid = tid_(), lane = tid & 63, wave = tid >> 6;
    float y[64], y16[16];
#pragma unroll
    for (int e = 0; e < 64; ++e) y[e] = 0.f;
    peer_gather_batches(p, row, wave * 4, wave * 4 + 4, y);
    pg_reduce_groups(y, y16, lds + wave * 16384);
    float* part = (float*)(lds + 128 * 1024);
    __syncthreads();
    if (wave > 0) {
#pragma unroll
        for (int q = 0; q < 4; ++q) *(float4*)(part + (wave - 1) * 1024 + lane * 16 + q * 4) = make_float4(y16[q * 4 + 0], y16[q * 4 + 1], y16[q * 4 + 2], y16[q * 4 + 3]);
    }
    __syncthreads();
    if (wave == 0) {
#pragma unroll
        for (int w = 0; w < 7; ++w)
#pragma unroll
            for (int q = 0; q < 4; ++q) { const float4 v = *(const float4*)(part + w * 1024 + lane * 16 + q * 4); y16[q * 4 + 0] += v.x; y16[q * 4 + 1] += v.y; y16[q * 4 + 2] += v.z; y16[q * 4 + 3] += v.w; }
        peer_gather_finish(p, row, l, false, y16);
    }
}

constexpr int GP_ROWS = 13;
__device__ __forceinline__ void gdn_prep_load(const Params& p, int item, u32x4 (&rw)[GP_ROWS + 2]) {
    const int tid = tid_(), r0 = item * GP_ROWS;
    if (tid < 384) {
        const bf16_t* src = (const bf16_t*)(p.ws + WS_QKVR) + tid * 8;
#pragma unroll
        for (int i = 0; i < GP_ROWS + 2; ++i) {
            int rr = r0 + i - 1; rr = rr < 0 ? 0 : (rr > R - 1 ? R - 1 : rr);
            rw[i] = *(const u32x4*)(src + (size_t)rr * 3072);
        }
    }
}
struct GpW { float w0[8], w1[8], w2[8]; };
__device__ __forceinline__ void gdn_prep_weights(const Params& p, GpW& w) {
    const int tid = tid_(); const float* cw = p.in[22] + (tid < 384 ? tid : 0) * 8;
#pragma unroll
    for (int e = 0; e < 8; ++e) { w.w0[e] = cw[e]; w.w1[e] = cw[3072 + e]; w.w2[e] = cw[6144 + e]; }
}
__device__ __forceinline__ void gdn_prep_item(const Params& p, int item, const u32x4 (&rw)[GP_ROWS + 2], const GpW& gw) {
    const int tid = tid_();
    const int r0 = item * GP_ROWS;
    if (tid < 384) {
        const int part = tid >> 7, ch = tid * 8;
        const bf16_t* src = (const bf16_t*)(p.ws + WS_QKVR) + ch;
        bf16_t* dst = (bf16_t*)(p.ws + (part == 0 ? WS_QN : part == 1 ? WS_KN : WS_VN)) + (ch & 1023);
#pragma unroll
        for (int i = 0; i < GP_ROWS; ++i) {
            const u32x4 z4 = {0u, 0u, 0u, 0u};
            const u32x4 a = gp_has_prev(r0 + i) ? rw[i] : z4, bq = rw[i + 1], cq = gp_has_next(r0 + i) ? rw[i + 2] : z4;
            const float xm[8] = {lo2f(a.x), hi2f(a.x), lo2f(a.y), hi2f(a.y), lo2f(a.z), hi2f(a.z), lo2f(a.w), hi2f(a.w)};
            const float x0[8] = {lo2f(bq.x), hi2f(bq.x), lo2f(bq.y), hi2f(bq.y), lo2f(bq.z), hi2f(bq.z), lo2f(bq.w), hi2f(bq.w)};
            const float xp[8] = {lo2f(cq.x), hi2f(cq.x), lo2f(cq.y), hi2f(cq.y), lo2f(cq.z), hi2f(cq.z), lo2f(cq.w), hi2f(cq.w)};
            float f[8], ss = 0.f;
#pragma unroll
            for (int e = 0; e < 8; ++e) { const float v = siluf_(xm[e] * gw.w0[e] + x0[e] * gw.w1[e] + xp[e] * gw.w2[e]); f[e] = v; ss += v * v; }
            if (part < 2) {
                ss += __shfl_xor(ss, 1, 64); ss += __shfl_xor(ss, 2, 64); ss += __shfl_xor(ss, 4, 64); ss += __shfl_xor(ss, 8, 64);
                const float sc = rsqrtf(ss + 1e-6f) * (part == 0 ? 0.08838834764831845f : 1.f);
#pragma unroll
                for (int e = 0; e < 8; ++e) f[e] *= sc;
            }
            if (part == 0) {
                const uint4 pk = pack8(f);
                const int cl = ch & 127, blk = cl & ~31, pc = (cl & 31) >> 2;
                bf16_t* d0 = dst - cl + blk + 8 * (pc & 3) + 4 * (pc >> 2) + (size_t)(r0 + i) * 1024;
                bf16_t* d1 = dst - cl + blk + 8 * ((pc + 1) & 3) + 4 * ((pc + 1) >> 2) + (size_t)(r0 + i) * 1024;
                *(uint2*)d0 = make_uint2(pk.x, pk.y); *(uint2*)d1 = make_uint2(pk.z, pk.w);
            } else *(uint4*)(dst + (size_t)(r0 + i) * 1024) = pack8(f);
        }
    } else if (tid < 384 + 64) {
        const int l = tid - 384;
#pragma unroll
        for (int q = 0; q < 4; ++q) {
            const int v = l * 4 + q, i = v >> 4, dh = v & 15, row = r0 + i;
            if (i >= GP_ROWS) continue;
            const float* ab = (const float*)(p.ws + WS_AB) + (size_t)row * 32;
            const float a = ab[dh] + p.in[24][dh], b = ab[16 + dh];
            const float sp = a > 20.f ? a : log1pf(__expf(a));
            ((float*)(p.ws + WS_GG))[(size_t)dh * R + row] = -__expf(p.in[23][dh]) * sp;
            ((float*)(p.ws + WS_BETA))[(size_t)dh * R + row] = sigmoidf_(b);
        }
    }
}

constexpr int GU_LDQ = 136, GU_LDT = 72, GU_LDA = 68;
constexpr int GU_SQ = 0, GU_SK = 17408, GU_SKB = 34816, GU_SVBT = 52224, GU_SKGT = 70656, GU_SA = 89088, GU_SAT = 106496, GU_ST = 123904, GU_SG = 133120;
__device__ __forceinline__ int perm_slot64(int pos) { return 32 * (pos >> 5) + 8 * ((pos >> 2) & 3) + 4 * ((pos >> 4) & 1) + (pos & 3); }
struct GuPre { u32x4 q[2], k[2], v[2]; float g, beta; };
__device__ __forceinline__ void gu_prefetch(const Params& p, int u, GuPre& pre) {
    const int tid = tid_(), lane = tid & 63;
    const int dh = u / NCH, c = u % NCH, dir = dh >> 3, head = dh & 7;
#pragma unroll
    for (int q = 0; q < 2; ++q) {
        const int t = tid + q * NTHREADS, i = t >> 4, d8 = (t & 15) * 8;
        const size_t ro = (size_t)(c * 64 + (dir ? 63 - i : i)) * 1024 + head * 128 + d8;
        pre.q[q] = *(const u32x4*)((const bf16_t*)(p.ws + WS_QN) + ro);
        pre.k[q] = *(const u32x4*)((const bf16_t*)(p.ws + WS_KN) + ro);
        pre.v[q] = *(const u32x4*)((const bf16_t*)(p.ws + WS_VN) + ro);
    }
    const int row = c * 64 + (dir ? 63 - lane : lane);
    pre.g = ((const float*)(p.ws + WS_GG))[(size_t)dh * R + row];
    pre.beta = ((const float*)(p.ws + WS_BETA))[(size_t)dh * R + row];
}
typedef short gu_s16x4_t __attribute__((ext_vector_type(4)));
__device__ __forceinline__ bf16x8 nat_frag(const bf16_t* T, int ct, int k2, int rr, int q4) {
    typedef LAS gu_s16x4_t lds_v4;
    const LAS short* a0 = (const LAS short*)(const LAS unsigned char*)(const unsigned char*)(T + (32 * k2 + 8 * q4 + (rr >> 2)) * GU_LDQ + 16 * ct + 4 * (rr & 3));
    const gu_s16x4_t r0 = __builtin_amdgcn_ds_read_tr16_b64_v4i16((lds_v4*)a0);
    const gu_s16x4_t r1 = __builtin_amdgcn_ds_read_tr16_b64_v4i16((lds_v4*)(a0 + 4 * GU_LDQ));
    return (bf16x8){r0[0], r0[1], r0[2], r0[3], r1[0], r1[1], r1[2], r1[3]};
}
struct GuOut { u32x2 o[4], w[4]; };
__device__ __forceinline__ void gu_flush(const Params& p, int u, const GuOut& po) {
    const int tid = tid_(), lane = tid & 63, wave = tid >> 6, rr = lane & 15, q4 = lane >> 4;
    bf16_t* ut = (bf16_t*)(p.ws + WS_UT) + (size_t)u * 128 * 64;
    bf16_t* wg = (bf16_t*)(p.ws + WS_W) + (size_t)u * 64 * 128;
#pragma unroll
    for (int m = 0; m < 4; ++m) {
        *(u32x2*)(ut + (size_t)(16 * wave + rr) * 64 + 16 * q4 + 4 * m) = po.o[m];
        *(u32x2*)(wg + (size_t)(16 * m + rr) * 128 + 32 * (wave >> 1) + 8 * q4 + 4 * (wave & 1)) = po.w[m];
    }
}
__device__ __forceinline__ void gdn_unit(const Params& p, int u, int u_next, GuPre& pre, GuOut& po, int u_prev, unsigned char* lds) {
    const int tid = tid_(), lane = tid & 63, wave = tid >> 6;
    gu_flush(p, u_prev, po);
    const int dh = u / NCH, c = u % NCH, dir = dh >> 3, head = dh & 7;
    bf16_t* sQ = (bf16_t*)(lds + GU_SQ); bf16_t* sK = (bf16_t*)(lds + GU_SK); bf16_t* sKB = (bf16_t*)(lds + GU_SKB);
    bf16_t* sVBT = (bf16_t*)(lds + GU_SVBT); bf16_t* sKGT = (bf16_t*)(lds + GU_SKGT);
    float* sA = (float*)(lds + GU_SA); float* sAT = (float*)(lds + GU_SAT); bf16_t* sT = (bf16_t*)(lds + GU_ST);
    float* sG = (float*)(lds + GU_SG); float* sBeta = sG + 64;
    lds_barrier();
    if (wave == 0) {
        float g = pre.g;
#pragma unroll
        for (int o = 1; o < 64; o <<= 1) { const float t = __shfl_up(g, o, 64); if (lane >= o) g += t; }
        sG[lane] = g; sBeta[lane] = pre.beta;
        ((float*)(p.ws + WS_GC))[(size_t)u * 64 + lane] = g;
    }
    lds_barrier();
#pragma unroll
    for (int qq = 0; qq < 2; ++qq) {
        const int t = tid + qq * NTHREADS, i = t >> 4, d8 = (t & 15) * 8;
        const u32x4 q = pre.q[qq], k = pre.k[qq], v = pre.v[qq];
        const float beta = sBeta[i], eg = __expf(sG[i]);
        const float kf[8] = {lo2f(k.x), hi2f(k.x), lo2f(k.y), hi2f(k.y), lo2f(k.z), hi2f(k.z), lo2f(k.w), hi2f(k.w)};
        const float vf[8] = {lo2f(v.x), hi2f(v.x), lo2f(v.y), hi2f(v.y), lo2f(v.z), hi2f(v.z), lo2f(v.w), hi2f(v.w)};
        float kb[8];
#pragma unroll
        for (int e = 0; e < 8; ++e) kb[e] = kf[e] * beta;
        const u32x4 kbp = {pack2(kb[0], kb[1]), pack2(kb[2], kb[3]), pack2(kb[4], kb[5]), pack2(kb[6], kb[7])};
        {
            const int blk = d8 & ~31, qp = (d8 & 31) >> 3;
            *(u32x2*)(sQ + i * GU_LDQ + blk + 4 * qp) = (u32x2){q.x, q.y}; *(u32x2*)(sQ + i * GU_LDQ + blk + 16 + 4 * qp) = (u32x2){q.z, q.w};
        }
        *(u32x4*)(sK + i * GU_LDQ + d8) = k; *(u32x4*)(sKB + i * GU_LDQ + d8) = kbp;
        {
            float vb8[8], kg8[8];
#pragma unroll
            for (int e = 0; e < 8; ++e) { vb8[e] = vf[e] * beta; kg8[e] = kb[e] * eg; }
            const uint4 pv = pack8(vb8), pk = pack8(kg8);
            *(u32x4*)(sVBT + i * GU_LDQ + d8) = (u32x4){pv.x, pv.y, pv.z, pv.w}; *(u32x4*)(sKGT + i * GU_LDQ + d8) = (u32x4){pk.x, pk.y, pk.z, pk.w};
        }
    }
    if (u_next < NUNITS) gu_prefetch(p, u_next, pre);
    lds_barrier();
    {
        const int mat = wave >> 2, mt = wave & 3, rr = lane & 15, q4 = lane >> 4;
        const bf16_t* sX = mat ? sQ : sKB;
        f32x4 acc[4];
#pragma unroll
        for (int nt = 0; nt < 4; ++nt) acc[nt] = (f32x4){0.f, 0.f, 0.f, 0.f};
#pragma unroll
        for (int kk = 0; kk < 4; ++kk) {
            const bf16x8 a = *(const bf16x8*)(sX + (16 * mt + rr) * GU_LDQ + kk * 32 + 8 * q4);
#pragma unroll
            for (int nt = 0; nt < 4; ++nt) {
                const bf16x8 b = *(const bf16x8*)(sK + (16 * nt + rr) * GU_LDQ + kk * 32 + 8 * q4);
                acc[nt] = __builtin_amdgcn_mfma_f32_16x16x32_bf16(a, b, acc[nt], 0, 0, 0);
            }
        }
        float* dstm = mat ? sAT : sA;
        float gi[4], gjv[4];
#pragma unroll
        for (int jj = 0; jj < 4; ++jj) { gi[jj] = sG[16 * mt + 4 * q4 + jj]; gjv[jj] = sG[16 * jj + rr]; }
#pragma unroll
        for (int nt = 0; nt < 4; ++nt) {
            const int j = 16 * nt + rr;
#pragma unroll
            for (int jj = 0; jj < 4; ++jj) {
                const int i = 16 * mt + 4 * q4 + jj;
                const bool keep = mat ? (j <= i) : (j < i);
                const float e = __expf(keep ? gi[jj] - gjv[nt] : 0.f);
                const float val = acc[nt][jj] * e;
                dstm[i * GU_LDA + j] = keep ? val : 0.f;
            }
        }
    }
    lds_barrier();
    float* sD = (float*)(lds + GU_SQ);
    if (wave < 4) {
        if (lane < 16) {
            float d[16];
            const float* Ab = sA + (16 * wave) * GU_LDA + 16 * wave;
            float4 cur[4], nxt[4];
#pragma unroll
            for (int q = 0; q < 4; ++q) cur[q] = *(const float4*)(Ab + GU_LDA + 4 * q);
            d[0] = (lane == 0) ? 1.f : 0.f;
#pragma unroll
            for (int i = 1; i < 16; ++i) {
                if (i < 15) {
#pragma unroll
                    for (int q = 0; q < 4; ++q) if (4 * q < i + 1) nxt[q] = *(const float4*)(Ab + (i + 1) * GU_LDA + 4 * q);
                }
                float a = (i == lane) ? 1.f : 0.f;
#pragma unroll
                for (int j = 0; j < i; ++j) { const float4 c4 = cur[j >> 2]; const float aij = (j & 3) == 0 ? c4.x : (j & 3) == 1 ? c4.y : (j & 3) == 2 ? c4.z : c4.w; a -= aij * d[j]; }
                d[i] = a;
#pragma unroll
                for (int q = 0; q < 4; ++q) cur[q] = nxt[q];
            }
#pragma unroll
            for (int i = 0; i < 16; ++i) sD[(wave * 16 + i) * 16 + lane] = d[i];
        }
    } else {
        bf16_t* att = (bf16_t*)(p.ws + WS_ATT) + (size_t)u * 64 * 64;
        for (int t = tid - 256; t < 512; t += 256) {
            const int i = t >> 3, kk2 = (t >> 2) & 1, qq = t & 3;
            const float4 lo = *(const float4*)(sAT + i * GU_LDA + 32 * kk2 + 4 * qq), hi = *(const float4*)(sAT + i * GU_LDA + 32 * kk2 + 16 + 4 * qq);
            uint4 o; o.x = pack2(lo.x, lo.y); o.y = pack2(lo.z, lo.w); o.z = pack2(hi.x, hi.y); o.w = pack2(hi.z, hi.w);
            *(uint4*)(att + i * 64 + 32 * kk2 + 8 * qq) = o;
        }
    }
    lds_barrier();
    if (wave < 4) {
        const int rr = lane & 15, q4 = lane >> 4;
        f32x4 Tt[4];
#pragma unroll
        for (int m = 0; m < 4; ++m) Tt[m] = (f32x4){0.f, 0.f, 0.f, 0.f};
#pragma unroll
        for (int b = 0; b < 4; ++b) {
            if (b >= wave) {
                f32x4 X = (f32x4){0.f, 0.f, 0.f, 0.f};
#pragma unroll
                for (int kk = 0; kk < 2; ++kk) {
                    if (2 * kk < b) {
                        const float* Ar = sA + (16 * b + rr) * GU_LDA + 32 * kk + 4 * q4;
                        const float4 lo = *(const float4*)Ar;
                        float4 hi = make_float4(0.f, 0.f, 0.f, 0.f);
                        if (2 * kk + 1 < b) hi = *(const float4*)(Ar + 16);
                        const u32x4 ap = {pack2(lo.x, lo.y), pack2(lo.z, lo.w), pack2(hi.x, hi.y), pack2(hi.z, hi.w)};
                        const u32x4 bp = {pack2(Tt[2 * kk][0], Tt[2 * kk][1]), pack2(Tt[2 * kk][2], Tt[2 * kk][3]),
                                          pack2(Tt[2 * kk + 1][0], Tt[2 * kk + 1][1]), pack2(Tt[2 * kk + 1][2], Tt[2 * kk + 1][3])};
                        X = __builtin_amdgcn_mfma_f32_16x16x32_bf16(__builtin_bit_cast(bf16x8, ap), __builtin_bit_cast(bf16x8, bp), X, 0, 0, 0);
                    }
                }
                float y[4];
#pragma unroll
                for (int jj = 0; jj < 4; ++jj) y[jj] = ((b == wave && 4 * q4 + jj == rr) ? 1.f : 0.f) - X[jj];
                const float4 dv4 = *(const float4*)(sD + (b * 16 + rr) * 16 + 4 * q4);
                const u32x4 ap = {pack2(dv4.x, dv4.y), pack2(dv4.z, dv4.w), 0u, 0u};
                const u32x4 bp = {pack2(y[0], y[1]), pack2(y[2], y[3]), 0u, 0u};
                const f32x4 z4 = (f32x4){0.f, 0.f, 0.f, 0.f};
                Tt[b] = __builtin_amdgcn_mfma_f32_16x16x32_bf16(__builtin_bit_cast(bf16x8, ap), __builtin_bit_cast(bf16x8, bp), z4, 0, 0, 0);
            }
#pragma unroll
            for (int jj = 0; jj < 4; ++jj) sT[(16 * b + 4 * q4 + jj) * GU_LDT + 16 * wave + rr] = f2bf(Tt[b][jj]);
        }
    }
    lds_barrier();
    {
        const int rr = lane & 15, q4 = lane >> 4;
        f32x4 au[4], aw[4];
#pragma unroll
        for (int m = 0; m < 4; ++m) { au[m] = (f32x4){0.f, 0.f, 0.f, 0.f}; aw[m] = (f32x4){0.f, 0.f, 0.f, 0.f}; }
#pragma unroll
        for (int kk2 = 0; kk2 < 2; ++kk2) {
            const bf16x8 bv = nat_frag(sVBT, wave, kk2, rr, q4);
            const bf16x8 ak = nat_frag(sKGT, wave, kk2, rr, q4);
#pragma unroll
            for (int m = 0; m < 4; ++m) {
                const bf16x8 tf = *(const bf16x8*)(sT + (16 * m + rr) * GU_LDT + kk2 * 32 + 8 * q4);
                au[m] = __builtin_amdgcn_mfma_f32_16x16x32_bf16(tf, bv, au[m], 0, 0, 0);
                aw[m] = __builtin_amdgcn_mfma_f32_16x16x32_bf16(ak, tf, aw[m], 0, 0, 0);
            }
        }
#pragma unroll
        for (int m = 0; m < 4; ++m) {
            po.o[m] = (u32x2){pack2(au[m][0], au[m][1]), pack2(au[m][2], au[m][3])};
            po.w[m] = (u32x2){pack2(aw[m][0], aw[m][1]), pack2(aw[m][2], aw[m][3])};
        }
    }
}

constexpr int GS_SW = 0, GS_SQD = 17408, GS_SKDT = 34816, GS_SATT = 53248, GS_BUF = 62464, GS_OT = 64 * 136 * 2;
__device__ __forceinline__ int gdn_chain_chunk(int dir, int s) { return dir == 0 ? (s < 4 ? NCH_LAT + s : s - 4) : NCH - 1 - s; }
struct GsG1 { u32x4 w[2]; u32x4 att; };
struct GsG2 { u32x2 qlo[2], qhi[2]; float gq[2]; };
struct GsG3 { u32x4 kd[2]; float gk[2]; float gl; u32x2 ut[4]; };
__device__ __forceinline__ void gs_load1(const Params& p, int dh, int c, GsG1& st) {
    const int tid = tid_(); const size_t u = (size_t)dh * NCH + c;
    const bf16_t* wg = (const bf16_t*)(p.ws + WS_W) + u * 64 * 128; const bf16_t* att = (const bf16_t*)(p.ws + WS_ATT) + u * 64 * 64;
#pragma unroll
    for (int q = 0; q < 2; ++q) { const int t = tid + q * NTHREADS; st.w[q] = *(const u32x4*)(wg + (size_t)(t >> 4) * 128 + (t & 15) * 8); }
    st.att = *(const u32x4*)(att + (size_t)(tid >> 3) * 64 + (tid & 7) * 8);
}
__device__ __forceinline__ void gs_store1(const GsG1& st, unsigned char* buf) {
    const int tid = tid_(); bf16_t* sW = (bf16_t*)(buf + GS_SW); bf16_t* sATT = (bf16_t*)(buf + GS_SATT);
#pragma unroll
    for (int q = 0; q < 2; ++q) { const int t = tid + q * NTHREADS; *(u32x4*)(sW + (t >> 4) * GU_LDQ + (t & 15) * 8) = st.w[q]; }
    *(u32x4*)(sATT + (tid >> 3) * GU_LDT + (tid & 7) * 8) = st.att;
}
__device__ __forceinline__ void gs_load2(const Params& p, int dh, int c, GsG2& st) {
    const int tid = tid_(), dir = dh >> 3, head = dh & 7; const size_t u = (size_t)dh * NCH + c;
    const float* gc = (const float*)(p.ws + WS_GC) + u * 64; const bf16_t* qn = (const bf16_t*)(p.ws + WS_QN);
#pragma unroll
    for (int q = 0; q < 2; ++q) {
        const int t = tid + q * NTHREADS, i = t >> 4, kk = (t >> 2) & 3, qq = t & 3;
        const bf16_t* src = qn + (size_t)(c * 64 + (dir ? 63 - i : i)) * 1024 + head * 128 + 32 * kk + 8 * qq;
        st.qlo[q] = *(const u32x2*)src; st.qhi[q] = *(const u32x2*)(src + 4); st.gq[q] = gc[i];
    }
}
__device__ __forceinline__ void gs_store2(const GsG2& st, unsigned char* buf) {
    const int tid = tid_(); bf16_t* sQD = (bf16_t*)(buf + GS_SQD);
#pragma unroll
    for (int q = 0; q < 2; ++q) {
        const int t = tid + q * NTHREADS, i = t >> 4, kk = (t >> 2) & 3, qq = t & 3; const float e = __expf(st.gq[q]);
        u32x4 o; o.x = pack2(lo2f(st.qlo[q].x) * e, hi2f(st.qlo[q].x) * e); o.y = pack2(lo2f(st.qlo[q].y) * e, hi2f(st.qlo[q].y) * e);
        o.z = pack2(lo2f(st.qhi[q].x) * e, hi2f(st.qhi[q].x) * e); o.w = pack2(lo2f(st.qhi[q].y) * e, hi2f(st.qhi[q].y) * e);
        *(u32x4*)(sQD + i * GU_LDQ + 32 * kk + 8 * qq) = o;
    }
}
__device__ __forceinline__ void gs_load3(const Params& p, int dh, int c, GsG3& st) {
    const int tid = tid_(), lane = tid & 63, wave = tid >> 6, dir = dh >> 3, head = dh & 7; const size_t u = (size_t)dh * NCH + c;
    const float* gc = (const float*)(p.ws + WS_GC) + u * 64; const bf16_t* kn = (const bf16_t*)(p.ws + WS_KN);
    st.gl = gc[63];
#pragma unroll
    for (int q = 0; q < 2; ++q) {
        const int t = tid + q * NTHREADS, pos = t >> 4, d8 = (t & 15) * 8;
        st.kd[q] = *(const u32x4*)(kn + (size_t)(c * 64 + (dir ? 63 - pos : pos)) * 1024 + head * 128 + d8); st.gk[q] = gc[pos];
    }
    const bf16_t* ut = (const bf16_t*)(p.ws + WS_UT) + u * 128 * 64 + (size_t)(16 * wave + (lane & 15)) * 64 + 16 * (lane >> 4);
#pragma unroll
    for (int m = 0; m < 4; ++m) st.ut[m] = *(const u32x2*)(ut + 4 * m);
}
__device__ __forceinline__ void gs_store3(const GsG3& st, unsigned char* buf) {
    const int tid = tid_(); bf16_t* sKD = (bf16_t*)(buf + GS_SKDT);
#pragma unroll
    for (int q = 0; q < 2; ++q) {
        const int t = tid + q * NTHREADS, pos = t >> 4, d8 = (t & 15) * 8; const float e = __expf(st.gl - st.gk[q]);
        const u32x4 kq = st.kd[q];
        u32x4 o; o.x = pack2(lo2f(kq.x) * e, hi2f(kq.x) * e); o.y = pack2(lo2f(kq.y) * e, hi2f(kq.y) * e); o.z = pack2(lo2f(kq.z) * e, hi2f(kq.z) * e); o.w = pack2(lo2f(kq.w) * e, hi2f(kq.w) * e);
        *(u32x4*)(sKD + pos * GU_LDQ + d8) = o;
    }
}
typedef short s16x4_t __attribute__((ext_vector_type(4)));
__device__ __forceinline__ bf16x8 kd_frag(const bf16_t* sKD, int m, int k2, int rr, int q4) {
    typedef LAS s16x4_t lds_s16x4;
    const LAS short* a0 = (const LAS short*)(const LAS unsigned char*)(const unsigned char*)(sKD + (32 * k2 + 4 * q4 + (rr >> 2)) * GU_LDQ + 16 * m + 4 * (rr & 3));
    const s16x4_t r0 = __builtin_amdgcn_ds_read_tr16_b64_v4i16((lds_s16x4*)a0);
    const s16x4_t r1 = __builtin_amdgcn_ds_read_tr16_b64_v4i16((lds_s16x4*)(a0 + 16 * GU_LDQ));
    return (bf16x8){r0[0], r0[1], r0[2], r0[3], r1[0], r1[1], r1[2], r1[3]};
}
template <bool first>
__device__ __forceinline__ void gdn_seg_ab(const Params& p, int dh, int k, unsigned char* lds) {
    const int tid = tid_(), lane = tid & 63, wave = tid >> 6, rr = lane & 15, q4 = lane >> 4, dir = dh >> 3;
    const int s_begin = first ? 0 : 4 + 16 * k, nsteps = first ? 20 : 16;
    f32x4 ScB[8], ScA[8]; bf16x8 SbB[4], SbA[4];
#pragma unroll
    for (int m = 0; m < 8; ++m) {
        ScB[m] = (f32x4){0.f, 0.f, 0.f, 0.f};
#pragma unroll
        for (int jj = 0; jj < 4; ++jj) ScA[m][jj] = (16 * m + 4 * q4 + jj == 16 * wave + rr) ? 1.f : 0.f;
    }
#pragma unroll
    for (int kk = 0; kk < 4; ++kk) {
        SbB[kk] = (bf16x8){0, 0, 0, 0, 0, 0, 0, 0};
        const u32x4 pk = {pack2(ScA[2 * kk][0], ScA[2 * kk][1]), pack2(ScA[2 * kk][2], ScA[2 * kk][3]),
                          pack2(ScA[2 * kk + 1][0], ScA[2 * kk + 1][1]), pack2(ScA[2 * kk + 1][2], ScA[2 * kk + 1][3])};
        SbA[kk] = __builtin_bit_cast(bf16x8, pk);
    }
    u32x2 ucur[4]; float glcur;
    float4* sin_img = (float4*)(p.ws + WS_SIN) + (size_t)(dh * 16) * 4096;
    __syncthreads();
    {
        const int c0 = gdn_chain_chunk(dir, s_begin);
        GsG1 g1; gs_load1(p, dh, c0, g1); gs_store1(g1, lds);
        GsG3 g3; gs_load3(p, dh, c0, g3); gs_store3(g3, lds);
#pragma unroll
        for (int m = 0; m < 4; ++m) ucur[m] = g3.ut[m];
        glcur = g3.gl;
    }
    __syncthreads();
    GsG1 g1a, g1b; GsG3 g3a, g3b;
    { const int c1 = gdn_chain_chunk(dir, s_begin + 1); gs_load1(p, dh, c1, g1a); gs_load3(p, dh, c1, g3a); }
    auto step = [&](const int t, GsG1& g1, GsG3& g3, GsG1& n1, GsG3& n3) __attribute__((always_inline)) {
        const int cn = gdn_chain_chunk(dir, s_begin + (t + 2 < nsteps ? t + 2 : nsteps - 1));
        const unsigned char* buf = lds + (t & 1) * GS_BUF; unsigned char* nbuf = lds + ((t + 1) & 1) * GS_BUF;
        const bf16_t* sW = (const bf16_t*)(buf + GS_SW); const bf16_t* sKDT = (const bf16_t*)(buf + GS_SKDT);
        gs_load1(p, dh, cn, n1);
        gs_load3(p, dh, cn, n3);
        __builtin_amdgcn_sched_barrier(0);
        f32x4 vb_[4], va_[4];
#pragma unroll
        for (int m = 0; m < 4; ++m) {
            f32x4 accb = (f32x4){0.f, 0.f, 0.f, 0.f}, acca = (f32x4){0.f, 0.f, 0.f, 0.f};
#pragma unroll
            for (int kk = 0; kk < 4; ++kk) {
                const bf16x8 a = *(const bf16x8*)(sW + (16 * m + rr) * GU_LDQ + kk * 32 + 8 * q4);
                accb = __builtin_amdgcn_mfma_f32_16x16x32_bf16(a, SbB[kk], accb, 0, 0, 0);
                if (!first) acca = __builtin_amdgcn_mfma_f32_16x16x32_bf16(a, SbA[kk], acca, 0, 0, 0);
            }
            vb_[m][0] = lo2f(ucur[m].x) - accb[0]; vb_[m][1] = hi2f(ucur[m].x) - accb[1]; vb_[m][2] = lo2f(ucur[m].y) - accb[2]; vb_[m][3] = hi2f(ucur[m].y) - accb[3];
            va_[m] = -acca;
        }
        bf16x8 VBb[2], VBa[2];
#pragma unroll
        for (int k2 = 0; k2 < 2; ++k2) {
            const u32x4 pb = {pack2(vb_[2 * k2][0], vb_[2 * k2][1]), pack2(vb_[2 * k2][2], vb_[2 * k2][3]), pack2(vb_[2 * k2 + 1][0], vb_[2 * k2 + 1][1]), pack2(vb_[2 * k2 + 1][2], vb_[2 * k2 + 1][3])};
            const u32x4 pa = {pack2(va_[2 * k2][0], va_[2 * k2][1]), pack2(va_[2 * k2][2], va_[2 * k2][3]), pack2(va_[2 * k2 + 1][0], va_[2 * k2 + 1][1]), pack2(va_[2 * k2 + 1][2], va_[2 * k2 + 1][3])};
            VBb[k2] = __builtin_bit_cast(bf16x8, pb); VBa[k2] = __builtin_bit_cast(bf16x8, pa);
        }
        const float egl = __expf(glcur);
#pragma unroll
        for (int m = 0; m < 8; ++m) {
            f32x4 accb = ScB[m] * egl, acca = ScA[m] * egl;
#pragma unroll
            for (int k2 = 0; k2 < 2; ++k2) {
                const bf16x8 a = kd_frag(sKDT, m, k2, rr, q4);
                accb = __builtin_amdgcn_mfma_f32_16x16x32_bf16(a, VBb[k2], accb, 0, 0, 0);
                if (!first) acca = __builtin_amdgcn_mfma_f32_16x16x32_bf16(a, VBa[k2], acca, 0, 0, 0);
            }
            ScB[m] = accb; ScA[m] = acca;
        }
#pragma unroll
        for (int kk = 0; kk < 4; ++kk) {
            const u32x4 pb = {pack2(ScB[2 * kk][0], ScB[2 * kk][1]), pack2(ScB[2 * kk][2], ScB[2 * kk][3]), pack2(ScB[2 * kk + 1][0], ScB[2 * kk + 1][1]), pack2(ScB[2 * kk + 1][2], ScB[2 * kk + 1][3])};
            const u32x4 pa = {pack2(ScA[2 * kk][0], ScA[2 * kk][1]), pack2(ScA[2 * kk][2], ScA[2 * kk][3]), pack2(ScA[2 * kk + 1][0], ScA[2 * kk + 1][1]), pack2(ScA[2 * kk + 1][2], ScA[2 * kk + 1][3])};
            SbB[kk] = __builtin_bit_cast(bf16x8, pb); SbA[kk] = __builtin_bit_cast(bf16x8, pa);
        }
        gs_store1(g1, nbuf); gs_store3(g3, nbuf);
#pragma unroll
        for (int m = 0; m < 4; ++m) ucur[m] = g3.ut[m];
        glcur = g3.gl;
        if (first && t == 3) {
#pragma unroll
            for (int m = 0; m < 8; ++m) sin_img[(wave * 8 + m) * 64 + lane] = make_float4(ScB[m][0], ScB[m][1], ScB[m][2], ScB[m][3]);
        }
        lds_barrier();
    };
#pragma unroll 1
    for (int t = 0; t < nsteps; t += 2) {
        step(t, g1a, g3a, g1b, g3b);
        step(t + 1, g1b, g3b, g1a, g3a);
    }
    if (first) {
#pragma unroll
        for (int m = 0; m < 8; ++m) sin_img[4096 + (wave * 8 + m) * 64 + lane] = make_float4(ScB[m][0], ScB[m][1], ScB[m][2], ScB[m][3]);
    } else {
        float4* bimg = (float4*)(p.ws + WS_BSEG) + (size_t)(dh * 16 + k) * 4096;
        bf16_t* aseg = (bf16_t*)(p.ws + WS_ASEG) + (size_t)(dh * 16 + k) * 128 * 128;
        const int pc = perm_slot64(16 * wave + rr);
#pragma unroll
        for (int m = 0; m < 8; ++m) {
            bimg[(wave * 8 + m) * 64 + lane] = make_float4(ScB[m][0], ScB[m][1], ScB[m][2], ScB[m][3]);
#pragma unroll
            for (int jj = 0; jj < 4; ++jj) aseg[(size_t)(16 * m + 4 * q4 + jj) * 128 + pc] = f2bf(ScA[m][jj]);
        }
    }
}
__device__ __forceinline__ void gdn_seg_chain(const Params& p, int dh, unsigned char* lds) {
    const int tid = tid_(), lane = tid & 63, wave = tid >> 6, rr = lane & 15, q4 = lane >> 4;
    float4* sin_img = (float4*)(p.ws + WS_SIN) + (size_t)(dh * 16) * 4096;
    const float4* bimg = (const float4*)(p.ws + WS_BSEG) + (size_t)(dh * 16) * 4096;
    const bf16_t* aseg = (const bf16_t*)(p.ws + WS_ASEG) + (size_t)(dh * 16) * 128 * 128;
    f32x4 Sc[8]; bf16x8 Sb[4];
#pragma unroll
    for (int m = 0; m < 8; ++m) { const float4 v = sin_img[4096 + (wave * 8 + m) * 64 + lane]; Sc[m] = (f32x4){v.x, v.y, v.z, v.w}; }
    u32x4 arA[4], arB[4]; f32x4 bn[8];
#define SC_LOADA(dst, kq) do { const int kq_ = (kq) < 14 ? (kq) : 14; _Pragma("unroll") for (int q = 0; q < 4; ++q) { const int t = tid + q * NTHREADS; \
        dst[q] = *(const u32x4*)(aseg + (size_t)kq_ * 16384 + (size_t)(t >> 4) * 128 + (t & 15) * 8); } } while (0)
#define SC_STOREA(src, bufi) do { _Pragma("unroll") for (int q = 0; q < 4; ++q) { const int t = tid + q * NTHREADS; \
        *(u32x4*)((bf16_t*)(lds + (bufi) * 34816) + (t >> 4) * GU_LDQ + (t & 15) * 8) = src[q]; } } while (0)
#define SC_STEP(k_, ARc, ARn) do { \
        const bf16_t* sA = (const bf16_t*)(lds + (((k_) - 1) & 1) * 34816); \
        SC_LOADA(ARn, (k_) + 2); \
        f32x4 bc[8]; const int kn_ = (k_) < 14 ? (k_) + 1 : 14; \
        _Pragma("unroll") for (int m = 0; m < 8; ++m) { bc[m] = bn[m]; const float4 bv = bimg[(size_t)kn_ * 4096 + (wave * 8 + m) * 64 + lane]; bn[m] = (f32x4){bv.x, bv.y, bv.z, bv.w}; } \
        __builtin_amdgcn_sched_barrier(0); \
        _Pragma("unroll") for (int kk = 0; kk < 4; ++kk) { \
            const u32x4 pk = {pack2(Sc[2 * kk][0], Sc[2 * kk][1]), pack2(Sc[2 * kk][2], Sc[2 * kk][3]), pack2(Sc[2 * kk + 1][0], Sc[2 * kk + 1][1]), pack2(Sc[2 * kk + 1][2], Sc[2 * kk + 1][3])}; \
            Sb[kk] = __builtin_bit_cast(bf16x8, pk); } \
        { bf16x8 fr[2][2][4];              \
          _Pragma("unroll") for (int h_ = 0; h_ < 2; ++h_) _Pragma("unroll") for (int kk = 0; kk < 4; ++kk) fr[0][h_][kk] = *(const bf16x8*)(sA + (16 * h_ + rr) * GU_LDQ + kk * 32 + 8 * q4); \
          _Pragma("unroll") for (int mp = 0; mp < 4; ++mp) { \
            if (mp < 3) { _Pragma("unroll") for (int h_ = 0; h_ < 2; ++h_) _Pragma("unroll") for (int kk = 0; kk < 4; ++kk) \
                fr[(mp + 1) & 1][h_][kk] = *(const bf16x8*)(sA + (16 * (2 * mp + 2 + h_) + rr) * GU_LDQ + kk * 32 + 8 * q4); } \
            __builtin_amdgcn_sched_barrier(0); \
            f32x4 acc0 = bc[2 * mp], acc1 = bc[2 * mp + 1]; \
            _Pragma("unroll") for (int kk = 0; kk < 4; ++kk) { \
                acc0 = __builtin_amdgcn_mfma_f32_16x16x32_bf16(fr[mp & 1][0][kk], Sb[kk], acc0, 0, 0, 0); \
                acc1 = __builtin_amdgcn_mfma_f32_16x16x32_bf16(fr[mp & 1][1][kk], Sb[kk], acc1, 0, 0, 0); } \
            Sc[2 * mp] = acc0; Sc[2 * mp + 1] = acc1; \
            sin_img[(size_t)((k_) + 1) * 4096 + (wave * 8 + 2 * mp) * 64 + lane] = make_float4(acc0[0], acc0[1], acc0[2], acc0[3]); \
            sin_img[(size_t)((k_) + 1) * 4096 + (wave * 8 + 2 * mp + 1) * 64 + lane] = make_float4(acc1[0], acc1[1], acc1[2], acc1[3]); \
            __builtin_amdgcn_sched_barrier(0); } } \
        SC_STOREA(ARc, (k_) & 1);          \
        lds_barrier(); } while (0)
    lds_barrier();
    SC_LOADA(arB, 1); SC_LOADA(arA, 2);
#pragma unroll
    for (int m = 0; m < 8; ++m) { const float4 bv = bimg[(size_t)1 * 4096 + (wave * 8 + m) * 64 + lane]; bn[m] = (f32x4){bv.x, bv.y, bv.z, bv.w}; }
    SC_STOREA(arB, 0);
    lds_barrier();
#pragma unroll 1
    for (int k = 1; k <= 14; k += 2) {
        SC_STEP(k, arA, arB);
        SC_STEP(k + 1, arB, arA);
    }
#undef SC_LOADA
#undef SC_STOREA
#undef SC_STEP
}
__device__ __forceinline__ void gdn_seq(const Params& p, int dh, int k, unsigned char* lds) {
    const int tid = tid_(), lane = tid & 63, wave = tid >> 6, rr = lane & 15, q4 = lane >> 4, dir = dh >> 3, head = dh & 7;
    const int s_begin = 4 + 16 * k;
    f32x4 Sc[8]; bf16x8 Sb[4];
    {
        const float4* sin_img = (const float4*)(p.ws + WS_SIN) + (size_t)(dh * 16 + k) * 4096;
#pragma unroll
        for (int m = 0; m < 8; ++m) { const float4 v = sin_img[(wave * 8 + m) * 64 + lane]; Sc[m] = (f32x4){v.x, v.y, v.z, v.w}; }
#pragma unroll
        for (int kk = 0; kk < 4; ++kk) {
            const u32x4 pk = {pack2(Sc[2 * kk][0], Sc[2 * kk][1]), pack2(Sc[2 * kk][2], Sc[2 * kk][3]), pack2(Sc[2 * kk + 1][0], Sc[2 * kk + 1][1]), pack2(Sc[2 * kk + 1][2], Sc[2 * kk + 1][3])};
            Sb[kk] = __builtin_bit_cast(bf16x8, pk);
        }
    }
    u32x2 ucur[4]; float glcur;
    __syncthreads();
    {
        const int c0 = gdn_chain_chunk(dir, s_begin);
        GsG1 g1; gs_load1(p, dh, c0, g1); gs_store1(g1, lds);
        GsG2 g2; gs_load2(p, dh, c0, g2); gs_store2(g2, lds);
        GsG3 g3; gs_load3(p, dh, c0, g3); gs_store3(g3, lds);
#pragma unroll
        for (int m = 0; m < 4; ++m) ucur[m] = g3.ut[m];
        glcur = g3.gl;
    }
    __syncthreads();
    bf16_t* of = (bf16_t*)(p.ws + WS_OF) + (size_t)dir * SEQ * 1024;
#pragma unroll 1
    for (int t = 0; t < 16; ++t) {
        const int s = s_begin + t;
        const int c = gdn_chain_chunk(dir, s);
        const int cn = gdn_chain_chunk(dir, t + 1 < 16 ? s + 1 : s);
        const unsigned char* buf = lds + (t & 1) * GS_BUF; unsigned char* nbuf = lds + ((t + 1) & 1) * GS_BUF;
        const bf16_t* sW = (const bf16_t*)(buf + GS_SW); const bf16_t* sQD = (const bf16_t*)(buf + GS_SQD);
        const bf16_t* sKDT = (const bf16_t*)(buf + GS_SKDT); const bf16_t* sATT = (const bf16_t*)(buf + GS_SATT);
        GsG1 g1; gs_load1(p, dh, cn, g1);
        GsG2 g2; gs_load2(p, dh, cn, g2);
        GsG3 g3; gs_load3(p, dh, cn, g3);
        f32x4 vn[4];
#pragma unroll
        for (int m = 0; m < 4; ++m) {
            f32x4 acc = (f32x4){0.f, 0.f, 0.f, 0.f};
#pragma unroll
            for (int kk = 0; kk < 4; ++kk)
                acc = __builtin_amdgcn_mfma_f32_16x16x32_bf16(*(const bf16x8*)(sW + (16 * m + rr) * GU_LDQ + kk * 32 + 8 * q4), Sb[kk], acc, 0, 0, 0);
            vn[m][0] = lo2f(ucur[m].x) - acc[0]; vn[m][1] = hi2f(ucur[m].x) - acc[1]; vn[m][2] = lo2f(ucur[m].y) - acc[2]; vn[m][3] = hi2f(ucur[m].y) - acc[3];
        }
        bf16x8 VB[2];
#pragma unroll
        for (int k2 = 0; k2 < 2; ++k2) {
            const unsigned a0 = pack2(vn[2 * k2][0], vn[2 * k2][1]), a1 = pack2(vn[2 * k2][2], vn[2 * k2][3]);
            const unsigned a2 = pack2(vn[2 * k2 + 1][0], vn[2 * k2 + 1][1]), a3 = pack2(vn[2 * k2 + 1][2], vn[2 * k2 + 1][3]);
            const u32x4 pk = {a0, a1, a2, a3}; VB[k2] = __builtin_bit_cast(bf16x8, pk);
        }
#pragma unroll
        for (int m = 0; m < 4; ++m) {
            f32x4 acc = (f32x4){0.f, 0.f, 0.f, 0.f};
#pragma unroll
            for (int kk = 0; kk < 4; ++kk)
                acc = __builtin_amdgcn_mfma_f32_16x16x32_bf16(*(const bf16x8*)(sQD + (16 * m + rr) * GU_LDQ + kk * 32 + 8 * q4), Sb[kk], acc, 0, 0, 0);
#pragma unroll
            for (int k2 = 0; k2 < 2; ++k2)
                acc = __builtin_amdgcn_mfma_f32_16x16x32_bf16(*(const bf16x8*)(sATT + (16 * m + rr) * GU_LDT + k2 * 32 + 8 * q4), VB[k2], acc, 0, 0, 0);
#pragma unroll
            for (int jj = 0; jj < 4; ++jj) {
                const int pos = 16 * m + 4 * q4 + jj;
                of[(size_t)(c * 64 + (dir ? 63 - pos : pos)) * 1024 + head * 128 + 16 * wave + rr] = f2bf(acc[jj]);
            }
        }
        const float egl = __expf(glcur);
#pragma unroll
        for (int m = 0; m < 8; ++m) {
            f32x4 acc = Sc[m] * egl;
#pragma unroll
            for (int k2 = 0; k2 < 2; ++k2)
                acc = __builtin_amdgcn_mfma_f32_16x16x32_bf16(*(const bf16x8*)(sKDT + (16 * m + rr) * GU_LDT + ((k2 * 32 + 8 * q4) ^ ((((16 * m + rr) >> 3) & 7) << 3))), VB[k2], acc, 0, 0, 0);
            Sc[m] = acc;
        }
#pragma unroll
        for (int kk = 0; kk < 4; ++kk) {
            const u32x4 pk = {pack2(Sc[2 * kk][0], Sc[2 * kk][1]), pack2(Sc[2 * kk][2], Sc[2 * kk][3]),
                              pack2(Sc[2 * kk + 1][0], Sc[2 * kk + 1][1]), pack2(Sc[2 * kk + 1][2], Sc[2 * kk + 1][3])};
            Sb[kk] = __builtin_bit_cast(bf16x8, pk);
        }
        gs_store1(g1, nbuf); gs_store2(g2, nbuf); gs_store3(g3, nbuf);
#pragma unroll
        for (int m = 0; m < 4; ++m) ucur[m] = g3.ut[m];
        glcur = g3.gl;
        lds_barrier();
    }
}

struct LdSet { u32x4 w[4]; u32x4 att[2]; u32x4 qv[4]; u32x4 kd[4]; float gcv; };
__device__ __forceinline__ void ld_load(const Params& p, int dh, int c, int ltid, LdSet& st) {
    const int dir = dh >> 3, head = dh & 7; const size_t u = (size_t)dh * NCH + c;
    const bf16_t* wg = (const bf16_t*)(p.ws + WS_W) + u * 64 * 128; const bf16_t* att = (const bf16_t*)(p.ws + WS_ATT) + u * 64 * 64;
    const float* gc = (const float*)(p.ws + WS_GC) + u * 64; const bf16_t* qn = (const bf16_t*)(p.ws + WS_QN); const bf16_t* kn = (const bf16_t*)(p.ws + WS_KN);
    st.gcv = gc[ltid & 63];
#pragma unroll
    for (int q = 0; q < 4; ++q) {
        const int t = ltid + q * 256, i = t >> 4, d8 = (t & 15) * 8;
        const size_t rowoff = (size_t)(c * 64 + (dir ? 63 - i : i)) * 1024 + head * 128 + d8;
        st.w[q] = *(const u32x4*)(wg + (size_t)i * 128 + d8);
        st.qv[q] = *(const u32x4*)(qn + rowoff);
        st.kd[q] = *(const u32x4*)(kn + rowoff);
    }
#pragma unroll
    for (int q = 0; q < 2; ++q) { const int t = ltid + q * 256; st.att[q] = *(const u32x4*)(att + (size_t)(t >> 3) * 64 + (t & 7) * 8); }
}
__device__ __forceinline__ void ld_store(const LdSet& st, int ltid, unsigned char* buf) {
    bf16_t* sW = (bf16_t*)(buf + GS_SW); bf16_t* sQD = (bf16_t*)(buf + GS_SQD); bf16_t* sKDT = (bf16_t*)(buf + GS_SKDT); bf16_t* sATT = (bf16_t*)(buf + GS_SATT);
    const float gl = __shfl(st.gcv, 63, 64);
#pragma unroll
    for (int q = 0; q < 4; ++q) {
        const int t = ltid + q * 256, i = t >> 4, d8 = (t & 15) * 8;
        const float gci = __shfl(st.gcv, i, 64);
        *(u32x4*)(sW + i * GU_LDQ + d8) = st.w[q];
        {
            const float e = __expf(gci); const u32x4 v = st.qv[q];
            u32x4 o; o.x = pack2(lo2f(v.x) * e, hi2f(v.x) * e); o.y = pack2(lo2f(v.y) * e, hi2f(v.y) * e); o.z = pack2(lo2f(v.z) * e, hi2f(v.z) * e); o.w = pack2(lo2f(v.w) * e, hi2f(v.w) * e);
            *(u32x4*)(sQD + i * GU_LDQ + d8) = o;
        }
        {
            const float e = __expf(gl - gci); const u32x4 kq = st.kd[q];
            u32x4 o; o.x = pack2(lo2f(kq.x) * e, hi2f(kq.x) * e); o.y = pack2(lo2f(kq.y) * e, hi2f(kq.y) * e); o.z = pack2(lo2f(kq.z) * e, hi2f(kq.z) * e); o.w = pack2(lo2f(kq.w) * e, hi2f(kq.w) * e);
            *(u32x4*)(sKDT + i * GU_LDQ + d8) = o;
        }
    }
#pragma unroll
    for (int q = 0; q < 2; ++q) { const int t = ltid + q * 256; *(u32x4*)(sATT + (t >> 3) * GU_LDT + (t & 7) * 8) = st.att[q]; }
}
__device__ __forceinline__ void gdn_seq_rs(const Params& p, int dh, int k, unsigned char* lds) {
    const int tid = tid_(), lane = tid & 63, wave = __builtin_amdgcn_readfirstlane(tid >> 6), rr = lane & 15, q4 = lane >> 4, dir = dh >> 3, head = dh & 7;
    const int s_begin = 4 + 16 * k;
    const bool loader = wave >= 4;
    __syncthreads();
    {
        const int c0 = gdn_chain_chunk(dir, s_begin);
        GsG1 g1; gs_load1(p, dh, c0, g1); gs_store1(g1, lds);
        GsG2 g2; gs_load2(p, dh, c0, g2); gs_store2(g2, lds);
        GsG3 g3; gs_load3(p, dh, c0, g3); gs_store3(g3, lds);
    }
    if (loader) {
        const int ltid = tid - 256;
        LdSet cur;
        ld_load(p, dh, gdn_chain_chunk(dir, s_begin + 1), ltid, cur);
        __syncthreads();
        bf16_t* of = (bf16_t*)(p.ws + WS_OF) + (size_t)dir * SEQ * 1024 + head * 128;
#define LD_OUT(tprev_) do { const bf16_t* sO = (const bf16_t*)(lds + 2 * GS_BUF + ((tprev_) & 1) * GS_OT); const int c = gdn_chain_chunk(dir, s_begin + (tprev_)); \
        _Pragma("unroll") for (int q = 0; q < 4; ++q) { const int tt = ltid + q * 256, pos = tt >> 4, c8 = (tt & 15) * 8; \
            *(u32x4*)(of + (size_t)(c * 64 + (dir ? 63 - pos : pos)) * 1024 + c8) = *(const u32x4*)(sO + pos * GU_LDQ + c8); } } while (0)
        LdSet nxt;
#define LD_STEP(t_, CUR, NXT) do { ld_load(p, dh, gdn_chain_chunk(dir, s_begin + ((t_) + 2 < 16 ? (t_) + 2 : 15)), ltid, NXT); \
        if ((t_) > 0) LD_OUT((t_) - 1); \
        ld_store(CUR, ltid, lds + (((t_) + 1) & 1) * GS_BUF);     \
        lds_barrier(); } while (0)
        LD_STEP(0, cur, nxt);
#pragma unroll 1
        for (int t = 1; t < 15; t += 2) {
            LD_STEP(t, nxt, cur);
            LD_STEP(t + 1, cur, nxt);
        }
        LD_STEP(15, nxt, cur);
#undef LD_STEP
        LD_OUT(15);
#undef LD_OUT
    } else {
        f32x4 Sc[2][8]; bf16x8 Sb[2][4];
        {
            const float4* sin_img = (const float4*)(p.ws + WS_SIN) + (size_t)(dh * 16 + k) * 4096;
#pragma unroll
            for (int sl = 0; sl < 2; ++sl) {
#pragma unroll
                for (int m = 0; m < 8; ++m) { const float4 v = sin_img[((2 * wave + sl) * 8 + m) * 64 + lane]; Sc[sl][m] = (f32x4){v.x, v.y, v.z, v.w}; }
#pragma unroll
                for (int kk = 0; kk < 4; ++kk) {
                    const u32x4 pk = {pack2(Sc[sl][2 * kk][0], Sc[sl][2 * kk][1]), pack2(Sc[sl][2 * kk][2], Sc[sl][2 * kk][3]), pack2(Sc[sl][2 * kk + 1][0], Sc[sl][2 * kk + 1][1]), pack2(Sc[sl][2 * kk + 1][2], Sc[sl][2 * kk + 1][3])};
                    Sb[sl][kk] = __builtin_bit_cast(bf16x8, pk);
                }
            }
        }
        const bf16_t* utbase = (const bf16_t*)(p.ws + WS_UT) + (size_t)(32 * wave + rr) * 64 + 16 * q4;
        const float* gcb = (const float*)(p.ws + WS_GC);
        u32x4 ucur[2][2]; float glcur;
        {
            const size_t u0 = (size_t)dh * NCH + gdn_chain_chunk(dir, s_begin);
#pragma unroll
            for (int sl = 0; sl < 2; ++sl)
#pragma unroll
                for (int hh = 0; hh < 2; ++hh) ucur[sl][hh] = *(const u32x4*)(utbase + u0 * 128 * 64 + sl * 16 * 64 + 8 * hh);
            glcur = gcb[u0 * 64 + 63];
        }
        __syncthreads();
#pragma unroll 1
        for (int t = 0; t < 16; ++t) {
            const size_t un = (size_t)dh * NCH + gdn_chain_chunk(dir, s_begin + (t + 1 < 16 ? t + 1 : t));
            u32x4 unext[2][2];
#pragma unroll
            for (int sl = 0; sl < 2; ++sl)
#pragma unroll
                for (int hh = 0; hh < 2; ++hh) unext[sl][hh] = *(const u32x4*)(utbase + un * 128 * 64 + sl * 16 * 64 + 8 * hh);
            const float glnext = gcb[un * 64 + 63];
            __builtin_amdgcn_sched_barrier(0);
            const unsigned char* buf = lds + (t & 1) * GS_BUF;
            const bf16_t* sW = (const bf16_t*)(buf + GS_SW); const bf16_t* sQD = (const bf16_t*)(buf + GS_SQD);
            const bf16_t* sKDT = (const bf16_t*)(buf + GS_SKDT); const bf16_t* sATT = (const bf16_t*)(buf + GS_SATT);
            bf16_t* sO = (bf16_t*)(lds + 2 * GS_BUF + (t & 1) * GS_OT);
            bf16x8 fa[4], fb[4];
#define GD_LW(dst, m_)  do { _Pragma("unroll") for (int kk = 0; kk < 4; ++kk) dst[kk] = *(const bf16x8*)(sW + (16 * (m_) + rr) * GU_LDQ + kk * 32 + 8 * q4); } while (0)
#define GD_LQ(dst, m_)  do { _Pragma("unroll") for (int kk = 0; kk < 4; ++kk) dst[kk] = *(const bf16x8*)(sQD + (16 * (m_) + rr) * GU_LDQ + kk * 32 + 8 * q4); } while (0)
#define GD_LA(dst, m_)  do { _Pragma("unroll") for (int k2 = 0; k2 < 2; ++k2) dst[k2] = *(const bf16x8*)(sATT + (16 * (m_) + rr) * GU_LDT + k2 * 32 + 8 * q4); } while (0)
#define GD_LK(dst, mp_) do { _Pragma("unroll") for (int h_ = 0; h_ < 2; ++h_) _Pragma("unroll") for (int k2 = 0; k2 < 2; ++k2) dst[2 * h_ + k2] = kd_frag(sKDT, 2 * (mp_) + h_, k2, rr, q4); } while (0)
#define GD_SB __builtin_amdgcn_sched_barrier(0)
            f32x4 vn[2][4];
#define GD_CW(m_, fr) do { f32x4 a0 = (f32x4){0.f, 0.f, 0.f, 0.f}, a1 = (f32x4){0.f, 0.f, 0.f, 0.f}; \
        _Pragma("unroll") for (int kk = 0; kk < 4; ++kk) { a0 = __builtin_amdgcn_mfma_f32_16x16x32_bf16(fr[kk], Sb[0][kk], a0, 0, 0, 0); a1 = __builtin_amdgcn_mfma_f32_16x16x32_bf16(fr[kk], Sb[1][kk], a1, 0, 0, 0); } \
        const unsigned u0a = ((m_) & 1) ? ucur[0][(m_) >> 1].z : ucur[0][(m_) >> 1].x, u0b = ((m_) & 1) ? ucur[0][(m_) >> 1].w : ucur[0][(m_) >> 1].y; \
        const unsigned u1a = ((m_) & 1) ? ucur[1][(m_) >> 1].z : ucur[1][(m_) >> 1].x, u1b = ((m_) & 1) ? ucur[1][(m_) >> 1].w : ucur[1][(m_) >> 1].y; \
        vn[0][m_][0] = lo2f(u0a) - a0[0]; vn[0][m_][1] = hi2f(u0a) - a0[1]; vn[0][m_][2] = lo2f(u0b) - a0[2]; vn[0][m_][3] = hi2f(u0b) - a0[3]; \
        vn[1][m_][0] = lo2f(u1a) - a1[0]; vn[1][m_][1] = hi2f(u1a) - a1[1]; vn[1][m_][2] = lo2f(u1b) - a1[2]; vn[1][m_][3] = hi2f(u1b) - a1[3]; } while (0)
            GD_LW(fa, 0);
            GD_LW(fb, 1); GD_SB; GD_CW(0, fa); GD_SB;
            GD_LW(fa, 2); GD_SB; GD_CW(1, fb); GD_SB;
            GD_LW(fb, 3); GD_SB; GD_CW(2, fa); GD_SB;
            GD_LQ(fa, 0); GD_SB; GD_CW(3, fb); GD_SB;
            bf16x8 VB[2][2];
#pragma unroll
            for (int sl = 0; sl < 2; ++sl)
#pragma unroll
                for (int k2 = 0; k2 < 2; ++k2) {
                    const u32x4 pk = {pack2(vn[sl][2 * k2][0], vn[sl][2 * k2][1]), pack2(vn[sl][2 * k2][2], vn[sl][2 * k2][3]), pack2(vn[sl][2 * k2 + 1][0], vn[sl][2 * k2 + 1][1]), pack2(vn[sl][2 * k2 + 1][2], vn[sl][2 * k2 + 1][3])};
                    VB[sl][k2] = __builtin_bit_cast(bf16x8, pk);
                }
            f32x4 o0, o1;
#define GD_CQ(fr) do { o0 = (f32x4){0.f, 0.f, 0.f, 0.f}; o1 = (f32x4){0.f, 0.f, 0.f, 0.f}; \
        _Pragma("unroll") for (int kk = 0; kk < 4; ++kk) { o0 = __builtin_amdgcn_mfma_f32_16x16x32_bf16(fr[kk], Sb[0][kk], o0, 0, 0, 0); o1 = __builtin_amdgcn_mfma_f32_16x16x32_bf16(fr[kk], Sb[1][kk], o1, 0, 0, 0); } } while (0)
#define GD_CA(m_, fr) do { _Pragma("unroll") for (int k2 = 0; k2 < 2; ++k2) { o0 = __builtin_amdgcn_mfma_f32_16x16x32_bf16(fr[k2], VB[0][k2], o0, 0, 0, 0); o1 = __builtin_amdgcn_mfma_f32_16x16x32_bf16(fr[k2], VB[1][k2], o1, 0, 0, 0); } \
        _Pragma("unroll") for (int jj = 0; jj < 4; ++jj) {     \
            bf16_t* orow = sO + (16 * (m_) + 4 * q4 + jj) * GU_LDQ + 32 * wave + rr; orow[0] = f2bf(o0[jj]); orow[16] = f2bf(o1[jj]); } } while (0)
            GD_LA(fb, 0); GD_SB; GD_CQ(fa); GD_SB;
            GD_LQ(fa, 1); GD_SB; GD_CA(0, fb); GD_SB;
            GD_LA(fb, 1); GD_SB; GD_CQ(fa); GD_SB;
            GD_LQ(fa, 2); GD_SB; GD_CA(1, fb); GD_SB;
            GD_LA(fb, 2); GD_SB; GD_CQ(fa); GD_SB;
            GD_LQ(fa, 3); GD_SB; GD_CA(2, fb); GD_SB;
            GD_LA(fb, 3); GD_SB; GD_CQ(fa); GD_SB;
            GD_LK(fa, 0); GD_SB; GD_CA(3, fb); GD_SB;
            const float egl = __expf(glcur);
#define GD_CK(mp_, fr) do { _Pragma("unroll") for (int h_ = 0; h_ < 2; ++h_) { const int m_ = 2 * (mp_) + h_; f32x4 a0 = Sc[0][m_] * egl, a1 = Sc[1][m_] * egl; \
        _Pragma("unroll") for (int k2 = 0; k2 < 2; ++k2) { a0 = __builtin_amdgcn_mfma_f32_16x16x32_bf16(fr[2 * h_ + k2], VB[0][k2], a0, 0, 0, 0); a1 = __builtin_amdgcn_mfma_f32_16x16x32_bf16(fr[2 * h_ + k2], VB[1][k2], a1, 0, 0, 0); } \
        Sc[0][m_] = a0; Sc[1][m_] = a1; } } while (0)
            GD_LK(fb, 1); GD_SB; GD_CK(0, fa); GD_SB;
            GD_LK(fa, 2); GD_SB; GD_CK(1, fb); GD_SB;
            GD_LK(fb, 3); GD_SB; GD_CK(2, fa); GD_SB;
            GD_CK(3, fb);
#undef GD_LW
#undef GD_LQ
#undef GD_LA
#undef GD_LK
#undef GD_SB
#undef GD_CW
#undef GD_CQ
#undef GD_CA
#undef GD_CK
#pragma unroll
            for (int sl = 0; sl < 2; ++sl)
#pragma unroll
                for (int kk = 0; kk < 4; ++kk) {
                    const u32x4 pk = {pack2(Sc[sl][2 * kk][0], Sc[sl][2 * kk][1]), pack2(Sc[sl][2 * kk][2], Sc[sl][2 * kk][3]), pack2(Sc[sl][2 * kk + 1][0], Sc[sl][2 * kk + 1][1]), pack2(Sc[sl][2 * kk + 1][2], Sc[sl][2 * kk + 1][3])};
                    Sb[sl][kk] = __builtin_bit_cast(bf16x8, pk);
                }
#pragma unroll
            for (int sl = 0; sl < 2; ++sl)
#pragma unroll
                for (int hh = 0; hh < 2; ++hh) ucur[sl][hh] = unext[sl][hh];
            glcur = glnext;
            lds_barrier();
        }
    }
}

__device__ __forceinline__ void gdn_readout_row(const Params& p, int row) {
    const int lane = tid_() & 63, head = lane >> 3, d0 = (lane & 7) * 16;
    const bf16_t* of0 = (const bf16_t*)(p.ws + WS_OF) + (size_t)row * 1024 + head * 128 + d0;
    const bf16_t* of1 = of0 + (size_t)SEQ * 1024;
    const bf16_t* zp = (const bf16_t*)(p.ws + WS_Z) + (size_t)row * 1024 + head * 128 + d0;
    float a[16], b[16], z[16];
    unpack8(*(const uint4*)of0, a); unpack8(*(const uint4*)(of0 + 8), a + 8);
    unpack8(*(const uint4*)of1, b); unpack8(*(const uint4*)(of1 + 8), b + 8);
    unpack8(*(const uint4*)zp, z); unpack8(*(const uint4*)(zp + 8), z + 8);
    float ss = 0.f;
#pragma unroll
    for (int e = 0; e < 16; ++e) { a[e] += b[e]; ss += a[e] * a[e]; }
    ss += __shfl_xor(ss, 1, 64); ss += __shfl_xor(ss, 2, 64); ss += __shfl_xor(ss, 4, 64);
    const float rs = rsqrtf(ss * (1.f / 128.f) + 1e-6f);
    const float* ng = p.in[25] + d0;
    float f[16];
#pragma unroll
    for (int e = 0; e < 16; ++e) f[e] = a[e] * rs * ng[e] * siluf_(z[e]);
    bf16_t* dst = (bf16_t*)(p.ws + WS_VN) + (size_t)row * 1024 + head * 128 + d0;
    *(uint4*)dst = pack8(f); *(uint4*)(dst + 8) = pack8(f + 8);
}

#define XB_TMO      128
#define XB_XCNT(j)  (256  + 64 * (j))
#define XB_XSUB(j)  (1280 + 64 * (j))
#define XB_XGEN(j)  (2304 + 64 * (j))
#define XB_TOP      3328
#define XB_TOPGEN   3392
#define XCD_BAR_WORDS 3456
#define XB_SPIN_CAP (1u << 22)
__device__ __forceinline__ unsigned xb_ld(unsigned* p)              { return __hip_atomic_load(p, __ATOMIC_RELAXED, __HIP_MEMORY_SCOPE_AGENT); }
__device__ __forceinline__ unsigned xb_add(unsigned* p, unsigned v) { return __hip_atomic_fetch_add(p, v, __ATOMIC_RELAXED, __HIP_MEMORY_SCOPE_AGENT); }
__device__ __forceinline__ unsigned xb_xcc_id() { return (unsigned)__builtin_amdgcn_s_getreg((3 << 11) | 20) & 0xFu; }
#define XB_SPIN(cond, bar) do { unsigned _sp = 0; while (cond) { __builtin_amdgcn_s_sleep(1); \
    if ((++_sp & 255u) == 0u) { if (xb_ld(&(bar)[XB_TMO])) break; if (_sp > XB_SPIN_CAP) { atomicAdd(&(bar)[XB_TMO], 1u); break; } } } } while (0)
struct XcdBarrier { unsigned* bar; unsigned x; volatile LAS unsigned* st; };
__device__ __forceinline__ XcdBarrier xcd_barrier_post(unsigned* bar, volatile LAS unsigned* st) {
    XcdBarrier b; b.bar = bar; b.x = xb_xcc_id(); b.st = st;
    if (threadIdx.x == 0) (void)xb_add(&bar[XB_XCNT(b.x)], 1u);
    return b;
}
__device__ __forceinline__ void xcd_barrier_complete(unsigned* bar, unsigned x, unsigned& nloc, unsigned& nx) {
    const unsigned G = gridDim.x * gridDim.y * gridDim.z;
    unsigned sum, cnt, mine, sp = 0u;
    for (;;) {
        sum = 0u; cnt = 0u; mine = 0u;
#pragma unroll
        for (unsigned j = 0; j < 16; ++j) { const unsigned c = xb_ld(&bar[XB_XCNT(j)]); sum += c; cnt += (c > 0u) ? 1u : 0u; mine = (j == x) ? c : mine; }
        if (sum == G) break;
        __builtin_amdgcn_s_sleep(1);
        if ((++sp & 255u) == 0u) { if (xb_ld(&bar[XB_TMO])) break; if (sp > XB_SPIN_CAP) { atomicAdd(&bar[XB_TMO], 1u); break; } }
    }
    nloc = mine > 0u ? mine : 1u; nx = cnt > 0u ? cnt : 1u;
}
__device__ __forceinline__ void xcd_barrier(const XcdBarrier& b) {
    asm volatile("s_waitcnt vmcnt(0)" ::: "memory");
    __syncthreads();
    if (threadIdx.x == 0) {
        unsigned* bar = b.bar;
        __builtin_amdgcn_s_waitcnt(0);
        unsigned nloc = b.st[0], nx = b.st[1];
        if (nloc == 0u) { xcd_barrier_complete(bar, b.x, nloc, nx); b.st[0] = nloc; b.st[1] = nx; }
        const unsigned old = xb_add(&bar[XB_XSUB(b.x)], 1u);
        const unsigned gen = old / nloc;
        if (old + 1u == (gen + 1u) * nloc) {
            __builtin_amdgcn_fence(__ATOMIC_RELEASE, "agent");
            asm volatile("s_waitcnt vmcnt(0)" ::: "memory");
            const unsigned og = xb_add(&bar[XB_TOP], 1u);
            const unsigned tg = og / nx;
            if (og + 1u == (tg + 1u) * nx) xb_add(&bar[XB_TOPGEN], 1u);
            else XB_SPIN(xb_ld(&bar[XB_TOPGEN]) == tg, bar);
            __builtin_amdgcn_fence(__ATOMIC_ACQUIRE, "agent");
            xb_add(&bar[XB_XGEN(b.x)], 1u);
            asm volatile("s_waitcnt vmcnt(0)" ::: "memory");
        } else {
            XB_SPIN(xb_ld(&bar[XB_XGEN(b.x)]) == gen, bar);
            __builtin_amdgcn_fence(__ATOMIC_ACQUIRE, "agent");
            asm volatile("s_waitcnt vmcnt(0)" ::: "memory");
        }
    }
    __syncthreads();
}

constexpr int PT_A = 672;
#ifndef PHMASK
#define PHMASK 0xFFFFFFFFull
#endif
#define PH(n) (((PHMASK) >> (n)) & 1ull)
#define FOR_ITEMS(n) for (int item = blockIdx.x; item < (n); item += gridDim.x)
__device__ __forceinline__ void mixer1_phases(const Params& p, unsigned char* ws, unsigned char* lds, const XcdBarrier& xbar) {
    if (PH(14)) {
        EpiOddIn e{(bf16_t*)(ws + WS_QKVR), (bf16_t*)(ws + WS_Z), (float*)(ws + WS_AB)};
        gemm_big((const bf16_t*)(ws + WS_ACT), (const bf16_t*)(ws + WS_WOIN), SEQ, 4096, 1024, e, lds);
        FOR_ITEMS(128 + 2 * 33) {
            if (item < 128) gemm_tile((const bf16_t*)(ws + WS_ACT), 1024, R, (const bf16_t*)(ws + WS_WOIN), 1024, ODD_IN, 1024, item * 128, 4096, e, lds);
            else { const int q = item - 128; gemm_tile((const bf16_t*)(ws + WS_ACT), 1024, R, (const bf16_t*)(ws + WS_WOIN), 1024, ODD_IN, 1024, SEQ + (q / 33) * 128, (q % 33) * 128, e, lds); }
        }
    }
    xcd_barrier(xbar);
    if (PH(15)) {
        u32x4 ra[GP_ROWS + 2], rb[GP_ROWS + 2]; GpW gw;
        gdn_prep_weights(p, gw);
        int item = blockIdx.x;
        gdn_prep_load(p, item, ra);
        const int G_ = (int)gridDim.x, NI_ = R / GP_ROWS;
#pragma unroll 1
        for (; item < NI_; item += 2 * G_) {
            gdn_prep_load(p, item + G_ < NI_ ? item + G_ : item, rb);
            gdn_prep_item(p, item, ra, gw);
            gdn_prep_load(p, item + 2 * G_ < NI_ ? item + 2 * G_ : item, ra);
            if (item + G_ < NI_) gdn_prep_item(p, item + G_, rb, gw);
        }
    }
    xcd_barrier(xbar);
    if (PH(16)) {
        GuPre pre; GuOut po;
#pragma unroll
        for (int m = 0; m < 4; ++m) { po.o[m] = (u32x2){0u, 0u}; po.w[m] = (u32x2){0u, 0u}; }
        int item = blockIdx.x, prev = blockIdx.x;
        if (item < NUNITS) gu_prefetch(p, item, pre);
        for (; item < NUNITS; item += gridDim.x) { gdn_unit(p, item, item + (int)gridDim.x, pre, po, prev, lds); prev = item; }
        gu_flush(p, prev, po);
    }
    xcd_barrier(xbar);
    if (PH(17)) {
        FOR_ITEMS(256) { const int kk_ = item & 15; if (kk_ == 0) gdn_seg_ab<true>(p, item >> 4, 0, lds); else if (kk_ != 15) gdn_seg_ab<false>(p, item >> 4, kk_, lds); }
        xcd_barrier(xbar);
        if (blockIdx.x < 16) gdn_seg_chain(p, blockIdx.x, lds);
        else {
            for (int item = (int)blockIdx.x - 16; item < 256 + 2048; item += (int)gridDim.x - 16) {
                if (item < 256) p0_transpose(p.in[26], 1024, 1024, (bf16_t*)(ws + WS_WOOUT), item, lds);
                else peer_tables_item(p, item - 256, 1);
            }
        }
        xcd_barrier(xbar);
        FOR_ITEMS(256) gdn_seq_rs(p, item >> 4, item & 15, lds);
    }
    xcd_barrier(xbar);
    if (PH(18)) FOR_ITEMS(SEQ / 8) gdn_readout_row(p, item * 8 + (tid_() >> 6));
    xcd_barrier(xbar);
    if (PH(19)) {
        EpiResid e{p.in[0], p.in[2], (bf16_t*)(ws + WS_H), (const float*)(ws + WS_MOD), 1, false};
        gemm_big((const bf16_t*)(ws + WS_VN), (const bf16_t*)(ws + WS_WOOUT), SEQ, 1024, 1024, e, lds);
    }
    xcd_barrier(xbar);
}

template <int L>
__device__ __forceinline__ void peer_phases(const Params& p, unsigned char* ws, unsigned char* lds, const XcdBarrier& xbar) {
    constexpr int l = L;
    constexpr int nrows = L == 0 ? R : SEQ, ntm = nrows / 128;
    if (PH(8)) {
        norm_rows_batch8(p, (int)blockIdx.x, SEQ / 8, (int)gridDim.x, l, p.in[7] + l * 1024, 3);
        if (l == 0) { FOR_ITEMS(CTX / 8) norm_rows_item(p, SEQ / 8 + item, l, p.in[7] + l * 1024, 3, false); }
    }
    xcd_barrier(xbar);
    if (PH(9)) {
        EpiScore e{(unsigned short*)(ws + WS_SC), 0};
        const bf16_t* wq = (const bf16_t*)(ws + (l == 0 ? WS_WQ0 : WS_WQ1));
        gemm_big((const bf16_t*)(ws + WS_ACT), wq, SEQ, 2048, 1024, e, lds);
        if (l == 0) { FOR_ITEMS(2 * 16) gemm_tile((const bf16_t*)(ws + WS_ACT), 1024, R, wq, 1024, 2048, 1024, SEQ + (item >> 4) * 128, (item & 15) * 128, e, lds); }
    }
    xcd_barrier(xbar);
    const bool own_rows = (int)gridDim.x == SEQ / 64 && (int)gridDim.x == CTX;
    if (PH(11)) {
        FOR_ITEMS(SEQ / 64) peer_route_item(p, item, nrows, lds);
        if (l == 0) {
            __syncthreads();
            FOR_ITEMS(CTX) peer_route_pair_wave(p, SEQ + item, tid_() >> 6, (unsigned*)lds + (tid_() >> 6) * 64);
        }
    }
    if (own_rows) { __threadfence_block(); __syncthreads(); } else xcd_barrier(xbar);
    if (PH(12)) {
        float* cst = (float*)(lds + 128 * 1024);
        __syncthreads();
        for (int c = tid_(); c < 1024; c += NTHREADS) {
            cst[c] = modp(p, l, 0, 5)[c];
            if (l == 0) { cst[1024 + c] = p.in[6][(l + 1) * 1024 + c] * (1.f + modp(p, l + 1, 0, 1)[c]); cst[2048 + c] = modp(p, l + 1, 0, 0)[c]; }
            else cst[1024 + c] = p.in[31][c];
        }
        __syncthreads();
        if (own_rows) {
            const int w_ = tid_() >> 6, g_ = (tid_() & 63) >> 4;
            for (int q = 0; q < 2; ++q) peer_gather_rows4(p, (int)blockIdx.x * 64 + 32 * q + 8 * g_ + w_, true, l, l == 1, lds + w_ * 16384, cst);
        } else
        {
            const int w_ = tid_() >> 6, g_ = (tid_() & 63) >> 4, G_ = (int)gridDim.x;
            for (int it0 = (int)blockIdx.x; it0 < SEQ / 8; it0 += 4 * G_) {
                const int it = it0 + g_ * G_; const bool valid = it < SEQ / 8;
                peer_gather_rows4(p, (valid ? it : it0) * 8 + w_, valid, l, l == 1, lds + w_ * 16384, cst);
            }
        }
        if (l == 0) { __syncthreads(); FOR_ITEMS(CTX) peer_gather_row_split(p, SEQ + item, 0, lds); }
    }
}

__global__ void __launch_bounds__(NTHREADS) fwd_megakernel(Params p) {
    extern __shared__ __attribute__((aligned(16))) unsigned char lds[];
    cg::grid_group grid = cg::this_grid();
    unsigned char* ws = p.ws;
    volatile LAS unsigned* xbst = (volatile LAS unsigned*)(LAS unsigned char*)(lds + LDS_BYTES - 16);
    if (threadIdx.x == 0) { xbst[0] = 0u; xbst[1] = 0u; }
    __syncthreads();
    const XcdBarrier xbar = xcd_barrier_post((unsigned*)(ws + WS_BAR), xbst);

    if (PH(0)) {
        constexpr int N_S5 = 256, N_ADA = 192, N_T0 = 512, N_T1 = 64, N_T2 = 256, N_T5 = 1024, N_SK = 16;
        constexpr int O1 = N_S5, O2 = O1 + N_ADA, O3 = O2 + N_T0, O4 = O3 + N_T1, O5 = O4 + N_T2, O6 = O5 + N_T5, O7 = O6 + N_SK;
        FOR_ITEMS(O7) {
            if (item < O1) p0_s5_tables(p, item, lds);
            else if (item < O2) p0_adaln(p, item - O1, lds);
            else if (item < O3) p0_transpose(p.in[8], 1024, 2048, (bf16_t*)(ws + WS_WEIN), item - O2, lds);
            else if (item < O4) p0_transpose(p.in[18], 512, 512, (bf16_t*)(ws + WS_WGLU), item - O3, lds);
            else if (item < O5) p0_transpose(p.in[20], 1024, 1024, (bf16_t*)(ws + WS_WEOUT), item - O4, lds);
            else if (item < O6) cvt_chunk(p.in[27], (bf16_t*)(ws + WS_WQB), item - O5);
            else cvt_chunk(p.in[28], (bf16_t*)(ws + WS_SK), item - O6);
        }
    }
    if (p.ws == nullptr) grid.sync();
    xcd_barrier(xbar);
    if (PH(1)) FOR_ITEMS(2080 + 2048 + 256) {
        if (item < 2080) norm_rows_item(p, item, 0, p.in[6], 0, true);
        else if (item < 2080 + 2048) s5_mintra_item(p, item - 2080);
        else {
            const int q = item - 4128, l = q >> 7, b = (q >> 3) & 15, tn = q & 7;
            EpiBf16 e{(bf16_t*)(ws + (l == 0 ? WS_WQ0 : WS_WQ1)) + (size_t)b * 128 * 1024, 1024};
            gemm_tile((const bf16_t*)(ws + WS_SK) + (size_t)(l * 2 + (b & 1)) * 128 * 128, 128, 128,
                      (const bf16_t*)(ws + WS_WQB) + (size_t)l * 1024 * 2048 + b * 128, 2048, 1024, 128, 0, tn * 128, e, lds);
        }
    }
    xcd_barrier(xbar);
    if (PH(2)) {
        EpiEvenIn e{(bf16_t*)(ws + WS_PA), (bf16_t*)(ws + WS_UG)};
        gemm_big((const bf16_t*)(ws + WS_ACT), (const bf16_t*)(ws + WS_WEIN), SEQ, 2048, 1024, e, lds);
        FOR_ITEMS(2 * 16) gemm_tile((const bf16_t*)(ws + WS_ACT), 1024, R, (const bf16_t*)(ws + WS_WEIN), 1024, 2048, 1024, SEQ + (item >> 4) * 128, (item & 15) * 128, e, lds);
        if ((int)gridDim.x > 32 && blockIdx.x >= 32) for (int item = (int)blockIdx.x - 32; item < PT_A; item += (int)gridDim.x - 32) peer_tables_item(p, item, 0);
    }
    xcd_barrier(xbar);
    if (PH(3)) for (int t = (int)blockIdx.x >> 3; t < 4 * 15; t += (int)gridDim.x >> 3) {
        const int g = ((int)blockIdx.x & 7) + 8 * (t / 15), r = t % 15, tm = r / 5, tn = r % 5;
        EpiS5Local e{(bf16_t*)(ws + WS_YL), (float*)(ws + WS_LST), g};
        gemm_tile_n256((const bf16_t*)(ws + WS_UG) + (size_t)g * NCH * 1024, 1024, NCH, (const bf16_t*)(ws + WS_MS5) + (size_t)g * 1280 * 1024, 1024, 1280, 1024, tm * 128, tn * 256, e, lds);
    }
    xcd_barrier(xbar);
    if (PH(4)) {
        s5_scan(p);
        if (blockIdx.x >= 8) {
            const int lo = (int)gridDim.x > 32 ? PT_A : 0;
            for (int item = lo + (int)blockIdx.x - 8; item < 2048; item += (int)gridDim.x - 8) peer_tables_item(p, item, 0);
        }
    }
    xcd_barrier(xbar);
    if (PH(5)) FOR_ITEMS(32 * 24) {
        const int g = item / 24, r = item % 24, tm = r / 8, tn = r % 8;
        EpiS5Out e{(const bf16_t*)(ws + WS_YL), (bf16_t*)(ws + WS_GS), g};
        gemm_tile((const bf16_t*)(ws + WS_A5) + (size_t)g * NCH * 256, 256, NCH, (const bf16_t*)(ws + WS_O5) + (size_t)g * 1024 * 256, 256, 1024, 256, tm * 128, tn * 128, e, lds);
    }
    xcd_barrier(xbar);
    if (PH(6)) {
        EpiGlu e{(const bf16_t*)(ws + WS_GS), p.in[19], (bf16_t*)(ws + WS_CB)};
        gemm_big((const bf16_t*)(ws + WS_GS), (const bf16_t*)(ws + WS_WGLU), SEQ, 512, 512, e, lds);
        const int G = (int)gridDim.x, nfree = G > 128 ? G - 128 : G, rank = G > 128 ? (int)blockIdx.x - 128 : (int)blockIdx.x;
        if (rank >= 0) for (int item = rank; item < 2 * NCH + 8; item += nfree) {
            if (item < 2 * NCH) even_conv_item(p, item);
            else { const int q = item - 2 * NCH; gemm_tile((const bf16_t*)(ws + WS_GS), 512, R, (const bf16_t*)(ws + WS_WGLU), 512, 512, 512, SEQ + (q >> 2) * 128, (q & 3) * 128, e, lds); }
        }
    }
    xcd_barrier(xbar);
    if (PH(7)) {
        EpiResid e{p.in[0], p.in[2], (bf16_t*)(ws + WS_H), (const float*)(ws + WS_MOD), 0, true};
        gemm_big((const bf16_t*)(ws + WS_CB), (const bf16_t*)(ws + WS_WEOUT), SEQ, 1024, 1024, e, lds);
        FOR_ITEMS(2 * 8) gemm_tile((const bf16_t*)(ws + WS_CB), 1024, R, (const bf16_t*)(ws + WS_WEOUT), 1024, 1024, 1024, SEQ + (item >> 3) * 128, (item & 7) * 128, e, lds);
        if ((int)gridDim.x > 16) { if (blockIdx.x >= 16) p0_transpose_run(p.in[21], 1024, ODD_IN, (bf16_t*)(ws + WS_WOIN), (int)blockIdx.x - 16, 16 * 65, (int)gridDim.x - 16, lds); }
        else p0_transpose_run(p.in[21], 1024, ODD_IN, (bf16_t*)(ws + WS_WOIN), (int)blockIdx.x, 16 * 65, (int)gridDim.x, lds);
    }
    xcd_barrier(xbar);
    peer_phases<0>(p, ws, lds, xbar);
    xcd_barrier(xbar);
    mixer1_phases(p, ws, lds, xbar);
    peer_phases<1>(p, ws, lds, xbar);
}

extern "C" void kernel_launch(void* const* d_in, const int* in_sizes, int n_in, void* d_out, int out_size, void* d_ws, size_t ws_size, hipStream_t stream) {
    static int grid_blocks = 0;
    if (grid_blocks == 0) {
        if (n_in != 32 || out_size != SEQ * D || ws_size < WS_NEED) {
            fprintf(stderr, "kernel_launch: unexpected problem (n_in %d, out %d, ws %zu, need %zu); nothing launched\n", n_in, out_size, ws_size, (size_t)WS_NEED);
            grid_blocks = -1; return;
        }
        int dev = 0, cus = 0, per_cu = 0;
        hipGetDevice(&dev);
        hipDeviceGetAttribute(&cus, hipDeviceAttributeMultiprocessorCount, dev);
        hipFuncSetAttribute((const void*)fwd_megakernel, hipFuncAttributeMaxDynamicSharedMemorySize, LDS_BYTES);
        hipOccupancyMaxActiveBlocksPerMultiprocessor(&per_cu, (const void*)fwd_megakernel, NTHREADS, LDS_BYTES);
        if (per_cu < 1) { fprintf(stderr, "kernel_launch: occupancy query says %d blocks per CU; nothing launched\n", per_cu); grid_blocks = -1; return; }
        grid_blocks = cus;
    }
    if (grid_blocks < 0) return;
    (void)hipMemsetAsync((unsigned char*)d_ws + WS_BAR, 0, XCD_BAR_WORDS * 4, stream);
    Params prm{};
    for (int i = 0; i < 32; ++i) prm.in[i] = (const float*)d_in[i];
    prm.out = (float*)d_out; prm.ws = (unsigned char*)d_ws;
    void* args[] = {&prm};
    hipError_t e = hipLaunchCooperativeKernel((const void*)fwd_megakernel, dim3(grid_blocks), dim3(NTHREADS), args, LDS_BYTES, stream);
    if (e != hipSuccess) fprintf(stderr, "cooperative launch failed: %s (grid %d)\n", hipGetErrorString(e), grid_blocks);
}
```
